# Optimizing an MI355X kernel written in HIP

```python
import jax, jax.numpy as jnp
from jax import lax
import numpy as np

D_MODEL = 1024
BATCH = 2
SEQ = 8192
DEPTH = 1

GRID_W = 64
NA_HEADS = 8
NA_HEAD_DIM = 64
NA_WIN_ROWS_MAX = 8
NA_WIN_COLS = 16
NA_WIDTH = NA_HEADS * NA_HEAD_DIM
MLA_HEADS = 8
MLA_Q_LORA = 384
MLA_KV_LORA = 256
MLA_NOPE = 64
MLA_ROPE = 32
MLA_V = 64
MLA_WIDTH = MLA_HEADS * MLA_V
ROPE_THETA = 100.0
Q_BLOCK = 128
IN_COLS = 3 * NA_WIDTH + MLA_Q_LORA + MLA_KV_LORA + MLA_ROPE + 2 * D_MODEL
N_EXPERTS = 32
TOP_K = 4
D_FF = 1024
SWIGLU_ALPHA = 1.702
SWIGLU_LIMIT = 7.0
MOE_BLOCK = 256
RMS_EPS = 1e-6

kernel_name = 'hybrid_na_mla_moe_block'


def rms_norm(x, g):
    xf = x.astype(jnp.float32)
    y = xf * lax.rsqrt(jnp.mean(xf * xf, axis=-1, keepdims=True) + RMS_EPS)
    return (y * g.astype(jnp.float32)).astype(x.dtype)


def rope_2d(x, rows, cols):
    half = MLA_ROPE // 2
    nf = half // 2
    inv = ROPE_THETA ** (-jnp.arange(nf, dtype=jnp.float32) / nf)

    def rot(xa, pos):
        ang = pos.astype(jnp.float32)[:, None] * inv
        cos, sin = jnp.cos(ang), jnp.sin(ang)
        xa = xa.astype(jnp.float32)
        x1, x2 = xa[..., :nf], xa[..., nf:]
        return jnp.concatenate([x1 * cos - x2 * sin, x1 * sin + x2 * cos], axis=-1)

    out = jnp.concatenate([rot(x[..., :half], rows), rot(x[..., half:], cols)], axis=-1)
    return out.astype(x.dtype)


def neighborhood_attention(q, k, v, rpb):
    B, H, S, Dh = q.shape
    rows = S // GRID_W
    kh = min(NA_WIN_ROWS_MAX, rows)
    kw = NA_WIN_COLS
    r = jnp.arange(rows)
    cidx = jnp.arange(GRID_W)
    row_start = jnp.clip(r - kh // 2, 0, rows - kh)
    col_start = jnp.clip(cidx - kw // 2, 0, GRID_W - kw)
    key_rows = row_start[:, None] + jnp.arange(kh)[None, :]
    qg = q.reshape(B, H, rows, GRID_W, Dh)
    kg = k.reshape(B, H, rows, GRID_W, Dh)[:, :, key_rows]
    vg = v.reshape(B, H, rows, GRID_W, Dh)[:, :, key_rows]
    s = jnp.einsum('bhrqd,bhrjkd->bhrqjk', qg, kg).astype(jnp.float32) * (Dh ** -0.5)
    dr = key_rows - r[:, None] + (NA_WIN_ROWS_MAX - 1)
    dc = jnp.clip(cidx[None, :] - cidx[:, None], -(kw - 1), kw - 1) + (kw - 1)
    bias = rpb.astype(jnp.float32)[:, dr][..., dc]
    s = s + bias.transpose(0, 1, 3, 2, 4)[None]
    col_in = (cidx[None, :] >= col_start[:, None]) & (cidx[None, :] < col_start[:, None] + kw)
    s = jnp.where(col_in[None, None, None, :, None, :], s, -1e30)
    p = jax.nn.softmax(s.reshape(B, H, rows, GRID_W, kh * GRID_W), axis=-1)
    p = p.reshape(B, H, rows, GRID_W, kh, GRID_W).astype(v.dtype)
    o = jnp.einsum('bhrqjk,bhrjkd->bhrqd', p, vg)
    return o.reshape(B, H, S, Dh)


def mla_attention(cq_lat, ckv_lat, k_rope, q_norm_g, kv_norm_g, w_uq, w_ukv, rows, cols):
    B, S, _ = cq_lat.shape
    c_q = rms_norm(cq_lat, q_norm_g)
    q = jnp.einsum('bsr,rhd->bhsd', c_q, w_uq)
    q_nope = q[..., :MLA_NOPE]
    q_rope = rope_2d(q[..., MLA_NOPE:], rows, cols)
    c_kv = rms_norm(ckv_lat, kv_norm_g)
    kv = jnp.einsum('bsr,rhd->bhsd', c_kv, w_ukv)
    k_nope, v = kv[..., :MLA_NOPE], kv[..., MLA_NOPE:]
    k_r = rope_2d(k_rope, rows, cols)
    scale = (MLA_NOPE + MLA_ROPE) ** -0.5
    nb = S // Q_BLOCK
    qn_b = q_nope.reshape(B, MLA_HEADS, nb, Q_BLOCK, MLA_NOPE).transpose(2, 0, 1, 3, 4)
    qr_b = q_rope.reshape(B, MLA_HEADS, nb, Q_BLOCK, MLA_ROPE).transpose(2, 0, 1, 3, 4)

    def block(args):
        qn, qr = args
        s = jnp.einsum('bhqd,bhkd->bhqk', qn, k_nope) + jnp.einsum('bhqd,bkd->bhqk', qr, k_r)
        p = jax.nn.softmax(s.astype(jnp.float32) * scale, axis=-1).astype(v.dtype)
        return jnp.einsum('bhqk,bhkd->bhqd', p, v)

    o = lax.map(block, (qn_b, qr_b))
    o = o.transpose(1, 0, 3, 2, 4).reshape(B, S, MLA_WIDTH)
    return o


def clamped_swiglu(hcat):
    x_glu = jnp.minimum(hcat[..., ::2], SWIGLU_LIMIT)
    x_lin = jnp.clip(hcat[..., 1::2], -SWIGLU_LIMIT, SWIGLU_LIMIT)
    return x_glu * jax.nn.sigmoid(SWIGLU_ALPHA * x_glu) * (x_lin + 1)


def moe_ffn(h, w_router, b_router, w1, b1, w2, b2):
    B, S, D = h.shape
    T = B * S
    xf = h.reshape(T, D)
    logits = (xf @ w_router + b_router).astype(jnp.float32)
    top_vals, top_idx = lax.top_k(logits, TOP_K)
    gates = jax.nn.softmax(top_vals, axis=-1)
    n_items = T * TOP_K
    flat_e = top_idx.reshape(-1)
    flat_tok = jnp.arange(n_items, dtype=jnp.int32) // TOP_K
    flat_g = gates.reshape(-1)
    order = jnp.argsort(flat_e)
    e_sorted = flat_e[order]
    counts = jnp.bincount(flat_e, length=N_EXPERTS)
    padded = ((counts + MOE_BLOCK - 1) // MOE_BLOCK) * MOE_BLOCK
    start = jnp.cumsum(counts) - counts
    pend = jnp.cumsum(padded)
    pstart = pend - padded
    dest = pstart[e_sorted] + (jnp.arange(n_items, dtype=jnp.int32) - start[e_sorted])
    nblk = -(-n_items // MOE_BLOCK) + N_EXPERTS
    cap = nblk * MOE_BLOCK
    buf_tok = jnp.zeros((cap,), jnp.int32).at[dest].set(flat_tok[order])
    buf_g = jnp.zeros((cap,), jnp.float32).at[dest].set(flat_g[order])
    blk_e = jnp.minimum(jnp.searchsorted(pend, jnp.arange(nblk) * MOE_BLOCK, side='right'), N_EXPERTS - 1)
    xb = xf[buf_tok].reshape(nblk, MOE_BLOCK, D)

    def expert_block(args):
        xblk, e = args
        hcat = xblk @ w1[e] + b1[e]
        return clamped_swiglu(hcat) @ w2[e] + b2[e]

    yb = lax.map(expert_block, (xb, blk_e)).reshape(cap, D)
    out = jnp.zeros((T, D), h.dtype).at[buf_tok].add(yb * buf_g[:, None].astype(yb.dtype))
    return out.reshape(B, S, D)


def setup_inputs(seed: int = 0) -> dict:
    key = jax.random.key(seed)
    ks = jax.random.split(key, 24)
    L, D, E = DEPTH, D_MODEL, N_EXPERTS
    nrm = lambda k, shape, s: jax.random.normal(k, shape, jnp.float32) * s
    gain = lambda k: 1.0 + nrm(k, (L, D), 0.02)
    return {
        'x': nrm(ks[0], (BATCH, SEQ, D), 1.0),
        'c': nrm(ks[1], (BATCH, D), 1.0),
        'w_ada': nrm(ks[2], (L, D, 6 * D), D ** -0.5),
        'b_ada': nrm(ks[3], (L, 6 * D), 0.02),
        'g_attn_pre': gain(ks[4]),
        'g_attn_post': gain(ks[5]),
        'w_in': nrm(ks[6], (L, D, IN_COLS), D ** -0.5),
        'b_gate': nrm(ks[7], (L, 2 * D), 0.02),
        'na_rpb': nrm(ks[8], (L, NA_HEADS, 2 * NA_WIN_ROWS_MAX - 1, 2 * NA_WIN_COLS - 1), 0.02),
        'q_norm_g': 1.0 + nrm(ks[9], (L, MLA_Q_LORA), 0.02),
        'kv_norm_g': 1.0 + nrm(ks[10], (L, MLA_KV_LORA), 0.02),
        'w_uq': nrm(ks[11], (L, MLA_Q_LORA, MLA_HEADS, MLA_NOPE + MLA_ROPE), MLA_Q_LORA ** -0.5),
        'w_ukv': nrm(ks[12], (L, MLA_KV_LORA, MLA_HEADS, MLA_NOPE + MLA_V), MLA_KV_LORA ** -0.5),
        'w_na_up': nrm(ks[13], (L, NA_WIDTH, D), NA_WIDTH ** -0.5),
        'w_mla_up': nrm(ks[14], (L, MLA_WIDTH, D), MLA_WIDTH ** -0.5),
        'w_out': nrm(ks[15], (L, D, D), D ** -0.5),
        'g_ffn_pre': gain(ks[16]),
        'g_ffn_post': gain(ks[17]),
        'w_router': nrm(ks[18], (L, D, E), D ** -0.5),
        'b_router': nrm(ks[19], (L, E), 0.01),
        'w1': nrm(ks[20], (L, E, D, 2 * D_FF), D ** -0.5),
        'b1': nrm(ks[21], (L, E, 2 * D_FF), 0.01),
        'w2': nrm(ks[22], (L, E, D_FF, D), D_FF ** -0.5),
        'b2': nrm(ks[23], (L, E, D), 0.01),
    }


def reference(x, c, w_ada, b_ada, g_attn_pre, g_attn_post, w_in, b_gate, na_rpb, q_norm_g, kv_norm_g,
              w_uq, w_ukv, w_na_up, w_mla_up, w_out, g_ffn_pre, g_ffn_post, w_router, b_router,
              w1, b1, w2, b2):
    B, S, D = x.shape
    t = jnp.arange(S, dtype=jnp.int32)
    rows, cols = t // GRID_W, t % GRID_W
    split_at = np.cumsum([3 * NA_WIDTH, MLA_Q_LORA, MLA_KV_LORA, MLA_ROPE, D_MODEL]).tolist()
    sc = jax.nn.silu(c)
    for l in range(DEPTH):
        mod = sc @ w_ada[l] + b_ada[l]
        shift_a, scale_a, gate_a, shift_f, scale_f, gate_f = [m[:, None, :] for m in jnp.split(mod, 6, axis=-1)]
        h = rms_norm(x, g_attn_pre[l]) * (1 + scale_a) + shift_a
        proj = h @ w_in[l]
        na_qkv, cq_lat, ckv_lat, k_rope, g_na, g_mla = jnp.split(proj, split_at, axis=-1)
        na_qkv = na_qkv.reshape(B, S, 3, NA_HEADS, NA_HEAD_DIM).transpose(2, 0, 3, 1, 4)
        o_na = neighborhood_attention(na_qkv[0], na_qkv[1], na_qkv[2], na_rpb[l])
        o_na = o_na.transpose(0, 2, 1, 3).reshape(B, S, NA_WIDTH)
        o_mla = mla_attention(cq_lat, ckv_lat, k_rope, q_norm_g[l], kv_norm_g[l], w_uq[l], w_ukv[l], rows, cols)
        gates = jax.nn.sigmoid(jnp.concatenate([g_na, g_mla], axis=-1) + b_gate[l])
        merged = gates[..., :D_MODEL] * (o_na @ w_na_up[l]) + gates[..., D_MODEL:] * (o_mla @ w_mla_up[l])
        y = merged @ w_out[l]
        x = x + gate_a * rms_norm(y, g_attn_post[l])
        h = rms_norm(x, g_ffn_pre[l]) * (1 + scale_f) + shift_f
        y = moe_ffn(h, w_router[l], b_router[l], w1[l], b1[l], w2[l], b2[l])
        x = x + gate_f * rms_norm(y, g_ffn_post[l])
    return x
```

```cpp
#include <hip/hip_runtime.h>
#include <hip/hip_bf16.h>
#include <cstdio>
#include <cstdint>

#ifndef MK_N_LAUNCHES
#define MK_N_LAUNCHES 11
#endif

constexpr int BATCH = 2, SEQ = 8192, DM = 1024, MTOK = BATCH * SEQ;
constexpr int NPROJ = 4352;
constexpr int NEXP = 32, DFF = 1024, TOPK = 4;
constexpr int QLORA = 384, KVLORA = 256;
constexpr float RMS_EPS = 1e-6f;
constexpr float LOG2E = 1.4426950408889634f;
constexpr float C2NA = 0.125f * LOG2E;
constexpr float C2MLA = 0.10206207261596575f * LOG2E;
constexpr int LISTCAP = 16384;
constexpr int MAXROWS = 65536 + NEXP * 256;

#define GAS __attribute__((address_space(1)))
#define LAS __attribute__((address_space(3)))
typedef unsigned short bf16_t;
typedef short bf16x8 __attribute__((ext_vector_type(8)));
typedef short s16x4 __attribute__((ext_vector_type(4)));
typedef float f32x4 __attribute__((ext_vector_type(4)));
typedef float f32x2 __attribute__((ext_vector_type(2)));
typedef float f32x16 __attribute__((ext_vector_type(16)));
typedef unsigned u32x4 __attribute__((ext_vector_type(4)));
typedef unsigned u32x2 __attribute__((ext_vector_type(2)));
typedef GAS unsigned gu32;

__device__ __forceinline__ unsigned cvt_pk_bf16(float lo, float hi) { unsigned r; asm volatile("v_cvt_pk_bf16_f32 %0, %1, %2" : "=v"(r) : "v"(lo), "v"(hi)); return r; }
__device__ __forceinline__ float bf16_lo(unsigned w) { return __uint_as_float(w << 16); }
__device__ __forceinline__ float bf16_hi(unsigned w) { return __uint_as_float(w & 0xffff0000u); }
__device__ __forceinline__ float sigmoidf_(float z) { return __builtin_amdgcn_rcpf(1.f + __builtin_amdgcn_exp2f(-z * LOG2E)); }
__device__ __forceinline__ float wave_sum(float v) {
#pragma unroll
    for (int o = 1; o < 64; o <<= 1) v += __shfl_xor(v, o);
    return v;
}
__device__ __forceinline__ void rope_cs(float pos, int j, float& c, float& s) {
    const float inv = __builtin_amdgcn_exp2f(-(float)j * 0.83048202372184059f);
    const float rev = __builtin_amdgcn_fractf(pos * inv * 0.15915494309189535f);
    c = __builtin_amdgcn_cosf(rev); s = __builtin_amdgcn_sinf(rev);
}

namespace pg8 {
constexpr int BM = 256, BK = 64, HALF = 128, HTB = HALF * BK * 2, STAGE_BYTES = 8 * HTB, NXCD = 8, WGM = 8;
__host__ __device__ __forceinline__ int lds_byte(int r, int c) { const int st = (r >> 4) * 2 + (c >> 5), rr = r & 15, cc = c & 31, ob = rr * 64 + cc * 2; return st * 1024 + (ob ^ (((ob >> 9) & 1) << 5)); }
__host__ __device__ __forceinline__ void stage_rc(int b, int& R, int& C) { const int st = b / 1024, sb = b % 1024, swz = sb ^ (((sb >> 9) & 1) << 5); R = (st >> 1) * 16 + swz / 64; C = (st & 1) * 32 + (swz % 64) / 2; }
__host__ __device__ __forceinline__ int perm32(int rho) { const int n = rho >> 4, i = rho & 15; return 8 * (i >> 2) + 4 * n + (i & 3); }

struct Unit { const char* A; const char* B; int pm, pn, aux, tab; };

__device__ __forceinline__ void tile_of(int wgid, int nM, int nN, int& pm, int& pn) {
    const int nwg = nM * nN;
    { const int q = nwg / NXCD, r = nwg % NXCD, xcd = wgid % NXCD, off = wgid / NXCD; wgid = (xcd < r ? xcd * (q + 1) : r * (q + 1) + (xcd - r) * q) + off; }
    const int nig = WGM * nN, gid = wgid / nig, fm = gid * WGM, gsz = (nM - fm) < WGM ? (nM - fm) : WGM;
    pm = fm + ((wgid % nig) % gsz); pn = (wgid % nig) / gsz;
}

template <class Epi, class Sched, bool ALIGN_EPI, bool GATHER>
__device__ __forceinline__ void gemm_phase(LAS unsigned char* lds, const int K, const int lda, const Sched& S, const Epi& E) {
    const int tid = threadIdx.x, wid = __builtin_amdgcn_readfirstlane(tid >> 6), lane = tid & 63, wr = wid >> 2, wc = wid & 3, fr = lane & 15, fq = lane >> 4;
    const int nt = K / BK;
    int Rr[2], Cc[2];
    unsigned voffA[2], voffB[2];
#pragma unroll
    for (int i = 0; i < 2; ++i) { int R, C; stage_rc(tid * 16 + i * 8192, R, C); const int Rb = Epi::PERM ? ((R & ~31) + perm32(R & 31)) : R;
        Rr[i] = R; Cc[i] = C; voffA[i] = (unsigned)(R * lda + C) * 2u; voffB[i] = (unsigned)(Rb * K + C) * 2u; }
    const size_t kstep = (size_t)(BK * 2);
    const size_t hstepA = (size_t)HALF * lda * 2, hstepB = (size_t)HALF * K * 2;
    const unsigned ldsw = (unsigned)wid * 1024u;
    const int aoff = lds_byte(wr * 64 + fr, fq * 8), boff = lds_byte(wc * 32 + fr, fq * 8);
#define PG8_SA(b, h) (((b) * 2 + (h)) * HTB)
#define PG8_SB(b, h) ((4 + (b) * 2 + (h)) * HTB)
#define PG8_STAGE(bufoff, gbase, voff) do { _Pragma("unroll") for (int _i = 0; _i < 2; ++_i) \
        __builtin_amdgcn_global_load_lds((const unsigned*)((const char*)(gbase) + (voff)[_i]), (LAS unsigned*)(lds + (bufoff) + ldsw + _i * 8192), 16, 0, 0); } while (0)
#define PG8_STAGE_A(bufoff, gbase, h, G) do { if constexpr (GATHER) { PG8_STAGE(bufoff, gbase, (G)[h]); } else { PG8_STAGE(bufoff, (gbase) + (h) * hstepA, voffA); } } while (0)
#define PG8_STAGE_B(bufoff, gbase, h) PG8_STAGE(bufoff, (gbase) + (h) * hstepB, voffB)
#define PG8_LDA(dst, b, h) do { _Pragma("unroll") for (int m = 0; m < 4; ++m) _Pragma("unroll") for (int k = 0; k < 2; ++k) dst[m][k] = *(const LAS bf16x8*)(lds + PG8_SA(b, h) + aoff + m * 2048 + k * 1024); } while (0)
#define PG8_LDB(dst, b, h) do { _Pragma("unroll") for (int n = 0; n < 2; ++n) _Pragma("unroll") for (int k = 0; k < 2; ++k) dst[n][k] = *(const LAS bf16x8*)(lds + PG8_SB(b, h) + boff + n * 2048 + k * 1024); } while (0)
#define PG8_MMA(ai, bj, At, Bt) do { __builtin_amdgcn_s_setprio(1); _Pragma("unroll") for (int m = 0; m < 4; ++m) _Pragma("unroll") for (int n = 0; n < 2; ++n) _Pragma("unroll") for (int k = 0; k < 2; ++k) \
        acc[ai][bj][m][n] = __builtin_amdgcn_mfma_f32_16x16x32_bf16(Bt[n][k], At[m][k], acc[ai][bj][m][n], 0, 0, 0); __builtin_amdgcn_s_setprio(0); } while (0)
#define PG8_WAIT_V(n) asm volatile("s_waitcnt vmcnt(" #n ")" ::: "memory")
#define PG8_WAIT_L(n) asm volatile("s_waitcnt lgkmcnt(" #n ")" ::: "memory")
#define PG8_BAR __builtin_amdgcn_s_barrier()
#define PG8_SCHED __builtin_amdgcn_sched_barrier(0)
    Unit cur, nxt; int ui = 0;
    if (!S.next(0, cur)) return;
    f32x4 acc[2][2][4][2];
#pragma unroll
    for (int a = 0; a < 2; ++a)
#pragma unroll
        for (int b = 0; b < 2; ++b)
#pragma unroll
            for (int m = 0; m < 4; ++m)
#pragma unroll
                for (int n = 0; n < 2; ++n) acc[a][b][m][n] = (f32x4){0.f, 0.f, 0.f, 0.f};
    bf16x8 At[4][2], B0[2][2], B1[2][2];
    unsigned gC[2][2], gN[2][2];
#define PG8_GLOAD(G, u) do { if constexpr (GATHER) { const LAS unsigned* tb_ = (const LAS unsigned*)(lds + (u).tab); _Pragma("unroll") for (int h_ = 0; h_ < 2; ++h_) _Pragma("unroll") for (int i_ = 0; i_ < 2; ++i_) \
        (G)[h_][i_] = tb_[h_ * 128 + Rr[i_]] + (unsigned)(Cc[i_] * 2); } } while (0)
    PG8_GLOAD(gC, cur);
    const char* cA = cur.A; const char* cB = cur.B;
    PG8_STAGE_B(PG8_SB(0, 0), cB, 0); PG8_STAGE_B(PG8_SB(0, 1), cB, 1); PG8_STAGE_A(PG8_SA(0, 0), cA, 0, gC); PG8_STAGE_A(PG8_SA(0, 1), cA, 1, gC);
    if (wr == 1) PG8_BAR;
    PG8_WAIT_V(2); PG8_BAR;
    PG8_STAGE_B(PG8_SB(1, 0), cB + kstep, 0); PG8_STAGE_A(PG8_SA(1, 0), cA + kstep, 0, gC); PG8_STAGE_B(PG8_SB(1, 1), cB + kstep, 1);
    PG8_WAIT_V(6); PG8_BAR;
    for (;;) {
        const bool has_next = S.next(ui + 1, nxt);
        const char* nA = has_next ? nxt.A : cA; const char* nB = has_next ? nxt.B : cB;
        if constexpr (GATHER) { if (has_next) { PG8_GLOAD(gN, nxt); } else {
#pragma unroll
            for (int h_ = 0; h_ < 2; ++h_)
#pragma unroll
                for (int i_ = 0; i_ < 2; ++i_) gN[h_][i_] = gC[h_][i_]; } }
#pragma unroll 1
        for (int t = 0; t < nt; t += 2) {
            const bool last = (t == nt - 2);
            const char* a1 = cA + (size_t)(t + 1) * kstep;
            const char* a2 = last ? nA : cA + (size_t)(t + 2) * kstep; const char* b2 = last ? nB : cB + (size_t)(t + 2) * kstep;
            const char* a3 = a2 + kstep; const char* b3 = b2 + kstep;
            unsigned g2[2][2];
            if constexpr (GATHER) {
#pragma unroll
                for (int h_ = 0; h_ < 2; ++h_)
#pragma unroll
                    for (int i_ = 0; i_ < 2; ++i_) g2[h_][i_] = last ? gN[h_][i_] : gC[h_][i_]; }
            PG8_LDB(B0, 0, 0); PG8_LDB(B1, 0, 1); PG8_SCHED; PG8_LDA(At, 0, 0); PG8_STAGE_A(PG8_SA(1, 1), a1, 1, gC);
            PG8_WAIT_V(8); PG8_WAIT_L(0); PG8_BAR; PG8_MMA(0, 0, At, B0); PG8_MMA(0, 1, At, B1); PG8_BAR; PG8_SCHED;
            PG8_LDA(At, 0, 1); PG8_STAGE_B(PG8_SB(0, 0), b2, 0); PG8_STAGE_B(PG8_SB(0, 1), b2, 1); PG8_STAGE_A(PG8_SA(0, 0), a2, 0, g2);
            PG8_WAIT_V(8); PG8_WAIT_L(0); PG8_BAR; PG8_MMA(1, 0, At, B0); PG8_MMA(1, 1, At, B1); PG8_BAR; PG8_SCHED;
            PG8_LDB(B0, 1, 0); PG8_LDB(B1, 1, 1); PG8_SCHED; PG8_LDA(At, 1, 0); PG8_STAGE_A(PG8_SA(0, 1), a2, 1, g2);
            PG8_WAIT_V(8); PG8_WAIT_L(0); PG8_BAR; PG8_MMA(0, 0, At, B0); PG8_MMA(0, 1, At, B1); PG8_BAR; PG8_SCHED;
            PG8_LDA(At, 1, 1); PG8_STAGE_B(PG8_SB(1, 0), b3, 0); PG8_STAGE_B(PG8_SB(1, 1), b3, 1); PG8_STAGE_A(PG8_SA(1, 0), a3, 0, g2);
            PG8_WAIT_V(8); PG8_WAIT_L(0); PG8_BAR; PG8_MMA(1, 0, At, B0); PG8_MMA(1, 1, At, B1); PG8_BAR; PG8_SCHED;
        }
        if constexpr (ALIGN_EPI) { if (wr == 0) PG8_BAR; }
        E(acc, cur, wr, wc, fr, fq);
        if (!has_next) break;
#pragma unroll
        for (int a = 0; a < 2; ++a)
#pragma unroll
            for (int b = 0; b < 2; ++b)
#pragma unroll
                for (int m = 0; m < 4; ++m)
#pragma unroll
                    for (int n = 0; n < 2; ++n) acc[a][b][m][n] = (f32x4){0.f, 0.f, 0.f, 0.f};
        cur = nxt; cA = nA; cB = nB; ++ui;
        if constexpr (GATHER) {
#pragma unroll
            for (int h_ = 0; h_ < 2; ++h_)
#pragma unroll
                for (int i_ = 0; i_ < 2; ++i_) gC[h_][i_] = gN[h_][i_]; }
        if constexpr (ALIGN_EPI) { if (wr == 1) PG8_BAR; }
    }
    PG8_WAIT_V(0);
    if constexpr (!ALIGN_EPI) { if (wr == 0) PG8_BAR; }
    PG8_BAR;
#undef PG8_SA
#undef PG8_SB
#undef PG8_STAGE
#undef PG8_STAGE_A
#undef PG8_STAGE_B
#undef PG8_LDA
#undef PG8_LDB
#undef PG8_MMA
#undef PG8_WAIT_V
#undef PG8_WAIT_L
#undef PG8_BAR
#undef PG8_SCHED
#undef PG8_GLOAD
}

typedef f32x4 Acc[2][2][4][2];

struct SchedDense {
    const char* A; const char* B; size_t a_tile_bytes, b_tile_bytes; int nM, nN, G, c;
    __device__ __forceinline__ bool next(int i, Unit& u) const {
        const long L = (long)i * G + c; if (L >= (long)nM * nN) return false;
        int pm, pn; tile_of((int)L, nM, nN, pm, pn);
        u.pm = pm; u.pn = pn; u.aux = 0; u.tab = 0; u.A = A + (size_t)pm * a_tile_bytes; u.B = B + (size_t)pn * b_tile_bytes; return true;
    }
};
struct SchedMerge {
    const char* A0; const char* A1; const char* B0; const char* B1; int nM, nN, G, c;
    __device__ __forceinline__ bool next(int i, Unit& u) const {
        const long T = (long)(i >> 1) * G + c; if (T >= (long)nM * nN) return false;
        int pm, pn; tile_of((int)T, nM, nN, pm, pn);
        const int sub = i & 1; u.pm = pm; u.pn = pn; u.aux = sub; u.tab = 0;
        u.A = (sub ? A1 : A0) + (size_t)pm * (256 * 512 * 2); u.B = (sub ? B1 : B0) + (size_t)pn * (256 * 512 * 2); return true;
    }
};
template <int NPN, bool GATHER>
struct SchedMoe {
    const char* A; const char* B; size_t b_expert_bytes; LAS const int* blk_e; int NB, G, c, tab0;
    __device__ __forceinline__ bool next(int i, Unit& u) const {
        const long L = (long)i * G + c; if (L >= (long)NB * NPN) return false;
        const int grb = (int)(L / NPN), pn = (int)(L % NPN);
        const int e = __builtin_amdgcn_readfirstlane(blk_e[grb]);
        u.pm = grb; u.pn = pn; u.aux = e; u.tab = tab0 + i * 1024;
        u.A = GATHER ? A : A + (size_t)grb * (256 * 1024 * 2);
        u.B = B + (size_t)e * b_expert_bytes + (size_t)pn * (256 * 1024 * 2); return true;
    }
};

struct EpiInProj {
    static constexpr bool PERM = true;
    bf16_t* PROJ; float* SSQ; bf16_t* KR; const float* ROPE;
    __device__ __forceinline__ void operator()(const Acc& acc, const Unit& u, int wr, int wc, int fr, int fq) const {
        const int pn = u.pn, row0 = u.pm * BM + wr * 64 + fr, colb = pn * BM + wc * 32 + 8 * fq;
        const float sc = (pn < 2) ? C2NA : 1.f;
#pragma unroll
        for (int ai = 0; ai < 2; ++ai)
#pragma unroll
            for (int m = 0; m < 4; ++m) { const int row = row0 + ai * HALF + m * 16; bf16_t* rowp = PROJ + (size_t)row * NPROJ + colb;
#pragma unroll
                for (int bj = 0; bj < 2; ++bj) { const f32x4 v0 = acc[ai][bj][m][0] * sc, v1 = acc[ai][bj][m][1] * sc; u32x4 w;
                    w.x = cvt_pk_bf16(v0[0], v0[1]); w.y = cvt_pk_bf16(v0[2], v0[3]); w.z = cvt_pk_bf16(v1[0], v1[1]); w.w = cvt_pk_bf16(v1[2], v1[3]);
                    *(u32x4*)(rowp + bj * HALF) = w; } }
        if (pn >= 6 && pn <= 8) {
#pragma unroll
            for (int ai = 0; ai < 2; ++ai)
#pragma unroll
                for (int m = 0; m < 4; ++m) { const int row = row0 + ai * HALF + m * 16; float s[2];
#pragma unroll
                    for (int bj = 0; bj < 2; ++bj) { const f32x4 a = acc[ai][bj][m][0], b = acc[ai][bj][m][1];
                        float t = (a[0] * a[0] + a[1] * a[1]) + (a[2] * a[2] + a[3] * a[3]) + (b[0] * b[0] + b[1] * b[1]) + (b[2] * b[2] + b[3] * b[3]);
                        t += __shfl_xor(t, 16); t += __shfl_xor(t, 32); s[bj] = t; }
                    if (fq == 0) {
                        float* sp = SSQ + (size_t)row * 16 + wc;
                        if (pn == 6) { sp[0] = s[0] + s[1]; }
                        else if (pn == 7) { sp[4] = s[0]; sp[8] = s[1]; }
                        else { sp[12] = s[0]; }
                    } }
            if (pn == 8 && wc == 0) {
#pragma unroll
                for (int ai = 0; ai < 2; ++ai)
#pragma unroll
                    for (int m = 0; m < 4; ++m) { const int row = row0 + ai * HALF + m * 16, tok = row & (SEQ - 1);
                        const int pos = (fq >> 1) ? (tok & 63) : (tok >> 6); float o[8];
                        const f32x4 cs4 = *(const f32x4*)(ROPE + pos * 16 + 4 * (fq & 1)), sn4 = *(const f32x4*)(ROPE + pos * 16 + 8 + 4 * (fq & 1));
#pragma unroll
                        for (int n = 0; n < 2; ++n)
#pragma unroll
                            for (int q = 0; q < 2; ++q) { const float c = cs4[2 * n + q], s = sn4[2 * n + q];
                                const float x1 = acc[ai][1][m][n][2 * q], x2 = acc[ai][1][m][n][2 * q + 1];
                                o[4 * n + 2 * q] = x1 * c - x2 * s; o[4 * n + 2 * q + 1] = x1 * s + x2 * c; }
                        u32x4 w; w.x = cvt_pk_bf16(o[0], o[1]); w.y = cvt_pk_bf16(o[2], o[3]); w.z = cvt_pk_bf16(o[4], o[5]); w.w = cvt_pk_bf16(o[6], o[7]);
                        *(u32x4*)(KR + (size_t)row * 32 + 8 * fq) = w; }
            }
        }
    }
};
struct EpiQUp {
    static constexpr bool PERM = true;
    bf16_t* QN; bf16_t* QR; const float* SSQ; const float* ROPE;
    __device__ __forceinline__ void operator()(const Acc& acc, const Unit& u, int wr, int wc, int fr, int fq) const {
        const int pn = u.pn, row0 = u.pm * BM + wr * 64 + fr, colt = wc * 32 + 8 * fq;
#pragma unroll
        for (int ai = 0; ai < 2; ++ai)
#pragma unroll
            for (int m = 0; m < 4; ++m) { const int row = row0 + ai * HALF + m * 16;
                const f32x4 q0_ = *(const f32x4*)(SSQ + (size_t)row * 16), q1_ = *(const f32x4*)(SSQ + (size_t)row * 16 + 4);
                const float rs = __builtin_amdgcn_rsqf((((q0_[0] + q0_[1]) + (q0_[2] + q0_[3])) + ((q1_[0] + q1_[1]) + (q1_[2] + q1_[3]))) * (1.f / QLORA) + RMS_EPS) * C2MLA;
                if (pn < 2) {
#pragma unroll
                    for (int bj = 0; bj < 2; ++bj) { const f32x4 v0 = acc[ai][bj][m][0] * rs, v1 = acc[ai][bj][m][1] * rs; u32x4 w;
                        w.x = cvt_pk_bf16(v0[0], v0[1]); w.y = cvt_pk_bf16(v0[2], v0[3]); w.z = cvt_pk_bf16(v1[0], v1[1]); w.w = cvt_pk_bf16(v1[2], v1[3]);
                        *(u32x4*)(QN + (size_t)row * 512 + pn * 256 + bj * HALF + colt) = w; }
                } else {
                    const int tok = row & (SEQ - 1); const int pos = (fq >> 1) ? (tok & 63) : (tok >> 6);
                    const f32x4 cs4 = *(const f32x4*)(ROPE + pos * 16 + 4 * (fq & 1)), sn4 = *(const f32x4*)(ROPE + pos * 16 + 8 + 4 * (fq & 1));
#pragma unroll
                    for (int bj = 0; bj < 2; ++bj) { float o[8];
#pragma unroll
                        for (int n = 0; n < 2; ++n)
#pragma unroll
                            for (int q = 0; q < 2; ++q) { const float c = cs4[2 * n + q], s = sn4[2 * n + q];
                                const float x1 = acc[ai][bj][m][n][2 * q] * rs, x2 = acc[ai][bj][m][n][2 * q + 1] * rs;
                                o[4 * n + 2 * q] = x1 * c - x2 * s; o[4 * n + 2 * q + 1] = x1 * s + x2 * c; }
                        u32x4 w; w.x = cvt_pk_bf16(o[0], o[1]); w.y = cvt_pk_bf16(o[2], o[3]); w.z = cvt_pk_bf16(o[4], o[5]); w.w = cvt_pk_bf16(o[6], o[7]);
                        *(u32x4*)(QR + (size_t)row * 256 + bj * HALF + colt) = w; }
                }
                asm volatile("" ::: "memory"); }
    }
};
struct EpiKVUp {
    static constexpr bool PERM = true;
    bf16_t* KN; bf16_t* VM; const float* SSQ;
    __device__ __forceinline__ void operator()(const Acc& acc, const Unit& u, int wr, int wc, int fr, int fq) const {
        const int pn = u.pn, row0 = u.pm * BM + wr * 64 + fr, colt = wc * 32 + 8 * fq;
        bf16_t* dst = (pn < 2) ? KN + pn * 256 : VM + (pn - 2) * 256;
#pragma unroll
        for (int ai = 0; ai < 2; ++ai)
#pragma unroll
            for (int m = 0; m < 4; ++m) { const int row = row0 + ai * HALF + m * 16;
                const f32x4 q0_ = *(const f32x4*)(SSQ + (size_t)row * 16 + 8), q1_ = *(const f32x4*)(SSQ + (size_t)row * 16 + 12);
                const float rs = __builtin_amdgcn_rsqf((((q0_[0] + q0_[1]) + (q0_[2] + q0_[3])) + ((q1_[0] + q1_[1]) + (q1_[2] + q1_[3]))) * (1.f / KVLORA) + RMS_EPS);
#pragma unroll
                for (int bj = 0; bj < 2; ++bj) { const f32x4 v0 = acc[ai][bj][m][0] * rs, v1 = acc[ai][bj][m][1] * rs; u32x4 w;
                    w.x = cvt_pk_bf16(v0[0], v0[1]); w.y = cvt_pk_bf16(v0[2], v0[3]); w.z = cvt_pk_bf16(v1[0], v1[1]); w.w = cvt_pk_bf16(v1[2], v1[3]);
                    *(u32x4*)(dst + (size_t)row * 512 + bj * HALF + colt) = w; } }
    }
};
struct EpiMerge {
    static constexpr bool PERM = true;
    const bf16_t* PROJ; const float* bgate; float* TMP; bf16_t* MERGED;
    __device__ __forceinline__ void operator()(const Acc& acc, const Unit& u, int wr, int wc, int fr, int fq) const {
        const int sub = u.aux, row0 = u.pm * BM + wr * 64 + fr, col0 = u.pn * BM + wc * 32 + 8 * fq;
        f32x4 bg[2][2];
#pragma unroll
        for (int bj = 0; bj < 2; ++bj)
#pragma unroll
            for (int n = 0; n < 2; ++n) bg[bj][n] = *(const f32x4*)(bgate + sub * 1024 + col0 + bj * HALF + 4 * n);
#pragma unroll
        for (int ai = 0; ai < 2; ++ai)
#pragma unroll
            for (int m = 0; m < 4; ++m) { const int row = row0 + ai * HALF + m * 16;
#pragma unroll
                for (int bj = 0; bj < 2; ++bj) { const int col = col0 + bj * HALF;
                    const u32x4 gl = *(const u32x4*)(PROJ + (size_t)row * NPROJ + 2304 + sub * 1024 + col);
                    f32x4 g0, g1;
                    g0[0] = sigmoidf_(bf16_lo(gl.x) + bg[bj][0][0]); g0[1] = sigmoidf_(bf16_hi(gl.x) + bg[bj][0][1]); g0[2] = sigmoidf_(bf16_lo(gl.y) + bg[bj][0][2]); g0[3] = sigmoidf_(bf16_hi(gl.y) + bg[bj][0][3]);
                    g1[0] = sigmoidf_(bf16_lo(gl.z) + bg[bj][1][0]); g1[1] = sigmoidf_(bf16_hi(gl.z) + bg[bj][1][1]); g1[2] = sigmoidf_(bf16_lo(gl.w) + bg[bj][1][2]); g1[3] = sigmoidf_(bf16_hi(gl.w) + bg[bj][1][3]);
                    f32x4 v0 = acc[ai][bj][m][0] * g0, v1 = acc[ai][bj][m][1] * g1;
                    float* tp = TMP + (size_t)row * 1024 + col;
                    if (sub == 0) { *(f32x4*)tp = v0; *(f32x4*)(tp + 4) = v1; }
                    else { v0 += *(const f32x4*)tp; v1 += *(const f32x4*)(tp + 4); u32x4 w;
                        w.x = cvt_pk_bf16(v0[0], v0[1]); w.y = cvt_pk_bf16(v0[2], v0[3]); w.z = cvt_pk_bf16(v1[0], v1[1]); w.w = cvt_pk_bf16(v1[2], v1[3]);
                        *(u32x4*)(MERGED + (size_t)row * 1024 + col) = w; } } }
    }
};
struct EpiF32 {
    static constexpr bool PERM = false;
    float* C; int ldc;
    __device__ __forceinline__ void operator()(const Acc& acc, const Unit& u, int wr, int wc, int fr, int fq) const {
        const int row0 = u.pm * BM + wr * 64 + fr, col0 = u.pn * BM + wc * 32 + 4 * fq;
#pragma unroll
        for (int ai = 0; ai < 2; ++ai)
#pragma unroll
            for (int m = 0; m < 4; ++m) { float* rowp = C + (size_t)(row0 + ai * HALF + m * 16) * ldc + col0;
#pragma unroll
                for (int bj = 0; bj < 2; ++bj)
#pragma unroll
                    for (int n = 0; n < 2; ++n) *(f32x4*)(rowp + bj * HALF + n * 16) = acc[ai][bj][m][n]; }
    }
};
struct EpiMoe1 {
    static constexpr bool PERM = true;
    const float* b1; bf16_t* ACT;
    __device__ __forceinline__ void operator()(const Acc& acc, const Unit& u, int wr, int wc, int fr, int fq) const {
        const int e = u.aux, row0 = u.pm * BM + wr * 64 + fr, col0 = u.pn * BM + wc * 32 + 8 * fq;
        f32x4 bv[2][2];
#pragma unroll
        for (int bj = 0; bj < 2; ++bj)
#pragma unroll
            for (int n = 0; n < 2; ++n) bv[bj][n] = *(const f32x4*)(b1 + (size_t)e * 2048 + col0 + bj * HALF + 4 * n);
#pragma unroll
        for (int ai = 0; ai < 2; ++ai)
#pragma unroll
            for (int m = 0; m < 4; ++m) { const int row = row0 + ai * HALF + m * 16;
#pragma unroll
                for (int bj = 0; bj < 2; ++bj) { float o[4];
#pragma unroll
                    for (int n = 0; n < 2; ++n) { const f32x4 v = acc[ai][bj][m][n] + bv[bj][n];
#pragma unroll
                        for (int q = 0; q < 2; ++q) { const float xg = fminf(v[2 * q], 7.f), xl = fminf(fmaxf(v[2 * q + 1], -7.f), 7.f);
                            o[2 * n + q] = xg * sigmoidf_(1.702f * xg) * (xl + 1.f); } }
                    u32x2 w; w.x = cvt_pk_bf16(o[0], o[1]); w.y = cvt_pk_bf16(o[2], o[3]);
                    *(u32x2*)(ACT + (size_t)row * 1024 + ((col0 + bj * HALF) >> 1)) = w; } }
    }
};
struct EpiMoe2 {
    static constexpr bool PERM = true;
    const float* b2; bf16_t* YIT;
    __device__ __forceinline__ void operator()(const Acc& acc, const Unit& u, int wr, int wc, int fr, int fq) const {
        const int e = u.aux, row0 = u.pm * BM + wr * 64 + fr, col0 = u.pn * BM + wc * 32 + 8 * fq;
        f32x4 bv[2][2];
#pragma unroll
        for (int bj = 0; bj < 2; ++bj)
#pragma unroll
            for (int n = 0; n < 2; ++n) bv[bj][n] = *(const f32x4*)(b2 + (size_t)e * 1024 + col0 + bj * HALF + 4 * n);
#pragma unroll
        for (int ai = 0; ai < 2; ++ai)
#pragma unroll
            for (int m = 0; m < 4; ++m) { const int row = row0 + ai * HALF + m * 16;
#pragma unroll
                for (int bj = 0; bj < 2; ++bj) { const f32x4 v0 = acc[ai][bj][m][0] + bv[bj][0], v1 = acc[ai][bj][m][1] + bv[bj][1]; u32x4 w;
                    w.x = cvt_pk_bf16(v0[0], v0[1]); w.y = cvt_pk_bf16(v0[2], v0[3]); w.z = cvt_pk_bf16(v1[0], v1[1]); w.w = cvt_pk_bf16(v1[2], v1[3]);
                    *(u32x4*)(YIT + (size_t)row * 1024 + col0 + bj * HALF) = w; } }
    }
};
}

namespace attn {
#define SBAR() __builtin_amdgcn_sched_barrier(0)
constexpr int NW = 8, QBLK = 32, KVBLK = 64;
constexpr float THR = 8.f;
__device__ __forceinline__ int crow(int r, int hi) { return (r & 3) + 8 * (r >> 2) + 4 * hi; }
constexpr int KROW_MLA = 96 * 2 + 16, KROW_NA = 64 * 2 + 16;
constexpr int SHM_K = 64 * KROW_MLA  , SHM_V = 64 * 64 * 2  ;
constexpr int OFF_V = 0, OFF_K = 2 * SHM_V, OFF_WS = OFF_K + 2 * SHM_K, OFF_OST = OFF_WS + NW * 256, OFF_BIAS = OFF_OST + NW * 4096, ATTN_LDS = OFF_BIAS + 2048;

__device__ __forceinline__ int v_st(int k, int c) { const int kk = (k & ~0xC) | ((k & 4) << 1) | ((k & 8) >> 1); return ((kk >> 3) * 2 + (c >> 5)) * 512 + ((kk & 7) * 32 + (c & 31)) * 2; }
__device__ __forceinline__ int v_rd_base(int lane) { return ((lane & 3) << 3) | (((lane >> 2) & 3) << 6) | (((lane >> 4) & 1) << 5) | (((lane >> 5) & 1) << 8); }
constexpr int v_rd_off(int d0, int ks, int half) { return d0 * 512 + ks * 2048 + half * 1024; }
template <int OFF> __device__ __forceinline__ s16x4 tr_read(int vb) {
    s16x4 r; asm volatile("ds_read_b64_tr_b16 %0, %1 offset:%2" : "=&v"(r) : "v"(vb), "i"(OFF) : "memory"); return r;
}
template <int D0> __device__ __forceinline__ void pv_one(f32x16& od, int vb, bf16x8 pa0, bf16x8 pa1, bf16x8 pa2, bf16x8 pa3) {
    const s16x4 l0 = tr_read<v_rd_off(D0, 0, 0)>(vb), h0 = tr_read<v_rd_off(D0, 0, 1)>(vb), l1 = tr_read<v_rd_off(D0, 1, 0)>(vb), h1 = tr_read<v_rd_off(D0, 1, 1)>(vb);
    const s16x4 l2 = tr_read<v_rd_off(D0, 2, 0)>(vb), h2 = tr_read<v_rd_off(D0, 2, 1)>(vb), l3 = tr_read<v_rd_off(D0, 3, 0)>(vb), h3 = tr_read<v_rd_off(D0, 3, 1)>(vb);
    asm volatile("s_waitcnt lgkmcnt(0)" ::: "memory"); SBAR();
#define PK(L, H) (bf16x8){L[0], L[1], L[2], L[3], H[0], H[1], H[2], H[3]}
    od = __builtin_amdgcn_mfma_f32_32x32x16_bf16(pa0, PK(l0, h0), od, 0, 0, 0);
    od = __builtin_amdgcn_mfma_f32_32x32x16_bf16(pa1, PK(l1, h1), od, 0, 0, 0);
    od = __builtin_amdgcn_mfma_f32_32x32x16_bf16(pa2, PK(l2, h2), od, 0, 0, 0);
    od = __builtin_amdgcn_mfma_f32_32x32x16_bf16(pa3, PK(l3, h3), od, 0, 0, 0);
#undef PK
}
__device__ __forceinline__ void pv_d0(f32x16* o, int vb, bf16x8 pa0, bf16x8 pa1, bf16x8 pa2, bf16x8 pa3) {
    pv_one<0>(o[0], vb, pa0, pa1, pa2, pa3); pv_one<1>(o[1], vb, pa0, pa1, pa2, pa3);
}
__device__ __forceinline__ void partialSM(f32x16& p0, f32x16& p1, float& m_reg, float& alpha) {
    float pmax = p0[0];
#pragma unroll
    for (int r = 1; r < 16; ++r) pmax = fmaxf(pmax, p0[r]);
#pragma unroll
    for (int r = 0; r < 16; ++r) pmax = fmaxf(pmax, p1[r]);
    { auto rr = __builtin_amdgcn_permlane32_swap(__float_as_uint(pmax), __float_as_uint(pmax), false, false);
      pmax = fmaxf(__uint_as_float(rr[0]), __uint_as_float(rr[1])); }
    float mn;
    if (__builtin_expect(__all(pmax - m_reg <= THR), 1)) { mn = m_reg; alpha = 1.f; }
    else { mn = fmaxf(m_reg, pmax); alpha = __builtin_amdgcn_exp2f(m_reg - mn); m_reg = mn; }
#pragma unroll
    for (int r = 0; r < 16; ++r) p0[r] = p0[r] - mn;
#pragma unroll
    for (int r = 0; r < 16; ++r) p1[r] = p1[r] - mn;
#pragma unroll
    for (int r = 0; r < 16; ++r) p0[r] = __builtin_amdgcn_exp2f(p0[r]);
}
__device__ __forceinline__ void finishSM(f32x16& p0, f32x16& p1, float alpha, float& l_reg, bf16x8& pa0, bf16x8& pa1, bf16x8& pa2, bf16x8& pa3) {
#pragma unroll
    for (int r = 0; r < 16; ++r) p1[r] = __builtin_amdgcn_exp2f(p1[r]);
    float ps = 0;
#pragma unroll
    for (int r = 0; r < 16; ++r) ps += p0[r];
#pragma unroll
    for (int r = 0; r < 16; ++r) ps += p1[r];
    { auto rr = __builtin_amdgcn_permlane32_swap(__float_as_uint(ps), __float_as_uint(ps), false, false);
      ps = __uint_as_float(rr[0]) + __uint_as_float(rr[1]); }
    l_reg = l_reg * alpha + ps;
#define PK4(P, BASE, OUT) do { unsigned a0 = cvt_pk_bf16(P[BASE + 0], P[BASE + 1]), a1 = cvt_pk_bf16(P[BASE + 2], P[BASE + 3]);   \
    unsigned b0 = cvt_pk_bf16(P[BASE + 4], P[BASE + 5]), b1 = cvt_pk_bf16(P[BASE + 6], P[BASE + 7]);                              \
    auto r0 = __builtin_amdgcn_permlane32_swap(a0, b0, false, false); auto r1 = __builtin_amdgcn_permlane32_swap(a1, b1, false, false); \
    u32x4 w = {r0[0], r1[0], r0[1], r1[1]}; OUT = *reinterpret_cast<bf16x8*>(&w); } while (0)
    PK4(p0, 0, pa0); PK4(p0, 8, pa1); PK4(p1, 0, pa2); PK4(p1, 8, pa3);
#undef PK4
}
template <int ND0, int KROW>
__device__ __forceinline__ void qkt(f32x16& p0, f32x16& p1, const char* Ks, const bf16x8* qr, int r32, int hi) {
    p0 = f32x16{}; p1 = f32x16{};
#pragma unroll
    for (int d0 = 0; d0 < ND0; ++d0) { const int cb = (d0 * 16 + hi * 8) * 2;
        const bf16x8 b0 = *reinterpret_cast<const bf16x8*>(Ks + r32 * KROW + cb);
        const bf16x8 b1 = *reinterpret_cast<const bf16x8*>(Ks + (32 + r32) * KROW + cb);
        p0 = __builtin_amdgcn_mfma_f32_32x32x16_bf16(b0, qr[d0], p0, 0, 0, 0);
        p1 = __builtin_amdgcn_mfma_f32_32x32x16_bf16(b1, qr[d0], p1, 0, 0, 0); }
}

template <int MODE>
__device__ __forceinline__ void attn_unit(const bf16_t* __restrict__ Qa, int ldqa, const bf16_t* __restrict__ Qb, int ldqb,
                                          const bf16_t* __restrict__ Ka, int ldka, const bf16_t* __restrict__ Kb, int ldkb, const bf16_t* __restrict__ Vv, int ldv,
                                          bf16_t* __restrict__ O, int NT, int krow0, int ntreal, int qrow0, const float* __restrict__ rpbh, char* lds) {
    constexpr int ND0 = MODE == 0 ? 6 : 4, KROW = MODE == 0 ? KROW_MLA : KROW_NA;
    const int tid = threadIdx.x, wid = __builtin_amdgcn_readfirstlane(tid >> 6), lane = tid & 63, r32 = lane & 31, hi = lane >> 5;
    char* V_lds = lds + OFF_V; char* K_lds = lds + OFF_K;
    float* ws = (float*)(lds + OFF_WS) + wid * 64; float* li_l = ws; float* al_l = ws + 32;
    float* biasL = (float*)(lds + OFF_BIAS);
    float m_reg = -1e30f, l_reg = 0; f32x16 o[2] = {}; bf16x8 qr[ND0];
    {   const bf16_t* Qw = Qa + (size_t)(wid * QBLK + r32) * ldqa + hi * 8;
#pragma unroll
        for (int d0 = 0; d0 < 4; ++d0) qr[d0] = *reinterpret_cast<const bf16x8*>(Qw + d0 * 16);
        if constexpr (MODE == 0) { const bf16_t* Qw2 = Qb + (size_t)(wid * QBLK + r32) * ldqb + hi * 8;
#pragma unroll
            for (int d0 = 0; d0 < 2; ++d0) qr[4 + d0] = *reinterpret_cast<const bf16x8*>(Qw2 + d0 * 16); } }
    int qgr = 0, rs0 = 0, qc = 0, cs = 0;
    if constexpr (MODE == 1) {
        qgr = qrow0 + (wid >> 1); rs0 = min(max(qgr - 4, 0), 120); qc = 32 * (wid & 1) + r32; cs = min(max(qc - 8, 0), 48);
        for (int i = tid; i < 15 * 31; i += 512) biasL[i] = rpbh[i] * LOG2E;
    }
    const int sr = tid >> 3, sc = (tid & 7) * 8;
    const int sr2 = (tid & 255) >> 2, sc2 = (tid & 3) * 8;
    const int vst = v_st(sr, sc);
    const int vb0 = (int)(uintptr_t)V_lds + v_rd_base(lane);
    struct { bf16x8 v, k, k2; } sr_[2];
#define KROWOF(t) (MODE == 1 ? min(krow0 + (t), 127) * 64 : (t) * 64)
#define SLOAD(i, t) do { const long k0_ = KROWOF(t); sr_[i].v = *reinterpret_cast<const bf16x8*>(&Vv[(k0_ + sr) * ldv + sc]); sr_[i].k = *reinterpret_cast<const bf16x8*>(&Ka[(k0_ + sr) * ldka + sc]); \
        if constexpr (MODE == 0) sr_[i].k2 = *reinterpret_cast<const bf16x8*>(&Kb[(k0_ + sr2) * ldkb + sc2]); } while (0)
#define SWRITE(b, i) do { *(bf16x8*)(V_lds + (b) * SHM_V + vst) = sr_[i].v; *(bf16x8*)(K_lds + (b) * SHM_K + sr * KROW + sc * 2) = sr_[i].k; \
        if constexpr (MODE == 0) { if (tid < 256) *(bf16x8*)(K_lds + (b) * SHM_K + sr2 * KROW + 128 + sc2 * 2) = sr_[i].k2; } } while (0)
#define SWAIT() do { if constexpr (MODE == 0) asm volatile("s_waitcnt vmcnt(3)" ::: "memory"); else asm volatile("s_waitcnt vmcnt(2)" ::: "memory"); } while (0)
#define RESC(a) do { if (__any((a) < 1.f)) { if (hi == 0) al_l[r32] = (a); asm volatile("s_waitcnt lgkmcnt(0)" ::: "memory"); \
        _Pragma("unroll") for (int d = 0; d < 2; ++d) _Pragma("unroll") for (int r = 0; r < 16; ++r) o[d][r] *= al_l[crow(r, hi)]; } } while (0)
#define TVALID(t) (MODE == 0 ? true : ((t) < ntreal && (krow0 + (t)) >= rs0 && (krow0 + (t)) < rs0 + 8))
#define MASKB(P0, P1, t) do { if constexpr (MODE == 1) { const int dr_ = krow0 + (t) - qgr + 7; int d_ = 4 * hi - cs; asm volatile("" : "+v"(d_)); \
        const LAS float* bl_ = (const LAS float*)((LAS char*)lds + OFF_BIAS) + (dr_ * 31 + 15 - qc + 4 * hi); \
        _Pragma("unroll") for (int r = 0; r < 16; ++r) { const int c0_ = (r & 3) + 8 * (r >> 2); \
            const bool in0 = (unsigned)(c0_ + d_) < 16u, in1 = (unsigned)(c0_ + 32 + d_) < 16u; \
            const float b0_ = bl_[c0_], b1_ = bl_[c0_ + 32]; \
            P0[r] = in0 ? P0[r] + b0_ : -1e30f; P1[r] = in1 ? P1[r] + b1_ : -1e30f; } } } while (0)
    f32x16 pA0, pA1, pB0, pB1; float alA = 1.f, alB = 1.f; bf16x8 pa0, pa1, pa2, pa3;
    bool vA, vB;
    constexpr int SE = 0, SO = 1;
    SLOAD(SE, 0); asm volatile("s_waitcnt vmcnt(0)" ::: "memory"); SWRITE(0, SE); __syncthreads();
    vA = TVALID(0);
    if (vA) { qkt<ND0, KROW>(pA0, pA1, K_lds, qr, r32, hi); MASKB(pA0, pA1, 0); partialSM(pA0, pA1, m_reg, alA); }
    SLOAD(SO, 1); if (2 < NT) SLOAD(SE, 2);
    SWAIT(); SWRITE(1, SO); __syncthreads();
    for (int j = 1; j + 1 < NT; j += 2) {
        vB = TVALID(j);
        SBAR(); if (vB) { qkt<ND0, KROW>(pB0, pB1, K_lds + SHM_K, qr, r32, hi); MASKB(pB0, pB1, j); }
        if (vA) finishSM(pA0, pA1, alA, l_reg, pa0, pa1, pa2, pa3); SBAR();
        SLOAD(SO, min(j + 2, NT - 1)); SBAR();
        if (vA) pv_d0(o, vb0, pa0, pa1, pa2, pa3);
        if (vB) partialSM(pB0, pB1, m_reg, alB);
        __syncthreads(); SWAIT(); SWRITE(0, SE);
        if (vB) RESC(alB); __syncthreads();
        vA = TVALID(j + 1);
        SBAR(); if (vA) { qkt<ND0, KROW>(pA0, pA1, K_lds, qr, r32, hi); MASKB(pA0, pA1, j + 1); }
        if (vB) finishSM(pB0, pB1, alB, l_reg, pa0, pa1, pa2, pa3); SBAR();
        SLOAD(SE, min(j + 3, NT - 1)); SBAR();
        if (vB) pv_d0(o, vb0 + SHM_V, pa0, pa1, pa2, pa3);
        if (vA) partialSM(pA0, pA1, m_reg, alA);
        __syncthreads(); SWAIT(); SWRITE(1, SO);
        if (vA) RESC(alA); __syncthreads();
    }
    vB = TVALID(NT - 1);
    SBAR(); if (vB) { qkt<ND0, KROW>(pB0, pB1, K_lds + SHM_K, qr, r32, hi); MASKB(pB0, pB1, NT - 1); }
    if (vA) finishSM(pA0, pA1, alA, l_reg, pa0, pa1, pa2, pa3); SBAR();
    if (vA) pv_d0(o, vb0, pa0, pa1, pa2, pa3);
    if (vB) { partialSM(pB0, pB1, m_reg, alB); RESC(alB);
        finishSM(pB0, pB1, alB, l_reg, pa0, pa1, pa2, pa3); SBAR();
        pv_d0(o, vb0 + SHM_V, pa0, pa1, pa2, pa3); }
    asm volatile("s_waitcnt vmcnt(0)" ::: "memory");
    if (hi == 0) li_l[r32] = l_reg; asm volatile("s_waitcnt lgkmcnt(0)" ::: "memory");
    float rli[16];
#pragma unroll
    for (int r = 0; r < 16; ++r) rli[r] = __builtin_amdgcn_rcpf(li_l[crow(r, hi)]);
    {   bf16_t* stg = (bf16_t*)(lds + OFF_OST) + wid * 2048;
#pragma unroll
        for (int r = 0; r < 16; ++r) { const int orow = crow(r, hi);
#pragma unroll
            for (int d0 = 0; d0 < 2; ++d0) stg[orow * 64 + d0 * 32 + r32] = (bf16_t)(cvt_pk_bf16(o[d0][r] * rli[r], 0.f) & 0xffffu); }
        asm volatile("s_waitcnt lgkmcnt(0)" ::: "memory");
        bf16_t* Ow = O + (size_t)(wid * QBLK) * 512;
#pragma unroll
        for (int i = 0; i < 4; ++i) { const int row = i * 8 + (lane >> 3), ch = lane & 7; const u32x4 v = *(const u32x4*)(stg + row * 64 + ch * 8); *(u32x4*)(Ow + (size_t)row * 512 + ch * 8) = v; } }
    __syncthreads();
#undef KROWOF
#undef SLOAD
#undef SWRITE
#undef SWAIT
#undef RESC
#undef TVALID
#undef MASKB
}
#undef SBAR
}

constexpr size_t MiB = 1u << 20;
constexpr size_t WS_CTL = 0, CTL_ZERO_BYTES = 1 * MiB;
constexpr size_t WS_WIN = 2 * MiB;
constexpr size_t WS_WUQ = 11 * MiB;
constexpr size_t WS_WUKV = 12 * MiB;
constexpr size_t WS_WNA = 13 * MiB, WS_WMLA = 14 * MiB;
constexpr size_t WS_WOUT = 15 * MiB;
constexpr size_t WS_W1 = 18 * MiB;
constexpr size_t WS_W2 = 146 * MiB;
constexpr size_t WS_XN = 210 * MiB;
constexpr size_t WS_PROJ = 242 * MiB;
constexpr size_t WS_QN = 378 * MiB, WS_QR = 394 * MiB, WS_KN = 402 * MiB, WS_KR = 418 * MiB, WS_VM = 419 * MiB;
constexpr size_t WS_ONA = 435 * MiB, WS_OMLA = 451 * MiB;
constexpr size_t WS_MERGED = 467 * MiB;
constexpr size_t WS_TMP = 499 * MiB;
constexpr size_t WS_LIST = 563 * MiB;
constexpr size_t WS_TOKPOS = 565 * MiB, WS_TOKG = 566 * MiB;
constexpr size_t WS_ACT = 568 * MiB;
constexpr size_t WS_YIT = 712 * MiB;
constexpr size_t WS_SSQ = 856 * MiB;
constexpr size_t WS_MODP = 857 * MiB;
constexpr size_t WS_END = 858 * MiB;
constexpr int CW_BAR = 4096;
constexpr int CW_CNT = 8192;
constexpr int CW_MOD = 16384;
constexpr int CW_ROPE = 32768;
static_assert((CW_ROPE + 2048) * 4 <= (int)CTL_ZERO_BYTES, "CTL");

constexpr int RING_BYTES = 131072;
constexpr int TAB_OFF = RING_BYTES;
constexpr int TAB_BLK = TAB_OFF, TAB_GATH = TAB_OFF + 2048;
constexpr int MISC_OFF = TAB_GATH + 11 * 1024;
constexpr int LDS_BYTES = 147456;
static_assert(MISC_OFF + 256 <= LDS_BYTES, "LDS map");

#define RLX_AGENT __ATOMIC_RELAXED, __HIP_MEMORY_SCOPE_AGENT
#define LDS_WAIT() asm volatile("s_waitcnt lgkmcnt(0)" ::: "memory")

#define XB_TMO      128
#define XB_XCNT(j)  (256  + 64 * (j))
#define XB_XSUB(j)  (1280 + 64 * (j))
#define XB_XGEN(j)  (2304 + 64 * (j))
#define XB_TOP      3328
#define XB_TOPGEN   3392
#define XCD_BAR_WORDS 3456
#define XB_SPIN_CAP (1u << 22)
__device__ __forceinline__ unsigned xb_ld(unsigned* p)              { return __hip_atomic_load(p, __ATOMIC_RELAXED, __HIP_MEMORY_SCOPE_AGENT); }
__device__ __forceinline__ unsigned xb_add(unsigned* p, unsigned v) { return __hip_atomic_fetch_add(p, v, __ATOMIC_RELAXED, __HIP_MEMORY_SCOPE_AGENT); }
__device__ __forceinline__ unsigned xb_xcc_id() { return (unsigned)__builtin_amdgcn_s_getreg((3 << 11) | 20) & 0xFu; }
#define XB_SPIN(cond, bar) do { unsigned _sp = 0; while (cond) { __builtin_amdgcn_s_sleep(1); \
    if ((++_sp & 255u) == 0u) { if (xb_ld(&(bar)[XB_TMO])) break; if (_sp > XB_SPIN_CAP) { atomicAdd(&(bar)[XB_TMO], 1u); break; } } } } while (0)
struct XcdBarrier { unsigned* bar; unsigned x; volatile LAS unsigned* st; };
__device__ __forceinline__ XcdBarrier xcd_barrier_post(unsigned* bar, volatile LAS unsigned* st) {
    XcdBarrier b; b.bar = bar; b.x = xb_xcc_id(); b.st = st;
    if (threadIdx.x == 0) (void)xb_add(&bar[XB_XCNT(b.x)], 1u);
    return b;
}
__device__ __forceinline__ void xcd_barrier_complete(unsigned* bar, unsigned x, unsigned& nloc, unsigned& nx) {
    const unsigned G = gridDim.x * gridDim.y * gridDim.z;
    unsigned sum, cnt, mine, sp = 0u;
    for (;;) {
        sum = 0u; cnt = 0u; mine = 0u;
#pragma unroll
        for (unsigned j = 0; j < 16; ++j) { const unsigned c = xb_ld(&bar[XB_XCNT(j)]); sum += c; cnt += (c > 0u) ? 1u : 0u; mine = (j == x) ? c : mine; }
        if (sum == G) break;
        __builtin_amdgcn_s_sleep(1);
        if ((++sp & 255u) == 0u) { if (xb_ld(&bar[XB_TMO])) break; if (sp > XB_SPIN_CAP) { atomicAdd(&bar[XB_TMO], 1u); break; } }
    }
    nloc = mine > 0u ? mine : 1u; nx = cnt > 0u ? cnt : 1u;
}
__device__ __forceinline__ void xcd_barrier(const XcdBarrier& b) {
    asm volatile("s_waitcnt vmcnt(0)" ::: "memory");
    __syncthreads();
    if (threadIdx.x == 0) {
        unsigned* bar = b.bar;
        __builtin_amdgcn_s_waitcnt(0);
        unsigned nloc = b.st[0], nx = b.st[1];
        if (nloc == 0u) { xcd_barrier_complete(bar, b.x, nloc, nx); b.st[0] = nloc; b.st[1] = nx; }
        const unsigned old = xb_add(&bar[XB_XSUB(b.x)], 1u);
        const unsigned gen = old / nloc;
        if (old + 1u == (gen + 1u) * nloc) {
            __builtin_amdgcn_fence(__ATOMIC_RELEASE, "agent");
            asm volatile("s_waitcnt vmcnt(0)" ::: "memory");
            const unsigned og = xb_add(&bar[XB_TOP], 1u);
            const unsigned tg = og / nx;
            if (og + 1u == (tg + 1u) * nx) xb_add(&bar[XB_TOPGEN], 1u);
            else XB_SPIN(xb_ld(&bar[XB_TOPGEN]) == tg, bar);
            __builtin_amdgcn_fence(__ATOMIC_ACQUIRE, "agent");
            xb_add(&bar[XB_XGEN(b.x)], 1u);
            asm volatile("s_waitcnt vmcnt(0)" ::: "memory");
        } else {
            XB_SPIN(xb_ld(&bar[XB_XGEN(b.x)]) == gen, bar);
            __builtin_amdgcn_fence(__ATOMIC_ACQUIRE, "agent");
            asm volatile("s_waitcnt vmcnt(0)" ::: "memory");
        }
    }
    __syncthreads();
}

constexpr int NWAVES = 8;
struct Args { const float* in[24]; float* out; unsigned char* ws; int ph_lo, ph_hi; };
enum { I_X = 0, I_C, I_WADA, I_BADA, I_GAPRE, I_GAPOST, I_WIN, I_BGATE, I_RPB, I_QNG, I_KVNG, I_WUQ, I_WUKV, I_WNAUP, I_WMLAUP, I_WOUT, I_GFPRE, I_GFPOST, I_WR, I_BR, I_W1, I_B1, I_W2, I_B2 };

__device__ __forceinline__ void tr_store_tile(LAS unsigned char* scr, bf16_t* dst, int K, int n0, int k0, int lane) {
    LDS_WAIT(); asm volatile("" ::: "memory");
#pragma unroll
    for (int j = 0; j < 8; ++j) { const int idx = j * 64 + lane, n = idx >> 3, ch = idx & 7;
        const u32x4 v = *(const LAS u32x4*)(scr + n * 144 + ch * 16);
        *(GAS u32x4*)(dst + (size_t)(n0 + n) * K + k0 + ch * 8) = v; }
    LDS_WAIT(); asm volatile("" ::: "memory");
}
__device__ __forceinline__ void tr_tile_fast(const float* src, int Nsrc, int src0, const float* kscale, bf16_t* dst, int K, int n0, int k0, LAS unsigned char* scr, int lane) {
#pragma unroll
    for (int st = 0; st < 8; ++st) { const int kq = st * 4 + (lane >> 4), c4 = (lane & 15) * 4, k = 2 * kq;
        f32x4 a = *(const GAS f32x4*)(src + (size_t)(k0 + k) * Nsrc + src0 + c4);
        f32x4 b = *(const GAS f32x4*)(src + (size_t)(k0 + k + 1) * Nsrc + src0 + c4);
        if (kscale) { const float s0 = kscale[k0 + k], s1 = kscale[k0 + k + 1]; a = a * s0; b = b * s1; }
#pragma unroll
        for (int i = 0; i < 4; ++i) *(LAS unsigned*)(scr + (c4 + i) * 144 + k * 2) = cvt_pk_bf16(a[i], b[i]); }
    tr_store_tile(scr, dst, K, n0, k0, lane);
}
__device__ __forceinline__ void tr_tile_slow(const float* src, int Nsrc, int srccol  , const float* kscale, bf16_t* dst, int K, int n0, int k0, LAS unsigned char* scr, int lane) {
#pragma unroll 8
    for (int k = 0; k < 64; k += 2) {
        float a = 0.f, b = 0.f;
        if (srccol >= 0) { a = src[(size_t)(k0 + k) * Nsrc + srccol]; b = src[(size_t)(k0 + k + 1) * Nsrc + srccol];
            if (kscale) { a *= kscale[k0 + k]; b *= kscale[k0 + k + 1]; } }
        *(LAS unsigned*)(scr + lane * 144 + k * 2) = cvt_pk_bf16(a, b); }
    tr_store_tile(scr, dst, K, n0, k0, lane);
}
__device__ __forceinline__ int rope_orig(int p) { return (p & 16) + 8 * (p & 1) + ((p & 15) >> 1); }

__global__ void __launch_bounds__(NWAVES * 64, 2) fwd_kernel(Args args) {
    extern __shared__ __attribute__((aligned(16))) unsigned char lds[];
    LAS unsigned char* L = (LAS unsigned char*)lds;
    volatile LAS unsigned* MISC = (volatile LAS unsigned*)(L + MISC_OFF);
    const int tid = threadIdx.x, lane = tid & 63, wave = __builtin_amdgcn_readfirstlane(tid >> 6);
    const int G = gridDim.x, bx = blockIdx.x, vcu = (G % 8 == 0) ? (bx % 8) * (G / 8) + bx / 8 : bx;
    unsigned char* ws = args.ws;
    gu32* ctl = (gu32*)(ws + WS_CTL);
    const int lo = args.ph_lo, hi = args.ph_hi;
    for (int u = tid; u < 64; u += NWAVES * 64) MISC[u] = 0u;
    __syncthreads();
    XcdBarrier bar; bar.bar = (unsigned*)(ctl + CW_BAR); bar.x = 0; bar.st = nullptr;
    const bool use_bar = (hi - lo) > 1;
    if (use_bar) bar = xcd_barrier_post((unsigned*)(ctl + CW_BAR), MISC + 8);
#ifndef PHASE_MASK
#define PHASE_MASK 0xFFFF
#endif
#define IN(k) (((PHASE_MASK >> (k)) & 1) && lo <= (k) && (k) < hi)
#define SEAM(k) do { if (IN(k) && IN((k) + 1)) xcd_barrier(bar); } while (0)
    const int gw = vcu * NWAVES + wave, NGW = G * NWAVES;
    float* ROPE = (float*)(ctl + CW_ROPE);
    float* MODP = (float*)(ws + WS_MODP); float* MOD = (float*)(ws + WS_MODP + 512 * 1024); float* SSQ = (float*)(ws + WS_SSQ); unsigned* CNT = (unsigned*)(ctl + CW_CNT);
    bf16_t* WINT = (bf16_t*)(ws + WS_WIN); bf16_t* WUQT = (bf16_t*)(ws + WS_WUQ); bf16_t* WUKVT = (bf16_t*)(ws + WS_WUKV);
    bf16_t* WNAT = (bf16_t*)(ws + WS_WNA); bf16_t* WMLAT = (bf16_t*)(ws + WS_WMLA); bf16_t* WOUTT = (bf16_t*)(ws + WS_WOUT);
    bf16_t* W1T = (bf16_t*)(ws + WS_W1); bf16_t* W2T = (bf16_t*)(ws + WS_W2);
    bf16_t* XN = (bf16_t*)(ws + WS_XN); bf16_t* PROJ = (bf16_t*)(ws + WS_PROJ);
    bf16_t* QN = (bf16_t*)(ws + WS_QN); bf16_t* QR = (bf16_t*)(ws + WS_QR); bf16_t* KN = (bf16_t*)(ws + WS_KN); bf16_t* KR = (bf16_t*)(ws + WS_KR); bf16_t* VM = (bf16_t*)(ws + WS_VM);
    bf16_t* ONA = (bf16_t*)(ws + WS_ONA); bf16_t* OMLA = (bf16_t*)(ws + WS_OMLA); bf16_t* MERGED = (bf16_t*)(ws + WS_MERGED);
    float* TMP = (float*)(ws + WS_TMP); unsigned* LIST = (unsigned*)(ws + WS_LIST); unsigned* TOKPOS = (unsigned*)(ws + WS_TOKPOS); float* TOKG = (float*)(ws + WS_TOKG);
    bf16_t* ACT = (bf16_t*)(ws + WS_ACT); bf16_t* YIT = (bf16_t*)(ws + WS_YIT);
    const float* X = args.in[I_X]; float* OUT = args.out;

    if (IN(0)) {
        LAS unsigned char* scr = L + wave * 16384;
        {   const float* c = args.in[I_C]; const float* wada = args.in[I_WADA]; const float* bada = args.in[I_BADA];
            for (int it = gw; it < 96 * 8; it += NGW) { const int nb = it % 96, kc = it / 96, n = nb * 64 + lane;
                float a0 = 0.f, a1 = 0.f;
#pragma unroll 8
                for (int k = 0; k < 128; ++k) { const int kk = kc * 128 + k; const float w = wada[(size_t)kk * 6144 + n];
                    const float c0 = c[kk], c1 = c[1024 + kk]; a0 += (c0 * sigmoidf_(c0)) * w; a1 += (c1 * sigmoidf_(c1)) * w; }
                if (kc == 0) { a0 += bada[n]; a1 += bada[n]; }
                MODP[(kc * 2 + 0) * 6144 + n] = a0; MODP[(kc * 2 + 1) * 6144 + n] = a1; } }
        if (bx == 0) { for (int i = tid; i < 128 * 8; i += NWAVES * 64) { const int pos = i >> 3, j = i & 7; float c, sn; rope_cs((float)pos, j, c, sn); ROPE[pos * 16 + j] = c; ROPE[pos * 16 + 8 + j] = sn; } }
        {   constexpr int I_WIN_ = 16 * 68, I_UQ = 6 * 12, I_UKV = 4 * 16, I_UP = 8 * 16, I_OUT = 16 * 16, I_W1_ = NEXP * 16 * 32, I_W2_ = NEXP * 16 * 16;
            constexpr int NITEMS = I_WIN_ + I_UQ + I_UKV + 2 * I_UP + I_OUT + I_W1_ + I_W2_;
            for (int it = gw; it < NITEMS; it += NGW) {
                int r = it;
                if (r < I_W1_) { const int e = r / 512, q = r % 512, kb = q / 32, nb = q % 32;
                    tr_tile_fast(args.in[I_W1] + (size_t)e * 1024 * 2048, 2048, nb * 64, nullptr, W1T + (size_t)e * 2048 * 1024, 1024, nb * 64, kb * 64, scr, lane); continue; } r -= I_W1_;
                if (r < I_W2_) { const int e = r / 256, q = r % 256, kb = q / 16, nb = q % 16;
                    tr_tile_fast(args.in[I_W2] + (size_t)e * 1024 * 1024, 1024, nb * 64, nullptr, W2T + (size_t)e * 1024 * 1024, 1024, nb * 64, kb * 64, scr, lane); continue; } r -= I_W2_;
                if (r < I_WIN_) { const int kb = r / 68, nb = r % 68;
                    if (nb < 34) tr_tile_fast(args.in[I_WIN], 4256, nb * 64, nullptr, WINT, 1024, nb * 64, kb * 64, scr, lane);
                    else if (nb >= 36) tr_tile_fast(args.in[I_WIN], 4256, 2208 + (nb - 36) * 64, nullptr, WINT, 1024, nb * 64, kb * 64, scr, lane);
                    else { const int n = nb * 64 + lane; const int sc = (n < 2208) ? 2176 + rope_orig(n - 2176) : -1;
                        tr_tile_slow(args.in[I_WIN], 4256, sc, nullptr, WINT, 1024, nb * 64, kb * 64, scr, lane); }
                    continue; } r -= I_WIN_;
                if (r < I_UQ) { const int kb = r / 12, nb = r % 12;
                    if (nb < 8) tr_tile_fast(args.in[I_WUQ], 768, nb * 96, args.in[I_QNG], WUQT, 384, nb * 64, kb * 64, scr, lane);
                    else { const int n = nb * 64 + lane - 512, h = n >> 5, p = n & 31;
                        tr_tile_slow(args.in[I_WUQ], 768, h * 96 + 64 + rope_orig(p), args.in[I_QNG], WUQT, 384, nb * 64, kb * 64, scr, lane); }
                    continue; } r -= I_UQ;
                if (r < I_UKV) { const int kb = r / 16, nb = r % 16;
                    const int s0 = (nb < 8) ? nb * 128 : (nb - 8) * 128 + 64;
                    tr_tile_fast(args.in[I_WUKV], 1024, s0, args.in[I_KVNG], WUKVT, 256, nb * 64, kb * 64, scr, lane); continue; } r -= I_UKV;
                if (r < I_UP) { const int kb = r / 16, nb = r % 16; tr_tile_fast(args.in[I_WNAUP], 1024, nb * 64, nullptr, WNAT, 512, nb * 64, kb * 64, scr, lane); continue; } r -= I_UP;
                if (r < I_UP) { const int kb = r / 16, nb = r % 16; tr_tile_fast(args.in[I_WMLAUP], 1024, nb * 64, nullptr, WMLAT, 512, nb * 64, kb * 64, scr, lane); continue; } r -= I_UP;
                { const int kb = r / 16, nb = r % 16; tr_tile_fast(args.in[I_WOUT], 1024, nb * 64, nullptr, WOUTT, 1024, nb * 64, kb * 64, scr, lane); }
            } }
    }
    SEAM(0);
    if (IN(1)) {
        const float* g = args.in[I_GAPRE];
        LAS float* modl = (LAS float*)L;
        for (int i = tid; i < 4096; i += NWAVES * 64) { const int b = i >> 11, c = i & 2047; float sm = 0.f;
#pragma unroll
            for (int kc = 0; kc < 8; ++kc) sm += MODP[(kc * 2 + b) * 6144 + c];
            modl[i] = sm; }
        for (int idx = bx * (NWAVES * 64) + tid; idx < 2 * 6144; idx += G * NWAVES * 64) { const int b = idx / 6144, n = idx % 6144; float sm = 0.f;
#pragma unroll
            for (int kc = 0; kc < 8; ++kc) sm += MODP[(kc * 2 + b) * 6144 + n];
            MOD[idx] = sm; }
        __syncthreads();
        for (int m = gw; m < MTOK; m += NGW) { const int b = m >> 13;
            const GAS f32x4* xr = (const GAS f32x4*)(X + (size_t)m * DM) + lane; f32x4 v[4]; float s = 0.f;
#pragma unroll
            for (int j = 0; j < 4; ++j) { v[j] = xr[64 * j]; s += (v[j].x * v[j].x + v[j].y * v[j].y) + (v[j].z * v[j].z + v[j].w * v[j].w); }
            const float rstd = __builtin_amdgcn_rsqf(wave_sum(s) * (1.f / DM) + RMS_EPS);
            GAS u32x2* o8 = (GAS u32x2*)(XN + (size_t)m * DM) + lane;
#pragma unroll
            for (int j = 0; j < 4; ++j) { const int col = 4 * lane + 256 * j;
                const f32x4 gg = *(const f32x4*)(g + col), sh = *(const LAS f32x4*)(modl + b * 2048 + col), scl = *(const LAS f32x4*)(modl + b * 2048 + 1024 + col);
                const f32x4 h = v[j] * rstd * gg * (scl + 1.f) + sh; u32x2 w; w.x = cvt_pk_bf16(h[0], h[1]); w.y = cvt_pk_bf16(h[2], h[3]); o8[64 * j] = w; } }
    }
    SEAM(1);
    if (IN(2)) {
        pg8::SchedDense S{(const char*)XN, (const char*)WINT, (size_t)256 * 1024 * 2, (size_t)256 * 1024 * 2, MTOK / 256, NPROJ / 256, G, bx};
        pg8::EpiInProj E{PROJ, SSQ, KR, ROPE};
        pg8::gemm_phase<pg8::EpiInProj, pg8::SchedDense, true, false>(L, 1024, 1024, S, E);
    }
    SEAM(2);
    if (IN(3)) {
#ifndef NO_QUP
        {   pg8::SchedDense S{(const char*)(PROJ + 1536), (const char*)WUQT, (size_t)256 * NPROJ * 2, (size_t)256 * 384 * 2, MTOK / 256, 3, G, bx};
            pg8::EpiQUp E{QN, QR, SSQ, ROPE};
            pg8::gemm_phase<pg8::EpiQUp, pg8::SchedDense, true, false>(L, 384, NPROJ, S, E); }
#endif
#ifndef NO_KVUP
        {   pg8::SchedDense S{(const char*)(PROJ + 1920), (const char*)WUKVT, (size_t)256 * NPROJ * 2, (size_t)256 * 256 * 2, MTOK / 256, 4, G, G - 1 - bx};
            pg8::EpiKVUp E{KN, VM, SSQ};
            pg8::gemm_phase<pg8::EpiKVUp, pg8::SchedDense, true, false>(L, 256, NPROJ, S, E); }
#endif
    }
    SEAM(3);
    if (IN(4)) {
#ifndef NO_MLA
        for (int u = vcu; u < 512; u += G) {
            const int bh = u >> 5, qb = u & 31, b = bh >> 3, h = bh & 7; const size_t row0 = (size_t)b * SEQ + qb * 256, key0 = (size_t)b * SEQ;
            attn::attn_unit<0>(QN + row0 * 512 + h * 64, 512, QR + row0 * 256 + h * 32, 256, KN + key0 * 512 + h * 64, 512, KR + key0 * 32, 32, VM + key0 * 512 + h * 64, 512,
                               OMLA + row0 * 512 + h * 64, 128, 0, 128, 0, nullptr, (char*)lds);
        }
#endif
#ifndef NO_NA
        for (int u = vcu; u < 512; u += G) {
            const int bh = u >> 5, rb = u & 31, b = bh >> 3, h = bh & 7; const size_t row0 = (size_t)b * SEQ + rb * 256, key0 = (size_t)b * SEQ;
            const int krow0 = min(max(4 * rb - 4, 0), 120), klast = min(max(4 * rb + 3 - 4, 0), 120) + 7, ntreal = klast - krow0 + 1, NT = (ntreal + 1) & ~1;
            attn::attn_unit<1>(PROJ + row0 * NPROJ + h * 64, NPROJ, nullptr, 0, PROJ + key0 * NPROJ + 512 + h * 64, NPROJ, nullptr, 0, PROJ + key0 * NPROJ + 1024 + h * 64, NPROJ,
                               ONA + row0 * 512 + h * 64, NT, krow0, ntreal, 4 * rb, args.in[I_RPB] + h * 15 * 31, (char*)lds);
        }
#endif
    }
    SEAM(4);
    if (IN(5)) {
        pg8::SchedMerge S{(const char*)ONA, (const char*)OMLA, (const char*)WNAT, (const char*)WMLAT, MTOK / 256, 4, G, bx};
        pg8::EpiMerge E{PROJ, args.in[I_BGATE], TMP, MERGED};
        pg8::gemm_phase<pg8::EpiMerge, pg8::SchedMerge, true, false>(L, 512, 512, S, E);
    }
    SEAM(5);
    if (IN(6)) {
        pg8::SchedDense S{(const char*)MERGED, (const char*)WOUTT, (size_t)256 * 1024 * 2, (size_t)256 * 1024 * 2, MTOK / 256, 4, G, bx};
        pg8::EpiF32 E{TMP, 1024};
        pg8::gemm_phase<pg8::EpiF32, pg8::SchedDense, true, false>(L, 1024, 1024, S, E);
    }
    SEAM(6);
    if (IN(7)) {
        LAS float* h2s = (LAS float*)(L + wave * 4096);
        LAS int* sel_e = (LAS int*)(L + 32768); LAS float* sel_g = (LAS float*)(L + 32768 + 1024); LAS int* sel_r = (LAS int*)(L + 32768 + 2048);
        LAS int* lcnt = (LAS int*)(L + 32768 + 3072); LAS int* lbase = (LAS int*)(L + 32768 + 3072 + 128);
        const float* gpo = args.in[I_GAPOST]; const float* gfp = args.in[I_GFPRE]; const float* Wr = args.in[I_WR]; const float* br = args.in[I_BR];
        for (int blk = vcu; blk < MTOK / 64; blk += G) {
            if (tid < 32) lcnt[tid] = 0;
            __syncthreads();
            for (int rr = 0; rr < 8; ++rr) { const int lrow = wave * 8 + rr, m = blk * 64 + lrow, b = m >> 13;
                const GAS f32x4* yr = (const GAS f32x4*)(TMP + (size_t)m * DM) + lane; const GAS f32x4* xr = (const GAS f32x4*)(X + (size_t)m * DM) + lane;
                f32x4 y[4], x1[4]; float s = 0.f;
#pragma unroll
                for (int j = 0; j < 4; ++j) { y[j] = yr[64 * j]; x1[j] = xr[64 * j]; s += (y[j].x * y[j].x + y[j].y * y[j].y) + (y[j].z * y[j].z + y[j].w * y[j].w); }
                const float rstd = __builtin_amdgcn_rsqf(wave_sum(s) * (1.f / DM) + RMS_EPS); float s2 = 0.f;
#pragma unroll
                for (int j = 0; j < 4; ++j) { const int col = 4 * lane + 256 * j;
                    const f32x4 gg = *(const f32x4*)(gpo + col), ga = *(const f32x4*)(MOD + b * 6144 + 2048 + col);
                    x1[j] = x1[j] + ga * (y[j] * rstd * gg);
                    *((GAS f32x4*)(OUT + (size_t)m * DM) + lane + 64 * j) = x1[j];
                    s2 += (x1[j].x * x1[j].x + x1[j].y * x1[j].y) + (x1[j].z * x1[j].z + x1[j].w * x1[j].w); }
                const float rstd2 = __builtin_amdgcn_rsqf(wave_sum(s2) * (1.f / DM) + RMS_EPS);
                GAS u32x2* o8 = (GAS u32x2*)(XN + (size_t)m * DM) + lane;
#pragma unroll
                for (int j = 0; j < 4; ++j) { const int col = 4 * lane + 256 * j;
                    const f32x4 gg = *(const f32x4*)(gfp + col), sh = *(const f32x4*)(MOD + b * 6144 + 3072 + col), scl = *(const f32x4*)(MOD + b * 6144 + 4096 + col);
                    const f32x4 h = x1[j] * rstd2 * gg * (scl + 1.f) + sh; u32x2 w; w.x = cvt_pk_bf16(h[0], h[1]); w.y = cvt_pk_bf16(h[2], h[3]); o8[64 * j] = w;
                    *(LAS f32x4*)(h2s + col) = h; }
                LDS_WAIT(); asm volatile("" ::: "memory");
                const int e = lane & 31, kh = lane >> 5; float a0 = 0.f, a1 = 0.f, a2 = 0.f, a3 = 0.f;
#pragma unroll 4
                for (int k = 0; k < 512; k += 4) { const int kk = kh * 512 + k; const f32x4 hv = *(const LAS f32x4*)(h2s + kk);
                    a0 += hv[0] * Wr[(size_t)(kk + 0) * 32 + e]; a1 += hv[1] * Wr[(size_t)(kk + 1) * 32 + e]; a2 += hv[2] * Wr[(size_t)(kk + 2) * 32 + e]; a3 += hv[3] * Wr[(size_t)(kk + 3) * 32 + e]; }
                float lg = (a0 + a1) + (a2 + a3); lg += __shfl_xor(lg, 32); lg += br[e];
                float tv[4]; int ti[4]; float cur = lg;
#pragma unroll
                for (int t = 0; t < 4; ++t) { float bv = cur; int bi = e;
#pragma unroll
                    for (int o = 1; o < 32; o <<= 1) { const float ov = __shfl_xor(bv, o); const int oi = __shfl_xor(bi, o); if (ov > bv || (ov == bv && oi < bi)) { bv = ov; bi = oi; } }
                    tv[t] = bv; ti[t] = bi; if (e == bi) cur = -3.0e38f; }
                const float e1 = __builtin_amdgcn_exp2f((tv[1] - tv[0]) * LOG2E), e2 = __builtin_amdgcn_exp2f((tv[2] - tv[0]) * LOG2E), e3 = __builtin_amdgcn_exp2f((tv[3] - tv[0]) * LOG2E);
                const float inv = 1.f / (1.f + e1 + e2 + e3);
                if (lane < 4) { const int t = lane; const int ee = t == 0 ? ti[0] : t == 1 ? ti[1] : t == 2 ? ti[2] : ti[3];
                    const float gg = (t == 0 ? 1.f : t == 1 ? e1 : t == 2 ? e2 : e3) * inv;
                    const int rk = __hip_atomic_fetch_add(&lcnt[ee], 1, __ATOMIC_RELAXED, __HIP_MEMORY_SCOPE_WORKGROUP);
                    sel_e[lrow * 4 + t] = ee; sel_g[lrow * 4 + t] = gg; sel_r[lrow * 4 + t] = rk; }
                LDS_WAIT(); asm volatile("" ::: "memory");
            }
            __syncthreads();
            if (tid < 32) lbase[tid] = (int)atomicAdd(CNT + tid, (unsigned)lcnt[tid]);
            __syncthreads();
            if (tid < 256) { const int ee = sel_e[tid], pos = lbase[ee] + sel_r[tid], tok = blk * 64 + (tid >> 2);
                LIST[(size_t)ee * LISTCAP + pos] = (unsigned)tok; TOKPOS[(size_t)tok * 4 + (tid & 3)] = ((unsigned)ee << 16) | (unsigned)pos; TOKG[(size_t)tok * 4 + (tid & 3)] = sel_g[tid]; }
            __syncthreads();
        }
    }
    SEAM(7);
    if (IN(8) || IN(9)) {
        LAS int* blk_e = (LAS int*)(L + TAB_BLK);
        if (tid == 0) { int nb = 0; for (int e = 0; e < NEXP; ++e) { const int c = (int)__hip_atomic_load(CNT + e, RLX_AGENT); const int n = (c + 255) >> 8; for (int i = 0; i < n; ++i) blk_e[nb + i] = e; nb += n; } MISC[16] = (unsigned)nb; }
        __syncthreads();
        const int NB = (int)MISC[16];
        if (IN(8)) {
            for (int i = 0;; ++i) { const long Lu = (long)i * G + bx; if (Lu >= (long)NB * 8 || i >= 11) break;
                const int grb = (int)(Lu >> 3), e = blk_e[grb]; int first = grb; while (first > 0 && blk_e[first - 1] == e) --first;
                const int cnt = (int)__hip_atomic_load(CNT + e, RLX_AGENT);
                if (tid < 256) { const int ri = (grb - first) * 256 + tid; const unsigned tok = (ri < cnt) ? LIST[(size_t)e * LISTCAP + ri] : 0u;
                    *(LAS unsigned*)(L + TAB_GATH + i * 1024 + tid * 4) = tok * 2048u; } }
            __syncthreads();
            pg8::SchedMoe<8, true> S{(const char*)XN, (const char*)W1T, (size_t)2048 * 1024 * 2, blk_e, NB, G, bx, TAB_GATH};
            pg8::EpiMoe1 E{args.in[I_B1], ACT};
            pg8::gemm_phase<pg8::EpiMoe1, pg8::SchedMoe<8, true>, true, true>(L, 1024, 1024, S, E);
        }
        SEAM(8);
        if (IN(9)) {
            pg8::SchedMoe<4, false> S{(const char*)ACT, (const char*)W2T, (size_t)1024 * 1024 * 2, blk_e, NB, G, bx, 0};
            pg8::EpiMoe2 E{args.in[I_B2], YIT};
            pg8::gemm_phase<pg8::EpiMoe2, pg8::SchedMoe<4, false>, true, false>(L, 1024, 1024, S, E);
        }
    }
    SEAM(9);
    if (IN(10)) {
        LAS int* rbase = (LAS int*)(L + 0);
        if (tid == 0) { int nb = 0; for (int e = 0; e < NEXP; ++e) { rbase[e] = nb * 256; nb += ((int)__hip_atomic_load(CNT + e, RLX_AGENT) + 255) >> 8; } }
        __syncthreads();
        const float* gfo = args.in[I_GFPOST];
        for (int m = gw; m < MTOK; m += NGW) { const int b = m >> 13;
            f32x4 y[4];
#pragma unroll
            for (int j = 0; j < 4; ++j) y[j] = (f32x4){0.f, 0.f, 0.f, 0.f};
#pragma unroll
            for (int t = 0; t < 4; ++t) { const unsigned tp = TOKPOS[(size_t)m * 4 + t]; const float gt = TOKG[(size_t)m * 4 + t];
                const size_t row = (size_t)rbase[tp >> 16] + (tp & 0xffffu); const GAS u32x2* yr = (const GAS u32x2*)(YIT + row * 1024) + lane;
#pragma unroll
                for (int j = 0; j < 4; ++j) { const u32x2 w = yr[64 * j]; y[j][0] += gt * bf16_lo(w.x); y[j][1] += gt * bf16_hi(w.x); y[j][2] += gt * bf16_lo(w.y); y[j][3] += gt * bf16_hi(w.y); } }
            float s = 0.f;
#pragma unroll
            for (int j = 0; j < 4; ++j) s += (y[j].x * y[j].x + y[j].y * y[j].y) + (y[j].z * y[j].z + y[j].w * y[j].w);
            const float rstd = __builtin_amdgcn_rsqf(wave_sum(s) * (1.f / DM) + RMS_EPS);
            GAS f32x4* orow = (GAS f32x4*)(OUT + (size_t)m * DM) + lane;
#pragma unroll
            for (int j = 0; j < 4; ++j) { const int col = 4 * lane + 256 * j;
                const f32x4 gg = *(const f32x4*)(gfo + col), gf = *(const f32x4*)(MOD + b * 6144 + 5120 + col);
                orow[64 * j] = orow[64 * j] + gf * (y[j] * rstd * gg); } }
    }
#undef IN
#undef SEAM
}

constexpr int N_PHASES = 11;
extern "C" void kernel_launch(void* const* d_in, const int* in_sizes, int n_in, void* d_out, int out_size, void* d_ws, size_t ws_size, hipStream_t stream) {
    static int grid = 0;
    if (grid == 0) {
        if (n_in != 24 || out_size != MTOK * DM || ws_size < WS_END) { fprintf(stderr, "kernel_launch: unexpected shapes (n_in %d out %d ws %zu)\n", n_in, out_size, ws_size); grid = -1; return; }
        int dev = 0, cus = 0, per_cu = 0;
        if (hipGetDevice(&dev) != hipSuccess || hipDeviceGetAttribute(&cus, hipDeviceAttributeMultiprocessorCount, dev) != hipSuccess) { grid = -1; return; }
        if (hipFuncSetAttribute((const void*)fwd_kernel, hipFuncAttributeMaxDynamicSharedMemorySize, LDS_BYTES) != hipSuccess) { fprintf(stderr, "kernel_launch: hipFuncSetAttribute failed\n"); grid = -1; return; }
        if (hipOccupancyMaxActiveBlocksPerMultiprocessor(&per_cu, (const void*)fwd_kernel, NWAVES * 64, LDS_BYTES) != hipSuccess || per_cu < 1) { fprintf(stderr, "kernel_launch: occupancy query says %d\n", per_cu); per_cu = 1; }
        (void)hipGetLastError();
        grid = cus;
    }
    if (grid < 0) return;
    (void)hipMemsetAsync((char*)d_ws + WS_CTL, 0, CTL_ZERO_BYTES, stream);
    Args a{};
    for (int i = 0; i < 24; ++i) a.in[i] = (const float*)d_in[i];
    a.out = (float*)d_out; a.ws = (unsigned char*)d_ws;
#if MK_N_LAUNCHES == 1
    a.ph_lo = 0; a.ph_hi = N_PHASES;
    hipLaunchKernelGGL(fwd_kernel, dim3(grid), dim3(NWAVES * 64), LDS_BYTES, stream, a);
#else
    for (int p = 0; p < N_PHASES; ++p) { a.ph_lo = p; a.ph_hi = p + 1; hipLaunchKernelGGL(fwd_kernel, dim3(grid), dim3(NWAVES * 64), LDS_BYTES, stream, a); }
#endif
    const hipError_t le = hipPeekAtLastError();
    if (le != hipSuccess) fprintf(stderr, "kernel_launch: launch failed: %s\n", hipGetErrorName(le));
}
```

```cpp
#include <hip/hip_runtime.h>
#include <hip/hip_bf16.h>
#include <cstdio>
#include <cstdint>

#ifndef MK_N_LAUNCHES
#define MK_N_LAUNCHES 1
#endif

constexpr int BATCH = 2, SEQ = 8192, DM = 1024, MTOK = BATCH * SEQ;
constexpr int NPROJ = 4352;
constexpr int NEXP = 32, DFF = 1024, TOPK = 4;
constexpr int QLORA = 384, KVLORA = 256;
constexpr float RMS_EPS = 1e-6f;
constexpr float LOG2E = 1.4426950408889634f;
constexpr float C2NA = 0.125f * LOG2E;
constexpr float C2MLA = 0.10206207261596575f * LOG2E;
constexpr int LISTCAP = 16384;
constexpr int MAXROWS = 65536 + NEXP * 256;

#define GAS __attribute__((address_space(1)))
#define LAS __attribute__((address_space(3)))
typedef unsigned short bf16_t;
typedef short bf16x8 __attribute__((ext_vector_type(8)));
typedef short s16x4 __attribute__((ext_vector_type(4)));
typedef float f32x4 __attribute__((ext_vector_type(4)));
typedef float f32x2 __attribute__((ext_vector_type(2)));
typedef float f32x16 __attribute__((ext_vector_type(16)));
typedef unsigned u32x4 __attribute__((ext_vector_type(4)));
typedef unsigned u32x2 __attribute__((ext_vector_type(2)));
typedef GAS unsigned gu32;

__device__ __forceinline__ unsigned cvt_pk_bf16(float lo, float hi) { unsigned r; asm volatile("v_cvt_pk_bf16_f32 %0, %1, %2" : "=v"(r) : "v"(lo), "v"(hi)); return r; }
__device__ __forceinline__ float bf16_lo(unsigned w) { return __uint_as_float(w << 16); }
__device__ __forceinline__ float bf16_hi(unsigned w) { return __uint_as_float(w & 0xffff0000u); }
__device__ __forceinline__ float sigmoidf_(float z) { return __builtin_amdgcn_rcpf(1.f + __builtin_amdgcn_exp2f(-z * LOG2E)); }
__device__ __forceinline__ float wave_sum(float v) {
#pragma unroll
    for (int o = 1; o < 64; o <<= 1) v += __shfl_xor(v, o);
    return v;
}
__device__ __forceinline__ void rope_cs(float pos, int j, float& c, float& s) {
    const float inv = __builtin_amdgcn_exp2f(-(float)j * 0.83048202372184059f);
    const float rev = __builtin_amdgcn_fractf(pos * inv * 0.15915494309189535f);
    c = __builtin_amdgcn_cosf(rev); s = __builtin_amdgcn_sinf(rev);
}

namespace pg8 {
constexpr int BM = 256, BK = 64, HALF = 128, HTB = HALF * BK * 2, STAGE_BYTES = 8 * HTB, NXCD = 8, WGM = 8;
__host__ __device__ __forceinline__ int lds_byte(int r, int c) { const int st = (r >> 4) * 2 + (c >> 5), rr = r & 15, cc = c & 31, ob = rr * 64 + cc * 2; return st * 1024 + (ob ^ (((ob >> 9) & 1) << 5)); }
__host__ __device__ __forceinline__ void stage_rc(int b, int& R, int& C) { const int st = b / 1024, sb = b % 1024, swz = sb ^ (((sb >> 9) & 1) << 5); R = (st >> 1) * 16 + swz / 64; C = (st & 1) * 32 + (swz % 64) / 2; }
__host__ __device__ __forceinline__ int perm32(int rho) { const int n = rho >> 4, i = rho & 15; return 8 * (i >> 2) + 4 * n + (i & 3); }

struct Unit { const char* A; const char* B; int pm, pn, aux, tab; };

__device__ __forceinline__ void tile_of(int wgid, int nM, int nN, int& pm, int& pn) {
    const int nwg = nM * nN;
    { const int q = nwg / NXCD, r = nwg % NXCD, xcd = wgid % NXCD, off = wgid / NXCD; wgid = (xcd < r ? xcd * (q + 1) : r * (q + 1) + (xcd - r) * q) + off; }
    const int nig = WGM * nN, gid = wgid / nig, fm = gid * WGM, gsz = (nM - fm) < WGM ? (nM - fm) : WGM;
    pm = fm + ((wgid % nig) % gsz); pn = (wgid % nig) / gsz;
}

template <class Epi, class Sched, bool ALIGN_EPI, bool GATHER>
__device__ __forceinline__ void gemm_phase(LAS unsigned char* lds, const int K, const int lda, const Sched& S, const Epi& E) {
    const int tid = threadIdx.x, wid = __builtin_amdgcn_readfirstlane(tid >> 6), lane = tid & 63, wr = wid >> 2, wc = wid & 3, fr = lane & 15, fq = lane >> 4;
    const int nt = K / BK;
    int Rr[2], Cc[2];
    unsigned voffA[2], voffB[2];
#pragma unroll
    for (int i = 0; i < 2; ++i) { int R, C; stage_rc(tid * 16 + i * 8192, R, C); const int Rb = Epi::PERM ? ((R & ~31) + perm32(R & 31)) : R;
        Rr[i] = R; Cc[i] = C; voffA[i] = (unsigned)(R * lda + C) * 2u; voffB[i] = (unsigned)(Rb * K + C) * 2u; }
    const size_t kstep = (size_t)(BK * 2);
    const size_t hstepA = (size_t)HALF * lda * 2, hstepB = (size_t)HALF * K * 2;
    const unsigned ldsw = (unsigned)wid * 1024u;
    const int aoff = lds_byte(wr * 64 + fr, fq * 8), boff = lds_byte(wc * 32 + fr, fq * 8);
#define PG8_SA(b, h) (((b) * 2 + (h)) * HTB)
#define PG8_SB(b, h) ((4 + (b) * 2 + (h)) * HTB)
#define PG8_STAGE(bufoff, gbase, voff) do { _Pragma("unroll") for (int _i = 0; _i < 2; ++_i) \
        __builtin_amdgcn_global_load_lds((const unsigned*)((const char*)(gbase) + (voff)[_i]), (LAS unsigned*)(lds + (bufoff) + ldsw + _i * 8192), 16, 0, 0); } while (0)
#define PG8_STAGE_A(bufoff, gbase, h, G) do { if constexpr (GATHER) { PG8_STAGE(bufoff, gbase, (G)[h]); } else { PG8_STAGE(bufoff, (gbase) + (h) * hstepA, voffA); } } while (0)
#define PG8_STAGE_B(bufoff, gbase, h) PG8_STAGE(bufoff, (gbase) + (h) * hstepB, voffB)
#define PG8_LDA(dst, b, h) do { _Pragma("unroll") for (int m = 0; m < 4; ++m) _Pragma("unroll") for (int k = 0; k < 2; ++k) dst[m][k] = *(const LAS bf16x8*)(lds + PG8_SA(b, h) + aoff + m * 2048 + k * 1024); } while (0)
#define PG8_LDB(dst, b, h) do { _Pragma("unroll") for (int n = 0; n < 2; ++n) _Pragma("unroll") for (int k = 0; k < 2; ++k) dst[n][k] = *(const LAS bf16x8*)(lds + PG8_SB(b, h) + boff + n * 2048 + k * 1024); } while (0)
#define PG8_MMA(ai, bj, At, Bt) do { __builtin_amdgcn_s_setprio(1); _Pragma("unroll") for (int m = 0; m < 4; ++m) _Pragma("unroll") for (int n = 0; n < 2; ++n) _Pragma("unroll") for (int k = 0; k < 2; ++k) \
        acc[ai][bj][m][n] = __builtin_amdgcn_mfma_f32_16x16x32_bf16(Bt[n][k], At[m][k], acc[ai][bj][m][n], 0, 0, 0); __builtin_amdgcn_s_setprio(0); } while (0)
#define PG8_WAIT_V(n) asm volatile("s_waitcnt vmcnt(" #n ")" ::: "memory")
#define PG8_WAIT_L(n) asm volatile("s_waitcnt lgkmcnt(" #n ")" ::: "memory")
#define PG8_BAR __builtin_amdgcn_s_barrier()
#define PG8_SCHED __builtin_amdgcn_sched_barrier(0)
    Unit cur, nxt; int ui = 0;
    if (!S.next(0, cur)) return;
    f32x4 acc[2][2][4][2];
#pragma unroll
    for (int a = 0; a < 2; ++a)
#pragma unroll
        for (int b = 0; b < 2; ++b)
#pragma unroll
            for (int m = 0; m < 4; ++m)
#pragma unroll
                for (int n = 0; n < 2; ++n) acc[a][b][m][n] = (f32x4){0.f, 0.f, 0.f, 0.f};
    bf16x8 At[4][2], B0[2][2], B1[2][2];
    unsigned gC[2][2], gN[2][2];
#define PG8_GLOAD(G, u) do { if constexpr (GATHER) { const LAS unsigned* tb_ = (const LAS unsigned*)(lds + (u).tab); _Pragma("unroll") for (int h_ = 0; h_ < 2; ++h_) _Pragma("unroll") for (int i_ = 0; i_ < 2; ++i_) \
        (G)[h_][i_] = tb_[h_ * 128 + Rr[i_]] + (unsigned)(Cc[i_] * 2); } } while (0)
    PG8_GLOAD(gC, cur);
    const char* cA = cur.A; const char* cB = cur.B;
    PG8_STAGE_B(PG8_SB(0, 0), cB, 0); PG8_STAGE_B(PG8_SB(0, 1), cB, 1); PG8_STAGE_A(PG8_SA(0, 0), cA, 0, gC); PG8_STAGE_A(PG8_SA(0, 1), cA, 1, gC);
    if (wr == 1) PG8_BAR;
    PG8_WAIT_V(2); PG8_BAR;
    PG8_STAGE_B(PG8_SB(1, 0), cB + kstep, 0); PG8_STAGE_A(PG8_SA(1, 0), cA + kstep, 0, gC); PG8_STAGE_B(PG8_SB(1, 1), cB + kstep, 1);
    PG8_WAIT_V(6); PG8_BAR;
    for (;;) {
        const bool has_next = S.next(ui + 1, nxt);
        const char* nA = has_next ? nxt.A : cA; const char* nB = has_next ? nxt.B : cB;
        if constexpr (GATHER) { if (has_next) { PG8_GLOAD(gN, nxt); } else {
#pragma unroll
            for (int h_ = 0; h_ < 2; ++h_)
#pragma unroll
                for (int i_ = 0; i_ < 2; ++i_) gN[h_][i_] = gC[h_][i_]; } }
#pragma unroll 1
        for (int t = 0; t < nt; t += 2) {
            const bool last = (t == nt - 2);
            const char* a1 = cA + (size_t)(t + 1) * kstep;
            const char* a2 = last ? nA : cA + (size_t)(t + 2) * kstep; const char* b2 = last ? nB : cB + (size_t)(t + 2) * kstep;
            const char* a3 = a2 + kstep; const char* b3 = b2 + kstep;
            unsigned g2[2][2];
            if constexpr (GATHER) {
#pragma unroll
                for (int h_ = 0; h_ < 2; ++h_)
#pragma unroll
                    for (int i_ = 0; i_ < 2; ++i_) g2[h_][i_] = last ? gN[h_][i_] : gC[h_][i_]; }
            PG8_LDB(B0, 0, 0); PG8_LDB(B1, 0, 1); PG8_SCHED; PG8_LDA(At, 0, 0); PG8_STAGE_A(PG8_SA(1, 1), a1, 1, gC);
            PG8_WAIT_V(8); PG8_WAIT_L(0); PG8_BAR; PG8_MMA(0, 0, At, B0); PG8_MMA(0, 1, At, B1); PG8_BAR; PG8_SCHED;
            PG8_LDA(At, 0, 1); PG8_STAGE_B(PG8_SB(0, 0), b2, 0); PG8_STAGE_B(PG8_SB(0, 1), b2, 1); PG8_STAGE_A(PG8_SA(0, 0), a2, 0, g2);
            PG8_WAIT_V(8); PG8_WAIT_L(0); PG8_BAR; PG8_MMA(1, 0, At, B0); PG8_MMA(1, 1, At, B1); PG8_BAR; PG8_SCHED;
            PG8_LDB(B0, 1, 0); PG8_LDB(B1, 1, 1); PG8_SCHED; PG8_LDA(At, 1, 0); PG8_STAGE_A(PG8_SA(0, 1), a2, 1, g2);
            PG8_WAIT_V(8); PG8_WAIT_L(0); PG8_BAR; PG8_MMA(0, 0, At, B0); PG8_MMA(0, 1, At, B1); PG8_BAR; PG8_SCHED;
            PG8_LDA(At, 1, 1); PG8_STAGE_B(PG8_SB(1, 0), b3, 0); PG8_STAGE_B(PG8_SB(1, 1), b3, 1); PG8_STAGE_A(PG8_SA(1, 0), a3, 0, g2);
            PG8_WAIT_V(8); PG8_WAIT_L(0); PG8_BAR; PG8_MMA(1, 0, At, B0); PG8_MMA(1, 1, At, B1); PG8_BAR; PG8_SCHED;
        }
        if constexpr (ALIGN_EPI) { if (wr == 0) PG8_BAR; }
        E(acc, cur, wr, wc, fr, fq);
        if (!has_next) break;
#pragma unroll
        for (int a = 0; a < 2; ++a)
#pragma unroll
            for (int b = 0; b < 2; ++b)
#pragma unroll
                for (int m = 0; m < 4; ++m)
#pragma unroll
                    for (int n = 0; n < 2; ++n) acc[a][b][m][n] = (f32x4){0.f, 0.f, 0.f, 0.f};
        cur = nxt; cA = nA; cB = nB; ++ui;
        if constexpr (GATHER) {
#pragma unroll
            for (int h_ = 0; h_ < 2; ++h_)
#pragma unroll
                for (int i_ = 0; i_ < 2; ++i_) gC[h_][i_] = gN[h_][i_]; }
        if constexpr (ALIGN_EPI) { if (wr == 1) PG8_BAR; }
    }
    PG8_WAIT_V(0);
    if constexpr (!ALIGN_EPI) { if (wr == 0) PG8_BAR; }
    PG8_BAR;
#undef PG8_SA
#undef PG8_SB
#undef PG8_STAGE
#undef PG8_STAGE_A
#undef PG8_STAGE_B
#undef PG8_LDA
#undef PG8_LDB
#undef PG8_MMA
#undef PG8_WAIT_V
#undef PG8_WAIT_L
#undef PG8_BAR
#undef PG8_SCHED
#undef PG8_GLOAD
}

typedef f32x4 Acc[2][2][4][2];

struct SchedDense {
    const char* A; const char* B; size_t a_tile_bytes, b_tile_bytes; int nM, nN, G, c;
    __device__ __forceinline__ bool next(int i, Unit& u) const {
        const long L = (long)i * G + c; if (L >= (long)nM * nN) return false;
        int pm, pn; tile_of((int)L, nM, nN, pm, pn);
        u.pm = pm; u.pn = pn; u.aux = 0; u.tab = 0; u.A = A + (size_t)pm * a_tile_bytes; u.B = B + (size_t)pn * b_tile_bytes; return true;
    }
};
struct SchedMerge {
    const char* A0; const char* A1; const char* B0; const char* B1; int nM, nN, G, c;
    __device__ __forceinline__ bool next(int i, Unit& u) const {
        const long T = (long)(i >> 1) * G + c; if (T >= (long)nM * nN) return false;
        int pm, pn; tile_of((int)T, nM, nN, pm, pn);
        const int sub = i & 1; u.pm = pm; u.pn = pn; u.aux = sub; u.tab = 0;
        u.A = (sub ? A1 : A0) + (size_t)pm * (256 * 512 * 2); u.B = (sub ? B1 : B0) + (size_t)pn * (256 * 512 * 2); return true;
    }
};
template <int NPN, bool GATHER>
struct SchedMoe {
    const char* A; const char* B; size_t b_expert_bytes; LAS const int* blk_e; int NB, G, c, tab0;
    __device__ __forceinline__ bool next(int i, Unit& u) const {
        const long L = (long)i * G + c; if (L >= (long)NB * NPN) return false;
        const int grb = (int)(L / NPN), pn = (int)(L % NPN);
        const int e = __builtin_amdgcn_readfirstlane(blk_e[grb]);
        u.pm = grb; u.pn = pn; u.aux = e; u.tab = tab0 + i * 1024;
        u.A = GATHER ? A : A + (size_t)grb * (256 * 1024 * 2);
        u.B = B + (size_t)e * b_expert_bytes + (size_t)pn * (256 * 1024 * 2); return true;
    }
};

struct EpiInProj {
    static constexpr bool PERM = true;
    bf16_t* PROJ; float* SSQ; bf16_t* KR; const float* ROPE;
    __device__ __forceinline__ void operator()(const Acc& acc, const Unit& u, int wr, int wc, int fr, int fq) const {
        const int pn = u.pn, row0 = u.pm * BM + wr * 64 + fr, colb = pn * BM + wc * 32 + 8 * fq;
        const float sc = (pn < 2) ? C2NA : 1.f;
#pragma unroll
        for (int ai = 0; ai < 2; ++ai)
#pragma unroll
            for (int m = 0; m < 4; ++m) { const int row = row0 + ai * HALF + m * 16; bf16_t* rowp = PROJ + (size_t)row * NPROJ + colb;
#pragma unroll
                for (int bj = 0; bj < 2; ++bj) { const f32x4 v0 = acc[ai][bj][m][0] * sc, v1 = acc[ai][bj][m][1] * sc; u32x4 w;
                    w.x = cvt_pk_bf16(v0[0], v0[1]); w.y = cvt_pk_bf16(v0[2], v0[3]); w.z = cvt_pk_bf16(v1[0], v1[1]); w.w = cvt_pk_bf16(v1[2], v1[3]);
                    *(u32x4*)(rowp + bj * HALF) = w; } }
        if (pn >= 6 && pn <= 8) {
#pragma unroll
            for (int ai = 0; ai < 2; ++ai)
#pragma unroll
                for (int m = 0; m < 4; ++m) { const int row = row0 + ai * HALF + m * 16; float s[2];
#pragma unroll
                    for (int bj = 0; bj < 2; ++bj) { const f32x4 a = acc[ai][bj][m][0], b = acc[ai][bj][m][1];
                        float t = (a[0] * a[0] + a[1] * a[1]) + (a[2] * a[2] + a[3] * a[3]) + (b[0] * b[0] + b[1] * b[1]) + (b[2] * b[2] + b[3] * b[3]);
                        t += __shfl_xor(t, 16); t += __shfl_xor(t, 32); s[bj] = t; }
                    if (fq == 0) {
                        float* sp = SSQ + (size_t)row * 16 + wc;
                        if (pn == 6) { sp[0] = s[0] + s[1]; }
                        else if (pn == 7) { sp[4] = s[0]; sp[8] = s[1]; }
                        else { sp[12] = s[0]; }
                    } }
            if (pn == 8 && wc == 0) {
#pragma unroll
                for (int ai = 0; ai < 2; ++ai)
#pragma unroll
                    for (int m = 0; m < 4; ++m) { const int row = row0 + ai * HALF + m * 16, tok = row & (SEQ - 1);
                        const int pos = (fq >> 1) ? (tok & 63) : (tok >> 6); float o[8];
                        const f32x4 cs4 = *(const f32x4*)(ROPE + pos * 16 + 4 * (fq & 1)), sn4 = *(const f32x4*)(ROPE + pos * 16 + 8 + 4 * (fq & 1));
#pragma unroll
                        for (int n = 0; n < 2; ++n)
#pragma unroll
                            for (int q = 0; q < 2; ++q) { const float c = cs4[2 * n + q], s = sn4[2 * n + q];
                                const float x1 = acc[ai][1][m][n][2 * q], x2 = acc[ai][1][m][n][2 * q + 1];
                                o[4 * n + 2 * q] = x1 * c - x2 * s; o[4 * n + 2 * q + 1] = x1 * s + x2 * c; }
                        u32x4 w; w.x = cvt_pk_bf16(o[0], o[1]); w.y = cvt_pk_bf16(o[2], o[3]); w.z = cvt_pk_bf16(o[4], o[5]); w.w = cvt_pk_bf16(o[6], o[7]);
                        *(u32x4*)(KR + (size_t)row * 32 + 8 * fq) = w; }
            }
        }
    }
};
struct EpiQUp {
    static constexpr bool PERM = true;
    bf16_t* QN; bf16_t* QR; const float* SSQ; const float* ROPE;
    __device__ __forceinline__ void operator()(const Acc& acc, const Unit& u, int wr, int wc, int fr, int fq) const {
        const int pn = u.pn, row0 = u.pm * BM + wr * 64 + fr, colt = wc * 32 + 8 * fq;
#pragma unroll
        for (int ai = 0; ai < 2; ++ai)
#pragma unroll
            for (int m = 0; m < 4; ++m) { const int row = row0 + ai * HALF + m * 16;
                const f32x4 q0_ = *(const f32x4*)(SSQ + (size_t)row * 16), q1_ = *(const f32x4*)(SSQ + (size_t)row * 16 + 4);
                const float rs = __builtin_amdgcn_rsqf((((q0_[0] + q0_[1]) + (q0_[2] + q0_[3])) + ((q1_[0] + q1_[1]) + (q1_[2] + q1_[3]))) * (1.f / QLORA) + RMS_EPS) * C2MLA;
                if (pn < 2) {
#pragma unroll
                    for (int bj = 0; bj < 2; ++bj) { const f32x4 v0 = acc[ai][bj][m][0] * rs, v1 = acc[ai][bj][m][1] * rs; u32x4 w;
                        w.x = cvt_pk_bf16(v0[0], v0[1]); w.y = cvt_pk_bf16(v0[2], v0[3]); w.z = cvt_pk_bf16(v1[0], v1[1]); w.w = cvt_pk_bf16(v1[2], v1[3]);
                        *(u32x4*)(QN + (size_t)row * 512 + pn * 256 + bj * HALF + colt) = w; }
                } else {
                    const int tok = row & (SEQ - 1); const int pos = (fq >> 1) ? (tok & 63) : (tok >> 6);
                    const f32x4 cs4 = *(const f32x4*)(ROPE + pos * 16 + 4 * (fq & 1)), sn4 = *(const f32x4*)(ROPE + pos * 16 + 8 + 4 * (fq & 1));
#pragma unroll
                    for (int bj = 0; bj < 2; ++bj) { float o[8];
#pragma unroll
                        for (int n = 0; n < 2; ++n)
#pragma unroll
                            for (int q = 0; q < 2; ++q) { const float c = cs4[2 * n + q], s = sn4[2 * n + q];
                                const float x1 = acc[ai][bj][m][n][2 * q] * rs, x2 = acc[ai][bj][m][n][2 * q + 1] * rs;
                                o[4 * n + 2 * q] = x1 * c - x2 * s; o[4 * n + 2 * q + 1] = x1 * s + x2 * c; }
                        u32x4 w; w.x = cvt_pk_bf16(o[0], o[1]); w.y = cvt_pk_bf16(o[2], o[3]); w.z = cvt_pk_bf16(o[4], o[5]); w.w = cvt_pk_bf16(o[6], o[7]);
                        *(u32x4*)(QR + (size_t)row * 256 + bj * HALF + colt) = w; }
                }
                asm volatile("" ::: "memory"); }
    }
};
struct EpiKVUp {
    static constexpr bool PERM = true;
    bf16_t* KN; bf16_t* VM; const float* SSQ;
    __device__ __forceinline__ void operator()(const Acc& acc, const Unit& u, int wr, int wc, int fr, int fq) const {
        const int pn = u.pn, row0 = u.pm * BM + wr * 64 + fr, colt = wc * 32 + 8 * fq;
        bf16_t* dst = (pn < 2) ? KN + pn * 256 : VM + (pn - 2) * 256;
#pragma unroll
        for (int ai = 0; ai < 2; ++ai)
#pragma unroll
            for (int m = 0; m < 4; ++m) { const int row = row0 + ai * HALF + m * 16;
                const f32x4 q0_ = *(const f32x4*)(SSQ + (size_t)row * 16 + 8), q1_ = *(const f32x4*)(SSQ + (size_t)row * 16 + 12);
                const float rs = __builtin_amdgcn_rsqf((((q0_[0] + q0_[1]) + (q0_[2] + q0_[3])) + ((q1_[0] + q1_[1]) + (q1_[2] + q1_[3]))) * (1.f / KVLORA) + RMS_EPS);
#pragma unroll
                for (int bj = 0; bj < 2; ++bj) { const f32x4 v0 = acc[ai][bj][m][0] * rs, v1 = acc[ai][bj][m][1] * rs; u32x4 w;
                    w.x = cvt_pk_bf16(v0[0], v0[1]); w.y = cvt_pk_bf16(v0[2], v0[3]); w.z = cvt_pk_bf16(v1[0], v1[1]); w.w = cvt_pk_bf16(v1[2], v1[3]);
                    *(u32x4*)(dst + (size_t)row * 512 + bj * HALF + colt) = w; } }
    }
};
struct EpiMerge {
    static constexpr bool PERM = true;
    const bf16_t* PROJ; const float* bgate; float* TMP; bf16_t* MERGED;
    __device__ __forceinline__ void operator()(const Acc& acc, const Unit& u, int wr, int wc, int fr, int fq) const {
        const int sub = u.aux, row0 = u.pm * BM + wr * 64 + fr, col0 = u.pn * BM + wc * 32 + 8 * fq;
        f32x4 bg[2][2];
#pragma unroll
        for (int bj = 0; bj < 2; ++bj)
#pragma unroll
            for (int n = 0; n < 2; ++n) bg[bj][n] = *(const f32x4*)(bgate + sub * 1024 + col0 + bj * HALF + 4 * n);
#pragma unroll
        for (int ai = 0; ai < 2; ++ai)
#pragma unroll
            for (int m = 0; m < 4; ++m) { const int row = row0 + ai * HALF + m * 16;
#pragma unroll
                for (int bj = 0; bj < 2; ++bj) { const int col = col0 + bj * HALF;
                    const u32x4 gl = *(const u32x4*)(PROJ + (size_t)row * NPROJ + 2304 + sub * 1024 + col);
                    f32x4 g0, g1;
                    g0[0] = sigmoidf_(bf16_lo(gl.x) + bg[bj][0][0]); g0[1] = sigmoidf_(bf16_hi(gl.x) + bg[bj][0][1]); g0[2] = sigmoidf_(bf16_lo(gl.y) + bg[bj][0][2]); g0[3] = sigmoidf_(bf16_hi(gl.y) + bg[bj][0][3]);
                    g1[0] = sigmoidf_(bf16_lo(gl.z) + bg[bj][1][0]); g1[1] = sigmoidf_(bf16_hi(gl.z) + bg[bj][1][1]); g1[2] = sigmoidf_(bf16_lo(gl.w) + bg[bj][1][2]); g1[3] = sigmoidf_(bf16_hi(gl.w) + bg[bj][1][3]);
                    f32x4 v0 = acc[ai][bj][m][0] * g0, v1 = acc[ai][bj][m][1] * g1;
                    float* tp = TMP + (size_t)row * 1024 + col;
                    if (sub == 0) { *(f32x4*)tp = v0; *(f32x4*)(tp + 4) = v1; }
                    else { v0 += *(const f32x4*)tp; v1 += *(const f32x4*)(tp + 4); u32x4 w;
                        w.x = cvt_pk_bf16(v0[0], v0[1]); w.y = cvt_pk_bf16(v0[2], v0[3]); w.z = cvt_pk_bf16(v1[0], v1[1]); w.w = cvt_pk_bf16(v1[2], v1[3]);
                        *(u32x4*)(MERGED + (size_t)row * 1024 + col) = w; } } }
    }
};
struct EpiF32 {
    static constexpr bool PERM = false;
    float* C; int ldc;
    __device__ __forceinline__ void operator()(const Acc& acc, const Unit& u, int wr, int wc, int fr, int fq) const {
        const int row0 = u.pm * BM + wr * 64 + fr, col0 = u.pn * BM + wc * 32 + 4 * fq;
#pragma unroll
        for (int ai = 0; ai < 2; ++ai)
#pragma unroll
            for (int m = 0; m < 4; ++m) { float* rowp = C + (size_t)(row0 + ai * HALF + m * 16) * ldc + col0;
#pragma unroll
                for (int bj = 0; bj < 2; ++bj)
#pragma unroll
                    for (int n = 0; n < 2; ++n) *(f32x4*)(rowp + bj * HALF + n * 16) = acc[ai][bj][m][n]; }
    }
};
struct EpiMoe1 {
    static constexpr bool PERM = true;
    const float* b1; bf16_t* ACT;
    __device__ __forceinline__ void operator()(const Acc& acc, const Unit& u, int wr, int wc, int fr, int fq) const {
        const int e = u.aux, row0 = u.pm * BM + wr * 64 + fr, col0 = u.pn * BM + wc * 32 + 8 * fq;
        f32x4 bv[2][2];
#pragma unroll
        for (int bj = 0; bj < 2; ++bj)
#pragma unroll
            for (int n = 0; n < 2; ++n) bv[bj][n] = *(const f32x4*)(b1 + (size_t)e * 2048 + col0 + bj * HALF + 4 * n);
#pragma unroll
        for (int ai = 0; ai < 2; ++ai)
#pragma unroll
            for (int m = 0; m < 4; ++m) { const int row = row0 + ai * HALF + m * 16;
#pragma unroll
                for (int bj = 0; bj < 2; ++bj) { float o[4];
#pragma unroll
                    for (int n = 0; n < 2; ++n) { const f32x4 v = acc[ai][bj][m][n] + bv[bj][n];
#pragma unroll
                        for (int q = 0; q < 2; ++q) { const float xg = fminf(v[2 * q], 7.f), xl = fminf(fmaxf(v[2 * q + 1], -7.f), 7.f);
                            o[2 * n + q] = xg * sigmoidf_(1.702f * xg) * (xl + 1.f); } }
                    u32x2 w; w.x = cvt_pk_bf16(o[0], o[1]); w.y = cvt_pk_bf16(o[2], o[3]);
                    *(u32x2*)(ACT + (size_t)row * 1024 + ((col0 + bj * HALF) >> 1)) = w; } }
    }
};
struct EpiMoe2 {
    static constexpr bool PERM = true;
    const float* b2; bf16_t* YIT;
    __device__ __forceinline__ void operator()(const Acc& acc, const Unit& u, int wr, int wc, int fr, int fq) const {
        const int e = u.aux, row0 = u.pm * BM + wr * 64 + fr, col0 = u.pn * BM + wc * 32 + 8 * fq;
        f32x4 bv[2][2];
#pragma unroll
        for (int bj = 0; bj < 2; ++bj)
#pragma unroll
            for (int n = 0; n < 2; ++n) bv[bj][n] = *(const f32x4*)(b2 + (size_t)e * 1024 + col0 + bj * HALF + 4 * n);
#pragma unroll
        for (int ai = 0; ai < 2; ++ai)
#pragma unroll
            for (int m = 0; m < 4; ++m) { const int row = row0 + ai * HALF + m * 16;
#pragma unroll
                for (int bj = 0; bj < 2; ++bj) { const f32x4 v0 = acc[ai][bj][m][0] + bv[bj][0], v1 = acc[ai][bj][m][1] + bv[bj][1]; u32x4 w;
                    w.x = cvt_pk_bf16(v0[0], v0[1]); w.y = cvt_pk_bf16(v0[2], v0[3]); w.z = cvt_pk_bf16(v1[0], v1[1]); w.w = cvt_pk_bf16(v1[2], v1[3]);
                    *(u32x4*)(YIT + (size_t)row * 1024 + col0 + bj * HALF) = w; } }
    }
};
}

namespace attn {
#define SBAR() __builtin_amdgcn_sched_barrier(0)
constexpr int NW = 8, QBLK = 32, KVBLK = 64;
constexpr float THR = 8.f;
__device__ __forceinline__ int crow(int r, int hi) { return (r & 3) + 8 * (r >> 2) + 4 * hi; }
constexpr int KROW_MLA = 96 * 2 + 16, KROW_NA = 64 * 2 + 16;
constexpr int SHM_K = 64 * KROW_MLA  , SHM_V = 64 * 64 * 2  ;
constexpr int OFF_V = 0, OFF_K = 2 * SHM_V, OFF_WS = OFF_K + 2 * SHM_K, OFF_OST = OFF_WS + NW * 256, OFF_BIAS = OFF_OST + NW * 4096, ATTN_LDS = OFF_BIAS + 2048;

__device__ __forceinline__ int v_st(int k, int c) { const int kk = (k & ~0xC) | ((k & 4) << 1) | ((k & 8) >> 1); return ((kk >> 3) * 2 + (c >> 5)) * 512 + ((kk & 7) * 32 + (c & 31)) * 2; }
__device__ __forceinline__ int v_rd_base(int lane) { return ((lane & 3) << 3) | (((lane >> 2) & 3) << 6) | (((lane >> 4) & 1) << 5) | (((lane >> 5) & 1) << 8); }
constexpr int v_rd_off(int d0, int ks, int half) { return d0 * 512 + ks * 2048 + half * 1024; }
template <int OFF> __device__ __forceinline__ s16x4 tr_read(int vb) {
    s16x4 r; asm volatile("ds_read_b64_tr_b16 %0, %1 offset:%2" : "=&v"(r) : "v"(vb), "i"(OFF) : "memory"); return r;
}
template <int D0> __device__ __forceinline__ void pv_one(f32x16& od, int vb, bf16x8 pa0, bf16x8 pa1, bf16x8 pa2, bf16x8 pa3) {
    const s16x4 l0 = tr_read<v_rd_off(D0, 0, 0)>(vb), h0 = tr_read<v_rd_off(D0, 0, 1)>(vb), l1 = tr_read<v_rd_off(D0, 1, 0)>(vb), h1 = tr_read<v_rd_off(D0, 1, 1)>(vb);
    const s16x4 l2 = tr_read<v_rd_off(D0, 2, 0)>(vb), h2 = tr_read<v_rd_off(D0, 2, 1)>(vb), l3 = tr_read<v_rd_off(D0, 3, 0)>(vb), h3 = tr_read<v_rd_off(D0, 3, 1)>(vb);
    asm volatile("s_waitcnt lgkmcnt(0)" ::: "memory"); SBAR();
#define PK(L, H) (bf16x8){L[0], L[1], L[2], L[3], H[0], H[1], H[2], H[3]}
    od = __builtin_amdgcn_mfma_f32_32x32x16_bf16(pa0, PK(l0, h0), od, 0, 0, 0);
    od = __builtin_amdgcn_mfma_f32_32x32x16_bf16(pa1, PK(l1, h1), od, 0, 0, 0);
    od = __builtin_amdgcn_mfma_f32_32x32x16_bf16(pa2, PK(l2, h2), od, 0, 0, 0);
    od = __builtin_amdgcn_mfma_f32_32x32x16_bf16(pa3, PK(l3, h3), od, 0, 0, 0);
#undef PK
}
__device__ __forceinline__ void pv_d0(f32x16* o, int vb, bf16x8 pa0, bf16x8 pa1, bf16x8 pa2, bf16x8 pa3) {
    pv_one<0>(o[0], vb, pa0, pa1, pa2, pa3); pv_one<1>(o[1], vb, pa0, pa1, pa2, pa3);
}
__device__ __forceinline__ void partialSM(f32x16& p0, f32x16& p1, float& m_reg, float& alpha) {
    float pmax = p0[0];
#pragma unroll
    for (int r = 1; r < 16; ++r) pmax = fmaxf(pmax, p0[r]);
#pragma unroll
    for (int r = 0; r < 16; ++r) pmax = fmaxf(pmax, p1[r]);
    { auto rr = __builtin_amdgcn_permlane32_swap(__float_as_uint(pmax), __float_as_uint(pmax), false, false);
      pmax = fmaxf(__uint_as_float(rr[0]), __uint_as_float(rr[1])); }
    float mn;
    if (__builtin_expect(__all(pmax - m_reg <= THR), 1)) { mn = m_reg; alpha = 1.f; }
    else { mn = fmaxf(m_reg, pmax); alpha = __builtin_amdgcn_exp2f(m_reg - mn); m_reg = mn; }
#pragma unroll
    for (int r = 0; r < 16; ++r) p0[r] = p0[r] - mn;
#pragma unroll
    for (int r = 0; r < 16; ++r) p1[r] = p1[r] - mn;
#pragma unroll
    for (int r = 0; r < 16; ++r) p0[r] = __builtin_amdgcn_exp2f(p0[r]);
}
__device__ __forceinline__ void finishSM(f32x16& p0, f32x16& p1, float alpha, float& l_reg, bf16x8& pa0, bf16x8& pa1, bf16x8& pa2, bf16x8& pa3) {
#pragma unroll
    for (int r = 0; r < 16; ++r) p1[r] = __builtin_amdgcn_exp2f(p1[r]);
    float ps = 0;
#pragma unroll
    for (int r = 0; r < 16; ++r) ps += p0[r];
#pragma unroll
    for (int r = 0; r < 16; ++r) ps += p1[r];
    { auto rr = __builtin_amdgcn_permlane32_swap(__float_as_uint(ps), __float_as_uint(ps), false, false);
      ps = __uint_as_float(rr[0]) + __uint_as_float(rr[1]); }
    l_reg = l_reg * alpha + ps;
#define PK4(P, BASE, OUT) do { unsigned a0 = cvt_pk_bf16(P[BASE + 0], P[BASE + 1]), a1 = cvt_pk_bf16(P[BASE + 2], P[BASE + 3]);   \
    unsigned b0 = cvt_pk_bf16(P[BASE + 4], P[BASE + 5]), b1 = cvt_pk_bf16(P[BASE + 6], P[BASE + 7]);                              \
    auto r0 = __builtin_amdgcn_permlane32_swap(a0, b0, false, false); auto r1 = __builtin_amdgcn_permlane32_swap(a1, b1, false, false); \
    u32x4 w = {r0[0], r1[0], r0[1], r1[1]}; OUT = *reinterpret_cast<bf16x8*>(&w); } while (0)
    PK4(p0, 0, pa0); PK4(p0, 8, pa1); PK4(p1, 0, pa2); PK4(p1, 8, pa3);
#undef PK4
}
template <int ND0, int KROW>
__device__ __forceinline__ void qkt(f32x16& p0, f32x16& p1, const char* Ks, const bf16x8* qr, int r32, int hi) {
    p0 = f32x16{}; p1 = f32x16{};
#pragma unroll
    for (int d0 = 0; d0 < ND0; ++d0) { const int cb = (d0 * 16 + hi * 8) * 2;
        const bf16x8 b0 = *reinterpret_cast<const bf16x8*>(Ks + r32 * KROW + cb);
        const bf16x8 b1 = *reinterpret_cast<const bf16x8*>(Ks + (32 + r32) * KROW + cb);
        p0 = __builtin_amdgcn_mfma_f32_32x32x16_bf16(b0, qr[d0], p0, 0, 0, 0);
        p1 = __builtin_amdgcn_mfma_f32_32x32x16_bf16(b1, qr[d0], p1, 0, 0, 0); }
}

template <int MODE>
__device__ __forceinline__ void attn_unit(const bf16_t* __restrict__ Qa, int ldqa, const bf16_t* __restrict__ Qb, int ldqb,
                                          const bf16_t* __restrict__ Ka, int ldka, const bf16_t* __restrict__ Kb, int ldkb, const bf16_t* __restrict__ Vv, int ldv,
                                          bf16_t* __restrict__ O, int NT, int krow0, int ntreal, int qrow0, const float* __restrict__ rpbh, char* lds) {
    constexpr int ND0 = MODE == 0 ? 6 : 4, KROW = MODE == 0 ? KROW_MLA : KROW_NA;
    const int tid = threadIdx.x, wid = __builtin_amdgcn_readfirstlane(tid >> 6), lane = tid & 63, r32 = lane & 31, hi = lane >> 5;
    char* V_lds = lds + OFF_V; char* K_lds = lds + OFF_K;
    float* ws = (float*)(lds + OFF_WS) + wid * 64; float* li_l = ws; float* al_l = ws + 32;
    float* biasL = (float*)(lds + OFF_BIAS);
    float m_reg = -1e30f, l_reg = 0; f32x16 o[2] = {}; bf16x8 qr[ND0];
    {   const bf16_t* Qw = Qa + (size_t)(wid * QBLK + r32) * ldqa + hi * 8;
#pragma unroll
        for (int d0 = 0; d0 < 4; ++d0) qr[d0] = *reinterpret_cast<const bf16x8*>(Qw + d0 * 16);
        if constexpr (MODE == 0) { const bf16_t* Qw2 = Qb + (size_t)(wid * QBLK + r32) * ldqb + hi * 8;
#pragma unroll
            for (int d0 = 0; d0 < 2; ++d0) qr[4 + d0] = *reinterpret_cast<const bf16x8*>(Qw2 + d0 * 16); } }
    int qgr = 0, rs0 = 0, qc = 0, cs = 0;
    if constexpr (MODE == 1) {
        qgr = qrow0 + (wid >> 1); rs0 = min(max(qgr - 4, 0), 120); qc = 32 * (wid & 1) + r32; cs = min(max(qc - 8, 0), 48);
        for (int i = tid; i < 15 * 31; i += 512) biasL[i] = rpbh[i] * LOG2E;
    }
    const int sr = tid >> 3, sc = (tid & 7) * 8;
    const int sr2 = (tid & 255) >> 2, sc2 = (tid & 3) * 8;
    const int vst = v_st(sr, sc);
    const int vb0 = (int)(uintptr_t)V_lds + v_rd_base(lane);
    struct { bf16x8 v, k, k2; } sr_[2];
#define KROWOF(t) (MODE == 1 ? min(krow0 + (t), 127) * 64 : (t) * 64)
#define SLOAD(i, t) do { const long k0_ = KROWOF(t); sr_[i].v = *reinterpret_cast<const bf16x8*>(&Vv[(k0_ + sr) * ldv + sc]); sr_[i].k = *reinterpret_cast<const bf16x8*>(&Ka[(k0_ + sr) * ldka + sc]); \
        if constexpr (MODE == 0) sr_[i].k2 = *reinterpret_cast<const bf16x8*>(&Kb[(k0_ + sr2) * ldkb + sc2]); } while (0)
#define SWRITE(b, i) do { *(bf16x8*)(V_lds + (b) * SHM_V + vst) = sr_[i].v; *(bf16x8*)(K_lds + (b) * SHM_K + sr * KROW + sc * 2) = sr_[i].k; \
        if constexpr (MODE == 0) { if (tid < 256) *(bf16x8*)(K_lds + (b) * SHM_K + sr2 * KROW + 128 + sc2 * 2) = sr_[i].k2; } } while (0)
#define SWAIT() do { if constexpr (MODE == 0) asm volatile("s_waitcnt vmcnt(3)" ::: "memory"); else asm volatile("s_waitcnt vmcnt(2)" ::: "memory"); } while (0)
#define RESC(a) do { if (__any((a) < 1.f)) { if (hi == 0) al_l[r32] = (a); asm volatile("s_waitcnt lgkmcnt(0)" ::: "memory"); \
        _Pragma("unroll") for (int d = 0; d < 2; ++d) _Pragma("unroll") for (int r = 0; r < 16; ++r) o[d][r] *= al_l[crow(r, hi)]; } } while (0)
#define TVALID(t) (MODE == 0 ? true : ((t) < ntreal && (krow0 + (t)) >= rs0 && (krow0 + (t)) < rs0 + 8))
#define MASKB(P0, P1, t) do { if constexpr (MODE == 1) { const int dr_ = krow0 + (t) - qgr + 7; int d_ = 4 * hi - cs; asm volatile("" : "+v"(d_)); \
        const LAS float* bl_ = (const LAS float*)((LAS char*)lds + OFF_BIAS) + (dr_ * 31 + 15 - qc + 4 * hi); \
        _Pragma("unroll") for (int r = 0; r < 16; ++r) { const int c0_ = (r & 3) + 8 * (r >> 2); \
            const bool in0 = (unsigned)(c0_ + d_) < 16u, in1 = (unsigned)(c0_ + 32 + d_) < 16u; \
            const float b0_ = bl_[c0_], b1_ = bl_[c0_ + 32]; \
            P0[r] = in0 ? P0[r] + b0_ : -1e30f; P1[r] = in1 ? P1[r] + b1_ : -1e30f; } } } while (0)
    f32x16 pA0, pA1, pB0, pB1; float alA = 1.f, alB = 1.f; bf16x8 pa0, pa1, pa2, pa3;
    bool vA, vB;
    constexpr int SE = 0, SO = 1;
    SLOAD(SE, 0); asm volatile("s_waitcnt vmcnt(0)" ::: "memory"); SWRITE(0, SE); __syncthreads();
    vA = TVALID(0);
    if (vA) { qkt<ND0, KROW>(pA0, pA1, K_lds, qr, r32, hi); MASKB(pA0, pA1, 0); partialSM(pA0, pA1, m_reg, alA); }
    SLOAD(SO, 1); if (2 < NT) SLOAD(SE, 2);
    SWAIT(); SWRITE(1, SO); __syncthreads();
    for (int j = 1; j + 1 < NT; j += 2) {
        vB = TVALID(j);
        SBAR(); if (vB) { qkt<ND0, KROW>(pB0, pB1, K_lds + SHM_K, qr, r32, hi); MASKB(pB0, pB1, j); }
        if (vA) finishSM(pA0, pA1, alA, l_reg, pa0, pa1, pa2, pa3); SBAR();
        SLOAD(SO, min(j + 2, NT - 1)); SBAR();
        if (vA) pv_d0(o, vb0, pa0, pa1, pa2, pa3);
        if (vB) partialSM(pB0, pB1, m_reg, alB);
        __syncthreads(); SWAIT(); SWRITE(0, SE);
        if (vB) RESC(alB); __syncthreads();
        vA = TVALID(j + 1);
        SBAR(); if (vA) { qkt<ND0, KROW>(pA0, pA1, K_lds, qr, r32, hi); MASKB(pA0, pA1, j + 1); }
        if (vB) finishSM(pB0, pB1, alB, l_reg, pa0, pa1, pa2, pa3); SBAR();
        SLOAD(SE, min(j + 3, NT - 1)); SBAR();
        if (vB) pv_d0(o, vb0 + SHM_V, pa0, pa1, pa2, pa3);
        if (vA) partialSM(pA0, pA1, m_reg, alA);
        __syncthreads(); SWAIT(); SWRITE(1, SO);
        if (vA) RESC(alA); __syncthreads();
    }
    vB = TVALID(NT - 1);
    SBAR(); if (vB) { qkt<ND0, KROW>(pB0, pB1, K_lds + SHM_K, qr, r32, hi); MASKB(pB0, pB1, NT - 1); }
    if (vA) finishSM(pA0, pA1, alA, l_reg, pa0, pa1, pa2, pa3); SBAR();
    if (vA) pv_d0(o, vb0, pa0, pa1, pa2, pa3);
    if (vB) { partialSM(pB0, pB1, m_reg, alB); RESC(alB);
        finishSM(pB0, pB1, alB, l_reg, pa0, pa1, pa2, pa3); SBAR();
        pv_d0(o, vb0 + SHM_V, pa0, pa1, pa2, pa3); }
    asm volatile("s_waitcnt vmcnt(0)" ::: "memory");
    if (hi == 0) li_l[r32] = l_reg; asm volatile("s_waitcnt lgkmcnt(0)" ::: "memory");
    float rli[16];
#pragma unroll
    for (int r = 0; r < 16; ++r) rli[r] = __builtin_amdgcn_rcpf(li_l[crow(r, hi)]);
    {   bf16_t* stg = (bf16_t*)(lds + OFF_OST) + wid * 2048;
#pragma unroll
        for (int r = 0; r < 16; ++r) { const int orow = crow(r, hi);
#pragma unroll
            for (int d0 = 0; d0 < 2; ++d0) stg[orow * 64 + d0 * 32 + r32] = (bf16_t)(cvt_pk_bf16(o[d0][r] * rli[r], 0.f) & 0xffffu); }
        asm volatile("s_waitcnt lgkmcnt(0)" ::: "memory");
        bf16_t* Ow = O + (size_t)(wid * QBLK) * 512;
#pragma unroll
        for (int i = 0; i < 4; ++i) { const int row = i * 8 + (lane >> 3), ch = lane & 7; const u32x4 v = *(const u32x4*)(stg + row * 64 + ch * 8); *(u32x4*)(Ow + (size_t)row * 512 + ch * 8) = v; } }
    __syncthreads();
#undef KROWOF
#undef SLOAD
#undef SWRITE
#undef SWAIT
#undef RESC
#undef TVALID
#undef MASKB
}
#undef SBAR
}

constexpr size_t MiB = 1u << 20;
constexpr size_t WS_CTL = 0, CTL_ZERO_BYTES = 1 * MiB;
constexpr size_t WS_WIN = 2 * MiB;
constexpr size_t WS_WUQ = 11 * MiB;
constexpr size_t WS_WUKV = 12 * MiB;
constexpr size_t WS_WNA = 13 * MiB, WS_WMLA = 14 * MiB;
constexpr size_t WS_WOUT = 15 * MiB;
constexpr size_t WS_W1 = 18 * MiB;
constexpr size_t WS_W2 = 146 * MiB;
constexpr size_t WS_XN = 210 * MiB;
constexpr size_t WS_PROJ = 242 * MiB;
constexpr size_t WS_QN = 378 * MiB, WS_QR = 394 * MiB, WS_KN = 402 * MiB, WS_KR = 418 * MiB, WS_VM = 419 * MiB;
constexpr size_t WS_ONA = 435 * MiB, WS_OMLA = 451 * MiB;
constexpr size_t WS_MERGED = 467 * MiB;
constexpr size_t WS_TMP = 499 * MiB;
constexpr size_t WS_LIST = 563 * MiB;
constexpr size_t WS_TOKPOS = 565 * MiB, WS_TOKG = 566 * MiB;
constexpr size_t WS_ACT = 568 * MiB;
constexpr size_t WS_YIT = 712 * MiB;
constexpr size_t WS_SSQ = 856 * MiB;
constexpr size_t WS_MODP = 857 * MiB;
constexpr size_t WS_END = 858 * MiB;
constexpr int CW_BAR = 4096;
constexpr int CW_CNT = 8192;
constexpr int CW_MOD = 16384;
constexpr int CW_ROPE = 32768;
static_assert((CW_ROPE + 2048) * 4 <= (int)CTL_ZERO_BYTES, "CTL");

constexpr int RING_BYTES = 131072;
constexpr int TAB_OFF = RING_BYTES;
constexpr int TAB_BLK = TAB_OFF, TAB_GATH = TAB_OFF + 2048;
constexpr int MISC_OFF = TAB_GATH + 11 * 1024;
constexpr int LDS_BYTES = 147456;
static_assert(MISC_OFF + 256 <= LDS_BYTES, "LDS map");

#define RLX_AGENT __ATOMIC_RELAXED, __HIP_MEMORY_SCOPE_AGENT
#define LDS_WAIT() asm volatile("s_waitcnt lgkmcnt(0)" ::: "memory")

#define XB_TMO      128
#define XB_XCNT(j)  (256  + 64 * (j))
#define XB_XSUB(j)  (1280 + 64 * (j))
#define XB_XGEN(j)  (2304 + 64 * (j))
#define XB_TOP      3328
#define XB_TOPGEN   3392
#define XCD_BAR_WORDS 3456
#define XB_SPIN_CAP (1u << 22)
__device__ __forceinline__ unsigned xb_ld(unsigned* p)              { return __hip_atomic_load(p, __ATOMIC_RELAXED, __HIP_MEMORY_SCOPE_AGENT); }
__device__ __forceinline__ unsigned xb_add(unsigned* p, unsigned v) { return __hip_atomic_fetch_add(p, v, __ATOMIC_RELAXED, __HIP_MEMORY_SCOPE_AGENT); }
__device__ __forceinline__ unsigned xb_xcc_id() { return (unsigned)__builtin_amdgcn_s_getreg((3 << 11) | 20) & 0xFu; }
#define XB_SPIN(cond, bar) do { unsigned _sp = 0; while (cond) { __builtin_amdgcn_s_sleep(1); \
    if ((++_sp & 255u) == 0u) { if (xb_ld(&(bar)[XB_TMO])) break; if (_sp > XB_SPIN_CAP) { atomicAdd(&(bar)[XB_TMO], 1u); break; } } } } while (0)
struct XcdBarrier { unsigned* bar; unsigned x; volatile LAS unsigned* st; };
__device__ __forceinline__ XcdBarrier xcd_barrier_post(unsigned* bar, volatile LAS unsigned* st) {
    XcdBarrier b; b.bar = bar; b.x = xb_xcc_id(); b.st = st;
    if (threadIdx.x == 0) (void)xb_add(&bar[XB_XCNT(b.x)], 1u);
    return b;
}
__device__ __forceinline__ void xcd_barrier_complete(unsigned* bar, unsigned x, unsigned& nloc, unsigned& nx) {
    const unsigned G = gridDim.x * gridDim.y * gridDim.z;
    unsigned sum, cnt, mine, sp = 0u;
    for (;;) {
        sum = 0u; cnt = 0u; mine = 0u;
#pragma unroll
        for (unsigned j = 0; j < 16; ++j) { const unsigned c = xb_ld(&bar[XB_XCNT(j)]); sum += c; cnt += (c > 0u) ? 1u : 0u; mine = (j == x) ? c : mine; }
        if (sum == G) break;
        __builtin_amdgcn_s_sleep(1);
        if ((++sp & 255u) == 0u) { if (xb_ld(&bar[XB_TMO])) break; if (sp > XB_SPIN_CAP) { atomicAdd(&bar[XB_TMO], 1u); break; } }
    }
    nloc = mine > 0u ? mine : 1u; nx = cnt > 0u ? cnt : 1u;
}
__device__ __forceinline__ void xcd_barrier(const XcdBarrier& b) {
    asm volatile("s_waitcnt vmcnt(0)" ::: "memory");
    __syncthreads();
    if (threadIdx.x == 0) {
        unsigned* bar = b.bar;
        __builtin_amdgcn_s_waitcnt(0);
        unsigned nloc = b.st[0], nx = b.st[1];
        if (nloc == 0u) { xcd_barrier_complete(bar, b.x, nloc, nx); b.st[0] = nloc; b.st[1] = nx; }
        const unsigned old = xb_add(&bar[XB_XSUB(b.x)], 1u);
        const unsigned gen = old / nloc;
        if (old + 1u == (gen + 1u) * nloc) {
            __builtin_amdgcn_fence(__ATOMIC_RELEASE, "agent");
            asm volatile("s_waitcnt vmcnt(0)" ::: "memory");
            const unsigned og = xb_add(&bar[XB_TOP], 1u);
            const unsigned tg = og / nx;
            if (og + 1u == (tg + 1u) * nx) xb_add(&bar[XB_TOPGEN], 1u);
            else XB_SPIN(xb_ld(&bar[XB_TOPGEN]) == tg, bar);
            __builtin_amdgcn_fence(__ATOMIC_ACQUIRE, "agent");
            xb_add(&bar[XB_XGEN(b.x)], 1u);
            asm volatile("s_waitcnt vmcnt(0)" ::: "memory");
        } else {
            XB_SPIN(xb_ld(&bar[XB_XGEN(b.x)]) == gen, bar);
            __builtin_amdgcn_fence(__ATOMIC_ACQUIRE, "agent");
            asm volatile("s_waitcnt vmcnt(0)" ::: "memory");
        }
    }
    __syncthreads();
}

constexpr int NWAVES = 8;
struct Args { const float* in[24]; float* out; unsigned char* ws; int ph_lo, ph_hi; };
enum { I_X = 0, I_C, I_WADA, I_BADA, I_GAPRE, I_GAPOST, I_WIN, I_BGATE, I_RPB, I_QNG, I_KVNG, I_WUQ, I_WUKV, I_WNAUP, I_WMLAUP, I_WOUT, I_GFPRE, I_GFPOST, I_WR, I_BR, I_W1, I_B1, I_W2, I_B2 };

__device__ __forceinline__ void tr_store_tile(LAS unsigned char* scr, bf16_t* dst, int K, int n0, int k0, int lane) {
    LDS_WAIT(); asm volatile("" ::: "memory");
#pragma unroll
    for (int j = 0; j < 8; ++j) { const int idx = j * 64 + lane, n = idx >> 3, ch = idx & 7;
        const u32x4 v = *(const LAS u32x4*)(scr + n * 144 + ch * 16);
        *(GAS u32x4*)(dst + (size_t)(n0 + n) * K + k0 + ch * 8) = v; }
    LDS_WAIT(); asm volatile("" ::: "memory");
}
__device__ __forceinline__ void tr_tile_fast(const float* src, int Nsrc, int src0, const float* kscale, bf16_t* dst, int K, int n0, int k0, LAS unsigned char* scr, int lane) {
#pragma unroll
    for (int st = 0; st < 8; ++st) { const int kq = st * 4 + (lane >> 4), c4 = (lane & 15) * 4, k = 2 * kq;
        f32x4 a = *(const GAS f32x4*)(src + (size_t)(k0 + k) * Nsrc + src0 + c4);
        f32x4 b = *(const GAS f32x4*)(src + (size_t)(k0 + k + 1) * Nsrc + src0 + c4);
        if (kscale) { const float s0 = kscale[k0 + k], s1 = kscale[k0 + k + 1]; a = a * s0; b = b * s1; }
#pragma unroll
        for (int i = 0; i < 4; ++i) *(LAS unsigned*)(scr + (c4 + i) * 144 + k * 2) = cvt_pk_bf16(a[i], b[i]); }
    tr_store_tile(scr, dst, K, n0, k0, lane);
}
__device__ __forceinline__ void tr_tile_slow(const float* src, int Nsrc, int srccol  , const float* kscale, bf16_t* dst, int K, int n0, int k0, LAS unsigned char* scr, int lane) {
#pragma unroll 8
    for (int k = 0; k < 64; k += 2) {
        float a = 0.f, b = 0.f;
        if (srccol >= 0) { a = src[(size_t)(k0 + k) * Nsrc + srccol]; b = src[(size_t)(k0 + k + 1) * Nsrc + srccol];
            if (kscale) { a *= kscale[k0 + k]; b *= kscale[k0 + k + 1]; } }
        *(LAS unsigned*)(scr + lane * 144 + k * 2) = cvt_pk_bf16(a, b); }
    tr_store_tile(scr, dst, K, n0, k0, lane);
}
__device__ __forceinline__ int rope_orig(int p) { return (p & 16) + 8 * (p & 1) + ((p & 15) >> 1); }

__global__ void __launch_bounds__(NWAVES * 64, 2) fwd_kernel(Args args) {
    extern __shared__ __attribute__((aligned(16))) unsigned char lds[];
    LAS unsigned char* L = (LAS unsigned char*)lds;
    volatile LAS unsigned* MISC = (volatile LAS unsigned*)(L + MISC_OFF);
    const int tid = threadIdx.x, lane = tid & 63, wave = __builtin_amdgcn_readfirstlane(tid >> 6);
    const int G = gridDim.x, bx = blockIdx.x, vcu = (G % 8 == 0) ? (bx % 8) * (G / 8) + bx / 8 : bx;
    unsigned char* ws = args.ws;
    gu32* ctl = (gu32*)(ws + WS_CTL);
    const int lo = args.ph_lo, hi = args.ph_hi;
    for (int u = tid; u < 64; u += NWAVES * 64) MISC[u] = 0u;
    __syncthreads();
    XcdBarrier bar; bar.bar = (unsigned*)(ctl + CW_BAR); bar.x = 0; bar.st = nullptr;
    const bool use_bar = (hi - lo) > 1;
    if (use_bar) bar = xcd_barrier_post((unsigned*)(ctl + CW_BAR), MISC + 8);
#ifndef PHASE_MASK
#define PHASE_MASK 0xFFFF
#endif
#define IN(k) (((PHASE_MASK >> (k)) & 1) && lo <= (k) && (k) < hi)
#define SEAM(k) do { if (IN(k) && IN((k) + 1)) xcd_barrier(bar); } while (0)
    const int gw = vcu * NWAVES + wave, NGW = G * NWAVES;
    float* ROPE = (float*)(ctl + CW_ROPE);
    float* MODP = (float*)(ws + WS_MODP); float* MOD = (float*)(ws + WS_MODP + 512 * 1024); float* SSQ = (float*)(ws + WS_SSQ); unsigned* CNT = (unsigned*)(ctl + CW_CNT);
    bf16_t* WINT = (bf16_t*)(ws + WS_WIN); bf16_t* WUQT = (bf16_t*)(ws + WS_WUQ); bf16_t* WUKVT = (bf16_t*)(ws + WS_WUKV);
    bf16_t* WNAT = (bf16_t*)(ws + WS_WNA); bf16_t* WMLAT = (bf16_t*)(ws + WS_WMLA); bf16_t* WOUTT = (bf16_t*)(ws + WS_WOUT);
    bf16_t* W1T = (bf16_t*)(ws + WS_W1); bf16_t* W2T = (bf16_t*)(ws + WS_W2);
    bf16_t* XN = (bf16_t*)(ws + WS_XN); bf16_t* PROJ = (bf16_t*)(ws + WS_PROJ);
    bf16_t* QN = (bf16_t*)(ws + WS_QN); bf16_t* QR = (bf16_t*)(ws + WS_QR); bf16_t* KN = (bf16_t*)(ws + WS_KN); bf16_t* KR = (bf16_t*)(ws + WS_KR); bf16_t* VM = (bf16_t*)(ws + WS_VM);
    bf16_t* ONA = (bf16_t*)(ws + WS_ONA); bf16_t* OMLA = (bf16_t*)(ws + WS_OMLA); bf16_t* MERGED = (bf16_t*)(ws + WS_MERGED);
    float* TMP = (float*)(ws + WS_TMP); unsigned* LIST = (unsigned*)(ws + WS_LIST); unsigned* TOKPOS = (unsigned*)(ws + WS_TOKPOS); float* TOKG = (float*)(ws + WS_TOKG);
    bf16_t* ACT = (bf16_t*)(ws + WS_ACT); bf16_t* YIT = (bf16_t*)(ws + WS_YIT);
    const float* X = args.in[I_X]; float* OUT = args.out;

    if (IN(0)) {
        LAS unsigned char* scr = L + wave * 16384;
        {   const float* c = args.in[I_C]; const float* wada = args.in[I_WADA]; const float* bada = args.in[I_BADA];
            for (int it = gw; it < 96 * 8; it += NGW) { const int nb = it % 96, kc = it / 96, n = nb * 64 + lane;
                float a0 = 0.f, a1 = 0.f;
#pragma unroll 8
                for (int k = 0; k < 128; ++k) { const int kk = kc * 128 + k; const float w = wada[(size_t)kk * 6144 + n];
                    const float c0 = c[kk], c1 = c[1024 + kk]; a0 += (c0 * sigmoidf_(c0)) * w; a1 += (c1 * sigmoidf_(c1)) * w; }
                if (kc == 0) { a0 += bada[n]; a1 += bada[n]; }
                MODP[(kc * 2 + 0) * 6144 + n] = a0; MODP[(kc * 2 + 1) * 6144 + n] = a1; } }
        if (bx == 0) { for (int i = tid; i < 128 * 8; i += NWAVES * 64) { const int pos = i >> 3, j = i & 7; float c, sn; rope_cs((float)pos, j, c, sn); ROPE[pos * 16 + j] = c; ROPE[pos * 16 + 8 + j] = sn; } }
        {   constexpr int I_WIN_ = 16 * 68, I_UQ = 6 * 12, I_UKV = 4 * 16, I_UP = 8 * 16, I_OUT = 16 * 16, I_W1_ = NEXP * 16 * 32, I_W2_ = NEXP * 16 * 16;
            constexpr int NITEMS = I_WIN_ + I_UQ + I_UKV + 2 * I_UP + I_OUT + I_W1_ + I_W2_;
            for (int it = gw; it < NITEMS; it += NGW) {
                int r = it;
                if (r < I_W1_) { const int e = r / 512, q = r % 512, kb = q / 32, nb = q % 32;
                    tr_tile_fast(args.in[I_W1] + (size_t)e * 1024 * 2048, 2048, nb * 64, nullptr, W1T + (size_t)e * 2048 * 1024, 1024, nb * 64, kb * 64, scr, lane); continue; } r -= I_W1_;
                if (r < I_W2_) { const int e = r / 256, q = r % 256, kb = q / 16, nb = q % 16;
                    tr_tile_fast(args.in[I_W2] + (size_t)e * 1024 * 1024, 1024, nb * 64, nullptr, W2T + (size_t)e * 1024 * 1024, 1024, nb * 64, kb * 64, scr, lane); continue; } r -= I_W2_;
                if (r < I_WIN_) { const int kb = r / 68, nb = r % 68;
                    if (nb < 34) tr_tile_fast(args.in[I_WIN], 4256, nb * 64, nullptr, WINT, 1024, nb * 64, kb * 64, scr, lane);
                    else if (nb >= 36) tr_tile_fast(args.in[I_WIN], 4256, 2208 + (nb - 36) * 64, nullptr, WINT, 1024, nb * 64, kb * 64, scr, lane);
                    else { const int n = nb * 64 + lane; const int sc = (n < 2208) ? 2176 + rope_orig(n - 2176) : -1;
                        tr_tile_slow(args.in[I_WIN], 4256, sc, nullptr, WINT, 1024, nb * 64, kb * 64, scr, lane); }
                    continue; } r -= I_WIN_;
                if (r < I_UQ) { const int kb = r / 12, nb = r % 12;
                    if (nb < 8) tr_tile_fast(args.in[I_WUQ], 768, nb * 96, args.in[I_QNG], WUQT, 384, nb * 64, kb * 64, scr, lane);
                    else { const int n = nb * 64 + lane - 512, h = n >> 5, p = n & 31;
                        tr_tile_slow(args.in[I_WUQ], 768, h * 96 + 64 + rope_orig(p), args.in[I_QNG], WUQT, 384, nb * 64, kb * 64, scr, lane); }
                    continue; } r -= I_UQ;
                if (r < I_UKV) { const int kb = r / 16, nb = r % 16;
                    const int s0 = (nb < 8) ? nb * 128 : (nb - 8) * 128 + 64;
                    tr_tile_fast(args.in[I_WUKV], 1024, s0, args.in[I_KVNG], WUKVT, 256, nb * 64, kb * 64, scr, lane); continue; } r -= I_UKV;
                if (r < I_UP) { const int kb = r / 16, nb = r % 16; tr_tile_fast(args.in[I_WNAUP], 1024, nb * 64, nullptr, WNAT, 512, nb * 64, kb * 64, scr, lane); continue; } r -= I_UP;
                if (r < I_UP) { const int kb = r / 16, nb = r % 16; tr_tile_fast(args.in[I_WMLAUP], 1024, nb * 64, nullptr, WMLAT, 512, nb * 64, kb * 64, scr, lane); continue; } r -= I_UP;
                { const int kb = r / 16, nb = r % 16; tr_tile_fast(args.in[I_WOUT], 1024, nb * 64, nullptr, WOUTT, 1024, nb * 64, kb * 64, scr, lane); }
            } }
    }
    SEAM(0);
    if (IN(1)) {
        const float* g = args.in[I_GAPRE];
        LAS float* modl = (LAS float*)L;
        for (int i = tid; i < 4096; i += NWAVES * 64) { const int b = i >> 11, c = i & 2047; float sm = 0.f;
#pragma unroll
            for (int kc = 0; kc < 8; ++kc) sm += MODP[(kc * 2 + b) * 6144 + c];
            modl[i] = sm; }
        for (int idx = bx * (NWAVES * 64) + tid; idx < 2 * 6144; idx += G * NWAVES * 64) { const int b = idx / 6144, n = idx % 6144; float sm = 0.f;
#pragma unroll
            for (int kc = 0; kc < 8; ++kc) sm += MODP[(kc * 2 + b) * 6144 + n];
            MOD[idx] = sm; }
        __syncthreads();
        for (int m = gw; m < MTOK; m += NGW) { const int b = m >> 13;
            const GAS f32x4* xr = (const GAS f32x4*)(X + (size_t)m * DM) + lane; f32x4 v[4]; float s = 0.f;
#pragma unroll
            for (int j = 0; j < 4; ++j) { v[j] = xr[64 * j]; s += (v[j].x * v[j].x + v[j].y * v[j].y) + (v[j].z * v[j].z + v[j].w * v[j].w); }
            const float rstd = __builtin_amdgcn_rsqf(wave_sum(s) * (1.f / DM) + RMS_EPS);
            GAS u32x2* o8 = (GAS u32x2*)(XN + (size_t)m * DM) + lane;
#pragma unroll
            for (int j = 0; j < 4; ++j) { const int col = 4 * lane + 256 * j;
                const f32x4 gg = *(const f32x4*)(g + col), sh = *(const LAS f32x4*)(modl + b * 2048 + col), scl = *(const LAS f32x4*)(modl + b * 2048 + 1024 + col);
                const f32x4 h = v[j] * rstd * gg * (scl + 1.f) + sh; u32x2 w; w.x = cvt_pk_bf16(h[0], h[1]); w.y = cvt_pk_bf16(h[2], h[3]); o8[64 * j] = w; } }
    }
    SEAM(1);
    if (IN(2)) {
        pg8::SchedDense S{(const char*)XN, (const char*)WINT, (size_t)256 * 1024 * 2, (size_t)256 * 1024 * 2, MTOK / 256, NPROJ / 256, G, bx};
        pg8::EpiInProj E{PROJ, SSQ, KR, ROPE};
        pg8::gemm_phase<pg8::EpiInProj, pg8::SchedDense, true, false>(L, 1024, 1024, S, E);
    }
    SEAM(2);
    if (IN(3)) {
#ifndef NO_QUP
        {   pg8::SchedDense S{(const char*)(PROJ + 1536), (const char*)WUQT, (size_t)256 * NPROJ * 2, (size_t)256 * 384 * 2, MTOK / 256, 3, G, bx};
            pg8::EpiQUp E{QN, QR, SSQ, ROPE};
            pg8::gemm_phase<pg8::EpiQUp, pg8::SchedDense, true, false>(L, 384, NPROJ, S, E); }
#endif
#ifndef NO_KVUP
        {   pg8::SchedDense S{(const char*)(PROJ + 1920), (const char*)WUKVT, (size_t)256 * NPROJ * 2, (size_t)256 * 256 * 2, MTOK / 256, 4, G, G - 1 - bx};
            pg8::EpiKVUp E{KN, VM, SSQ};
            pg8::gemm_phase<pg8::EpiKVUp, pg8::SchedDense, true, false>(L, 256, NPROJ, S, E); }
#endif
    }
    SEAM(3);
    if (IN(4)) {
#ifndef NO_MLA
        for (int u = vcu; u < 512; u += G) {
            const int bh = u >> 5, qb = u & 31, b = bh >> 3, h = bh & 7; const size_t row0 = (size_t)b * SEQ + qb * 256, key0 = (size_t)b * SEQ;
            attn::attn_unit<0>(QN + row0 * 512 + h * 64, 512, QR + row0 * 256 + h * 32, 256, KN + key0 * 512 + h * 64, 512, KR + key0 * 32, 32, VM + key0 * 512 + h * 64, 512,
                               OMLA + row0 * 512 + h * 64, 128, 0, 128, 0, nullptr, (char*)lds);
        }
#endif
#ifndef NO_NA
        for (int u = vcu; u < 512; u += G) {
            const int bh = u >> 5, rb = u & 31, b = bh >> 3, h = bh & 7; const size_t row0 = (size_t)b * SEQ + rb * 256, key0 = (size_t)b * SEQ;
            const int krow0 = min(max(4 * rb - 4, 0), 120), klast = min(max(4 * rb + 3 - 4, 0), 120) + 7, ntreal = klast - krow0 + 1, NT = (ntreal + 1) & ~1;
            attn::attn_unit<1>(PROJ + row0 * NPROJ + h * 64, NPROJ, nullptr, 0, PROJ + key0 * NPROJ + 512 + h * 64, NPROJ, nullptr, 0, PROJ + key0 * NPROJ + 1024 + h * 64, NPROJ,
                               ONA + row0 * 512 + h * 64, NT, krow0, ntreal, 4 * rb, args.in[I_RPB] + h * 15 * 31, (char*)lds);
        }
#endif
    }
    SEAM(4);
    if (IN(5)) {
        pg8::SchedMerge S{(const char*)ONA, (const char*)OMLA, (const char*)WNAT, (const char*)WMLAT, MTOK / 256, 4, G, bx};
        pg8::EpiMerge E{PROJ, args.in[I_BGATE], TMP, MERGED};
        pg8::gemm_phase<pg8::EpiMerge, pg8::SchedMerge, true, false>(L, 512, 512, S, E);
    }
    SEAM(5);
    if (IN(6)) {
        pg8::SchedDense S{(const char*)MERGED, (const char*)WOUTT, (size_t)256 * 1024 * 2, (size_t)256 * 1024 * 2, MTOK / 256, 4, G, bx};
        pg8::EpiF32 E{TMP, 1024};
        pg8::gemm_phase<pg8::EpiF32, pg8::SchedDense, true, false>(L, 1024, 1024, S, E);
    }
    SEAM(6);
    if (IN(7)) {
        LAS float* h2s = (LAS float*)(L + wave * 4096);
        LAS int* sel_e = (LAS int*)(L + 32768); LAS float* sel_g = (LAS float*)(L + 32768 + 1024); LAS int* sel_r = (LAS int*)(L + 32768 + 2048);
        LAS int* lcnt = (LAS int*)(L + 32768 + 3072); LAS int* lbase = (LAS int*)(L + 32768 + 3072 + 128);
        const float* gpo = args.in[I_GAPOST]; const float* gfp = args.in[I_GFPRE]; const float* Wr = args.in[I_WR]; const float* br = args.in[I_BR];
        for (int blk = vcu; blk < MTOK / 64; blk += G) {
            if (tid < 32) lcnt[tid] = 0;
            __syncthreads();
            for (int rr = 0; rr < 8; ++rr) { const int lrow = wave * 8 + rr, m = blk * 64 + lrow, b = m >> 13;
                const GAS f32x4* yr = (const GAS f32x4*)(TMP + (size_t)m * DM) + lane; const GAS f32x4* xr = (const GAS f32x4*)(X + (size_t)m * DM) + lane;
                f32x4 y[4], x1[4]; float s = 0.f;
#pragma unroll
                for (int j = 0; j < 4; ++j) { y[j] = yr[64 * j]; x1[j] = xr[64 * j]; s += (y[j].x * y[j].x + y[j].y * y[j].y) + (y[j].z * y[j].z + y[j].w * y[j].w); }
                const float rstd = __builtin_amdgcn_rsqf(wave_sum(s) * (1.f / DM) + RMS_EPS); float s2 = 0.f;
#pragma unroll
                for (int j = 0; j < 4; ++j) { const int col = 4 * lane + 256 * j;
                    const f32x4 gg = *(const f32x4*)(gpo + col), ga = *(const f32x4*)(MOD + b * 6144 + 2048 + col);
                    x1[j] = x1[j] + ga * (y[j] * rstd * gg);
                    *((GAS f32x4*)(OUT + (size_t)m * DM) + lane + 64 * j) = x1[j];
                    s2 += (x1[j].x * x1[j].x + x1[j].y * x1[j].y) + (x1[j].z * x1[j].z + x1[j].w * x1[j].w); }
                const float rstd2 = __builtin_amdgcn_rsqf(wave_sum(s2) * (1.f / DM) + RMS_EPS);
                GAS u32x2* o8 = (GAS u32x2*)(XN + (size_t)m * DM) + lane;
#pragma unroll
                for (int j = 0; j < 4; ++j) { const int col = 4 * lane + 256 * j;
                    const f32x4 gg = *(const f32x4*)(gfp + col), sh = *(const f32x4*)(MOD + b * 6144 + 3072 + col), scl = *(const f32x4*)(MOD + b * 6144 + 4096 + col);
                    const f32x4 h = x1[j] * rstd2 * gg * (scl + 1.f) + sh; u32x2 w; w.x = cvt_pk_bf16(h[0], h[1]); w.y = cvt_pk_bf16(h[2], h[3]); o8[64 * j] = w;
                    *(LAS f32x4*)(h2s + col) = h; }
                LDS_WAIT(); asm volatile("" ::: "memory");
                const int e = lane & 31, kh = lane >> 5; float a0 = 0.f, a1 = 0.f, a2 = 0.f, a3 = 0.f;
#pragma unroll 4
                for (int k = 0; k < 512; k += 4) { const int kk = kh * 512 + k; const f32x4 hv = *(const LAS f32x4*)(h2s + kk);
                    a0 += hv[0] * Wr[(size_t)(kk + 0) * 32 + e]; a1 += hv[1] * Wr[(size_t)(kk + 1) * 32 + e]; a2 += hv[2] * Wr[(size_t)(kk + 2) * 32 + e]; a3 += hv[3] * Wr[(size_t)(kk + 3) * 32 + e]; }
                float lg = (a0 + a1) + (a2 + a3); lg += __shfl_xor(lg, 32); lg += br[e];
                float tv[4]; int ti[4]; float cur = lg;
#pragma unroll
                for (int t = 0; t < 4; ++t) { float bv = cur; int bi = e;
#pragma unroll
                    for (int o = 1; o < 32; o <<= 1) { const float ov = __shfl_xor(bv, o); const int oi = __shfl_xor(bi, o); if (ov > bv || (ov == bv && oi < bi)) { bv = ov; bi = oi; } }
                    tv[t] = bv; ti[t] = bi; if (e == bi) cur = -3.0e38f; }
                const float e1 = __builtin_amdgcn_exp2f((tv[1] - tv[0]) * LOG2E), e2 = __builtin_amdgcn_exp2f((tv[2] - tv[0]) * LOG2E), e3 = __builtin_amdgcn_exp2f((tv[3] - tv[0]) * LOG2E);
                const float inv = 1.f / (1.f + e1 + e2 + e3);
                if (lane < 4) { const int t = lane; const int ee = t == 0 ? ti[0] : t == 1 ? ti[1] : t == 2 ? ti[2] : ti[3];
                    const float gg = (t == 0 ? 1.f : t == 1 ? e1 : t == 2 ? e2 : e3) * inv;
                    const int rk = __hip_atomic_fetch_add(&lcnt[ee], 1, __ATOMIC_RELAXED, __HIP_MEMORY_SCOPE_WORKGROUP);
                    sel_e[lrow * 4 + t] = ee; sel_g[lrow * 4 + t] = gg; sel_r[lrow * 4 + t] = rk; }
                LDS_WAIT(); asm volatile("" ::: "memory");
            }
            __syncthreads();
            if (tid < 32) lbase[tid] = (int)atomicAdd(CNT + tid, (unsigned)lcnt[tid]);
            __syncthreads();
            if (tid < 256) { const int ee = sel_e[tid], pos = lbase[ee] + sel_r[tid], tok = blk * 64 + (tid >> 2);
                LIST[(size_t)ee * LISTCAP + pos] = (unsigned)tok; TOKPOS[(size_t)tok * 4 + (tid & 3)] = ((unsigned)ee << 16) | (unsigned)pos; TOKG[(size_t)tok * 4 + (tid & 3)] = sel_g[tid]; }
            __syncthreads();
        }
    }
    SEAM(7);
    if (IN(8) || IN(9)) {
        LAS int* blk_e = (LAS int*)(L + TAB_BLK);
        if (tid == 0) { int nb = 0; for (int e = 0; e < NEXP; ++e) { const int c = (int)__hip_atomic_load(CNT + e, RLX_AGENT); const int n = (c + 255) >> 8; for (int i = 0; i < n; ++i) blk_e[nb + i] = e; nb += n; } MISC[16] = (unsigned)nb; }
        __syncthreads();
        const int NB = (int)MISC[16];
        if (IN(8)) {
            for (int i = 0;; ++i) { const long Lu = (long)i * G + bx; if (Lu >= (long)NB * 8 || i >= 11) break;
                const int grb = (int)(Lu >> 3), e = blk_e[grb]; int first = grb; while (first > 0 && blk_e[first - 1] == e) --first;
                const int cnt = (int)__hip_atomic_load(CNT + e, RLX_AGENT);
                if (tid < 256) { const int ri = (grb - first) * 256 + tid; const unsigned tok = (ri < cnt) ? LIST[(size_t)e * LISTCAP + ri] : 0u;
                    *(LAS unsigned*)(L + TAB_GATH + i * 1024 + tid * 4) = tok * 2048u; } }
            __syncthreads();
            pg8::SchedMoe<8, true> S{(const char*)XN, (const char*)W1T, (size_t)2048 * 1024 * 2, blk_e, NB, G, bx, TAB_GATH};
            pg8::EpiMoe1 E{args.in[I_B1], ACT};
            pg8::gemm_phase<pg8::EpiMoe1, pg8::SchedMoe<8, true>, true, true>(L, 1024, 1024, S, E);
        }
        SEAM(8);
        if (IN(9)) {
            pg8::SchedMoe<4, false> S{(const char*)ACT, (const char*)W2T, (size_t)1024 * 1024 * 2, blk_e, NB, G, bx, 0};
            pg8::EpiMoe2 E{args.in[I_B2], YIT};
            pg8::gemm_phase<pg8::EpiMoe2, pg8::SchedMoe<4, false>, true, false>(L, 1024, 1024, S, E);
        }
    }
    SEAM(9);
    if (IN(10)) {
        LAS int* rbase = (LAS int*)(L + 0);
        if (tid == 0) { int nb = 0; for (int e = 0; e < NEXP; ++e) { rbase[e] = nb * 256; nb += ((int)__hip_atomic_load(CNT + e, RLX_AGENT) + 255) >> 8; } }
        __syncthreads();
        const float* gfo = args.in[I_GFPOST];
        for (int m = gw; m < MTOK; m += NGW) { const int b = m >> 13;
            f32x4 y[4];
#pragma unroll
            for (int j = 0; j < 4; ++j) y[j] = (f32x4){0.f, 0.f, 0.f, 0.f};
#pragma unroll
            for (int t = 0; t < 4; ++t) { const unsigned tp = TOKPOS[(size_t)m * 4 + t]; const float gt = TOKG[(size_t)m * 4 + t];
                const size_t row = (size_t)rbase[tp >> 16] + (tp & 0xffffu); const GAS u32x2* yr = (const GAS u32x2*)(YIT + row * 1024) + lane;
#pragma unroll
                for (int j = 0; j < 4; ++j) { const u32x2 w = yr[64 * j]; y[j][0] += gt * bf16_lo(w.x); y[j][1] += gt * bf16_hi(w.x); y[j][2] += gt * bf16_lo(w.y); y[j][3] += gt * bf16_hi(w.y); } }
            float s = 0.f;
#pragma unroll
            for (int j = 0; j < 4; ++j) s += (y[j].x * y[j].x + y[j].y * y[j].y) + (y[j].z * y[j].z + y[j].w * y[j].w);
            const float rstd = __builtin_amdgcn_rsqf(wave_sum(s) * (1.f / DM) + RMS_EPS);
            GAS f32x4* orow = (GAS f32x4*)(OUT + (size_t)m * DM) + lane;
#pragma unroll
            for (int j = 0; j < 4; ++j) { const int col = 4 * lane + 256 * j;
                const f32x4 gg = *(const f32x4*)(gfo + col), gf = *(const f32x4*)(MOD + b * 6144 + 5120 + col);
                orow[64 * j] = orow[64 * j] + gf * (y[j] * rstd * gg); } }
    }
#undef IN
#undef SEAM
}

constexpr int N_PHASES = 11;
extern "C" void kernel_launch(void* const* d_in, const int* in_sizes, int n_in, void* d_out, int out_size, void* d_ws, size_t ws_size, hipStream_t stream) {
    static int grid = 0;
    if (grid == 0) {
        if (n_in != 24 || out_size != MTOK * DM || ws_size < WS_END) { fprintf(stderr, "kernel_launch: unexpected shapes (n_in %d out %d ws %zu)\n", n_in, out_size, ws_size); grid = -1; return; }
        int dev = 0, cus = 0, per_cu = 0;
        if (hipGetDevice(&dev) != hipSuccess || hipDeviceGetAttribute(&cus, hipDeviceAttributeMultiprocessorCount, dev) != hipSuccess) { grid = -1; return; }
        if (hipFuncSetAttribute((const void*)fwd_kernel, hipFuncAttributeMaxDynamicSharedMemorySize, LDS_BYTES) != hipSuccess) { fprintf(stderr, "kernel_launch: hipFuncSetAttribute failed\n"); grid = -1; return; }
        if (hipOccupancyMaxActiveBlocksPerMultiprocessor(&per_cu, (const void*)fwd_kernel, NWAVES * 64, LDS_BYTES) != hipSuccess || per_cu < 1) { fprintf(stderr, "kernel_launch: occupancy query says %d\n", per_cu); per_cu = 1; }
        (void)hipGetLastError();
        grid = cus;
    }
    if (grid < 0) return;
    (void)hipMemsetAsync((char*)d_ws + WS_CTL, 0, CTL_ZERO_BYTES, stream);
    Args a{};
    for (int i = 0; i < 24; ++i) a.in[i] = (const float*)d_in[i];
    a.out = (float*)d_out; a.ws = (unsigned char*)d_ws;
#if MK_N_LAUNCHES == 1
    a.ph_lo = 0; a.ph_hi = N_PHASES;
    {   void* kargs[] = {(void*)&a};
        const hipError_t ce = hipLaunchCooperativeKernel((const void*)fwd_kernel, dim3(grid), dim3(NWAVES * 64), kargs, LDS_BYTES, stream);
        if (ce != hipSuccess) fprintf(stderr, "kernel_launch: cooperative launch failed: %s (grid %d)\n", hipGetErrorName(ce), grid); }
#else
    for (int p = 0; p < N_PHASES; ++p) { a.ph_lo = p; a.ph_hi = p + 1; hipLaunchKernelGGL(fwd_kernel, dim3(grid), dim3(NWAVES * 64), LDS_BYTES, stream, a); }
#endif
    const hipError_t le = hipPeekAtLastError();
    if (le != hipSuccess) fprintf(stderr, "kernel_launch: launch failed: %s\n", hipGetErrorName(le));
}
```

```cpp
#include <hip/hip_runtime.h>
#include <hip/hip_bf16.h>
#include <cstdio>
#include <cstdint>

#ifndef MK_N_LAUNCHES
#define MK_N_LAUNCHES 1
#endif

constexpr int BATCH = 2, SEQ = 8192, DM = 1024, MTOK = BATCH * SEQ;
constexpr int NPROJ = 4352;
constexpr int NEXP = 32, DFF = 1024, TOPK = 4;
constexpr int QLORA = 384, KVLORA = 256;
constexpr float RMS_EPS = 1e-6f;
constexpr float LOG2E = 1.4426950408889634f;
constexpr float C2NA = 0.125f * LOG2E;
constexpr float C2MLA = 0.10206207261596575f * LOG2E;
constexpr int LISTCAP = 16384;
constexpr int MAXROWS = 65536 + NEXP * 256;

#define GAS __attribute__((address_space(1)))
#define LAS __attribute__((address_space(3)))
typedef unsigned short bf16_t;
typedef short bf16x8 __attribute__((ext_vector_type(8)));
typedef short s16x4 __attribute__((ext_vector_type(4)));
typedef float f32x4 __attribute__((ext_vector_type(4)));
typedef float f32x2 __attribute__((ext_vector_type(2)));
typedef float f32x16 __attribute__((ext_vector_type(16)));
typedef unsigned u32x4 __attribute__((ext_vector_type(4)));
typedef unsigned u32x2 __attribute__((ext_vector_type(2)));
typedef GAS unsigned gu32;

__device__ __forceinline__ unsigned cvt_pk_bf16(float lo, float hi) { unsigned r; asm volatile("v_cvt_pk_bf16_f32 %0, %1, %2" : "=v"(r) : "v"(lo), "v"(hi)); return r; }
__device__ __forceinline__ float bf16_lo(unsigned w) { return __uint_as_float(w << 16); }
__device__ __forceinline__ float bf16_hi(unsigned w) { return __uint_as_float(w & 0xffff0000u); }
__device__ __forceinline__ float sigmoidf_(float z) { return __builtin_amdgcn_rcpf(1.f + __builtin_amdgcn_exp2f(-z * LOG2E)); }
__device__ __forceinline__ float wave_sum(float v) {
#pragma unroll
    for (int o = 1; o < 64; o <<= 1) v += __shfl_xor(v, o);
    return v;
}
__device__ __forceinline__ void rope_cs(float pos, int j, float& c, float& s) {
    const float inv = __builtin_amdgcn_exp2f(-(float)j * 0.83048202372184059f);
    const float rev = __builtin_amdgcn_fractf(pos * inv * 0.15915494309189535f);
    c = __builtin_amdgcn_cosf(rev); s = __builtin_amdgcn_sinf(rev);
}

namespace pg8 {
constexpr int BM = 256, BK = 64, HALF = 128, HTB = HALF * BK * 2, STAGE_BYTES = 8 * HTB, NXCD = 8, WGM = 8;
__host__ __device__ __forceinline__ int lds_byte(int r, int c) { const int st = (r >> 4) * 2 + (c >> 5), rr = r & 15, cc = c & 31, ob = rr * 64 + cc * 2; return st * 1024 + (ob ^ (((ob >> 9) & 1) << 5)); }
__host__ __device__ __forceinline__ void stage_rc(int b, int& R, int& C) { const int st = b / 1024, sb = b % 1024, swz = sb ^ (((sb >> 9) & 1) << 5); R = (st >> 1) * 16 + swz / 64; C = (st & 1) * 32 + (swz % 64) / 2; }
__host__ __device__ __forceinline__ int perm32(int rho) { const int n = rho >> 4, i = rho & 15; return 8 * (i >> 2) + 4 * n + (i & 3); }

struct Unit { const char* A; const char* B; int pm, pn, aux, tab; };

__device__ __forceinline__ void tile_of(int wgid, int nM, int nN, int& pm, int& pn) {
    const int nwg = nM * nN;
    { const int q = nwg / NXCD, r = nwg % NXCD, xcd = wgid % NXCD, off = wgid / NXCD; wgid = (xcd < r ? xcd * (q + 1) : r * (q + 1) + (xcd - r) * q) + off; }
    const int nig = WGM * nN, gid = wgid / nig, fm = gid * WGM, gsz = (nM - fm) < WGM ? (nM - fm) : WGM;
    pm = fm + ((wgid % nig) % gsz); pn = (wgid % nig) / gsz;
}

template <class Epi, class Sched, bool ALIGN_EPI, bool GATHER>
__device__ __forceinline__ void gemm_phase(LAS unsigned char* lds, const int K, const int lda, const Sched& S, const Epi& E) {
    const int tid = threadIdx.x, wid = __builtin_amdgcn_readfirstlane(tid >> 6), lane = tid & 63, wr = wid >> 2, wc = wid & 3, fr = lane & 15, fq = lane >> 4;
    const int nt = K / BK;
    int Rr[2], Cc[2];
    unsigned voffA[2], voffB[2];
#pragma unroll
    for (int i = 0; i < 2; ++i) { int R, C; stage_rc(tid * 16 + i * 8192, R, C); const int Rb = Epi::PERM ? ((R & ~31) + perm32(R & 31)) : R;
        Rr[i] = R; Cc[i] = C; voffA[i] = (unsigned)(R * lda + C) * 2u; voffB[i] = (unsigned)(Rb * K + C) * 2u; }
    const size_t kstep = (size_t)(BK * 2);
    const size_t hstepA = (size_t)HALF * lda * 2, hstepB = (size_t)HALF * K * 2;
    const unsigned ldsw = (unsigned)wid * 1024u;
    const int aoff = lds_byte(wr * 64 + fr, fq * 8), boff = lds_byte(wc * 32 + fr, fq * 8);
#define PG8_SA(b, h) (((b) * 2 + (h)) * HTB)
#define PG8_SB(b, h) ((4 + (b) * 2 + (h)) * HTB)
#define PG8_STAGE(bufoff, gbase, voff) do { _Pragma("unroll") for (int _i = 0; _i < 2; ++_i) \
        __builtin_amdgcn_global_load_lds((const unsigned*)((const char*)(gbase) + (voff)[_i]), (LAS unsigned*)(lds + (bufoff) + ldsw + _i * 8192), 16, 0, 0); } while (0)
#define PG8_STAGE_A(bufoff, gbase, h, G) do { if constexpr (GATHER) { PG8_STAGE(bufoff, gbase, (G)[h]); } else { PG8_STAGE(bufoff, (gbase) + (h) * hstepA, voffA); } } while (0)
#define PG8_STAGE_B(bufoff, gbase, h) PG8_STAGE(bufoff, (gbase) + (h) * hstepB, voffB)
#define PG8_LDA(dst, b, h) do { _Pragma("unroll") for (int m = 0; m < 4; ++m) _Pragma("unroll") for (int k = 0; k < 2; ++k) dst[m][k] = *(const LAS bf16x8*)(lds + PG8_SA(b, h) + aoff + m * 2048 + k * 1024); } while (0)
#define PG8_LDB(dst, b, h) do { _Pragma("unroll") for (int n = 0; n < 2; ++n) _Pragma("unroll") for (int k = 0; k < 2; ++k) dst[n][k] = *(const LAS bf16x8*)(lds + PG8_SB(b, h) + boff + n * 2048 + k * 1024); } while (0)
#define PG8_MMA(ai, bj, At, Bt) do { __builtin_amdgcn_s_setprio(1); _Pragma("unroll") for (int m = 0; m < 4; ++m) _Pragma("unroll") for (int n = 0; n < 2; ++n) _Pragma("unroll") for (int k = 0; k < 2; ++k) \
        acc[ai][bj][m][n] = __builtin_amdgcn_mfma_f32_16x16x32_bf16(Bt[n][k], At[m][k], acc[ai][bj][m][n], 0, 0, 0); __builtin_amdgcn_s_setprio(0); } while (0)
#define PG8_WAIT_V(n) asm volatile("s_waitcnt vmcnt(" #n ")" ::: "memory")
#define PG8_WAIT_L(n) asm volatile("s_waitcnt lgkmcnt(" #n ")" ::: "memory")
#define PG8_BAR __builtin_amdgcn_s_barrier()
#define PG8_SCHED __builtin_amdgcn_sched_barrier(0)
    Unit cur, nxt; int ui = 0;
    if (!S.next(0, cur)) return;
    f32x4 acc[2][2][4][2];
#pragma unroll
    for (int a = 0; a < 2; ++a)
#pragma unroll
        for (int b = 0; b < 2; ++b)
#pragma unroll
            for (int m = 0; m < 4; ++m)
#pragma unroll
                for (int n = 0; n < 2; ++n) acc[a][b][m][n] = (f32x4){0.f, 0.f, 0.f, 0.f};
    bf16x8 At[4][2], B0[2][2], B1[2][2];
    unsigned gC[2][2], gN[2][2];
#define PG8_GLOAD(G, u) do { if constexpr (GATHER) { const LAS unsigned* tb_ = (const LAS unsigned*)(lds + (u).tab); _Pragma("unroll") for (int h_ = 0; h_ < 2; ++h_) _Pragma("unroll") for (int i_ = 0; i_ < 2; ++i_) \
        (G)[h_][i_] = tb_[h_ * 128 + Rr[i_]] + (unsigned)(Cc[i_] * 2); } } while (0)
    PG8_GLOAD(gC, cur);
    const char* cA = cur.A; const char* cB = cur.B;
    PG8_STAGE_B(PG8_SB(0, 0), cB, 0); PG8_STAGE_B(PG8_SB(0, 1), cB, 1); PG8_STAGE_A(PG8_SA(0, 0), cA, 0, gC); PG8_STAGE_A(PG8_SA(0, 1), cA, 1, gC);
    if (wr == 1) PG8_BAR;
    PG8_WAIT_V(2); PG8_BAR;
    PG8_STAGE_B(PG8_SB(1, 0), cB + kstep, 0); PG8_STAGE_A(PG8_SA(1, 0), cA + kstep, 0, gC); PG8_STAGE_B(PG8_SB(1, 1), cB + kstep, 1);
    PG8_WAIT_V(6); PG8_BAR;
    for (;;) {
        const bool has_next = S.next(ui + 1, nxt);
        const char* nA = has_next ? nxt.A : cA; const char* nB = has_next ? nxt.B : cB;
        if constexpr (GATHER) { if (has_next) { PG8_GLOAD(gN, nxt); } else {
#pragma unroll
            for (int h_ = 0; h_ < 2; ++h_)
#pragma unroll
                for (int i_ = 0; i_ < 2; ++i_) gN[h_][i_] = gC[h_][i_]; } }
#pragma unroll 1
        for (int t = 0; t < nt; t += 2) {
            const bool last = (t == nt - 2);
            const char* a1 = cA + (size_t)(t + 1) * kstep;
            const char* a2 = last ? nA : cA + (size_t)(t + 2) * kstep; const char* b2 = last ? nB : cB + (size_t)(t + 2) * kstep;
            const char* a3 = a2 + kstep; const char* b3 = b2 + kstep;
            unsigned g2[2][2];
            if constexpr (GATHER) {
#pragma unroll
                for (int h_ = 0; h_ < 2; ++h_)
#pragma unroll
                    for (int i_ = 0; i_ < 2; ++i_) g2[h_][i_] = last ? gN[h_][i_] : gC[h_][i_]; }
            PG8_LDB(B0, 0, 0); PG8_LDB(B1, 0, 1); PG8_SCHED; PG8_LDA(At, 0, 0); PG8_STAGE_A(PG8_SA(1, 1), a1, 1, gC);
            PG8_WAIT_V(8); PG8_WAIT_L(0); PG8_BAR; PG8_MMA(0, 0, At, B0); PG8_MMA(0, 1, At, B1); PG8_BAR; PG8_SCHED;
            PG8_LDA(At, 0, 1); PG8_STAGE_B(PG8_SB(0, 0), b2, 0); PG8_STAGE_B(PG8_SB(0, 1), b2, 1); PG8_STAGE_A(PG8_SA(0, 0), a2, 0, g2);
            PG8_WAIT_V(8); PG8_WAIT_L(0); PG8_BAR; PG8_MMA(1, 0, At, B0); PG8_MMA(1, 1, At, B1); PG8_BAR; PG8_SCHED;
            PG8_LDB(B0, 1, 0); PG8_LDB(B1, 1, 1); PG8_SCHED; PG8_LDA(At, 1, 0); PG8_STAGE_A(PG8_SA(0, 1), a2, 1, g2);
            PG8_WAIT_V(8); PG8_WAIT_L(0); PG8_BAR; PG8_MMA(0, 0, At, B0); PG8_MMA(0, 1, At, B1); PG8_BAR; PG8_SCHED;
            PG8_LDA(At, 1, 1); PG8_STAGE_B(PG8_SB(1, 0), b3, 0); PG8_STAGE_B(PG8_SB(1, 1), b3, 1); PG8_STAGE_A(PG8_SA(1, 0), a3, 0, g2);
            PG8_WAIT_V(8); PG8_WAIT_L(0); PG8_BAR; PG8_MMA(1, 0, At, B0); PG8_MMA(1, 1, At, B1); PG8_BAR; PG8_SCHED;
        }
        if constexpr (ALIGN_EPI) { if (wr == 0) PG8_BAR; }
        E(acc, cur, wr, wc, fr, fq);
        if (!has_next) break;
#pragma unroll
        for (int a = 0; a < 2; ++a)
#pragma unroll
            for (int b = 0; b < 2; ++b)
#pragma unroll
                for (int m = 0; m < 4; ++m)
#pragma unroll
                    for (int n = 0; n < 2; ++n) acc[a][b][m][n] = (f32x4){0.f, 0.f, 0.f, 0.f};
        cur = nxt; cA = nA; cB = nB; ++ui;
        if constexpr (GATHER) {
#pragma unroll
            for (int h_ = 0; h_ < 2; ++h_)
#pragma unroll
                for (int i_ = 0; i_ < 2; ++i_) gC[h_][i_] = gN[h_][i_]; }
        if constexpr (ALIGN_EPI) { if (wr == 1) PG8_BAR; }
    }
    PG8_WAIT_V(0);
    if constexpr (!ALIGN_EPI) { if (wr == 0) PG8_BAR; }
    PG8_BAR;
#undef PG8_SA
#undef PG8_SB
#undef PG8_STAGE
#undef PG8_STAGE_A
#undef PG8_STAGE_B
#undef PG8_LDA
#undef PG8_LDB
#undef PG8_MMA
#undef PG8_WAIT_V
#undef PG8_WAIT_L
#undef PG8_BAR
#undef PG8_SCHED
#undef PG8_GLOAD
}

typedef f32x4 Acc[2][2][4][2];

struct SchedDense {
    const char* A; const char* B; size_t a_tile_bytes, b_tile_bytes; int nM, nN, G, c;
    __device__ __forceinline__ bool next(int i, Unit& u) const {
        const long L = (long)i * G + c; if (L >= (long)nM * nN) return false;
        int pm, pn; tile_of((int)L, nM, nN, pm, pn);
        u.pm = pm; u.pn = pn; u.aux = 0; u.tab = 0; u.A = A + (size_t)pm * a_tile_bytes; u.B = B + (size_t)pn * b_tile_bytes; return true;
    }
};
struct SchedMerge {
    const char* A0; const char* A1; const char* B0; const char* B1; int nM, nN, G, c;
    __device__ __forceinline__ bool next(int i, Unit& u) const {
        const long T = (long)(i >> 1) * G + c; if (T >= (long)nM * nN) return false;
        int pm, pn; tile_of((int)T, nM, nN, pm, pn);
        const int sub = i & 1; u.pm = pm; u.pn = pn; u.aux = sub; u.tab = 0;
        u.A = (sub ? A1 : A0) + (size_t)pm * (256 * 512 * 2); u.B = (sub ? B1 : B0) + (size_t)pn * (256 * 512 * 2); return true;
    }
};
template <int NPN, bool GATHER>
struct SchedMoe {
    const char* A; const char* B; size_t b_expert_bytes; LAS const int* blk_e; int NB, G, c, tab0;
    __device__ __forceinline__ bool next(int i, Unit& u) const {
        const long L = (long)i * G + c; if (L >= (long)NB * NPN) return false;
        const int grb = (int)(L / NPN), pn = (int)(L % NPN);
        const int e = __builtin_amdgcn_readfirstlane(blk_e[grb]);
        u.pm = grb; u.pn = pn; u.aux = e; u.tab = tab0 + i * 1024;
        u.A = GATHER ? A : A + (size_t)grb * (256 * 1024 * 2);
        u.B = B + (size_t)e * b_expert_bytes + (size_t)pn * (256 * 1024 * 2); return true;
    }
};

struct EpiInProj {
    static constexpr bool PERM = true;
    bf16_t* PROJ; float* SSQ; bf16_t* KR; const float* ROPE;
    __device__ __forceinline__ void operator()(const Acc& acc, const Unit& u, int wr, int wc, int fr, int fq) const {
        const int pn = u.pn, row0 = u.pm * BM + wr * 64 + fr, colb = pn * BM + wc * 32 + 8 * fq;
        const float sc = (pn < 2) ? C2NA : 1.f;
#pragma unroll
        for (int ai = 0; ai < 2; ++ai)
#pragma unroll
            for (int m = 0; m < 4; ++m) { const int row = row0 + ai * HALF + m * 16; bf16_t* rowp = PROJ + (size_t)row * NPROJ + colb;
#pragma unroll
                for (int bj = 0; bj < 2; ++bj) { const f32x4 v0 = acc[ai][bj][m][0] * sc, v1 = acc[ai][bj][m][1] * sc; u32x4 w;
                    w.x = cvt_pk_bf16(v0[0], v0[1]); w.y = cvt_pk_bf16(v0[2], v0[3]); w.z = cvt_pk_bf16(v1[0], v1[1]); w.w = cvt_pk_bf16(v1[2], v1[3]);
                    *(u32x4*)(rowp + bj * HALF) = w; } }
        if (pn >= 6 && pn <= 8) {
#pragma unroll
            for (int ai = 0; ai < 2; ++ai)
#pragma unroll
                for (int m = 0; m < 4; ++m) { const int row = row0 + ai * HALF + m * 16; float s[2];
#pragma unroll
                    for (int bj = 0; bj < 2; ++bj) { const f32x4 a = acc[ai][bj][m][0], b = acc[ai][bj][m][1];
                        float t = (a[0] * a[0] + a[1] * a[1]) + (a[2] * a[2] + a[3] * a[3]) + (b[0] * b[0] + b[1] * b[1]) + (b[2] * b[2] + b[3] * b[3]);
                        t += __shfl_xor(t, 16); t += __shfl_xor(t, 32); s[bj] = t; }
                    if (fq == 0) {
                        float* sp = SSQ + (size_t)row * 16 + wc;
                        if (pn == 6) { sp[0] = s[0] + s[1]; }
                        else if (pn == 7) { sp[4] = s[0]; sp[8] = s[1]; }
                        else { sp[12] = s[0]; }
                    } }
            if (pn == 8 && wc == 0) {
#pragma unroll
                for (int ai = 0; ai < 2; ++ai)
#pragma unroll
                    for (int m = 0; m < 4; ++m) { const int row = row0 + ai * HALF + m * 16, tok = row & (SEQ - 1);
                        const int pos = (fq >> 1) ? (tok & 63) : (tok >> 6); float o[8];
                        const f32x4 cs4 = *(const f32x4*)(ROPE + pos * 16 + 4 * (fq & 1)), sn4 = *(const f32x4*)(ROPE + pos * 16 + 8 + 4 * (fq & 1));
#pragma unroll
                        for (int n = 0; n < 2; ++n)
#pragma unroll
                            for (int q = 0; q < 2; ++q) { const float c = cs4[2 * n + q], s = sn4[2 * n + q];
                                const float x1 = acc[ai][1][m][n][2 * q], x2 = acc[ai][1][m][n][2 * q + 1];
                                o[4 * n + 2 * q] = x1 * c - x2 * s; o[4 * n + 2 * q + 1] = x1 * s + x2 * c; }
                        u32x4 w; w.x = cvt_pk_bf16(o[0], o[1]); w.y = cvt_pk_bf16(o[2], o[3]); w.z = cvt_pk_bf16(o[4], o[5]); w.w = cvt_pk_bf16(o[6], o[7]);
                        *(u32x4*)(KR + (size_t)row * 32 + 8 * fq) = w; }
            }
        }
    }
};
struct EpiQUp {
    static constexpr bool PERM = true;
    bf16_t* QN; bf16_t* QR; const float* SSQ; const float* ROPE;
    __device__ __forceinline__ void operator()(const Acc& acc, const Unit& u, int wr, int wc, int fr, int fq) const {
        const int pn = u.pn, row0 = u.pm * BM + wr * 64 + fr, colt = wc * 32 + 8 * fq;
#pragma unroll
        for (int ai = 0; ai < 2; ++ai)
#pragma unroll
            for (int m = 0; m < 4; ++m) { const int row = row0 + ai * HALF + m * 16;
                const f32x4 q0_ = *(const f32x4*)(SSQ + (size_t)row * 16), q1_ = *(const f32x4*)(SSQ + (size_t)row * 16 + 4);
                const float rs = __builtin_amdgcn_rsqf((((q0_[0] + q0_[1]) + (q0_[2] + q0_[3])) + ((q1_[0] + q1_[1]) + (q1_[2] + q1_[3]))) * (1.f / QLORA) + RMS_EPS) * C2MLA;
                if (pn < 2) {
#pragma unroll
                    for (int bj = 0; bj < 2; ++bj) { const f32x4 v0 = acc[ai][bj][m][0] * rs, v1 = acc[ai][bj][m][1] * rs; u32x4 w;
                        w.x = cvt_pk_bf16(v0[0], v0[1]); w.y = cvt_pk_bf16(v0[2], v0[3]); w.z = cvt_pk_bf16(v1[0], v1[1]); w.w = cvt_pk_bf16(v1[2], v1[3]);
                        *(u32x4*)(QN + (size_t)row * 512 + pn * 256 + bj * HALF + colt) = w; }
                } else {
                    const int tok = row & (SEQ - 1); const int pos = (fq >> 1) ? (tok & 63) : (tok >> 6);
                    const f32x4 cs4 = *(const f32x4*)(ROPE + pos * 16 + 4 * (fq & 1)), sn4 = *(const f32x4*)(ROPE + pos * 16 + 8 + 4 * (fq & 1));
#pragma unroll
                    for (int bj = 0; bj < 2; ++bj) { float o[8];
#pragma unroll
                        for (int n = 0; n < 2; ++n)
#pragma unroll
                            for (int q = 0; q < 2; ++q) { const float c = cs4[2 * n + q], s = sn4[2 * n + q];
                                const float x1 = acc[ai][bj][m][n][2 * q] * rs, x2 = acc[ai][bj][m][n][2 * q + 1] * rs;
                                o[4 * n + 2 * q] = x1 * c - x2 * s; o[4 * n + 2 * q + 1] = x1 * s + x2 * c; }
                        u32x4 w; w.x = cvt_pk_bf16(o[0], o[1]); w.y = cvt_pk_bf16(o[2], o[3]); w.z = cvt_pk_bf16(o[4], o[5]); w.w = cvt_pk_bf16(o[6], o[7]);
                        *(u32x4*)(QR + (size_t)row * 256 + bj * HALF + colt) = w; }
                }
                asm volatile("" ::: "memory"); }
    }
};
struct EpiKVUp {
    static constexpr bool PERM = true;
    bf16_t* KN; bf16_t* VM; const float* SSQ;
    __device__ __forceinline__ void operator()(const Acc& acc, const Unit& u, int wr, int wc, int fr, int fq) const {
        const int pn = u.pn, row0 = u.pm * BM + wr * 64 + fr, colt = wc * 32 + 8 * fq;
        bf16_t* dst = (pn < 2) ? KN + pn * 256 : VM + (pn - 2) * 256;
#pragma unroll
        for (int ai = 0; ai < 2; ++ai)
#pragma unroll
            for (int m = 0; m < 4; ++m) { const int row = row0 + ai * HALF + m * 16;
                const f32x4 q0_ = *(const f32x4*)(SSQ + (size_t)row * 16 + 8), q1_ = *(const f32x4*)(SSQ + (size_t)row * 16 + 12);
                const float rs = __builtin_amdgcn_rsqf((((q0_[0] + q0_[1]) + (q0_[2] + q0_[3])) + ((q1_[0] + q1_[1]) + (q1_[2] + q1_[3]))) * (1.f / KVLORA) + RMS_EPS);
#pragma unroll
                for (int bj = 0; bj < 2; ++bj) { const f32x4 v0 = acc[ai][bj][m][0] * rs, v1 = acc[ai][bj][m][1] * rs; u32x4 w;
                    w.x = cvt_pk_bf16(v0[0], v0[1]); w.y = cvt_pk_bf16(v0[2], v0[3]); w.z = cvt_pk_bf16(v1[0], v1[1]); w.w = cvt_pk_bf16(v1[2], v1[3]);
                    *(u32x4*)(dst + (size_t)row * 512 + bj * HALF + colt) = w; } }
    }
};
struct EpiMerge {
    static constexpr bool PERM = true;
    const bf16_t* PROJ; const float* bgate; float* TMP; bf16_t* MERGED;
    __device__ __forceinline__ void operator()(const Acc& acc, const Unit& u, int wr, int wc, int fr, int fq) const {
        const int sub = u.aux, row0 = u.pm * BM + wr * 64 + fr, col0 = u.pn * BM + wc * 32 + 8 * fq;
        f32x4 bg[2][2];
#pragma unroll
        for (int bj = 0; bj < 2; ++bj)
#pragma unroll
            for (int n = 0; n < 2; ++n) bg[bj][n] = *(const f32x4*)(bgate + sub * 1024 + col0 + bj * HALF + 4 * n);
#pragma unroll
        for (int ai = 0; ai < 2; ++ai)
#pragma unroll
            for (int m = 0; m < 4; ++m) { const int row = row0 + ai * HALF + m * 16;
#pragma unroll
                for (int bj = 0; bj < 2; ++bj) { const int col = col0 + bj * HALF;
                    const u32x4 gl = *(const u32x4*)(PROJ + (size_t)row * NPROJ + 2304 + sub * 1024 + col);
                    f32x4 g0, g1;
                    g0[0] = sigmoidf_(bf16_lo(gl.x) + bg[bj][0][0]); g0[1] = sigmoidf_(bf16_hi(gl.x) + bg[bj][0][1]); g0[2] = sigmoidf_(bf16_lo(gl.y) + bg[bj][0][2]); g0[3] = sigmoidf_(bf16_hi(gl.y) + bg[bj][0][3]);
                    g1[0] = sigmoidf_(bf16_lo(gl.z) + bg[bj][1][0]); g1[1] = sigmoidf_(bf16_hi(gl.z) + bg[bj][1][1]); g1[2] = sigmoidf_(bf16_lo(gl.w) + bg[bj][1][2]); g1[3] = sigmoidf_(bf16_hi(gl.w) + bg[bj][1][3]);
                    f32x4 v0 = acc[ai][bj][m][0] * g0, v1 = acc[ai][bj][m][1] * g1;
                    float* tp = TMP + (size_t)row * 1024 + col;
                    if (sub == 0) { *(f32x4*)tp = v0; *(f32x4*)(tp + 4) = v1; }
                    else { v0 += *(const f32x4*)tp; v1 += *(const f32x4*)(tp + 4); u32x4 w;
                        w.x = cvt_pk_bf16(v0[0], v0[1]); w.y = cvt_pk_bf16(v0[2], v0[3]); w.z = cvt_pk_bf16(v1[0], v1[1]); w.w = cvt_pk_bf16(v1[2], v1[3]);
                        *(u32x4*)(MERGED + (size_t)row * 1024 + col) = w; } } }
    }
};
struct EpiF32 {
    static constexpr bool PERM = false;
    float* C; int ldc;
    __device__ __forceinline__ void operator()(const Acc& acc, const Unit& u, int wr, int wc, int fr, int fq) const {
        const int row0 = u.pm * BM + wr * 64 + fr, col0 = u.pn * BM + wc * 32 + 4 * fq;
#pragma unroll
        for (int ai = 0; ai < 2; ++ai)
#pragma unroll
            for (int m = 0; m < 4; ++m) { float* rowp = C + (size_t)(row0 + ai * HALF + m * 16) * ldc + col0;
#pragma unroll
                for (int bj = 0; bj < 2; ++bj)
#pragma unroll
                    for (int n = 0; n < 2; ++n) *(f32x4*)(rowp + bj * HALF + n * 16) = acc[ai][bj][m][n]; }
    }
};
struct EpiMoe1 {
    static constexpr bool PERM = true;
    const float* b1; bf16_t* ACT;
    __device__ __forceinline__ void operator()(const Acc& acc, const Unit& u, int wr, int wc, int fr, int fq) const {
        const int e = u.aux, row0 = u.pm * BM + wr * 64 + fr, col0 = u.pn * BM + wc * 32 + 8 * fq;
        f32x4 bv[2][2];
#pragma unroll
        for (int bj = 0; bj < 2; ++bj)
#pragma unroll
            for (int n = 0; n < 2; ++n) bv[bj][n] = *(const f32x4*)(b1 + (size_t)e * 2048 + col0 + bj * HALF + 4 * n);
#pragma unroll
        for (int ai = 0; ai < 2; ++ai)
#pragma unroll
            for (int m = 0; m < 4; ++m) { const int row = row0 + ai * HALF + m * 16;
#pragma unroll
                for (int bj = 0; bj < 2; ++bj) { float o[4];
#pragma unroll
                    for (int n = 0; n < 2; ++n) { const f32x4 v = acc[ai][bj][m][n] + bv[bj][n];
#pragma unroll
                        for (int q = 0; q < 2; ++q) { const float xg = fminf(v[2 * q], 7.f), xl = fminf(fmaxf(v[2 * q + 1], -7.f), 7.f);
                            o[2 * n + q] = xg * sigmoidf_(1.702f * xg) * (xl + 1.f); } }
                    u32x2 w; w.x = cvt_pk_bf16(o[0], o[1]); w.y = cvt_pk_bf16(o[2], o[3]);
                    *(u32x2*)(ACT + (size_t)row * 1024 + ((col0 + bj * HALF) >> 1)) = w; } }
    }
};
struct EpiMoe2 {
    static constexpr bool PERM = true;
    const float* b2; bf16_t* YIT;
    __device__ __forceinline__ void operator()(const Acc& acc, const Unit& u, int wr, int wc, int fr, int fq) const {
        const int e = u.aux, row0 = u.pm * BM + wr * 64 + fr, col0 = u.pn * BM + wc * 32 + 8 * fq;
        f32x4 bv[2][2];
#pragma unroll
        for (int bj = 0; bj < 2; ++bj)
#pragma unroll
            for (int n = 0; n < 2; ++n) bv[bj][n] = *(const f32x4*)(b2 + (size_t)e * 1024 + col0 + bj * HALF + 4 * n);
#pragma unroll
        for (int ai = 0; ai < 2; ++ai)
#pragma unroll
            for (int m = 0; m < 4; ++m) { const int row = row0 + ai * HALF + m * 16;
#pragma unroll
                for (int bj = 0; bj < 2; ++bj) { const f32x4 v0 = acc[ai][bj][m][0] + bv[bj][0], v1 = acc[ai][bj][m][1] + bv[bj][1]; u32x4 w;
                    w.x = cvt_pk_bf16(v0[0], v0[1]); w.y = cvt_pk_bf16(v0[2], v0[3]); w.z = cvt_pk_bf16(v1[0], v1[1]); w.w = cvt_pk_bf16(v1[2], v1[3]);
                    *(u32x4*)(YIT + (size_t)row * 1024 + col0 + bj * HALF) = w; } }
    }
};
}

namespace attn {
#define SBAR() __builtin_amdgcn_sched_barrier(0)
constexpr int NW = 8, QBLK = 32, KVBLK = 64;
constexpr float THR = 8.f;
__device__ __forceinline__ int crow(int r, int hi) { return (r & 3) + 8 * (r >> 2) + 4 * hi; }
constexpr int KROW_MLA = 96 * 2 + 16, KROW_NA = 64 * 2 + 16;
constexpr int SHM_K = 64 * KROW_MLA  , SHM_V = 64 * 64 * 2  ;
constexpr int OFF_V = 0, OFF_K = 2 * SHM_V, OFF_WS = OFF_K + 2 * SHM_K, OFF_OST = OFF_WS + NW * 256, OFF_BIAS = OFF_OST + NW * 4096, ATTN_LDS = OFF_BIAS + 2048;

__device__ __forceinline__ int v_st(int k, int c) { const int kk = (k & ~0xC) | ((k & 4) << 1) | ((k & 8) >> 1); return ((kk >> 3) * 2 + (c >> 5)) * 512 + ((kk & 7) * 32 + (c & 31)) * 2; }
__device__ __forceinline__ int v_rd_base(int lane) { return ((lane & 3) << 3) | (((lane >> 2) & 3) << 6) | (((lane >> 4) & 1) << 5) | (((lane >> 5) & 1) << 8); }
constexpr int v_rd_off(int d0, int ks, int half) { return d0 * 512 + ks * 2048 + half * 1024; }
template <int OFF> __device__ __forceinline__ s16x4 tr_read(int vb) {
    s16x4 r; asm volatile("ds_read_b64_tr_b16 %0, %1 offset:%2" : "=&v"(r) : "v"(vb), "i"(OFF) : "memory"); return r;
}
template <int D0> __device__ __forceinline__ void pv_one(f32x16& od, int vb, bf16x8 pa0, bf16x8 pa1, bf16x8 pa2, bf16x8 pa3) {
    const s16x4 l0 = tr_read<v_rd_off(D0, 0, 0)>(vb), h0 = tr_read<v_rd_off(D0, 0, 1)>(vb), l1 = tr_read<v_rd_off(D0, 1, 0)>(vb), h1 = tr_read<v_rd_off(D0, 1, 1)>(vb);
    const s16x4 l2 = tr_read<v_rd_off(D0, 2, 0)>(vb), h2 = tr_read<v_rd_off(D0, 2, 1)>(vb), l3 = tr_read<v_rd_off(D0, 3, 0)>(vb), h3 = tr_read<v_rd_off(D0, 3, 1)>(vb);
    asm volatile("s_waitcnt lgkmcnt(0)" ::: "memory"); SBAR();
#define PK(L, H) (bf16x8){L[0], L[1], L[2], L[3], H[0], H[1], H[2], H[3]}
    od = __builtin_amdgcn_mfma_f32_32x32x16_bf16(pa0, PK(l0, h0), od, 0, 0, 0);
    od = __builtin_amdgcn_mfma_f32_32x32x16_bf16(pa1, PK(l1, h1), od, 0, 0, 0);
    od = __builtin_amdgcn_mfma_f32_32x32x16_bf16(pa2, PK(l2, h2), od, 0, 0, 0);
    od = __builtin_amdgcn_mfma_f32_32x32x16_bf16(pa3, PK(l3, h3), od, 0, 0, 0);
#undef PK
}
__device__ __forceinline__ void pv_d0(f32x16* o, int vb, bf16x8 pa0, bf16x8 pa1, bf16x8 pa2, bf16x8 pa3) {
    pv_one<0>(o[0], vb, pa0, pa1, pa2, pa3); pv_one<1>(o[1], vb, pa0, pa1, pa2, pa3);
}
__device__ __forceinline__ void partialSM(f32x16& p0, f32x16& p1, float& m_reg, float& alpha) {
    float pmax = p0[0];
#pragma unroll
    for (int r = 1; r < 16; ++r) pmax = fmaxf(pmax, p0[r]);
#pragma unroll
    for (int r = 0; r < 16; ++r) pmax = fmaxf(pmax, p1[r]);
    { auto rr = __builtin_amdgcn_permlane32_swap(__float_as_uint(pmax), __float_as_uint(pmax), false, false);
      pmax = fmaxf(__uint_as_float(rr[0]), __uint_as_float(rr[1])); }
    float mn;
    if (__builtin_expect(__all(pmax - m_reg <= THR), 1)) { mn = m_reg; alpha = 1.f; }
    else { mn = fmaxf(m_reg, pmax); alpha = __builtin_amdgcn_exp2f(m_reg - mn); m_reg = mn; }
#pragma unroll
    for (int r = 0; r < 16; ++r) p0[r] = p0[r] - mn;
#pragma unroll
    for (int r = 0; r < 16; ++r) p1[r] = p1[r] - mn;
#pragma unroll
    for (int r = 0; r < 16; ++r) p0[r] = __builtin_amdgcn_exp2f(p0[r]);
}
__device__ __forceinline__ void finishSM(f32x16& p0, f32x16& p1, float alpha, float& l_reg, bf16x8& pa0, bf16x8& pa1, bf16x8& pa2, bf16x8& pa3) {
#pragma unroll
    for (int r = 0; r < 16; ++r) p1[r] = __builtin_amdgcn_exp2f(p1[r]);
    float ps = 0;
#pragma unroll
    for (int r = 0; r < 16; ++r) ps += p0[r];
#pragma unroll
    for (int r = 0; r < 16; ++r) ps += p1[r];
    { auto rr = __builtin_amdgcn_permlane32_swap(__float_as_uint(ps), __float_as_uint(ps), false, false);
      ps = __uint_as_float(rr[0]) + __uint_as_float(rr[1]); }
    l_reg = l_reg * alpha + ps;
#define PK4(P, BASE, OUT) do { unsigned a0 = cvt_pk_bf16(P[BASE + 0], P[BASE + 1]), a1 = cvt_pk_bf16(P[BASE + 2], P[BASE + 3]);   \
    unsigned b0 = cvt_pk_bf16(P[BASE + 4], P[BASE + 5]), b1 = cvt_pk_bf16(P[BASE + 6], P[BASE + 7]);                              \
    auto r0 = __builtin_amdgcn_permlane32_swap(a0, b0, false, false); auto r1 = __builtin_amdgcn_permlane32_swap(a1, b1, false, false); \
    u32x4 w = {r0[0], r1[0], r0[1], r1[1]}; OUT = *reinterpret_cast<bf16x8*>(&w); } while (0)
    PK4(p0, 0, pa0); PK4(p0, 8, pa1); PK4(p1, 0, pa2); PK4(p1, 8, pa3);
#undef PK4
}
template <int ND0, int KROW>
__device__ __forceinline__ void qkt(f32x16& p0, f32x16& p1, const char* Ks, const bf16x8* qr, int r32, int hi) {
    p0 = f32x16{}; p1 = f32x16{};
#pragma unroll
    for (int d0 = 0; d0 < ND0; ++d0) { const int cb = (d0 * 16 + hi * 8) * 2;
        const bf16x8 b0 = *reinterpret_cast<const bf16x8*>(Ks + r32 * KROW + cb);
        const bf16x8 b1 = *reinterpret_cast<const bf16x8*>(Ks + (32 + r32) * KROW + cb);
        p0 = __builtin_amdgcn_mfma_f32_32x32x16_bf16(b0, qr[d0], p0, 0, 0, 0);
        p1 = __builtin_amdgcn_mfma_f32_32x32x16_bf16(b1, qr[d0], p1, 0, 0, 0); }
}

template <int MODE>
__device__ __forceinline__ void attn_unit(const bf16_t* __restrict__ Qa, int ldqa, const bf16_t* __restrict__ Qb, int ldqb,
                                          const bf16_t* __restrict__ Ka, int ldka, const bf16_t* __restrict__ Kb, int ldkb, const bf16_t* __restrict__ Vv, int ldv,
                                          bf16_t* __restrict__ O, int NT, int krow0, int ntreal, int qrow0, const float* __restrict__ rpbh, char* lds) {
    constexpr int ND0 = MODE == 0 ? 6 : 4, KROW = MODE == 0 ? KROW_MLA : KROW_NA;
    const int tid = threadIdx.x, wid = __builtin_amdgcn_readfirstlane(tid >> 6), lane = tid & 63, r32 = lane & 31, hi = lane >> 5;
    char* V_lds = lds + OFF_V; char* K_lds = lds + OFF_K;
    float* ws = (float*)(lds + OFF_WS) + wid * 64; float* li_l = ws; float* al_l = ws + 32;
    float* biasL = (float*)(lds + OFF_BIAS);
    float m_reg = -1e30f, l_reg = 0; f32x16 o[2] = {}; bf16x8 qr[ND0];
    {   const bf16_t* Qw = Qa + (size_t)(wid * QBLK + r32) * ldqa + hi * 8;
#pragma unroll
        for (int d0 = 0; d0 < 4; ++d0) qr[d0] = *reinterpret_cast<const bf16x8*>(Qw + d0 * 16);
        if constexpr (MODE == 0) { const bf16_t* Qw2 = Qb + (size_t)(wid * QBLK + r32) * ldqb + hi * 8;
#pragma unroll
            for (int d0 = 0; d0 < 2; ++d0) qr[4 + d0] = *reinterpret_cast<const bf16x8*>(Qw2 + d0 * 16); } }
    int qgr = 0, rs0 = 0, qc = 0, cs = 0;
    if constexpr (MODE == 1) {
        qgr = qrow0 + (wid >> 1); rs0 = min(max(qgr - 4, 0), 120); qc = 32 * (wid & 1) + r32; cs = min(max(qc - 8, 0), 48);
        for (int i = tid; i < 15 * 31; i += 512) biasL[i] = rpbh[i] * LOG2E;
    }
    const int sr = tid >> 3, sc = (tid & 7) * 8;
    const int sr2 = (tid & 255) >> 2, sc2 = (tid & 3) * 8;
    const int vst = v_st(sr, sc);
    const int vb0 = (int)(uintptr_t)V_lds + v_rd_base(lane);
    struct { bf16x8 v, k, k2; } sr_[2];
#define KROWOF(t) (MODE == 1 ? min(krow0 + (t), 127) * 64 : (t) * 64)
#define SLOAD(i, t) do { const long k0_ = KROWOF(t); sr_[i].v = *reinterpret_cast<const bf16x8*>(&Vv[(k0_ + sr) * ldv + sc]); sr_[i].k = *reinterpret_cast<const bf16x8*>(&Ka[(k0_ + sr) * ldka + sc]); \
        if constexpr (MODE == 0) sr_[i].k2 = *reinterpret_cast<const bf16x8*>(&Kb[(k0_ + sr2) * ldkb + sc2]); } while (0)
#define SWRITE(b, i) do { *(bf16x8*)(V_lds + (b) * SHM_V + vst) = sr_[i].v; *(bf16x8*)(K_lds + (b) * SHM_K + sr * KROW + sc * 2) = sr_[i].k; \
        if constexpr (MODE == 0) { if (tid < 256) *(bf16x8*)(K_lds + (b) * SHM_K + sr2 * KROW + 128 + sc2 * 2) = sr_[i].k2; } } while (0)
#define SWAIT() do { if constexpr (MODE == 0) asm volatile("s_waitcnt vmcnt(3)" ::: "memory"); else asm volatile("s_waitcnt vmcnt(2)" ::: "memory"); } while (0)
#define RESC(a) do { if (__any((a) < 1.f)) { if (hi == 0) al_l[r32] = (a); asm volatile("s_waitcnt lgkmcnt(0)" ::: "memory"); \
        _Pragma("unroll") for (int d = 0; d < 2; ++d) _Pragma("unroll") for (int r = 0; r < 16; ++r) o[d][r] *= al_l[crow(r, hi)]; } } while (0)
#define TVALID(t) (MODE == 0 ? true : ((t) < ntreal && (krow0 + (t)) >= rs0 && (krow0 + (t)) < rs0 + 8))
#define MASKB(P0, P1, t) do { if constexpr (MODE == 1) { const int dr_ = krow0 + (t) - qgr + 7; int d_ = 4 * hi - cs; asm volatile("" : "+v"(d_)); \
        const LAS float* bl_ = (const LAS float*)((LAS char*)lds + OFF_BIAS) + (dr_ * 31 + 15 - qc + 4 * hi); \
        _Pragma("unroll") for (int r = 0; r < 16; ++r) { const int c0_ = (r & 3) + 8 * (r >> 2); \
            const bool in0 = (unsigned)(c0_ + d_) < 16u, in1 = (unsigned)(c0_ + 32 + d_) < 16u; \
            const float b0_ = bl_[c0_], b1_ = bl_[c0_ + 32]; \
            P0[r] = in0 ? P0[r] + b0_ : -1e30f; P1[r] = in1 ? P1[r] + b1_ : -1e30f; } } } while (0)
    f32x16 pA0, pA1, pB0, pB1; float alA = 1.f, alB = 1.f; bf16x8 pa0, pa1, pa2, pa3;
    bool vA, vB;
    constexpr int SE = 0, SO = 1;
    SLOAD(SE, 0); asm volatile("s_waitcnt vmcnt(0)" ::: "memory"); SWRITE(0, SE); __syncthreads();
    vA = TVALID(0);
    if (vA) { qkt<ND0, KROW>(pA0, pA1, K_lds, qr, r32, hi); MASKB(pA0, pA1, 0); partialSM(pA0, pA1, m_reg, alA); }
    SLOAD(SO, 1); if (2 < NT) SLOAD(SE, 2);
    SWAIT(); SWRITE(1, SO); __syncthreads();
    for (int j = 1; j + 1 < NT; j += 2) {
        vB = TVALID(j);
        SBAR(); if (vB) { qkt<ND0, KROW>(pB0, pB1, K_lds + SHM_K, qr, r32, hi); MASKB(pB0, pB1, j); }
        if (vA) finishSM(pA0, pA1, alA, l_reg, pa0, pa1, pa2, pa3); SBAR();
        SLOAD(SO, min(j + 2, NT - 1)); SBAR();
        if (vA) pv_d0(o, vb0, pa0, pa1, pa2, pa3);
        if (vB) partialSM(pB0, pB1, m_reg, alB);
        __syncthreads(); SWAIT(); SWRITE(0, SE);
        if (vB) RESC(alB); __syncthreads();
        vA = TVALID(j + 1);
        SBAR(); if (vA) { qkt<ND0, KROW>(pA0, pA1, K_lds, qr, r32, hi); MASKB(pA0, pA1, j + 1); }
        if (vB) finishSM(pB0, pB1, alB, l_reg, pa0, pa1, pa2, pa3); SBAR();
        SLOAD(SE, min(j + 3, NT - 1)); SBAR();
        if (vB) pv_d0(o, vb0 + SHM_V, pa0, pa1, pa2, pa3);
        if (vA) partialSM(pA0, pA1, m_reg, alA);
        __syncthreads(); SWAIT(); SWRITE(1, SO);
        if (vA) RESC(alA); __syncthreads();
    }
    vB = TVALID(NT - 1);
    SBAR(); if (vB) { qkt<ND0, KROW>(pB0, pB1, K_lds + SHM_K, qr, r32, hi); MASKB(pB0, pB1, NT - 1); }
    if (vA) finishSM(pA0, pA1, alA, l_reg, pa0, pa1, pa2, pa3); SBAR();
    if (vA) pv_d0(o, vb0, pa0, pa1, pa2, pa3);
    if (vB) { partialSM(pB0, pB1, m_reg, alB); RESC(alB);
        finishSM(pB0, pB1, alB, l_reg, pa0, pa1, pa2, pa3); SBAR();
        pv_d0(o, vb0 + SHM_V, pa0, pa1, pa2, pa3); }
    asm volatile("s_waitcnt vmcnt(0)" ::: "memory");
    if (hi == 0) li_l[r32] = l_reg; asm volatile("s_waitcnt lgkmcnt(0)" ::: "memory");
    float rli[16];
#pragma unroll
    for (int r = 0; r < 16; ++r) rli[r] = __builtin_amdgcn_rcpf(li_l[crow(r, hi)]);
    {   bf16_t* stg = (bf16_t*)(lds + OFF_OST) + wid * 2048;
#pragma unroll
        for (int r = 0; r < 16; ++r) { const int orow = crow(r, hi);
#pragma unroll
            for (int d0 = 0; d0 < 2; ++d0) stg[orow * 64 + d0 * 32 + r32] = (bf16_t)(cvt_pk_bf16(o[d0][r] * rli[r], 0.f) & 0xffffu); }
        asm volatile("s_waitcnt lgkmcnt(0)" ::: "memory");
        bf16_t* Ow = O + (size_t)(wid * QBLK) * 512;
#pragma unroll
        for (int i = 0; i < 4; ++i) { const int row = i * 8 + (lane >> 3), ch = lane & 7; const u32x4 v = *(const u32x4*)(stg + row * 64 + ch * 8); *(u32x4*)(Ow + (size_t)row * 512 + ch * 8) = v; } }
    __syncthreads();
#undef KROWOF
#undef SLOAD
#undef SWRITE
#undef SWAIT
#undef RESC
#undef TVALID
#undef MASKB
}
#undef SBAR
}

constexpr size_t MiB = 1u << 20;
constexpr size_t WS_CTL = 0, CTL_ZERO_BYTES = 1 * MiB;
constexpr size_t WS_WIN = 2 * MiB;
constexpr size_t WS_WUQ = 11 * MiB;
constexpr size_t WS_WUKV = 12 * MiB;
constexpr size_t WS_WNA = 13 * MiB, WS_WMLA = 14 * MiB;
constexpr size_t WS_WOUT = 15 * MiB;
constexpr size_t WS_W1 = 18 * MiB;
constexpr size_t WS_W2 = 146 * MiB;
constexpr size_t WS_XN = 210 * MiB;
constexpr size_t WS_PROJ = 242 * MiB;
constexpr size_t WS_QN = 378 * MiB, WS_QR = 394 * MiB, WS_KN = 402 * MiB, WS_KR = 418 * MiB, WS_VM = 419 * MiB;
constexpr size_t WS_ONA = 435 * MiB, WS_OMLA = 451 * MiB;
constexpr size_t WS_MERGED = 467 * MiB;
constexpr size_t WS_TMP = 499 * MiB;
constexpr size_t WS_LIST = 563 * MiB;
constexpr size_t WS_TOKPOS = 565 * MiB, WS_TOKG = 566 * MiB;
constexpr size_t WS_ACT = 568 * MiB;
constexpr size_t WS_YIT = 712 * MiB;
constexpr size_t WS_SSQ = 856 * MiB;
constexpr size_t WS_MODP = 857 * MiB;
constexpr size_t WS_WRT = 858 * MiB;
constexpr size_t WS_END = 859 * MiB;
constexpr int CW_BAR = 4096;
constexpr int CW_CNT = 8192;
constexpr int CW_MOD = 16384;
constexpr int CW_ROPE = 32768;
static_assert((CW_ROPE + 2048) * 4 <= (int)CTL_ZERO_BYTES, "CTL");

constexpr int RING_BYTES = 131072;
constexpr int TAB_OFF = RING_BYTES;
constexpr int TAB_BLK = TAB_OFF, TAB_GATH = TAB_OFF + 2048;
constexpr int MISC_OFF = TAB_GATH + 11 * 1024;
constexpr int LDS_BYTES = 147456;
static_assert(MISC_OFF + 256 <= LDS_BYTES, "LDS map");

#define RLX_AGENT __ATOMIC_RELAXED, __HIP_MEMORY_SCOPE_AGENT
#define LDS_WAIT() asm volatile("s_waitcnt lgkmcnt(0)" ::: "memory")

#define XB_TMO      128
#define XB_XCNT(j)  (256  + 64 * (j))
#define XB_XSUB(j)  (1280 + 64 * (j))
#define XB_XGEN(j)  (2304 + 64 * (j))
#define XB_TOP      3328
#define XB_TOPGEN   3392
#define XCD_BAR_WORDS 3456
#define XB_SPIN_CAP (1u << 22)
__device__ __forceinline__ unsigned xb_ld(unsigned* p)              { return __hip_atomic_load(p, __ATOMIC_RELAXED, __HIP_MEMORY_SCOPE_AGENT); }
__device__ __forceinline__ unsigned xb_add(unsigned* p, unsigned v) { return __hip_atomic_fetch_add(p, v, __ATOMIC_RELAXED, __HIP_MEMORY_SCOPE_AGENT); }
__device__ __forceinline__ unsigned xb_xcc_id() { return (unsigned)__builtin_amdgcn_s_getreg((3 << 11) | 20) & 0xFu; }
#define XB_SPIN(cond, bar) do { unsigned _sp = 0; while (cond) { __builtin_amdgcn_s_sleep(1); \
    if ((++_sp & 255u) == 0u) { if (xb_ld(&(bar)[XB_TMO])) break; if (_sp > XB_SPIN_CAP) { atomicAdd(&(bar)[XB_TMO], 1u); break; } } } } while (0)
struct XcdBarrier { unsigned* bar; unsigned x; volatile LAS unsigned* st; };
__device__ __forceinline__ XcdBarrier xcd_barrier_post(unsigned* bar, volatile LAS unsigned* st) {
    XcdBarrier b; b.bar = bar; b.x = xb_xcc_id(); b.st = st;
    if (threadIdx.x == 0) (void)xb_add(&bar[XB_XCNT(b.x)], 1u);
    return b;
}
__device__ __forceinline__ void xcd_barrier_complete(unsigned* bar, unsigned x, unsigned& nloc, unsigned& nx) {
    const unsigned G = gridDim.x * gridDim.y * gridDim.z;
    unsigned sum, cnt, mine, sp = 0u;
    for (;;) {
        sum = 0u; cnt = 0u; mine = 0u;
#pragma unroll
        for (unsigned j = 0; j < 16; ++j) { const unsigned c = xb_ld(&bar[XB_XCNT(j)]); sum += c; cnt += (c > 0u) ? 1u : 0u; mine = (j == x) ? c : mine; }
        if (sum == G) break;
        __builtin_amdgcn_s_sleep(1);
        if ((++sp & 255u) == 0u) { if (xb_ld(&bar[XB_TMO])) break; if (sp > XB_SPIN_CAP) { atomicAdd(&bar[XB_TMO], 1u); break; } }
    }
    nloc = mine > 0u ? mine : 1u; nx = cnt > 0u ? cnt : 1u;
}
__device__ __forceinline__ void xcd_barrier(const XcdBarrier& b) {
    asm volatile("s_waitcnt vmcnt(0)" ::: "memory");
    __syncthreads();
    if (threadIdx.x == 0) {
        unsigned* bar = b.bar;
        __builtin_amdgcn_s_waitcnt(0);
        unsigned nloc = b.st[0], nx = b.st[1];
        if (nloc == 0u) { xcd_barrier_complete(bar, b.x, nloc, nx); b.st[0] = nloc; b.st[1] = nx; }
        const unsigned old = xb_add(&bar[XB_XSUB(b.x)], 1u);
        const unsigned gen = old / nloc;
        if (old + 1u == (gen + 1u) * nloc) {
            __builtin_amdgcn_fence(__ATOMIC_RELEASE, "agent");
            asm volatile("s_waitcnt vmcnt(0)" ::: "memory");
            const unsigned og = xb_add(&bar[XB_TOP], 1u);
            const unsigned tg = og / nx;
            if (og + 1u == (tg + 1u) * nx) xb_add(&bar[XB_TOPGEN], 1u);
            else XB_SPIN(xb_ld(&bar[XB_TOPGEN]) == tg, bar);
            __builtin_amdgcn_fence(__ATOMIC_ACQUIRE, "agent");
            xb_add(&bar[XB_XGEN(b.x)], 1u);
            asm volatile("s_waitcnt vmcnt(0)" ::: "memory");
        } else {
            XB_SPIN(xb_ld(&bar[XB_XGEN(b.x)]) == gen, bar);
            __builtin_amdgcn_fence(__ATOMIC_ACQUIRE, "agent");
            asm volatile("s_waitcnt vmcnt(0)" ::: "memory");
        }
    }
    __syncthreads();
}

constexpr int NWAVES = 8;
struct Args { const float* in[24]; float* out; unsigned char* ws; int ph_lo, ph_hi; };
enum { I_X = 0, I_C, I_WADA, I_BADA, I_GAPRE, I_GAPOST, I_WIN, I_BGATE, I_RPB, I_QNG, I_KVNG, I_WUQ, I_WUKV, I_WNAUP, I_WMLAUP, I_WOUT, I_GFPRE, I_GFPOST, I_WR, I_BR, I_W1, I_B1, I_W2, I_B2 };

__device__ __forceinline__ void tr_store_tile(LAS unsigned char* scr, bf16_t* dst, int K, int n0, int k0, int lane) {
    LDS_WAIT(); asm volatile("" ::: "memory");
#pragma unroll
    for (int j = 0; j < 8; ++j) { const int idx = j * 64 + lane, n = idx >> 3, ch = idx & 7;
        const u32x4 v = *(const LAS u32x4*)(scr + n * 144 + ch * 16);
        *(GAS u32x4*)(dst + (size_t)(n0 + n) * K + k0 + ch * 8) = v; }
    LDS_WAIT(); asm volatile("" ::: "memory");
}
__device__ __forceinline__ void tr_tile_fast(const float* src, int Nsrc, int src0, const float* kscale, bf16_t* dst, int K, int n0, int k0, LAS unsigned char* scr, int lane) {
#pragma unroll
    for (int st = 0; st < 8; ++st) { const int kq = st * 4 + (lane >> 4), c4 = (lane & 15) * 4, k = 2 * kq;
        f32x4 a = *(const GAS f32x4*)(src + (size_t)(k0 + k) * Nsrc + src0 + c4);
        f32x4 b = *(const GAS f32x4*)(src + (size_t)(k0 + k + 1) * Nsrc + src0 + c4);
        if (kscale) { const float s0 = kscale[k0 + k], s1 = kscale[k0 + k + 1]; a = a * s0; b = b * s1; }
#pragma unroll
        for (int i = 0; i < 4; ++i) *(LAS unsigned*)(scr + (c4 + i) * 144 + k * 2) = cvt_pk_bf16(a[i], b[i]); }
    tr_store_tile(scr, dst, K, n0, k0, lane);
}
__device__ __forceinline__ void tr_tile_slow(const float* src, int Nsrc, int srccol  , const float* kscale, bf16_t* dst, int K, int n0, int k0, LAS unsigned char* scr, int lane) {
#pragma unroll 8
    for (int k = 0; k < 64; k += 2) {
        float a = 0.f, b = 0.f;
        if (srccol >= 0) { a = src[(size_t)(k0 + k) * Nsrc + srccol]; b = src[(size_t)(k0 + k + 1) * Nsrc + srccol];
            if (kscale) { a *= kscale[k0 + k]; b *= kscale[k0 + k + 1]; } }
        *(LAS unsigned*)(scr + lane * 144 + k * 2) = cvt_pk_bf16(a, b); }
    tr_store_tile(scr, dst, K, n0, k0, lane);
}
__device__ __forceinline__ int rope_orig(int p) { return (p & 16) + 8 * (p & 1) + ((p & 15) >> 1); }

__global__ void __launch_bounds__(NWAVES * 64, 2) fwd_kernel(Args args) {
    extern __shared__ __attribute__((aligned(16))) unsigned char lds[];
    LAS unsigned char* L = (LAS unsigned char*)lds;
    volatile LAS unsigned* MISC = (volatile LAS unsigned*)(L + MISC_OFF);
    const int tid = threadIdx.x, lane = tid & 63, wave = __builtin_amdgcn_readfirstlane(tid >> 6);
    const int G = gridDim.x, bx = blockIdx.x, vcu = (G % 8 == 0) ? (bx % 8) * (G / 8) + bx / 8 : bx;
    unsigned char* ws = args.ws;
    gu32* ctl = (gu32*)(ws + WS_CTL);
    const int lo = args.ph_lo, hi = args.ph_hi;
    for (int u = tid; u < 64; u += NWAVES * 64) MISC[u] = 0u;
    __syncthreads();
    XcdBarrier bar; bar.bar = (unsigned*)(ctl + CW_BAR); bar.x = 0; bar.st = nullptr;
    const bool use_bar = (hi - lo) > 1;
    if (use_bar) bar = xcd_barrier_post((unsigned*)(ctl + CW_BAR), MISC + 8);
#ifndef PHASE_MASK
#define PHASE_MASK 0xFFFF
#endif
#define IN(k) (((PHASE_MASK >> (k)) & 1) && lo <= (k) && (k) < hi)
#ifndef REPMASK
#define REPMASK 0
#endif
#define NREP(k) (1 + ((REPMASK >> (k)) & 1))
#define SEAM(k) do { if (IN(k) && IN((k) + 1)) xcd_barrier(bar); } while (0)
    const int gw = vcu * NWAVES + wave, NGW = G * NWAVES;
    float* ROPE = (float*)(ctl + CW_ROPE);
    float* MODP = (float*)(ws + WS_MODP); float* MOD = (float*)(ws + WS_MODP + 512 * 1024); float* SSQ = (float*)(ws + WS_SSQ); unsigned* CNT = (unsigned*)(ctl + CW_CNT);
    bf16_t* WINT = (bf16_t*)(ws + WS_WIN); bf16_t* WUQT = (bf16_t*)(ws + WS_WUQ); bf16_t* WUKVT = (bf16_t*)(ws + WS_WUKV);
    bf16_t* WNAT = (bf16_t*)(ws + WS_WNA); bf16_t* WMLAT = (bf16_t*)(ws + WS_WMLA); bf16_t* WOUTT = (bf16_t*)(ws + WS_WOUT);
    bf16_t* W1T = (bf16_t*)(ws + WS_W1); bf16_t* W2T = (bf16_t*)(ws + WS_W2);
    bf16_t* XN = (bf16_t*)(ws + WS_XN); bf16_t* PROJ = (bf16_t*)(ws + WS_PROJ);
    bf16_t* QN = (bf16_t*)(ws + WS_QN); bf16_t* QR = (bf16_t*)(ws + WS_QR); bf16_t* KN = (bf16_t*)(ws + WS_KN); bf16_t* KR = (bf16_t*)(ws + WS_KR); bf16_t* VM = (bf16_t*)(ws + WS_VM);
    bf16_t* ONA = (bf16_t*)(ws + WS_ONA); bf16_t* OMLA = (bf16_t*)(ws + WS_OMLA); bf16_t* MERGED = (bf16_t*)(ws + WS_MERGED);
    float* TMP = (float*)(ws + WS_TMP); unsigned* LIST = (unsigned*)(ws + WS_LIST); unsigned* TOKPOS = (unsigned*)(ws + WS_TOKPOS); float* TOKG = (float*)(ws + WS_TOKG);
    bf16_t* ACT = (bf16_t*)(ws + WS_ACT); bf16_t* YIT = (bf16_t*)(ws + WS_YIT);
    const float* X = args.in[I_X]; float* OUT = args.out;

    if (IN(0)) for (int rep_ = 0; rep_ < NREP(0); ++rep_) {
        LAS unsigned char* scr = L + wave * 16384;
        {   const float* c = args.in[I_C]; const float* wada = args.in[I_WADA]; const float* bada = args.in[I_BADA];
            for (int it = gw; it < 96 * 8; it += NGW) { const int nb = it % 96, kc = it / 96, n = nb * 64 + lane;
                float a0 = 0.f, a1 = 0.f;
#pragma unroll 8
                for (int k = 0; k < 128; ++k) { const int kk = kc * 128 + k; const float w = wada[(size_t)kk * 6144 + n];
                    const float c0 = c[kk], c1 = c[1024 + kk]; a0 += (c0 * sigmoidf_(c0)) * w; a1 += (c1 * sigmoidf_(c1)) * w; }
                if (kc == 0) { a0 += bada[n]; a1 += bada[n]; }
                MODP[(kc * 2 + 0) * 6144 + n] = a0; MODP[(kc * 2 + 1) * 6144 + n] = a1; } }
        if (bx == 0) { for (int i = tid; i < 128 * 8; i += NWAVES * 64) { const int pos = i >> 3, j = i & 7; float c, sn; rope_cs((float)pos, j, c, sn); ROPE[pos * 16 + j] = c; ROPE[pos * 16 + 8 + j] = sn; } }
        if (bx == 1 % G) { const float* Wr = args.in[I_WR]; float* WRT = (float*)(ws + WS_WRT); for (int i = tid; i < NEXP * 1024; i += NWAVES * 64) WRT[i] = Wr[(size_t)(i & 1023) * 32 + (i >> 10)]; }
        {   constexpr int I_WIN_ = 16 * 68, I_UQ = 6 * 12, I_UKV = 4 * 16, I_UP = 8 * 16, I_OUT = 16 * 16, I_W1_ = NEXP * 16 * 32, I_W2_ = NEXP * 16 * 16;
            constexpr int NITEMS = I_WIN_ + I_UQ + I_UKV + 2 * I_UP + I_OUT + I_W1_ + I_W2_;
            for (int it = gw; it < NITEMS; it += NGW) {
                int r = it;
                if (r < I_W1_) { const int e = r / 512, q = r % 512, kb = q / 32, nb = q % 32;
                    tr_tile_fast(args.in[I_W1] + (size_t)e * 1024 * 2048, 2048, nb * 64, nullptr, W1T + (size_t)e * 2048 * 1024, 1024, nb * 64, kb * 64, scr, lane); continue; } r -= I_W1_;
                if (r < I_W2_) { const int e = r / 256, q = r % 256, kb = q / 16, nb = q % 16;
                    tr_tile_fast(args.in[I_W2] + (size_t)e * 1024 * 1024, 1024, nb * 64, nullptr, W2T + (size_t)e * 1024 * 1024, 1024, nb * 64, kb * 64, scr, lane); continue; } r -= I_W2_;
                if (r < I_WIN_) { const int kb = r / 68, nb = r % 68;
                    if (nb < 34) tr_tile_fast(args.in[I_WIN], 4256, nb * 64, nullptr, WINT, 1024, nb * 64, kb * 64, scr, lane);
                    else if (nb >= 36) tr_tile_fast(args.in[I_WIN], 4256, 2208 + (nb - 36) * 64, nullptr, WINT, 1024, nb * 64, kb * 64, scr, lane);
                    else { const int n = nb * 64 + lane; const int sc = (n < 2208) ? 2176 + rope_orig(n - 2176) : -1;
                        tr_tile_slow(args.in[I_WIN], 4256, sc, nullptr, WINT, 1024, nb * 64, kb * 64, scr, lane); }
                    continue; } r -= I_WIN_;
                if (r < I_UQ) { const int kb = r / 12, nb = r % 12;
                    if (nb < 8) tr_tile_fast(args.in[I_WUQ], 768, nb * 96, args.in[I_QNG], WUQT, 384, nb * 64, kb * 64, scr, lane);
                    else { const int n = nb * 64 + lane - 512, h = n >> 5, p = n & 31;
                        tr_tile_slow(args.in[I_WUQ], 768, h * 96 + 64 + rope_orig(p), args.in[I_QNG], WUQT, 384, nb * 64, kb * 64, scr, lane); }
                    continue; } r -= I_UQ;
                if (r < I_UKV) { const int kb = r / 16, nb = r % 16;
                    const int s0 = (nb < 8) ? nb * 128 : (nb - 8) * 128 + 64;
                    tr_tile_fast(args.in[I_WUKV], 1024, s0, args.in[I_KVNG], WUKVT, 256, nb * 64, kb * 64, scr, lane); continue; } r -= I_UKV;
                if (r < I_UP) { const int kb = r / 16, nb = r % 16; tr_tile_fast(args.in[I_WNAUP], 1024, nb * 64, nullptr, WNAT, 512, nb * 64, kb * 64, scr, lane); continue; } r -= I_UP;
                if (r < I_UP) { const int kb = r / 16, nb = r % 16; tr_tile_fast(args.in[I_WMLAUP], 1024, nb * 64, nullptr, WMLAT, 512, nb * 64, kb * 64, scr, lane); continue; } r -= I_UP;
                { const int kb = r / 16, nb = r % 16; tr_tile_fast(args.in[I_WOUT], 1024, nb * 64, nullptr, WOUTT, 1024, nb * 64, kb * 64, scr, lane); }
            } }
    }
    SEAM(0);
    if (IN(1)) {
        const float* g = args.in[I_GAPRE];
        LAS float* modl = (LAS float*)L;
        for (int i = tid; i < 4096; i += NWAVES * 64) { const int b = i >> 11, c = i & 2047; float sm = 0.f;
#pragma unroll
            for (int kc = 0; kc < 8; ++kc) sm += MODP[(kc * 2 + b) * 6144 + c];
            modl[i] = sm; }
        for (int idx = bx * (NWAVES * 64) + tid; idx < 2 * 6144; idx += G * NWAVES * 64) { const int b = idx / 6144, n = idx % 6144; float sm = 0.f;
#pragma unroll
            for (int kc = 0; kc < 8; ++kc) sm += MODP[(kc * 2 + b) * 6144 + n];
            MOD[idx] = sm; }
        __syncthreads();
        for (int m = gw; m < MTOK; m += NGW) { const int b = m >> 13;
            const GAS f32x4* xr = (const GAS f32x4*)(X + (size_t)m * DM) + lane; f32x4 v[4]; float s = 0.f;
#pragma unroll
            for (int j = 0; j < 4; ++j) { v[j] = xr[64 * j]; s += (v[j].x * v[j].x + v[j].y * v[j].y) + (v[j].z * v[j].z + v[j].w * v[j].w); }
            const float rstd = __builtin_amdgcn_rsqf(wave_sum(s) * (1.f / DM) + RMS_EPS);
            GAS u32x2* o8 = (GAS u32x2*)(XN + (size_t)m * DM) + lane;
#pragma unroll
            for (int j = 0; j < 4; ++j) { const int col = 4 * lane + 256 * j;
                const f32x4 gg = *(const f32x4*)(g + col), sh = *(const LAS f32x4*)(modl + b * 2048 + col), scl = *(const LAS f32x4*)(modl + b * 2048 + 1024 + col);
                const f32x4 h = v[j] * rstd * gg * (scl + 1.f) + sh; u32x2 w; w.x = cvt_pk_bf16(h[0], h[1]); w.y = cvt_pk_bf16(h[2], h[3]); o8[64 * j] = w; } }
    }
    SEAM(1);
    if (IN(2)) for (int rep_ = 0; rep_ < NREP(2); ++rep_) {
        pg8::SchedDense S{(const char*)XN, (const char*)WINT, (size_t)256 * 1024 * 2, (size_t)256 * 1024 * 2, MTOK / 256, NPROJ / 256, G, bx};
        pg8::EpiInProj E{PROJ, SSQ, KR, ROPE};
        pg8::gemm_phase<pg8::EpiInProj, pg8::SchedDense, true, false>(L, 1024, 1024, S, E);
    }
    SEAM(2);
    if (IN(3)) for (int rep_ = 0; rep_ < NREP(3); ++rep_) {
#ifndef NO_QUP
        {   pg8::SchedDense S{(const char*)(PROJ + 1536), (const char*)WUQT, (size_t)256 * NPROJ * 2, (size_t)256 * 384 * 2, MTOK / 256, 3, G, bx};
            pg8::EpiQUp E{QN, QR, SSQ, ROPE};
            pg8::gemm_phase<pg8::EpiQUp, pg8::SchedDense, true, false>(L, 384, NPROJ, S, E); }
#endif
#ifndef NO_KVUP
        {   pg8::SchedDense S{(const char*)(PROJ + 1920), (const char*)WUKVT, (size_t)256 * NPROJ * 2, (size_t)256 * 256 * 2, MTOK / 256, 4, G, G - 1 - bx};
            pg8::EpiKVUp E{KN, VM, SSQ};
            pg8::gemm_phase<pg8::EpiKVUp, pg8::SchedDense, true, false>(L, 256, NPROJ, S, E); }
#endif
    }
    SEAM(3);
    if (IN(4)) for (int rep_ = 0; rep_ < NREP(4); ++rep_) {
#ifndef NO_MLA
        for (int u = vcu; u < 512; u += G) {
            const int bh = u >> 5, qb = u & 31, b = bh >> 3, h = bh & 7; const size_t row0 = (size_t)b * SEQ + qb * 256, key0 = (size_t)b * SEQ;
            attn::attn_unit<0>(QN + row0 * 512 + h * 64, 512, QR + row0 * 256 + h * 32, 256, KN + key0 * 512 + h * 64, 512, KR + key0 * 32, 32, VM + key0 * 512 + h * 64, 512,
                               OMLA + row0 * 512 + h * 64, 128, 0, 128, 0, nullptr, (char*)lds);
        }
#endif
#ifndef NO_NA
        for (int u = vcu; u < 512; u += G) {
            const int bh = u >> 5, rb = u & 31, b = bh >> 3, h = bh & 7; const size_t row0 = (size_t)b * SEQ + rb * 256, key0 = (size_t)b * SEQ;
            const int krow0 = min(max(4 * rb - 4, 0), 120), klast = min(max(4 * rb + 3 - 4, 0), 120) + 7, ntreal = klast - krow0 + 1, NT = (ntreal + 1) & ~1;
            attn::attn_unit<1>(PROJ + row0 * NPROJ + h * 64, NPROJ, nullptr, 0, PROJ + key0 * NPROJ + 512 + h * 64, NPROJ, nullptr, 0, PROJ + key0 * NPROJ + 1024 + h * 64, NPROJ,
                               ONA + row0 * 512 + h * 64, NT, krow0, ntreal, 4 * rb, args.in[I_RPB] + h * 15 * 31, (char*)lds);
        }
#endif
    }
    SEAM(4);
    if (IN(5)) for (int rep_ = 0; rep_ < NREP(5); ++rep_) {
        pg8::SchedMerge S{(const char*)ONA, (const char*)OMLA, (const char*)WNAT, (const char*)WMLAT, MTOK / 256, 4, G, bx};
        pg8::EpiMerge E{PROJ, args.in[I_BGATE], TMP, MERGED};
        pg8::gemm_phase<pg8::EpiMerge, pg8::SchedMerge, true, false>(L, 512, 512, S, E);
    }
    SEAM(5);
    if (IN(6)) for (int rep_ = 0; rep_ < NREP(6); ++rep_) {
        pg8::SchedDense S{(const char*)MERGED, (const char*)WOUTT, (size_t)256 * 1024 * 2, (size_t)256 * 1024 * 2, MTOK / 256, 4, G, bx};
        pg8::EpiF32 E{TMP, 1024};
        pg8::gemm_phase<pg8::EpiF32, pg8::SchedDense, true, false>(L, 1024, 1024, S, E);
    }
    SEAM(6);
    if (IN(7)) {
        LAS int* sel_e = (LAS int*)(L + 0); LAS float* sel_g = (LAS float*)(L + 1024); LAS int* sel_r = (LAS int*)(L + 2048);
        LAS int* lcnt = (LAS int*)(L + 3072); LAS int* lbase = (LAS int*)(L + 3072 + 128);
        const float* gpo = args.in[I_GAPOST]; const float* gfp = args.in[I_GFPRE]; const float* br = args.in[I_BR];
        const float* WRT = (const float*)(ws + WS_WRT);
        for (int blk = vcu; blk < MTOK / 64; blk += G) {
            if (tid < 32) lcnt[tid] = 0;
            __syncthreads();
            f32x4 hreg[8][4];
#pragma unroll
            for (int rr = 0; rr < 8; ++rr) { const int m = blk * 64 + wave * 8 + rr, b = m >> 13;
                const GAS f32x4* yr = (const GAS f32x4*)(TMP + (size_t)m * DM) + lane; const GAS f32x4* xr = (const GAS f32x4*)(X + (size_t)m * DM) + lane;
                f32x4 y[4], x1[4]; float s = 0.f;
#pragma unroll
                for (int j = 0; j < 4; ++j) { y[j] = yr[64 * j]; x1[j] = xr[64 * j]; s += (y[j].x * y[j].x + y[j].y * y[j].y) + (y[j].z * y[j].z + y[j].w * y[j].w); }
                const float rstd = __builtin_amdgcn_rsqf(wave_sum(s) * (1.f / DM) + RMS_EPS); float s2 = 0.f;
#pragma unroll
                for (int j = 0; j < 4; ++j) { const int col = 4 * lane + 256 * j;
                    const f32x4 gg = *(const f32x4*)(gpo + col), ga = *(const f32x4*)(MOD + b * 6144 + 2048 + col);
                    x1[j] = x1[j] + ga * (y[j] * rstd * gg);
                    *((GAS f32x4*)(OUT + (size_t)m * DM) + lane + 64 * j) = x1[j];
                    s2 += (x1[j].x * x1[j].x + x1[j].y * x1[j].y) + (x1[j].z * x1[j].z + x1[j].w * x1[j].w); }
                const float rstd2 = __builtin_amdgcn_rsqf(wave_sum(s2) * (1.f / DM) + RMS_EPS);
                GAS u32x2* o8 = (GAS u32x2*)(XN + (size_t)m * DM) + lane;
#pragma unroll
                for (int j = 0; j < 4; ++j) { const int col = 4 * lane + 256 * j;
                    const f32x4 gg = *(const f32x4*)(gfp + col), sh = *(const f32x4*)(MOD + b * 6144 + 3072 + col), scl = *(const f32x4*)(MOD + b * 6144 + 4096 + col);
                    const f32x4 h = x1[j] * rstd2 * gg * (scl + 1.f) + sh; u32x2 w; w.x = cvt_pk_bf16(h[0], h[1]); w.y = cvt_pk_bf16(h[2], h[3]); o8[64 * j] = w;
                    hreg[rr][j] = h; }
            }
            const bool b5 = (lane & 32) != 0, b4 = (lane & 16) != 0, b3 = (lane & 8) != 0;
            float t0 = -3.0e38f, t1 = -3.0e38f, t2 = -3.0e38f, t3 = -3.0e38f; int i0 = 0, i1 = 0, i2 = 0, i3 = 0;
#pragma unroll 2
            for (int e = 0; e < NEXP; ++e) {
                f32x4 w[4];
#pragma unroll
                for (int j = 0; j < 4; ++j) w[j] = *(const GAS f32x4*)(WRT + e * 1024 + 4 * lane + 256 * j);
                float p[8];
#pragma unroll
                for (int r = 0; r < 8; ++r) { f32x4 a = hreg[r][0] * w[0]; a += hreg[r][1] * w[1]; a += hreg[r][2] * w[2]; a += hreg[r][3] * w[3]; p[r] = (a.x + a.y) + (a.z + a.w); }
                float q[4], u[2];
#pragma unroll
                for (int i = 0; i < 4; ++i) { const float keep = b5 ? p[i + 4] : p[i], send = b5 ? p[i] : p[i + 4]; q[i] = keep + __shfl_xor(send, 32); }
#pragma unroll
                for (int i = 0; i < 2; ++i) { const float keep = b4 ? q[i + 2] : q[i], send = b4 ? q[i] : q[i + 2]; u[i] = keep + __shfl_xor(send, 16); }
                float v = (b3 ? u[1] : u[0]) + __shfl_xor(b3 ? u[0] : u[1], 8);
                v += __shfl_xor(v, 4); v += __shfl_xor(v, 2); v += __shfl_xor(v, 1);
                v += br[e];
                const bool c0 = v > t0, c1 = v > t1, c2 = v > t2, c3 = v > t3;
                t3 = c2 ? t2 : (c3 ? v : t3); i3 = c2 ? i2 : (c3 ? e : i3);
                t2 = c1 ? t1 : (c2 ? v : t2); i2 = c1 ? i1 : (c2 ? e : i2);
                t1 = c0 ? t0 : (c1 ? v : t1); i1 = c0 ? i0 : (c1 ? e : i1);
                t0 = c0 ? v : t0;             i0 = c0 ? e : i0;
            }
            {   const float e1 = __builtin_amdgcn_exp2f((t1 - t0) * LOG2E), e2 = __builtin_amdgcn_exp2f((t2 - t0) * LOG2E), e3 = __builtin_amdgcn_exp2f((t3 - t0) * LOG2E);
                const float inv = 1.f / (1.f + e1 + e2 + e3);
                const int lrow = wave * 8 + (b5 ? 4 : 0) + (b4 ? 2 : 0) + (b3 ? 1 : 0), t = lane & 7;
                if (t < 4) { const int ee = t == 0 ? i0 : t == 1 ? i1 : t == 2 ? i2 : i3;
                    const float gg = (t == 0 ? 1.f : t == 1 ? e1 : t == 2 ? e2 : e3) * inv;
                    const int rk = __hip_atomic_fetch_add(&lcnt[ee], 1, __ATOMIC_RELAXED, __HIP_MEMORY_SCOPE_WORKGROUP);
                    sel_e[lrow * 4 + t] = ee; sel_g[lrow * 4 + t] = gg; sel_r[lrow * 4 + t] = rk; } }
            __syncthreads();
            if (tid < 32) lbase[tid] = (int)atomicAdd(CNT + tid, (unsigned)lcnt[tid]);
            __syncthreads();
            if (tid < 256) { const int ee = sel_e[tid], pos = lbase[ee] + sel_r[tid], tok = blk * 64 + (tid >> 2);
                LIST[(size_t)ee * LISTCAP + pos] = (unsigned)tok; TOKPOS[(size_t)tok * 4 + (tid & 3)] = ((unsigned)ee << 16) | (unsigned)pos; TOKG[(size_t)tok * 4 + (tid & 3)] = sel_g[tid]; }
            __syncthreads();
        }
    }
    SEAM(7);
    if (IN(8) || IN(9)) {
        LAS int* blk_e = (LAS int*)(L + TAB_BLK);
        if (tid == 0) { int nb = 0; for (int e = 0; e < NEXP; ++e) { const int c = (int)__hip_atomic_load(CNT + e, RLX_AGENT); const int n = (c + 255) >> 8; for (int i = 0; i < n; ++i) blk_e[nb + i] = e; nb += n; } MISC[16] = (unsigned)nb; }
        __syncthreads();
        const int NB = (int)MISC[16];
        if (IN(8)) for (int rep_ = 0; rep_ < NREP(8); ++rep_) {
            for (int i = 0;; ++i) { const long Lu = (long)i * G + bx; if (Lu >= (long)NB * 8 || i >= 11) break;
                const int grb = (int)(Lu >> 3), e = blk_e[grb]; int first = grb; while (first > 0 && blk_e[first - 1] == e) --first;
                const int cnt = (int)__hip_atomic_load(CNT + e, RLX_AGENT);
                if (tid < 256) { const int ri = (grb - first) * 256 + tid; const unsigned tok = (ri < cnt) ? LIST[(size_t)e * LISTCAP + ri] : 0u;
                    *(LAS unsigned*)(L + TAB_GATH + i * 1024 + tid * 4) = tok * 2048u; } }
            __syncthreads();
            pg8::SchedMoe<8, true> S{(const char*)XN, (const char*)W1T, (size_t)2048 * 1024 * 2, blk_e, NB, G, bx, TAB_GATH};
            pg8::EpiMoe1 E{args.in[I_B1], ACT};
            pg8::gemm_phase<pg8::EpiMoe1, pg8::SchedMoe<8, true>, true, true>(L, 1024, 1024, S, E);
        }
        SEAM(8);
        if (IN(9)) for (int rep_ = 0; rep_ < NREP(9); ++rep_) {
            pg8::SchedMoe<4, false> S{(const char*)ACT, (const char*)W2T, (size_t)1024 * 1024 * 2, blk_e, NB, G, bx, 0};
            pg8::EpiMoe2 E{args.in[I_B2], YIT};
            pg8::gemm_phase<pg8::EpiMoe2, pg8::SchedMoe<4, false>, true, false>(L, 1024, 1024, S, E);
        }
    }
    SEAM(9);
    if (IN(10)) {
        LAS int* rbase = (LAS int*)(L + 0);
        if (tid == 0) { int nb = 0; for (int e = 0; e < NEXP; ++e) { rbase[e] = nb * 256; nb += ((int)__hip_atomic_load(CNT + e, RLX_AGENT) + 255) >> 8; } }
        __syncthreads();
        const float* gfo = args.in[I_GFPOST];
        for (int m = gw; m < MTOK; m += NGW) { const int b = m >> 13;
            f32x4 y[4];
#pragma unroll
            for (int j = 0; j < 4; ++j) y[j] = (f32x4){0.f, 0.f, 0.f, 0.f};
#pragma unroll
            for (int t = 0; t < 4; ++t) { const unsigned tp = TOKPOS[(size_t)m * 4 + t]; const float gt = TOKG[(size_t)m * 4 + t];
                const size_t row = (size_t)rbase[tp >> 16] + (tp & 0xffffu); const GAS u32x2* yr = (const GAS u32x2*)(YIT + row * 1024) + lane;
#pragma unroll
                for (int j = 0; j < 4; ++j) { const u32x2 w = yr[64 * j]; y[j][0] += gt * bf16_lo(w.x); y[j][1] += gt * bf16_hi(w.x); y[j][2] += gt * bf16_lo(w.y); y[j][3] += gt * bf16_hi(w.y); } }
            float s = 0.f;
#pragma unroll
            for (int j = 0; j < 4; ++j) s += (y[j].x * y[j].x + y[j].y * y[j].y) + (y[j].z * y[j].z + y[j].w * y[j].w);
            const float rstd = __builtin_amdgcn_rsqf(wave_sum(s) * (1.f / DM) + RMS_EPS);
            GAS f32x4* orow = (GAS f32x4*)(OUT + (size_t)m * DM) + lane;
#pragma unroll
            for (int j = 0; j < 4; ++j) { const int col = 4 * lane + 256 * j;
                const f32x4 gg = *(const f32x4*)(gfo + col), gf = *(const f32x4*)(MOD + b * 6144 + 5120 + col);
                orow[64 * j] = orow[64 * j] + gf * (y[j] * rstd * gg); } }
    }
#undef IN
#undef SEAM
}

constexpr int N_PHASES = 11;
extern "C" void kernel_launch(void* const* d_in, const int* in_sizes, int n_in, void* d_out, int out_size, void* d_ws, size_t ws_size, hipStream_t stream) {
    static int grid = 0;
    if (grid == 0) {
        if (n_in != 24 || out_size != MTOK * DM || ws_size < WS_END) { fprintf(stderr, "kernel_launch: unexpected shapes (n_in %d out %d ws %zu)\n", n_in, out_size, ws_size); grid = -1; return; }
        int dev = 0, cus = 0, per_cu = 0;
        if (hipGetDevice(&dev) != hipSuccess || hipDeviceGetAttribute(&cus, hipDeviceAttributeMultiprocessorCount, dev) != hipSuccess) { grid = -1; return; }
        if (hipFuncSetAttribute((const void*)fwd_kernel, hipFuncAttributeMaxDynamicSharedMemorySize, LDS_BYTES) != hipSuccess) { fprintf(stderr, "kernel_launch: hipFuncSetAttribute failed\n"); grid = -1; return; }
        if (hipOccupancyMaxActiveBlocksPerMultiprocessor(&per_cu, (const void*)fwd_kernel, NWAVES * 64, LDS_BYTES) != hipSuccess || per_cu < 1) { fprintf(stderr, "kernel_launch: occupancy query says %d\n", per_cu); per_cu = 1; }
        (void)hipGetLastError();
        grid = cus;
    }
    if (grid < 0) return;
    (void)hipMemsetAsync((char*)d_ws + WS_CTL, 0, CTL_ZERO_BYTES, stream);
    Args a{};
    for (int i = 0; i < 24; ++i) a.in[i] = (const float*)d_in[i];
    a.out = (float*)d_out; a.ws = (unsigned char*)d_ws;
#if MK_N_LAUNCHES == 1
    a.ph_lo = 0; a.ph_hi = N_PHASES;
    {   void* kargs[] = {(void*)&a};
        const hipError_t ce = hipLaunchCooperativeKernel((const void*)fwd_kernel, dim3(grid), dim3(NWAVES * 64), kargs, LDS_BYTES, stream);
        if (ce != hipSuccess) fprintf(stderr, "kernel_launch: cooperative launch failed: %s (grid %d)\n", hipGetErrorName(ce), grid); }
#else
    for (int p = 0; p < N_PHASES; ++p) { a.ph_lo = p; a.ph_hi = p + 1; hipLaunchKernelGGL(fwd_kernel, dim3(grid), dim3(NWAVES * 64), LDS_BYTES, stream, a); }
#endif
    const hipError_t le = hipPeekAtLastError();
    if (le != hipSuccess) fprintf(stderr, "kernel_launch: launch failed: %s\n", hipGetErrorName(le));
}
```

```cpp
#include <hip/hip_runtime.h>
#include <hip/hip_bf16.h>
#include <cstdio>
#include <cstdint>

#ifndef MK_N_LAUNCHES
#define MK_N_LAUNCHES 1
#endif

constexpr int BATCH = 2, SEQ = 8192, DM = 1024, MTOK = BATCH * SEQ;
constexpr int NPROJ = 4352;
constexpr int NEXP = 32, DFF = 1024, TOPK = 4;
constexpr int QLORA = 384, KVLORA = 256;
constexpr float RMS_EPS = 1e-6f;
constexpr float LOG2E = 1.4426950408889634f;
constexpr float C2NA = 0.125f * LOG2E;
constexpr float C2MLA = 0.10206207261596575f * LOG2E;
constexpr float SC_H2 = 8.f, SC_W = 64.f, SC_ACT = 4.f;
constexpr int LISTCAP = 16384;
constexpr int MAXROWS = 65536 + NEXP * 256;

#define GAS __attribute__((address_space(1)))
#define LAS __attribute__((address_space(3)))
typedef unsigned short bf16_t;
typedef short bf16x8 __attribute__((ext_vector_type(8)));
typedef short s16x4 __attribute__((ext_vector_type(4)));
typedef float f32x4 __attribute__((ext_vector_type(4)));
typedef float f32x2 __attribute__((ext_vector_type(2)));
typedef float f32x16 __attribute__((ext_vector_type(16)));
typedef unsigned u32x4 __attribute__((ext_vector_type(4)));
typedef unsigned u32x2 __attribute__((ext_vector_type(2)));
typedef GAS unsigned gu32;

__device__ __forceinline__ unsigned cvt_pk_bf16(float lo, float hi) { unsigned r; asm volatile("v_cvt_pk_bf16_f32 %0, %1, %2" : "=v"(r) : "v"(lo), "v"(hi)); return r; }
__device__ __forceinline__ float bf16_lo(unsigned w) { return __uint_as_float(w << 16); }
__device__ __forceinline__ float bf16_hi(unsigned w) { return __uint_as_float(w & 0xffff0000u); }
__device__ __forceinline__ float sigmoidf_(float z) { return __builtin_amdgcn_rcpf(1.f + __builtin_amdgcn_exp2f(-z * LOG2E)); }
__device__ __forceinline__ float wave_sum(float v) {
#pragma unroll
    for (int o = 1; o < 64; o <<= 1) v += __shfl_xor(v, o);
    return v;
}
__device__ __forceinline__ void rope_cs(float pos, int j, float& c, float& s) {
    const float inv = __builtin_amdgcn_exp2f(-(float)j * 0.83048202372184059f);
    const float rev = __builtin_amdgcn_fractf(pos * inv * 0.15915494309189535f);
    c = __builtin_amdgcn_cosf(rev); s = __builtin_amdgcn_sinf(rev);
}

namespace pg8 {
constexpr int BM = 256, BK = 64, HALF = 128, HTB = HALF * BK * 2, STAGE_BYTES = 8 * HTB, NXCD = 8, WGM = 8;
__host__ __device__ __forceinline__ int lds_byte(int r, int c) { const int st = (r >> 4) * 2 + (c >> 5), rr = r & 15, cc = c & 31, ob = rr * 64 + cc * 2; return st * 1024 + (ob ^ (((ob >> 9) & 1) << 5)); }
__host__ __device__ __forceinline__ void stage_rc(int b, int& R, int& C) { const int st = b / 1024, sb = b % 1024, swz = sb ^ (((sb >> 9) & 1) << 5); R = (st >> 1) * 16 + swz / 64; C = (st & 1) * 32 + (swz % 64) / 2; }
__host__ __device__ __forceinline__ int perm32(int rho) { const int n = rho >> 4, i = rho & 15; return 8 * (i >> 2) + 4 * n + (i & 3); }

struct Unit { const char* A; const char* B; int pm, pn, aux, tab; };

__device__ __forceinline__ void tile_of(int wgid, int nM, int nN, int& pm, int& pn) {
    const int nwg = nM * nN;
    { const int q = nwg / NXCD, r = nwg % NXCD, xcd = wgid % NXCD, off = wgid / NXCD; wgid = (xcd < r ? xcd * (q + 1) : r * (q + 1) + (xcd - r) * q) + off; }
    const int nig = WGM * nN, gid = wgid / nig, fm = gid * WGM, gsz = (nM - fm) < WGM ? (nM - fm) : WGM;
    pm = fm + ((wgid % nig) % gsz); pn = (wgid % nig) / gsz;
}

typedef int v8i32 __attribute__((ext_vector_type(8)));
typedef int v4i32_ __attribute__((ext_vector_type(4)));
template <class Epi, class Sched, bool ALIGN_EPI, bool GATHER, bool FP8>
__device__ __forceinline__ void gemm_phase(LAS unsigned char* lds, const int nt, const int ldab, const int ldbb, const Sched& S, const Epi& E) {
    const int tid = threadIdx.x, wid = __builtin_amdgcn_readfirstlane(tid >> 6), lane = tid & 63, wr = wid >> 2, wc = wid & 3, fr = lane & 15, fq = lane >> 4;
    int Rr[2], Cc[2];
    unsigned voffA[2], voffB[2];
#pragma unroll
    for (int i = 0; i < 2; ++i) { int R, C; stage_rc(tid * 16 + i * 8192, R, C); const int Rb = Epi::PERM ? ((R & ~31) + perm32(R & 31)) : R;
        Rr[i] = R; Cc[i] = C; voffA[i] = (unsigned)(R * ldab + C * 2); voffB[i] = (unsigned)(Rb * ldbb + C * 2); }
    const size_t kstep = (size_t)(BK * 2);
    const size_t hstepA = (size_t)HALF * ldab, hstepB = (size_t)HALF * ldbb;
    const unsigned ldsw = (unsigned)wid * 1024u;
    const int aoff = lds_byte(wr * 64 + fr, fq * 8), boff = lds_byte(wc * 32 + fr, fq * 8);
#define PG8_SA(b, h) (((b) * 2 + (h)) * HTB)
#define PG8_SB(b, h) ((4 + (b) * 2 + (h)) * HTB)
#define PG8_STAGE(bufoff, gbase, voff) do { _Pragma("unroll") for (int _i = 0; _i < 2; ++_i) \
        __builtin_amdgcn_global_load_lds((const unsigned*)((const char*)(gbase) + (voff)[_i]), (LAS unsigned*)(lds + (bufoff) + ldsw + _i * 8192), 16, 0, 0); } while (0)
#define PG8_STAGE_A(bufoff, gbase, h, G) do { if constexpr (GATHER) { PG8_STAGE(bufoff, gbase, (G)[h]); } else { PG8_STAGE(bufoff, (gbase) + (h) * hstepA, voffA); } } while (0)
#define PG8_STAGE_B(bufoff, gbase, h) PG8_STAGE(bufoff, (gbase) + (h) * hstepB, voffB)
#define PG8_LD8(addr) __builtin_shufflevector(*(const LAS v4i32_*)(addr), *(const LAS v4i32_*)((addr) + 1024), 0, 1, 2, 3, 4, 5, 6, 7)
#define PG8_LDA(dst, b, h) do { if constexpr (FP8) { _Pragma("unroll") for (int m = 0; m < 4; ++m) dst##8[m] = PG8_LD8(lds + PG8_SA(b, h) + aoff + m * 2048); } \
        else { _Pragma("unroll") for (int m = 0; m < 4; ++m) _Pragma("unroll") for (int k = 0; k < 2; ++k) dst[m][k] = *(const LAS bf16x8*)(lds + PG8_SA(b, h) + aoff + m * 2048 + k * 1024); } } while (0)
#define PG8_LDB(dst, b, h) do { if constexpr (FP8) { _Pragma("unroll") for (int n = 0; n < 2; ++n) dst##8[n] = PG8_LD8(lds + PG8_SB(b, h) + boff + n * 2048); } \
        else { _Pragma("unroll") for (int n = 0; n < 2; ++n) _Pragma("unroll") for (int k = 0; k < 2; ++k) dst[n][k] = *(const LAS bf16x8*)(lds + PG8_SB(b, h) + boff + n * 2048 + k * 1024); } } while (0)
#define PG8_MMA(ai, bj, At, Bt) do { __builtin_amdgcn_s_setprio(1); _Pragma("unroll") for (int m = 0; m < 4; ++m) _Pragma("unroll") for (int n = 0; n < 2; ++n) { \
        if constexpr (FP8) { asm volatile("v_mfma_scale_f32_16x16x128_f8f6f4 %0, %1, %2, %0, %3, %3 op_sel_hi:[0,0,0]" : "+v"(acc[ai][bj][m][n]) : "v"(Bt##8[n]), "v"(At##8[m]), "v"(sc1_)); } \
        else { _Pragma("unroll") for (int k = 0; k < 2; ++k) acc[ai][bj][m][n] = __builtin_amdgcn_mfma_f32_16x16x32_bf16(Bt[n][k], At[m][k], acc[ai][bj][m][n], 0, 0, 0); } } \
        __builtin_amdgcn_s_setprio(0); } while (0)
#define PG8_WAIT_V(n) asm volatile("s_waitcnt vmcnt(" #n ")" ::: "memory")
#define PG8_WAIT_L(n) asm volatile("s_waitcnt lgkmcnt(" #n ")" ::: "memory")
#define PG8_BAR __builtin_amdgcn_s_barrier()
#define PG8_SCHED __builtin_amdgcn_sched_barrier(0)
    Unit cur, nxt; int ui = 0;
    if (!S.next(0, cur)) return;
    f32x4 acc[2][2][4][2];
#pragma unroll
    for (int a = 0; a < 2; ++a)
#pragma unroll
        for (int b = 0; b < 2; ++b)
#pragma unroll
            for (int m = 0; m < 4; ++m)
#pragma unroll
                for (int n = 0; n < 2; ++n) acc[a][b][m][n] = (f32x4){0.f, 0.f, 0.f, 0.f};
    bf16x8 At[4][2], B0[2][2], B1[2][2]; v8i32 At8[4], B08[2], B18[2];
    int sc1_ = 0x7F7F7F7F; asm volatile("" : "+v"(sc1_));
    unsigned gC[2][2], gN[2][2];
#define PG8_GLOAD(G, u) do { if constexpr (GATHER) { const LAS unsigned* tb_ = (const LAS unsigned*)(lds + (u).tab); _Pragma("unroll") for (int h_ = 0; h_ < 2; ++h_) _Pragma("unroll") for (int i_ = 0; i_ < 2; ++i_) \
        (G)[h_][i_] = tb_[h_ * 128 + Rr[i_]] + (unsigned)(Cc[i_] * 2); } } while (0)
    PG8_GLOAD(gC, cur);
    const char* cA = cur.A; const char* cB = cur.B;
    PG8_STAGE_B(PG8_SB(0, 0), cB, 0); PG8_STAGE_B(PG8_SB(0, 1), cB, 1); PG8_STAGE_A(PG8_SA(0, 0), cA, 0, gC); PG8_STAGE_A(PG8_SA(0, 1), cA, 1, gC);
    if (wr == 1) PG8_BAR;
    PG8_WAIT_V(2); PG8_BAR;
    PG8_STAGE_B(PG8_SB(1, 0), cB + kstep, 0); PG8_STAGE_A(PG8_SA(1, 0), cA + kstep, 0, gC); PG8_STAGE_B(PG8_SB(1, 1), cB + kstep, 1);
    PG8_WAIT_V(6); PG8_BAR;
    for (;;) {
        const bool has_next = S.next(ui + 1, nxt);
        const char* nA = has_next ? nxt.A : cA; const char* nB = has_next ? nxt.B : cB;
        if constexpr (GATHER) { if (has_next) { PG8_GLOAD(gN, nxt); } else {
#pragma unroll
            for (int h_ = 0; h_ < 2; ++h_)
#pragma unroll
                for (int i_ = 0; i_ < 2; ++i_) gN[h_][i_] = gC[h_][i_]; } }
#pragma unroll 1
        for (int t = 0; t < nt; t += 2) {
            const bool last = (t == nt - 2);
            const char* a1 = cA + (size_t)(t + 1) * kstep;
            const char* a2 = last ? nA : cA + (size_t)(t + 2) * kstep; const char* b2 = last ? nB : cB + (size_t)(t + 2) * kstep;
            const char* a3 = a2 + kstep; const char* b3 = b2 + kstep;
            unsigned g2[2][2];
            if constexpr (GATHER) {
#pragma unroll
                for (int h_ = 0; h_ < 2; ++h_)
#pragma unroll
                    for (int i_ = 0; i_ < 2; ++i_) g2[h_][i_] = last ? gN[h_][i_] : gC[h_][i_]; }
            PG8_LDB(B0, 0, 0); PG8_LDB(B1, 0, 1); PG8_SCHED; PG8_LDA(At, 0, 0); PG8_STAGE_A(PG8_SA(1, 1), a1, 1, gC);
            PG8_WAIT_V(8); PG8_WAIT_L(0); PG8_BAR; PG8_MMA(0, 0, At, B0); PG8_MMA(0, 1, At, B1); PG8_BAR; PG8_SCHED;
            PG8_LDA(At, 0, 1); PG8_STAGE_B(PG8_SB(0, 0), b2, 0); PG8_STAGE_B(PG8_SB(0, 1), b2, 1); PG8_STAGE_A(PG8_SA(0, 0), a2, 0, g2);
            PG8_WAIT_V(8); PG8_WAIT_L(0); PG8_BAR; PG8_MMA(1, 0, At, B0); PG8_MMA(1, 1, At, B1); PG8_BAR; PG8_SCHED;
            PG8_LDB(B0, 1, 0); PG8_LDB(B1, 1, 1); PG8_SCHED; PG8_LDA(At, 1, 0); PG8_STAGE_A(PG8_SA(0, 1), a2, 1, g2);
            PG8_WAIT_V(8); PG8_WAIT_L(0); PG8_BAR; PG8_MMA(0, 0, At, B0); PG8_MMA(0, 1, At, B1); PG8_BAR; PG8_SCHED;
            PG8_LDA(At, 1, 1); PG8_STAGE_B(PG8_SB(1, 0), b3, 0); PG8_STAGE_B(PG8_SB(1, 1), b3, 1); PG8_STAGE_A(PG8_SA(1, 0), a3, 0, g2);
            PG8_WAIT_V(8); PG8_WAIT_L(0); PG8_BAR; PG8_MMA(1, 0, At, B0); PG8_MMA(1, 1, At, B1); PG8_BAR; PG8_SCHED;
        }
        if constexpr (ALIGN_EPI) { if (wr == 0) PG8_BAR; }
        if constexpr (FP8) asm volatile("s_nop 15\n\ts_nop 15" ::: "memory");
        E(acc, cur, wr, wc, fr, fq);
        if (!has_next) break;
#pragma unroll
        for (int a = 0; a < 2; ++a)
#pragma unroll
            for (int b = 0; b < 2; ++b)
#pragma unroll
                for (int m = 0; m < 4; ++m)
#pragma unroll
                    for (int n = 0; n < 2; ++n) acc[a][b][m][n] = (f32x4){0.f, 0.f, 0.f, 0.f};
        cur = nxt; cA = nA; cB = nB; ++ui;
        if constexpr (GATHER) {
#pragma unroll
            for (int h_ = 0; h_ < 2; ++h_)
#pragma unroll
                for (int i_ = 0; i_ < 2; ++i_) gC[h_][i_] = gN[h_][i_]; }
        if constexpr (ALIGN_EPI) { if (wr == 1) PG8_BAR; }
    }
    PG8_WAIT_V(0);
    if constexpr (!ALIGN_EPI) { if (wr == 0) PG8_BAR; }
    PG8_BAR;
#undef PG8_SA
#undef PG8_SB
#undef PG8_STAGE
#undef PG8_STAGE_A
#undef PG8_STAGE_B
#undef PG8_LDA
#undef PG8_LD8
#undef PG8_LDB
#undef PG8_MMA
#undef PG8_WAIT_V
#undef PG8_WAIT_L
#undef PG8_BAR
#undef PG8_SCHED
#undef PG8_GLOAD
}

typedef f32x4 Acc[2][2][4][2];

struct SchedDense {
    const char* A; const char* B; size_t a_tile_bytes, b_tile_bytes; int nM, nN, G, c;
    __device__ __forceinline__ bool next(int i, Unit& u) const {
        const long L = (long)i * G + c; if (L >= (long)nM * nN) return false;
        int pm, pn; tile_of((int)L, nM, nN, pm, pn);
        u.pm = pm; u.pn = pn; u.aux = 0; u.tab = 0; u.A = A + (size_t)pm * a_tile_bytes; u.B = B + (size_t)pn * b_tile_bytes; return true;
    }
};
struct SchedMerge {
    const char* A0; const char* A1; const char* B0; const char* B1; int nM, nN, G, c;
    __device__ __forceinline__ bool next(int i, Unit& u) const {
        const long T = (long)(i >> 1) * G + c; if (T >= (long)nM * nN) return false;
        int pm, pn; tile_of((int)T, nM, nN, pm, pn);
        const int sub = i & 1; u.pm = pm; u.pn = pn; u.aux = sub; u.tab = 0;
        u.A = (sub ? A1 : A0) + (size_t)pm * (256 * 512 * 2); u.B = (sub ? B1 : B0) + (size_t)pn * (256 * 512 * 2); return true;
    }
};
template <int NPN, bool GATHER>
struct SchedMoe {
    const char* A; const char* B; size_t b_expert_bytes; LAS const int* blk_e; int NB, G, c, tab0;
    __device__ __forceinline__ bool next(int i, Unit& u) const {
        const long L = (long)i * G + c; if (L >= (long)NB * NPN) return false;
        const int grb = (int)(L / NPN), pn = (int)(L % NPN);
        const int e = __builtin_amdgcn_readfirstlane(blk_e[grb]);
        u.pm = grb; u.pn = pn; u.aux = e; u.tab = tab0 + i * 1024;
        u.A = GATHER ? A : A + (size_t)grb * (256 * 1024);
        u.B = B + (size_t)e * b_expert_bytes + (size_t)pn * (256 * 1024); return true;
    }
};

struct EpiInProj {
    static constexpr bool PERM = true;
    bf16_t* PROJ; float* SSQ; bf16_t* KR; const float* ROPE;
    __device__ __forceinline__ void operator()(const Acc& acc, const Unit& u, int wr, int wc, int fr, int fq) const {
        const int pn = u.pn, row0 = u.pm * BM + wr * 64 + fr, colb = pn * BM + wc * 32 + 8 * fq;
        const float sc = (pn < 2) ? C2NA : 1.f;
#pragma unroll
        for (int ai = 0; ai < 2; ++ai)
#pragma unroll
            for (int m = 0; m < 4; ++m) { const int row = row0 + ai * HALF + m * 16; bf16_t* rowp = PROJ + (size_t)row * NPROJ + colb;
#pragma unroll
                for (int bj = 0; bj < 2; ++bj) { const f32x4 v0 = acc[ai][bj][m][0] * sc, v1 = acc[ai][bj][m][1] * sc; u32x4 w;
                    w.x = cvt_pk_bf16(v0[0], v0[1]); w.y = cvt_pk_bf16(v0[2], v0[3]); w.z = cvt_pk_bf16(v1[0], v1[1]); w.w = cvt_pk_bf16(v1[2], v1[3]);
                    *(u32x4*)(rowp + bj * HALF) = w; } }
        if (pn >= 6 && pn <= 8) {
#pragma unroll
            for (int ai = 0; ai < 2; ++ai)
#pragma unroll
                for (int m = 0; m < 4; ++m) { const int row = row0 + ai * HALF + m * 16; float s[2];
#pragma unroll
                    for (int bj = 0; bj < 2; ++bj) { const f32x4 a = acc[ai][bj][m][0], b = acc[ai][bj][m][1];
                        float t = (a[0] * a[0] + a[1] * a[1]) + (a[2] * a[2] + a[3] * a[3]) + (b[0] * b[0] + b[1] * b[1]) + (b[2] * b[2] + b[3] * b[3]);
                        t += __shfl_xor(t, 16); t += __shfl_xor(t, 32); s[bj] = t; }
                    if (fq == 0) {
                        float* sp = SSQ + (size_t)row * 16 + wc;
                        if (pn == 6) { sp[0] = s[0] + s[1]; }
                        else if (pn == 7) { sp[4] = s[0]; sp[8] = s[1]; }
                        else { sp[12] = s[0]; }
                    } }
            if (pn == 8 && wc == 0) {
#pragma unroll
                for (int ai = 0; ai < 2; ++ai)
#pragma unroll
                    for (int m = 0; m < 4; ++m) { const int row = row0 + ai * HALF + m * 16, tok = row & (SEQ - 1);
                        const int pos = (fq >> 1) ? (tok & 63) : (tok >> 6); float o[8];
                        const f32x4 cs4 = *(const f32x4*)(ROPE + pos * 16 + 4 * (fq & 1)), sn4 = *(const f32x4*)(ROPE + pos * 16 + 8 + 4 * (fq & 1));
#pragma unroll
                        for (int n = 0; n < 2; ++n)
#pragma unroll
                            for (int q = 0; q < 2; ++q) { const float c = cs4[2 * n + q], s = sn4[2 * n + q];
                                const float x1 = acc[ai][1][m][n][2 * q], x2 = acc[ai][1][m][n][2 * q + 1];
                                o[4 * n + 2 * q] = x1 * c - x2 * s; o[4 * n + 2 * q + 1] = x1 * s + x2 * c; }
                        u32x4 w; w.x = cvt_pk_bf16(o[0], o[1]); w.y = cvt_pk_bf16(o[2], o[3]); w.z = cvt_pk_bf16(o[4], o[5]); w.w = cvt_pk_bf16(o[6], o[7]);
                        *(u32x4*)(KR + (size_t)row * 32 + 8 * fq) = w; }
            }
        }
    }
};
struct EpiQUp {
    static constexpr bool PERM = true;
    bf16_t* QN; bf16_t* QR; const float* SSQ; const float* ROPE;
    __device__ __forceinline__ void operator()(const Acc& acc, const Unit& u, int wr, int wc, int fr, int fq) const {
        const int pn = u.pn, row0 = u.pm * BM + wr * 64 + fr, colt = wc * 32 + 8 * fq;
#pragma unroll
        for (int ai = 0; ai < 2; ++ai)
#pragma unroll
            for (int m = 0; m < 4; ++m) { const int row = row0 + ai * HALF + m * 16;
                const f32x4 q0_ = *(const f32x4*)(SSQ + (size_t)row * 16), q1_ = *(const f32x4*)(SSQ + (size_t)row * 16 + 4);
                const float rs = __builtin_amdgcn_rsqf((((q0_[0] + q0_[1]) + (q0_[2] + q0_[3])) + ((q1_[0] + q1_[1]) + (q1_[2] + q1_[3]))) * (1.f / QLORA) + RMS_EPS) * C2MLA;
                if (pn < 2) {
#pragma unroll
                    for (int bj = 0; bj < 2; ++bj) { const f32x4 v0 = acc[ai][bj][m][0] * rs, v1 = acc[ai][bj][m][1] * rs; u32x4 w;
                        w.x = cvt_pk_bf16(v0[0], v0[1]); w.y = cvt_pk_bf16(v0[2], v0[3]); w.z = cvt_pk_bf16(v1[0], v1[1]); w.w = cvt_pk_bf16(v1[2], v1[3]);
                        *(u32x4*)(QN + (size_t)row * 512 + pn * 256 + bj * HALF + colt) = w; }
                } else {
                    const int tok = row & (SEQ - 1); const int pos = (fq >> 1) ? (tok & 63) : (tok >> 6);
                    const f32x4 cs4 = *(const f32x4*)(ROPE + pos * 16 + 4 * (fq & 1)), sn4 = *(const f32x4*)(ROPE + pos * 16 + 8 + 4 * (fq & 1));
#pragma unroll
                    for (int bj = 0; bj < 2; ++bj) { float o[8];
#pragma unroll
                        for (int n = 0; n < 2; ++n)
#pragma unroll
                            for (int q = 0; q < 2; ++q) { const float c = cs4[2 * n + q], s = sn4[2 * n + q];
                                const float x1 = acc[ai][bj][m][n][2 * q] * rs, x2 = acc[ai][bj][m][n][2 * q + 1] * rs;
                                o[4 * n + 2 * q] = x1 * c - x2 * s; o[4 * n + 2 * q + 1] = x1 * s + x2 * c; }
                        u32x4 w; w.x = cvt_pk_bf16(o[0], o[1]); w.y = cvt_pk_bf16(o[2], o[3]); w.z = cvt_pk_bf16(o[4], o[5]); w.w = cvt_pk_bf16(o[6], o[7]);
                        *(u32x4*)(QR + (size_t)row * 256 + bj * HALF + colt) = w; }
                }
                asm volatile("" ::: "memory"); }
    }
};
struct EpiKVUp {
    static constexpr bool PERM = true;
    bf16_t* KN; bf16_t* VM; const float* SSQ;
    __device__ __forceinline__ void operator()(const Acc& acc, const Unit& u, int wr, int wc, int fr, int fq) const {
        const int pn = u.pn, row0 = u.pm * BM + wr * 64 + fr, colt = wc * 32 + 8 * fq;
        bf16_t* dst = (pn < 2) ? KN + pn * 256 : VM + (pn - 2) * 256;
#pragma unroll
        for (int ai = 0; ai < 2; ++ai)
#pragma unroll
            for (int m = 0; m < 4; ++m) { const int row = row0 + ai * HALF + m * 16;
                const f32x4 q0_ = *(const f32x4*)(SSQ + (size_t)row * 16 + 8), q1_ = *(const f32x4*)(SSQ + (size_t)row * 16 + 12);
                const float rs = __builtin_amdgcn_rsqf((((q0_[0] + q0_[1]) + (q0_[2] + q0_[3])) + ((q1_[0] + q1_[1]) + (q1_[2] + q1_[3]))) * (1.f / KVLORA) + RMS_EPS);
#pragma unroll
                for (int bj = 0; bj < 2; ++bj) { const f32x4 v0 = acc[ai][bj][m][0] * rs, v1 = acc[ai][bj][m][1] * rs; u32x4 w;
                    w.x = cvt_pk_bf16(v0[0], v0[1]); w.y = cvt_pk_bf16(v0[2], v0[3]); w.z = cvt_pk_bf16(v1[0], v1[1]); w.w = cvt_pk_bf16(v1[2], v1[3]);
                    *(u32x4*)(dst + (size_t)row * 512 + bj * HALF + colt) = w; } }
    }
};
struct EpiMerge {
    static constexpr bool PERM = true;
    const bf16_t* PROJ; const float* bgate; float* TMP; bf16_t* MERGED;
    __device__ __forceinline__ void operator()(const Acc& acc, const Unit& u, int wr, int wc, int fr, int fq) const {
        const int sub = u.aux, row0 = u.pm * BM + wr * 64 + fr, col0 = u.pn * BM + wc * 32 + 8 * fq;
        f32x4 bg[2][2];
#pragma unroll
        for (int bj = 0; bj < 2; ++bj)
#pragma unroll
            for (int n = 0; n < 2; ++n) bg[bj][n] = *(const f32x4*)(bgate + sub * 1024 + col0 + bj * HALF + 4 * n);
#pragma unroll
        for (int ai = 0; ai < 2; ++ai)
#pragma unroll
            for (int m = 0; m < 4; ++m) { const int row = row0 + ai * HALF + m * 16;
#pragma unroll
                for (int bj = 0; bj < 2; ++bj) { const int col = col0 + bj * HALF;
                    const u32x4 gl = *(const u32x4*)(PROJ + (size_t)row * NPROJ + 2304 + sub * 1024 + col);
                    f32x4 g0, g1;
                    g0[0] = sigmoidf_(bf16_lo(gl.x) + bg[bj][0][0]); g0[1] = sigmoidf_(bf16_hi(gl.x) + bg[bj][0][1]); g0[2] = sigmoidf_(bf16_lo(gl.y) + bg[bj][0][2]); g0[3] = sigmoidf_(bf16_hi(gl.y) + bg[bj][0][3]);
                    g1[0] = sigmoidf_(bf16_lo(gl.z) + bg[bj][1][0]); g1[1] = sigmoidf_(bf16_hi(gl.z) + bg[bj][1][1]); g1[2] = sigmoidf_(bf16_lo(gl.w) + bg[bj][1][2]); g1[3] = sigmoidf_(bf16_hi(gl.w) + bg[bj][1][3]);
                    f32x4 v0 = acc[ai][bj][m][0] * g0, v1 = acc[ai][bj][m][1] * g1;
                    float* tp = TMP + (size_t)row * 1024 + col;
                    if (sub == 0) { *(f32x4*)tp = v0; *(f32x4*)(tp + 4) = v1; }
                    else { v0 += *(const f32x4*)tp; v1 += *(const f32x4*)(tp + 4); u32x4 w;
                        w.x = cvt_pk_bf16(v0[0], v0[1]); w.y = cvt_pk_bf16(v0[2], v0[3]); w.z = cvt_pk_bf16(v1[0], v1[1]); w.w = cvt_pk_bf16(v1[2], v1[3]);
                        *(u32x4*)(MERGED + (size_t)row * 1024 + col) = w; } } }
    }
};
struct EpiF32 {
    static constexpr bool PERM = false;
    float* C; int ldc;
    __device__ __forceinline__ void operator()(const Acc& acc, const Unit& u, int wr, int wc, int fr, int fq) const {
        const int row0 = u.pm * BM + wr * 64 + fr, col0 = u.pn * BM + wc * 32 + 4 * fq;
#pragma unroll
        for (int ai = 0; ai < 2; ++ai)
#pragma unroll
            for (int m = 0; m < 4; ++m) { float* rowp = C + (size_t)(row0 + ai * HALF + m * 16) * ldc + col0;
#pragma unroll
                for (int bj = 0; bj < 2; ++bj)
#pragma unroll
                    for (int n = 0; n < 2; ++n) *(f32x4*)(rowp + bj * HALF + n * 16) = acc[ai][bj][m][n]; }
    }
};
struct EpiMoe1 {
    static constexpr bool PERM = true;
    const float* b1; unsigned char* ACT;
    __device__ __forceinline__ void operator()(const Acc& acc, const Unit& u, int wr, int wc, int fr, int fq) const {
        const int e = u.aux, row0 = u.pm * BM + wr * 64 + fr, col0 = u.pn * BM + wc * 32 + 8 * fq;
        constexpr float DS = 1.f / (SC_H2 * SC_W);
        f32x4 bv[2][2];
#pragma unroll
        for (int bj = 0; bj < 2; ++bj)
#pragma unroll
            for (int n = 0; n < 2; ++n) bv[bj][n] = *(const f32x4*)(b1 + (size_t)e * 2048 + col0 + bj * HALF + 4 * n);
#pragma unroll
        for (int ai = 0; ai < 2; ++ai)
#pragma unroll
            for (int m = 0; m < 4; ++m) { const int row = row0 + ai * HALF + m * 16;
#pragma unroll
                for (int bj = 0; bj < 2; ++bj) { float o[4];
#pragma unroll
                    for (int n = 0; n < 2; ++n) { const f32x4 v = acc[ai][bj][m][n] * DS + bv[bj][n];
#pragma unroll
                        for (int q = 0; q < 2; ++q) { const float xg = fminf(v[2 * q], 7.f), xl = fminf(fmaxf(v[2 * q + 1], -7.f), 7.f);
                            o[2 * n + q] = xg * sigmoidf_(1.702f * xg) * (xl + 1.f) * SC_ACT; } }
                    int w = __builtin_amdgcn_cvt_pk_fp8_f32(o[0], o[1], 0, false); w = __builtin_amdgcn_cvt_pk_fp8_f32(o[2], o[3], w, true);
                    *(int*)(ACT + (size_t)row * 1024 + ((col0 + bj * HALF) >> 1)) = w; } }
    }
};
struct EpiMoe2 {
    static constexpr bool PERM = true;
    const float* b2; bf16_t* YIT;
    __device__ __forceinline__ void operator()(const Acc& acc, const Unit& u, int wr, int wc, int fr, int fq) const {
        const int e = u.aux, row0 = u.pm * BM + wr * 64 + fr, col0 = u.pn * BM + wc * 32 + 8 * fq;
        f32x4 bv[2][2];
#pragma unroll
        for (int bj = 0; bj < 2; ++bj)
#pragma unroll
            for (int n = 0; n < 2; ++n) bv[bj][n] = *(const f32x4*)(b2 + (size_t)e * 1024 + col0 + bj * HALF + 4 * n);
#pragma unroll
        for (int ai = 0; ai < 2; ++ai)
#pragma unroll
            for (int m = 0; m < 4; ++m) { const int row = row0 + ai * HALF + m * 16;
#pragma unroll
                for (int bj = 0; bj < 2; ++bj) { const f32x4 v0 = acc[ai][bj][m][0] * (1.f / (SC_ACT * SC_W)) + bv[bj][0], v1 = acc[ai][bj][m][1] * (1.f / (SC_ACT * SC_W)) + bv[bj][1]; u32x4 w;
                    w.x = cvt_pk_bf16(v0[0], v0[1]); w.y = cvt_pk_bf16(v0[2], v0[3]); w.z = cvt_pk_bf16(v1[0], v1[1]); w.w = cvt_pk_bf16(v1[2], v1[3]);
                    *(u32x4*)(YIT + (size_t)row * 1024 + col0 + bj * HALF) = w; } }
    }
};
}

namespace attn {
#define SBAR() __builtin_amdgcn_sched_barrier(0)
constexpr int NW = 8, QBLK = 32, KVBLK = 64;
constexpr float THR = 8.f;
__device__ __forceinline__ int crow(int r, int hi) { return (r & 3) + 8 * (r >> 2) + 4 * hi; }
constexpr int KROW_MLA = 96 * 2 + 16, KROW_NA = 64 * 2 + 16;
constexpr int SHM_K = 64 * KROW_MLA  , SHM_V = 64 * 64 * 2  ;
constexpr int OFF_V = 0, OFF_K = 2 * SHM_V, OFF_WS = OFF_K + 2 * SHM_K, OFF_OST = OFF_WS + NW * 256, OFF_BIAS = OFF_OST + NW * 4096, ATTN_LDS = OFF_BIAS + 2048;

__device__ __forceinline__ int v_st(int k, int c) { const int kk = (k & ~0xC) | ((k & 4) << 1) | ((k & 8) >> 1); return ((kk >> 3) * 2 + (c >> 5)) * 512 + ((kk & 7) * 32 + (c & 31)) * 2; }
__device__ __forceinline__ int v_rd_base(int lane) { return ((lane & 3) << 3) | (((lane >> 2) & 3) << 6) | (((lane >> 4) & 1) << 5) | (((lane >> 5) & 1) << 8); }
constexpr int v_rd_off(int d0, int ks, int half) { return d0 * 512 + ks * 2048 + half * 1024; }
template <int OFF> __device__ __forceinline__ s16x4 tr_read(int vb) {
    s16x4 r; asm volatile("ds_read_b64_tr_b16 %0, %1 offset:%2" : "=&v"(r) : "v"(vb), "i"(OFF) : "memory"); return r;
}
template <int D0> __device__ __forceinline__ void pv_one(f32x16& od, int vb, bf16x8 pa0, bf16x8 pa1, bf16x8 pa2, bf16x8 pa3) {
    const s16x4 l0 = tr_read<v_rd_off(D0, 0, 0)>(vb), h0 = tr_read<v_rd_off(D0, 0, 1)>(vb), l1 = tr_read<v_rd_off(D0, 1, 0)>(vb), h1 = tr_read<v_rd_off(D0, 1, 1)>(vb);
    const s16x4 l2 = tr_read<v_rd_off(D0, 2, 0)>(vb), h2 = tr_read<v_rd_off(D0, 2, 1)>(vb), l3 = tr_read<v_rd_off(D0, 3, 0)>(vb), h3 = tr_read<v_rd_off(D0, 3, 1)>(vb);
    asm volatile("s_waitcnt lgkmcnt(0)" ::: "memory"); SBAR();
#define PK(L, H) (bf16x8){L[0], L[1], L[2], L[3], H[0], H[1], H[2], H[3]}
    od = __builtin_amdgcn_mfma_f32_32x32x16_bf16(pa0, PK(l0, h0), od, 0, 0, 0);
    od = __builtin_amdgcn_mfma_f32_32x32x16_bf16(pa1, PK(l1, h1), od, 0, 0, 0);
    od = __builtin_amdgcn_mfma_f32_32x32x16_bf16(pa2, PK(l2, h2), od, 0, 0, 0);
    od = __builtin_amdgcn_mfma_f32_32x32x16_bf16(pa3, PK(l3, h3), od, 0, 0, 0);
#undef PK
}
__device__ __forceinline__ void pv_d0(f32x16* o, int vb, bf16x8 pa0, bf16x8 pa1, bf16x8 pa2, bf16x8 pa3) {
    pv_one<0>(o[0], vb, pa0, pa1, pa2, pa3); pv_one<1>(o[1], vb, pa0, pa1, pa2, pa3);
}
__device__ __forceinline__ void partialSM(f32x16& p0, f32x16& p1, float& m_reg, float& alpha) {
    float pmax = p0[0];
#pragma unroll
    for (int r = 1; r < 16; ++r) pmax = fmaxf(pmax, p0[r]);
#pragma unroll
    for (int r = 0; r < 16; ++r) pmax = fmaxf(pmax, p1[r]);
    { auto rr = __builtin_amdgcn_permlane32_swap(__float_as_uint(pmax), __float_as_uint(pmax), false, false);
      pmax = fmaxf(__uint_as_float(rr[0]), __uint_as_float(rr[1])); }
    float mn;
    if (__builtin_expect(__all(pmax - m_reg <= THR), 1)) { mn = m_reg; alpha = 1.f; }
    else { mn = fmaxf(m_reg, pmax); alpha = __builtin_amdgcn_exp2f(m_reg - mn); m_reg = mn; }
#pragma unroll
    for (int r = 0; r < 16; ++r) p0[r] = p0[r] - mn;
#pragma unroll
    for (int r = 0; r < 16; ++r) p1[r] = p1[r] - mn;
#pragma unroll
    for (int r = 0; r < 16; ++r) p0[r] = __builtin_amdgcn_exp2f(p0[r]);
}
__device__ __forceinline__ void finishSM(f32x16& p0, f32x16& p1, float alpha, float& l_reg, bf16x8& pa0, bf16x8& pa1, bf16x8& pa2, bf16x8& pa3) {
#pragma unroll
    for (int r = 0; r < 16; ++r) p1[r] = __builtin_amdgcn_exp2f(p1[r]);
    float ps = 0;
#pragma unroll
    for (int r = 0; r < 16; ++r) ps += p0[r];
#pragma unroll
    for (int r = 0; r < 16; ++r) ps += p1[r];
    { auto rr = __builtin_amdgcn_permlane32_swap(__float_as_uint(ps), __float_as_uint(ps), false, false);
      ps = __uint_as_float(rr[0]) + __uint_as_float(rr[1]); }
    l_reg = l_reg * alpha + ps;
#define PK4(P, BASE, OUT) do { unsigned a0 = cvt_pk_bf16(P[BASE + 0], P[BASE + 1]), a1 = cvt_pk_bf16(P[BASE + 2], P[BASE + 3]);   \
    unsigned b0 = cvt_pk_bf16(P[BASE + 4], P[BASE + 5]), b1 = cvt_pk_bf16(P[BASE + 6], P[BASE + 7]);                              \
    auto r0 = __builtin_amdgcn_permlane32_swap(a0, b0, false, false); auto r1 = __builtin_amdgcn_permlane32_swap(a1, b1, false, false); \
    u32x4 w = {r0[0], r1[0], r0[1], r1[1]}; OUT = *reinterpret_cast<bf16x8*>(&w); } while (0)
    PK4(p0, 0, pa0); PK4(p0, 8, pa1); PK4(p1, 0, pa2); PK4(p1, 8, pa3);
#undef PK4
}
template <int ND0, int KROW>
__device__ __forceinline__ void qkt(f32x16& p0, f32x16& p1, const char* Ks, const bf16x8* qr, int r32, int hi) {
    p0 = f32x16{}; p1 = f32x16{};
#pragma unroll
    for (int d0 = 0; d0 < ND0; ++d0) { const int cb = (d0 * 16 + hi * 8) * 2;
        const bf16x8 b0 = *reinterpret_cast<const bf16x8*>(Ks + r32 * KROW + cb);
        const bf16x8 b1 = *reinterpret_cast<const bf16x8*>(Ks + (32 + r32) * KROW + cb);
        p0 = __builtin_amdgcn_mfma_f32_32x32x16_bf16(b0, qr[d0], p0, 0, 0, 0);
        p1 = __builtin_amdgcn_mfma_f32_32x32x16_bf16(b1, qr[d0], p1, 0, 0, 0); }
}

template <int MODE>
__device__ __forceinline__ void attn_unit(const bf16_t* __restrict__ Qa, int ldqa, const bf16_t* __restrict__ Qb, int ldqb,
                                          const bf16_t* __restrict__ Ka, int ldka, const bf16_t* __restrict__ Kb, int ldkb, const bf16_t* __restrict__ Vv, int ldv,
                                          bf16_t* __restrict__ O, int NT, int krow0, int ntreal, int qrow0, const float* __restrict__ rpbh, char* lds) {
    constexpr int ND0 = MODE == 0 ? 6 : 4, KROW = MODE == 0 ? KROW_MLA : KROW_NA;
    const int tid = threadIdx.x, wid = __builtin_amdgcn_readfirstlane(tid >> 6), lane = tid & 63, r32 = lane & 31, hi = lane >> 5;
    char* V_lds = lds + OFF_V; char* K_lds = lds + OFF_K;
    float* ws = (float*)(lds + OFF_WS) + wid * 64; float* li_l = ws; float* al_l = ws + 32;
    float* biasL = (float*)(lds + OFF_BIAS);
    float m_reg = -1e30f, l_reg = 0; f32x16 o[2] = {}; bf16x8 qr[ND0];
    {   const bf16_t* Qw = Qa + (size_t)(wid * QBLK + r32) * ldqa + hi * 8;
#pragma unroll
        for (int d0 = 0; d0 < 4; ++d0) qr[d0] = *reinterpret_cast<const bf16x8*>(Qw + d0 * 16);
        if constexpr (MODE == 0) { const bf16_t* Qw2 = Qb + (size_t)(wid * QBLK + r32) * ldqb + hi * 8;
#pragma unroll
            for (int d0 = 0; d0 < 2; ++d0) qr[4 + d0] = *reinterpret_cast<const bf16x8*>(Qw2 + d0 * 16); } }
    int qgr = 0, rs0 = 0, qc = 0, cs = 0;
    if constexpr (MODE == 1) {
        qgr = qrow0 + (wid >> 1); rs0 = min(max(qgr - 4, 0), 120); qc = 32 * (wid & 1) + r32; cs = min(max(qc - 8, 0), 48);
        for (int i = tid; i < 15 * 31; i += 512) biasL[i] = rpbh[i] * LOG2E;
    }
    const int sr = tid >> 3, sc = (tid & 7) * 8;
    const int sr2 = (tid & 255) >> 2, sc2 = (tid & 3) * 8;
    const int vst = v_st(sr, sc);
    const int vb0 = (int)(uintptr_t)V_lds + v_rd_base(lane);
    struct { bf16x8 v, k, k2; } sr_[2];
#define KROWOF(t) (MODE == 1 ? min(krow0 + (t), 127) * 64 : (t) * 64)
#define SLOAD(i, t) do { const long k0_ = KROWOF(t); sr_[i].v = *reinterpret_cast<const bf16x8*>(&Vv[(k0_ + sr) * ldv + sc]); sr_[i].k = *reinterpret_cast<const bf16x8*>(&Ka[(k0_ + sr) * ldka + sc]); \
        if constexpr (MODE == 0) sr_[i].k2 = *reinterpret_cast<const bf16x8*>(&Kb[(k0_ + sr2) * ldkb + sc2]); } while (0)
#define SWRITE(b, i) do { *(bf16x8*)(V_lds + (b) * SHM_V + vst) = sr_[i].v; *(bf16x8*)(K_lds + (b) * SHM_K + sr * KROW + sc * 2) = sr_[i].k; \
        if constexpr (MODE == 0) { if (tid < 256) *(bf16x8*)(K_lds + (b) * SHM_K + sr2 * KROW + 128 + sc2 * 2) = sr_[i].k2; } } while (0)
#define SWAIT() do { if constexpr (MODE == 0) asm volatile("s_waitcnt vmcnt(3)" ::: "memory"); else asm volatile("s_waitcnt vmcnt(2)" ::: "memory"); } while (0)
#define RESC(a) do { if (__any((a) < 1.f)) { if (hi == 0) al_l[r32] = (a); asm volatile("s_waitcnt lgkmcnt(0)" ::: "memory"); \
        _Pragma("unroll") for (int d = 0; d < 2; ++d) _Pragma("unroll") for (int r = 0; r < 16; ++r) o[d][r] *= al_l[crow(r, hi)]; } } while (0)
#define TVALID(t) (MODE == 0 ? true : ((t) < ntreal && (krow0 + (t)) >= rs0 && (krow0 + (t)) < rs0 + 8))
#define MASKB(P0, P1, t) do { if constexpr (MODE == 1) { const int dr_ = krow0 + (t) - qgr + 7; int d_ = 4 * hi - cs; asm volatile("" : "+v"(d_)); \
        const LAS float* bl_ = (const LAS float*)((LAS char*)lds + OFF_BIAS) + (dr_ * 31 + 15 - qc + 4 * hi); \
        _Pragma("unroll") for (int r = 0; r < 16; ++r) { const int c0_ = (r & 3) + 8 * (r >> 2); \
            const bool in0 = (unsigned)(c0_ + d_) < 16u, in1 = (unsigned)(c0_ + 32 + d_) < 16u; \
            const float b0_ = bl_[c0_], b1_ = bl_[c0_ + 32]; \
            P0[r] = in0 ? P0[r] + b0_ : -1e30f; P1[r] = in1 ? P1[r] + b1_ : -1e30f; } } } while (0)
    f32x16 pA0, pA1, pB0, pB1; float alA = 1.f, alB = 1.f; bf16x8 pa0, pa1, pa2, pa3;
    bool vA, vB;
    constexpr int SE = 0, SO = 1;
    SLOAD(SE, 0); asm volatile("s_waitcnt vmcnt(0)" ::: "memory"); SWRITE(0, SE); __syncthreads();
    vA = TVALID(0);
    if (vA) { qkt<ND0, KROW>(pA0, pA1, K_lds, qr, r32, hi); MASKB(pA0, pA1, 0); partialSM(pA0, pA1, m_reg, alA); }
    SLOAD(SO, 1); if (2 < NT) SLOAD(SE, 2);
    SWAIT(); SWRITE(1, SO); __syncthreads();
    for (int j = 1; j + 1 < NT; j += 2) {
        vB = TVALID(j);
        SBAR(); if (vB) { qkt<ND0, KROW>(pB0, pB1, K_lds + SHM_K, qr, r32, hi); MASKB(pB0, pB1, j); }
        if (vA) finishSM(pA0, pA1, alA, l_reg, pa0, pa1, pa2, pa3); SBAR();
        SLOAD(SO, min(j + 2, NT - 1)); SBAR();
        if (vA) pv_d0(o, vb0, pa0, pa1, pa2, pa3);
        if (vB) partialSM(pB0, pB1, m_reg, alB);
        __syncthreads(); SWAIT(); SWRITE(0, SE);
        if (vB) RESC(alB); __syncthreads();
        vA = TVALID(j + 1);
        SBAR(); if (vA) { qkt<ND0, KROW>(pA0, pA1, K_lds, qr, r32, hi); MASKB(pA0, pA1, j + 1); }
        if (vB) finishSM(pB0, pB1, alB, l_reg, pa0, pa1, pa2, pa3); SBAR();
        SLOAD(SE, min(j + 3, NT - 1)); SBAR();
        if (vB) pv_d0(o, vb0 + SHM_V, pa0, pa1, pa2, pa3);
        if (vA) partialSM(pA0, pA1, m_reg, alA);
        __syncthreads(); SWAIT(); SWRITE(1, SO);
        if (vA) RESC(alA); __syncthreads();
    }
    vB = TVALID(NT - 1);
    SBAR(); if (vB) { qkt<ND0, KROW>(pB0, pB1, K_lds + SHM_K, qr, r32, hi); MASKB(pB0, pB1, NT - 1); }
    if (vA) finishSM(pA0, pA1, alA, l_reg, pa0, pa1, pa2, pa3); SBAR();
    if (vA) pv_d0(o, vb0, pa0, pa1, pa2, pa3);
    if (vB) { partialSM(pB0, pB1, m_reg, alB); RESC(alB);
        finishSM(pB0, pB1, alB, l_reg, pa0, pa1, pa2, pa3); SBAR();
        pv_d0(o, vb0 + SHM_V, pa0, pa1, pa2, pa3); }
    asm volatile("s_waitcnt vmcnt(0)" ::: "memory");
    if (hi == 0) li_l[r32] = l_reg; asm volatile("s_waitcnt lgkmcnt(0)" ::: "memory");
    float rli[16];
#pragma unroll
    for (int r = 0; r < 16; ++r) rli[r] = __builtin_amdgcn_rcpf(li_l[crow(r, hi)]);
    {   bf16_t* stg = (bf16_t*)(lds + OFF_OST) + wid * 2048;
#pragma unroll
        for (int r = 0; r < 16; ++r) { const int orow = crow(r, hi);
#pragma unroll
            for (int d0 = 0; d0 < 2; ++d0) stg[orow * 64 + d0 * 32 + r32] = (bf16_t)(cvt_pk_bf16(o[d0][r] * rli[r], 0.f) & 0xffffu); }
        asm volatile("s_waitcnt lgkmcnt(0)" ::: "memory");
        bf16_t* Ow = O + (size_t)(wid * QBLK) * 512;
#pragma unroll
        for (int i = 0; i < 4; ++i) { const int row = i * 8 + (lane >> 3), ch = lane & 7; const u32x4 v = *(const u32x4*)(stg + row * 64 + ch * 8); *(u32x4*)(Ow + (size_t)row * 512 + ch * 8) = v; } }
    __syncthreads();
#undef KROWOF
#undef SLOAD
#undef SWRITE
#undef SWAIT
#undef RESC
#undef TVALID
#undef MASKB
}
#undef SBAR
}

constexpr size_t MiB = 1u << 20;
constexpr size_t WS_CTL = 0, CTL_ZERO_BYTES = 1 * MiB;
constexpr size_t WS_WIN = 2 * MiB;
constexpr size_t WS_WUQ = 11 * MiB;
constexpr size_t WS_WUKV = 12 * MiB;
constexpr size_t WS_WNA = 13 * MiB, WS_WMLA = 14 * MiB;
constexpr size_t WS_WOUT = 15 * MiB;
constexpr size_t WS_W1 = 18 * MiB;
constexpr size_t WS_W2 = 146 * MiB;
constexpr size_t WS_XN = 210 * MiB;
constexpr size_t WS_PROJ = 242 * MiB;
constexpr size_t WS_QN = 378 * MiB, WS_QR = 394 * MiB, WS_KN = 402 * MiB, WS_KR = 418 * MiB, WS_VM = 419 * MiB;
constexpr size_t WS_ONA = 435 * MiB, WS_OMLA = 451 * MiB;
constexpr size_t WS_MERGED = 467 * MiB;
constexpr size_t WS_TMP = 499 * MiB;
constexpr size_t WS_LIST = 563 * MiB;
constexpr size_t WS_TOKPOS = 565 * MiB, WS_TOKG = 566 * MiB;
constexpr size_t WS_ACT = 568 * MiB;
constexpr size_t WS_YIT = 712 * MiB;
constexpr size_t WS_SSQ = 856 * MiB;
constexpr size_t WS_MODP = 857 * MiB;
constexpr size_t WS_WRT = 858 * MiB;
constexpr size_t WS_END = 859 * MiB;
constexpr int CW_BAR = 4096;
constexpr int CW_CNT = 8192;
constexpr int CW_MOD = 16384;
constexpr int CW_ROPE = 32768;
static_assert((CW_ROPE + 2048) * 4 <= (int)CTL_ZERO_BYTES, "CTL");

constexpr int RING_BYTES = 131072;
constexpr int TAB_OFF = RING_BYTES;
constexpr int TAB_BLK = TAB_OFF, TAB_GATH = TAB_OFF + 2048;
constexpr int MISC_OFF = TAB_GATH + 11 * 1024;
constexpr int LDS_BYTES = 147456;
static_assert(MISC_OFF + 256 <= LDS_BYTES, "LDS map");

#define RLX_AGENT __ATOMIC_RELAXED, __HIP_MEMORY_SCOPE_AGENT
#define LDS_WAIT() asm volatile("s_waitcnt lgkmcnt(0)" ::: "memory")

#define XB_TMO      128
#define XB_XCNT(j)  (256  + 64 * (j))
#define XB_XSUB(j)  (1280 + 64 * (j))
#define XB_XGEN(j)  (2304 + 64 * (j))
#define XB_TOP      3328
#define XB_TOPGEN   3392
#define XCD_BAR_WORDS 3456
#define XB_SPIN_CAP (1u << 22)
__device__ __forceinline__ unsigned xb_ld(unsigned* p)              { return __hip_atomic_load(p, __ATOMIC_RELAXED, __HIP_MEMORY_SCOPE_AGENT); }
__device__ __forceinline__ unsigned xb_add(unsigned* p, unsigned v) { return __hip_atomic_fetch_add(p, v, __ATOMIC_RELAXED, __HIP_MEMORY_SCOPE_AGENT); }
__device__ __forceinline__ unsigned xb_xcc_id() { return (unsigned)__builtin_amdgcn_s_getreg((3 << 11) | 20) & 0xFu; }
#define XB_SPIN(cond, bar) do { unsigned _sp = 0; while (cond) { __builtin_amdgcn_s_sleep(1); \
    if ((++_sp & 255u) == 0u) { if (xb_ld(&(bar)[XB_TMO])) break; if (_sp > XB_SPIN_CAP) { atomicAdd(&(bar)[XB_TMO], 1u); break; } } } } while (0)
struct XcdBarrier { unsigned* bar; unsigned x; volatile LAS unsigned* st; };
__device__ __forceinline__ XcdBarrier xcd_barrier_post(unsigned* bar, volatile LAS unsigned* st) {
    XcdBarrier b; b.bar = bar; b.x = xb_xcc_id(); b.st = st;
    if (threadIdx.x == 0) (void)xb_add(&bar[XB_XCNT(b.x)], 1u);
    return b;
}
__device__ __forceinline__ void xcd_barrier_complete(unsigned* bar, unsigned x, unsigned& nloc, unsigned& nx) {
    const unsigned G = gridDim.x * gridDim.y * gridDim.z;
    unsigned sum, cnt, mine, sp = 0u;
    for (;;) {
        sum = 0u; cnt = 0u; mine = 0u;
#pragma unroll
        for (unsigned j = 0; j < 16; ++j) { const unsigned c = xb_ld(&bar[XB_XCNT(j)]); sum += c; cnt += (c > 0u) ? 1u : 0u; mine = (j == x) ? c : mine; }
        if (sum == G) break;
        __builtin_amdgcn_s_sleep(1);
        if ((++sp & 255u) == 0u) { if (xb_ld(&bar[XB_TMO])) break; if (sp > XB_SPIN_CAP) { atomicAdd(&bar[XB_TMO], 1u); break; } }
    }
    nloc = mine > 0u ? mine : 1u; nx = cnt > 0u ? cnt : 1u;
}
__device__ __forceinline__ void xcd_barrier(const XcdBarrier& b) {
    asm volatile("s_waitcnt vmcnt(0)" ::: "memory");
    __syncthreads();
    if (threadIdx.x == 0) {
        unsigned* bar = b.bar;
        __builtin_amdgcn_s_waitcnt(0);
        unsigned nloc = b.st[0], nx = b.st[1];
        if (nloc == 0u) { xcd_barrier_complete(bar, b.x, nloc, nx); b.st[0] = nloc; b.st[1] = nx; }
        const unsigned old = xb_add(&bar[XB_XSUB(b.x)], 1u);
        const unsigned gen = old / nloc;
        if (old + 1u == (gen + 1u) * nloc) {
            __builtin_amdgcn_fence(__ATOMIC_RELEASE, "agent");
            asm volatile("s_waitcnt vmcnt(0)" ::: "memory");
            const unsigned og = xb_add(&bar[XB_TOP], 1u);
            const unsigned tg = og / nx;
            if (og + 1u == (tg + 1u) * nx) xb_add(&bar[XB_TOPGEN], 1u);
            else XB_SPIN(xb_ld(&bar[XB_TOPGEN]) == tg, bar);
            __builtin_amdgcn_fence(__ATOMIC_ACQUIRE, "agent");
            xb_add(&bar[XB_XGEN(b.x)], 1u);
            asm volatile("s_waitcnt vmcnt(0)" ::: "memory");
        } else {
            XB_SPIN(xb_ld(&bar[XB_XGEN(b.x)]) == gen, bar);
            __builtin_amdgcn_fence(__ATOMIC_ACQUIRE, "agent");
            asm volatile("s_waitcnt vmcnt(0)" ::: "memory");
        }
    }
    __syncthreads();
}

constexpr int NWAVES = 8;
struct Args { const float* in[24]; float* out; unsigned char* ws; int ph_lo, ph_hi; };
enum { I_X = 0, I_C, I_WADA, I_BADA, I_GAPRE, I_GAPOST, I_WIN, I_BGATE, I_RPB, I_QNG, I_KVNG, I_WUQ, I_WUKV, I_WNAUP, I_WMLAUP, I_WOUT, I_GFPRE, I_GFPOST, I_WR, I_BR, I_W1, I_B1, I_W2, I_B2 };

__device__ __forceinline__ void tr_store_tile(LAS unsigned char* scr, bf16_t* dst, int K, int n0, int k0, int lane) {
    LDS_WAIT(); asm volatile("" ::: "memory");
#pragma unroll
    for (int j = 0; j < 8; ++j) { const int idx = j * 64 + lane, n = idx >> 3, ch = idx & 7;
        const u32x4 v = *(const LAS u32x4*)(scr + n * 144 + ch * 16);
        *(GAS u32x4*)(dst + (size_t)(n0 + n) * K + k0 + ch * 8) = v; }
    LDS_WAIT(); asm volatile("" ::: "memory");
}
__device__ __forceinline__ void tr_tile_fast(const float* src, int Nsrc, int src0, const float* kscale, bf16_t* dst, int K, int n0, int k0, LAS unsigned char* scr, int lane) {
#pragma unroll
    for (int st = 0; st < 8; ++st) { const int kq = st * 4 + (lane >> 4), c4 = (lane & 15) * 4, k = 2 * kq;
        f32x4 a = *(const GAS f32x4*)(src + (size_t)(k0 + k) * Nsrc + src0 + c4);
        f32x4 b = *(const GAS f32x4*)(src + (size_t)(k0 + k + 1) * Nsrc + src0 + c4);
        if (kscale) { const float s0 = kscale[k0 + k], s1 = kscale[k0 + k + 1]; a = a * s0; b = b * s1; }
#pragma unroll
        for (int i = 0; i < 4; ++i) *(LAS unsigned*)(scr + (c4 + i) * 144 + k * 2) = cvt_pk_bf16(a[i], b[i]); }
    tr_store_tile(scr, dst, K, n0, k0, lane);
}
__device__ __forceinline__ void tr_tile_slow(const float* src, int Nsrc, int srccol  , const float* kscale, bf16_t* dst, int K, int n0, int k0, LAS unsigned char* scr, int lane) {
#pragma unroll 8
    for (int k = 0; k < 64; k += 2) {
        float a = 0.f, b = 0.f;
        if (srccol >= 0) { a = src[(size_t)(k0 + k) * Nsrc + srccol]; b = src[(size_t)(k0 + k + 1) * Nsrc + srccol];
            if (kscale) { a *= kscale[k0 + k]; b *= kscale[k0 + k + 1]; } }
        *(LAS unsigned*)(scr + lane * 144 + k * 2) = cvt_pk_bf16(a, b); }
    tr_store_tile(scr, dst, K, n0, k0, lane);
}
__device__ __forceinline__ void tr_tile_fast8(const float* src, int Nsrc, int src0, unsigned char* dst, int K, int n0, int k0, LAS unsigned char* scr, int lane) {
#pragma unroll
    for (int st = 0; st < 4; ++st) { const int kq = st * 4 + (lane >> 4), c4 = (lane & 15) * 4, k = 4 * kq;
        const f32x4 a = *(const GAS f32x4*)(src + (size_t)(k0 + k) * Nsrc + src0 + c4) * SC_W, b = *(const GAS f32x4*)(src + (size_t)(k0 + k + 1) * Nsrc + src0 + c4) * SC_W;
        const f32x4 c = *(const GAS f32x4*)(src + (size_t)(k0 + k + 2) * Nsrc + src0 + c4) * SC_W, d = *(const GAS f32x4*)(src + (size_t)(k0 + k + 3) * Nsrc + src0 + c4) * SC_W;
#pragma unroll
        for (int i = 0; i < 4; ++i) { int w = __builtin_amdgcn_cvt_pk_fp8_f32(a[i], b[i], 0, false); w = __builtin_amdgcn_cvt_pk_fp8_f32(c[i], d[i], w, true);
            *(LAS int*)(scr + (c4 + i) * 80 + k) = w; } }
    LDS_WAIT(); asm volatile("" ::: "memory");
#pragma unroll
    for (int j = 0; j < 4; ++j) { const int idx = j * 64 + lane, n = idx >> 2, ch = idx & 3;
        const u32x4 v = *(const LAS u32x4*)(scr + n * 80 + ch * 16);
        *(GAS u32x4*)(dst + (size_t)(n0 + n) * K + k0 + ch * 16) = v; }
    LDS_WAIT(); asm volatile("" ::: "memory");
}
__device__ __forceinline__ int rope_orig(int p) { return (p & 16) + 8 * (p & 1) + ((p & 15) >> 1); }

__global__ void __launch_bounds__(NWAVES * 64, 2) fwd_kernel(Args args) {
    extern __shared__ __attribute__((aligned(16))) unsigned char lds[];
    LAS unsigned char* L = (LAS unsigned char*)lds;
    volatile LAS unsigned* MISC = (volatile LAS unsigned*)(L + MISC_OFF);
    const int tid = threadIdx.x, lane = tid & 63, wave = __builtin_amdgcn_readfirstlane(tid >> 6);
    const int G = gridDim.x, bx = blockIdx.x, vcu = (G % 8 == 0) ? (bx % 8) * (G / 8) + bx / 8 : bx;
    unsigned char* ws = args.ws;
    gu32* ctl = (gu32*)(ws + WS_CTL);
    const int lo = args.ph_lo, hi = args.ph_hi;
    for (int u = tid; u < 64; u += NWAVES * 64) MISC[u] = 0u;
    __syncthreads();
    XcdBarrier bar; bar.bar = (unsigned*)(ctl + CW_BAR); bar.x = 0; bar.st = nullptr;
    const bool use_bar = (hi - lo) > 1;
    if (use_bar) bar = xcd_barrier_post((unsigned*)(ctl + CW_BAR), MISC + 8);
#ifndef PHASE_MASK
#define PHASE_MASK 0xFFFF
#endif
#define IN(k) (((PHASE_MASK >> (k)) & 1) && lo <= (k) && (k) < hi)
#ifndef REPMASK
#define REPMASK 0
#endif
#define NREP(k) (1 + ((REPMASK >> (k)) & 1))
#define SEAM(k) do { if (IN(k) && IN((k) + 1)) xcd_barrier(bar); } while (0)
    const int gw = vcu * NWAVES + wave, NGW = G * NWAVES;
    float* ROPE = (float*)(ctl + CW_ROPE);
    float* MODP = (float*)(ws + WS_MODP); float* MOD = (float*)(ws + WS_MODP + 512 * 1024); float* SSQ = (float*)(ws + WS_SSQ); unsigned* CNT = (unsigned*)(ctl + CW_CNT);
    bf16_t* WINT = (bf16_t*)(ws + WS_WIN); bf16_t* WUQT = (bf16_t*)(ws + WS_WUQ); bf16_t* WUKVT = (bf16_t*)(ws + WS_WUKV);
    bf16_t* WNAT = (bf16_t*)(ws + WS_WNA); bf16_t* WMLAT = (bf16_t*)(ws + WS_WMLA); bf16_t* WOUTT = (bf16_t*)(ws + WS_WOUT);
    bf16_t* W1T = (bf16_t*)(ws + WS_W1); bf16_t* W2T = (bf16_t*)(ws + WS_W2);
    bf16_t* XN = (bf16_t*)(ws + WS_XN); bf16_t* PROJ = (bf16_t*)(ws + WS_PROJ);
    bf16_t* QN = (bf16_t*)(ws + WS_QN); bf16_t* QR = (bf16_t*)(ws + WS_QR); bf16_t* KN = (bf16_t*)(ws + WS_KN); bf16_t* KR = (bf16_t*)(ws + WS_KR); bf16_t* VM = (bf16_t*)(ws + WS_VM);
    bf16_t* ONA = (bf16_t*)(ws + WS_ONA); bf16_t* OMLA = (bf16_t*)(ws + WS_OMLA); bf16_t* MERGED = (bf16_t*)(ws + WS_MERGED);
    float* TMP = (float*)(ws + WS_TMP); unsigned* LIST = (unsigned*)(ws + WS_LIST); unsigned* TOKPOS = (unsigned*)(ws + WS_TOKPOS); float* TOKG = (float*)(ws + WS_TOKG);
    bf16_t* ACT = (bf16_t*)(ws + WS_ACT); bf16_t* YIT = (bf16_t*)(ws + WS_YIT);
    const float* X = args.in[I_X]; float* OUT = args.out;

    if (IN(0)) for (int rep_ = 0; rep_ < NREP(0); ++rep_) {
        LAS unsigned char* scr = L + wave * 16384;
        {   const float* c = args.in[I_C]; const float* wada = args.in[I_WADA]; const float* bada = args.in[I_BADA];
            for (int it = gw; it < 96 * 8; it += NGW) { const int nb = it % 96, kc = it / 96, n = nb * 64 + lane;
                float a0 = 0.f, a1 = 0.f;
#pragma unroll 8
                for (int k = 0; k < 128; ++k) { const int kk = kc * 128 + k; const float w = wada[(size_t)kk * 6144 + n];
                    const float c0 = c[kk], c1 = c[1024 + kk]; a0 += (c0 * sigmoidf_(c0)) * w; a1 += (c1 * sigmoidf_(c1)) * w; }
                if (kc == 0) { a0 += bada[n]; a1 += bada[n]; }
                MODP[(kc * 2 + 0) * 6144 + n] = a0; MODP[(kc * 2 + 1) * 6144 + n] = a1; } }
        if (bx == 0) { for (int i = tid; i < 128 * 8; i += NWAVES * 64) { const int pos = i >> 3, j = i & 7; float c, sn; rope_cs((float)pos, j, c, sn); ROPE[pos * 16 + j] = c; ROPE[pos * 16 + 8 + j] = sn; } }
        if (bx == 1 % G) { const float* Wr = args.in[I_WR]; float* WRT = (float*)(ws + WS_WRT); for (int i = tid; i < NEXP * 1024; i += NWAVES * 64) WRT[i] = Wr[(size_t)(i & 1023) * 32 + (i >> 10)]; }
        {   constexpr int I_WIN_ = 16 * 68, I_UQ = 6 * 12, I_UKV = 4 * 16, I_UP = 8 * 16, I_OUT = 16 * 16, I_W1_ = NEXP * 16 * 32, I_W2_ = NEXP * 16 * 16;
            constexpr int NITEMS = I_WIN_ + I_UQ + I_UKV + 2 * I_UP + I_OUT + I_W1_ + I_W2_;
            for (int it = gw; it < NITEMS; it += NGW) {
                int r = it;
                if (r < I_W1_) { const int e = r / 512, q = r % 512, kb = q / 32, nb = q % 32;
                    tr_tile_fast8(args.in[I_W1] + (size_t)e * 1024 * 2048, 2048, nb * 64, (unsigned char*)W1T + (size_t)e * 2048 * 1024, 1024, nb * 64, kb * 64, scr, lane); continue; } r -= I_W1_;
                if (r < I_W2_) { const int e = r / 256, q = r % 256, kb = q / 16, nb = q % 16;
                    tr_tile_fast8(args.in[I_W2] + (size_t)e * 1024 * 1024, 1024, nb * 64, (unsigned char*)W2T + (size_t)e * 1024 * 1024, 1024, nb * 64, kb * 64, scr, lane); continue; } r -= I_W2_;
                if (r < I_WIN_) { const int kb = r / 68, nb = r % 68;
                    if (nb < 34) tr_tile_fast(args.in[I_WIN], 4256, nb * 64, nullptr, WINT, 1024, nb * 64, kb * 64, scr, lane);
                    else if (nb >= 36) tr_tile_fast(args.in[I_WIN], 4256, 2208 + (nb - 36) * 64, nullptr, WINT, 1024, nb * 64, kb * 64, scr, lane);
                    else { const int n = nb * 64 + lane; const int sc = (n < 2208) ? 2176 + rope_orig(n - 2176) : -1;
                        tr_tile_slow(args.in[I_WIN], 4256, sc, nullptr, WINT, 1024, nb * 64, kb * 64, scr, lane); }
                    continue; } r -= I_WIN_;
                if (r < I_UQ) { const int kb = r / 12, nb = r % 12;
                    if (nb < 8) tr_tile_fast(args.in[I_WUQ], 768, nb * 96, args.in[I_QNG], WUQT, 384, nb * 64, kb * 64, scr, lane);
                    else { const int n = nb * 64 + lane - 512, h = n >> 5, p = n & 31;
                        tr_tile_slow(args.in[I_WUQ], 768, h * 96 + 64 + rope_orig(p), args.in[I_QNG], WUQT, 384, nb * 64, kb * 64, scr, lane); }
                    continue; } r -= I_UQ;
                if (r < I_UKV) { const int kb = r / 16, nb = r % 16;
                    const int s0 = (nb < 8) ? nb * 128 : (nb - 8) * 128 + 64;
                    tr_tile_fast(args.in[I_WUKV], 1024, s0, args.in[I_KVNG], WUKVT, 256, nb * 64, kb * 64, scr, lane); continue; } r -= I_UKV;
                if (r < I_UP) { const int kb = r / 16, nb = r % 16; tr_tile_fast(args.in[I_WNAUP], 1024, nb * 64, nullptr, WNAT, 512, nb * 64, kb * 64, scr, lane); continue; } r -= I_UP;
                if (r < I_UP) { const int kb = r / 16, nb = r % 16; tr_tile_fast(args.in[I_WMLAUP], 1024, nb * 64, nullptr, WMLAT, 512, nb * 64, kb * 64, scr, lane); continue; } r -= I_UP;
                { const int kb = r / 16, nb = r % 16; tr_tile_fast(args.in[I_WOUT], 1024, nb * 64, nullptr, WOUTT, 1024, nb * 64, kb * 64, scr, lane); }
            } }
    }
    SEAM(0);
    if (IN(1)) {
        const float* g = args.in[I_GAPRE];
        LAS float* modl = (LAS float*)L;
        for (int i = tid; i < 4096; i += NWAVES * 64) { const int b = i >> 11, c = i & 2047; float sm = 0.f;
#pragma unroll
            for (int kc = 0; kc < 8; ++kc) sm += MODP[(kc * 2 + b) * 6144 + c];
            modl[i] = sm; }
        for (int idx = bx * (NWAVES * 64) + tid; idx < 2 * 6144; idx += G * NWAVES * 64) { const int b = idx / 6144, n = idx % 6144; float sm = 0.f;
#pragma unroll
            for (int kc = 0; kc < 8; ++kc) sm += MODP[(kc * 2 + b) * 6144 + n];
            MOD[idx] = sm; }
        __syncthreads();
        for (int m = gw; m < MTOK; m += NGW) { const int b = m >> 13;
            const GAS f32x4* xr = (const GAS f32x4*)(X + (size_t)m * DM) + lane; f32x4 v[4]; float s = 0.f;
#pragma unroll
            for (int j = 0; j < 4; ++j) { v[j] = xr[64 * j]; s += (v[j].x * v[j].x + v[j].y * v[j].y) + (v[j].z * v[j].z + v[j].w * v[j].w); }
            const float rstd = __builtin_amdgcn_rsqf(wave_sum(s) * (1.f / DM) + RMS_EPS);
            GAS u32x2* o8 = (GAS u32x2*)(XN + (size_t)m * DM) + lane;
#pragma unroll
            for (int j = 0; j < 4; ++j) { const int col = 4 * lane + 256 * j;
                const f32x4 gg = *(const f32x4*)(g + col), sh = *(const LAS f32x4*)(modl + b * 2048 + col), scl = *(const LAS f32x4*)(modl + b * 2048 + 1024 + col);
                const f32x4 h = v[j] * rstd * gg * (scl + 1.f) + sh; u32x2 w; w.x = cvt_pk_bf16(h[0], h[1]); w.y = cvt_pk_bf16(h[2], h[3]); o8[64 * j] = w; } }
    }
    SEAM(1);
    if (IN(2)) for (int rep_ = 0; rep_ < NREP(2); ++rep_) {
        pg8::SchedDense S{(const char*)XN, (const char*)WINT, (size_t)256 * 1024 * 2, (size_t)256 * 1024 * 2, MTOK / 256, NPROJ / 256, G, bx};
        pg8::EpiInProj E{PROJ, SSQ, KR, ROPE};
        pg8::gemm_phase<pg8::EpiInProj, pg8::SchedDense, true, false, false>(L, 16, 2048, 2048, S, E);
    }
    SEAM(2);
    if (IN(3)) for (int rep_ = 0; rep_ < NREP(3); ++rep_) {
#ifndef NO_QUP
        {   pg8::SchedDense S{(const char*)(PROJ + 1536), (const char*)WUQT, (size_t)256 * NPROJ * 2, (size_t)256 * 384 * 2, MTOK / 256, 3, G, bx};
            pg8::EpiQUp E{QN, QR, SSQ, ROPE};
            pg8::gemm_phase<pg8::EpiQUp, pg8::SchedDense, true, false, false>(L, 6, NPROJ * 2, 768, S, E); }
#endif
#ifndef NO_KVUP
        {   pg8::SchedDense S{(const char*)(PROJ + 1920), (const char*)WUKVT, (size_t)256 * NPROJ * 2, (size_t)256 * 256 * 2, MTOK / 256, 4, G, G - 1 - bx};
            pg8::EpiKVUp E{KN, VM, SSQ};
            pg8::gemm_phase<pg8::EpiKVUp, pg8::SchedDense, true, false, false>(L, 4, NPROJ * 2, 512, S, E); }
#endif
    }
    SEAM(3);
    if (IN(4)) for (int rep_ = 0; rep_ < NREP(4); ++rep_) {
#ifndef NO_MLA
        for (int u = vcu; u < 512; u += G) {
            const int bh = u >> 5, qb = u & 31, b = bh >> 3, h = bh & 7; const size_t row0 = (size_t)b * SEQ + qb * 256, key0 = (size_t)b * SEQ;
            attn::attn_unit<0>(QN + row0 * 512 + h * 64, 512, QR + row0 * 256 + h * 32, 256, KN + key0 * 512 + h * 64, 512, KR + key0 * 32, 32, VM + key0 * 512 + h * 64, 512,
                               OMLA + row0 * 512 + h * 64, 128, 0, 128, 0, nullptr, (char*)lds);
        }
#endif
#ifndef NO_NA
        for (int u = vcu; u < 512; u += G) {
            const int bh = u >> 5, rb = u & 31, b = bh >> 3, h = bh & 7; const size_t row0 = (size_t)b * SEQ + rb * 256, key0 = (size_t)b * SEQ;
            const int krow0 = min(max(4 * rb - 4, 0), 120), klast = min(max(4 * rb + 3 - 4, 0), 120) + 7, ntreal = klast - krow0 + 1, NT = (ntreal + 1) & ~1;
            attn::attn_unit<1>(PROJ + row0 * NPROJ + h * 64, NPROJ, nullptr, 0, PROJ + key0 * NPROJ + 512 + h * 64, NPROJ, nullptr, 0, PROJ + key0 * NPROJ + 1024 + h * 64, NPROJ,
                               ONA + row0 * 512 + h * 64, NT, krow0, ntreal, 4 * rb, args.in[I_RPB] + h * 15 * 31, (char*)lds);
        }
#endif
    }
    SEAM(4);
    if (IN(5)) for (int rep_ = 0; rep_ < NREP(5); ++rep_) {
        pg8::SchedMerge S{(const char*)ONA, (const char*)OMLA, (const char*)WNAT, (const char*)WMLAT, MTOK / 256, 4, G, bx};
        pg8::EpiMerge E{PROJ, args.in[I_BGATE], TMP, MERGED};
        pg8::gemm_phase<pg8::EpiMerge, pg8::SchedMerge, true, false, false>(L, 8, 1024, 1024, S, E);
    }
    SEAM(5);
    if (IN(6)) for (int rep_ = 0; rep_ < NREP(6); ++rep_) {
        pg8::SchedDense S{(const char*)MERGED, (const char*)WOUTT, (size_t)256 * 1024 * 2, (size_t)256 * 1024 * 2, MTOK / 256, 4, G, bx};
        pg8::EpiF32 E{TMP, 1024};
        pg8::gemm_phase<pg8::EpiF32, pg8::SchedDense, true, false, false>(L, 16, 2048, 2048, S, E);
    }
    SEAM(6);
    if (IN(7)) {
        LAS int* sel_e = (LAS int*)(L + 0); LAS float* sel_g = (LAS float*)(L + 1024); LAS int* sel_r = (LAS int*)(L + 2048);
        LAS int* lcnt = (LAS int*)(L + 3072); LAS int* lbase = (LAS int*)(L + 3072 + 128);
        const float* gpo = args.in[I_GAPOST]; const float* gfp = args.in[I_GFPRE]; const float* br = args.in[I_BR];
        const float* WRT = (const float*)(ws + WS_WRT);
        for (int blk = vcu; blk < MTOK / 64; blk += G) {
            if (tid < 32) lcnt[tid] = 0;
            __syncthreads();
            f32x4 hreg[8][4];
#pragma unroll
            for (int rr = 0; rr < 8; ++rr) { const int m = blk * 64 + wave * 8 + rr, b = m >> 13;
                const GAS f32x4* yr = (const GAS f32x4*)(TMP + (size_t)m * DM) + lane; const GAS f32x4* xr = (const GAS f32x4*)(X + (size_t)m * DM) + lane;
                f32x4 y[4], x1[4]; float s = 0.f;
#pragma unroll
                for (int j = 0; j < 4; ++j) { y[j] = yr[64 * j]; x1[j] = xr[64 * j]; s += (y[j].x * y[j].x + y[j].y * y[j].y) + (y[j].z * y[j].z + y[j].w * y[j].w); }
                const float rstd = __builtin_amdgcn_rsqf(wave_sum(s) * (1.f / DM) + RMS_EPS); float s2 = 0.f;
#pragma unroll
                for (int j = 0; j < 4; ++j) { const int col = 4 * lane + 256 * j;
                    const f32x4 gg = *(const f32x4*)(gpo + col), ga = *(const f32x4*)(MOD + b * 6144 + 2048 + col);
                    x1[j] = x1[j] + ga * (y[j] * rstd * gg);
                    *((GAS f32x4*)(OUT + (size_t)m * DM) + lane + 64 * j) = x1[j];
                    s2 += (x1[j].x * x1[j].x + x1[j].y * x1[j].y) + (x1[j].z * x1[j].z + x1[j].w * x1[j].w); }
                const float rstd2 = __builtin_amdgcn_rsqf(wave_sum(s2) * (1.f / DM) + RMS_EPS);
                GAS int* o4 = (GAS int*)((unsigned char*)XN + (size_t)m * DM) + lane;
#pragma unroll
                for (int j = 0; j < 4; ++j) { const int col = 4 * lane + 256 * j;
                    const f32x4 gg = *(const f32x4*)(gfp + col), sh = *(const f32x4*)(MOD + b * 6144 + 3072 + col), scl = *(const f32x4*)(MOD + b * 6144 + 4096 + col);
                    const f32x4 h = x1[j] * rstd2 * gg * (scl + 1.f) + sh;
                    int w = __builtin_amdgcn_cvt_pk_fp8_f32(h[0] * SC_H2, h[1] * SC_H2, 0, false); w = __builtin_amdgcn_cvt_pk_fp8_f32(h[2] * SC_H2, h[3] * SC_H2, w, true); o4[64 * j] = w;
                    hreg[rr][j] = h; }
            }
            const bool b5 = (lane & 32) != 0, b4 = (lane & 16) != 0, b3 = (lane & 8) != 0;
            float t0 = -3.0e38f, t1 = -3.0e38f, t2 = -3.0e38f, t3 = -3.0e38f; int i0 = 0, i1 = 0, i2 = 0, i3 = 0;
#pragma unroll 2
            for (int e = 0; e < NEXP; ++e) {
                f32x4 w[4];
#pragma unroll
                for (int j = 0; j < 4; ++j) w[j] = *(const GAS f32x4*)(WRT + e * 1024 + 4 * lane + 256 * j);
                float p[8];
#pragma unroll
                for (int r = 0; r < 8; ++r) { f32x4 a = hreg[r][0] * w[0]; a += hreg[r][1] * w[1]; a += hreg[r][2] * w[2]; a += hreg[r][3] * w[3]; p[r] = (a.x + a.y) + (a.z + a.w); }
                float q[4], u[2];
#pragma unroll
                for (int i = 0; i < 4; ++i) { const float keep = b5 ? p[i + 4] : p[i], send = b5 ? p[i] : p[i + 4]; q[i] = keep + __shfl_xor(send, 32); }
#pragma unroll
                for (int i = 0; i < 2; ++i) { const float keep = b4 ? q[i + 2] : q[i], send = b4 ? q[i] : q[i + 2]; u[i] = keep + __shfl_xor(send, 16); }
                float v = (b3 ? u[1] : u[0]) + __shfl_xor(b3 ? u[0] : u[1], 8);
                v += __shfl_xor(v, 4); v += __shfl_xor(v, 2); v += __shfl_xor(v, 1);
                v += br[e];
                const bool c0 = v > t0, c1 = v > t1, c2 = v > t2, c3 = v > t3;
                t3 = c2 ? t2 : (c3 ? v : t3); i3 = c2 ? i2 : (c3 ? e : i3);
                t2 = c1 ? t1 : (c2 ? v : t2); i2 = c1 ? i1 : (c2 ? e : i2);
                t1 = c0 ? t0 : (c1 ? v : t1); i1 = c0 ? i0 : (c1 ? e : i1);
                t0 = c0 ? v : t0;             i0 = c0 ? e : i0;
            }
            {   const float e1 = __builtin_amdgcn_exp2f((t1 - t0) * LOG2E), e2 = __builtin_amdgcn_exp2f((t2 - t0) * LOG2E), e3 = __builtin_amdgcn_exp2f((t3 - t0) * LOG2E);
                const float inv = 1.f / (1.f + e1 + e2 + e3);
                const int lrow = wave * 8 + (b5 ? 4 : 0) + (b4 ? 2 : 0) + (b3 ? 1 : 0), t = lane & 7;
                if (t < 4) { const int ee = t == 0 ? i0 : t == 1 ? i1 : t == 2 ? i2 : i3;
                    const float gg = (t == 0 ? 1.f : t == 1 ? e1 : t == 2 ? e2 : e3) * inv;
                    const int rk = __hip_atomic_fetch_add(&lcnt[ee], 1, __ATOMIC_RELAXED, __HIP_MEMORY_SCOPE_WORKGROUP);
                    sel_e[lrow * 4 + t] = ee; sel_g[lrow * 4 + t] = gg; sel_r[lrow * 4 + t] = rk; } }
            __syncthreads();
            if (tid < 32) lbase[tid] = (int)atomicAdd(CNT + tid, (unsigned)lcnt[tid]);
            __syncthreads();
            if (tid < 256) { const int ee = sel_e[tid], pos = lbase[ee] + sel_r[tid], tok = blk * 64 + (tid >> 2);
                LIST[(size_t)ee * LISTCAP + pos] = (unsigned)tok; TOKPOS[(size_t)tok * 4 + (tid & 3)] = ((unsigned)ee << 16) | (unsigned)pos; TOKG[(size_t)tok * 4 + (tid & 3)] = sel_g[tid]; }
            __syncthreads();
        }
    }
    SEAM(7);
    if (IN(8) || IN(9)) {
        LAS int* blk_e = (LAS int*)(L + TAB_BLK);
        if (tid == 0) { int nb = 0; for (int e = 0; e < NEXP; ++e) { const int c = (int)__hip_atomic_load(CNT + e, RLX_AGENT); const int n = (c + 255) >> 8; for (int i = 0; i < n; ++i) blk_e[nb + i] = e; nb += n; } MISC[16] = (unsigned)nb; }
        __syncthreads();
        const int NB = (int)MISC[16];
        if (IN(8)) for (int rep_ = 0; rep_ < NREP(8); ++rep_) {
            for (int i = 0;; ++i) { const long Lu = (long)i * G + bx; if (Lu >= (long)NB * 8 || i >= 11) break;
                const int grb = (int)(Lu >> 3), e = blk_e[grb]; int first = grb; while (first > 0 && blk_e[first - 1] == e) --first;
                const int cnt = (int)__hip_atomic_load(CNT + e, RLX_AGENT);
                if (tid < 256) { const int ri = (grb - first) * 256 + tid; const unsigned tok = (ri < cnt) ? LIST[(size_t)e * LISTCAP + ri] : 0u;
                    *(LAS unsigned*)(L + TAB_GATH + i * 1024 + tid * 4) = tok * 1024u; } }
            __syncthreads();
            pg8::SchedMoe<8, true> S{(const char*)XN, (const char*)W1T, (size_t)2048 * 1024, blk_e, NB, G, bx, TAB_GATH};
            pg8::EpiMoe1 E{args.in[I_B1], (unsigned char*)ACT};
            pg8::gemm_phase<pg8::EpiMoe1, pg8::SchedMoe<8, true>, true, true, true>(L, 8, 1024, 1024, S, E);
        }
        SEAM(8);
        if (IN(9)) for (int rep_ = 0; rep_ < NREP(9); ++rep_) {
            pg8::SchedMoe<4, false> S{(const char*)ACT, (const char*)W2T, (size_t)1024 * 1024, blk_e, NB, G, bx, 0};
            pg8::EpiMoe2 E{args.in[I_B2], YIT};
            pg8::gemm_phase<pg8::EpiMoe2, pg8::SchedMoe<4, false>, true, false, true>(L, 8, 1024, 1024, S, E);
        }
    }
    SEAM(9);
    if (IN(10)) {
        LAS int* rbase = (LAS int*)(L + 0);
        if (tid == 0) { int nb = 0; for (int e = 0; e < NEXP; ++e) { rbase[e] = nb * 256; nb += ((int)__hip_atomic_load(CNT + e, RLX_AGENT) + 255) >> 8; } }
        __syncthreads();
        const float* gfo = args.in[I_GFPOST];
        for (int m = gw; m < MTOK; m += NGW) { const int b = m >> 13;
            f32x4 y[4];
#pragma unroll
            for (int j = 0; j < 4; ++j) y[j] = (f32x4){0.f, 0.f, 0.f, 0.f};
#pragma unroll
            for (int t = 0; t < 4; ++t) { const unsigned tp = TOKPOS[(size_t)m * 4 + t]; const float gt = TOKG[(size_t)m * 4 + t];
                const size_t row = (size_t)rbase[tp >> 16] + (tp & 0xffffu); const GAS u32x2* yr = (const GAS u32x2*)(YIT + row * 1024) + lane;
#pragma unroll
                for (int j = 0; j < 4; ++j) { const u32x2 w = yr[64 * j]; y[j][0] += gt * bf16_lo(w.x); y[j][1] += gt * bf16_hi(w.x); y[j][2] += gt * bf16_lo(w.y); y[j][3] += gt * bf16_hi(w.y); } }
            float s = 0.f;
#pragma unroll
            for (int j = 0; j < 4; ++j) s += (y[j].x * y[j].x + y[j].y * y[j].y) + (y[j].z * y[j].z + y[j].w * y[j].w);
            const float rstd = __builtin_amdgcn_rsqf(wave_sum(s) * (1.f / DM) + RMS_EPS);
            GAS f32x4* orow = (GAS f32x4*)(OUT + (size_t)m * DM) + lane;
#pragma unroll
            for (int j = 0; j < 4; ++j) { const int col = 4 * lane + 256 * j;
                const f32x4 gg = *(const f32x4*)(gfo + col), gf = *(const f32x4*)(MOD + b * 6144 + 5120 + col);
                orow[64 * j] = orow[64 * j] + gf * (y[j] * rstd * gg); } }
    }
#undef IN
#undef SEAM
}

constexpr int N_PHASES = 11;
extern "C" void kernel_launch(void* const* d_in, const int* in_sizes, int n_in, void* d_out, int out_size, void* d_ws, size_t ws_size, hipStream_t stream) {
    static int grid = 0;
    if (grid == 0) {
        if (n_in != 24 || out_size != MTOK * DM || ws_size < WS_END) { fprintf(stderr, "kernel_launch: unexpected shapes (n_in %d out %d ws %zu)\n", n_in, out_size, ws_size); grid = -1; return; }
        int dev = 0, cus = 0, per_cu = 0;
        if (hipGetDevice(&dev) != hipSuccess || hipDeviceGetAttribute(&cus, hipDeviceAttributeMultiprocessorCount, dev) != hipSuccess) { grid = -1; return; }
        if (hipFuncSetAttribute((const void*)fwd_kernel, hipFuncAttributeMaxDynamicSharedMemorySize, LDS_BYTES) != hipSuccess) { fprintf(stderr, "kernel_launch: hipFuncSetAttribute failed\n"); grid = -1; return; }
        if (hipOccupancyMaxActiveBlocksPerMultiprocessor(&per_cu, (const void*)fwd_kernel, NWAVES * 64, LDS_BYTES) != hipSuccess || per_cu < 1) { fprintf(stderr, "kernel_launch: occupancy query says %d\n", per_cu); per_cu = 1; }
        (void)hipGetLastError();
        grid = cus;
    }
    if (grid < 0) return;
    (void)hipMemsetAsync((char*)d_ws + WS_CTL, 0, CTL_ZERO_BYTES, stream);
    Args a{};
    for (int i = 0; i < 24; ++i) a.in[i] = (const float*)d_in[i];
    a.out = (float*)d_out; a.ws = (unsigned char*)d_ws;
#if MK_N_LAUNCHES == 1
    a.ph_lo = 0; a.ph_hi = N_PHASES;
    {   void* kargs[] = {(void*)&a};
        const hipError_t ce = hipLaunchCooperativeKernel((const void*)fwd_kernel, dim3(grid), dim3(NWAVES * 64), kargs, LDS_BYTES, stream);
        if (ce != hipSuccess) fprintf(stderr, "kernel_launch: cooperative launch failed: %s (grid %d)\n", hipGetErrorName(ce), grid); }
#else
    for (int p = 0; p < N_PHASES; ++p) { a.ph_lo = p; a.ph_hi = p + 1; hipLaunchKernelGGL(fwd_kernel, dim3(grid), dim3(NWAVES * 64), LDS_BYTES, stream, a); }
#endif
    const hipError_t le = hipPeekAtLastError();
    if (le != hipSuccess) fprintf(stderr, "kernel_launch: launch failed: %s\n", hipGetErrorName(le));
}
```

```cpp
#include <hip/hip_runtime.h>
#include <hip/hip_bf16.h>
#include <cstdio>
#include <cstdint>

#ifndef MK_N_LAUNCHES
#define MK_N_LAUNCHES 1
#endif

constexpr int BATCH = 2, SEQ = 8192, DM = 1024, MTOK = BATCH * SEQ;
constexpr int NPROJ = 4352;
constexpr int NEXP = 32, DFF = 1024, TOPK = 4;
constexpr int QLORA = 384, KVLORA = 256;
constexpr float RMS_EPS = 1e-6f;
constexpr float LOG2E = 1.4426950408889634f;
constexpr float C2NA = 0.125f * LOG2E;
constexpr float C2MLA = 0.10206207261596575f * LOG2E;
constexpr float SC_H2 = 8.f, SC_W = 64.f, SC_ACT = 4.f;
constexpr int NG_INPROJ = 218;
constexpr int LISTCAP = 16384;
constexpr int MAXROWS = 65536 + NEXP * 256;

#define GAS __attribute__((address_space(1)))
#define LAS __attribute__((address_space(3)))
typedef unsigned short bf16_t;
typedef short bf16x8 __attribute__((ext_vector_type(8)));
typedef short s16x4 __attribute__((ext_vector_type(4)));
typedef float f32x4 __attribute__((ext_vector_type(4)));
typedef float f32x2 __attribute__((ext_vector_type(2)));
typedef float f32x16 __attribute__((ext_vector_type(16)));
typedef unsigned u32x4 __attribute__((ext_vector_type(4)));
typedef unsigned u32x2 __attribute__((ext_vector_type(2)));
typedef GAS unsigned gu32;

__device__ __forceinline__ unsigned cvt_pk_bf16(float lo, float hi) { unsigned r; asm volatile("v_cvt_pk_bf16_f32 %0, %1, %2" : "=v"(r) : "v"(lo), "v"(hi)); return r; }
__device__ __forceinline__ float bf16_lo(unsigned w) { return __uint_as_float(w << 16); }
__device__ __forceinline__ float bf16_hi(unsigned w) { return __uint_as_float(w & 0xffff0000u); }
__device__ __forceinline__ float sigmoidf_(float z) { return __builtin_amdgcn_rcpf(1.f + __builtin_amdgcn_exp2f(-z * LOG2E)); }
__device__ __forceinline__ float wave_sum(float v) {
#pragma unroll
    for (int o = 1; o < 64; o <<= 1) v += __shfl_xor(v, o);
    return v;
}
__device__ __forceinline__ void rope_cs(float pos, int j, float& c, float& s) {
    const float inv = __builtin_amdgcn_exp2f(-(float)j * 0.83048202372184059f);
    const float rev = __builtin_amdgcn_fractf(pos * inv * 0.15915494309189535f);
    c = __builtin_amdgcn_cosf(rev); s = __builtin_amdgcn_sinf(rev);
}

namespace pg8 {
constexpr int BM = 256, BK = 64, HALF = 128, HTB = HALF * BK * 2, STAGE_BYTES = 8 * HTB, NXCD = 8, WGM = 8;
__host__ __device__ __forceinline__ int lds_byte(int r, int c) { const int st = (r >> 4) * 2 + (c >> 5), rr = r & 15, cc = c & 31, ob = rr * 64 + cc * 2; return st * 1024 + (ob ^ (((ob >> 9) & 1) << 5)); }
__host__ __device__ __forceinline__ void stage_rc(int b, int& R, int& C) { const int st = b / 1024, sb = b % 1024, swz = sb ^ (((sb >> 9) & 1) << 5); R = (st >> 1) * 16 + swz / 64; C = (st & 1) * 32 + (swz % 64) / 2; }
__host__ __device__ __forceinline__ int perm32(int rho) { const int n = rho >> 4, i = rho & 15; return 8 * (i >> 2) + 4 * n + (i & 3); }

struct Unit { const char* A; const char* B; int pm, pn, aux, tab; };

__device__ __forceinline__ void tile_of(int wgid, int nM, int nN, int& pm, int& pn) {
    const int nwg = nM * nN;
    { const int q = nwg / NXCD, r = nwg % NXCD, xcd = wgid % NXCD, off = wgid / NXCD; wgid = (xcd < r ? xcd * (q + 1) : r * (q + 1) + (xcd - r) * q) + off; }
    const int nig = WGM * nN, gid = wgid / nig, fm = gid * WGM, gsz = (nM - fm) < WGM ? (nM - fm) : WGM;
    pm = fm + ((wgid % nig) % gsz); pn = (wgid % nig) / gsz;
}

typedef int v8i32 __attribute__((ext_vector_type(8)));
typedef int v4i32_ __attribute__((ext_vector_type(4)));
template <class Epi, class Sched, bool ALIGN_EPI, bool GATHER, bool FP8>
__device__ __forceinline__ void gemm_phase(LAS unsigned char* lds, const int nt, const int ldab, const int ldbb, const Sched& S, const Epi& E) {
    const int tid = threadIdx.x, wid = __builtin_amdgcn_readfirstlane(tid >> 6), lane = tid & 63, wr = wid >> 2, wc = wid & 3, fr = lane & 15, fq = lane >> 4;
    int Rr[2], Cc[2];
    unsigned voffA[2], voffB[2];
#pragma unroll
    for (int i = 0; i < 2; ++i) { int R, C; stage_rc(tid * 16 + i * 8192, R, C); const int Rb = Epi::PERM ? ((R & ~31) + perm32(R & 31)) : R;
        Rr[i] = R; Cc[i] = C; voffA[i] = (unsigned)(R * ldab + C * 2); voffB[i] = (unsigned)(Rb * ldbb + C * 2); }
    const size_t kstep = (size_t)(BK * 2);
    const size_t hstepA = (size_t)HALF * ldab, hstepB = (size_t)HALF * ldbb;
    const unsigned ldsw = (unsigned)wid * 1024u;
    const int aoff = lds_byte(wr * 64 + fr, fq * 8), boff = lds_byte(wc * 32 + fr, fq * 8);
#define PG8_SA(b, h) (((b) * 2 + (h)) * HTB)
#define PG8_SB(b, h) ((4 + (b) * 2 + (h)) * HTB)
#define PG8_STAGE(bufoff, gbase, voff) do { _Pragma("unroll") for (int _i = 0; _i < 2; ++_i) \
        __builtin_amdgcn_global_load_lds((const unsigned*)((const char*)(gbase) + (voff)[_i]), (LAS unsigned*)(lds + (bufoff) + ldsw + _i * 8192), 16, 0, 0); } while (0)
#define PG8_STAGE_A(bufoff, gbase, h, G) do { if constexpr (GATHER) { PG8_STAGE(bufoff, gbase, (G)[h]); } else { PG8_STAGE(bufoff, (gbase) + (h) * hstepA, voffA); } } while (0)
#define PG8_STAGE_B(bufoff, gbase, h) PG8_STAGE(bufoff, (gbase) + (h) * hstepB, voffB)
#define PG8_LD8(addr) __builtin_shufflevector(*(const LAS v4i32_*)(addr), *(const LAS v4i32_*)((addr) + 1024), 0, 1, 2, 3, 4, 5, 6, 7)
#define PG8_LDA(dst, b, h) do { if constexpr (FP8) { _Pragma("unroll") for (int m = 0; m < 4; ++m) dst##8[m] = PG8_LD8(lds + PG8_SA(b, h) + aoff + m * 2048); } \
        else { _Pragma("unroll") for (int m = 0; m < 4; ++m) _Pragma("unroll") for (int k = 0; k < 2; ++k) dst[m][k] = *(const LAS bf16x8*)(lds + PG8_SA(b, h) + aoff + m * 2048 + k * 1024); } } while (0)
#define PG8_LDB(dst, b, h) do { if constexpr (FP8) { _Pragma("unroll") for (int n = 0; n < 2; ++n) dst##8[n] = PG8_LD8(lds + PG8_SB(b, h) + boff + n * 2048); } \
        else { _Pragma("unroll") for (int n = 0; n < 2; ++n) _Pragma("unroll") for (int k = 0; k < 2; ++k) dst[n][k] = *(const LAS bf16x8*)(lds + PG8_SB(b, h) + boff + n * 2048 + k * 1024); } } while (0)
#define PG8_MMA(ai, bj, At, Bt) do { __builtin_amdgcn_s_setprio(1); _Pragma("unroll") for (int m = 0; m < 4; ++m) _Pragma("unroll") for (int n = 0; n < 2; ++n) { \
        if constexpr (FP8) { asm volatile("v_mfma_scale_f32_16x16x128_f8f6f4 %0, %1, %2, %0, %3, %3 op_sel_hi:[0,0,0]" : "+v"(acc[ai][bj][m][n]) : "v"(Bt##8[n]), "v"(At##8[m]), "v"(sc1_)); } \
        else { _Pragma("unroll") for (int k = 0; k < 2; ++k) acc[ai][bj][m][n] = __builtin_amdgcn_mfma_f32_16x16x32_bf16(Bt[n][k], At[m][k], acc[ai][bj][m][n], 0, 0, 0); } } \
        __builtin_amdgcn_s_setprio(0); } while (0)
#define PG8_WAIT_V(n) asm volatile("s_waitcnt vmcnt(" #n ")" ::: "memory")
#define PG8_WAIT_L(n) asm volatile("s_waitcnt lgkmcnt(" #n ")" ::: "memory")
#define PG8_BAR __builtin_amdgcn_s_barrier()
#define PG8_SCHED __builtin_amdgcn_sched_barrier(0)
    Unit cur, nxt; int ui = 0;
    if (!S.next(0, cur)) return;
    f32x4 acc[2][2][4][2];
#pragma unroll
    for (int a = 0; a < 2; ++a)
#pragma unroll
        for (int b = 0; b < 2; ++b)
#pragma unroll
            for (int m = 0; m < 4; ++m)
#pragma unroll
                for (int n = 0; n < 2; ++n) acc[a][b][m][n] = (f32x4){0.f, 0.f, 0.f, 0.f};
    bf16x8 At[4][2], B0[2][2], B1[2][2]; v8i32 At8[4], B08[2], B18[2];
    int sc1_ = 0x7F7F7F7F; asm volatile("" : "+v"(sc1_));
    unsigned gC[2][2], gN[2][2];
#define PG8_GLOAD(G, u) do { if constexpr (GATHER) { const LAS unsigned* tb_ = (const LAS unsigned*)(lds + (u).tab); _Pragma("unroll") for (int h_ = 0; h_ < 2; ++h_) _Pragma("unroll") for (int i_ = 0; i_ < 2; ++i_) \
        (G)[h_][i_] = tb_[h_ * 128 + Rr[i_]] + (unsigned)(Cc[i_] * 2); } } while (0)
    PG8_GLOAD(gC, cur);
    const char* cA = cur.A; const char* cB = cur.B;
    PG8_STAGE_B(PG8_SB(0, 0), cB, 0); PG8_STAGE_B(PG8_SB(0, 1), cB, 1); PG8_STAGE_A(PG8_SA(0, 0), cA, 0, gC); PG8_STAGE_A(PG8_SA(0, 1), cA, 1, gC);
    if (wr == 1) PG8_BAR;
    PG8_WAIT_V(2); PG8_BAR;
    PG8_STAGE_B(PG8_SB(1, 0), cB + kstep, 0); PG8_STAGE_A(PG8_SA(1, 0), cA + kstep, 0, gC); PG8_STAGE_B(PG8_SB(1, 1), cB + kstep, 1);
    PG8_WAIT_V(6); PG8_BAR;
    for (;;) {
        const bool has_next = S.next(ui + 1, nxt);
        const char* nA = has_next ? nxt.A : cA; const char* nB = has_next ? nxt.B : cB;
        if constexpr (GATHER) { if (has_next) { PG8_GLOAD(gN, nxt); } else {
#pragma unroll
            for (int h_ = 0; h_ < 2; ++h_)
#pragma unroll
                for (int i_ = 0; i_ < 2; ++i_) gN[h_][i_] = gC[h_][i_]; } }
#pragma unroll 1
        for (int t = 0; t < nt; t += 2) {
            const bool last = (t == nt - 2);
            const char* a1 = cA + (size_t)(t + 1) * kstep;
            const char* a2 = last ? nA : cA + (size_t)(t + 2) * kstep; const char* b2 = last ? nB : cB + (size_t)(t + 2) * kstep;
            const char* a3 = a2 + kstep; const char* b3 = b2 + kstep;
            unsigned g2[2][2];
            if constexpr (GATHER) {
#pragma unroll
                for (int h_ = 0; h_ < 2; ++h_)
#pragma unroll
                    for (int i_ = 0; i_ < 2; ++i_) g2[h_][i_] = last ? gN[h_][i_] : gC[h_][i_]; }
            PG8_LDB(B0, 0, 0); PG8_LDB(B1, 0, 1); PG8_SCHED; PG8_LDA(At, 0, 0); PG8_STAGE_A(PG8_SA(1, 1), a1, 1, gC);
            PG8_WAIT_V(8); PG8_WAIT_L(0); PG8_BAR; PG8_MMA(0, 0, At, B0); PG8_MMA(0, 1, At, B1); PG8_BAR; PG8_SCHED;
            PG8_LDA(At, 0, 1); PG8_STAGE_B(PG8_SB(0, 0), b2, 0); PG8_STAGE_B(PG8_SB(0, 1), b2, 1); PG8_STAGE_A(PG8_SA(0, 0), a2, 0, g2);
            PG8_WAIT_V(8); PG8_WAIT_L(0); PG8_BAR; PG8_MMA(1, 0, At, B0); PG8_MMA(1, 1, At, B1); PG8_BAR; PG8_SCHED;
            PG8_LDB(B0, 1, 0); PG8_LDB(B1, 1, 1); PG8_SCHED; PG8_LDA(At, 1, 0); PG8_STAGE_A(PG8_SA(0, 1), a2, 1, g2);
            PG8_WAIT_V(8); PG8_WAIT_L(0); PG8_BAR; PG8_MMA(0, 0, At, B0); PG8_MMA(0, 1, At, B1); PG8_BAR; PG8_SCHED;
            PG8_LDA(At, 1, 1); PG8_STAGE_B(PG8_SB(1, 0), b3, 0); PG8_STAGE_B(PG8_SB(1, 1), b3, 1); PG8_STAGE_A(PG8_SA(1, 0), a3, 0, g2);
            PG8_WAIT_V(8); PG8_WAIT_L(0); PG8_BAR; PG8_MMA(1, 0, At, B0); PG8_MMA(1, 1, At, B1); PG8_BAR; PG8_SCHED;
        }
        if constexpr (ALIGN_EPI) { if (wr == 0) PG8_BAR; }
        if constexpr (FP8) asm volatile("s_nop 15\n\ts_nop 15" ::: "memory");
        E(acc, cur, wr, wc, fr, fq);
        if (!has_next) break;
#pragma unroll
        for (int a = 0; a < 2; ++a)
#pragma unroll
            for (int b = 0; b < 2; ++b)
#pragma unroll
                for (int m = 0; m < 4; ++m)
#pragma unroll
                    for (int n = 0; n < 2; ++n) acc[a][b][m][n] = (f32x4){0.f, 0.f, 0.f, 0.f};
        cur = nxt; cA = nA; cB = nB; ++ui;
        if constexpr (GATHER) {
#pragma unroll
            for (int h_ = 0; h_ < 2; ++h_)
#pragma unroll
                for (int i_ = 0; i_ < 2; ++i_) gC[h_][i_] = gN[h_][i_]; }
        if constexpr (ALIGN_EPI) { if (wr == 1) PG8_BAR; }
    }
    PG8_WAIT_V(0);
    if constexpr (!ALIGN_EPI) { if (wr == 0) PG8_BAR; }
    PG8_BAR;
#undef PG8_SA
#undef PG8_SB
#undef PG8_STAGE
#undef PG8_STAGE_A
#undef PG8_STAGE_B
#undef PG8_LDA
#undef PG8_LD8
#undef PG8_LDB
#undef PG8_MMA
#undef PG8_WAIT_V
#undef PG8_WAIT_L
#undef PG8_BAR
#undef PG8_SCHED
#undef PG8_GLOAD
}

typedef f32x4 Acc[2][2][4][2];

struct SchedDense {
    const char* A; const char* B; size_t a_tile_bytes, b_tile_bytes; int nM, nN, G, c;
    __device__ __forceinline__ bool next(int i, Unit& u) const {
        const long L = (long)i * G + c; if (L >= (long)nM * nN) return false;
        int pm, pn; tile_of((int)L, nM, nN, pm, pn);
        u.pm = pm; u.pn = pn; u.aux = 0; u.tab = 0; u.A = A + (size_t)pm * a_tile_bytes; u.B = B + (size_t)pn * b_tile_bytes; return true;
    }
};
struct SchedMerge {
    const char* A0; const char* A1; const char* B0; const char* B1; int nM, nN, G, c;
    __device__ __forceinline__ bool next(int i, Unit& u) const {
        const long T = (long)(i >> 1) * G + c; if (T >= (long)nM * nN) return false;
        int pm, pn; tile_of((int)T, nM, nN, pm, pn);
        const int sub = i & 1; u.pm = pm; u.pn = pn; u.aux = sub; u.tab = 0;
        u.A = (sub ? A1 : A0) + (size_t)pm * (256 * 512 * 2); u.B = (sub ? B1 : B0) + (size_t)pn * (256 * 512 * 2); return true;
    }
};
template <int NPN, bool GATHER>
struct SchedMoe {
    const char* A; const char* B; size_t b_expert_bytes; LAS const int* blk_e; int NB, G, c, tab0;
    __device__ __forceinline__ bool next(int i, Unit& u) const {
        const long L = (long)i * G + c; if (L >= (long)NB * NPN) return false;
        const int grb = (int)(L / NPN), pn = (int)(L % NPN);
        const int e = __builtin_amdgcn_readfirstlane(blk_e[grb]);
        u.pm = grb; u.pn = pn; u.aux = e; u.tab = tab0 + i * 1024;
        u.A = GATHER ? A : A + (size_t)grb * (256 * 1024);
        u.B = B + (size_t)e * b_expert_bytes + (size_t)pn * (256 * 1024); return true;
    }
};

struct EpiInProj {
    static constexpr bool PERM = true;
    bf16_t* PROJ; float* SSQ; bf16_t* KR; const float* ROPE;
    __device__ __forceinline__ void operator()(const Acc& acc, const Unit& u, int wr, int wc, int fr, int fq) const {
        const int pn = u.pn, row0 = u.pm * BM + wr * 64 + fr, colb = pn * BM + wc * 32 + 8 * fq;
        const float sc = (pn < 2) ? C2NA : 1.f;
#pragma unroll
        for (int ai = 0; ai < 2; ++ai)
#pragma unroll
            for (int m = 0; m < 4; ++m) { const int row = row0 + ai * HALF + m * 16; bf16_t* rowp = PROJ + (size_t)row * NPROJ + colb;
#pragma unroll
                for (int bj = 0; bj < 2; ++bj) { const f32x4 v0 = acc[ai][bj][m][0] * sc, v1 = acc[ai][bj][m][1] * sc; u32x4 w;
                    w.x = cvt_pk_bf16(v0[0], v0[1]); w.y = cvt_pk_bf16(v0[2], v0[3]); w.z = cvt_pk_bf16(v1[0], v1[1]); w.w = cvt_pk_bf16(v1[2], v1[3]);
                    *(u32x4*)(rowp + bj * HALF) = w; } }
        if (pn >= 6 && pn <= 8) {
#pragma unroll
            for (int ai = 0; ai < 2; ++ai)
#pragma unroll
                for (int m = 0; m < 4; ++m) { const int row = row0 + ai * HALF + m * 16; float s[2];
#pragma unroll
                    for (int bj = 0; bj < 2; ++bj) { const f32x4 a = acc[ai][bj][m][0], b = acc[ai][bj][m][1];
                        float t = (a[0] * a[0] + a[1] * a[1]) + (a[2] * a[2] + a[3] * a[3]) + (b[0] * b[0] + b[1] * b[1]) + (b[2] * b[2] + b[3] * b[3]);
                        t += __shfl_xor(t, 16); t += __shfl_xor(t, 32); s[bj] = t; }
                    if (fq == 0) {
                        float* sp = SSQ + (size_t)row * 16 + wc;
                        if (pn == 6) { sp[0] = s[0] + s[1]; }
                        else if (pn == 7) { sp[4] = s[0]; sp[8] = s[1]; }
                        else { sp[12] = s[0]; }
                    } }
            if (pn == 8 && wc == 0) {
#pragma unroll
                for (int ai = 0; ai < 2; ++ai)
#pragma unroll
                    for (int m = 0; m < 4; ++m) { const int row = row0 + ai * HALF + m * 16, tok = row & (SEQ - 1);
                        const int pos = (fq >> 1) ? (tok & 63) : (tok >> 6); float o[8];
                        const f32x4 cs4 = *(const f32x4*)(ROPE + pos * 16 + 4 * (fq & 1)), sn4 = *(const f32x4*)(ROPE + pos * 16 + 8 + 4 * (fq & 1));
#pragma unroll
                        for (int n = 0; n < 2; ++n)
#pragma unroll
                            for (int q = 0; q < 2; ++q) { const float c = cs4[2 * n + q], s = sn4[2 * n + q];
                                const float x1 = acc[ai][1][m][n][2 * q], x2 = acc[ai][1][m][n][2 * q + 1];
                                o[4 * n + 2 * q] = x1 * c - x2 * s; o[4 * n + 2 * q + 1] = x1 * s + x2 * c; }
                        u32x4 w; w.x = cvt_pk_bf16(o[0], o[1]); w.y = cvt_pk_bf16(o[2], o[3]); w.z = cvt_pk_bf16(o[4], o[5]); w.w = cvt_pk_bf16(o[6], o[7]);
                        *(u32x4*)(KR + (size_t)row * 32 + 8 * fq) = w; }
            }
        }
    }
};
struct EpiQUp {
    static constexpr bool PERM = true;
    bf16_t* QN; bf16_t* QR; const float* SSQ; const float* ROPE;
    __device__ __forceinline__ void operator()(const Acc& acc, const Unit& u, int wr, int wc, int fr, int fq) const {
        const int pn = u.pn, row0 = u.pm * BM + wr * 64 + fr, colt = wc * 32 + 8 * fq;
#pragma unroll
        for (int ai = 0; ai < 2; ++ai)
#pragma unroll
            for (int m = 0; m < 4; ++m) { const int row = row0 + ai * HALF + m * 16;
                const f32x4 q0_ = *(const f32x4*)(SSQ + (size_t)row * 16), q1_ = *(const f32x4*)(SSQ + (size_t)row * 16 + 4);
                const float rs = __builtin_amdgcn_rsqf((((q0_[0] + q0_[1]) + (q0_[2] + q0_[3])) + ((q1_[0] + q1_[1]) + (q1_[2] + q1_[3]))) * (1.f / QLORA) + RMS_EPS) * C2MLA;
                if (pn < 2) {
#pragma unroll
                    for (int bj = 0; bj < 2; ++bj) { const f32x4 v0 = acc[ai][bj][m][0] * rs, v1 = acc[ai][bj][m][1] * rs; u32x4 w;
                        w.x = cvt_pk_bf16(v0[0], v0[1]); w.y = cvt_pk_bf16(v0[2], v0[3]); w.z = cvt_pk_bf16(v1[0], v1[1]); w.w = cvt_pk_bf16(v1[2], v1[3]);
                        *(u32x4*)(QN + (size_t)row * 512 + pn * 256 + bj * HALF + colt) = w; }
                } else {
                    const int tok = row & (SEQ - 1); const int pos = (fq >> 1) ? (tok & 63) : (tok >> 6);
                    const f32x4 cs4 = *(const f32x4*)(ROPE + pos * 16 + 4 * (fq & 1)), sn4 = *(const f32x4*)(ROPE + pos * 16 + 8 + 4 * (fq & 1));
#pragma unroll
                    for (int bj = 0; bj < 2; ++bj) { float o[8];
#pragma unroll
                        for (int n = 0; n < 2; ++n)
#pragma unroll
                            for (int q = 0; q < 2; ++q) { const float c = cs4[2 * n + q], s = sn4[2 * n + q];
                                const float x1 = acc[ai][bj][m][n][2 * q] * rs, x2 = acc[ai][bj][m][n][2 * q + 1] * rs;
                                o[4 * n + 2 * q] = x1 * c - x2 * s; o[4 * n + 2 * q + 1] = x1 * s + x2 * c; }
                        u32x4 w; w.x = cvt_pk_bf16(o[0], o[1]); w.y = cvt_pk_bf16(o[2], o[3]); w.z = cvt_pk_bf16(o[4], o[5]); w.w = cvt_pk_bf16(o[6], o[7]);
                        *(u32x4*)(QR + (size_t)row * 256 + bj * HALF + colt) = w; }
                }
                asm volatile("" ::: "memory"); }
    }
};
struct EpiKVUp {
    static constexpr bool PERM = true;
    bf16_t* KN; bf16_t* VM; const float* SSQ;
    __device__ __forceinline__ void operator()(const Acc& acc, const Unit& u, int wr, int wc, int fr, int fq) const {
        const int pn = u.pn, row0 = u.pm * BM + wr * 64 + fr, colt = wc * 32 + 8 * fq;
        bf16_t* dst = (pn < 2) ? KN + pn * 256 : VM + (pn - 2) * 256;
#pragma unroll
        for (int ai = 0; ai < 2; ++ai)
#pragma unroll
            for (int m = 0; m < 4; ++m) { const int row = row0 + ai * HALF + m * 16;
                const f32x4 q0_ = *(const f32x4*)(SSQ + (size_t)row * 16 + 8), q1_ = *(const f32x4*)(SSQ + (size_t)row * 16 + 12);
                const float rs = __builtin_amdgcn_rsqf((((q0_[0] + q0_[1]) + (q0_[2] + q0_[3])) + ((q1_[0] + q1_[1]) + (q1_[2] + q1_[3]))) * (1.f / KVLORA) + RMS_EPS);
#pragma unroll
                for (int bj = 0; bj < 2; ++bj) { const f32x4 v0 = acc[ai][bj][m][0] * rs, v1 = acc[ai][bj][m][1] * rs; u32x4 w;
                    w.x = cvt_pk_bf16(v0[0], v0[1]); w.y = cvt_pk_bf16(v0[2], v0[3]); w.z = cvt_pk_bf16(v1[0], v1[1]); w.w = cvt_pk_bf16(v1[2], v1[3]);
                    *(u32x4*)(dst + (size_t)row * 512 + bj * HALF + colt) = w; } }
    }
};
struct EpiMerge {
    static constexpr bool PERM = true;
    const bf16_t* PROJ; const float* bgate; float* TMP; bf16_t* MERGED;
    __device__ __forceinline__ void operator()(const Acc& acc, const Unit& u, int wr, int wc, int fr, int fq) const {
        const int sub = u.aux, row0 = u.pm * BM + wr * 64 + fr, col0 = u.pn * BM + wc * 32 + 8 * fq;
        f32x4 bg[2][2];
#pragma unroll
        for (int bj = 0; bj < 2; ++bj)
#pragma unroll
            for (int n = 0; n < 2; ++n) bg[bj][n] = *(const f32x4*)(bgate + sub * 1024 + col0 + bj * HALF + 4 * n);
#pragma unroll
        for (int ai = 0; ai < 2; ++ai)
#pragma unroll
            for (int m = 0; m < 4; ++m) { const int row = row0 + ai * HALF + m * 16;
#pragma unroll
                for (int bj = 0; bj < 2; ++bj) { const int col = col0 + bj * HALF;
                    const u32x4 gl = *(const u32x4*)(PROJ + (size_t)row * NPROJ + 2304 + sub * 1024 + col);
                    f32x4 g0, g1;
                    g0[0] = sigmoidf_(bf16_lo(gl.x) + bg[bj][0][0]); g0[1] = sigmoidf_(bf16_hi(gl.x) + bg[bj][0][1]); g0[2] = sigmoidf_(bf16_lo(gl.y) + bg[bj][0][2]); g0[3] = sigmoidf_(bf16_hi(gl.y) + bg[bj][0][3]);
                    g1[0] = sigmoidf_(bf16_lo(gl.z) + bg[bj][1][0]); g1[1] = sigmoidf_(bf16_hi(gl.z) + bg[bj][1][1]); g1[2] = sigmoidf_(bf16_lo(gl.w) + bg[bj][1][2]); g1[3] = sigmoidf_(bf16_hi(gl.w) + bg[bj][1][3]);
                    f32x4 v0 = acc[ai][bj][m][0] * g0, v1 = acc[ai][bj][m][1] * g1;
                    float* tp = TMP + (size_t)row * 1024 + col;
                    if (sub == 0) { *(f32x4*)tp = v0; *(f32x4*)(tp + 4) = v1; }
                    else { v0 += *(const f32x4*)tp; v1 += *(const f32x4*)(tp + 4); u32x4 w;
                        w.x = cvt_pk_bf16(v0[0], v0[1]); w.y = cvt_pk_bf16(v0[2], v0[3]); w.z = cvt_pk_bf16(v1[0], v1[1]); w.w = cvt_pk_bf16(v1[2], v1[3]);
                        *(u32x4*)(MERGED + (size_t)row * 1024 + col) = w; } } }
    }
};
struct EpiF32 {
    static constexpr bool PERM = false;
    float* C; int ldc;
    __device__ __forceinline__ void operator()(const Acc& acc, const Unit& u, int wr, int wc, int fr, int fq) const {
        const int row0 = u.pm * BM + wr * 64 + fr, col0 = u.pn * BM + wc * 32 + 4 * fq;
#pragma unroll
        for (int ai = 0; ai < 2; ++ai)
#pragma unroll
            for (int m = 0; m < 4; ++m) { float* rowp = C + (size_t)(row0 + ai * HALF + m * 16) * ldc + col0;
#pragma unroll
                for (int bj = 0; bj < 2; ++bj)
#pragma unroll
                    for (int n = 0; n < 2; ++n) *(f32x4*)(rowp + bj * HALF + n * 16) = acc[ai][bj][m][n]; }
    }
};
struct EpiMoe1 {
    static constexpr bool PERM = true;
    const float* b1; unsigned char* ACT;
    __device__ __forceinline__ void operator()(const Acc& acc, const Unit& u, int wr, int wc, int fr, int fq) const {
        const int e = u.aux, row0 = u.pm * BM + wr * 64 + fr, col0 = u.pn * BM + wc * 32 + 8 * fq;
        constexpr float DS = 1.f / (SC_H2 * SC_W);
        f32x4 bv[2][2];
#pragma unroll
        for (int bj = 0; bj < 2; ++bj)
#pragma unroll
            for (int n = 0; n < 2; ++n) bv[bj][n] = *(const f32x4*)(b1 + (size_t)e * 2048 + col0 + bj * HALF + 4 * n);
#pragma unroll
        for (int ai = 0; ai < 2; ++ai)
#pragma unroll
            for (int m = 0; m < 4; ++m) { const int row = row0 + ai * HALF + m * 16;
#pragma unroll
                for (int bj = 0; bj < 2; ++bj) { float o[4];
#pragma unroll
                    for (int n = 0; n < 2; ++n) { const f32x4 v = acc[ai][bj][m][n] * DS + bv[bj][n];
#pragma unroll
                        for (int q = 0; q < 2; ++q) { const float xg = fminf(v[2 * q], 7.f), xl = fminf(fmaxf(v[2 * q + 1], -7.f), 7.f);
                            o[2 * n + q] = xg * sigmoidf_(1.702f * xg) * (xl + 1.f) * SC_ACT; } }
                    int w = __builtin_amdgcn_cvt_pk_fp8_f32(o[0], o[1], 0, false); w = __builtin_amdgcn_cvt_pk_fp8_f32(o[2], o[3], w, true);
                    *(int*)(ACT + (size_t)row * 1024 + ((col0 + bj * HALF) >> 1)) = w; } }
    }
};
struct EpiMoe2 {
    static constexpr bool PERM = true;
    const float* b2; bf16_t* YIT;
    __device__ __forceinline__ void operator()(const Acc& acc, const Unit& u, int wr, int wc, int fr, int fq) const {
        const int e = u.aux, row0 = u.pm * BM + wr * 64 + fr, col0 = u.pn * BM + wc * 32 + 8 * fq;
        f32x4 bv[2][2];
#pragma unroll
        for (int bj = 0; bj < 2; ++bj)
#pragma unroll
            for (int n = 0; n < 2; ++n) bv[bj][n] = *(const f32x4*)(b2 + (size_t)e * 1024 + col0 + bj * HALF + 4 * n);
#pragma unroll
        for (int ai = 0; ai < 2; ++ai)
#pragma unroll
            for (int m = 0; m < 4; ++m) { const int row = row0 + ai * HALF + m * 16;
#pragma unroll
                for (int bj = 0; bj < 2; ++bj) { const f32x4 v0 = acc[ai][bj][m][0] * (1.f / (SC_ACT * SC_W)) + bv[bj][0], v1 = acc[ai][bj][m][1] * (1.f / (SC_ACT * SC_W)) + bv[bj][1]; u32x4 w;
                    w.x = cvt_pk_bf16(v0[0], v0[1]); w.y = cvt_pk_bf16(v0[2], v0[3]); w.z = cvt_pk_bf16(v1[0], v1[1]); w.w = cvt_pk_bf16(v1[2], v1[3]);
                    *(u32x4*)(YIT + (size_t)row * 1024 + col0 + bj * HALF) = w; } }
    }
};
}

namespace attn {
#define SBAR() __builtin_amdgcn_sched_barrier(0)
constexpr int NW = 8, QBLK = 32, KVBLK = 64;
constexpr float THR = 8.f;
__device__ __forceinline__ int crow(int r, int hi) { return (r & 3) + 8 * (r >> 2) + 4 * hi; }
constexpr int KROW_MLA = 96 * 2 + 16, KROW_NA = 64 * 2 + 16;
constexpr int SHM_K = 64 * KROW_MLA  , SHM_V = 64 * 64 * 2  ;
constexpr int OFF_V = 0, OFF_K = 4 * SHM_V, OFF_WS = OFF_K + 4 * SHM_K, OFF_OST = OFF_WS + NW * 256, OFF_BIAS = OFF_OST + NW * 4096, ATTN_LDS = OFF_BIAS + 2048;

__device__ __forceinline__ int v_st(int k, int c) { const int kk = (k & ~0xC) | ((k & 4) << 1) | ((k & 8) >> 1); return ((kk >> 3) * 2 + (c >> 5)) * 512 + ((kk & 7) * 32 + (c & 31)) * 2; }
__device__ __forceinline__ int v_rd_base(int lane) { return ((lane & 3) << 3) | (((lane >> 2) & 3) << 6) | (((lane >> 4) & 1) << 5) | (((lane >> 5) & 1) << 8); }
constexpr int v_rd_off(int d0, int ks, int half) { return d0 * 512 + ks * 2048 + half * 1024; }
template <int OFF> __device__ __forceinline__ s16x4 tr_read(int vb) {
    s16x4 r; asm volatile("ds_read_b64_tr_b16 %0, %1 offset:%2" : "=&v"(r) : "v"(vb), "i"(OFF) : "memory"); return r;
}
template <int D0> __device__ __forceinline__ void pv_one(f32x16& od, int vb, bf16x8 pa0, bf16x8 pa1, bf16x8 pa2, bf16x8 pa3) {
    const s16x4 l0 = tr_read<v_rd_off(D0, 0, 0)>(vb), h0 = tr_read<v_rd_off(D0, 0, 1)>(vb), l1 = tr_read<v_rd_off(D0, 1, 0)>(vb), h1 = tr_read<v_rd_off(D0, 1, 1)>(vb);
    const s16x4 l2 = tr_read<v_rd_off(D0, 2, 0)>(vb), h2 = tr_read<v_rd_off(D0, 2, 1)>(vb), l3 = tr_read<v_rd_off(D0, 3, 0)>(vb), h3 = tr_read<v_rd_off(D0, 3, 1)>(vb);
    asm volatile("s_waitcnt lgkmcnt(0)" ::: "memory"); SBAR();
#define PK(L, H) (bf16x8){L[0], L[1], L[2], L[3], H[0], H[1], H[2], H[3]}
    od = __builtin_amdgcn_mfma_f32_32x32x16_bf16(pa0, PK(l0, h0), od, 0, 0, 0);
    od = __builtin_amdgcn_mfma_f32_32x32x16_bf16(pa1, PK(l1, h1), od, 0, 0, 0);
    od = __builtin_amdgcn_mfma_f32_32x32x16_bf16(pa2, PK(l2, h2), od, 0, 0, 0);
    od = __builtin_amdgcn_mfma_f32_32x32x16_bf16(pa3, PK(l3, h3), od, 0, 0, 0);
#undef PK
}
__device__ __forceinline__ void pv_d0(f32x16* o, int vb, bf16x8 pa0, bf16x8 pa1, bf16x8 pa2, bf16x8 pa3) {
    pv_one<0>(o[0], vb, pa0, pa1, pa2, pa3); pv_one<1>(o[1], vb, pa0, pa1, pa2, pa3);
}
__device__ __forceinline__ void partialSM(f32x16& p0, f32x16& p1, float& m_ref, f32x16& negm, float& alpha, bool& fresh) {
    float pmax = p0[0];
#pragma unroll
    for (int r = 1; r < 16; ++r) pmax = fmaxf(pmax, p0[r]);
#pragma unroll
    for (int r = 0; r < 16; ++r) pmax = fmaxf(pmax, p1[r]);
    { auto rr = __builtin_amdgcn_permlane32_swap(__float_as_uint(pmax), __float_as_uint(pmax), false, false);
      pmax = fmaxf(__uint_as_float(rr[0]), __uint_as_float(rr[1])); }
    alpha = 1.f;
    if (__builtin_expect(fresh || !__all(pmax <= THR), 0)) {
        const float dl = fresh ? pmax : fmaxf(pmax, 0.f);
        m_ref += dl;
#pragma unroll
        for (int r = 0; r < 16; ++r) { p0[r] -= dl; p1[r] -= dl; }
        const float nm = -m_ref;
#pragma unroll
        for (int r = 0; r < 16; ++r) negm[r] = nm;
        alpha = fresh ? 1.f : __builtin_amdgcn_exp2f(-dl);
        fresh = false;
    }
#pragma unroll
    for (int r = 0; r < 16; ++r) p0[r] = __builtin_amdgcn_exp2f(p0[r]);
}
__device__ __forceinline__ void finishSM(f32x16& p0, f32x16& p1, float alpha, float& l_reg, bf16x8& pa0, bf16x8& pa1, bf16x8& pa2, bf16x8& pa3) {
#pragma unroll
    for (int r = 0; r < 16; ++r) p1[r] = __builtin_amdgcn_exp2f(p1[r]);
    float ps = 0;
#pragma unroll
    for (int r = 0; r < 16; ++r) ps += p0[r];
#pragma unroll
    for (int r = 0; r < 16; ++r) ps += p1[r];
    { auto rr = __builtin_amdgcn_permlane32_swap(__float_as_uint(ps), __float_as_uint(ps), false, false);
      ps = __uint_as_float(rr[0]) + __uint_as_float(rr[1]); }
    l_reg = l_reg * alpha + ps;
#define PK4(P, BASE, OUT) do { unsigned a0 = cvt_pk_bf16(P[BASE + 0], P[BASE + 1]), a1 = cvt_pk_bf16(P[BASE + 2], P[BASE + 3]);   \
    unsigned b0 = cvt_pk_bf16(P[BASE + 4], P[BASE + 5]), b1 = cvt_pk_bf16(P[BASE + 6], P[BASE + 7]);                              \
    auto r0 = __builtin_amdgcn_permlane32_swap(a0, b0, false, false); auto r1 = __builtin_amdgcn_permlane32_swap(a1, b1, false, false); \
    u32x4 w = {r0[0], r1[0], r0[1], r1[1]}; OUT = *reinterpret_cast<bf16x8*>(&w); } while (0)
    PK4(p0, 0, pa0); PK4(p0, 8, pa1); PK4(p1, 0, pa2); PK4(p1, 8, pa3);
#undef PK4
}
template <int ND0, int KROW>
__device__ __forceinline__ void qkt(f32x16& p0, f32x16& p1, const char* Ks, const bf16x8* qr, const f32x16& negm, int r32, int hi) {
#pragma unroll
    for (int d0 = 0; d0 < ND0; ++d0) { const int cb = (d0 * 16 + hi * 8) * 2;
        const bf16x8 b0 = *reinterpret_cast<const bf16x8*>(Ks + r32 * KROW + cb);
        const bf16x8 b1 = *reinterpret_cast<const bf16x8*>(Ks + (32 + r32) * KROW + cb);
        if (d0 == 0) { p0 = __builtin_amdgcn_mfma_f32_32x32x16_bf16(b0, qr[0], negm, 0, 0, 0); p1 = __builtin_amdgcn_mfma_f32_32x32x16_bf16(b1, qr[0], negm, 0, 0, 0); }
        else { p0 = __builtin_amdgcn_mfma_f32_32x32x16_bf16(b0, qr[d0], p0, 0, 0, 0); p1 = __builtin_amdgcn_mfma_f32_32x32x16_bf16(b1, qr[d0], p1, 0, 0, 0); } }
}

template <int MODE>
__device__ __forceinline__ void attn_unit(const bf16_t* __restrict__ Qa, int ldqa, const bf16_t* __restrict__ Qb, int ldqb,
                                          const bf16_t* __restrict__ Ka, int ldka, const bf16_t* __restrict__ Kb, int ldkb, const bf16_t* __restrict__ Vv, int ldv,
                                          bf16_t* __restrict__ O, int NT, int krow0, int ntreal, int qrow0, const float* __restrict__ rpbh, char* lds) {
    constexpr int ND0 = MODE == 0 ? 6 : 4, KROW = MODE == 0 ? KROW_MLA : KROW_NA;
    const int tid = threadIdx.x, wid = __builtin_amdgcn_readfirstlane(tid >> 6), lane = tid & 63, r32 = lane & 31, hi = lane >> 5;
    char* V_lds = lds + OFF_V; char* K_lds = lds + OFF_K;
    float* ws = (float*)(lds + OFF_WS) + wid * 64; float* li_l = ws; float* al_l = ws + 32;
    float* biasL = (float*)(lds + OFF_BIAS);
    float m_ref = 0.f, l_reg = 0; f32x16 o[2] = {}; f32x16 negm = {}; bool fresh = true; bf16x8 qr[ND0];
    {   const bf16_t* Qw = Qa + (size_t)(wid * QBLK + r32) * ldqa + hi * 8;
#pragma unroll
        for (int d0 = 0; d0 < 4; ++d0) qr[d0] = *reinterpret_cast<const bf16x8*>(Qw + d0 * 16);
        if constexpr (MODE == 0) { const bf16_t* Qw2 = Qb + (size_t)(wid * QBLK + r32) * ldqb + hi * 8;
#pragma unroll
            for (int d0 = 0; d0 < 2; ++d0) qr[4 + d0] = *reinterpret_cast<const bf16x8*>(Qw2 + d0 * 16); } }
    int qgr = 0, rs0 = 0, qc = 0, cs = 0;
    if constexpr (MODE == 1) {
        qgr = qrow0 + (wid >> 1); rs0 = min(max(qgr - 4, 0), 120); qc = 32 * (wid & 1) + r32; cs = min(max(qc - 8, 0), 48);
        for (int i = tid; i < 15 * 31; i += 512) biasL[i] = rpbh[i] * LOG2E;
    }
    const int sr = tid >> 3, sc = (tid & 7) * 8;
    const int sr2 = (tid & 255) >> 2, sc2 = (tid & 3) * 8;
    const int vst = v_st(sr, sc);
    const int vb0 = (int)(uintptr_t)V_lds + v_rd_base(lane);
    struct { bf16x8 v, k, k2; } sr_[1];
#define KROWOF(t) (MODE == 1 ? min(krow0 + (t), 127) * 64 : (t) * 64)
#define SLOAD(i, t) do { const long k0_ = KROWOF(t); sr_[i].v = *reinterpret_cast<const bf16x8*>(&Vv[(k0_ + sr) * ldv + sc]); sr_[i].k = *reinterpret_cast<const bf16x8*>(&Ka[(k0_ + sr) * ldka + sc]); \
        if constexpr (MODE == 0) sr_[i].k2 = *reinterpret_cast<const bf16x8*>(&Kb[(k0_ + sr2) * ldkb + sc2]); } while (0)
#define SWRITE(b, i) do { *(bf16x8*)(V_lds + (b) * SHM_V + vst) = sr_[i].v; *(bf16x8*)(K_lds + (b) * SHM_K + sr * KROW + sc * 2) = sr_[i].k; \
        if constexpr (MODE == 0) { if (tid < 256) *(bf16x8*)(K_lds + (b) * SHM_K + sr2 * KROW + 128 + sc2 * 2) = sr_[i].k2; } } while (0)
#define SWAIT() do { if constexpr (MODE == 0) asm volatile("s_waitcnt vmcnt(3)" ::: "memory"); else asm volatile("s_waitcnt vmcnt(2)" ::: "memory"); } while (0)
#define RESC(a) do { if (__any((a) < 1.f)) { if (hi == 0) al_l[r32] = (a); asm volatile("s_waitcnt lgkmcnt(0)" ::: "memory"); \
        _Pragma("unroll") for (int d = 0; d < 2; ++d) _Pragma("unroll") for (int r = 0; r < 16; ++r) o[d][r] *= al_l[crow(r, hi)]; } } while (0)
#define TVALID(t) (MODE == 0 ? true : ((t) < ntreal && (krow0 + (t)) >= rs0 && (krow0 + (t)) < rs0 + 8))
#define MASKB(P0, P1, t) do { if constexpr (MODE == 1) { const int dr_ = krow0 + (t) - qgr + 7; int d_ = 4 * hi - cs; asm volatile("" : "+v"(d_)); \
        const LAS float* bl_ = (const LAS float*)((LAS char*)lds + OFF_BIAS) + (dr_ * 31 + 15 - qc + 4 * hi); \
        _Pragma("unroll") for (int r = 0; r < 16; ++r) { const int c0_ = (r & 3) + 8 * (r >> 2); \
            const bool in0 = (unsigned)(c0_ + d_) < 16u, in1 = (unsigned)(c0_ + 32 + d_) < 16u; \
            const float b0_ = bl_[c0_], b1_ = bl_[c0_ + 32]; \
            P0[r] = in0 ? P0[r] + b0_ : -1e30f; P1[r] = in1 ? P1[r] + b1_ : -1e30f; } } } while (0)
    f32x16 pA0, pA1, pB0, pB1; float alA = 1.f, alB = 1.f; bf16x8 pa0, pa1, pa2, pa3;
    SLOAD(0, 0); asm volatile("s_waitcnt vmcnt(0)" ::: "memory"); SWRITE(0, 0); SLOAD(0, 1); asm volatile("s_waitcnt vmcnt(0)" ::: "memory"); SWRITE(1, 0);
    if (NT > 2) SLOAD(0, 2);
    __syncthreads();
    const int NI = NT >> 1;
    for (int it = 0; it < NI; ++it) {
        const int kb = (it & 1) * 2, nb = 2 - kb; const bool more = it + 1 < NI;
        if (more) { SWRITE(nb, 0); SLOAD(0, 2 * it + 3); }
        const int ta = 2 * it, tb = ta + 1;
        const bool vA = TVALID(ta), vB = TVALID(tb);
        if (vA) { qkt<ND0, KROW>(pA0, pA1, K_lds + kb * SHM_K, qr, negm, r32, hi); MASKB(pA0, pA1, ta); partialSM(pA0, pA1, m_ref, negm, alA, fresh); RESC(alA); }
        SBAR();
        if (vB) { qkt<ND0, KROW>(pB0, pB1, K_lds + (kb + 1) * SHM_K, qr, negm, r32, hi); MASKB(pB0, pB1, tb); }
        if (vA) { finishSM(pA0, pA1, alA, l_reg, pa0, pa1, pa2, pa3); SBAR(); pv_d0(o, vb0 + kb * SHM_V, pa0, pa1, pa2, pa3); }
        if (more) { SWRITE(nb + 1, 0); if (it + 2 < NI) SLOAD(0, 2 * it + 4); }
        if (vB) { partialSM(pB0, pB1, m_ref, negm, alB, fresh); RESC(alB); finishSM(pB0, pB1, alB, l_reg, pa0, pa1, pa2, pa3); SBAR(); pv_d0(o, vb0 + (kb + 1) * SHM_V, pa0, pa1, pa2, pa3); }
        __syncthreads();
    }
    asm volatile("s_waitcnt vmcnt(0)" ::: "memory");
    if (hi == 0) li_l[r32] = l_reg; asm volatile("s_waitcnt lgkmcnt(0)" ::: "memory");
    float rli[16];
#pragma unroll
    for (int r = 0; r < 16; ++r) rli[r] = __builtin_amdgcn_rcpf(li_l[crow(r, hi)]);
    {   bf16_t* stg = (bf16_t*)(lds + OFF_OST) + wid * 2048;
#pragma unroll
        for (int r = 0; r < 16; ++r) { const int orow = crow(r, hi);
#pragma unroll
            for (int d0 = 0; d0 < 2; ++d0) stg[orow * 64 + d0 * 32 + r32] = (bf16_t)(cvt_pk_bf16(o[d0][r] * rli[r], 0.f) & 0xffffu); }
        asm volatile("s_waitcnt lgkmcnt(0)" ::: "memory");
        bf16_t* Ow = O + (size_t)(wid * QBLK) * 512;
#pragma unroll
        for (int i = 0; i < 4; ++i) { const int row = i * 8 + (lane >> 3), ch = lane & 7; const u32x4 v = *(const u32x4*)(stg + row * 64 + ch * 8); *(u32x4*)(Ow + (size_t)row * 512 + ch * 8) = v; } }
    __syncthreads();
#undef KROWOF
#undef SLOAD
#undef SWRITE
#undef SWAIT
#undef RESC
#undef TVALID
#undef MASKB
}
#undef SBAR
}

constexpr size_t MiB = 1u << 20;
constexpr size_t WS_CTL = 0, CTL_ZERO_BYTES = 1 * MiB;
constexpr size_t WS_WIN = 2 * MiB;
constexpr size_t WS_WUQ = 11 * MiB;
constexpr size_t WS_WUKV = 12 * MiB;
constexpr size_t WS_WNA = 13 * MiB, WS_WMLA = 14 * MiB;
constexpr size_t WS_WOUT = 15 * MiB;
constexpr size_t WS_W1 = 18 * MiB;
constexpr size_t WS_W2 = 146 * MiB;
constexpr size_t WS_XN = 210 * MiB;
constexpr size_t WS_PROJ = 242 * MiB;
constexpr size_t WS_QN = 378 * MiB, WS_QR = 394 * MiB, WS_KN = 402 * MiB, WS_KR = 418 * MiB, WS_VM = 419 * MiB;
constexpr size_t WS_ONA = 435 * MiB, WS_OMLA = 451 * MiB;
constexpr size_t WS_MERGED = 467 * MiB;
constexpr size_t WS_TMP = 499 * MiB;
constexpr size_t WS_LIST = 563 * MiB;
constexpr size_t WS_TOKPOS = 565 * MiB, WS_TOKG = 566 * MiB;
constexpr size_t WS_ACT = 568 * MiB;
constexpr size_t WS_YIT = 712 * MiB;
constexpr size_t WS_SSQ = 856 * MiB;
constexpr size_t WS_MODP = 857 * MiB;
constexpr size_t WS_WRT = 858 * MiB;
constexpr size_t WS_END = 859 * MiB;
constexpr int CW_BAR = 4096;
constexpr int CW_CNT = 8192;
constexpr int CW_MOD = 16384;
constexpr int CW_ROPE = 32768;
static_assert((CW_ROPE + 2048) * 4 <= (int)CTL_ZERO_BYTES, "CTL");

constexpr int RING_BYTES = 131072;
constexpr int TAB_OFF = RING_BYTES;
constexpr int TAB_BLK = TAB_OFF, TAB_GATH = TAB_OFF + 2048;
constexpr int MISC_OFF = TAB_GATH + 11 * 1024;
constexpr int LDS_BYTES = 147456;
static_assert(MISC_OFF + 256 <= LDS_BYTES, "LDS map");

#define RLX_AGENT __ATOMIC_RELAXED, __HIP_MEMORY_SCOPE_AGENT
#define LDS_WAIT() asm volatile("s_waitcnt lgkmcnt(0)" ::: "memory")

#define XB_TMO      128
#define XB_XCNT(j)  (256  + 64 * (j))
#define XB_XSUB(j)  (1280 + 64 * (j))
#define XB_XGEN(j)  (2304 + 64 * (j))
#define XB_TOP      3328
#define XB_TOPGEN   3392
#define XCD_BAR_WORDS 3456
#define XB_SPIN_CAP (1u << 22)
__device__ __forceinline__ unsigned xb_ld(unsigned* p)              { return __hip_atomic_load(p, __ATOMIC_RELAXED, __HIP_MEMORY_SCOPE_AGENT); }
__device__ __forceinline__ unsigned xb_add(unsigned* p, unsigned v) { return __hip_atomic_fetch_add(p, v, __ATOMIC_RELAXED, __HIP_MEMORY_SCOPE_AGENT); }
__device__ __forceinline__ unsigned xb_xcc_id() { return (unsigned)__builtin_amdgcn_s_getreg((3 << 11) | 20) & 0xFu; }
#define XB_SPIN(cond, bar) do { unsigned _sp = 0; while (cond) { __builtin_amdgcn_s_sleep(1); \
    if ((++_sp & 255u) == 0u) { if (xb_ld(&(bar)[XB_TMO])) break; if (_sp > XB_SPIN_CAP) { atomicAdd(&(bar)[XB_TMO], 1u); break; } } } } while (0)
struct XcdBarrier { unsigned* bar; unsigned x; volatile LAS unsigned* st; };
__device__ __forceinline__ XcdBarrier xcd_barrier_post(unsigned* bar, volatile LAS unsigned* st) {
    XcdBarrier b; b.bar = bar; b.x = xb_xcc_id(); b.st = st;
    if (threadIdx.x == 0) (void)xb_add(&bar[XB_XCNT(b.x)], 1u);
    return b;
}
__device__ __forceinline__ void xcd_barrier_complete(unsigned* bar, unsigned x, unsigned& nloc, unsigned& nx) {
    const unsigned G = gridDim.x * gridDim.y * gridDim.z;
    unsigned sum, cnt, mine, sp = 0u;
    for (;;) {
        sum = 0u; cnt = 0u; mine = 0u;
#pragma unroll
        for (unsigned j = 0; j < 16; ++j) { const unsigned c = xb_ld(&bar[XB_XCNT(j)]); sum += c; cnt += (c > 0u) ? 1u : 0u; mine = (j == x) ? c : mine; }
        if (sum == G) break;
        __builtin_amdgcn_s_sleep(1);
        if ((++sp & 255u) == 0u) { if (xb_ld(&bar[XB_TMO])) break; if (sp > XB_SPIN_CAP) { atomicAdd(&bar[XB_TMO], 1u); break; } }
    }
    nloc = mine > 0u ? mine : 1u; nx = cnt > 0u ? cnt : 1u;
}
__device__ __forceinline__ void xcd_barrier(const XcdBarrier& b) {
    asm volatile("s_waitcnt vmcnt(0)" ::: "memory");
    __syncthreads();
    if (threadIdx.x == 0) {
        unsigned* bar = b.bar;
        __builtin_amdgcn_s_waitcnt(0);
        unsigned nloc = b.st[0], nx = b.st[1];
        if (nloc == 0u) { xcd_barrier_complete(bar, b.x, nloc, nx); b.st[0] = nloc; b.st[1] = nx; }
        const unsigned old = xb_add(&bar[XB_XSUB(b.x)], 1u);
        const unsigned gen = old / nloc;
        if (old + 1u == (gen + 1u) * nloc) {
            __builtin_amdgcn_fence(__ATOMIC_RELEASE, "agent");
            asm volatile("s_waitcnt vmcnt(0)" ::: "memory");
            const unsigned og = xb_add(&bar[XB_TOP], 1u);
            const unsigned tg = og / nx;
            if (og + 1u == (tg + 1u) * nx) xb_add(&bar[XB_TOPGEN], 1u);
            else XB_SPIN(xb_ld(&bar[XB_TOPGEN]) == tg, bar);
            __builtin_amdgcn_fence(__ATOMIC_ACQUIRE, "agent");
            xb_add(&bar[XB_XGEN(b.x)], 1u);
            asm volatile("s_waitcnt vmcnt(0)" ::: "memory");
        } else {
            XB_SPIN(xb_ld(&bar[XB_XGEN(b.x)]) == gen, bar);
            __builtin_amdgcn_fence(__ATOMIC_ACQUIRE, "agent");
            asm volatile("s_waitcnt vmcnt(0)" ::: "memory");
        }
    }
    __syncthreads();
}

constexpr int NWAVES = 8;
struct Args { const float* in[24]; float* out; unsigned char* ws; int ph_lo, ph_hi; };
enum { I_X = 0, I_C, I_WADA, I_BADA, I_GAPRE, I_GAPOST, I_WIN, I_BGATE, I_RPB, I_QNG, I_KVNG, I_WUQ, I_WUKV, I_WNAUP, I_WMLAUP, I_WOUT, I_GFPRE, I_GFPOST, I_WR, I_BR, I_W1, I_B1, I_W2, I_B2 };

__device__ __forceinline__ void tr_store_tile(LAS unsigned char* scr, bf16_t* dst, int K, int n0, int k0, int lane) {
    LDS_WAIT(); asm volatile("" ::: "memory");
#pragma unroll
    for (int j = 0; j < 8; ++j) { const int idx = j * 64 + lane, n = idx >> 3, ch = idx & 7;
        const u32x4 v = *(const LAS u32x4*)(scr + n * 144 + ch * 16);
        *(GAS u32x4*)(dst + (size_t)(n0 + n) * K + k0 + ch * 8) = v; }
    LDS_WAIT(); asm volatile("" ::: "memory");
}
__device__ __forceinline__ void tr_tile_fast(const float* src, int Nsrc, int src0, const float* kscale, bf16_t* dst, int K, int n0, int k0, LAS unsigned char* scr, int lane) {
#pragma unroll
    for (int st = 0; st < 8; ++st) { const int kq = st * 4 + (lane >> 4), c4 = (lane & 15) * 4, k = 2 * kq;
        f32x4 a = *(const GAS f32x4*)(src + (size_t)(k0 + k) * Nsrc + src0 + c4);
        f32x4 b = *(const GAS f32x4*)(src + (size_t)(k0 + k + 1) * Nsrc + src0 + c4);
        if (kscale) { const float s0 = kscale[k0 + k], s1 = kscale[k0 + k + 1]; a = a * s0; b = b * s1; }
#pragma unroll
        for (int i = 0; i < 4; ++i) *(LAS unsigned*)(scr + (c4 + i) * 144 + k * 2) = cvt_pk_bf16(a[i], b[i]); }
    tr_store_tile(scr, dst, K, n0, k0, lane);
}
__device__ __forceinline__ void tr_tile_slow(const float* src, int Nsrc, int srccol  , const float* kscale, bf16_t* dst, int K, int n0, int k0, LAS unsigned char* scr, int lane) {
#pragma unroll 8
    for (int k = 0; k < 64; k += 2) {
        float a = 0.f, b = 0.f;
        if (srccol >= 0) { a = src[(size_t)(k0 + k) * Nsrc + srccol]; b = src[(size_t)(k0 + k + 1) * Nsrc + srccol];
            if (kscale) { a *= kscale[k0 + k]; b *= kscale[k0 + k + 1]; } }
        *(LAS unsigned*)(scr + lane * 144 + k * 2) = cvt_pk_bf16(a, b); }
    tr_store_tile(scr, dst, K, n0, k0, lane);
}
__device__ __forceinline__ void tr_tile_fast8(const float* src, int Nsrc, int src0, unsigned char* dst, int K, int n0, int k0, LAS unsigned char* scr, int lane) {
#pragma unroll
    for (int st = 0; st < 4; ++st) { const int kq = st * 4 + (lane >> 4), c4 = (lane & 15) * 4, k = 4 * kq;
        const f32x4 a = __builtin_nontemporal_load((const f32x4*)(src + (size_t)(k0 + k) * Nsrc + src0 + c4)) * SC_W, b = __builtin_nontemporal_load((const f32x4*)(src + (size_t)(k0 + k + 1) * Nsrc + src0 + c4)) * SC_W;
        const f32x4 c = __builtin_nontemporal_load((const f32x4*)(src + (size_t)(k0 + k + 2) * Nsrc + src0 + c4)) * SC_W, d = __builtin_nontemporal_load((const f32x4*)(src + (size_t)(k0 + k + 3) * Nsrc + src0 + c4)) * SC_W;
#pragma unroll
        for (int i = 0; i < 4; ++i) { int w = __builtin_amdgcn_cvt_pk_fp8_f32(a[i], b[i], 0, false); w = __builtin_amdgcn_cvt_pk_fp8_f32(c[i], d[i], w, true);
            *(LAS int*)(scr + (c4 + i) * 80 + k) = w; } }
    LDS_WAIT(); asm volatile("" ::: "memory");
#pragma unroll
    for (int j = 0; j < 4; ++j) { const int idx = j * 64 + lane, n = idx >> 2, ch = idx & 3;
        const u32x4 v = *(const LAS u32x4*)(scr + n * 80 + ch * 16);
        __builtin_nontemporal_store(v, (u32x4*)(dst + (size_t)(n0 + n) * K + k0 + ch * 16)); }
    LDS_WAIT(); asm volatile("" ::: "memory");
}
__device__ __forceinline__ int rope_orig(int p) { return (p & 16) + 8 * (p & 1) + ((p & 15) >> 1); }

__global__ void __launch_bounds__(NWAVES * 64, 2) fwd_kernel(Args args) {
    extern __shared__ __attribute__((aligned(16))) unsigned char lds[];
    LAS unsigned char* L = (LAS unsigned char*)lds;
    volatile LAS unsigned* MISC = (volatile LAS unsigned*)(L + MISC_OFF);
    const int tid = threadIdx.x, lane = tid & 63, wave = __builtin_amdgcn_readfirstlane(tid >> 6);
    const int G = gridDim.x, bx = blockIdx.x, vcu = (G % 8 == 0) ? (bx % 8) * (G / 8) + bx / 8 : bx;
    unsigned char* ws = args.ws;
    gu32* ctl = (gu32*)(ws + WS_CTL);
    const int lo = args.ph_lo, hi = args.ph_hi;
    for (int u = tid; u < 64; u += NWAVES * 64) MISC[u] = 0u;
    __syncthreads();
    XcdBarrier bar; bar.bar = (unsigned*)(ctl + CW_BAR); bar.x = 0; bar.st = nullptr;
    const bool use_bar = (hi - lo) > 1;
    if (use_bar) bar = xcd_barrier_post((unsigned*)(ctl + CW_BAR), MISC + 8);
#ifndef PHASE_MASK
#define PHASE_MASK 0xFFFF
#endif
#define IN(k) (((PHASE_MASK >> (k)) & 1) && lo <= (k) && (k) < hi)
#ifndef REPMASK
#define REPMASK 0
#endif
#define NREP(k) (1 + ((REPMASK >> (k)) & 1))
#define SEAM(k) do { if (IN(k) && IN((k) + 1)) xcd_barrier(bar); } while (0)
    const int gw = vcu * NWAVES + wave, NGW = G * NWAVES;
    float* ROPE = (float*)(ctl + CW_ROPE);
    float* MODP = (float*)(ws + WS_MODP); float* MOD = (float*)(ws + WS_MODP + 512 * 1024); float* SSQ = (float*)(ws + WS_SSQ); unsigned* CNT = (unsigned*)(ctl + CW_CNT);
    bf16_t* WINT = (bf16_t*)(ws + WS_WIN); bf16_t* WUQT = (bf16_t*)(ws + WS_WUQ); bf16_t* WUKVT = (bf16_t*)(ws + WS_WUKV);
    bf16_t* WNAT = (bf16_t*)(ws + WS_WNA); bf16_t* WMLAT = (bf16_t*)(ws + WS_WMLA); bf16_t* WOUTT = (bf16_t*)(ws + WS_WOUT);
    bf16_t* W1T = (bf16_t*)(ws + WS_W1); bf16_t* W2T = (bf16_t*)(ws + WS_W2);
    bf16_t* XN = (bf16_t*)(ws + WS_XN); bf16_t* PROJ = (bf16_t*)(ws + WS_PROJ);
    bf16_t* QN = (bf16_t*)(ws + WS_QN); bf16_t* QR = (bf16_t*)(ws + WS_QR); bf16_t* KN = (bf16_t*)(ws + WS_KN); bf16_t* KR = (bf16_t*)(ws + WS_KR); bf16_t* VM = (bf16_t*)(ws + WS_VM);
    bf16_t* ONA = (bf16_t*)(ws + WS_ONA); bf16_t* OMLA = (bf16_t*)(ws + WS_OMLA); bf16_t* MERGED = (bf16_t*)(ws + WS_MERGED);
    float* TMP = (float*)(ws + WS_TMP); unsigned* LIST = (unsigned*)(ws + WS_LIST); unsigned* TOKPOS = (unsigned*)(ws + WS_TOKPOS); float* TOKG = (float*)(ws + WS_TOKG);
    bf16_t* ACT = (bf16_t*)(ws + WS_ACT); bf16_t* YIT = (bf16_t*)(ws + WS_YIT);
    const float* X = args.in[I_X]; float* OUT = args.out;

    if (IN(0)) for (int rep_ = 0; rep_ < NREP(0); ++rep_) {
        LAS unsigned char* scr = L + wave * 16384;
        {   const float* c = args.in[I_C]; const float* wada = args.in[I_WADA]; const float* bada = args.in[I_BADA];
            for (int it = gw; it < 96 * 8; it += NGW) { const int nb = it % 96, kc = it / 96, n = nb * 64 + lane;
                float a0 = 0.f, a1 = 0.f;
#pragma unroll 8
                for (int k = 0; k < 128; ++k) { const int kk = kc * 128 + k; const float w = wada[(size_t)kk * 6144 + n];
                    const float c0 = c[kk], c1 = c[1024 + kk]; a0 += (c0 * sigmoidf_(c0)) * w; a1 += (c1 * sigmoidf_(c1)) * w; }
                if (kc == 0) { a0 += bada[n]; a1 += bada[n]; }
                MODP[(kc * 2 + 0) * 6144 + n] = a0; MODP[(kc * 2 + 1) * 6144 + n] = a1; } }
        if (bx == 0) { for (int i = tid; i < 128 * 8; i += NWAVES * 64) { const int pos = i >> 3, j = i & 7; float c, sn; rope_cs((float)pos, j, c, sn); ROPE[pos * 16 + j] = c; ROPE[pos * 16 + 8 + j] = sn; } }
        if (bx == 1 % G) { const float* Wr = args.in[I_WR]; float* WRT = (float*)(ws + WS_WRT); for (int i = tid; i < NEXP * 1024; i += NWAVES * 64) WRT[i] = Wr[(size_t)(i & 1023) * 32 + (i >> 10)]; }
        {   constexpr int I_WIN_ = 16 * 68, I_UQ = 6 * 12, I_UKV = 4 * 16, I_UP = 8 * 16, I_OUT = 16 * 16;
            constexpr int NITEMS = I_WIN_ + I_UQ + I_UKV + 2 * I_UP + I_OUT;
            for (int it = gw; it < NITEMS; it += NGW) {
                int r = it;
                if (r < I_WIN_) { const int kb = r / 68, nb = r % 68;
                    if (nb < 34) tr_tile_fast(args.in[I_WIN], 4256, nb * 64, nullptr, WINT, 1024, nb * 64, kb * 64, scr, lane);
                    else if (nb >= 36) tr_tile_fast(args.in[I_WIN], 4256, 2208 + (nb - 36) * 64, nullptr, WINT, 1024, nb * 64, kb * 64, scr, lane);
                    else { const int n = nb * 64 + lane; const int sc = (n < 2208) ? 2176 + rope_orig(n - 2176) : -1;
                        tr_tile_slow(args.in[I_WIN], 4256, sc, nullptr, WINT, 1024, nb * 64, kb * 64, scr, lane); }
                    continue; } r -= I_WIN_;
                if (r < I_UQ) { const int kb = r / 12, nb = r % 12;
                    if (nb < 8) tr_tile_fast(args.in[I_WUQ], 768, nb * 96, args.in[I_QNG], WUQT, 384, nb * 64, kb * 64, scr, lane);
                    else { const int n = nb * 64 + lane - 512, h = n >> 5, p = n & 31;
                        tr_tile_slow(args.in[I_WUQ], 768, h * 96 + 64 + rope_orig(p), args.in[I_QNG], WUQT, 384, nb * 64, kb * 64, scr, lane); }
                    continue; } r -= I_UQ;
                if (r < I_UKV) { const int kb = r / 16, nb = r % 16;
                    const int s0 = (nb < 8) ? nb * 128 : (nb - 8) * 128 + 64;
                    tr_tile_fast(args.in[I_WUKV], 1024, s0, args.in[I_KVNG], WUKVT, 256, nb * 64, kb * 64, scr, lane); continue; } r -= I_UKV;
                if (r < I_UP) { const int kb = r / 16, nb = r % 16; tr_tile_fast(args.in[I_WNAUP], 1024, nb * 64, nullptr, WNAT, 512, nb * 64, kb * 64, scr, lane); continue; } r -= I_UP;
                if (r < I_UP) { const int kb = r / 16, nb = r % 16; tr_tile_fast(args.in[I_WMLAUP], 1024, nb * 64, nullptr, WMLAT, 512, nb * 64, kb * 64, scr, lane); continue; } r -= I_UP;
                { const int kb = r / 16, nb = r % 16; tr_tile_fast(args.in[I_WOUT], 1024, nb * 64, nullptr, WOUTT, 1024, nb * 64, kb * 64, scr, lane); }
            } }
    }
    SEAM(0);
    if (IN(1)) {
        const float* g = args.in[I_GAPRE];
        LAS float* modl = (LAS float*)L;
        for (int i = tid; i < 4096; i += NWAVES * 64) { const int b = i >> 11, c = i & 2047; float sm = 0.f;
#pragma unroll
            for (int kc = 0; kc < 8; ++kc) sm += MODP[(kc * 2 + b) * 6144 + c];
            modl[i] = sm; }
        for (int idx = bx * (NWAVES * 64) + tid; idx < 2 * 6144; idx += G * NWAVES * 64) { const int b = idx / 6144, n = idx % 6144; float sm = 0.f;
#pragma unroll
            for (int kc = 0; kc < 8; ++kc) sm += MODP[(kc * 2 + b) * 6144 + n];
            MOD[idx] = sm; }
        __syncthreads();
        for (int m = gw; m < MTOK; m += NGW) { const int b = m >> 13;
            const GAS f32x4* xr = (const GAS f32x4*)(X + (size_t)m * DM) + lane; f32x4 v[4]; float s = 0.f;
#pragma unroll
            for (int j = 0; j < 4; ++j) { v[j] = xr[64 * j]; s += (v[j].x * v[j].x + v[j].y * v[j].y) + (v[j].z * v[j].z + v[j].w * v[j].w); }
            const float rstd = __builtin_amdgcn_rsqf(wave_sum(s) * (1.f / DM) + RMS_EPS);
            GAS u32x2* o8 = (GAS u32x2*)(XN + (size_t)m * DM) + lane;
#pragma unroll
            for (int j = 0; j < 4; ++j) { const int col = 4 * lane + 256 * j;
                const f32x4 gg = *(const f32x4*)(g + col), sh = *(const LAS f32x4*)(modl + b * 2048 + col), scl = *(const LAS f32x4*)(modl + b * 2048 + 1024 + col);
                const f32x4 h = v[j] * rstd * gg * (scl + 1.f) + sh; u32x2 w; w.x = cvt_pk_bf16(h[0], h[1]); w.y = cvt_pk_bf16(h[2], h[3]); o8[64 * j] = w; } }
    }
    SEAM(1);
    if (IN(2)) for (int rep_ = 0; rep_ < NREP(2); ++rep_) {
        if (bx < NG_INPROJ || G < 256) {
            const int ng = G < 256 ? G : NG_INPROJ;
            pg8::SchedDense S{(const char*)XN, (const char*)WINT, (size_t)256 * 1024 * 2, (size_t)256 * 1024 * 2, MTOK / 256, NPROJ / 256, ng, bx};
            pg8::EpiInProj E{PROJ, SSQ, KR, ROPE};
            pg8::gemm_phase<pg8::EpiInProj, pg8::SchedDense, true, false, false>(L, 16, 2048, 2048, S, E);
        }
        {   LAS unsigned char* scr = L + wave * 16384;
            constexpr int I_W1_ = NEXP * 16 * 32, I_W2_ = NEXP * 16 * 16, NCHUNK = (I_W1_ + I_W2_) / 32;
            for (;;) {
                if (tid == 0) MISC[20] = atomicAdd(CNT + 64, 1u);
                __syncthreads();
                const int chunk = (int)MISC[20];
                __syncthreads();
                if (chunk >= NCHUNK) break;
#pragma unroll 1
                for (int k = 0; k < 4; ++k) { int r = chunk * 32 + wave * 4 + k;
                    if (r < I_W1_) { const int e = r / 512, q = r % 512, kb = q / 32, nb = q % 32;
                        tr_tile_fast8(args.in[I_W1] + (size_t)e * 1024 * 2048, 2048, nb * 64, (unsigned char*)W1T + (size_t)e * 2048 * 1024, 1024, nb * 64, kb * 64, scr, lane); }
                    else { r -= I_W1_; const int e = r / 256, q = r % 256, kb = q / 16, nb = q % 16;
                        tr_tile_fast8(args.in[I_W2] + (size_t)e * 1024 * 1024, 1024, nb * 64, (unsigned char*)W2T + (size_t)e * 1024 * 1024, 1024, nb * 64, kb * 64, scr, lane); } }
            } }
    }
    SEAM(2);
    if (IN(3)) for (int rep_ = 0; rep_ < NREP(3); ++rep_) {
#ifndef NO_QUP
        {   pg8::SchedDense S{(const char*)(PROJ + 1536), (const char*)WUQT, (size_t)256 * NPROJ * 2, (size_t)256 * 384 * 2, MTOK / 256, 3, G, bx};
            pg8::EpiQUp E{QN, QR, SSQ, ROPE};
            pg8::gemm_phase<pg8::EpiQUp, pg8::SchedDense, true, false, false>(L, 6, NPROJ * 2, 768, S, E); }
#endif
#ifndef NO_KVUP
        {   pg8::SchedDense S{(const char*)(PROJ + 1920), (const char*)WUKVT, (size_t)256 * NPROJ * 2, (size_t)256 * 256 * 2, MTOK / 256, 4, G, G - 1 - bx};
            pg8::EpiKVUp E{KN, VM, SSQ};
            pg8::gemm_phase<pg8::EpiKVUp, pg8::SchedDense, true, false, false>(L, 4, NPROJ * 2, 512, S, E); }
#endif
    }
    SEAM(3);
    if (IN(4)) for (int rep_ = 0; rep_ < NREP(4); ++rep_) {
#ifndef NO_MLA
        for (int u = vcu; u < 512; u += G) {
            const int bh = u >> 5, qb = u & 31, b = bh >> 3, h = bh & 7; const size_t row0 = (size_t)b * SEQ + qb * 256, key0 = (size_t)b * SEQ;
            attn::attn_unit<0>(QN + row0 * 512 + h * 64, 512, QR + row0 * 256 + h * 32, 256, KN + key0 * 512 + h * 64, 512, KR + key0 * 32, 32, VM + key0 * 512 + h * 64, 512,
                               OMLA + row0 * 512 + h * 64, 128, 0, 128, 0, nullptr, (char*)lds);
        }
#endif
#ifndef NO_NA
        for (int u = vcu; u < 512; u += G) {
            const int bh = u >> 5, rb = u & 31, b = bh >> 3, h = bh & 7; const size_t row0 = (size_t)b * SEQ + rb * 256, key0 = (size_t)b * SEQ;
            const int krow0 = min(max(4 * rb - 4, 0), 120), klast = min(max(4 * rb + 3 - 4, 0), 120) + 7, ntreal = klast - krow0 + 1, NT = (ntreal + 1) & ~1;
            attn::attn_unit<1>(PROJ + row0 * NPROJ + h * 64, NPROJ, nullptr, 0, PROJ + key0 * NPROJ + 512 + h * 64, NPROJ, nullptr, 0, PROJ + key0 * NPROJ + 1024 + h * 64, NPROJ,
                               ONA + row0 * 512 + h * 64, NT, krow0, ntreal, 4 * rb, args.in[I_RPB] + h * 15 * 31, (char*)lds);
        }
#endif
    }
    SEAM(4);
    if (IN(5)) for (int rep_ = 0; rep_ < NREP(5); ++rep_) {
        pg8::SchedMerge S{(const char*)ONA, (const char*)OMLA, (const char*)WNAT, (const char*)WMLAT, MTOK / 256, 4, G, bx};
        pg8::EpiMerge E{PROJ, args.in[I_BGATE], TMP, MERGED};
        pg8::gemm_phase<pg8::EpiMerge, pg8::SchedMerge, true, false, false>(L, 8, 1024, 1024, S, E);
    }
    SEAM(5);
    if (IN(6)) for (int rep_ = 0; rep_ < NREP(6); ++rep_) {
        pg8::SchedDense S{(const char*)MERGED, (const char*)WOUTT, (size_t)256 * 1024 * 2, (size_t)256 * 1024 * 2, MTOK / 256, 4, G, bx};
        pg8::EpiF32 E{TMP, 1024};
        pg8::gemm_phase<pg8::EpiF32, pg8::SchedDense, true, false, false>(L, 16, 2048, 2048, S, E);
    }
    SEAM(6);
    if (IN(7)) {
        LAS int* sel_e = (LAS int*)(L + 0); LAS float* sel_g = (LAS float*)(L + 1024); LAS int* sel_r = (LAS int*)(L + 2048);
        LAS int* lcnt = (LAS int*)(L + 3072); LAS int* lbase = (LAS int*)(L + 3072 + 128);
        const float* gpo = args.in[I_GAPOST]; const float* gfp = args.in[I_GFPRE]; const float* br = args.in[I_BR];
        const float* WRT = (const float*)(ws + WS_WRT);
        for (int blk = vcu; blk < MTOK / 64; blk += G) {
            if (tid < 32) lcnt[tid] = 0;
            __syncthreads();
            f32x4 hreg[8][4];
#pragma unroll
            for (int rr = 0; rr < 8; ++rr) { const int m = blk * 64 + wave * 8 + rr, b = m >> 13;
                const GAS f32x4* yr = (const GAS f32x4*)(TMP + (size_t)m * DM) + lane; const GAS f32x4* xr = (const GAS f32x4*)(X + (size_t)m * DM) + lane;
                f32x4 y[4], x1[4]; float s = 0.f;
#pragma unroll
                for (int j = 0; j < 4; ++j) { y[j] = yr[64 * j]; x1[j] = xr[64 * j]; s += (y[j].x * y[j].x + y[j].y * y[j].y) + (y[j].z * y[j].z + y[j].w * y[j].w); }
                const float rstd = __builtin_amdgcn_rsqf(wave_sum(s) * (1.f / DM) + RMS_EPS); float s2 = 0.f;
#pragma unroll
                for (int j = 0; j < 4; ++j) { const int col = 4 * lane + 256 * j;
                    const f32x4 gg = *(const f32x4*)(gpo + col), ga = *(const f32x4*)(MOD + b * 6144 + 2048 + col);
                    x1[j] = x1[j] + ga * (y[j] * rstd * gg);
                    *((GAS f32x4*)(OUT + (size_t)m * DM) + lane + 64 * j) = x1[j];
                    s2 += (x1[j].x * x1[j].x + x1[j].y * x1[j].y) + (x1[j].z * x1[j].z + x1[j].w * x1[j].w); }
                const float rstd2 = __builtin_amdgcn_rsqf(wave_sum(s2) * (1.f / DM) + RMS_EPS);
                GAS int* o4 = (GAS int*)((unsigned char*)XN + (size_t)m * DM) + lane;
#pragma unroll
                for (int j = 0; j < 4; ++j) { const int col = 4 * lane + 256 * j;
                    const f32x4 gg = *(const f32x4*)(gfp + col), sh = *(const f32x4*)(MOD + b * 6144 + 3072 + col), scl = *(const f32x4*)(MOD + b * 6144 + 4096 + col);
                    const f32x4 h = x1[j] * rstd2 * gg * (scl + 1.f) + sh;
                    int w = __builtin_amdgcn_cvt_pk_fp8_f32(h[0] * SC_H2, h[1] * SC_H2, 0, false); w = __builtin_amdgcn_cvt_pk_fp8_f32(h[2] * SC_H2, h[3] * SC_H2, w, true); o4[64 * j] = w;
                    hreg[rr][j] = h; }
            }
            const bool b5 = (lane & 32) != 0, b4 = (lane & 16) != 0, b3 = (lane & 8) != 0;
            float t0 = -3.0e38f, t1 = -3.0e38f, t2 = -3.0e38f, t3 = -3.0e38f; int i0 = 0, i1 = 0, i2 = 0, i3 = 0;
#pragma unroll 2
            for (int e = 0; e < NEXP; ++e) {
                f32x4 w[4];
#pragma unroll
                for (int j = 0; j < 4; ++j) w[j] = *(const GAS f32x4*)(WRT + e * 1024 + 4 * lane + 256 * j);
                float p[8];
#pragma unroll
                for (int r = 0; r < 8; ++r) { f32x4 a = hreg[r][0] * w[0]; a += hreg[r][1] * w[1]; a += hreg[r][2] * w[2]; a += hreg[r][3] * w[3]; p[r] = (a.x + a.y) + (a.z + a.w); }
                float q[4], u[2];
#pragma unroll
                for (int i = 0; i < 4; ++i) { const float keep = b5 ? p[i + 4] : p[i], send = b5 ? p[i] : p[i + 4]; q[i] = keep + __shfl_xor(send, 32); }
#pragma unroll
                for (int i = 0; i < 2; ++i) { const float keep = b4 ? q[i + 2] : q[i], send = b4 ? q[i] : q[i + 2]; u[i] = keep + __shfl_xor(send, 16); }
                float v = (b3 ? u[1] : u[0]) + __shfl_xor(b3 ? u[0] : u[1], 8);
                v += __shfl_xor(v, 4); v += __shfl_xor(v, 2); v += __shfl_xor(v, 1);
                v += br[e];
                const bool c0 = v > t0, c1 = v > t1, c2 = v > t2, c3 = v > t3;
                t3 = c2 ? t2 : (c3 ? v : t3); i3 = c2 ? i2 : (c3 ? e : i3);
                t2 = c1 ? t1 : (c2 ? v : t2); i2 = c1 ? i1 : (c2 ? e : i2);
                t1 = c0 ? t0 : (c1 ? v : t1); i1 = c0 ? i0 : (c1 ? e : i1);
                t0 = c0 ? v : t0;             i0 = c0 ? e : i0;
            }
            {   const float e1 = __builtin_amdgcn_exp2f((t1 - t0) * LOG2E), e2 = __builtin_amdgcn_exp2f((t2 - t0) * LOG2E), e3 = __builtin_amdgcn_exp2f((t3 - t0) * LOG2E);
                const float inv = 1.f / (1.f + e1 + e2 + e3);
                const int lrow = wave * 8 + (b5 ? 4 : 0) + (b4 ? 2 : 0) + (b3 ? 1 : 0), t = lane & 7;
                if (t < 4) { const int ee = t == 0 ? i0 : t == 1 ? i1 : t == 2 ? i2 : i3;
                    const float gg = (t == 0 ? 1.f : t == 1 ? e1 : t == 2 ? e2 : e3) * inv;
                    const int rk = __hip_atomic_fetch_add(&lcnt[ee], 1, __ATOMIC_RELAXED, __HIP_MEMORY_SCOPE_WORKGROUP);
                    sel_e[lrow * 4 + t] = ee; sel_g[lrow * 4 + t] = gg; sel_r[lrow * 4 + t] = rk; } }
            __syncthreads();
            if (tid < 32) lbase[tid] = (int)atomicAdd(CNT + tid, (unsigned)lcnt[tid]);
            __syncthreads();
            if (tid < 256) { const int ee = sel_e[tid], pos = lbase[ee] + sel_r[tid], tok = blk * 64 + (tid >> 2);
                LIST[(size_t)ee * LISTCAP + pos] = (unsigned)tok; TOKPOS[(size_t)tok * 4 + (tid & 3)] = ((unsigned)ee << 16) | (unsigned)pos; TOKG[(size_t)tok * 4 + (tid & 3)] = sel_g[tid]; }
            __syncthreads();
        }
    }
    SEAM(7);
    if (IN(8) || IN(9)) {
        LAS int* blk_e = (LAS int*)(L + TAB_BLK);
        if (tid == 0) { int nb = 0; for (int e = 0; e < NEXP; ++e) { const int c = (int)__hip_atomic_load(CNT + e, RLX_AGENT); const int n = (c + 255) >> 8; for (int i = 0; i < n; ++i) blk_e[nb + i] = e; nb += n; } MISC[16] = (unsigned)nb; }
        __syncthreads();
        const int NB = (int)MISC[16];
        if (IN(8)) for (int rep_ = 0; rep_ < NREP(8); ++rep_) {
            for (int i = 0;; ++i) { const long Lu = (long)i * G + bx; if (Lu >= (long)NB * 8 || i >= 11) break;
                const int grb = (int)(Lu >> 3), e = blk_e[grb]; int first = grb; while (first > 0 && blk_e[first - 1] == e) --first;
                const int cnt = (int)__hip_atomic_load(CNT + e, RLX_AGENT);
                if (tid < 256) { const int ri = (grb - first) * 256 + tid; const unsigned tok = (ri < cnt) ? LIST[(size_t)e * LISTCAP + ri] : 0u;
                    *(LAS unsigned*)(L + TAB_GATH + i * 1024 + tid * 4) = tok * 1024u; } }
            __syncthreads();
            pg8::SchedMoe<8, true> S{(const char*)XN, (const char*)W1T, (size_t)2048 * 1024, blk_e, NB, G, bx, TAB_GATH};
            pg8::EpiMoe1 E{args.in[I_B1], (unsigned char*)ACT};
            pg8::gemm_phase<pg8::EpiMoe1, pg8::SchedMoe<8, true>, true, true, true>(L, 8, 1024, 1024, S, E);
        }
        SEAM(8);
        if (IN(9)) for (int rep_ = 0; rep_ < NREP(9); ++rep_) {
            pg8::SchedMoe<4, false> S{(const char*)ACT, (const char*)W2T, (size_t)1024 * 1024, blk_e, NB, G, bx, 0};
            pg8::EpiMoe2 E{args.in[I_B2], YIT};
            pg8::gemm_phase<pg8::EpiMoe2, pg8::SchedMoe<4, false>, true, false, true>(L, 8, 1024, 1024, S, E);
        }
    }
    SEAM(9);
    if (IN(10)) {
        LAS int* rbase = (LAS int*)(L + 0);
        if (tid == 0) { int nb = 0; for (int e = 0; e < NEXP; ++e) { rbase[e] = nb * 256; nb += ((int)__hip_atomic_load(CNT + e, RLX_AGENT) + 255) >> 8; } }
        __syncthreads();
        const float* gfo = args.in[I_GFPOST];
        for (int m = gw; m < MTOK; m += NGW) { const int b = m >> 13;
            f32x4 y[4];
#pragma unroll
            for (int j = 0; j < 4; ++j) y[j] = (f32x4){0.f, 0.f, 0.f, 0.f};
#pragma unroll
            for (int t = 0; t < 4; ++t) { const unsigned tp = TOKPOS[(size_t)m * 4 + t]; const float gt = TOKG[(size_t)m * 4 + t];
                const size_t row = (size_t)rbase[tp >> 16] + (tp & 0xffffu); const GAS u32x2* yr = (const GAS u32x2*)(YIT + row * 1024) + lane;
#pragma unroll
                for (int j = 0; j < 4; ++j) { const u32x2 w = yr[64 * j]; y[j][0] += gt * bf16_lo(w.x); y[j][1] += gt * bf16_hi(w.x); y[j][2] += gt * bf16_lo(w.y); y[j][3] += gt * bf16_hi(w.y); } }
            float s = 0.f;
#pragma unroll
            for (int j = 0; j < 4; ++j) s += (y[j].x * y[j].x + y[j].y * y[j].y) + (y[j].z * y[j].z + y[j].w * y[j].w);
            const float rstd = __builtin_amdgcn_rsqf(wave_sum(s) * (1.f / DM) + RMS_EPS);
            GAS f32x4* orow = (GAS f32x4*)(OUT + (size_t)m * DM) + lane;
#pragma unroll
            for (int j = 0; j < 4; ++j) { const int col = 4 * lane + 256 * j;
                const f32x4 gg = *(const f32x4*)(gfo + col), gf = *(const f32x4*)(MOD + b * 6144 + 5120 + col);
                orow[64 * j] = orow[64 * j] + gf * (y[j] * rstd * gg); } }
    }
#undef IN
#undef SEAM
}

constexpr int N_PHASES = 11;
extern "C" void kernel_launch(void* const* d_in, const int* in_sizes, int n_in, void* d_out, int out_size, void* d_ws, size_t ws_size, hipStream_t stream) {
    static int grid = 0;
    if (grid == 0) {
        if (n_in != 24 || out_size != MTOK * DM || ws_size < WS_END) { fprintf(stderr, "kernel_launch: unexpected shapes (n_in %d out %d ws %zu)\n", n_in, out_size, ws_size); grid = -1; return; }
        int dev = 0, cus = 0, per_cu = 0;
        if (hipGetDevice(&dev) != hipSuccess || hipDeviceGetAttribute(&cus, hipDeviceAttributeMultiprocessorCount, dev) != hipSuccess) { grid = -1; return; }
        if (hipFuncSetAttribute((const void*)fwd_kernel, hipFuncAttributeMaxDynamicSharedMemorySize, LDS_BYTES) != hipSuccess) { fprintf(stderr, "kernel_launch: hipFuncSetAttribute failed\n"); grid = -1; return; }
        if (hipOccupancyMaxActiveBlocksPerMultiprocessor(&per_cu, (const void*)fwd_kernel, NWAVES * 64, LDS_BYTES) != hipSuccess || per_cu < 1) { fprintf(stderr, "kernel_launch: occupancy query says %d\n", per_cu); per_cu = 1; }
        (void)hipGetLastError();
        grid = cus;
    }
    if (grid < 0) return;
    (void)hipMemsetAsync((char*)d_ws + WS_CTL, 0, CTL_ZERO_BYTES, stream);
    Args a{};
    for (int i = 0; i < 24; ++i) a.in[i] = (const float*)d_in[i];
    a.out = (float*)d_out; a.ws = (unsigned char*)d_ws;
#if MK_N_LAUNCHES == 1
    a.ph_lo = 0; a.ph_hi = N_PHASES;
    {   void* kargs[] = {(void*)&a};
        const hipError_t ce = hipLaunchCooperativeKernel((const void*)fwd_kernel, dim3(grid), dim3(NWAVES * 64), kargs, LDS_BYTES, stream);
        if (ce != hipSuccess) fprintf(stderr, "kernel_launch: cooperative launch failed: %s (grid %d)\n", hipGetErrorName(ce), grid); }
#else
    for (int p = 0; p < N_PHASES; ++p) { a.ph_lo = p; a.ph_hi = p + 1; hipLaunchKernelGGL(fwd_kernel, dim3(grid), dim3(NWAVES * 64), LDS_BYTES, stream, a); }
#endif
    const hipError_t le = hipPeekAtLastError();
    if (le != hipSuccess) fprintf(stderr, "kernel_launch: launch failed: %s\n", hipGetErrorName(le));
}
```

```cpp
#include <hip/hip_runtime.h>
#include <hip/hip_bf16.h>
#include <cstdio>
#include <cstdint>

#ifndef MK_N_LAUNCHES
#define MK_N_LAUNCHES 1
#endif

constexpr int BATCH = 2, SEQ = 8192, DM = 1024, MTOK = BATCH * SEQ;
constexpr int NPROJ = 4352;
constexpr int NEXP = 32, DFF = 1024, TOPK = 4;
constexpr int QLORA = 384, KVLORA = 256;
constexpr float RMS_EPS = 1e-6f;
constexpr float LOG2E = 1.4426950408889634f;
constexpr float C2NA = 0.125f * LOG2E;
constexpr float C2MLA = 0.10206207261596575f * LOG2E;
constexpr float SC_H2 = 8.f, SC_W = 64.f, SC_ACT = 4.f;
constexpr int NG_INPROJ = 218;
constexpr int LISTCAP = 16384;
constexpr int MAXROWS = 65536 + NEXP * 256;

#define GAS __attribute__((address_space(1)))
#define LAS __attribute__((address_space(3)))
typedef unsigned short bf16_t;
typedef short bf16x8 __attribute__((ext_vector_type(8)));
typedef short s16x4 __attribute__((ext_vector_type(4)));
typedef float f32x4 __attribute__((ext_vector_type(4)));
typedef float f32x2 __attribute__((ext_vector_type(2)));
typedef float f32x16 __attribute__((ext_vector_type(16)));
typedef unsigned u32x4 __attribute__((ext_vector_type(4)));
typedef unsigned u32x2 __attribute__((ext_vector_type(2)));
typedef GAS unsigned gu32;

__device__ __forceinline__ unsigned cvt_pk_bf16(float lo, float hi) { unsigned r; asm volatile("v_cvt_pk_bf16_f32 %0, %1, %2" : "=v"(r) : "v"(lo), "v"(hi)); return r; }
__device__ __forceinline__ float bf16_lo(unsigned w) { return __uint_as_float(w << 16); }
__device__ __forceinline__ float bf16_hi(unsigned w) { return __uint_as_float(w & 0xffff0000u); }
__device__ __forceinline__ float sigmoidf_(float z) { return __builtin_amdgcn_rcpf(1.f + __builtin_amdgcn_exp2f(-z * LOG2E)); }
__device__ __forceinline__ float wave_sum(float v) {
#pragma unroll
    for (int o = 1; o < 64; o <<= 1) v += __shfl_xor(v, o);
    return v;
}
__device__ __forceinline__ void rope_cs(float pos, int j, float& c, float& s) {
    const float inv = __builtin_amdgcn_exp2f(-(float)j * 0.83048202372184059f);
    const float rev = __builtin_amdgcn_fractf(pos * inv * 0.15915494309189535f);
    c = __builtin_amdgcn_cosf(rev); s = __builtin_amdgcn_sinf(rev);
}

namespace pg8 {
constexpr int BM = 256, BK = 64, HALF = 128, HTB = HALF * BK * 2, STAGE_BYTES = 8 * HTB, NXCD = 8, WGM = 8;
__host__ __device__ __forceinline__ int lds_byte(int r, int c) { const int st = (r >> 4) * 2 + (c >> 5), rr = r & 15, cc = c & 31, ob = rr * 64 + cc * 2; return st * 1024 + (ob ^ (((ob >> 9) & 1) << 5)); }
__host__ __device__ __forceinline__ void stage_rc(int b, int& R, int& C) { const int st = b / 1024, sb = b % 1024, swz = sb ^ (((sb >> 9) & 1) << 5); R = (st >> 1) * 16 + swz / 64; C = (st & 1) * 32 + (swz % 64) / 2; }
__host__ __device__ __forceinline__ int perm32(int rho) { const int n = rho >> 4, i = rho & 15; return 8 * (i >> 2) + 4 * n + (i & 3); }

struct Unit { const char* A; const char* B; const char* A2; const char* B2; int pm, pn, aux, tab; };

__device__ __forceinline__ void tile_of(int wgid, int nM, int nN, int& pm, int& pn) {
    const int nwg = nM * nN;
    { const int q = nwg / NXCD, r = nwg % NXCD, xcd = wgid % NXCD, off = wgid / NXCD; wgid = (xcd < r ? xcd * (q + 1) : r * (q + 1) + (xcd - r) * q) + off; }
    const int nig = WGM * nN, gid = wgid / nig, fm = gid * WGM, gsz = (nM - fm) < WGM ? (nM - fm) : WGM;
    pm = fm + ((wgid % nig) % gsz); pn = (wgid % nig) / gsz;
}

typedef int v8i32 __attribute__((ext_vector_type(8)));
typedef int v4i32_ __attribute__((ext_vector_type(4)));
template <class Epi, class Sched, bool ALIGN_EPI, bool GATHER, bool FP8, bool DUAL = false>
__device__ __forceinline__ void gemm_phase(LAS unsigned char* lds, const int nt, const int ldab, const int ldbb, const Sched& S, const Epi& E) {
    const int tid = threadIdx.x, wid = __builtin_amdgcn_readfirstlane(tid >> 6), lane = tid & 63, wr = wid >> 2, wc = wid & 3, fr = lane & 15, fq = lane >> 4;
    int Rr[2], Cc[2];
    unsigned voffA[2], voffB[2];
#pragma unroll
    for (int i = 0; i < 2; ++i) { int R, C; stage_rc(tid * 16 + i * 8192, R, C); const int Rb = Epi::PERM ? ((R & ~31) + perm32(R & 31)) : R;
        Rr[i] = R; Cc[i] = C; voffA[i] = (unsigned)(R * ldab + C * 2); voffB[i] = (unsigned)(Rb * ldbb + C * 2); }
    const size_t kstep = (size_t)(BK * 2);
    const size_t hstepA = (size_t)HALF * ldab, hstepB = (size_t)HALF * ldbb;
    const unsigned ldsw = (unsigned)wid * 1024u;
    const int aoff = lds_byte(wr * 64 + fr, fq * 8), boff = lds_byte(wc * 32 + fr, fq * 8);
#define PG8_SA(b, h) (((b) * 2 + (h)) * HTB)
#define PG8_SB(b, h) ((4 + (b) * 2 + (h)) * HTB)
#define PG8_STAGE(bufoff, gbase, voff) do { _Pragma("unroll") for (int _i = 0; _i < 2; ++_i) \
        __builtin_amdgcn_global_load_lds((const unsigned*)((const char*)(gbase) + (voff)[_i]), (LAS unsigned*)(lds + (bufoff) + ldsw + _i * 8192), 16, 0, 0); } while (0)
#define PG8_STAGE_A(bufoff, gbase, h, G) do { if constexpr (GATHER) { PG8_STAGE(bufoff, gbase, (G)[h]); } else { PG8_STAGE(bufoff, (gbase) + (h) * hstepA, voffA); } } while (0)
#define PG8_STAGE_B(bufoff, gbase, h) PG8_STAGE(bufoff, (gbase) + (h) * hstepB, voffB)
#define PG8_LD8(addr) __builtin_shufflevector(*(const LAS v4i32_*)(addr), *(const LAS v4i32_*)((addr) + 1024), 0, 1, 2, 3, 4, 5, 6, 7)
#define PG8_LDA(dst, b, h) do { if constexpr (FP8) { _Pragma("unroll") for (int m = 0; m < 4; ++m) dst##8[m] = PG8_LD8(lds + PG8_SA(b, h) + aoff + m * 2048); } \
        else { _Pragma("unroll") for (int m = 0; m < 4; ++m) _Pragma("unroll") for (int k = 0; k < 2; ++k) dst[m][k] = *(const LAS bf16x8*)(lds + PG8_SA(b, h) + aoff + m * 2048 + k * 1024); } } while (0)
#define PG8_LDB(dst, b, h) do { if constexpr (FP8) { _Pragma("unroll") for (int n = 0; n < 2; ++n) dst##8[n] = PG8_LD8(lds + PG8_SB(b, h) + boff + n * 2048); } \
        else { _Pragma("unroll") for (int n = 0; n < 2; ++n) _Pragma("unroll") for (int k = 0; k < 2; ++k) dst[n][k] = *(const LAS bf16x8*)(lds + PG8_SB(b, h) + boff + n * 2048 + k * 1024); } } while (0)
#define PG8_MMA(ai, bj, At, Bt) do { __builtin_amdgcn_s_setprio(1); _Pragma("unroll") for (int m = 0; m < 4; ++m) _Pragma("unroll") for (int n = 0; n < 2; ++n) { \
        if constexpr (FP8) { asm volatile("v_mfma_scale_f32_16x16x128_f8f6f4 %0, %1, %2, %0, %3, %3 op_sel_hi:[0,0,0]" : "+v"(acc[ai][bj][m][n]) : "v"(Bt##8[n]), "v"(At##8[m]), "v"(sc1_)); } \
        else { _Pragma("unroll") for (int k = 0; k < 2; ++k) acc[ai][bj][m][n] = __builtin_amdgcn_mfma_f32_16x16x32_bf16(Bt[n][k], At[m][k], acc[ai][bj][m][n], 0, 0, 0); } } \
        __builtin_amdgcn_s_setprio(0); } while (0)
#define PG8_WAIT_V(n) asm volatile("s_waitcnt vmcnt(" #n ")" ::: "memory")
#define PG8_WAIT_L(n) asm volatile("s_waitcnt lgkmcnt(" #n ")" ::: "memory")
#define PG8_BAR __builtin_amdgcn_s_barrier()
#define PG8_SCHED __builtin_amdgcn_sched_barrier(0)
    Unit cur, nxt; int ui = 0;
    if (!S.next(0, cur)) return;
    f32x4 acc[2][2][4][2];
#pragma unroll
    for (int a = 0; a < 2; ++a)
#pragma unroll
        for (int b = 0; b < 2; ++b)
#pragma unroll
            for (int m = 0; m < 4; ++m)
#pragma unroll
                for (int n = 0; n < 2; ++n) acc[a][b][m][n] = (f32x4){0.f, 0.f, 0.f, 0.f};
    bf16x8 At[4][2], B0[2][2], B1[2][2]; v8i32 At8[4], B08[2], B18[2];
    int sc1_ = 0x7F7F7F7F; asm volatile("" : "+v"(sc1_));
    unsigned gC[2][2], gN[2][2];
#define PG8_GLOAD(G, u) do { if constexpr (GATHER) { const LAS unsigned* tb_ = (const LAS unsigned*)(lds + (u).tab); _Pragma("unroll") for (int h_ = 0; h_ < 2; ++h_) _Pragma("unroll") for (int i_ = 0; i_ < 2; ++i_) \
        (G)[h_][i_] = tb_[h_ * 128 + Rr[i_]] + (unsigned)(Cc[i_] * 2); } } while (0)
    PG8_GLOAD(gC, cur);
    const char* cA = cur.A; const char* cB = cur.B; const char* cA2 = cur.A2; const char* cB2 = cur.B2; const int nth = nt >> 1;
    PG8_STAGE_B(PG8_SB(0, 0), cB, 0); PG8_STAGE_B(PG8_SB(0, 1), cB, 1); PG8_STAGE_A(PG8_SA(0, 0), cA, 0, gC); PG8_STAGE_A(PG8_SA(0, 1), cA, 1, gC);
    if (wr == 1) PG8_BAR;
    PG8_WAIT_V(2); PG8_BAR;
    PG8_STAGE_B(PG8_SB(1, 0), cB + kstep, 0); PG8_STAGE_A(PG8_SA(1, 0), cA + kstep, 0, gC); PG8_STAGE_B(PG8_SB(1, 1), cB + kstep, 1);
    PG8_WAIT_V(6); PG8_BAR;
    for (;;) {
        const bool has_next = S.next(ui + 1, nxt);
        const char* nA = has_next ? nxt.A : cA; const char* nB = has_next ? nxt.B : cB;
        if constexpr (GATHER) { if (has_next) { PG8_GLOAD(gN, nxt); } else {
#pragma unroll
            for (int h_ = 0; h_ < 2; ++h_)
#pragma unroll
                for (int i_ = 0; i_ < 2; ++i_) gN[h_][i_] = gC[h_][i_]; } }
#pragma unroll 1
        for (int t = 0; t < nt; t += 2) {
            const bool last = (t == nt - 2);
            if constexpr (DUAL) { if (t == nth) E.mid(acc, cur, wr, wc, fr, fq); }
#define PG8_TILEA(tt) (((DUAL && (tt) >= nth) ? cA2 - (size_t)nth * kstep : cA) + (size_t)(tt) * kstep)
#define PG8_TILEB(tt) (((DUAL && (tt) >= nth) ? cB2 - (size_t)nth * kstep : cB) + (size_t)(tt) * kstep)
            const char* a1 = PG8_TILEA(t + 1);
            const char* a2 = last ? nA : PG8_TILEA(t + 2); const char* b2 = last ? nB : PG8_TILEB(t + 2);
            const char* a3 = a2 + kstep; const char* b3 = b2 + kstep;
            unsigned g2[2][2];
            if constexpr (GATHER) {
#pragma unroll
                for (int h_ = 0; h_ < 2; ++h_)
#pragma unroll
                    for (int i_ = 0; i_ < 2; ++i_) g2[h_][i_] = last ? gN[h_][i_] : gC[h_][i_]; }
            PG8_LDB(B0, 0, 0); PG8_LDB(B1, 0, 1); PG8_SCHED; PG8_LDA(At, 0, 0); PG8_STAGE_A(PG8_SA(1, 1), a1, 1, gC);
            PG8_WAIT_V(8); PG8_WAIT_L(0); PG8_BAR; PG8_MMA(0, 0, At, B0); PG8_MMA(0, 1, At, B1); PG8_BAR; PG8_SCHED;
            PG8_LDA(At, 0, 1); PG8_STAGE_B(PG8_SB(0, 0), b2, 0); PG8_STAGE_B(PG8_SB(0, 1), b2, 1); PG8_STAGE_A(PG8_SA(0, 0), a2, 0, g2);
            PG8_WAIT_V(8); PG8_WAIT_L(0); PG8_BAR; PG8_MMA(1, 0, At, B0); PG8_MMA(1, 1, At, B1); PG8_BAR; PG8_SCHED;
            PG8_LDB(B0, 1, 0); PG8_LDB(B1, 1, 1); PG8_SCHED; PG8_LDA(At, 1, 0); PG8_STAGE_A(PG8_SA(0, 1), a2, 1, g2);
            PG8_WAIT_V(8); PG8_WAIT_L(0); PG8_BAR; PG8_MMA(0, 0, At, B0); PG8_MMA(0, 1, At, B1); PG8_BAR; PG8_SCHED;
            PG8_LDA(At, 1, 1); PG8_STAGE_B(PG8_SB(1, 0), b3, 0); PG8_STAGE_B(PG8_SB(1, 1), b3, 1); PG8_STAGE_A(PG8_SA(1, 0), a3, 0, g2);
            PG8_WAIT_V(8); PG8_WAIT_L(0); PG8_BAR; PG8_MMA(1, 0, At, B0); PG8_MMA(1, 1, At, B1); PG8_BAR; PG8_SCHED;
        }
        if constexpr (ALIGN_EPI) { if (wr == 0) PG8_BAR; }
        if constexpr (FP8) asm volatile("s_nop 15\n\ts_nop 15" ::: "memory");
        E(acc, cur, wr, wc, fr, fq);
        if (!has_next) break;
#pragma unroll
        for (int a = 0; a < 2; ++a)
#pragma unroll
            for (int b = 0; b < 2; ++b)
#pragma unroll
                for (int m = 0; m < 4; ++m)
#pragma unroll
                    for (int n = 0; n < 2; ++n) acc[a][b][m][n] = (f32x4){0.f, 0.f, 0.f, 0.f};
        cur = nxt; cA = nA; cB = nB; cA2 = cur.A2; cB2 = cur.B2; ++ui;
        if constexpr (GATHER) {
#pragma unroll
            for (int h_ = 0; h_ < 2; ++h_)
#pragma unroll
                for (int i_ = 0; i_ < 2; ++i_) gC[h_][i_] = gN[h_][i_]; }
        if constexpr (ALIGN_EPI) { if (wr == 1) PG8_BAR; }
    }
    PG8_WAIT_V(0);
    if constexpr (!ALIGN_EPI) { if (wr == 0) PG8_BAR; }
    PG8_BAR;
#undef PG8_SA
#undef PG8_SB
#undef PG8_STAGE
#undef PG8_STAGE_A
#undef PG8_STAGE_B
#undef PG8_LDA
#undef PG8_LD8
#undef PG8_LDB
#undef PG8_MMA
#undef PG8_WAIT_V
#undef PG8_WAIT_L
#undef PG8_BAR
#undef PG8_SCHED
#undef PG8_GLOAD
#undef PG8_TILEA
#undef PG8_TILEB
}

typedef f32x4 Acc[2][2][4][2];

struct SchedDense {
    const char* A; const char* B; size_t a_tile_bytes, b_tile_bytes; int nM, nN, G, c;
    __device__ __forceinline__ bool next(int i, Unit& u) const {
        const long L = (long)i * G + c; if (L >= (long)nM * nN) return false;
        int pm, pn; tile_of((int)L, nM, nN, pm, pn);
        u.pm = pm; u.pn = pn; u.aux = 0; u.tab = 0; u.A = A + (size_t)pm * a_tile_bytes; u.B = B + (size_t)pn * b_tile_bytes; u.A2 = u.A; u.B2 = u.B; return true;
    }
};
struct SchedMerge {
    const char* A0; const char* A1; const char* B0; const char* B1; int nM, nN, G, c;
    __device__ __forceinline__ bool next(int i, Unit& u) const {
        const long T = (long)i * G + c; if (T >= (long)nM * nN) return false;
        int pm, pn; tile_of((int)T, nM, nN, pm, pn);
        u.pm = pm; u.pn = pn; u.aux = 0; u.tab = 0;
        u.A = A0 + (size_t)pm * (256 * 512 * 2); u.B = B0 + (size_t)pn * (256 * 512 * 2); u.A2 = A1 + (size_t)pm * (256 * 512 * 2); u.B2 = B1 + (size_t)pn * (256 * 512 * 2); return true;
    }
};
template <int NPN, bool GATHER>
struct SchedMoe {
    const char* A; const char* B; size_t b_expert_bytes; LAS const int* blk_e; int NB, G, c, tab0;
    __device__ __forceinline__ bool next(int i, Unit& u) const {
        const long L = (long)i * G + c; if (L >= (long)NB * NPN) return false;
        const int grb = (int)(L / NPN), pn = (int)(L % NPN);
        const int e = __builtin_amdgcn_readfirstlane(blk_e[grb]);
        u.pm = grb; u.pn = pn; u.aux = e; u.tab = tab0 + i * 1024;
        u.A = GATHER ? A : A + (size_t)grb * (256 * 1024);
        u.B = B + (size_t)e * b_expert_bytes + (size_t)pn * (256 * 1024); u.A2 = u.A; u.B2 = u.B; return true;
    }
};

struct EpiInProj {
    static constexpr bool PERM = true;
    bf16_t* PROJ; float* SSQ; bf16_t* KR; const float* ROPE; const float* bgate;
    __device__ __forceinline__ void operator()(const Acc& acc, const Unit& u, int wr, int wc, int fr, int fq) const {
        const int pn = u.pn, row0 = u.pm * BM + wr * 64 + fr, colb = pn * BM + wc * 32 + 8 * fq;
        const float sc = (pn < 2) ? C2NA : 1.f;
        f32x4 gb[2][2];
#pragma unroll
        for (int bj = 0; bj < 2; ++bj)
#pragma unroll
            for (int n = 0; n < 2; ++n) gb[bj][n] = (pn >= 9) ? *(const f32x4*)(bgate + (colb - 2304) + bj * HALF + 4 * n) : (f32x4){0.f, 0.f, 0.f, 0.f};
#pragma unroll
        for (int ai = 0; ai < 2; ++ai)
#pragma unroll
            for (int m = 0; m < 4; ++m) { const int row = row0 + ai * HALF + m * 16; bf16_t* rowp = PROJ + (size_t)row * NPROJ + colb;
#pragma unroll
                for (int bj = 0; bj < 2; ++bj) { const f32x4 v0 = acc[ai][bj][m][0] * sc + gb[bj][0], v1 = acc[ai][bj][m][1] * sc + gb[bj][1]; u32x4 w;
                    w.x = cvt_pk_bf16(v0[0], v0[1]); w.y = cvt_pk_bf16(v0[2], v0[3]); w.z = cvt_pk_bf16(v1[0], v1[1]); w.w = cvt_pk_bf16(v1[2], v1[3]);
                    *(u32x4*)(rowp + bj * HALF) = w; } }
        if (pn >= 6 && pn <= 8) {
#pragma unroll
            for (int ai = 0; ai < 2; ++ai)
#pragma unroll
                for (int m = 0; m < 4; ++m) { const int row = row0 + ai * HALF + m * 16; float s[2];
#pragma unroll
                    for (int bj = 0; bj < 2; ++bj) { const f32x4 a = acc[ai][bj][m][0], b = acc[ai][bj][m][1];
                        float t = (a[0] * a[0] + a[1] * a[1]) + (a[2] * a[2] + a[3] * a[3]) + (b[0] * b[0] + b[1] * b[1]) + (b[2] * b[2] + b[3] * b[3]);
                        t += __shfl_xor(t, 16); t += __shfl_xor(t, 32); s[bj] = t; }
                    if (fq == 0) {
                        float* sp = SSQ + (size_t)row * 16 + wc;
                        if (pn == 6) { sp[0] = s[0] + s[1]; }
                        else if (pn == 7) { sp[4] = s[0]; sp[8] = s[1]; }
                        else { sp[12] = s[0]; }
                    } }
            if (pn == 8 && wc == 0) {
#pragma unroll
                for (int ai = 0; ai < 2; ++ai)
#pragma unroll
                    for (int m = 0; m < 4; ++m) { const int row = row0 + ai * HALF + m * 16, tok = row & (SEQ - 1);
                        const int pos = (fq >> 1) ? (tok & 63) : (tok >> 6); float o[8];
                        const f32x4 cs4 = *(const f32x4*)(ROPE + pos * 16 + 4 * (fq & 1)), sn4 = *(const f32x4*)(ROPE + pos * 16 + 8 + 4 * (fq & 1));
#pragma unroll
                        for (int n = 0; n < 2; ++n)
#pragma unroll
                            for (int q = 0; q < 2; ++q) { const float c = cs4[2 * n + q], s = sn4[2 * n + q];
                                const float x1 = acc[ai][1][m][n][2 * q], x2 = acc[ai][1][m][n][2 * q + 1];
                                o[4 * n + 2 * q] = x1 * c - x2 * s; o[4 * n + 2 * q + 1] = x1 * s + x2 * c; }
                        u32x4 w; w.x = cvt_pk_bf16(o[0], o[1]); w.y = cvt_pk_bf16(o[2], o[3]); w.z = cvt_pk_bf16(o[4], o[5]); w.w = cvt_pk_bf16(o[6], o[7]);
                        *(u32x4*)(KR + (size_t)row * 32 + 8 * fq) = w; }
            }
        }
    }
};
struct EpiQUp {
    static constexpr bool PERM = true;
    bf16_t* QN; bf16_t* QR; const float* SSQ; const float* ROPE;
    __device__ __forceinline__ void operator()(const Acc& acc, const Unit& u, int wr, int wc, int fr, int fq) const {
        const int pn = u.pn, row0 = u.pm * BM + wr * 64 + fr, colt = wc * 32 + 8 * fq;
#pragma unroll
        for (int ai = 0; ai < 2; ++ai)
#pragma unroll
            for (int m = 0; m < 4; ++m) { const int row = row0 + ai * HALF + m * 16;
                const f32x4 q0_ = *(const f32x4*)(SSQ + (size_t)row * 16), q1_ = *(const f32x4*)(SSQ + (size_t)row * 16 + 4);
                const float rs = __builtin_amdgcn_rsqf((((q0_[0] + q0_[1]) + (q0_[2] + q0_[3])) + ((q1_[0] + q1_[1]) + (q1_[2] + q1_[3]))) * (1.f / QLORA) + RMS_EPS) * C2MLA;
                if (pn < 2) {
#pragma unroll
                    for (int bj = 0; bj < 2; ++bj) { const f32x4 v0 = acc[ai][bj][m][0] * rs, v1 = acc[ai][bj][m][1] * rs; u32x4 w;
                        w.x = cvt_pk_bf16(v0[0], v0[1]); w.y = cvt_pk_bf16(v0[2], v0[3]); w.z = cvt_pk_bf16(v1[0], v1[1]); w.w = cvt_pk_bf16(v1[2], v1[3]);
                        *(u32x4*)(QN + (size_t)row * 512 + pn * 256 + bj * HALF + colt) = w; }
                } else {
                    const int tok = row & (SEQ - 1); const int pos = (fq >> 1) ? (tok & 63) : (tok >> 6);
                    const f32x4 cs4 = *(const f32x4*)(ROPE + pos * 16 + 4 * (fq & 1)), sn4 = *(const f32x4*)(ROPE + pos * 16 + 8 + 4 * (fq & 1));
#pragma unroll
                    for (int bj = 0; bj < 2; ++bj) { float o[8];
#pragma unroll
                        for (int n = 0; n < 2; ++n)
#pragma unroll
                            for (int q = 0; q < 2; ++q) { const float c = cs4[2 * n + q], s = sn4[2 * n + q];
                                const float x1 = acc[ai][bj][m][n][2 * q] * rs, x2 = acc[ai][bj][m][n][2 * q + 1] * rs;
                                o[4 * n + 2 * q] = x1 * c - x2 * s; o[4 * n + 2 * q + 1] = x1 * s + x2 * c; }
                        u32x4 w; w.x = cvt_pk_bf16(o[0], o[1]); w.y = cvt_pk_bf16(o[2], o[3]); w.z = cvt_pk_bf16(o[4], o[5]); w.w = cvt_pk_bf16(o[6], o[7]);
                        *(u32x4*)(QR + (size_t)row * 256 + bj * HALF + colt) = w; }
                }
                asm volatile("" ::: "memory"); }
    }
};
struct EpiKVUp {
    static constexpr bool PERM = true;
    bf16_t* KN; bf16_t* VM; const float* SSQ;
    __device__ __forceinline__ void operator()(const Acc& acc, const Unit& u, int wr, int wc, int fr, int fq) const {
        const int pn = u.pn, row0 = u.pm * BM + wr * 64 + fr, colt = wc * 32 + 8 * fq;
        bf16_t* dst = (pn < 2) ? KN + pn * 256 : VM + (pn - 2) * 256;
#pragma unroll
        for (int ai = 0; ai < 2; ++ai)
#pragma unroll
            for (int m = 0; m < 4; ++m) { const int row = row0 + ai * HALF + m * 16;
                const f32x4 q0_ = *(const f32x4*)(SSQ + (size_t)row * 16 + 8), q1_ = *(const f32x4*)(SSQ + (size_t)row * 16 + 12);
                const float rs = __builtin_amdgcn_rsqf((((q0_[0] + q0_[1]) + (q0_[2] + q0_[3])) + ((q1_[0] + q1_[1]) + (q1_[2] + q1_[3]))) * (1.f / KVLORA) + RMS_EPS);
#pragma unroll
                for (int bj = 0; bj < 2; ++bj) { const f32x4 v0 = acc[ai][bj][m][0] * rs, v1 = acc[ai][bj][m][1] * rs; u32x4 w;
                    w.x = cvt_pk_bf16(v0[0], v0[1]); w.y = cvt_pk_bf16(v0[2], v0[3]); w.z = cvt_pk_bf16(v1[0], v1[1]); w.w = cvt_pk_bf16(v1[2], v1[3]);
                    *(u32x4*)(dst + (size_t)row * 512 + bj * HALF + colt) = w; } }
    }
};
struct EpiMerge {
    static constexpr bool PERM = true;
    const bf16_t* PROJ; bf16_t* MERGED;
    __device__ __forceinline__ void mid(Acc& acc, const Unit& u, int wr, int wc, int fr, int fq) const {
        int row0 = u.pm * BM + wr * 64 + fr; const int col0 = u.pn * BM + wc * 32 + 8 * fq;
        asm volatile("" : "+v"(row0));
#pragma unroll
        for (int ai = 0; ai < 2; ++ai)
#pragma unroll
            for (int m = 0; m < 4; ++m) { const bf16_t* rp = PROJ + (size_t)(row0 + ai * HALF + m * 16) * NPROJ + 2304 + col0;
#pragma unroll
                for (int bj = 0; bj < 2; ++bj) { const u32x4 g1 = *(const u32x4*)(rp + bj * HALF), g2 = *(const u32x4*)(rp + 1024 + bj * HALF);
                    const unsigned w1[4] = {g1.x, g1.y, g1.z, g1.w}, w2[4] = {g2.x, g2.y, g2.z, g2.w};
#pragma unroll
                    for (int q = 0; q < 4; ++q) { const int n = q >> 1, i = (q & 1) * 2;
                        const float r0 = (1.f + __builtin_amdgcn_exp2f(-bf16_lo(w2[q]) * LOG2E)) * __builtin_amdgcn_rcpf(1.f + __builtin_amdgcn_exp2f(-bf16_lo(w1[q]) * LOG2E));
                        const float r1 = (1.f + __builtin_amdgcn_exp2f(-bf16_hi(w2[q]) * LOG2E)) * __builtin_amdgcn_rcpf(1.f + __builtin_amdgcn_exp2f(-bf16_hi(w1[q]) * LOG2E));
                        acc[ai][bj][m][n][i] *= r0; acc[ai][bj][m][n][i + 1] *= r1; } }
                asm volatile("" ::: "memory"); }
    }
    __device__ __forceinline__ void operator()(const Acc& acc, const Unit& u, int wr, int wc, int fr, int fq) const {
        const int row0 = u.pm * BM + wr * 64 + fr, col0 = u.pn * BM + wc * 32 + 8 * fq;
#pragma unroll
        for (int ai = 0; ai < 2; ++ai)
#pragma unroll
            for (int m = 0; m < 4; ++m) { const int row = row0 + ai * HALF + m * 16; const bf16_t* rp = PROJ + (size_t)row * NPROJ + 3328 + col0;
#pragma unroll
                for (int bj = 0; bj < 2; ++bj) { const u32x4 g2 = *(const u32x4*)(rp + bj * HALF);
                    f32x4 s0, s1;
                    s0[0] = sigmoidf_(bf16_lo(g2.x)); s0[1] = sigmoidf_(bf16_hi(g2.x)); s0[2] = sigmoidf_(bf16_lo(g2.y)); s0[3] = sigmoidf_(bf16_hi(g2.y));
                    s1[0] = sigmoidf_(bf16_lo(g2.z)); s1[1] = sigmoidf_(bf16_hi(g2.z)); s1[2] = sigmoidf_(bf16_lo(g2.w)); s1[3] = sigmoidf_(bf16_hi(g2.w));
                    const f32x4 v0 = acc[ai][bj][m][0] * s0, v1 = acc[ai][bj][m][1] * s1; u32x4 w;
                    w.x = cvt_pk_bf16(v0[0], v0[1]); w.y = cvt_pk_bf16(v0[2], v0[3]); w.z = cvt_pk_bf16(v1[0], v1[1]); w.w = cvt_pk_bf16(v1[2], v1[3]);
                    *(u32x4*)(MERGED + (size_t)row * 1024 + col0 + bj * HALF) = w; }
                asm volatile("" ::: "memory"); }
    }
};
struct EpiBf16Y {
    static constexpr bool PERM = true;
    bf16_t* C;
    __device__ __forceinline__ void operator()(const Acc& acc, const Unit& u, int wr, int wc, int fr, int fq) const {
        const int row0 = u.pm * BM + wr * 64 + fr, col0 = u.pn * BM + wc * 32 + 8 * fq;
#pragma unroll
        for (int ai = 0; ai < 2; ++ai)
#pragma unroll
            for (int m = 0; m < 4; ++m) { bf16_t* rowp = C + (size_t)(row0 + ai * HALF + m * 16) * 1024 + col0;
#pragma unroll
                for (int bj = 0; bj < 2; ++bj) { const f32x4 v0 = acc[ai][bj][m][0], v1 = acc[ai][bj][m][1]; u32x4 w;
                    w.x = cvt_pk_bf16(v0[0], v0[1]); w.y = cvt_pk_bf16(v0[2], v0[3]); w.z = cvt_pk_bf16(v1[0], v1[1]); w.w = cvt_pk_bf16(v1[2], v1[3]);
                    *(u32x4*)(rowp + bj * HALF) = w; } }
    }
};
struct EpiMoe1 {
    static constexpr bool PERM = true;
    const float* b1; unsigned char* ACT;
    __device__ __forceinline__ void operator()(const Acc& acc, const Unit& u, int wr, int wc, int fr, int fq) const {
        const int e = u.aux, row0 = u.pm * BM + wr * 64 + fr, col0 = u.pn * BM + wc * 32 + 8 * fq;
        constexpr float DS = 1.f / (SC_H2 * SC_W);
        f32x4 bv[2][2];
#pragma unroll
        for (int bj = 0; bj < 2; ++bj)
#pragma unroll
            for (int n = 0; n < 2; ++n) bv[bj][n] = *(const f32x4*)(b1 + (size_t)e * 2048 + col0 + bj * HALF + 4 * n);
#pragma unroll
        for (int ai = 0; ai < 2; ++ai)
#pragma unroll
            for (int m = 0; m < 4; ++m) { const int row = row0 + ai * HALF + m * 16;
#pragma unroll
                for (int bj = 0; bj < 2; ++bj) { float o[4];
#pragma unroll
                    for (int n = 0; n < 2; ++n) { const f32x4 v = acc[ai][bj][m][n] * DS + bv[bj][n];
#pragma unroll
                        for (int q = 0; q < 2; ++q) { const float xg = fminf(v[2 * q], 7.f), xl = fminf(fmaxf(v[2 * q + 1], -7.f), 7.f);
                            o[2 * n + q] = xg * sigmoidf_(1.702f * xg) * (xl + 1.f) * SC_ACT; } }
                    int w = __builtin_amdgcn_cvt_pk_fp8_f32(o[0], o[1], 0, false); w = __builtin_amdgcn_cvt_pk_fp8_f32(o[2], o[3], w, true);
                    *(int*)(ACT + (size_t)row * 1024 + ((col0 + bj * HALF) >> 1)) = w; } }
    }
};
struct EpiMoe2 {
    static constexpr bool PERM = true;
    const float* b2; bf16_t* YIT;
    __device__ __forceinline__ void operator()(const Acc& acc, const Unit& u, int wr, int wc, int fr, int fq) const {
        const int e = u.aux, row0 = u.pm * BM + wr * 64 + fr, col0 = u.pn * BM + wc * 32 + 8 * fq;
        f32x4 bv[2][2];
#pragma unroll
        for (int bj = 0; bj < 2; ++bj)
#pragma unroll
            for (int n = 0; n < 2; ++n) bv[bj][n] = *(const f32x4*)(b2 + (size_t)e * 1024 + col0 + bj * HALF + 4 * n);
#pragma unroll
        for (int ai = 0; ai < 2; ++ai)
#pragma unroll
            for (int m = 0; m < 4; ++m) { const int row = row0 + ai * HALF + m * 16;
#pragma unroll
                for (int bj = 0; bj < 2; ++bj) { const f32x4 v0 = acc[ai][bj][m][0] * (1.f / (SC_ACT * SC_W)) + bv[bj][0], v1 = acc[ai][bj][m][1] * (1.f / (SC_ACT * SC_W)) + bv[bj][1]; u32x4 w;
                    w.x = cvt_pk_bf16(v0[0], v0[1]); w.y = cvt_pk_bf16(v0[2], v0[3]); w.z = cvt_pk_bf16(v1[0], v1[1]); w.w = cvt_pk_bf16(v1[2], v1[3]);
                    *(u32x4*)(YIT + (size_t)row * 1024 + col0 + bj * HALF) = w; } }
    }
};
}

namespace attn {
#define SBAR() __builtin_amdgcn_sched_barrier(0)
constexpr int NW = 8, QBLK = 32, KVBLK = 64;
constexpr float THR = 8.f;
__device__ __forceinline__ int crow(int r, int hi) { return (r & 3) + 8 * (r >> 2) + 4 * hi; }
constexpr int KROW_MLA = 96 * 2 + 16, KROW_NA = 64 * 2 + 16;
constexpr int SHM_K = 64 * KROW_MLA  , SHM_V = 64 * 64 * 2  ;
constexpr int OFF_V = 0, OFF_K = 4 * SHM_V, OFF_WS = OFF_K + 4 * SHM_K, OFF_OST = OFF_WS + NW * 256, OFF_BIAS = OFF_OST + NW * 4096, ATTN_LDS = OFF_BIAS + 2048;

__device__ __forceinline__ int v_st(int k, int c) { const int kk = (k & ~0xC) | ((k & 4) << 1) | ((k & 8) >> 1); return ((kk >> 3) * 2 + (c >> 5)) * 512 + ((kk & 7) * 32 + (c & 31)) * 2; }
__device__ __forceinline__ int v_rd_base(int lane) { return ((lane & 3) << 3) | (((lane >> 2) & 3) << 6) | (((lane >> 4) & 1) << 5) | (((lane >> 5) & 1) << 8); }
constexpr int v_rd_off(int d0, int ks, int half) { return d0 * 512 + ks * 2048 + half * 1024; }
template <int OFF> __device__ __forceinline__ s16x4 tr_read(int vb) {
    s16x4 r; asm volatile("ds_read_b64_tr_b16 %0, %1 offset:%2" : "=&v"(r) : "v"(vb), "i"(OFF) : "memory"); return r;
}
template <int D0> __device__ __forceinline__ void pv_one(f32x16& od, int vb, bf16x8 pa0, bf16x8 pa1, bf16x8 pa2, bf16x8 pa3) {
    const s16x4 l0 = tr_read<v_rd_off(D0, 0, 0)>(vb), h0 = tr_read<v_rd_off(D0, 0, 1)>(vb), l1 = tr_read<v_rd_off(D0, 1, 0)>(vb), h1 = tr_read<v_rd_off(D0, 1, 1)>(vb);
    const s16x4 l2 = tr_read<v_rd_off(D0, 2, 0)>(vb), h2 = tr_read<v_rd_off(D0, 2, 1)>(vb), l3 = tr_read<v_rd_off(D0, 3, 0)>(vb), h3 = tr_read<v_rd_off(D0, 3, 1)>(vb);
    asm volatile("s_waitcnt lgkmcnt(0)" ::: "memory"); SBAR();
#define PK(L, H) (bf16x8){L[0], L[1], L[2], L[3], H[0], H[1], H[2], H[3]}
    od = __builtin_amdgcn_mfma_f32_32x32x16_bf16(pa0, PK(l0, h0), od, 0, 0, 0);
    od = __builtin_amdgcn_mfma_f32_32x32x16_bf16(pa1, PK(l1, h1), od, 0, 0, 0);
    od = __builtin_amdgcn_mfma_f32_32x32x16_bf16(pa2, PK(l2, h2), od, 0, 0, 0);
    od = __builtin_amdgcn_mfma_f32_32x32x16_bf16(pa3, PK(l3, h3), od, 0, 0, 0);
#undef PK
}
__device__ __forceinline__ void pv_d0(f32x16* o, int vb, bf16x8 pa0, bf16x8 pa1, bf16x8 pa2, bf16x8 pa3) {
    pv_one<0>(o[0], vb, pa0, pa1, pa2, pa3); pv_one<1>(o[1], vb, pa0, pa1, pa2, pa3);
}
__device__ __forceinline__ void partialSM(f32x16& p0, f32x16& p1, float& m_ref, f32x16& negm, float& alpha, bool& fresh) {
    float pmax = p0[0];
#pragma unroll
    for (int r = 1; r < 16; ++r) pmax = fmaxf(pmax, p0[r]);
#pragma unroll
    for (int r = 0; r < 16; ++r) pmax = fmaxf(pmax, p1[r]);
    { auto rr = __builtin_amdgcn_permlane32_swap(__float_as_uint(pmax), __float_as_uint(pmax), false, false);
      pmax = fmaxf(__uint_as_float(rr[0]), __uint_as_float(rr[1])); }
    alpha = 1.f;
    if (__builtin_expect(fresh || !__all(pmax <= THR), 0)) {
        const float dl = fresh ? pmax : fmaxf(pmax, 0.f);
        m_ref += dl;
#pragma unroll
        for (int r = 0; r < 16; ++r) { p0[r] -= dl; p1[r] -= dl; }
        const float nm = -m_ref;
#pragma unroll
        for (int r = 0; r < 16; ++r) negm[r] = nm;
        alpha = fresh ? 1.f : __builtin_amdgcn_exp2f(-dl);
        fresh = false;
    }
#pragma unroll
    for (int r = 0; r < 16; ++r) p0[r] = __builtin_amdgcn_exp2f(p0[r]);
}
__device__ __forceinline__ void finishSM(f32x16& p0, f32x16& p1, float alpha, float& l_reg, bf16x8& pa0, bf16x8& pa1, bf16x8& pa2, bf16x8& pa3) {
#pragma unroll
    for (int r = 0; r < 16; ++r) p1[r] = __builtin_amdgcn_exp2f(p1[r]);
    float ps = 0;
#pragma unroll
    for (int r = 0; r < 16; ++r) ps += p0[r];
#pragma unroll
    for (int r = 0; r < 16; ++r) ps += p1[r];
    { auto rr = __builtin_amdgcn_permlane32_swap(__float_as_uint(ps), __float_as_uint(ps), false, false);
      ps = __uint_as_float(rr[0]) + __uint_as_float(rr[1]); }
    l_reg = l_reg * alpha + ps;
#define PK4(P, BASE, OUT) do { unsigned a0 = cvt_pk_bf16(P[BASE + 0], P[BASE + 1]), a1 = cvt_pk_bf16(P[BASE + 2], P[BASE + 3]);   \
    unsigned b0 = cvt_pk_bf16(P[BASE + 4], P[BASE + 5]), b1 = cvt_pk_bf16(P[BASE + 6], P[BASE + 7]);                              \
    auto r0 = __builtin_amdgcn_permlane32_swap(a0, b0, false, false); auto r1 = __builtin_amdgcn_permlane32_swap(a1, b1, false, false); \
    u32x4 w = {r0[0], r1[0], r0[1], r1[1]}; OUT = *reinterpret_cast<bf16x8*>(&w); } while (0)
    PK4(p0, 0, pa0); PK4(p0, 8, pa1); PK4(p1, 0, pa2); PK4(p1, 8, pa3);
#undef PK4
}
template <int ND0, int KROW>
__device__ __forceinline__ void qkt(f32x16& p0, f32x16& p1, const char* Ks, const bf16x8* qr, const f32x16& negm, int r32, int hi) {
#pragma unroll
    for (int d0 = 0; d0 < ND0; ++d0) { const int cb = (d0 * 16 + hi * 8) * 2;
        const bf16x8 b0 = *reinterpret_cast<const bf16x8*>(Ks + r32 * KROW + cb);
        const bf16x8 b1 = *reinterpret_cast<const bf16x8*>(Ks + (32 + r32) * KROW + cb);
        if (d0 == 0) { p0 = __builtin_amdgcn_mfma_f32_32x32x16_bf16(b0, qr[0], negm, 0, 0, 0); p1 = __builtin_amdgcn_mfma_f32_32x32x16_bf16(b1, qr[0], negm, 0, 0, 0); }
        else { p0 = __builtin_amdgcn_mfma_f32_32x32x16_bf16(b0, qr[d0], p0, 0, 0, 0); p1 = __builtin_amdgcn_mfma_f32_32x32x16_bf16(b1, qr[d0], p1, 0, 0, 0); } }
}

template <int MODE>
__device__ __forceinline__ void attn_unit(const bf16_t* __restrict__ Qa, int ldqa, const bf16_t* __restrict__ Qb, int ldqb,
                                          const bf16_t* __restrict__ Ka, int ldka, const bf16_t* __restrict__ Kb, int ldkb, const bf16_t* __restrict__ Vv, int ldv,
                                          bf16_t* __restrict__ O, int NT, int krow0, int ntreal, int qrow0, const float* __restrict__ rpbh, char* lds) {
    constexpr int ND0 = MODE == 0 ? 6 : 4, KROW = MODE == 0 ? KROW_MLA : KROW_NA;
    const int tid = threadIdx.x, wid = __builtin_amdgcn_readfirstlane(tid >> 6), lane = tid & 63, r32 = lane & 31, hi = lane >> 5;
    char* V_lds = lds + OFF_V; char* K_lds = lds + OFF_K;
    float* ws = (float*)(lds + OFF_WS) + wid * 64; float* li_l = ws; float* al_l = ws + 32;
    float* biasL = (float*)(lds + OFF_BIAS);
    float m_ref = 0.f, l_reg = 0; f32x16 o[2] = {}; f32x16 negm = {}; bool fresh = true; bf16x8 qr[ND0];
    {   const bf16_t* Qw = Qa + (size_t)(wid * QBLK + r32) * ldqa + hi * 8;
#pragma unroll
        for (int d0 = 0; d0 < 4; ++d0) qr[d0] = *reinterpret_cast<const bf16x8*>(Qw + d0 * 16);
        if constexpr (MODE == 0) { const bf16_t* Qw2 = Qb + (size_t)(wid * QBLK + r32) * ldqb + hi * 8;
#pragma unroll
            for (int d0 = 0; d0 < 2; ++d0) qr[4 + d0] = *reinterpret_cast<const bf16x8*>(Qw2 + d0 * 16); } }
    int qgr = 0, rs0 = 0, qc = 0, cs = 0;
    if constexpr (MODE == 1) {
        qgr = qrow0 + (wid >> 1); rs0 = min(max(qgr - 4, 0), 120); qc = 32 * (wid & 1) + r32; cs = min(max(qc - 8, 0), 48);
        for (int i = tid; i < 15 * 31; i += 512) biasL[i] = rpbh[i] * LOG2E;
    }
    const int sr = tid >> 3, sc = (tid & 7) * 8;
    const int sr2 = (tid & 255) >> 2, sc2 = (tid & 3) * 8;
    const int vst = v_st(sr, sc);
    const int vb0 = (int)(uintptr_t)V_lds + v_rd_base(lane);
    struct { bf16x8 v, k, k2; } sr_[1];
#define KROWOF(t) (MODE == 1 ? min(krow0 + (t), 127) * 64 : (t) * 64)
#define SLOAD(i, t) do { const long k0_ = KROWOF(t); sr_[i].v = *reinterpret_cast<const bf16x8*>(&Vv[(k0_ + sr) * ldv + sc]); sr_[i].k = *reinterpret_cast<const bf16x8*>(&Ka[(k0_ + sr) * ldka + sc]); \
        if constexpr (MODE == 0) sr_[i].k2 = *reinterpret_cast<const bf16x8*>(&Kb[(k0_ + sr2) * ldkb + sc2]); } while (0)
#define SWRITE(b, i) do { *(bf16x8*)(V_lds + (b) * SHM_V + vst) = sr_[i].v; *(bf16x8*)(K_lds + (b) * SHM_K + sr * KROW + sc * 2) = sr_[i].k; \
        if constexpr (MODE == 0) { if (tid < 256) *(bf16x8*)(K_lds + (b) * SHM_K + sr2 * KROW + 128 + sc2 * 2) = sr_[i].k2; } } while (0)
#define SWAIT() do { if constexpr (MODE == 0) asm volatile("s_waitcnt vmcnt(3)" ::: "memory"); else asm volatile("s_waitcnt vmcnt(2)" ::: "memory"); } while (0)
#define RESC(a) do { if (__any((a) < 1.f)) { if (hi == 0) al_l[r32] = (a); asm volatile("s_waitcnt lgkmcnt(0)" ::: "memory"); \
        _Pragma("unroll") for (int d = 0; d < 2; ++d) _Pragma("unroll") for (int r = 0; r < 16; ++r) o[d][r] *= al_l[crow(r, hi)]; } } while (0)
#define TVALID(t) (MODE == 0 ? true : ((t) < ntreal && (krow0 + (t)) >= rs0 && (krow0 + (t)) < rs0 + 8))
#define MASKB(P0, P1, t) do { if constexpr (MODE == 1) { const int dr_ = krow0 + (t) - qgr + 7; int d_ = 4 * hi - cs; asm volatile("" : "+v"(d_)); \
        const LAS float* bl_ = (const LAS float*)((LAS char*)lds + OFF_BIAS) + (dr_ * 31 + 15 - qc + 4 * hi); \
        _Pragma("unroll") for (int r = 0; r < 16; ++r) { const int c0_ = (r & 3) + 8 * (r >> 2); \
            const bool in0 = (unsigned)(c0_ + d_) < 16u, in1 = (unsigned)(c0_ + 32 + d_) < 16u; \
            const float b0_ = bl_[c0_], b1_ = bl_[c0_ + 32]; \
            P0[r] = in0 ? P0[r] + b0_ : -1e30f; P1[r] = in1 ? P1[r] + b1_ : -1e30f; } } } while (0)
    f32x16 pA0, pA1, pB0, pB1; float alA = 1.f, alB = 1.f; bf16x8 pa0, pa1, pa2, pa3;
    SLOAD(0, 0); asm volatile("s_waitcnt vmcnt(0)" ::: "memory"); SWRITE(0, 0); SLOAD(0, 1); asm volatile("s_waitcnt vmcnt(0)" ::: "memory"); SWRITE(1, 0);
    if (NT > 2) SLOAD(0, 2);
    __syncthreads();
    const int NI = NT >> 1;
    for (int it = 0; it < NI; ++it) {
        const int kb = (it & 1) * 2, nb = 2 - kb; const bool more = it + 1 < NI;
        if (more) { SWRITE(nb, 0); SLOAD(0, 2 * it + 3); }
        const int ta = 2 * it, tb = ta + 1;
        const bool vA = TVALID(ta), vB = TVALID(tb);
        if (vA) { qkt<ND0, KROW>(pA0, pA1, K_lds + kb * SHM_K, qr, negm, r32, hi); MASKB(pA0, pA1, ta); partialSM(pA0, pA1, m_ref, negm, alA, fresh); RESC(alA); }
        SBAR();
        if (vB) { qkt<ND0, KROW>(pB0, pB1, K_lds + (kb + 1) * SHM_K, qr, negm, r32, hi); MASKB(pB0, pB1, tb); }
        if (vA) { finishSM(pA0, pA1, alA, l_reg, pa0, pa1, pa2, pa3); SBAR(); pv_d0(o, vb0 + kb * SHM_V, pa0, pa1, pa2, pa3); }
        if (more) { SWRITE(nb + 1, 0); if (it + 2 < NI) SLOAD(0, 2 * it + 4); }
        if (vB) { partialSM(pB0, pB1, m_ref, negm, alB, fresh); RESC(alB); finishSM(pB0, pB1, alB, l_reg, pa0, pa1, pa2, pa3); SBAR(); pv_d0(o, vb0 + (kb + 1) * SHM_V, pa0, pa1, pa2, pa3); }
        __syncthreads();
    }
    asm volatile("s_waitcnt vmcnt(0)" ::: "memory");
    if (hi == 0) li_l[r32] = l_reg; asm volatile("s_waitcnt lgkmcnt(0)" ::: "memory");
    float rli[16];
#pragma unroll
    for (int r = 0; r < 16; ++r) rli[r] = __builtin_amdgcn_rcpf(li_l[crow(r, hi)]);
    {   bf16_t* stg = (bf16_t*)(lds + OFF_OST) + wid * 2048;
#pragma unroll
        for (int r = 0; r < 16; ++r) { const int orow = crow(r, hi);
#pragma unroll
            for (int d0 = 0; d0 < 2; ++d0) stg[orow * 64 + d0 * 32 + r32] = (bf16_t)(cvt_pk_bf16(o[d0][r] * rli[r], 0.f) & 0xffffu); }
        asm volatile("s_waitcnt lgkmcnt(0)" ::: "memory");
        bf16_t* Ow = O + (size_t)(wid * QBLK) * 512;
#pragma unroll
        for (int i = 0; i < 4; ++i) { const int row = i * 8 + (lane >> 3), ch = lane & 7; const u32x4 v = *(const u32x4*)(stg + row * 64 + ch * 8); *(u32x4*)(Ow + (size_t)row * 512 + ch * 8) = v; } }
    __syncthreads();
#undef KROWOF
#undef SLOAD
#undef SWRITE
#undef SWAIT
#undef RESC
#undef TVALID
#undef MASKB
}
#undef SBAR
}

constexpr size_t MiB = 1u << 20;
constexpr size_t WS_CTL = 0, CTL_ZERO_BYTES = 1 * MiB;
constexpr size_t WS_WIN = 2 * MiB;
constexpr size_t WS_WUQ = 11 * MiB;
constexpr size_t WS_WUKV = 12 * MiB;
constexpr size_t WS_WNA = 13 * MiB, WS_WMLA = 14 * MiB;
constexpr size_t WS_WOUT = 15 * MiB;
constexpr size_t WS_W1 = 18 * MiB;
constexpr size_t WS_W2 = 146 * MiB;
constexpr size_t WS_XN = 210 * MiB;
constexpr size_t WS_PROJ = 242 * MiB;
constexpr size_t WS_QN = 378 * MiB, WS_QR = 394 * MiB, WS_KN = 402 * MiB, WS_KR = 418 * MiB, WS_VM = 419 * MiB;
constexpr size_t WS_ONA = 435 * MiB, WS_OMLA = 451 * MiB;
constexpr size_t WS_MERGED = 467 * MiB;
constexpr size_t WS_TMP = 499 * MiB;
constexpr size_t WS_LIST = 563 * MiB;
constexpr size_t WS_TOKPOS = 565 * MiB, WS_TOKG = 566 * MiB;
constexpr size_t WS_ACT = 568 * MiB;
constexpr size_t WS_YIT = 712 * MiB;
constexpr size_t WS_SSQ = 856 * MiB;
constexpr size_t WS_MODP = 857 * MiB;
constexpr size_t WS_WRT = 858 * MiB;
constexpr size_t WS_END = 859 * MiB;
constexpr int CW_BAR = 4096;
constexpr int CW_CNT = 8192;
constexpr int CW_MOD = 16384;
constexpr int CW_ROPE = 32768;
static_assert((CW_ROPE + 2048) * 4 <= (int)CTL_ZERO_BYTES, "CTL");

constexpr int RING_BYTES = 131072;
constexpr int TAB_OFF = RING_BYTES;
constexpr int TAB_BLK = TAB_OFF, TAB_GATH = TAB_OFF + 2048;
constexpr int MISC_OFF = TAB_GATH + 11 * 1024;
constexpr int LDS_BYTES = 147456;
static_assert(MISC_OFF + 256 <= LDS_BYTES, "LDS map");

#define RLX_AGENT __ATOMIC_RELAXED, __HIP_MEMORY_SCOPE_AGENT
#define LDS_WAIT() asm volatile("s_waitcnt lgkmcnt(0)" ::: "memory")

#define XB_TMO      128
#define XB_XCNT(j)  (256  + 64 * (j))
#define XB_XSUB(j)  (1280 + 64 * (j))
#define XB_XGEN(j)  (2304 + 64 * (j))
#define XB_TOP      3328
#define XB_TOPGEN   3392
#define XCD_BAR_WORDS 3456
#define XB_SPIN_CAP (1u << 22)
__device__ __forceinline__ unsigned xb_ld(unsigned* p)              { return __hip_atomic_load(p, __ATOMIC_RELAXED, __HIP_MEMORY_SCOPE_AGENT); }
__device__ __forceinline__ unsigned xb_add(unsigned* p, unsigned v) { return __hip_atomic_fetch_add(p, v, __ATOMIC_RELAXED, __HIP_MEMORY_SCOPE_AGENT); }
__device__ __forceinline__ unsigned xb_xcc_id() { return (unsigned)__builtin_amdgcn_s_getreg((3 << 11) | 20) & 0xFu; }
#define XB_SPIN(cond, bar) do { unsigned _sp = 0; while (cond) { __builtin_amdgcn_s_sleep(1); \
    if ((++_sp & 255u) == 0u) { if (xb_ld(&(bar)[XB_TMO])) break; if (_sp > XB_SPIN_CAP) { atomicAdd(&(bar)[XB_TMO], 1u); break; } } } } while (0)
struct XcdBarrier { unsigned* bar; unsigned x; volatile LAS unsigned* st; };
__device__ __forceinline__ XcdBarrier xcd_barrier_post(unsigned* bar, volatile LAS unsigned* st) {
    XcdBarrier b; b.bar = bar; b.x = xb_xcc_id(); b.st = st;
    if (threadIdx.x == 0) (void)xb_add(&bar[XB_XCNT(b.x)], 1u);
    return b;
}
__device__ __forceinline__ void xcd_barrier_complete(unsigned* bar, unsigned x, unsigned& nloc, unsigned& nx) {
    const unsigned G = gridDim.x * gridDim.y * gridDim.z;
    unsigned sum, cnt, mine, sp = 0u;
    for (;;) {
        sum = 0u; cnt = 0u; mine = 0u;
#pragma unroll
        for (unsigned j = 0; j < 16; ++j) { const unsigned c = xb_ld(&bar[XB_XCNT(j)]); sum += c; cnt += (c > 0u) ? 1u : 0u; mine = (j == x) ? c : mine; }
        if (sum == G) break;
        __builtin_amdgcn_s_sleep(1);
        if ((++sp & 255u) == 0u) { if (xb_ld(&bar[XB_TMO])) break; if (sp > XB_SPIN_CAP) { atomicAdd(&bar[XB_TMO], 1u); break; } }
    }
    nloc = mine > 0u ? mine : 1u; nx = cnt > 0u ? cnt : 1u;
}
__device__ __forceinline__ void xcd_barrier(const XcdBarrier& b) {
    asm volatile("s_waitcnt vmcnt(0)" ::: "memory");
    __syncthreads();
    if (threadIdx.x == 0) {
        unsigned* bar = b.bar;
        __builtin_amdgcn_s_waitcnt(0);
        unsigned nloc = b.st[0], nx = b.st[1];
        if (nloc == 0u) { xcd_barrier_complete(bar, b.x, nloc, nx); b.st[0] = nloc; b.st[1] = nx; }
        const unsigned old = xb_add(&bar[XB_XSUB(b.x)], 1u);
        const unsigned gen = old / nloc;
        if (old + 1u == (gen + 1u) * nloc) {
            __builtin_amdgcn_fence(__ATOMIC_RELEASE, "agent");
            asm volatile("s_waitcnt vmcnt(0)" ::: "memory");
            const unsigned og = xb_add(&bar[XB_TOP], 1u);
            const unsigned tg = og / nx;
            if (og + 1u == (tg + 1u) * nx) xb_add(&bar[XB_TOPGEN], 1u);
            else XB_SPIN(xb_ld(&bar[XB_TOPGEN]) == tg, bar);
            __builtin_amdgcn_fence(__ATOMIC_ACQUIRE, "agent");
            xb_add(&bar[XB_XGEN(b.x)], 1u);
            asm volatile("s_waitcnt vmcnt(0)" ::: "memory");
        } else {
            XB_SPIN(xb_ld(&bar[XB_XGEN(b.x)]) == gen, bar);
            __builtin_amdgcn_fence(__ATOMIC_ACQUIRE, "agent");
            asm volatile("s_waitcnt vmcnt(0)" ::: "memory");
        }
    }
    __syncthreads();
}

constexpr int NWAVES = 8;
struct Args { const float* in[24]; float* out; unsigned char* ws; int ph_lo, ph_hi; };
enum { I_X = 0, I_C, I_WADA, I_BADA, I_GAPRE, I_GAPOST, I_WIN, I_BGATE, I_RPB, I_QNG, I_KVNG, I_WUQ, I_WUKV, I_WNAUP, I_WMLAUP, I_WOUT, I_GFPRE, I_GFPOST, I_WR, I_BR, I_W1, I_B1, I_W2, I_B2 };

__device__ __forceinline__ void tr_store_tile(LAS unsigned char* scr, bf16_t* dst, int K, int n0, int k0, int lane) {
    LDS_WAIT(); asm volatile("" ::: "memory");
#pragma unroll
    for (int j = 0; j < 8; ++j) { const int idx = j * 64 + lane, n = idx >> 3, ch = idx & 7;
        const u32x4 v = *(const LAS u32x4*)(scr + n * 144 + ch * 16);
        *(GAS u32x4*)(dst + (size_t)(n0 + n) * K + k0 + ch * 8) = v; }
    LDS_WAIT(); asm volatile("" ::: "memory");
}
__device__ __forceinline__ void tr_tile_fast(const float* src, int Nsrc, int src0, const float* kscale, bf16_t* dst, int K, int n0, int k0, LAS unsigned char* scr, int lane) {
#pragma unroll
    for (int st = 0; st < 8; ++st) { const int kq = st * 4 + (lane >> 4), c4 = (lane & 15) * 4, k = 2 * kq;
        f32x4 a = *(const GAS f32x4*)(src + (size_t)(k0 + k) * Nsrc + src0 + c4);
        f32x4 b = *(const GAS f32x4*)(src + (size_t)(k0 + k + 1) * Nsrc + src0 + c4);
        if (kscale) { const float s0 = kscale[k0 + k], s1 = kscale[k0 + k + 1]; a = a * s0; b = b * s1; }
#pragma unroll
        for (int i = 0; i < 4; ++i) *(LAS unsigned*)(scr + (c4 + i) * 144 + k * 2) = cvt_pk_bf16(a[i], b[i]); }
    tr_store_tile(scr, dst, K, n0, k0, lane);
}
__device__ __forceinline__ void tr_tile_slow(const float* src, int Nsrc, int srccol  , const float* kscale, bf16_t* dst, int K, int n0, int k0, LAS unsigned char* scr, int lane) {
#pragma unroll 8
    for (int k = 0; k < 64; k += 2) {
        float a = 0.f, b = 0.f;
        if (srccol >= 0) { a = src[(size_t)(k0 + k) * Nsrc + srccol]; b = src[(size_t)(k0 + k + 1) * Nsrc + srccol];
            if (kscale) { a *= kscale[k0 + k]; b *= kscale[k0 + k + 1]; } }
        *(LAS unsigned*)(scr + lane * 144 + k * 2) = cvt_pk_bf16(a, b); }
    tr_store_tile(scr, dst, K, n0, k0, lane);
}
__device__ __forceinline__ void tr_tile_fast8(const float* src, int Nsrc, int src0, unsigned char* dst, int K, int n0, int k0, LAS unsigned char* scr, int lane) {
#pragma unroll
    for (int st = 0; st < 4; ++st) { const int kq = st * 4 + (lane >> 4), c4 = (lane & 15) * 4, k = 4 * kq;
        const f32x4 a = __builtin_nontemporal_load((const f32x4*)(src + (size_t)(k0 + k) * Nsrc + src0 + c4)) * SC_W, b = __builtin_nontemporal_load((const f32x4*)(src + (size_t)(k0 + k + 1) * Nsrc + src0 + c4)) * SC_W;
        const f32x4 c = __builtin_nontemporal_load((const f32x4*)(src + (size_t)(k0 + k + 2) * Nsrc + src0 + c4)) * SC_W, d = __builtin_nontemporal_load((const f32x4*)(src + (size_t)(k0 + k + 3) * Nsrc + src0 + c4)) * SC_W;
#pragma unroll
        for (int i = 0; i < 4; ++i) { int w = __builtin_amdgcn_cvt_pk_fp8_f32(a[i], b[i], 0, false); w = __builtin_amdgcn_cvt_pk_fp8_f32(c[i], d[i], w, true);
            *(LAS int*)(scr + (c4 + i) * 80 + k) = w; } }
    LDS_WAIT(); asm volatile("" ::: "memory");
#pragma unroll
    for (int j = 0; j < 4; ++j) { const int idx = j * 64 + lane, n = idx >> 2, ch = idx & 3;
        const u32x4 v = *(const LAS u32x4*)(scr + n * 80 + ch * 16);
        __builtin_nontemporal_store(v, (u32x4*)(dst + (size_t)(n0 + n) * K + k0 + ch * 16)); }
    LDS_WAIT(); asm volatile("" ::: "memory");
}
__device__ __forceinline__ int rope_orig(int p) { return (p & 16) + 8 * (p & 1) + ((p & 15) >> 1); }

__global__ void __launch_bounds__(NWAVES * 64, 2) fwd_kernel(Args args) {
    extern __shared__ __attribute__((aligned(16))) unsigned char lds[];
    LAS unsigned char* L = (LAS unsigned char*)lds;
    volatile LAS unsigned* MISC = (volatile LAS unsigned*)(L + MISC_OFF);
    const int tid = threadIdx.x, lane = tid & 63, wave = __builtin_amdgcn_readfirstlane(tid >> 6);
    const int G = gridDim.x, bx = blockIdx.x, vcu = (G % 8 == 0) ? (bx % 8) * (G / 8) + bx / 8 : bx;
    unsigned char* ws = args.ws;
    gu32* ctl = (gu32*)(ws + WS_CTL);
    const int lo = args.ph_lo, hi = args.ph_hi;
    for (int u = tid; u < 64; u += NWAVES * 64) MISC[u] = 0u;
    __syncthreads();
    XcdBarrier bar; bar.bar = (unsigned*)(ctl + CW_BAR); bar.x = 0; bar.st = nullptr;
    const bool use_bar = (hi - lo) > 1;
    if (use_bar) bar = xcd_barrier_post((unsigned*)(ctl + CW_BAR), MISC + 8);
#ifndef PHASE_MASK
#define PHASE_MASK 0xFFFF
#endif
#define IN(k) (((PHASE_MASK >> (k)) & 1) && lo <= (k) && (k) < hi)
#ifndef REPMASK
#define REPMASK 0
#endif
#define NREP(k) (1 + ((REPMASK >> (k)) & 1))
#define SEAM(k) do { if (IN(k) && IN((k) + 1)) xcd_barrier(bar); } while (0)
    const int gw = vcu * NWAVES + wave, NGW = G * NWAVES;
    float* ROPE = (float*)(ctl + CW_ROPE);
    float* MODP = (float*)(ws + WS_MODP); float* MOD = (float*)(ws + WS_MODP + 512 * 1024); float* SSQ = (float*)(ws + WS_SSQ); unsigned* CNT = (unsigned*)(ctl + CW_CNT);
    bf16_t* WINT = (bf16_t*)(ws + WS_WIN); bf16_t* WUQT = (bf16_t*)(ws + WS_WUQ); bf16_t* WUKVT = (bf16_t*)(ws + WS_WUKV);
    bf16_t* WNAT = (bf16_t*)(ws + WS_WNA); bf16_t* WMLAT = (bf16_t*)(ws + WS_WMLA); bf16_t* WOUTT = (bf16_t*)(ws + WS_WOUT);
    bf16_t* W1T = (bf16_t*)(ws + WS_W1); bf16_t* W2T = (bf16_t*)(ws + WS_W2);
    bf16_t* XN = (bf16_t*)(ws + WS_XN); bf16_t* PROJ = (bf16_t*)(ws + WS_PROJ);
    bf16_t* QN = (bf16_t*)(ws + WS_QN); bf16_t* QR = (bf16_t*)(ws + WS_QR); bf16_t* KN = (bf16_t*)(ws + WS_KN); bf16_t* KR = (bf16_t*)(ws + WS_KR); bf16_t* VM = (bf16_t*)(ws + WS_VM);
    bf16_t* ONA = (bf16_t*)(ws + WS_ONA); bf16_t* OMLA = (bf16_t*)(ws + WS_OMLA); bf16_t* MERGED = (bf16_t*)(ws + WS_MERGED);
    float* TMP = (float*)(ws + WS_TMP); unsigned* LIST = (unsigned*)(ws + WS_LIST); unsigned* TOKPOS = (unsigned*)(ws + WS_TOKPOS); float* TOKG = (float*)(ws + WS_TOKG);
    bf16_t* ACT = (bf16_t*)(ws + WS_ACT); bf16_t* YIT = (bf16_t*)(ws + WS_YIT);
    const float* X = args.in[I_X]; float* OUT = args.out;

    if (IN(0)) for (int rep_ = 0; rep_ < NREP(0); ++rep_) {
        LAS unsigned char* scr = L + wave * 16384;
        {   const float* c = args.in[I_C]; const float* wada = args.in[I_WADA]; const float* bada = args.in[I_BADA];
            for (int it = gw; it < 96 * 8; it += NGW) { const int nb = it % 96, kc = it / 96, n = nb * 64 + lane;
                float a0 = 0.f, a1 = 0.f;
#pragma unroll 8
                for (int k = 0; k < 128; ++k) { const int kk = kc * 128 + k; const float w = wada[(size_t)kk * 6144 + n];
                    const float c0 = c[kk], c1 = c[1024 + kk]; a0 += (c0 * sigmoidf_(c0)) * w; a1 += (c1 * sigmoidf_(c1)) * w; }
                if (kc == 0) { a0 += bada[n]; a1 += bada[n]; }
                MODP[(kc * 2 + 0) * 6144 + n] = a0; MODP[(kc * 2 + 1) * 6144 + n] = a1; } }
        if (bx == 0) { for (int i = tid; i < 128 * 8; i += NWAVES * 64) { const int pos = i >> 3, j = i & 7; float c, sn; rope_cs((float)pos, j, c, sn); ROPE[pos * 16 + j] = c; ROPE[pos * 16 + 8 + j] = sn; } }
        if (bx == 1 % G) { const float* Wr = args.in[I_WR]; float* WRT = (float*)(ws + WS_WRT); for (int i = tid; i < NEXP * 1024; i += NWAVES * 64) WRT[i] = Wr[(size_t)(i & 1023) * 32 + (i >> 10)]; }
        {   constexpr int I_WIN_ = 16 * 68, I_UQ = 6 * 12, I_UKV = 4 * 16, I_UP = 8 * 16, I_OUT = 16 * 16;
            constexpr int NITEMS = I_WIN_ + I_UQ + I_UKV + 2 * I_UP + I_OUT;
            for (int it = gw; it < NITEMS; it += NGW) {
                int r = it;
                if (r < I_WIN_) { const int kb = r / 68, nb = r % 68;
                    if (nb < 34) tr_tile_fast(args.in[I_WIN], 4256, nb * 64, nullptr, WINT, 1024, nb * 64, kb * 64, scr, lane);
                    else if (nb >= 36) tr_tile_fast(args.in[I_WIN], 4256, 2208 + (nb - 36) * 64, nullptr, WINT, 1024, nb * 64, kb * 64, scr, lane);
                    else { const int n = nb * 64 + lane; const int sc = (n < 2208) ? 2176 + rope_orig(n - 2176) : -1;
                        tr_tile_slow(args.in[I_WIN], 4256, sc, nullptr, WINT, 1024, nb * 64, kb * 64, scr, lane); }
                    continue; } r -= I_WIN_;
                if (r < I_UQ) { const int kb = r / 12, nb = r % 12;
                    if (nb < 8) tr_tile_fast(args.in[I_WUQ], 768, nb * 96, args.in[I_QNG], WUQT, 384, nb * 64, kb * 64, scr, lane);
                    else { const int n = nb * 64 + lane - 512, h = n >> 5, p = n & 31;
                        tr_tile_slow(args.in[I_WUQ], 768, h * 96 + 64 + rope_orig(p), args.in[I_QNG], WUQT, 384, nb * 64, kb * 64, scr, lane); }
                    continue; } r -= I_UQ;
                if (r < I_UKV) { const int kb = r / 16, nb = r % 16;
                    const int s0 = (nb < 8) ? nb * 128 : (nb - 8) * 128 + 64;
                    tr_tile_fast(args.in[I_WUKV], 1024, s0, args.in[I_KVNG], WUKVT, 256, nb * 64, kb * 64, scr, lane); continue; } r -= I_UKV;
                if (r < I_UP) { const int kb = r / 16, nb = r % 16; tr_tile_fast(args.in[I_WNAUP], 1024, nb * 64, nullptr, WNAT, 512, nb * 64, kb * 64, scr, lane); continue; } r -= I_UP;
                if (r < I_UP) { const int kb = r / 16, nb = r % 16; tr_tile_fast(args.in[I_WMLAUP], 1024, nb * 64, nullptr, WMLAT, 512, nb * 64, kb * 64, scr, lane); continue; } r -= I_UP;
                { const int kb = r / 16, nb = r % 16; tr_tile_fast(args.in[I_WOUT], 1024, nb * 64, nullptr, WOUTT, 1024, nb * 64, kb * 64, scr, lane); }
            } }
    }
    SEAM(0);
    if (IN(1)) {
        const float* g = args.in[I_GAPRE];
        LAS float* modl = (LAS float*)L;
        for (int i = tid; i < 4096; i += NWAVES * 64) { const int b = i >> 11, c = i & 2047; float sm = 0.f;
#pragma unroll
            for (int kc = 0; kc < 8; ++kc) sm += MODP[(kc * 2 + b) * 6144 + c];
            modl[i] = sm; }
        for (int idx = bx * (NWAVES * 64) + tid; idx < 2 * 6144; idx += G * NWAVES * 64) { const int b = idx / 6144, n = idx % 6144; float sm = 0.f;
#pragma unroll
            for (int kc = 0; kc < 8; ++kc) sm += MODP[(kc * 2 + b) * 6144 + n];
            MOD[idx] = sm; }
        __syncthreads();
        for (int m = gw; m < MTOK; m += NGW) { const int b = m >> 13;
            const GAS f32x4* xr = (const GAS f32x4*)(X + (size_t)m * DM) + lane; f32x4 v[4]; float s = 0.f;
#pragma unroll
            for (int j = 0; j < 4; ++j) { v[j] = xr[64 * j]; s += (v[j].x * v[j].x + v[j].y * v[j].y) + (v[j].z * v[j].z + v[j].w * v[j].w); }
            const float rstd = __builtin_amdgcn_rsqf(wave_sum(s) * (1.f / DM) + RMS_EPS);
            GAS u32x2* o8 = (GAS u32x2*)(XN + (size_t)m * DM) + lane;
#pragma unroll
            for (int j = 0; j < 4; ++j) { const int col = 4 * lane + 256 * j;
                const f32x4 gg = *(const f32x4*)(g + col), sh = *(const LAS f32x4*)(modl + b * 2048 + col), scl = *(const LAS f32x4*)(modl + b * 2048 + 1024 + col);
                const f32x4 h = v[j] * rstd * gg * (scl + 1.f) + sh; u32x2 w; w.x = cvt_pk_bf16(h[0], h[1]); w.y = cvt_pk_bf16(h[2], h[3]); o8[64 * j] = w; } }
    }
    SEAM(1);
    if (IN(2)) for (int rep_ = 0; rep_ < NREP(2); ++rep_) {
        if (bx < NG_INPROJ || G < 256) {
            const int ng = G < 256 ? G : NG_INPROJ;
            pg8::SchedDense S{(const char*)XN, (const char*)WINT, (size_t)256 * 1024 * 2, (size_t)256 * 1024 * 2, MTOK / 256, NPROJ / 256, ng, bx};
            pg8::EpiInProj E{PROJ, SSQ, KR, ROPE, args.in[I_BGATE]};
            pg8::gemm_phase<pg8::EpiInProj, pg8::SchedDense, true, false, false>(L, 16, 2048, 2048, S, E);
        }
        {   LAS unsigned char* scr = L + wave * 16384;
            constexpr int I_W1_ = NEXP * 16 * 32, I_W2_ = NEXP * 16 * 16, NCHUNK = (I_W1_ + I_W2_) / 32;
            for (;;) {
                if (tid == 0) MISC[20] = atomicAdd(CNT + 64, 1u);
                __syncthreads();
                const int chunk = (int)MISC[20];
                __syncthreads();
                if (chunk >= NCHUNK) break;
#pragma unroll 1
                for (int k = 0; k < 4; ++k) { int r = chunk * 32 + wave * 4 + k;
                    if (r < I_W1_) { const int e = r / 512, q = r % 512, kb = q / 32, nb = q % 32;
                        tr_tile_fast8(args.in[I_W1] + (size_t)e * 1024 * 2048, 2048, nb * 64, (unsigned char*)W1T + (size_t)e * 2048 * 1024, 1024, nb * 64, kb * 64, scr, lane); }
                    else { r -= I_W1_; const int e = r / 256, q = r % 256, kb = q / 16, nb = q % 16;
                        tr_tile_fast8(args.in[I_W2] + (size_t)e * 1024 * 1024, 1024, nb * 64, (unsigned char*)W2T + (size_t)e * 1024 * 1024, 1024, nb * 64, kb * 64, scr, lane); } }
            } }
    }
    SEAM(2);
    if (IN(3)) for (int rep_ = 0; rep_ < NREP(3); ++rep_) {
#ifndef NO_QUP
        {   pg8::SchedDense S{(const char*)(PROJ + 1536), (const char*)WUQT, (size_t)256 * NPROJ * 2, (size_t)256 * 384 * 2, MTOK / 256, 3, G, bx};
            pg8::EpiQUp E{QN, QR, SSQ, ROPE};
            pg8::gemm_phase<pg8::EpiQUp, pg8::SchedDense, true, false, false>(L, 6, NPROJ * 2, 768, S, E); }
#endif
#ifndef NO_KVUP
        {   pg8::SchedDense S{(const char*)(PROJ + 1920), (const char*)WUKVT, (size_t)256 * NPROJ * 2, (size_t)256 * 256 * 2, MTOK / 256, 4, G, G - 1 - bx};
            pg8::EpiKVUp E{KN, VM, SSQ};
            pg8::gemm_phase<pg8::EpiKVUp, pg8::SchedDense, true, false, false>(L, 4, NPROJ * 2, 512, S, E); }
#endif
    }
    SEAM(3);
    if (IN(4)) for (int rep_ = 0; rep_ < NREP(4); ++rep_) {
#ifndef NO_MLA
        for (int u = vcu; u < 512; u += G) {
            const int bh = u >> 5, qb = u & 31, b = bh >> 3, h = bh & 7; const size_t row0 = (size_t)b * SEQ + qb * 256, key0 = (size_t)b * SEQ;
            attn::attn_unit<0>(QN + row0 * 512 + h * 64, 512, QR + row0 * 256 + h * 32, 256, KN + key0 * 512 + h * 64, 512, KR + key0 * 32, 32, VM + key0 * 512 + h * 64, 512,
                               OMLA + row0 * 512 + h * 64, 128, 0, 128, 0, nullptr, (char*)lds);
        }
#endif
#ifndef NO_NA
        for (int u = vcu; u < 512; u += G) {
            const int bh = u >> 5, rb = u & 31, b = bh >> 3, h = bh & 7; const size_t row0 = (size_t)b * SEQ + rb * 256, key0 = (size_t)b * SEQ;
            const int krow0 = min(max(4 * rb - 4, 0), 120), klast = min(max(4 * rb + 3 - 4, 0), 120) + 7, ntreal = klast - krow0 + 1, NT = (ntreal + 1) & ~1;
            attn::attn_unit<1>(PROJ + row0 * NPROJ + h * 64, NPROJ, nullptr, 0, PROJ + key0 * NPROJ + 512 + h * 64, NPROJ, nullptr, 0, PROJ + key0 * NPROJ + 1024 + h * 64, NPROJ,
                               ONA + row0 * 512 + h * 64, NT, krow0, ntreal, 4 * rb, args.in[I_RPB] + h * 15 * 31, (char*)lds);
        }
#endif
    }
    SEAM(4);
    if (IN(5)) for (int rep_ = 0; rep_ < NREP(5); ++rep_) {
        pg8::SchedMerge S{(const char*)ONA, (const char*)OMLA, (const char*)WNAT, (const char*)WMLAT, MTOK / 256, 4, G, bx};
        pg8::EpiMerge E{PROJ, MERGED};
        pg8::gemm_phase<pg8::EpiMerge, pg8::SchedMerge, true, false, false, true>(L, 16, 1024, 1024, S, E);
    }
    SEAM(5);
    if (IN(6)) for (int rep_ = 0; rep_ < NREP(6); ++rep_) {
        pg8::SchedDense S{(const char*)MERGED, (const char*)WOUTT, (size_t)256 * 1024 * 2, (size_t)256 * 1024 * 2, MTOK / 256, 4, G, bx};
        pg8::EpiBf16Y E{(bf16_t*)TMP};
        pg8::gemm_phase<pg8::EpiBf16Y, pg8::SchedDense, true, false, false>(L, 16, 2048, 2048, S, E);
    }
    SEAM(6);
    if (IN(7)) {
        LAS int* sel_e = (LAS int*)(L + 0); LAS float* sel_g = (LAS float*)(L + 1024); LAS int* sel_r = (LAS int*)(L + 2048);
        LAS int* lcnt = (LAS int*)(L + 3072); LAS int* lbase = (LAS int*)(L + 3072 + 128);
        const float* gpo = args.in[I_GAPOST]; const float* gfp = args.in[I_GFPRE]; const float* br = args.in[I_BR];
        const float* WRT = (const float*)(ws + WS_WRT);
        for (int blk = vcu; blk < MTOK / 64; blk += G) {
            if (tid < 32) lcnt[tid] = 0;
            __syncthreads();
            f32x4 hreg[8][4];
#pragma unroll
            for (int rr = 0; rr < 8; ++rr) { const int m = blk * 64 + wave * 8 + rr, b = m >> 13;
                const GAS u32x2* yr = (const GAS u32x2*)((const bf16_t*)TMP + (size_t)m * DM) + lane; const GAS f32x4* xr = (const GAS f32x4*)(X + (size_t)m * DM) + lane;
                f32x4 y[4], x1[4]; float s = 0.f;
#pragma unroll
                for (int j = 0; j < 4; ++j) { const u32x2 yw = yr[64 * j]; y[j] = (f32x4){bf16_lo(yw.x), bf16_hi(yw.x), bf16_lo(yw.y), bf16_hi(yw.y)}; x1[j] = xr[64 * j]; s += (y[j].x * y[j].x + y[j].y * y[j].y) + (y[j].z * y[j].z + y[j].w * y[j].w); }
                const float rstd = __builtin_amdgcn_rsqf(wave_sum(s) * (1.f / DM) + RMS_EPS); float s2 = 0.f;
#pragma unroll
                for (int j = 0; j < 4; ++j) { const int col = 4 * lane + 256 * j;
                    const f32x4 gg = *(const f32x4*)(gpo + col), ga = *(const f32x4*)(MOD + b * 6144 + 2048 + col);
                    x1[j] = x1[j] + ga * (y[j] * rstd * gg);
                    *((GAS f32x4*)(OUT + (size_t)m * DM) + lane + 64 * j) = x1[j];
                    s2 += (x1[j].x * x1[j].x + x1[j].y * x1[j].y) + (x1[j].z * x1[j].z + x1[j].w * x1[j].w); }
                const float rstd2 = __builtin_amdgcn_rsqf(wave_sum(s2) * (1.f / DM) + RMS_EPS);
                GAS int* o4 = (GAS int*)((unsigned char*)XN + (size_t)m * DM) + lane;
#pragma unroll
                for (int j = 0; j < 4; ++j) { const int col = 4 * lane + 256 * j;
                    const f32x4 gg = *(const f32x4*)(gfp + col), sh = *(const f32x4*)(MOD + b * 6144 + 3072 + col), scl = *(const f32x4*)(MOD + b * 6144 + 4096 + col);
                    const f32x4 h = x1[j] * rstd2 * gg * (scl + 1.f) + sh;
                    int w = __builtin_amdgcn_cvt_pk_fp8_f32(h[0] * SC_H2, h[1] * SC_H2, 0, false); w = __builtin_amdgcn_cvt_pk_fp8_f32(h[2] * SC_H2, h[3] * SC_H2, w, true); o4[64 * j] = w;
                    hreg[rr][j] = h; }
            }
            const bool b5 = (lane & 32) != 0, b4 = (lane & 16) != 0, b3 = (lane & 8) != 0;
            float t0 = -3.0e38f, t1 = -3.0e38f, t2 = -3.0e38f, t3 = -3.0e38f; int i0 = 0, i1 = 0, i2 = 0, i3 = 0;
#pragma unroll 2
            for (int e = 0; e < NEXP; ++e) {
                f32x4 w[4];
#pragma unroll
                for (int j = 0; j < 4; ++j) w[j] = *(const GAS f32x4*)(WRT + e * 1024 + 4 * lane + 256 * j);
                float p[8];
#pragma unroll
                for (int r = 0; r < 8; ++r) { f32x4 a = hreg[r][0] * w[0]; a += hreg[r][1] * w[1]; a += hreg[r][2] * w[2]; a += hreg[r][3] * w[3]; p[r] = (a.x + a.y) + (a.z + a.w); }
                float q[4], u[2];
#pragma unroll
                for (int i = 0; i < 4; ++i) { const float keep = b5 ? p[i + 4] : p[i], send = b5 ? p[i] : p[i + 4]; q[i] = keep + __shfl_xor(send, 32); }
#pragma unroll
                for (int i = 0; i < 2; ++i) { const float keep = b4 ? q[i + 2] : q[i], send = b4 ? q[i] : q[i + 2]; u[i] = keep + __shfl_xor(send, 16); }
                float v = (b3 ? u[1] : u[0]) + __shfl_xor(b3 ? u[0] : u[1], 8);
                v += __shfl_xor(v, 4); v += __shfl_xor(v, 2); v += __shfl_xor(v, 1);
                v += br[e];
                const bool c0 = v > t0, c1 = v > t1, c2 = v > t2, c3 = v > t3;
                t3 = c2 ? t2 : (c3 ? v : t3); i3 = c2 ? i2 : (c3 ? e : i3);
                t2 = c1 ? t1 : (c2 ? v : t2); i2 = c1 ? i1 : (c2 ? e : i2);
                t1 = c0 ? t0 : (c1 ? v : t1); i1 = c0 ? i0 : (c1 ? e : i1);
                t0 = c0 ? v : t0;             i0 = c0 ? e : i0;
            }
            {   const float e1 = __builtin_amdgcn_exp2f((t1 - t0) * LOG2E), e2 = __builtin_amdgcn_exp2f((t2 - t0) * LOG2E), e3 = __builtin_amdgcn_exp2f((t3 - t0) * LOG2E);
                const float inv = 1.f / (1.f + e1 + e2 + e3);
                const int lrow = wave * 8 + (b5 ? 4 : 0) + (b4 ? 2 : 0) + (b3 ? 1 : 0), t = lane & 7;
                if (t < 4) { const int ee = t == 0 ? i0 : t == 1 ? i1 : t == 2 ? i2 : i3;
                    const float gg = (t == 0 ? 1.f : t == 1 ? e1 : t == 2 ? e2 : e3) * inv;
                    const int rk = __hip_atomic_fetch_add(&lcnt[ee], 1, __ATOMIC_RELAXED, __HIP_MEMORY_SCOPE_WORKGROUP);
                    sel_e[lrow * 4 + t] = ee; sel_g[lrow * 4 + t] = gg; sel_r[lrow * 4 + t] = rk; } }
            __syncthreads();
            if (tid < 32) lbase[tid] = (int)atomicAdd(CNT + tid, (unsigned)lcnt[tid]);
            __syncthreads();
            if (tid < 256) { const int ee = sel_e[tid], pos = lbase[ee] + sel_r[tid], tok = blk * 64 + (tid >> 2);
                LIST[(size_t)ee * LISTCAP + pos] = (unsigned)tok; TOKPOS[(size_t)tok * 4 + (tid & 3)] = ((unsigned)ee << 16) | (unsigned)pos; TOKG[(size_t)tok * 4 + (tid & 3)] = sel_g[tid]; }
            __syncthreads();
        }
    }
    SEAM(7);
    if (IN(8) || IN(9)) {
        LAS int* blk_e = (LAS int*)(L + TAB_BLK);
        if (tid == 0) { int nb = 0; for (int e = 0; e < NEXP; ++e) { const int c = (int)__hip_atomic_load(CNT + e, RLX_AGENT); const int n = (c + 255) >> 8; for (int i = 0; i < n; ++i) blk_e[nb + i] = e; nb += n; } MISC[16] = (unsigned)nb; }
        __syncthreads();
        const int NB = (int)MISC[16];
        if (IN(8)) for (int rep_ = 0; rep_ < NREP(8); ++rep_) {
            for (int i = 0;; ++i) { const long Lu = (long)i * G + bx; if (Lu >= (long)NB * 8 || i >= 11) break;
                const int grb = (int)(Lu >> 3), e = blk_e[grb]; int first = grb; while (first > 0 && blk_e[first - 1] == e) --first;
                const int cnt = (int)__hip_atomic_load(CNT + e, RLX_AGENT);
                if (tid < 256) { const int ri = (grb - first) * 256 + tid; const unsigned tok = (ri < cnt) ? LIST[(size_t)e * LISTCAP + ri] : 0u;
                    *(LAS unsigned*)(L + TAB_GATH + i * 1024 + tid * 4) = tok * 1024u; } }
            __syncthreads();
            pg8::SchedMoe<8, true> S{(const char*)XN, (const char*)W1T, (size_t)2048 * 1024, blk_e, NB, G, bx, TAB_GATH};
            pg8::EpiMoe1 E{args.in[I_B1], (unsigned char*)ACT};
            pg8::gemm_phase<pg8::EpiMoe1, pg8::SchedMoe<8, true>, true, true, true>(L, 8, 1024, 1024, S, E);
        }
        SEAM(8);
        if (IN(9)) for (int rep_ = 0; rep_ < NREP(9); ++rep_) {
            pg8::SchedMoe<4, false> S{(const char*)ACT, (const char*)W2T, (size_t)1024 * 1024, blk_e, NB, G, bx, 0};
            pg8::EpiMoe2 E{args.in[I_B2], YIT};
            pg8::gemm_phase<pg8::EpiMoe2, pg8::SchedMoe<4, false>, true, false, true>(L, 8, 1024, 1024, S, E);
        }
    }
    SEAM(9);
    if (IN(10)) {
        LAS int* rbase = (LAS int*)(L + 0);
        if (tid == 0) { int nb = 0; for (int e = 0; e < NEXP; ++e) { rbase[e] = nb * 256; nb += ((int)__hip_atomic_load(CNT + e, RLX_AGENT) + 255) >> 8; } }
        __syncthreads();
        const float* gfo = args.in[I_GFPOST];
        for (int m = gw; m < MTOK; m += NGW) { const int b = m >> 13;
            f32x4 y[4];
#pragma unroll
            for (int j = 0; j < 4; ++j) y[j] = (f32x4){0.f, 0.f, 0.f, 0.f};
#pragma unroll
            for (int t = 0; t < 4; ++t) { const unsigned tp = TOKPOS[(size_t)m * 4 + t]; const float gt = TOKG[(size_t)m * 4 + t];
                const size_t row = (size_t)rbase[tp >> 16] + (tp & 0xffffu); const GAS u32x2* yr = (const GAS u32x2*)(YIT + row * 1024) + lane;
#pragma unroll
                for (int j = 0; j < 4; ++j) { const u32x2 w = yr[64 * j]; y[j][0] += gt * bf16_lo(w.x); y[j][1] += gt * bf16_hi(w.x); y[j][2] += gt * bf16_lo(w.y); y[j][3] += gt * bf16_hi(w.y); } }
            float s = 0.f;
#pragma unroll
            for (int j = 0; j < 4; ++j) s += (y[j].x * y[j].x + y[j].y * y[j].y) + (y[j].z * y[j].z + y[j].w * y[j].w);
            const float rstd = __builtin_amdgcn_rsqf(wave_sum(s) * (1.f / DM) + RMS_EPS);
            GAS f32x4* orow = (GAS f32x4*)(OUT + (size_t)m * DM) + lane;
#pragma unroll
            for (int j = 0; j < 4; ++j) { const int col = 4 * lane + 256 * j;
                const f32x4 gg = *(const f32x4*)(gfo + col), gf = *(const f32x4*)(MOD + b * 6144 + 5120 + col);
                orow[64 * j] = orow[64 * j] + gf * (y[j] * rstd * gg); } }
    }
#undef IN
#undef SEAM
}

constexpr int N_PHASES = 11;
extern "C" void kernel_launch(void* const* d_in, const int* in_sizes, int n_in, void* d_out, int out_size, void* d_ws, size_t ws_size, hipStream_t stream) {
    static int grid = 0;
    if (grid == 0) {
        if (n_in != 24 || out_size != MTOK * DM || ws_size < WS_END) { fprintf(stderr, "kernel_launch: unexpected shapes (n_in %d out %d ws %zu)\n", n_in, out_size, ws_size); grid = -1; return; }
        int dev = 0, cus = 0, per_cu = 0;
        if (hipGetDevice(&dev) != hipSuccess || hipDeviceGetAttribute(&cus, hipDeviceAttributeMultiprocessorCount, dev) != hipSuccess) { grid = -1; return; }
        if (hipFuncSetAttribute((const void*)fwd_kernel, hipFuncAttributeMaxDynamicSharedMemorySize, LDS_BYTES) != hipSuccess) { fprintf(stderr, "kernel_launch: hipFuncSetAttribute failed\n"); grid = -1; return; }
        if (hipOccupancyMaxActiveBlocksPerMultiprocessor(&per_cu, (const void*)fwd_kernel, NWAVES * 64, LDS_BYTES) != hipSuccess || per_cu < 1) { fprintf(stderr, "kernel_launch: occupancy query says %d\n", per_cu); per_cu = 1; }
        (void)hipGetLastError();
        grid = cus;
    }
    if (grid < 0) return;
    (void)hipMemsetAsync((char*)d_ws + WS_CTL, 0, CTL_ZERO_BYTES, stream);
    Args a{};
    for (int i = 0; i < 24; ++i) a.in[i] = (const float*)d_in[i];
    a.out = (float*)d_out; a.ws = (unsigned char*)d_ws;
#if MK_N_LAUNCHES == 1
    a.ph_lo = 0; a.ph_hi = N_PHASES;
    {   void* kargs[] = {(void*)&a};
        const hipError_t ce = hipLaunchCooperativeKernel((const void*)fwd_kernel, dim3(grid), dim3(NWAVES * 64), kargs, LDS_BYTES, stream);
        if (ce != hipSuccess) fprintf(stderr, "kernel_launch: cooperative launch failed: %s (grid %d)\n", hipGetErrorName(ce), grid); }
#else
    for (int p = 0; p < N_PHASES; ++p) { a.ph_lo = p; a.ph_hi = p + 1; hipLaunchKernelGGL(fwd_kernel, dim3(grid), dim3(NWAVES * 64), LDS_BYTES, stream, a); }
#endif
    const hipError_t le = hipPeekAtLastError();
    if (le != hipSuccess) fprintf(stderr, "kernel_launch: launch failed: %s\n", hipGetErrorName(le));
}
```

```cpp
#include <hip/hip_runtime.h>
#include <hip/hip_bf16.h>
#include <cstdio>
#include <cstdint>

#ifndef MK_N_LAUNCHES
#define MK_N_LAUNCHES 1
#endif

constexpr int BATCH = 2, SEQ = 8192, DM = 1024, MTOK = BATCH * SEQ;
constexpr int NPROJ = 4352;
constexpr int NEXP = 32, DFF = 1024, TOPK = 4;
constexpr int QLORA = 384, KVLORA = 256;
constexpr float RMS_EPS = 1e-6f;
constexpr float LOG2E = 1.4426950408889634f;
constexpr float C2NA = 0.125f * LOG2E;
constexpr float C2MLA = 0.10206207261596575f * LOG2E;
constexpr float SC_H2 = 8.f, SC_W = 64.f, SC_ACT = 4.f;
constexpr int NG_INPROJ = 218;
constexpr int LISTCAP = 16384;
constexpr int MAXROWS = 65536 + NEXP * 256;

#define GAS __attribute__((address_space(1)))
#define LAS __attribute__((address_space(3)))
typedef unsigned short bf16_t;
typedef short bf16x8 __attribute__((ext_vector_type(8)));
typedef short s16x4 __attribute__((ext_vector_type(4)));
typedef float f32x4 __attribute__((ext_vector_type(4)));
typedef float f32x2 __attribute__((ext_vector_type(2)));
typedef float f32x16 __attribute__((ext_vector_type(16)));
typedef unsigned u32x4 __attribute__((ext_vector_type(4)));
typedef unsigned u32x2 __attribute__((ext_vector_type(2)));
typedef GAS unsigned gu32;

__device__ __forceinline__ unsigned cvt_pk_bf16(float lo, float hi) { unsigned r; asm volatile("v_cvt_pk_bf16_f32 %0, %1, %2" : "=v"(r) : "v"(lo), "v"(hi)); return r; }
__device__ __forceinline__ float bf16_lo(unsigned w) { return __uint_as_float(w << 16); }
__device__ __forceinline__ float bf16_hi(unsigned w) { return __uint_as_float(w & 0xffff0000u); }
__device__ __forceinline__ float sigmoidf_(float z) { return __builtin_amdgcn_rcpf(1.f + __builtin_amdgcn_exp2f(-z * LOG2E)); }
__device__ __forceinline__ float wave_sum(float v) {
#pragma unroll
    for (int o = 1; o < 64; o <<= 1) v += __shfl_xor(v, o);
    return v;
}
__device__ __forceinline__ void rope_cs(float pos, int j, float& c, float& s) {
    const float inv = __builtin_amdgcn_exp2f(-(float)j * 0.83048202372184059f);
    const float rev = __builtin_amdgcn_fractf(pos * inv * 0.15915494309189535f);
    c = __builtin_amdgcn_cosf(rev); s = __builtin_amdgcn_sinf(rev);
}

namespace pg8 {
constexpr int BM = 256, BK = 64, HALF = 128, HTB = HALF * BK * 2, STAGE_BYTES = 8 * HTB, NXCD = 8, WGM = 8;
__host__ __device__ __forceinline__ int lds_byte(int r, int c) { const int st = (r >> 4) * 2 + (c >> 5), rr = r & 15, cc = c & 31, ob = rr * 64 + cc * 2; return st * 1024 + (ob ^ (((ob >> 9) & 1) << 5)); }
__host__ __device__ __forceinline__ void stage_rc(int b, int& R, int& C) { const int st = b / 1024, sb = b % 1024, swz = sb ^ (((sb >> 9) & 1) << 5); R = (st >> 1) * 16 + swz / 64; C = (st & 1) * 32 + (swz % 64) / 2; }
__host__ __device__ __forceinline__ int perm32(int rho) { const int n = rho >> 4, i = rho & 15; return 8 * (i >> 2) + 4 * n + (i & 3); }

struct Unit { const char* A; const char* B; const char* A2; const char* B2; int pm, pn, aux, tab; };

__device__ __forceinline__ void tile_of(int wgid, int nM, int nN, int& pm, int& pn) {
    const int nwg = nM * nN;
    { const int q = nwg / NXCD, r = nwg % NXCD, xcd = wgid % NXCD, off = wgid / NXCD; wgid = (xcd < r ? xcd * (q + 1) : r * (q + 1) + (xcd - r) * q) + off; }
    const int nig = WGM * nN, gid = wgid / nig, fm = gid * WGM, gsz = (nM - fm) < WGM ? (nM - fm) : WGM;
    pm = fm + ((wgid % nig) % gsz); pn = (wgid % nig) / gsz;
}

typedef int v8i32 __attribute__((ext_vector_type(8)));
typedef int v4i32_ __attribute__((ext_vector_type(4)));
template <class Epi, class Sched, bool ALIGN_EPI, bool GATHER, bool FP8, bool DUAL = false>
__device__ __forceinline__ void gemm_phase(LAS unsigned char* lds, const int nt, const int ldab, const int ldbb, const Sched& S, const Epi& E) {
    const int tid = threadIdx.x, wid = __builtin_amdgcn_readfirstlane(tid >> 6), lane = tid & 63, wr = wid >> 2, wc = wid & 3, fr = lane & 15, fq = lane >> 4;
    int Rr[2], Cc[2];
    unsigned voffA[2], voffB[2];
#pragma unroll
    for (int i = 0; i < 2; ++i) { int R, C; stage_rc(tid * 16 + i * 8192, R, C); const int Rb = Epi::PERM ? ((R & ~31) + perm32(R & 31)) : R;
        Rr[i] = R; Cc[i] = C; voffA[i] = (unsigned)(R * ldab + C * 2); voffB[i] = (unsigned)(Rb * ldbb + C * 2); }
    const size_t kstep = (size_t)(BK * 2);
    const size_t hstepA = (size_t)HALF * ldab, hstepB = (size_t)HALF * ldbb;
    const unsigned ldsw = (unsigned)wid * 1024u;
    const int aoff = lds_byte(wr * 64 + fr, fq * 8), boff = lds_byte(wc * 32 + fr, fq * 8);
#define PG8_SA(b, h) (((b) * 2 + (h)) * HTB)
#define PG8_SB(b, h) ((4 + (b) * 2 + (h)) * HTB)
#define PG8_STAGE(bufoff, gbase, voff) do { _Pragma("unroll") for (int _i = 0; _i < 2; ++_i) \
        __builtin_amdgcn_global_load_lds((const unsigned*)((const char*)(gbase) + (voff)[_i]), (LAS unsigned*)(lds + (bufoff) + ldsw + _i * 8192), 16, 0, 0); } while (0)
#define PG8_STAGE_A(bufoff, gbase, h, G) do { if constexpr (GATHER) { PG8_STAGE(bufoff, gbase, (G)[h]); } else { PG8_STAGE(bufoff, (gbase) + (h) * hstepA, voffA); } } while (0)
#define PG8_STAGE_B(bufoff, gbase, h) PG8_STAGE(bufoff, (gbase) + (h) * hstepB, voffB)
#define PG8_LD8(addr) __builtin_shufflevector(*(const LAS v4i32_*)(addr), *(const LAS v4i32_*)((addr) + 1024), 0, 1, 2, 3, 4, 5, 6, 7)
#define PG8_LDA(dst, b, h) do { if constexpr (FP8) { _Pragma("unroll") for (int m = 0; m < 4; ++m) dst##8[m] = PG8_LD8(lds + PG8_SA(b, h) + aoff + m * 2048); } \
        else { _Pragma("unroll") for (int m = 0; m < 4; ++m) _Pragma("unroll") for (int k = 0; k < 2; ++k) dst[m][k] = *(const LAS bf16x8*)(lds + PG8_SA(b, h) + aoff + m * 2048 + k * 1024); } } while (0)
#define PG8_LDB(dst, b, h) do { if constexpr (FP8) { _Pragma("unroll") for (int n = 0; n < 2; ++n) dst##8[n] = PG8_LD8(lds + PG8_SB(b, h) + boff + n * 2048); } \
        else { _Pragma("unroll") for (int n = 0; n < 2; ++n) _Pragma("unroll") for (int k = 0; k < 2; ++k) dst[n][k] = *(const LAS bf16x8*)(lds + PG8_SB(b, h) + boff + n * 2048 + k * 1024); } } while (0)
#define PG8_MMA(ai, bj, At, Bt) do { __builtin_amdgcn_s_setprio(1); _Pragma("unroll") for (int m = 0; m < 4; ++m) _Pragma("unroll") for (int n = 0; n < 2; ++n) { \
        if constexpr (FP8) { asm volatile("v_mfma_scale_f32_16x16x128_f8f6f4 %0, %1, %2, %0, %3, %3 op_sel_hi:[0,0,0]" : "+v"(acc[ai][bj][m][n]) : "v"(Bt##8[n]), "v"(At##8[m]), "v"(sc1_)); } \
        else { _Pragma("unroll") for (int k = 0; k < 2; ++k) acc[ai][bj][m][n] = __builtin_amdgcn_mfma_f32_16x16x32_bf16(Bt[n][k], At[m][k], acc[ai][bj][m][n], 0, 0, 0); } } \
        __builtin_amdgcn_s_setprio(0); } while (0)
#define PG8_WAIT_V(n) asm volatile("s_waitcnt vmcnt(" #n ")" ::: "memory")
#define PG8_WAIT_L(n) asm volatile("s_waitcnt lgkmcnt(" #n ")" ::: "memory")
#define PG8_BAR __builtin_amdgcn_s_barrier()
#define PG8_SCHED __builtin_amdgcn_sched_barrier(0)
    Unit cur, nxt; int ui = 0;
    if (!S.next(0, cur)) return;
    f32x4 acc[2][2][4][2];
#pragma unroll
    for (int a = 0; a < 2; ++a)
#pragma unroll
        for (int b = 0; b < 2; ++b)
#pragma unroll
            for (int m = 0; m < 4; ++m)
#pragma unroll
                for (int n = 0; n < 2; ++n) acc[a][b][m][n] = (f32x4){0.f, 0.f, 0.f, 0.f};
    bf16x8 At[4][2], B0[2][2], B1[2][2]; v8i32 At8[4], B08[2], B18[2];
    int sc1_ = 0x7F7F7F7F; asm volatile("" : "+v"(sc1_));
    unsigned gC[2][2], gN[2][2];
#define PG8_GLOAD(G, u) do { if constexpr (GATHER) { const LAS unsigned* tb_ = (const LAS unsigned*)(lds + (u).tab); _Pragma("unroll") for (int h_ = 0; h_ < 2; ++h_) _Pragma("unroll") for (int i_ = 0; i_ < 2; ++i_) \
        (G)[h_][i_] = tb_[h_ * 128 + Rr[i_]] + (unsigned)(Cc[i_] * 2); } } while (0)
    PG8_GLOAD(gC, cur);
    const char* cA = cur.A; const char* cB = cur.B; const char* cA2 = cur.A2; const char* cB2 = cur.B2; const int nth = nt >> 1;
    PG8_STAGE_B(PG8_SB(0, 0), cB, 0); PG8_STAGE_B(PG8_SB(0, 1), cB, 1); PG8_STAGE_A(PG8_SA(0, 0), cA, 0, gC); PG8_STAGE_A(PG8_SA(0, 1), cA, 1, gC);
    if (wr == 1) PG8_BAR;
    PG8_WAIT_V(2); PG8_BAR;
    PG8_STAGE_B(PG8_SB(1, 0), cB + kstep, 0); PG8_STAGE_A(PG8_SA(1, 0), cA + kstep, 0, gC); PG8_STAGE_B(PG8_SB(1, 1), cB + kstep, 1);
    PG8_WAIT_V(6); PG8_BAR;
    for (;;) {
        const bool has_next = S.next(ui + 1, nxt);
        const char* nA = has_next ? nxt.A : cA; const char* nB = has_next ? nxt.B : cB;
        if constexpr (GATHER) { if (has_next) { PG8_GLOAD(gN, nxt); } else {
#pragma unroll
            for (int h_ = 0; h_ < 2; ++h_)
#pragma unroll
                for (int i_ = 0; i_ < 2; ++i_) gN[h_][i_] = gC[h_][i_]; } }
#pragma unroll 1
        for (int t = 0; t < nt; t += 2) {
            const bool last = (t == nt - 2);
            if constexpr (DUAL) { if (t == nth) E.mid(acc, cur, wr, wc, fr, fq); }
#define PG8_TILEA(tt) (((DUAL && (tt) >= nth) ? cA2 - (size_t)nth * kstep : cA) + (size_t)(tt) * kstep)
#define PG8_TILEB(tt) (((DUAL && (tt) >= nth) ? cB2 - (size_t)nth * kstep : cB) + (size_t)(tt) * kstep)
            const char* a1 = PG8_TILEA(t + 1);
            const char* a2 = last ? nA : PG8_TILEA(t + 2); const char* b2 = last ? nB : PG8_TILEB(t + 2);
            const char* a3 = a2 + kstep; const char* b3 = b2 + kstep;
            unsigned g2[2][2];
            if constexpr (GATHER) {
#pragma unroll
                for (int h_ = 0; h_ < 2; ++h_)
#pragma unroll
                    for (int i_ = 0; i_ < 2; ++i_) g2[h_][i_] = last ? gN[h_][i_] : gC[h_][i_]; }
            PG8_LDB(B0, 0, 0); PG8_LDB(B1, 0, 1); PG8_SCHED; PG8_LDA(At, 0, 0); PG8_STAGE_A(PG8_SA(1, 1), a1, 1, gC);
            PG8_WAIT_V(8); PG8_WAIT_L(0); PG8_BAR; PG8_MMA(0, 0, At, B0); PG8_MMA(0, 1, At, B1); PG8_BAR; PG8_SCHED;
            PG8_LDA(At, 0, 1); PG8_STAGE_B(PG8_SB(0, 0), b2, 0); PG8_STAGE_B(PG8_SB(0, 1), b2, 1); PG8_STAGE_A(PG8_SA(0, 0), a2, 0, g2);
            PG8_WAIT_V(8); PG8_WAIT_L(0); PG8_BAR; PG8_MMA(1, 0, At, B0); PG8_MMA(1, 1, At, B1); PG8_BAR; PG8_SCHED;
            PG8_LDB(B0, 1, 0); PG8_LDB(B1, 1, 1); PG8_SCHED; PG8_LDA(At, 1, 0); PG8_STAGE_A(PG8_SA(0, 1), a2, 1, g2);
            PG8_WAIT_V(8); PG8_WAIT_L(0); PG8_BAR; PG8_MMA(0, 0, At, B0); PG8_MMA(0, 1, At, B1); PG8_BAR; PG8_SCHED;
            PG8_LDA(At, 1, 1); PG8_STAGE_B(PG8_SB(1, 0), b3, 0); PG8_STAGE_B(PG8_SB(1, 1), b3, 1); PG8_STAGE_A(PG8_SA(1, 0), a3, 0, g2);
            PG8_WAIT_V(8); PG8_WAIT_L(0); PG8_BAR; PG8_MMA(1, 0, At, B0); PG8_MMA(1, 1, At, B1); PG8_BAR; PG8_SCHED;
        }
        if constexpr (ALIGN_EPI) { if (wr == 0) PG8_BAR; }
        if constexpr (FP8) asm volatile("s_nop 15\n\ts_nop 15" ::: "memory");
        E(acc, cur, wr, wc, fr, fq);
        if (!has_next) break;
#pragma unroll
        for (int a = 0; a < 2; ++a)
#pragma unroll
            for (int b = 0; b < 2; ++b)
#pragma unroll
                for (int m = 0; m < 4; ++m)
#pragma unroll
                    for (int n = 0; n < 2; ++n) acc[a][b][m][n] = (f32x4){0.f, 0.f, 0.f, 0.f};
        cur = nxt; cA = nA; cB = nB; cA2 = cur.A2; cB2 = cur.B2; ++ui;
        if constexpr (GATHER) {
#pragma unroll
            for (int h_ = 0; h_ < 2; ++h_)
#pragma unroll
                for (int i_ = 0; i_ < 2; ++i_) gC[h_][i_] = gN[h_][i_]; }
        if constexpr (ALIGN_EPI) { if (wr == 1) PG8_BAR; }
    }
    PG8_WAIT_V(0);
    if constexpr (!ALIGN_EPI) { if (wr == 0) PG8_BAR; }
    PG8_BAR;
#undef PG8_SA
#undef PG8_SB
#undef PG8_STAGE
#undef PG8_STAGE_A
#undef PG8_STAGE_B
#undef PG8_LDA
#undef PG8_LD8
#undef PG8_LDB
#undef PG8_MMA
#undef PG8_WAIT_V
#undef PG8_WAIT_L
#undef PG8_BAR
#undef PG8_SCHED
#undef PG8_GLOAD
#undef PG8_TILEA
#undef PG8_TILEB
}

typedef f32x4 Acc[2][2][4][2];

struct SchedDense {
    const char* A; const char* B; size_t a_tile_bytes, b_tile_bytes; int nM, nN, G, c;
    __device__ __forceinline__ bool next(int i, Unit& u) const {
        const long L = (long)i * G + c; if (L >= (long)nM * nN) return false;
        int pm, pn; tile_of((int)L, nM, nN, pm, pn);
        u.pm = pm; u.pn = pn; u.aux = 0; u.tab = 0; u.A = A + (size_t)pm * a_tile_bytes; u.B = B + (size_t)pn * b_tile_bytes; u.A2 = u.A; u.B2 = u.B; return true;
    }
};
struct SchedMerge {
    const char* A0; const char* A1; const char* B0; const char* B1; int nM, nN, G, c;
    __device__ __forceinline__ bool next(int i, Unit& u) const {
        const long T = (long)i * G + c; if (T >= (long)nM * nN) return false;
        int pm, pn; tile_of((int)T, nM, nN, pm, pn);
        u.pm = pm; u.pn = pn; u.aux = 0; u.tab = 0;
        u.A = A0 + (size_t)pm * (256 * 512 * 2); u.B = B0 + (size_t)pn * (256 * 512 * 2); u.A2 = A1 + (size_t)pm * (256 * 512 * 2); u.B2 = B1 + (size_t)pn * (256 * 512 * 2); return true;
    }
};
template <int NPN, bool GATHER>
struct SchedMoe {
    const char* A; const char* B; size_t b_expert_bytes; LAS const int* blk_e; int NB, G, c, tab0;
    __device__ __forceinline__ bool next(int i, Unit& u) const {
        const long L = (long)i * G + c; if (L >= (long)NB * NPN) return false;
        const int grb = (int)(L / NPN), pn = (int)(L % NPN);
        const int e = __builtin_amdgcn_readfirstlane(blk_e[grb]);
        u.pm = grb; u.pn = pn; u.aux = e; u.tab = tab0 + i * 1024;
        u.A = GATHER ? A : A + (size_t)grb * (256 * 1024);
        u.B = B + (size_t)e * b_expert_bytes + (size_t)pn * (256 * 1024); u.A2 = u.A; u.B2 = u.B; return true;
    }
};

struct EpiInProj {
    static constexpr bool PERM = true;
    bf16_t* PROJ; float* SSQ; bf16_t* KR; const float* ROPE; const float* bgate;
    __device__ __forceinline__ void operator()(const Acc& acc, const Unit& u, int wr, int wc, int fr, int fq) const {
        const int pn = u.pn, row0 = u.pm * BM + wr * 64 + fr, colb = pn * BM + wc * 32 + 8 * fq;
        const float sc = (pn < 2) ? C2NA : 1.f;
        f32x4 gb[2][2];
#pragma unroll
        for (int bj = 0; bj < 2; ++bj)
#pragma unroll
            for (int n = 0; n < 2; ++n) gb[bj][n] = (pn >= 9) ? *(const f32x4*)(bgate + (colb - 2304) + bj * HALF + 4 * n) : (f32x4){0.f, 0.f, 0.f, 0.f};
#pragma unroll
        for (int ai = 0; ai < 2; ++ai)
#pragma unroll
            for (int m = 0; m < 4; ++m) { const int row = row0 + ai * HALF + m * 16; bf16_t* rowp = PROJ + (size_t)row * NPROJ + colb;
#pragma unroll
                for (int bj = 0; bj < 2; ++bj) { const f32x4 v0 = acc[ai][bj][m][0] * sc + gb[bj][0], v1 = acc[ai][bj][m][1] * sc + gb[bj][1]; u32x4 w;
                    w.x = cvt_pk_bf16(v0[0], v0[1]); w.y = cvt_pk_bf16(v0[2], v0[3]); w.z = cvt_pk_bf16(v1[0], v1[1]); w.w = cvt_pk_bf16(v1[2], v1[3]);
                    *(u32x4*)(rowp + bj * HALF) = w; } }
        if (pn >= 6 && pn <= 8) {
#pragma unroll
            for (int ai = 0; ai < 2; ++ai)
#pragma unroll
                for (int m = 0; m < 4; ++m) { const int row = row0 + ai * HALF + m * 16; float s[2];
#pragma unroll
                    for (int bj = 0; bj < 2; ++bj) { const f32x4 a = acc[ai][bj][m][0], b = acc[ai][bj][m][1];
                        float t = (a[0] * a[0] + a[1] * a[1]) + (a[2] * a[2] + a[3] * a[3]) + (b[0] * b[0] + b[1] * b[1]) + (b[2] * b[2] + b[3] * b[3]);
                        t += __shfl_xor(t, 16); t += __shfl_xor(t, 32); s[bj] = t; }
                    if (fq == 0) {
                        float* sp = SSQ + (size_t)row * 16 + wc;
                        if (pn == 6) { sp[0] = s[0] + s[1]; }
                        else if (pn == 7) { sp[4] = s[0]; sp[8] = s[1]; }
                        else { sp[12] = s[0]; }
                    } }
            if (pn == 8 && wc == 0) {
#pragma unroll
                for (int ai = 0; ai < 2; ++ai)
#pragma unroll
                    for (int m = 0; m < 4; ++m) { const int row = row0 + ai * HALF + m * 16, tok = row & (SEQ - 1);
                        const int pos = (fq >> 1) ? (tok & 63) : (tok >> 6); float o[8];
                        const f32x4 cs4 = *(const f32x4*)(ROPE + pos * 16 + 4 * (fq & 1)), sn4 = *(const f32x4*)(ROPE + pos * 16 + 8 + 4 * (fq & 1));
#pragma unroll
                        for (int n = 0; n < 2; ++n)
#pragma unroll
                            for (int q = 0; q < 2; ++q) { const float c = cs4[2 * n + q], s = sn4[2 * n + q];
                                const float x1 = acc[ai][1][m][n][2 * q], x2 = acc[ai][1][m][n][2 * q + 1];
                                o[4 * n + 2 * q] = x1 * c - x2 * s; o[4 * n + 2 * q + 1] = x1 * s + x2 * c; }
                        u32x4 w; w.x = cvt_pk_bf16(o[0], o[1]); w.y = cvt_pk_bf16(o[2], o[3]); w.z = cvt_pk_bf16(o[4], o[5]); w.w = cvt_pk_bf16(o[6], o[7]);
                        *(u32x4*)(KR + (size_t)row * 32 + 8 * fq) = w; }
            }
        }
    }
};
struct EpiQUp {
    static constexpr bool PERM = true;
    bf16_t* QN; bf16_t* QR; const float* SSQ; const float* ROPE;
    __device__ __forceinline__ void operator()(const Acc& acc, const Unit& u, int wr, int wc, int fr, int fq) const {
        const int pn = u.pn, row0 = u.pm * BM + wr * 64 + fr, colt = wc * 32 + 8 * fq;
#pragma unroll
        for (int ai = 0; ai < 2; ++ai)
#pragma unroll
            for (int m = 0; m < 4; ++m) { const int row = row0 + ai * HALF + m * 16;
                const f32x4 q0_ = *(const f32x4*)(SSQ + (size_t)row * 16), q1_ = *(const f32x4*)(SSQ + (size_t)row * 16 + 4);
                const float rs = __builtin_amdgcn_rsqf((((q0_[0] + q0_[1]) + (q0_[2] + q0_[3])) + ((q1_[0] + q1_[1]) + (q1_[2] + q1_[3]))) * (1.f / QLORA) + RMS_EPS) * C2MLA;
                if (pn < 2) {
#pragma unroll
                    for (int bj = 0; bj < 2; ++bj) { const f32x4 v0 = acc[ai][bj][m][0] * rs, v1 = acc[ai][bj][m][1] * rs; u32x4 w;
                        w.x = cvt_pk_bf16(v0[0], v0[1]); w.y = cvt_pk_bf16(v0[2], v0[3]); w.z = cvt_pk_bf16(v1[0], v1[1]); w.w = cvt_pk_bf16(v1[2], v1[3]);
                        *(u32x4*)(QN + (size_t)row * 512 + pn * 256 + bj * HALF + colt) = w; }
                } else {
                    const int tok = row & (SEQ - 1); const int pos = (fq >> 1) ? (tok & 63) : (tok >> 6);
                    const f32x4 cs4 = *(const f32x4*)(ROPE + pos * 16 + 4 * (fq & 1)), sn4 = *(const f32x4*)(ROPE + pos * 16 + 8 + 4 * (fq & 1));
#pragma unroll
                    for (int bj = 0; bj < 2; ++bj) { float o[8];
#pragma unroll
                        for (int n = 0; n < 2; ++n)
#pragma unroll
                            for (int q = 0; q < 2; ++q) { const float c = cs4[2 * n + q], s = sn4[2 * n + q];
                                const float x1 = acc[ai][bj][m][n][2 * q] * rs, x2 = acc[ai][bj][m][n][2 * q + 1] * rs;
                                o[4 * n + 2 * q] = x1 * c - x2 * s; o[4 * n + 2 * q + 1] = x1 * s + x2 * c; }
                        u32x4 w; w.x = cvt_pk_bf16(o[0], o[1]); w.y = cvt_pk_bf16(o[2], o[3]); w.z = cvt_pk_bf16(o[4], o[5]); w.w = cvt_pk_bf16(o[6], o[7]);
                        *(u32x4*)(QR + (size_t)row * 256 + bj * HALF + colt) = w; }
                }
                asm volatile("" ::: "memory"); }
    }
};
struct EpiKVUp {
    static constexpr bool PERM = true;
    bf16_t* KN; bf16_t* VM; const float* SSQ;
    __device__ __forceinline__ void operator()(const Acc& acc, const Unit& u, int wr, int wc, int fr, int fq) const {
        const int pn = u.pn, row0 = u.pm * BM + wr * 64 + fr, colt = wc * 32 + 8 * fq;
        bf16_t* dst = (pn < 2) ? KN + pn * 256 : VM + (pn - 2) * 256;
#pragma unroll
        for (int ai = 0; ai < 2; ++ai)
#pragma unroll
            for (int m = 0; m < 4; ++m) { const int row = row0 + ai * HALF + m * 16;
                const f32x4 q0_ = *(const f32x4*)(SSQ + (size_t)row * 16 + 8), q1_ = *(const f32x4*)(SSQ + (size_t)row * 16 + 12);
                const float rs = __builtin_amdgcn_rsqf((((q0_[0] + q0_[1]) + (q0_[2] + q0_[3])) + ((q1_[0] + q1_[1]) + (q1_[2] + q1_[3]))) * (1.f / KVLORA) + RMS_EPS);
#pragma unroll
                for (int bj = 0; bj < 2; ++bj) { const f32x4 v0 = acc[ai][bj][m][0] * rs, v1 = acc[ai][bj][m][1] * rs; u32x4 w;
                    w.x = cvt_pk_bf16(v0[0], v0[1]); w.y = cvt_pk_bf16(v0[2], v0[3]); w.z = cvt_pk_bf16(v1[0], v1[1]); w.w = cvt_pk_bf16(v1[2], v1[3]);
                    *(u32x4*)(dst + (size_t)row * 512 + bj * HALF + colt) = w; } }
    }
};
struct EpiMerge {
    static constexpr bool PERM = true;
    const bf16_t* PROJ; bf16_t* MERGED;
    __device__ __forceinline__ void mid(Acc& acc, const Unit& u, int wr, int wc, int fr, int fq) const {
        int row0 = u.pm * BM + wr * 64 + fr; const int col0 = u.pn * BM + wc * 32 + 8 * fq;
        asm volatile("" : "+v"(row0));
#pragma unroll
        for (int ai = 0; ai < 2; ++ai)
#pragma unroll
            for (int m = 0; m < 4; ++m) { const bf16_t* rp = PROJ + (size_t)(row0 + ai * HALF + m * 16) * NPROJ + 2304 + col0;
#pragma unroll
                for (int bj = 0; bj < 2; ++bj) { const u32x4 g1 = *(const u32x4*)(rp + bj * HALF), g2 = *(const u32x4*)(rp + 1024 + bj * HALF);
                    const unsigned w1[4] = {g1.x, g1.y, g1.z, g1.w}, w2[4] = {g2.x, g2.y, g2.z, g2.w};
#pragma unroll
                    for (int q = 0; q < 4; ++q) { const int n = q >> 1, i = (q & 1) * 2;
                        const float r0 = (1.f + __builtin_amdgcn_exp2f(-bf16_lo(w2[q]) * LOG2E)) * __builtin_amdgcn_rcpf(1.f + __builtin_amdgcn_exp2f(-bf16_lo(w1[q]) * LOG2E));
                        const float r1 = (1.f + __builtin_amdgcn_exp2f(-bf16_hi(w2[q]) * LOG2E)) * __builtin_amdgcn_rcpf(1.f + __builtin_amdgcn_exp2f(-bf16_hi(w1[q]) * LOG2E));
                        acc[ai][bj][m][n][i] *= r0; acc[ai][bj][m][n][i + 1] *= r1; } }
                asm volatile("" ::: "memory"); }
    }
    __device__ __forceinline__ void operator()(const Acc& acc, const Unit& u, int wr, int wc, int fr, int fq) const {
        const int row0 = u.pm * BM + wr * 64 + fr, col0 = u.pn * BM + wc * 32 + 8 * fq;
#pragma unroll
        for (int ai = 0; ai < 2; ++ai)
#pragma unroll
            for (int m = 0; m < 4; ++m) { const int row = row0 + ai * HALF + m * 16; const bf16_t* rp = PROJ + (size_t)row * NPROJ + 3328 + col0;
#pragma unroll
                for (int bj = 0; bj < 2; ++bj) { const u32x4 g2 = *(const u32x4*)(rp + bj * HALF);
                    f32x4 s0, s1;
                    s0[0] = sigmoidf_(bf16_lo(g2.x)); s0[1] = sigmoidf_(bf16_hi(g2.x)); s0[2] = sigmoidf_(bf16_lo(g2.y)); s0[3] = sigmoidf_(bf16_hi(g2.y));
                    s1[0] = sigmoidf_(bf16_lo(g2.z)); s1[1] = sigmoidf_(bf16_hi(g2.z)); s1[2] = sigmoidf_(bf16_lo(g2.w)); s1[3] = sigmoidf_(bf16_hi(g2.w));
                    const f32x4 v0 = acc[ai][bj][m][0] * s0, v1 = acc[ai][bj][m][1] * s1; u32x4 w;
                    w.x = cvt_pk_bf16(v0[0], v0[1]); w.y = cvt_pk_bf16(v0[2], v0[3]); w.z = cvt_pk_bf16(v1[0], v1[1]); w.w = cvt_pk_bf16(v1[2], v1[3]);
                    *(u32x4*)(MERGED + (size_t)row * 1024 + col0 + bj * HALF) = w; }
                asm volatile("" ::: "memory"); }
    }
};
struct EpiBf16Y {
    static constexpr bool PERM = true;
    bf16_t* C;
    __device__ __forceinline__ void operator()(const Acc& acc, const Unit& u, int wr, int wc, int fr, int fq) const {
        const int row0 = u.pm * BM + wr * 64 + fr, col0 = u.pn * BM + wc * 32 + 8 * fq;
#pragma unroll
        for (int ai = 0; ai < 2; ++ai)
#pragma unroll
            for (int m = 0; m < 4; ++m) { bf16_t* rowp = C + (size_t)(row0 + ai * HALF + m * 16) * 1024 + col0;
#pragma unroll
                for (int bj = 0; bj < 2; ++bj) { const f32x4 v0 = acc[ai][bj][m][0], v1 = acc[ai][bj][m][1]; u32x4 w;
                    w.x = cvt_pk_bf16(v0[0], v0[1]); w.y = cvt_pk_bf16(v0[2], v0[3]); w.z = cvt_pk_bf16(v1[0], v1[1]); w.w = cvt_pk_bf16(v1[2], v1[3]);
                    *(u32x4*)(rowp + bj * HALF) = w; } }
    }
};
struct EpiMoe1 {
    static constexpr bool PERM = true;
    const float* b1; unsigned char* ACT;
    __device__ __forceinline__ void operator()(const Acc& acc, const Unit& u, int wr, int wc, int fr, int fq) const {
        const int e = u.aux, row0 = u.pm * BM + wr * 64 + fr, col0 = u.pn * BM + wc * 32 + 8 * fq;
        constexpr float DS = 1.f / (SC_H2 * SC_W);
        f32x4 bv[2][2];
#pragma unroll
        for (int bj = 0; bj < 2; ++bj)
#pragma unroll
            for (int n = 0; n < 2; ++n) bv[bj][n] = *(const f32x4*)(b1 + (size_t)e * 2048 + col0 + bj * HALF + 4 * n);
#pragma unroll
        for (int ai = 0; ai < 2; ++ai)
#pragma unroll
            for (int m = 0; m < 4; ++m) { const int row = row0 + ai * HALF + m * 16;
#pragma unroll
                for (int bj = 0; bj < 2; ++bj) { float o[4];
#pragma unroll
                    for (int n = 0; n < 2; ++n) { const f32x4 v = acc[ai][bj][m][n] * DS + bv[bj][n];
#pragma unroll
                        for (int q = 0; q < 2; ++q) { const float xg = fminf(v[2 * q], 7.f), xl = fminf(fmaxf(v[2 * q + 1], -7.f), 7.f);
                            o[2 * n + q] = xg * sigmoidf_(1.702f * xg) * (xl + 1.f) * SC_ACT; } }
                    int w = __builtin_amdgcn_cvt_pk_fp8_f32(o[0], o[1], 0, false); w = __builtin_amdgcn_cvt_pk_fp8_f32(o[2], o[3], w, true);
                    *(int*)(ACT + (size_t)row * 1024 + ((col0 + bj * HALF) >> 1)) = w; } }
    }
};
struct EpiMoe2 {
    static constexpr bool PERM = true;
    const float* b2; bf16_t* YIT;
    __device__ __forceinline__ void operator()(const Acc& acc, const Unit& u, int wr, int wc, int fr, int fq) const {
        const int e = u.aux, row0 = u.pm * BM + wr * 64 + fr, col0 = u.pn * BM + wc * 32 + 8 * fq;
        f32x4 bv[2][2];
#pragma unroll
        for (int bj = 0; bj < 2; ++bj)
#pragma unroll
            for (int n = 0; n < 2; ++n) bv[bj][n] = *(const f32x4*)(b2 + (size_t)e * 1024 + col0 + bj * HALF + 4 * n);
#pragma unroll
        for (int ai = 0; ai < 2; ++ai)
#pragma unroll
            for (int m = 0; m < 4; ++m) { const int row = row0 + ai * HALF + m * 16;
#pragma unroll
                for (int bj = 0; bj < 2; ++bj) { const f32x4 v0 = acc[ai][bj][m][0] * (1.f / (SC_ACT * SC_W)) + bv[bj][0], v1 = acc[ai][bj][m][1] * (1.f / (SC_ACT * SC_W)) + bv[bj][1]; u32x4 w;
                    w.x = cvt_pk_bf16(v0[0], v0[1]); w.y = cvt_pk_bf16(v0[2], v0[3]); w.z = cvt_pk_bf16(v1[0], v1[1]); w.w = cvt_pk_bf16(v1[2], v1[3]);
                    *(u32x4*)(YIT + (size_t)row * 1024 + col0 + bj * HALF) = w; } }
    }
};
}

namespace attn {
#define SBAR() __builtin_amdgcn_sched_barrier(0)
constexpr int NW = 8, QBLK = 32, KVBLK = 64;
constexpr float THR = 8.f;
__device__ __forceinline__ int crow(int r, int hi) { return (r & 3) + 8 * (r >> 2) + 4 * hi; }
constexpr int KROW_MLA = 96 * 2 + 16, KROW_NA = 64 * 2 + 16;
constexpr int SHM_K = 64 * KROW_MLA  , SHM_V = 64 * 64 * 2  ;
constexpr int OFF_V = 0, OFF_K = 4 * SHM_V, OFF_WS = OFF_K + 4 * SHM_K, OFF_OST = OFF_WS + NW * 256, OFF_BIAS = OFF_OST + NW * 4096, ATTN_LDS = OFF_BIAS + 2048;

__device__ __forceinline__ int v_st(int k, int c) { const int kk = (k & ~0xC) | ((k & 4) << 1) | ((k & 8) >> 1); return ((kk >> 3) * 2 + (c >> 5)) * 512 + ((kk & 7) * 32 + (c & 31)) * 2; }
__device__ __forceinline__ int v_rd_base(int lane) { return ((lane & 3) << 3) | (((lane >> 2) & 3) << 6) | (((lane >> 4) & 1) << 5) | (((lane >> 5) & 1) << 8); }
constexpr int v_rd_off(int d0, int ks, int half) { return d0 * 512 + ks * 2048 + half * 1024; }
template <int OFF> __device__ __forceinline__ s16x4 tr_read(int vb) {
    s16x4 r; asm volatile("ds_read_b64_tr_b16 %0, %1 offset:%2" : "=&v"(r) : "v"(vb), "i"(OFF) : "memory"); return r;
}
template <int D0> __device__ __forceinline__ void pv_one(f32x16& od, int vb, bf16x8 pa0, bf16x8 pa1, bf16x8 pa2, bf16x8 pa3) {
    const s16x4 l0 = tr_read<v_rd_off(D0, 0, 0)>(vb), h0 = tr_read<v_rd_off(D0, 0, 1)>(vb), l1 = tr_read<v_rd_off(D0, 1, 0)>(vb), h1 = tr_read<v_rd_off(D0, 1, 1)>(vb);
    const s16x4 l2 = tr_read<v_rd_off(D0, 2, 0)>(vb), h2 = tr_read<v_rd_off(D0, 2, 1)>(vb), l3 = tr_read<v_rd_off(D0, 3, 0)>(vb), h3 = tr_read<v_rd_off(D0, 3, 1)>(vb);
    asm volatile("s_waitcnt lgkmcnt(0)" ::: "memory"); SBAR();
#define PK(L, H) (bf16x8){L[0], L[1], L[2], L[3], H[0], H[1], H[2], H[3]}
    od = __builtin_amdgcn_mfma_f32_32x32x16_bf16(pa0, PK(l0, h0), od, 0, 0, 0);
    od = __builtin_amdgcn_mfma_f32_32x32x16_bf16(pa1, PK(l1, h1), od, 0, 0, 0);
    od = __builtin_amdgcn_mfma_f32_32x32x16_bf16(pa2, PK(l2, h2), od, 0, 0, 0);
    od = __builtin_amdgcn_mfma_f32_32x32x16_bf16(pa3, PK(l3, h3), od, 0, 0, 0);
#undef PK
}
__device__ __forceinline__ void pv_d0(f32x16* o, int vb, bf16x8 pa0, bf16x8 pa1, bf16x8 pa2, bf16x8 pa3) {
    pv_one<0>(o[0], vb, pa0, pa1, pa2, pa3); pv_one<1>(o[1], vb, pa0, pa1, pa2, pa3);
}
__device__ __forceinline__ void partialSM(f32x16& p0, f32x16& p1, float& m_ref, f32x16& negm, float& alpha, bool& fresh) {
    float pmax = p0[0];
#pragma unroll
    for (int r = 1; r < 16; ++r) pmax = fmaxf(pmax, p0[r]);
#pragma unroll
    for (int r = 0; r < 16; ++r) pmax = fmaxf(pmax, p1[r]);
    { auto rr = __builtin_amdgcn_permlane32_swap(__float_as_uint(pmax), __float_as_uint(pmax), false, false);
      pmax = fmaxf(__uint_as_float(rr[0]), __uint_as_float(rr[1])); }
    alpha = 1.f;
    if (__builtin_expect(fresh || !__all(pmax <= THR), 0)) {
        const float dl = fresh ? pmax : fmaxf(pmax, 0.f);
        m_ref += dl;
#pragma unroll
        for (int r = 0; r < 16; ++r) { p0[r] -= dl; p1[r] -= dl; }
        const float nm = -m_ref;
#pragma unroll
        for (int r = 0; r < 16; ++r) negm[r] = nm;
        alpha = fresh ? 1.f : __builtin_amdgcn_exp2f(-dl);
        fresh = false;
    }
#pragma unroll
    for (int r = 0; r < 16; ++r) p0[r] = __builtin_amdgcn_exp2f(p0[r]);
}
__device__ __forceinline__ void finishSM(f32x16& p0, f32x16& p1, float alpha, float& l_reg, bf16x8& pa0, bf16x8& pa1, bf16x8& pa2, bf16x8& pa3) {
#pragma unroll
    for (int r = 0; r < 16; ++r) p1[r] = __builtin_amdgcn_exp2f(p1[r]);
    float ps = 0;
#pragma unroll
    for (int r = 0; r < 16; ++r) ps += p0[r];
#pragma unroll
    for (int r = 0; r < 16; ++r) ps += p1[r];
    { auto rr = __builtin_amdgcn_permlane32_swap(__float_as_uint(ps), __float_as_uint(ps), false, false);
      ps = __uint_as_float(rr[0]) + __uint_as_float(rr[1]); }
    l_reg = l_reg * alpha + ps;
#define PK4(P, BASE, OUT) do { unsigned a0 = cvt_pk_bf16(P[BASE + 0], P[BASE + 1]), a1 = cvt_pk_bf16(P[BASE + 2], P[BASE + 3]);   \
    unsigned b0 = cvt_pk_bf16(P[BASE + 4], P[BASE + 5]), b1 = cvt_pk_bf16(P[BASE + 6], P[BASE + 7]);                              \
    auto r0 = __builtin_amdgcn_permlane32_swap(a0, b0, false, false); auto r1 = __builtin_amdgcn_permlane32_swap(a1, b1, false, false); \
    u32x4 w = {r0[0], r1[0], r0[1], r1[1]}; OUT = *reinterpret_cast<bf16x8*>(&w); } while (0)
    PK4(p0, 0, pa0); PK4(p0, 8, pa1); PK4(p1, 0, pa2); PK4(p1, 8, pa3);
#undef PK4
}
template <int ND0, int KROW>
__device__ __forceinline__ void qkt(f32x16& p0, f32x16& p1, const char* Ks, const bf16x8* qr, const f32x16& negm, int r32, int hi) {
#pragma unroll
    for (int d0 = 0; d0 < ND0; ++d0) { const int cb = (d0 * 16 + hi * 8) * 2;
        const bf16x8 b0 = *reinterpret_cast<const bf16x8*>(Ks + r32 * KROW + cb);
        const bf16x8 b1 = *reinterpret_cast<const bf16x8*>(Ks + (32 + r32) * KROW + cb);
        if (d0 == 0) { p0 = __builtin_amdgcn_mfma_f32_32x32x16_bf16(b0, qr[0], negm, 0, 0, 0); p1 = __builtin_amdgcn_mfma_f32_32x32x16_bf16(b1, qr[0], negm, 0, 0, 0); }
        else { p0 = __builtin_amdgcn_mfma_f32_32x32x16_bf16(b0, qr[d0], p0, 0, 0, 0); p1 = __builtin_amdgcn_mfma_f32_32x32x16_bf16(b1, qr[d0], p1, 0, 0, 0); } }
}

template <int MODE>
__device__ __forceinline__ void attn_unit(const bf16_t* __restrict__ Qa, int ldqa, const bf16_t* __restrict__ Qb, int ldqb,
                                          const bf16_t* __restrict__ Ka, int ldka, const bf16_t* __restrict__ Kb, int ldkb, const bf16_t* __restrict__ Vv, int ldv,
                                          bf16_t* __restrict__ O, int NT, int krow0, int ntreal, int qrow0, const float* __restrict__ rpbh, char* lds) {
    constexpr int ND0 = MODE == 0 ? 6 : 4, KROW = MODE == 0 ? KROW_MLA : KROW_NA;
    const int tid = threadIdx.x, wid = __builtin_amdgcn_readfirstlane(tid >> 6), lane = tid & 63, r32 = lane & 31, hi = lane >> 5;
    char* V_lds = lds + OFF_V; char* K_lds = lds + OFF_K;
    float* ws = (float*)(lds + OFF_WS) + wid * 64; float* li_l = ws; float* al_l = ws + 32;
    float* biasL = (float*)(lds + OFF_BIAS);
    float m_ref = 0.f, l_reg = 0; f32x16 o[2] = {}; f32x16 negm = {}; bool fresh = true; bf16x8 qr[ND0];
    {   const bf16_t* Qw = Qa + (size_t)(wid * QBLK + r32) * ldqa + hi * 8;
#pragma unroll
        for (int d0 = 0; d0 < 4; ++d0) qr[d0] = *reinterpret_cast<const bf16x8*>(Qw + d0 * 16);
        if constexpr (MODE == 0) { const bf16_t* Qw2 = Qb + (size_t)(wid * QBLK + r32) * ldqb + hi * 8;
#pragma unroll
            for (int d0 = 0; d0 < 2; ++d0) qr[4 + d0] = *reinterpret_cast<const bf16x8*>(Qw2 + d0 * 16); } }
    int qgr = 0, rs0 = 0, qc = 0, cs = 0;
    if constexpr (MODE == 1) {
        qgr = qrow0 + (wid >> 1); rs0 = min(max(qgr - 4, 0), 120); qc = 32 * (wid & 1) + r32; cs = min(max(qc - 8, 0), 48);
        for (int i = tid; i < 15 * 31; i += 512) biasL[i] = rpbh[i] * LOG2E;
    }
    const int sr = tid >> 3, sc = (tid & 7) * 8;
    const int sr2 = (tid & 255) >> 2, sc2 = (tid & 3) * 8;
    const int vst = v_st(sr, sc);
    const int vb0 = (int)(uintptr_t)V_lds + v_rd_base(lane);
    struct { bf16x8 v, k, k2; } sr_[1];
#define KROWOF(t) (MODE == 1 ? min(krow0 + (t), 127) * 64 : (t) * 64)
#define SLOAD(i, t) do { const long k0_ = KROWOF(t); sr_[i].v = *reinterpret_cast<const bf16x8*>(&Vv[(k0_ + sr) * ldv + sc]); sr_[i].k = *reinterpret_cast<const bf16x8*>(&Ka[(k0_ + sr) * ldka + sc]); \
        if constexpr (MODE == 0) sr_[i].k2 = *reinterpret_cast<const bf16x8*>(&Kb[(k0_ + sr2) * ldkb + sc2]); } while (0)
#define SWRITE(b, i) do { *(bf16x8*)(V_lds + (b) * SHM_V + vst) = sr_[i].v; *(bf16x8*)(K_lds + (b) * SHM_K + sr * KROW + sc * 2) = sr_[i].k; \
        if constexpr (MODE == 0) { if (tid < 256) *(bf16x8*)(K_lds + (b) * SHM_K + sr2 * KROW + 128 + sc2 * 2) = sr_[i].k2; } } while (0)
#define SWAIT() do { if constexpr (MODE == 0) asm volatile("s_waitcnt vmcnt(3)" ::: "memory"); else asm volatile("s_waitcnt vmcnt(2)" ::: "memory"); } while (0)
#define RESC(a) do { if (__any((a) < 1.f)) { if (hi == 0) al_l[r32] = (a); asm volatile("s_waitcnt lgkmcnt(0)" ::: "memory"); \
        _Pragma("unroll") for (int d = 0; d < 2; ++d) _Pragma("unroll") for (int r = 0; r < 16; ++r) o[d][r] *= al_l[crow(r, hi)]; } } while (0)
#define TVALID(t) (MODE == 0 ? true : ((t) < ntreal && (krow0 + (t)) >= rs0 && (krow0 + (t)) < rs0 + 8))
#define MASKB(P0, P1, t) do { if constexpr (MODE == 1) { const int dr_ = krow0 + (t) - qgr + 7; int d_ = 4 * hi - cs; asm volatile("" : "+v"(d_)); \
        const LAS float* bl_ = (const LAS float*)((LAS char*)lds + OFF_BIAS) + (dr_ * 31 + 15 - qc + 4 * hi); \
        _Pragma("unroll") for (int r = 0; r < 16; ++r) { const int c0_ = (r & 3) + 8 * (r >> 2); \
            const bool in0 = (unsigned)(c0_ + d_) < 16u, in1 = (unsigned)(c0_ + 32 + d_) < 16u; \
            const float b0_ = bl_[c0_], b1_ = bl_[c0_ + 32]; \
            P0[r] = in0 ? P0[r] + b0_ : -1e30f; P1[r] = in1 ? P1[r] + b1_ : -1e30f; } } } while (0)
    f32x16 pA0, pA1, pB0, pB1; float alA = 1.f, alB = 1.f; bf16x8 pa0, pa1, pa2, pa3;
    SLOAD(0, 0); asm volatile("s_waitcnt vmcnt(0)" ::: "memory"); SWRITE(0, 0); SLOAD(0, 1); asm volatile("s_waitcnt vmcnt(0)" ::: "memory"); SWRITE(1, 0);
    if (NT > 2) SLOAD(0, 2);
    __syncthreads();
    const int NI = NT >> 1;
    for (int it = 0; it < NI; ++it) {
        const int kb = (it & 1) * 2, nb = 2 - kb; const bool more = it + 1 < NI;
        if (more) { SWRITE(nb, 0); SLOAD(0, 2 * it + 3); }
        const int ta = 2 * it, tb = ta + 1;
        const bool vA = TVALID(ta), vB = TVALID(tb);
        if (vA) { qkt<ND0, KROW>(pA0, pA1, K_lds + kb * SHM_K, qr, negm, r32, hi); MASKB(pA0, pA1, ta); partialSM(pA0, pA1, m_ref, negm, alA, fresh); RESC(alA); }
        SBAR();
        if (vB) { qkt<ND0, KROW>(pB0, pB1, K_lds + (kb + 1) * SHM_K, qr, negm, r32, hi); MASKB(pB0, pB1, tb); }
        if (vA) { finishSM(pA0, pA1, alA, l_reg, pa0, pa1, pa2, pa3); SBAR(); pv_d0(o, vb0 + kb * SHM_V, pa0, pa1, pa2, pa3); }
        if (more) { SWRITE(nb + 1, 0); if (it + 2 < NI) SLOAD(0, 2 * it + 4); }
        if (vB) { partialSM(pB0, pB1, m_ref, negm, alB, fresh); RESC(alB); finishSM(pB0, pB1, alB, l_reg, pa0, pa1, pa2, pa3); SBAR(); pv_d0(o, vb0 + (kb + 1) * SHM_V, pa0, pa1, pa2, pa3); }
        __syncthreads();
    }
    asm volatile("s_waitcnt vmcnt(0)" ::: "memory");
    if (hi == 0) li_l[r32] = l_reg; asm volatile("s_waitcnt lgkmcnt(0)" ::: "memory");
    float rli[16];
#pragma unroll
    for (int r = 0; r < 16; ++r) rli[r] = __builtin_amdgcn_rcpf(li_l[crow(r, hi)]);
    {   bf16_t* stg = (bf16_t*)(lds + OFF_OST) + wid * 2048;
#pragma unroll
        for (int r = 0; r < 16; ++r) { const int orow = crow(r, hi);
#pragma unroll
            for (int d0 = 0; d0 < 2; ++d0) stg[orow * 64 + d0 * 32 + r32] = (bf16_t)(cvt_pk_bf16(o[d0][r] * rli[r], 0.f) & 0xffffu); }
        asm volatile("s_waitcnt lgkmcnt(0)" ::: "memory");
        bf16_t* Ow = O + (size_t)(wid * QBLK) * 512;
#pragma unroll
        for (int i = 0; i < 4; ++i) { const int row = i * 8 + (lane >> 3), ch = lane & 7; const u32x4 v = *(const u32x4*)(stg + row * 64 + ch * 8); *(u32x4*)(Ow + (size_t)row * 512 + ch * 8) = v; } }
    __syncthreads();
#undef KROWOF
#undef SLOAD
#undef SWRITE
#undef SWAIT
#undef RESC
#undef TVALID
#undef MASKB
}
#undef SBAR
}

constexpr size_t MiB = 1u << 20;
constexpr size_t WS_CTL = 0, CTL_ZERO_BYTES = 1 * MiB;
constexpr size_t WS_WIN = 2 * MiB;
constexpr size_t WS_WUQ = 11 * MiB;
constexpr size_t WS_WUKV = 12 * MiB;
constexpr size_t WS_WNA = 13 * MiB, WS_WMLA = 14 * MiB;
constexpr size_t WS_WOUT = 15 * MiB;
constexpr size_t WS_W1 = 18 * MiB;
constexpr size_t WS_W2 = 146 * MiB;
constexpr size_t WS_XN = 210 * MiB;
constexpr size_t WS_PROJ = 242 * MiB;
constexpr size_t WS_QN = 378 * MiB, WS_QR = 394 * MiB, WS_KN = 402 * MiB, WS_KR = 418 * MiB, WS_VM = 419 * MiB;
constexpr size_t WS_ONA = 435 * MiB, WS_OMLA = 451 * MiB;
constexpr size_t WS_MERGED = 467 * MiB;
constexpr size_t WS_TMP = 499 * MiB;
constexpr size_t WS_LIST = 563 * MiB;
constexpr size_t WS_TOKPOS = 565 * MiB, WS_TOKG = 566 * MiB;
constexpr size_t WS_ACT = 568 * MiB;
constexpr size_t WS_YIT = 712 * MiB;
constexpr size_t WS_SSQ = 856 * MiB;
constexpr size_t WS_MODP = 857 * MiB;
constexpr size_t WS_WRT = 858 * MiB;
constexpr size_t WS_END = 859 * MiB;
constexpr int CW_BAR = 4096;
constexpr int CW_CNT = 8192;
constexpr int CW_MOD = 16384;
constexpr int CW_ROPE = 32768;
static_assert((CW_ROPE + 2048) * 4 <= (int)CTL_ZERO_BYTES, "CTL");

constexpr int RING_BYTES = 131072;
constexpr int TAB_OFF = RING_BYTES;
constexpr int TAB_BLK = TAB_OFF, TAB_GATH = TAB_OFF + 2048;
constexpr int MISC_OFF = TAB_GATH + 11 * 1024;
constexpr int LDS_BYTES = 147456;
static_assert(MISC_OFF + 256 <= LDS_BYTES, "LDS map");

#define RLX_AGENT __ATOMIC_RELAXED, __HIP_MEMORY_SCOPE_AGENT
#define LDS_WAIT() asm volatile("s_waitcnt lgkmcnt(0)" ::: "memory")

#define XB_TMO      128
#define XB_XCNT(j)  (256  + 64 * (j))
#define XB_XSUB(j)  (1280 + 64 * (j))
#define XB_XGEN(j)  (2304 + 64 * (j))
#define XB_TOP      3328
#define XB_TOPGEN   3392
#define XCD_BAR_WORDS 3456
#define XB_SPIN_CAP (1u << 22)
__device__ __forceinline__ unsigned xb_ld(unsigned* p)              { return __hip_atomic_load(p, __ATOMIC_RELAXED, __HIP_MEMORY_SCOPE_AGENT); }
__device__ __forceinline__ unsigned xb_add(unsigned* p, unsigned v) { return __hip_atomic_fetch_add(p, v, __ATOMIC_RELAXED, __HIP_MEMORY_SCOPE_AGENT); }
__device__ __forceinline__ unsigned xb_xcc_id() { return (unsigned)__builtin_amdgcn_s_getreg((3 << 11) | 20) & 0xFu; }
#define XB_SPIN(cond, bar) do { unsigned _sp = 0; while (cond) { __builtin_amdgcn_s_sleep(1); \
    if ((++_sp & 255u) == 0u) { if (xb_ld(&(bar)[XB_TMO])) break; if (_sp > XB_SPIN_CAP) { atomicAdd(&(bar)[XB_TMO], 1u); break; } } } } while (0)
struct XcdBarrier { unsigned* bar; unsigned x; volatile LAS unsigned* st; };
__device__ __forceinline__ XcdBarrier xcd_barrier_post(unsigned* bar, volatile LAS unsigned* st) {
    XcdBarrier b; b.bar = bar; b.x = xb_xcc_id(); b.st = st;
    if (threadIdx.x == 0) (void)xb_add(&bar[XB_XCNT(b.x)], 1u);
    return b;
}
__device__ __forceinline__ void xcd_barrier_complete(unsigned* bar, unsigned x, unsigned& nloc, unsigned& nx) {
    const unsigned G = gridDim.x * gridDim.y * gridDim.z;
    unsigned sum, cnt, mine, sp = 0u;
    for (;;) {
        sum = 0u; cnt = 0u; mine = 0u;
#pragma unroll
        for (unsigned j = 0; j < 16; ++j) { const unsigned c = xb_ld(&bar[XB_XCNT(j)]); sum += c; cnt += (c > 0u) ? 1u : 0u; mine = (j == x) ? c : mine; }
        if (sum == G) break;
        __builtin_amdgcn_s_sleep(1);
        if ((++sp & 255u) == 0u) { if (xb_ld(&bar[XB_TMO])) break; if (sp > XB_SPIN_CAP) { atomicAdd(&bar[XB_TMO], 1u); break; } }
    }
    nloc = mine > 0u ? mine : 1u; nx = cnt > 0u ? cnt : 1u;
}
__device__ __forceinline__ void xcd_barrier(const XcdBarrier& b) {
    asm volatile("s_waitcnt vmcnt(0)" ::: "memory");
    __syncthreads();
    if (threadIdx.x == 0) {
        unsigned* bar = b.bar;
        __builtin_amdgcn_s_waitcnt(0);
        unsigned nloc = b.st[0], nx = b.st[1];
        if (nloc == 0u) { xcd_barrier_complete(bar, b.x, nloc, nx); b.st[0] = nloc; b.st[1] = nx; }
        const unsigned old = xb_add(&bar[XB_XSUB(b.x)], 1u);
        const unsigned gen = old / nloc;
        if (old + 1u == (gen + 1u) * nloc) {
            __builtin_amdgcn_fence(__ATOMIC_RELEASE, "agent");
            asm volatile("s_waitcnt vmcnt(0)" ::: "memory");
            const unsigned og = xb_add(&bar[XB_TOP], 1u);
            const unsigned tg = og / nx;
            if (og + 1u == (tg + 1u) * nx) xb_add(&bar[XB_TOPGEN], 1u);
            else XB_SPIN(xb_ld(&bar[XB_TOPGEN]) == tg, bar);
            __builtin_amdgcn_fence(__ATOMIC_ACQUIRE, "agent");
            xb_add(&bar[XB_XGEN(b.x)], 1u);
            asm volatile("s_waitcnt vmcnt(0)" ::: "memory");
        } else {
            XB_SPIN(xb_ld(&bar[XB_XGEN(b.x)]) == gen, bar);
            __builtin_amdgcn_fence(__ATOMIC_ACQUIRE, "agent");
            asm volatile("s_waitcnt vmcnt(0)" ::: "memory");
        }
    }
    __syncthreads();
}

constexpr int NWAVES = 8;
struct Args { const float* in[24]; float* out; unsigned char* ws; int ph_lo, ph_hi; };
enum { I_X = 0, I_C, I_WADA, I_BADA, I_GAPRE, I_GAPOST, I_WIN, I_BGATE, I_RPB, I_QNG, I_KVNG, I_WUQ, I_WUKV, I_WNAUP, I_WMLAUP, I_WOUT, I_GFPRE, I_GFPOST, I_WR, I_BR, I_W1, I_B1, I_W2, I_B2 };

__device__ __forceinline__ void tr_store_tile(LAS unsigned char* scr, bf16_t* dst, int K, int n0, int k0, int lane) {
    LDS_WAIT(); asm volatile("" ::: "memory");
#pragma unroll
    for (int j = 0; j < 8; ++j) { const int idx = j * 64 + lane, n = idx >> 3, ch = idx & 7;
        const u32x4 v = *(const LAS u32x4*)(scr + n * 144 + ch * 16);
        *(GAS u32x4*)(dst + (size_t)(n0 + n) * K + k0 + ch * 8) = v; }
    LDS_WAIT(); asm volatile("" ::: "memory");
}
__device__ __forceinline__ void tr_tile_fast(const float* src, int Nsrc, int src0, const float* kscale, bf16_t* dst, int K, int n0, int k0, LAS unsigned char* scr, int lane) {
#pragma unroll
    for (int st = 0; st < 8; ++st) { const int kq = st * 4 + (lane >> 4), c4 = (lane & 15) * 4, k = 2 * kq;
        f32x4 a = *(const GAS f32x4*)(src + (size_t)(k0 + k) * Nsrc + src0 + c4);
        f32x4 b = *(const GAS f32x4*)(src + (size_t)(k0 + k + 1) * Nsrc + src0 + c4);
        if (kscale) { const float s0 = kscale[k0 + k], s1 = kscale[k0 + k + 1]; a = a * s0; b = b * s1; }
#pragma unroll
        for (int i = 0; i < 4; ++i) *(LAS unsigned*)(scr + (c4 + i) * 144 + k * 2) = cvt_pk_bf16(a[i], b[i]); }
    tr_store_tile(scr, dst, K, n0, k0, lane);
}
__device__ __forceinline__ void tr_tile_slow(const float* src, int Nsrc, int srccol  , const float* kscale, bf16_t* dst, int K, int n0, int k0, LAS unsigned char* scr, int lane) {
#pragma unroll 8
    for (int k = 0; k < 64; k += 2) {
        float a = 0.f, b = 0.f;
        if (srccol >= 0) { a = src[(size_t)(k0 + k) * Nsrc + srccol]; b = src[(size_t)(k0 + k + 1) * Nsrc + srccol];
            if (kscale) { a *= kscale[k0 + k]; b *= kscale[k0 + k + 1]; } }
        *(LAS unsigned*)(scr + lane * 144 + k * 2) = cvt_pk_bf16(a, b); }
    tr_store_tile(scr, dst, K, n0, k0, lane);
}
__device__ __forceinline__ void tr_tile_fast8(const float* src, int Nsrc, int src0, unsigned char* dst, int K, int n0, int k0, LAS unsigned char* scr, int lane) {
#pragma unroll
    for (int st = 0; st < 4; ++st) { const int kq = st * 4 + (lane >> 4), c4 = (lane & 15) * 4, k = 4 * kq;
        const f32x4 a = __builtin_nontemporal_load((const f32x4*)(src + (size_t)(k0 + k) * Nsrc + src0 + c4)) * SC_W, b = __builtin_nontemporal_load((const f32x4*)(src + (size_t)(k0 + k + 1) * Nsrc + src0 + c4)) * SC_W;
        const f32x4 c = __builtin_nontemporal_load((const f32x4*)(src + (size_t)(k0 + k + 2) * Nsrc + src0 + c4)) * SC_W, d = __builtin_nontemporal_load((const f32x4*)(src + (size_t)(k0 + k + 3) * Nsrc + src0 + c4)) * SC_W;
#pragma unroll
        for (int i = 0; i < 4; ++i) { int w = __builtin_amdgcn_cvt_pk_fp8_f32(a[i], b[i], 0, false); w = __builtin_amdgcn_cvt_pk_fp8_f32(c[i], d[i], w, true);
            *(LAS int*)(scr + (c4 + i) * 80 + k) = w; } }
    LDS_WAIT(); asm volatile("" ::: "memory");
#pragma unroll
    for (int j = 0; j < 4; ++j) { const int idx = j * 64 + lane, n = idx >> 2, ch = idx & 3;
        const u32x4 v = *(const LAS u32x4*)(scr + n * 80 + ch * 16);
        __builtin_nontemporal_store(v, (u32x4*)(dst + (size_t)(n0 + n) * K + k0 + ch * 16)); }
    LDS_WAIT(); asm volatile("" ::: "memory");
}
__device__ __forceinline__ int rope_orig(int p) { return (p & 16) + 8 * (p & 1) + ((p & 15) >> 1); }

__global__ void __launch_bounds__(NWAVES * 64, 2) fwd_kernel(Args args_unused_) {
#define args (*(const __attribute__((address_space(4))) Args*)__builtin_amdgcn_kernarg_segment_ptr())
    extern __shared__ __attribute__((aligned(16))) unsigned char lds[];
    LAS unsigned char* L = (LAS unsigned char*)lds;
    volatile LAS unsigned* MISC = (volatile LAS unsigned*)(L + MISC_OFF);
    const int tid = threadIdx.x, lane = tid & 63, wave = __builtin_amdgcn_readfirstlane(tid >> 6);
    const int G = gridDim.x, bx = blockIdx.x, vcu = (G % 8 == 0) ? (bx % 8) * (G / 8) + bx / 8 : bx;
    unsigned char* ws = args.ws;
    gu32* ctl = (gu32*)(ws + WS_CTL);
    const int lo = args.ph_lo, hi = args.ph_hi;
    for (int u = tid; u < 64; u += NWAVES * 64) MISC[u] = 0u;
    __syncthreads();
    XcdBarrier bar; bar.bar = (unsigned*)(ctl + CW_BAR); bar.x = 0; bar.st = nullptr;
    const bool use_bar = (hi - lo) > 1;
    if (use_bar) bar = xcd_barrier_post((unsigned*)(ctl + CW_BAR), MISC + 8);
#ifndef PHASE_MASK
#define PHASE_MASK 0xFFFF
#endif
#define IN(k) (((PHASE_MASK >> (k)) & 1) && lo <= (k) && (k) < hi)
#ifndef REPMASK
#define REPMASK 0
#endif
#define NREP(k) (1 + ((REPMASK >> (k)) & 1))
#define SEAM(k) do { if (IN(k) && IN((k) + 1)) xcd_barrier(bar); } while (0)
    const int gw = vcu * NWAVES + wave, NGW = G * NWAVES;
    float* ROPE = (float*)(ctl + CW_ROPE);
    float* MODP = (float*)(ws + WS_MODP); float* MOD = (float*)(ws + WS_MODP + 512 * 1024); float* SSQ = (float*)(ws + WS_SSQ); unsigned* CNT = (unsigned*)(ctl + CW_CNT);
    bf16_t* WINT = (bf16_t*)(ws + WS_WIN); bf16_t* WUQT = (bf16_t*)(ws + WS_WUQ); bf16_t* WUKVT = (bf16_t*)(ws + WS_WUKV);
    bf16_t* WNAT = (bf16_t*)(ws + WS_WNA); bf16_t* WMLAT = (bf16_t*)(ws + WS_WMLA); bf16_t* WOUTT = (bf16_t*)(ws + WS_WOUT);
    bf16_t* W1T = (bf16_t*)(ws + WS_W1); bf16_t* W2T = (bf16_t*)(ws + WS_W2);
    bf16_t* XN = (bf16_t*)(ws + WS_XN); bf16_t* PROJ = (bf16_t*)(ws + WS_PROJ);
    bf16_t* QN = (bf16_t*)(ws + WS_QN); bf16_t* QR = (bf16_t*)(ws + WS_QR); bf16_t* KN = (bf16_t*)(ws + WS_KN); bf16_t* KR = (bf16_t*)(ws + WS_KR); bf16_t* VM = (bf16_t*)(ws + WS_VM);
    bf16_t* ONA = (bf16_t*)(ws + WS_ONA); bf16_t* OMLA = (bf16_t*)(ws + WS_OMLA); bf16_t* MERGED = (bf16_t*)(ws + WS_MERGED);
    float* TMP = (float*)(ws + WS_TMP); unsigned* LIST = (unsigned*)(ws + WS_LIST); unsigned* TOKPOS = (unsigned*)(ws + WS_TOKPOS); float* TOKG = (float*)(ws + WS_TOKG);
    bf16_t* ACT = (bf16_t*)(ws + WS_ACT); bf16_t* YIT = (bf16_t*)(ws + WS_YIT);
    const float* X = args.in[I_X]; float* OUT = args.out;

    if (IN(0)) for (int rep_ = 0; rep_ < NREP(0); ++rep_) {
        LAS unsigned char* scr = L + wave * 16384;
        {   const float* c = args.in[I_C]; const float* wada = args.in[I_WADA]; const float* bada = args.in[I_BADA];
            for (int it = gw; it < 96 * 8; it += NGW) { const int nb = it % 96, kc = it / 96, n = nb * 64 + lane;
                float a0 = 0.f, a1 = 0.f;
#pragma unroll 8
                for (int k = 0; k < 128; ++k) { const int kk = kc * 128 + k; const float w = wada[(size_t)kk * 6144 + n];
                    const float c0 = c[kk], c1 = c[1024 + kk]; a0 += (c0 * sigmoidf_(c0)) * w; a1 += (c1 * sigmoidf_(c1)) * w; }
                if (kc == 0) { a0 += bada[n]; a1 += bada[n]; }
                MODP[(kc * 2 + 0) * 6144 + n] = a0; MODP[(kc * 2 + 1) * 6144 + n] = a1; } }
        if (bx == 0) { for (int i = tid; i < 128 * 8; i += NWAVES * 64) { const int pos = i >> 3, j = i & 7; float c, sn; rope_cs((float)pos, j, c, sn); ROPE[pos * 16 + j] = c; ROPE[pos * 16 + 8 + j] = sn; } }
        if (bx == 1 % G) { const float* Wr = args.in[I_WR]; float* WRT = (float*)(ws + WS_WRT); for (int i = tid; i < NEXP * 1024; i += NWAVES * 64) WRT[i] = Wr[(size_t)(i & 1023) * 32 + (i >> 10)]; }
        {   constexpr int I_WIN_ = 16 * 68, I_UQ = 6 * 12, I_UKV = 4 * 16, I_UP = 8 * 16, I_OUT = 16 * 16;
            constexpr int NITEMS = I_WIN_ + I_UQ + I_UKV + 2 * I_UP + I_OUT;
            for (int it = gw; it < NITEMS; it += NGW) {
                int r = it;
                if (r < I_WIN_) { const int kb = r / 68, nb = r % 68;
                    if (nb < 34) tr_tile_fast(args.in[I_WIN], 4256, nb * 64, nullptr, WINT, 1024, nb * 64, kb * 64, scr, lane);
                    else if (nb >= 36) tr_tile_fast(args.in[I_WIN], 4256, 2208 + (nb - 36) * 64, nullptr, WINT, 1024, nb * 64, kb * 64, scr, lane);
                    else { const int n = nb * 64 + lane; const int sc = (n < 2208) ? 2176 + rope_orig(n - 2176) : -1;
                        tr_tile_slow(args.in[I_WIN], 4256, sc, nullptr, WINT, 1024, nb * 64, kb * 64, scr, lane); }
                    continue; } r -= I_WIN_;
                if (r < I_UQ) { const int kb = r / 12, nb = r % 12;
                    if (nb < 8) tr_tile_fast(args.in[I_WUQ], 768, nb * 96, args.in[I_QNG], WUQT, 384, nb * 64, kb * 64, scr, lane);
                    else { const int n = nb * 64 + lane - 512, h = n >> 5, p = n & 31;
                        tr_tile_slow(args.in[I_WUQ], 768, h * 96 + 64 + rope_orig(p), args.in[I_QNG], WUQT, 384, nb * 64, kb * 64, scr, lane); }
                    continue; } r -= I_UQ;
                if (r < I_UKV) { const int kb = r / 16, nb = r % 16;
                    const int s0 = (nb < 8) ? nb * 128 : (nb - 8) * 128 + 64;
                    tr_tile_fast(args.in[I_WUKV], 1024, s0, args.in[I_KVNG], WUKVT, 256, nb * 64, kb * 64, scr, lane); continue; } r -= I_UKV;
                if (r < I_UP) { const int kb = r / 16, nb = r % 16; tr_tile_fast(args.in[I_WNAUP], 1024, nb * 64, nullptr, WNAT, 512, nb * 64, kb * 64, scr, lane); continue; } r -= I_UP;
                if (r < I_UP) { const int kb = r / 16, nb = r % 16; tr_tile_fast(args.in[I_WMLAUP], 1024, nb * 64, nullptr, WMLAT, 512, nb * 64, kb * 64, scr, lane); continue; } r -= I_UP;
                { const int kb = r / 16, nb = r % 16; tr_tile_fast(args.in[I_WOUT], 1024, nb * 64, nullptr, WOUTT, 1024, nb * 64, kb * 64, scr, lane); }
            } }
    }
    SEAM(0);
    if (IN(1)) {
        const float* g = args.in[I_GAPRE];
        LAS float* modl = (LAS float*)L;
        for (int i = tid; i < 4096; i += NWAVES * 64) { const int b = i >> 11, c = i & 2047; float sm = 0.f;
#pragma unroll
            for (int kc = 0; kc < 8; ++kc) sm += MODP[(kc * 2 + b) * 6144 + c];
            modl[i] = sm; }
        for (int idx = bx * (NWAVES * 64) + tid; idx < 2 * 6144; idx += G * NWAVES * 64) { const int b = idx / 6144, n = idx % 6144; float sm = 0.f;
#pragma unroll
            for (int kc = 0; kc < 8; ++kc) sm += MODP[(kc * 2 + b) * 6144 + n];
            MOD[idx] = sm; }
        __syncthreads();
        for (int m = gw; m < MTOK; m += NGW) { const int b = m >> 13;
            const GAS f32x4* xr = (const GAS f32x4*)(X + (size_t)m * DM) + lane; f32x4 v[4]; float s = 0.f;
#pragma unroll
            for (int j = 0; j < 4; ++j) { v[j] = xr[64 * j]; s += (v[j].x * v[j].x + v[j].y * v[j].y) + (v[j].z * v[j].z + v[j].w * v[j].w); }
            const float rstd = __builtin_amdgcn_rsqf(wave_sum(s) * (1.f / DM) + RMS_EPS);
            GAS u32x2* o8 = (GAS u32x2*)(XN + (size_t)m * DM) + lane;
#pragma unroll
            for (int j = 0; j < 4; ++j) { const int col = 4 * lane + 256 * j;
                const f32x4 gg = *(const f32x4*)(g + col), sh = *(const LAS f32x4*)(modl + b * 2048 + col), scl = *(const LAS f32x4*)(modl + b * 2048 + 1024 + col);
                const f32x4 h = v[j] * rstd * gg * (scl + 1.f) + sh; u32x2 w; w.x = cvt_pk_bf16(h[0], h[1]); w.y = cvt_pk_bf16(h[2], h[3]); o8[64 * j] = w; } }
    }
    SEAM(1);
    if (IN(2)) for (int rep_ = 0; rep_ < NREP(2); ++rep_) {
        if (bx < NG_INPROJ || G < 256) {
            const int ng = G < 256 ? G : NG_INPROJ;
            pg8::SchedDense S{(const char*)XN, (const char*)WINT, (size_t)256 * 1024 * 2, (size_t)256 * 1024 * 2, MTOK / 256, NPROJ / 256, ng, bx};
            pg8::EpiInProj E{PROJ, SSQ, KR, ROPE, args.in[I_BGATE]};
            pg8::gemm_phase<pg8::EpiInProj, pg8::SchedDense, true, false, false>(L, 16, 2048, 2048, S, E);
        }
        {   LAS unsigned char* scr = L + wave * 16384;
            constexpr int I_W1_ = NEXP * 16 * 32, I_W2_ = NEXP * 16 * 16, NCHUNK = (I_W1_ + I_W2_) / 32;
            for (;;) {
                if (tid == 0) MISC[20] = atomicAdd(CNT + 64, 1u);
                __syncthreads();
                const int chunk = (int)MISC[20];
                __syncthreads();
                if (chunk >= NCHUNK) break;
#pragma unroll 1
                for (int k = 0; k < 4; ++k) { int r = chunk * 32 + wave * 4 + k;
                    if (r < I_W1_) { const int e = r / 512, q = r % 512, kb = q / 32, nb = q % 32;
                        tr_tile_fast8(args.in[I_W1] + (size_t)e * 1024 * 2048, 2048, nb * 64, (unsigned char*)W1T + (size_t)e * 2048 * 1024, 1024, nb * 64, kb * 64, scr, lane); }
                    else { r -= I_W1_; const int e = r / 256, q = r % 256, kb = q / 16, nb = q % 16;
                        tr_tile_fast8(args.in[I_W2] + (size_t)e * 1024 * 1024, 1024, nb * 64, (unsigned char*)W2T + (size_t)e * 1024 * 1024, 1024, nb * 64, kb * 64, scr, lane); } }
            } }
    }
    SEAM(2);
    if (IN(3)) for (int rep_ = 0; rep_ < NREP(3); ++rep_) {
#ifndef NO_QUP
        {   pg8::SchedDense S{(const char*)(PROJ + 1536), (const char*)WUQT, (size_t)256 * NPROJ * 2, (size_t)256 * 384 * 2, MTOK / 256, 3, G, bx};
            pg8::EpiQUp E{QN, QR, SSQ, ROPE};
            pg8::gemm_phase<pg8::EpiQUp, pg8::SchedDense, true, false, false>(L, 6, NPROJ * 2, 768, S, E); }
#endif
#ifndef NO_KVUP
        {   pg8::SchedDense S{(const char*)(PROJ + 1920), (const char*)WUKVT, (size_t)256 * NPROJ * 2, (size_t)256 * 256 * 2, MTOK / 256, 4, G, G - 1 - bx};
            pg8::EpiKVUp E{KN, VM, SSQ};
            pg8::gemm_phase<pg8::EpiKVUp, pg8::SchedDense, true, false, false>(L, 4, NPROJ * 2, 512, S, E); }
#endif
    }
    SEAM(3);
    if (IN(4)) for (int rep_ = 0; rep_ < NREP(4); ++rep_) {
#ifndef NO_MLA
        for (int u = vcu; u < 512; u += G) {
            const int bh = u >> 5, qb = u & 31, b = bh >> 3, h = bh & 7; const size_t row0 = (size_t)b * SEQ + qb * 256, key0 = (size_t)b * SEQ;
            attn::attn_unit<0>(QN + row0 * 512 + h * 64, 512, QR + row0 * 256 + h * 32, 256, KN + key0 * 512 + h * 64, 512, KR + key0 * 32, 32, VM + key0 * 512 + h * 64, 512,
                               OMLA + row0 * 512 + h * 64, 128, 0, 128, 0, nullptr, (char*)lds);
        }
#endif
#ifndef NO_NA
        for (int u = vcu; u < 512; u += G) {
            const int bh = u >> 5, rb = u & 31, b = bh >> 3, h = bh & 7; const size_t row0 = (size_t)b * SEQ + rb * 256, key0 = (size_t)b * SEQ;
            const int krow0 = min(max(4 * rb - 4, 0), 120), klast = min(max(4 * rb + 3 - 4, 0), 120) + 7, ntreal = klast - krow0 + 1, NT = (ntreal + 1) & ~1;
            attn::attn_unit<1>(PROJ + row0 * NPROJ + h * 64, NPROJ, nullptr, 0, PROJ + key0 * NPROJ + 512 + h * 64, NPROJ, nullptr, 0, PROJ + key0 * NPROJ + 1024 + h * 64, NPROJ,
                               ONA + row0 * 512 + h * 64, NT, krow0, ntreal, 4 * rb, args.in[I_RPB] + h * 15 * 31, (char*)lds);
        }
#endif
    }
    SEAM(4);
    if (IN(5)) for (int rep_ = 0; rep_ < NREP(5); ++rep_) {
        pg8::SchedMerge S{(const char*)ONA, (const char*)OMLA, (const char*)WNAT, (const char*)WMLAT, MTOK / 256, 4, G, bx};
        pg8::EpiMerge E{PROJ, MERGED};
        pg8::gemm_phase<pg8::EpiMerge, pg8::SchedMerge, true, false, false, true>(L, 16, 1024, 1024, S, E);
    }
    SEAM(5);
    if (IN(6)) for (int rep_ = 0; rep_ < NREP(6); ++rep_) {
        pg8::SchedDense S{(const char*)MERGED, (const char*)WOUTT, (size_t)256 * 1024 * 2, (size_t)256 * 1024 * 2, MTOK / 256, 4, G, bx};
        pg8::EpiBf16Y E{(bf16_t*)TMP};
        pg8::gemm_phase<pg8::EpiBf16Y, pg8::SchedDense, true, false, false>(L, 16, 2048, 2048, S, E);
    }
    SEAM(6);
    if (IN(7)) {
        LAS int* sel_e = (LAS int*)(L + 0); LAS float* sel_g = (LAS float*)(L + 1024); LAS int* sel_r = (LAS int*)(L + 2048);
        LAS int* lcnt = (LAS int*)(L + 3072); LAS int* lbase = (LAS int*)(L + 3072 + 128);
        const float* gpo = args.in[I_GAPOST]; const float* gfp = args.in[I_GFPRE]; const float* br = args.in[I_BR];
        const float* WRT = (const float*)(ws + WS_WRT);
        for (int blk = vcu; blk < MTOK / 64; blk += G) {
            if (tid < 32) lcnt[tid] = 0;
            __syncthreads();
            f32x4 hreg[8][4];
#pragma unroll
            for (int rr = 0; rr < 8; ++rr) { const int m = blk * 64 + wave * 8 + rr, b = m >> 13;
                const GAS u32x2* yr = (const GAS u32x2*)((const bf16_t*)TMP + (size_t)m * DM) + lane; const GAS f32x4* xr = (const GAS f32x4*)(X + (size_t)m * DM) + lane;
                f32x4 y[4], x1[4]; float s = 0.f;
#pragma unroll
                for (int j = 0; j < 4; ++j) { const u32x2 yw = yr[64 * j]; y[j] = (f32x4){bf16_lo(yw.x), bf16_hi(yw.x), bf16_lo(yw.y), bf16_hi(yw.y)}; x1[j] = xr[64 * j]; s += (y[j].x * y[j].x + y[j].y * y[j].y) + (y[j].z * y[j].z + y[j].w * y[j].w); }
                const float rstd = __builtin_amdgcn_rsqf(wave_sum(s) * (1.f / DM) + RMS_EPS); float s2 = 0.f;
#pragma unroll
                for (int j = 0; j < 4; ++j) { const int col = 4 * lane + 256 * j;
                    const f32x4 gg = *(const f32x4*)(gpo + col), ga = *(const f32x4*)(MOD + b * 6144 + 2048 + col);
                    x1[j] = x1[j] + ga * (y[j] * rstd * gg);
                    *((GAS f32x4*)(OUT + (size_t)m * DM) + lane + 64 * j) = x1[j];
                    s2 += (x1[j].x * x1[j].x + x1[j].y * x1[j].y) + (x1[j].z * x1[j].z + x1[j].w * x1[j].w); }
                const float rstd2 = __builtin_amdgcn_rsqf(wave_sum(s2) * (1.f / DM) + RMS_EPS);
                GAS int* o4 = (GAS int*)((unsigned char*)XN + (size_t)m * DM) + lane;
#pragma unroll
                for (int j = 0; j < 4; ++j) { const int col = 4 * lane + 256 * j;
                    const f32x4 gg = *(const f32x4*)(gfp + col), sh = *(const f32x4*)(MOD + b * 6144 + 3072 + col), scl = *(const f32x4*)(MOD + b * 6144 + 4096 + col);
                    const f32x4 h = x1[j] * rstd2 * gg * (scl + 1.f) + sh;
                    int w = __builtin_amdgcn_cvt_pk_fp8_f32(h[0] * SC_H2, h[1] * SC_H2, 0, false); w = __builtin_amdgcn_cvt_pk_fp8_f32(h[2] * SC_H2, h[3] * SC_H2, w, true); o4[64 * j] = w;
                    hreg[rr][j] = h; }
            }
            const bool b5 = (lane & 32) != 0, b4 = (lane & 16) != 0, b3 = (lane & 8) != 0;
            float t0 = -3.0e38f, t1 = -3.0e38f, t2 = -3.0e38f, t3 = -3.0e38f; int i0 = 0, i1 = 0, i2 = 0, i3 = 0;
#pragma unroll 2
            for (int e = 0; e < NEXP; ++e) {
                f32x4 w[4];
#pragma unroll
                for (int j = 0; j < 4; ++j) w[j] = *(const GAS f32x4*)(WRT + e * 1024 + 4 * lane + 256 * j);
                float p[8];
#pragma unroll
                for (int r = 0; r < 8; ++r) { f32x4 a = hreg[r][0] * w[0]; a += hreg[r][1] * w[1]; a += hreg[r][2] * w[2]; a += hreg[r][3] * w[3]; p[r] = (a.x + a.y) + (a.z + a.w); }
                float q[4], u[2];
#pragma unroll
                for (int i = 0; i < 4; ++i) { const float keep = b5 ? p[i + 4] : p[i], send = b5 ? p[i] : p[i + 4]; q[i] = keep + __shfl_xor(send, 32); }
#pragma unroll
                for (int i = 0; i < 2; ++i) { const float keep = b4 ? q[i + 2] : q[i], send = b4 ? q[i] : q[i + 2]; u[i] = keep + __shfl_xor(send, 16); }
                float v = (b3 ? u[1] : u[0]) + __shfl_xor(b3 ? u[0] : u[1], 8);
                v += __shfl_xor(v, 4); v += __shfl_xor(v, 2); v += __shfl_xor(v, 1);
                v += br[e];
                const bool c0 = v > t0, c1 = v > t1, c2 = v > t2, c3 = v > t3;
                t3 = c2 ? t2 : (c3 ? v : t3); i3 = c2 ? i2 : (c3 ? e : i3);
                t2 = c1 ? t1 : (c2 ? v : t2); i2 = c1 ? i1 : (c2 ? e : i2);
                t1 = c0 ? t0 : (c1 ? v : t1); i1 = c0 ? i0 : (c1 ? e : i1);
                t0 = c0 ? v : t0;             i0 = c0 ? e : i0;
            }
            {   const float e1 = __builtin_amdgcn_exp2f((t1 - t0) * LOG2E), e2 = __builtin_amdgcn_exp2f((t2 - t0) * LOG2E), e3 = __builtin_amdgcn_exp2f((t3 - t0) * LOG2E);
                const float inv = 1.f / (1.f + e1 + e2 + e3);
                const int lrow = wave * 8 + (b5 ? 4 : 0) + (b4 ? 2 : 0) + (b3 ? 1 : 0), t = lane & 7;
                if (t < 4) { const int ee = t == 0 ? i0 : t == 1 ? i1 : t == 2 ? i2 : i3;
                    const float gg = (t == 0 ? 1.f : t == 1 ? e1 : t == 2 ? e2 : e3) * inv;
                    const int rk = __hip_atomic_fetch_add(&lcnt[ee], 1, __ATOMIC_RELAXED, __HIP_MEMORY_SCOPE_WORKGROUP);
                    sel_e[lrow * 4 + t] = ee; sel_g[lrow * 4 + t] = gg; sel_r[lrow * 4 + t] = rk; } }
            __syncthreads();
            if (tid < 32) lbase[tid] = (int)atomicAdd(CNT + tid, (unsigned)lcnt[tid]);
            __syncthreads();
            if (tid < 256) { const int ee = sel_e[tid], pos = lbase[ee] + sel_r[tid], tok = blk * 64 + (tid >> 2);
                LIST[(size_t)ee * LISTCAP + pos] = (unsigned)tok; TOKPOS[(size_t)tok * 4 + (tid & 3)] = ((unsigned)ee << 16) | (unsigned)pos; TOKG[(size_t)tok * 4 + (tid & 3)] = sel_g[tid]; }
            __syncthreads();
        }
    }
    SEAM(7);
    if (IN(8) || IN(9)) {
        LAS int* blk_e = (LAS int*)(L + TAB_BLK);
        if (tid == 0) { int nb = 0; for (int e = 0; e < NEXP; ++e) { const int c = (int)__hip_atomic_load(CNT + e, RLX_AGENT); const int n = (c + 255) >> 8; for (int i = 0; i < n; ++i) blk_e[nb + i] = e; nb += n; } MISC[16] = (unsigned)nb; }
        __syncthreads();
        const int NB = (int)MISC[16];
        if (IN(8)) for (int rep_ = 0; rep_ < NREP(8); ++rep_) {
            for (int i = 0;; ++i) { const long Lu = (long)i * G + bx; if (Lu >= (long)NB * 8 || i >= 11) break;
                const int grb = (int)(Lu >> 3), e = blk_e[grb]; int first = grb; while (first > 0 && blk_e[first - 1] == e) --first;
                const int cnt = (int)__hip_atomic_load(CNT + e, RLX_AGENT);
                if (tid < 256) { const int ri = (grb - first) * 256 + tid; const unsigned tok = (ri < cnt) ? LIST[(size_t)e * LISTCAP + ri] : 0u;
                    *(LAS unsigned*)(L + TAB_GATH + i * 1024 + tid * 4) = tok * 1024u; } }
            __syncthreads();
            pg8::SchedMoe<8, true> S{(const char*)XN, (const char*)W1T, (size_t)2048 * 1024, blk_e, NB, G, bx, TAB_GATH};
            pg8::EpiMoe1 E{args.in[I_B1], (unsigned char*)ACT};
            pg8::gemm_phase<pg8::EpiMoe1, pg8::SchedMoe<8, true>, true, true, true>(L, 8, 1024, 1024, S, E);
        }
        SEAM(8);
        if (IN(9)) for (int rep_ = 0; rep_ < NREP(9); ++rep_) {
            pg8::SchedMoe<4, false> S{(const char*)ACT, (const char*)W2T, (size_t)1024 * 1024, blk_e, NB, G, bx, 0};
            pg8::EpiMoe2 E{args.in[I_B2], YIT};
            pg8::gemm_phase<pg8::EpiMoe2, pg8::SchedMoe<4, false>, true, false, true>(L, 8, 1024, 1024, S, E);
        }
    }
    SEAM(9);
    if (IN(10)) {
        LAS int* rbase = (LAS int*)(L + 0);
        if (tid == 0) { int nb = 0; for (int e = 0; e < NEXP; ++e) { rbase[e] = nb * 256; nb += ((int)__hip_atomic_load(CNT + e, RLX_AGENT) + 255) >> 8; } }
        __syncthreads();
        const float* gfo = args.in[I_GFPOST];
        for (int m = gw; m < MTOK; m += NGW) { const int b = m >> 13;
            f32x4 y[4];
#pragma unroll
            for (int j = 0; j < 4; ++j) y[j] = (f32x4){0.f, 0.f, 0.f, 0.f};
#pragma unroll
            for (int t = 0; t < 4; ++t) { const unsigned tp = TOKPOS[(size_t)m * 4 + t]; const float gt = TOKG[(size_t)m * 4 + t];
                const size_t row = (size_t)rbase[tp >> 16] + (tp & 0xffffu); const GAS u32x2* yr = (const GAS u32x2*)(YIT + row * 1024) + lane;
#pragma unroll
                for (int j = 0; j < 4; ++j) { const u32x2 w = yr[64 * j]; y[j][0] += gt * bf16_lo(w.x); y[j][1] += gt * bf16_hi(w.x); y[j][2] += gt * bf16_lo(w.y); y[j][3] += gt * bf16_hi(w.y); } }
            float s = 0.f;
#pragma unroll
            for (int j = 0; j < 4; ++j) s += (y[j].x * y[j].x + y[j].y * y[j].y) + (y[j].z * y[j].z + y[j].w * y[j].w);
            const float rstd = __builtin_amdgcn_rsqf(wave_sum(s) * (1.f / DM) + RMS_EPS);
            GAS f32x4* orow = (GAS f32x4*)(OUT + (size_t)m * DM) + lane;
#pragma unroll
            for (int j = 0; j < 4; ++j) { const int col = 4 * lane + 256 * j;
                const f32x4 gg = *(const f32x4*)(gfo + col), gf = *(const f32x4*)(MOD + b * 6144 + 5120 + col);
                orow[64 * j] = orow[64 * j] + gf * (y[j] * rstd * gg); } }
    }
#undef IN
#undef SEAM
#undef args
}

constexpr int N_PHASES = 11;
extern "C" void kernel_launch(void* const* d_in, const int* in_sizes, int n_in, void* d_out, int out_size, void* d_ws, size_t ws_size, hipStream_t stream) {
    static int grid = 0;
    if (grid == 0) {
        if (n_in != 24 || out_size != MTOK * DM || ws_size < WS_END) { fprintf(stderr, "kernel_launch: unexpected shapes (n_in %d out %d ws %zu)\n", n_in, out_size, ws_size); grid = -1; return; }
        int dev = 0, cus = 0, per_cu = 0;
        if (hipGetDevice(&dev) != hipSuccess || hipDeviceGetAttribute(&cus, hipDeviceAttributeMultiprocessorCount, dev) != hipSuccess) { grid = -1; return; }
        if (hipFuncSetAttribute((const void*)fwd_kernel, hipFuncAttributeMaxDynamicSharedMemorySize, LDS_BYTES) != hipSuccess) { fprintf(stderr, "kernel_launch: hipFuncSetAttribute failed\n"); grid = -1; return; }
        if (hipOccupancyMaxActiveBlocksPerMultiprocessor(&per_cu, (const void*)fwd_kernel, NWAVES * 64, LDS_BYTES) != hipSuccess || per_cu < 1) { fprintf(stderr, "kernel_launch: occupancy query says %d\n", per_cu); per_cu = 1; }
        (void)hipGetLastError();
        grid = cus;
    }
    if (grid < 0) return;
    (void)hipMemsetAsync((char*)d_ws + WS_CTL + 16384, 0, 32768, stream);
    Args a{};
    for (int i = 0; i < 24; ++i) a.in[i] = (const float*)d_in[i];
    a.out = (float*)d_out; a.ws = (unsigned char*)d_ws;
#if MK_N_LAUNCHES == 1
    a.ph_lo = 0; a.ph_hi = N_PHASES;
    {   void* kargs[] = {(void*)&a};
        const hipError_t ce = hipLaunchCooperativeKernel((const void*)fwd_kernel, dim3(grid), dim3(NWAVES * 64), kargs, LDS_BYTES, stream);
        if (ce != hipSuccess) fprintf(stderr, "kernel_launch: cooperative launch failed: %s (grid %d)\n", hipGetErrorName(ce), grid); }
#else
    for (int p = 0; p < N_PHASES; ++p) { a.ph_lo = p; a.ph_hi = p + 1; hipLaunchKernelGGL(fwd_kernel, dim3(grid), dim3(NWAVES * 64), LDS_BYTES, stream, a); }
#endif
    const hipError_t le = hipPeekAtLastError();
    if (le != hipSuccess) fprintf(stderr, "kernel_launch: launch failed: %s\n", hipGetErrorName(le));
}
```

```cpp
#include <hip/hip_runtime.h>
#include <hip/hip_bf16.h>
#include <cstdio>
#include <cstdint>

#ifndef MK_N_LAUNCHES
#define MK_N_LAUNCHES 1
#endif

constexpr int BATCH = 2, SEQ = 8192, DM = 1024, MTOK = BATCH * SEQ;
constexpr int NPROJ = 4352;
constexpr int NEXP = 32, DFF = 1024, TOPK = 4;
constexpr int QLORA = 384, KVLORA = 256;
constexpr float RMS_EPS = 1e-6f;
constexpr float LOG2E = 1.4426950408889634f;
constexpr float C2NA = 0.125f * LOG2E;
constexpr float C2MLA = 0.10206207261596575f * LOG2E;
constexpr float SC_H2 = 8.f, SC_W = 64.f, SC_ACT = 4.f;
constexpr int NG_INPROJ = 168;
constexpr int LISTCAP = 16384;
constexpr int MAXROWS = 65536 + NEXP * 256;

#define GAS __attribute__((address_space(1)))
#define LAS __attribute__((address_space(3)))
typedef unsigned short bf16_t;
typedef short bf16x8 __attribute__((ext_vector_type(8)));
typedef short s16x4 __attribute__((ext_vector_type(4)));
typedef float f32x4 __attribute__((ext_vector_type(4)));
typedef float f32x2 __attribute__((ext_vector_type(2)));
typedef float f32x16 __attribute__((ext_vector_type(16)));
typedef unsigned u32x4 __attribute__((ext_vector_type(4)));
typedef unsigned u32x2 __attribute__((ext_vector_type(2)));
typedef GAS unsigned gu32;

__device__ __forceinline__ unsigned cvt_pk_bf16(float lo, float hi) { unsigned r; asm volatile("v_cvt_pk_bf16_f32 %0, %1, %2" : "=v"(r) : "v"(lo), "v"(hi)); return r; }
__device__ __forceinline__ float bf16_lo(unsigned w) { return __uint_as_float(w << 16); }
__device__ __forceinline__ float bf16_hi(unsigned w) { return __uint_as_float(w & 0xffff0000u); }
__device__ __forceinline__ float sigmoidf_(float z) { return __builtin_amdgcn_rcpf(1.f + __builtin_amdgcn_exp2f(-z * LOG2E)); }
__device__ __forceinline__ float wave_sum(float v) {
#pragma unroll
    for (int o = 1; o < 64; o <<= 1) v += __shfl_xor(v, o);
    return v;
}
__device__ __forceinline__ void rope_cs(float pos, int j, float& c, float& s) {
    const float inv = __builtin_amdgcn_exp2f(-(float)j * 0.83048202372184059f);
    const float rev = __builtin_amdgcn_fractf(pos * inv * 0.15915494309189535f);
    c = __builtin_amdgcn_cosf(rev); s = __builtin_amdgcn_sinf(rev);
}

namespace pg8 {
constexpr int BM = 256, BK = 64, HALF = 128, HTB = HALF * BK * 2, STAGE_BYTES = 8 * HTB, NXCD = 8, WGM = 8;
__host__ __device__ __forceinline__ int lds_byte(int r, int c) { const int st = (r >> 4) * 2 + (c >> 5), rr = r & 15, cc = c & 31, ob = rr * 64 + cc * 2; return st * 1024 + (ob ^ (((ob >> 9) & 1) << 5)); }
__host__ __device__ __forceinline__ void stage_rc(int b, int& R, int& C) { const int st = b / 1024, sb = b % 1024, swz = sb ^ (((sb >> 9) & 1) << 5); R = (st >> 1) * 16 + swz / 64; C = (st & 1) * 32 + (swz % 64) / 2; }
__host__ __device__ __forceinline__ int perm32(int rho) { const int n = rho >> 4, i = rho & 15; return 8 * (i >> 2) + 4 * n + (i & 3); }

struct Unit { const char* A; const char* B; const char* A2; const char* B2; int pm, pn, aux, tab; };

__device__ __forceinline__ void tile_of(int wgid, int nM, int nN, int& pm, int& pn) {
    const int nwg = nM * nN;
    { const int q = nwg / NXCD, r = nwg % NXCD, xcd = wgid % NXCD, off = wgid / NXCD; wgid = (xcd < r ? xcd * (q + 1) : r * (q + 1) + (xcd - r) * q) + off; }
    const int nig = WGM * nN, gid = wgid / nig, fm = gid * WGM, gsz = (nM - fm) < WGM ? (nM - fm) : WGM;
    pm = fm + ((wgid % nig) % gsz); pn = (wgid % nig) / gsz;
}

typedef int v8i32 __attribute__((ext_vector_type(8)));
typedef int v4i32_ __attribute__((ext_vector_type(4)));
template <class Epi, class Sched, bool ALIGN_EPI, bool GATHER, bool FP8, bool DUAL = false>
__device__ __forceinline__ void gemm_phase(LAS unsigned char* lds, const int nt, const int ldab, const int ldbb, const Sched& S, const Epi& E) {
    const int tid = threadIdx.x, wid = __builtin_amdgcn_readfirstlane(tid >> 6), lane = tid & 63, wr = wid >> 2, wc = wid & 3, fr = lane & 15, fq = lane >> 4;
    int Rr[2], Cc[2];
    unsigned voffA[2], voffB[2];
#pragma unroll
    for (int i = 0; i < 2; ++i) { int R, C; stage_rc(tid * 16 + i * 8192, R, C); const int Rb = Epi::PERM ? ((R & ~31) + perm32(R & 31)) : R;
        Rr[i] = R; Cc[i] = C; voffA[i] = (unsigned)(R * ldab + C * 2); voffB[i] = (unsigned)(Rb * ldbb + C * 2); }
    const size_t kstep = (size_t)(BK * 2);
    const size_t hstepA = (size_t)HALF * ldab, hstepB = (size_t)HALF * ldbb;
    const unsigned ldsw = (unsigned)wid * 1024u;
    const int aoff = lds_byte(wr * 64 + fr, fq * 8), boff = lds_byte(wc * 32 + fr, fq * 8);
#define PG8_SA(b, h) (((b) * 2 + (h)) * HTB)
#define PG8_SB(b, h) ((4 + (b) * 2 + (h)) * HTB)
#define PG8_STAGE(bufoff, gbase, voff) do { _Pragma("unroll") for (int _i = 0; _i < 2; ++_i) \
        __builtin_amdgcn_global_load_lds((const unsigned*)((const char*)(gbase) + (voff)[_i]), (LAS unsigned*)(lds + (bufoff) + ldsw + _i * 8192), 16, 0, 0); } while (0)
#define PG8_STAGE_A(bufoff, gbase, h, G) do { if constexpr (GATHER) { PG8_STAGE(bufoff, gbase, (G)[h]); } else { PG8_STAGE(bufoff, (gbase) + (h) * hstepA, voffA); } } while (0)
#define PG8_STAGE_B(bufoff, gbase, h) PG8_STAGE(bufoff, (gbase) + (h) * hstepB, voffB)
#define PG8_LD8(addr) __builtin_shufflevector(*(const LAS v4i32_*)(addr), *(const LAS v4i32_*)((addr) + 1024), 0, 1, 2, 3, 4, 5, 6, 7)
#define PG8_LDA(dst, b, h) do { if constexpr (FP8) { _Pragma("unroll") for (int m = 0; m < 4; ++m) dst##8[m] = PG8_LD8(lds + PG8_SA(b, h) + aoff + m * 2048); } \
        else { _Pragma("unroll") for (int m = 0; m < 4; ++m) _Pragma("unroll") for (int k = 0; k < 2; ++k) dst[m][k] = *(const LAS bf16x8*)(lds + PG8_SA(b, h) + aoff + m * 2048 + k * 1024); } } while (0)
#define PG8_LDB(dst, b, h) do { if constexpr (FP8) { _Pragma("unroll") for (int n = 0; n < 2; ++n) dst##8[n] = PG8_LD8(lds + PG8_SB(b, h) + boff + n * 2048); } \
        else { _Pragma("unroll") for (int n = 0; n < 2; ++n) _Pragma("unroll") for (int k = 0; k < 2; ++k) dst[n][k] = *(const LAS bf16x8*)(lds + PG8_SB(b, h) + boff + n * 2048 + k * 1024); } } while (0)
#define PG8_MMA(ai, bj, At, Bt) do { __builtin_amdgcn_s_setprio(1); _Pragma("unroll") for (int m = 0; m < 4; ++m) _Pragma("unroll") for (int n = 0; n < 2; ++n) { \
        if constexpr (FP8) { asm volatile("v_mfma_scale_f32_16x16x128_f8f6f4 %0, %1, %2, %0, %3, %3 op_sel_hi:[0,0,0]" : "+v"(acc[ai][bj][m][n]) : "v"(Bt##8[n]), "v"(At##8[m]), "v"(sc1_)); } \
        else { _Pragma("unroll") for (int k = 0; k < 2; ++k) acc[ai][bj][m][n] = __builtin_amdgcn_mfma_f32_16x16x32_bf16(Bt[n][k], At[m][k], acc[ai][bj][m][n], 0, 0, 0); } } \
        __builtin_amdgcn_s_setprio(0); } while (0)
#define PG8_WAIT_V(n) asm volatile("s_waitcnt vmcnt(" #n ")" ::: "memory")
#define PG8_WAIT_L(n) asm volatile("s_waitcnt lgkmcnt(" #n ")" ::: "memory")
#define PG8_BAR __builtin_amdgcn_s_barrier()
#define PG8_SCHED __builtin_amdgcn_sched_barrier(0)
    Unit cur, nxt; int ui = 0;
    if (!S.next(0, cur)) return;
    f32x4 acc[2][2][4][2];
#pragma unroll
    for (int a = 0; a < 2; ++a)
#pragma unroll
        for (int b = 0; b < 2; ++b)
#pragma unroll
            for (int m = 0; m < 4; ++m)
#pragma unroll
                for (int n = 0; n < 2; ++n) acc[a][b][m][n] = (f32x4){0.f, 0.f, 0.f, 0.f};
    bf16x8 At[4][2], B0[2][2], B1[2][2]; v8i32 At8[4], B08[2], B18[2];
    int sc1_ = 0x7F7F7F7F; asm volatile("" : "+v"(sc1_));
    unsigned gC[2][2], gN[2][2];
#define PG8_GLOAD(G, u) do { if constexpr (GATHER) { const LAS unsigned* tb_ = (const LAS unsigned*)(lds + (u).tab); _Pragma("unroll") for (int h_ = 0; h_ < 2; ++h_) _Pragma("unroll") for (int i_ = 0; i_ < 2; ++i_) \
        (G)[h_][i_] = tb_[h_ * 128 + Rr[i_]] + (unsigned)(Cc[i_] * 2); } } while (0)
    PG8_GLOAD(gC, cur);
    const char* cA = cur.A; const char* cB = cur.B; const char* cA2 = cur.A2; const char* cB2 = cur.B2; const int nth = nt >> 1;
    PG8_STAGE_B(PG8_SB(0, 0), cB, 0); PG8_STAGE_B(PG8_SB(0, 1), cB, 1); PG8_STAGE_A(PG8_SA(0, 0), cA, 0, gC); PG8_STAGE_A(PG8_SA(0, 1), cA, 1, gC);
    if (wr == 1) PG8_BAR;
    PG8_WAIT_V(2); PG8_BAR;
    PG8_STAGE_B(PG8_SB(1, 0), cB + kstep, 0); PG8_STAGE_A(PG8_SA(1, 0), cA + kstep, 0, gC); PG8_STAGE_B(PG8_SB(1, 1), cB + kstep, 1);
    PG8_WAIT_V(6); PG8_BAR;
    for (;;) {
        const bool has_next = S.next(ui + 1, nxt);
        const char* nA = has_next ? nxt.A : cA; const char* nB = has_next ? nxt.B : cB;
        if constexpr (GATHER) { if (has_next) { PG8_GLOAD(gN, nxt); } else {
#pragma unroll
            for (int h_ = 0; h_ < 2; ++h_)
#pragma unroll
                for (int i_ = 0; i_ < 2; ++i_) gN[h_][i_] = gC[h_][i_]; } }
#pragma unroll 1
        for (int t = 0; t < nt; t += 2) {
            const bool last = (t == nt - 2);
            if constexpr (DUAL) { if (t == nth) E.mid(acc, cur, wr, wc, fr, fq); }
#define PG8_TILEA(tt) (((DUAL && (tt) >= nth) ? cA2 - (size_t)nth * kstep : cA) + (size_t)(tt) * kstep)
#define PG8_TILEB(tt) (((DUAL && (tt) >= nth) ? cB2 - (size_t)nth * kstep : cB) + (size_t)(tt) * kstep)
            const char* a1 = PG8_TILEA(t + 1);
            const char* a2 = last ? nA : PG8_TILEA(t + 2); const char* b2 = last ? nB : PG8_TILEB(t + 2);
            const char* a3 = a2 + kstep; const char* b3 = b2 + kstep;
            unsigned g2[2][2];
            if constexpr (GATHER) {
#pragma unroll
                for (int h_ = 0; h_ < 2; ++h_)
#pragma unroll
                    for (int i_ = 0; i_ < 2; ++i_) g2[h_][i_] = last ? gN[h_][i_] : gC[h_][i_]; }
            PG8_LDB(B0, 0, 0); PG8_LDB(B1, 0, 1); PG8_SCHED; PG8_LDA(At, 0, 0); PG8_STAGE_A(PG8_SA(1, 1), a1, 1, gC);
            PG8_WAIT_V(8); PG8_WAIT_L(0); PG8_BAR; PG8_MMA(0, 0, At, B0); PG8_MMA(0, 1, At, B1); PG8_BAR; PG8_SCHED;
            PG8_LDA(At, 0, 1); PG8_STAGE_B(PG8_SB(0, 0), b2, 0); PG8_STAGE_B(PG8_SB(0, 1), b2, 1); PG8_STAGE_A(PG8_SA(0, 0), a2, 0, g2);
            PG8_WAIT_V(8); PG8_WAIT_L(0); PG8_BAR; PG8_MMA(1, 0, At, B0); PG8_MMA(1, 1, At, B1); PG8_BAR; PG8_SCHED;
            PG8_LDB(B0, 1, 0); PG8_LDB(B1, 1, 1); PG8_SCHED; PG8_LDA(At, 1, 0); PG8_STAGE_A(PG8_SA(0, 1), a2, 1, g2);
            PG8_WAIT_V(8); PG8_WAIT_L(0); PG8_BAR; PG8_MMA(0, 0, At, B0); PG8_MMA(0, 1, At, B1); PG8_BAR; PG8_SCHED;
            PG8_LDA(At, 1, 1); PG8_STAGE_B(PG8_SB(1, 0), b3, 0); PG8_STAGE_B(PG8_SB(1, 1), b3, 1); PG8_STAGE_A(PG8_SA(1, 0), a3, 0, g2);
            PG8_WAIT_V(8); PG8_WAIT_L(0); PG8_BAR; PG8_MMA(1, 0, At, B0); PG8_MMA(1, 1, At, B1); PG8_BAR; PG8_SCHED;
        }
        if constexpr (ALIGN_EPI) { if (wr == 0) PG8_BAR; }
        if constexpr (FP8) asm volatile("s_nop 15\n\ts_nop 15" ::: "memory");
        E(acc, cur, wr, wc, fr, fq);
        if (!has_next) break;
#pragma unroll
        for (int a = 0; a < 2; ++a)
#pragma unroll
            for (int b = 0; b < 2; ++b)
#pragma unroll
                for (int m = 0; m < 4; ++m)
#pragma unroll
                    for (int n = 0; n < 2; ++n) acc[a][b][m][n] = (f32x4){0.f, 0.f, 0.f, 0.f};
        cur = nxt; cA = nA; cB = nB; cA2 = cur.A2; cB2 = cur.B2; ++ui;
        if constexpr (GATHER) {
#pragma unroll
            for (int h_ = 0; h_ < 2; ++h_)
#pragma unroll
                for (int i_ = 0; i_ < 2; ++i_) gC[h_][i_] = gN[h_][i_]; }
        if constexpr (ALIGN_EPI) { if (wr == 1) PG8_BAR; }
    }
    PG8_WAIT_V(0);
    if constexpr (!ALIGN_EPI) { if (wr == 0) PG8_BAR; }
    PG8_BAR;
#undef PG8_SA
#undef PG8_SB
#undef PG8_STAGE
#undef PG8_STAGE_A
#undef PG8_STAGE_B
#undef PG8_LDA
#undef PG8_LD8
#undef PG8_LDB
#undef PG8_MMA
#undef PG8_WAIT_V
#undef PG8_WAIT_L
#undef PG8_BAR
#undef PG8_SCHED
#undef PG8_GLOAD
#undef PG8_TILEA
#undef PG8_TILEB
}

typedef f32x4 Acc[2][2][4][2];

struct SchedDense {
    const char* A; const char* B; size_t a_tile_bytes, b_tile_bytes; int nM, nN, G, c;
    __device__ __forceinline__ bool next(int i, Unit& u) const {
        const long L = (long)i * G + c; if (L >= (long)nM * nN) return false;
        int pm, pn; tile_of((int)L, nM, nN, pm, pn);
        u.pm = pm; u.pn = pn; u.aux = 0; u.tab = 0; u.A = A + (size_t)pm * a_tile_bytes; u.B = B + (size_t)pn * b_tile_bytes; u.A2 = u.A; u.B2 = u.B; return true;
    }
};
struct SchedMerge {
    const char* A0; const char* A1; const char* B0; const char* B1; int nM, nN, G, c;
    __device__ __forceinline__ bool next(int i, Unit& u) const {
        const long T = (long)i * G + c; if (T >= (long)nM * nN) return false;
        int pm, pn; tile_of((int)T, nM, nN, pm, pn);
        u.pm = pm; u.pn = pn; u.aux = 0; u.tab = 0;
        u.A = A0 + (size_t)pm * (256 * 512 * 2); u.B = B0 + (size_t)pn * (256 * 512 * 2); u.A2 = A1 + (size_t)pm * (256 * 512 * 2); u.B2 = B1 + (size_t)pn * (256 * 512 * 2); return true;
    }
};
template <int NPN, bool GATHER>
struct SchedMoe {
    const char* A; const char* B; size_t b_expert_bytes; LAS const int* blk_e; int NB, G, c, tab0;
    __device__ __forceinline__ bool next(int i, Unit& u) const {
        const long L = (long)i * G + c; if (L >= (long)NB * NPN) return false;
        const int grb = (int)(L / NPN), pn = (int)(L % NPN);
        const int e = __builtin_amdgcn_readfirstlane(blk_e[grb]);
        u.pm = grb; u.pn = pn; u.aux = e; u.tab = tab0 + i * 1024;
        u.A = GATHER ? A : A + (size_t)grb * (256 * 1024);
        u.B = B + (size_t)e * b_expert_bytes + (size_t)pn * (256 * 1024); u.A2 = u.A; u.B2 = u.B; return true;
    }
};

struct EpiInProj {
    static constexpr bool PERM = true;
    bf16_t* PROJ; float* SSQ; bf16_t* KR; const float* ROPE; const float* bgate;
    __device__ __forceinline__ void operator()(const Acc& acc, const Unit& u, int wr, int wc, int fr, int fq) const {
        const int pn = u.pn, row0 = u.pm * BM + wr * 64 + fr, colb = pn * BM + wc * 32 + 8 * fq;
        const float sc = (pn < 2) ? C2NA : 1.f;
        f32x4 gb[2][2];
#pragma unroll
        for (int bj = 0; bj < 2; ++bj)
#pragma unroll
            for (int n = 0; n < 2; ++n) gb[bj][n] = (pn >= 9) ? *(const f32x4*)(bgate + (colb - 2304) + bj * HALF + 4 * n) : (f32x4){0.f, 0.f, 0.f, 0.f};
#pragma unroll
        for (int ai = 0; ai < 2; ++ai)
#pragma unroll
            for (int m = 0; m < 4; ++m) { const int row = row0 + ai * HALF + m * 16; bf16_t* rowp = PROJ + (size_t)row * NPROJ + colb;
#pragma unroll
                for (int bj = 0; bj < 2; ++bj) { const f32x4 v0 = acc[ai][bj][m][0] * sc + gb[bj][0], v1 = acc[ai][bj][m][1] * sc + gb[bj][1]; u32x4 w;
                    w.x = cvt_pk_bf16(v0[0], v0[1]); w.y = cvt_pk_bf16(v0[2], v0[3]); w.z = cvt_pk_bf16(v1[0], v1[1]); w.w = cvt_pk_bf16(v1[2], v1[3]);
                    *(u32x4*)(rowp + bj * HALF) = w; } }
        if (pn >= 6 && pn <= 8) {
#pragma unroll
            for (int ai = 0; ai < 2; ++ai)
#pragma unroll
                for (int m = 0; m < 4; ++m) { const int row = row0 + ai * HALF + m * 16; float s[2];
#pragma unroll
                    for (int bj = 0; bj < 2; ++bj) { const f32x4 a = acc[ai][bj][m][0], b = acc[ai][bj][m][1];
                        float t = (a[0] * a[0] + a[1] * a[1]) + (a[2] * a[2] + a[3] * a[3]) + (b[0] * b[0] + b[1] * b[1]) + (b[2] * b[2] + b[3] * b[3]);
                        t += __shfl_xor(t, 16); t += __shfl_xor(t, 32); s[bj] = t; }
                    if (fq == 0) {
                        float* sp = SSQ + (size_t)row * 16 + wc;
                        if (pn == 6) { sp[0] = s[0] + s[1]; }
                        else if (pn == 7) { sp[4] = s[0]; sp[8] = s[1]; }
                        else { sp[12] = s[0]; }
                    } }
            if (pn == 8 && wc == 0) {
#pragma unroll
                for (int ai = 0; ai < 2; ++ai)
#pragma unroll
                    for (int m = 0; m < 4; ++m) { const int row = row0 + ai * HALF + m * 16, tok = row & (SEQ - 1);
                        const int pos = (fq >> 1) ? (tok & 63) : (tok >> 6); float o[8];
                        const f32x4 cs4 = *(const f32x4*)(ROPE + pos * 16 + 4 * (fq & 1)), sn4 = *(const f32x4*)(ROPE + pos * 16 + 8 + 4 * (fq & 1));
#pragma unroll
                        for (int n = 0; n < 2; ++n)
#pragma unroll
                            for (int q = 0; q < 2; ++q) { const float c = cs4[2 * n + q], s = sn4[2 * n + q];
                                const float x1 = acc[ai][1][m][n][2 * q], x2 = acc[ai][1][m][n][2 * q + 1];
                                o[4 * n + 2 * q] = x1 * c - x2 * s; o[4 * n + 2 * q + 1] = x1 * s + x2 * c; }
                        u32x4 w; w.x = cvt_pk_bf16(o[0], o[1]); w.y = cvt_pk_bf16(o[2], o[3]); w.z = cvt_pk_bf16(o[4], o[5]); w.w = cvt_pk_bf16(o[6], o[7]);
                        *(u32x4*)(KR + (size_t)row * 32 + 8 * fq) = w; }
            }
        }
    }
};
struct EpiQUp {
    static constexpr bool PERM = true;
    bf16_t* QN; bf16_t* QR; const float* SSQ; const float* ROPE;
    __device__ __forceinline__ void operator()(const Acc& acc, const Unit& u, int wr, int wc, int fr, int fq) const {
        const int pn = u.pn, row0 = u.pm * BM + wr * 64 + fr, colt = wc * 32 + 8 * fq;
#pragma unroll
        for (int ai = 0; ai < 2; ++ai)
#pragma unroll
            for (int m = 0; m < 4; ++m) { const int row = row0 + ai * HALF + m * 16;
                const f32x4 q0_ = *(const f32x4*)(SSQ + (size_t)row * 16), q1_ = *(const f32x4*)(SSQ + (size_t)row * 16 + 4);
                const float rs = __builtin_amdgcn_rsqf((((q0_[0] + q0_[1]) + (q0_[2] + q0_[3])) + ((q1_[0] + q1_[1]) + (q1_[2] + q1_[3]))) * (1.f / QLORA) + RMS_EPS) * C2MLA;
                if (pn < 2) {
#pragma unroll
                    for (int bj = 0; bj < 2; ++bj) { const f32x4 v0 = acc[ai][bj][m][0] * rs, v1 = acc[ai][bj][m][1] * rs; u32x4 w;
                        w.x = cvt_pk_bf16(v0[0], v0[1]); w.y = cvt_pk_bf16(v0[2], v0[3]); w.z = cvt_pk_bf16(v1[0], v1[1]); w.w = cvt_pk_bf16(v1[2], v1[3]);
                        *(u32x4*)(QN + (size_t)row * 512 + pn * 256 + bj * HALF + colt) = w; }
                } else {
                    const int tok = row & (SEQ - 1); const int pos = (fq >> 1) ? (tok & 63) : (tok >> 6);
                    const f32x4 cs4 = *(const f32x4*)(ROPE + pos * 16 + 4 * (fq & 1)), sn4 = *(const f32x4*)(ROPE + pos * 16 + 8 + 4 * (fq & 1));
#pragma unroll
                    for (int bj = 0; bj < 2; ++bj) { float o[8];
#pragma unroll
                        for (int n = 0; n < 2; ++n)
#pragma unroll
                            for (int q = 0; q < 2; ++q) { const float c = cs4[2 * n + q], s = sn4[2 * n + q];
                                const float x1 = acc[ai][bj][m][n][2 * q] * rs, x2 = acc[ai][bj][m][n][2 * q + 1] * rs;
                                o[4 * n + 2 * q] = x1 * c - x2 * s; o[4 * n + 2 * q + 1] = x1 * s + x2 * c; }
                        u32x4 w; w.x = cvt_pk_bf16(o[0], o[1]); w.y = cvt_pk_bf16(o[2], o[3]); w.z = cvt_pk_bf16(o[4], o[5]); w.w = cvt_pk_bf16(o[6], o[7]);
                        *(u32x4*)(QR + (size_t)row * 256 + bj * HALF + colt) = w; }
                }
                asm volatile("" ::: "memory"); }
    }
};
struct EpiKVUp {
    static constexpr bool PERM = true;
    bf16_t* KN; bf16_t* VM; const float* SSQ;
    __device__ __forceinline__ void operator()(const Acc& acc, const Unit& u, int wr, int wc, int fr, int fq) const {
        const int pn = u.pn, row0 = u.pm * BM + wr * 64 + fr, colt = wc * 32 + 8 * fq;
        bf16_t* dst = (pn < 2) ? KN + pn * 256 : VM + (pn - 2) * 256;
#pragma unroll
        for (int ai = 0; ai < 2; ++ai)
#pragma unroll
            for (int m = 0; m < 4; ++m) { const int row = row0 + ai * HALF + m * 16;
                const f32x4 q0_ = *(const f32x4*)(SSQ + (size_t)row * 16 + 8), q1_ = *(const f32x4*)(SSQ + (size_t)row * 16 + 12);
                const float rs = __builtin_amdgcn_rsqf((((q0_[0] + q0_[1]) + (q0_[2] + q0_[3])) + ((q1_[0] + q1_[1]) + (q1_[2] + q1_[3]))) * (1.f / KVLORA) + RMS_EPS);
#pragma unroll
                for (int bj = 0; bj < 2; ++bj) { const f32x4 v0 = acc[ai][bj][m][0] * rs, v1 = acc[ai][bj][m][1] * rs; u32x4 w;
                    w.x = cvt_pk_bf16(v0[0], v0[1]); w.y = cvt_pk_bf16(v0[2], v0[3]); w.z = cvt_pk_bf16(v1[0], v1[1]); w.w = cvt_pk_bf16(v1[2], v1[3]);
                    *(u32x4*)(dst + (size_t)row * 512 + bj * HALF + colt) = w; } }
    }
};
struct EpiMerge {
    static constexpr bool PERM = true;
    const bf16_t* PROJ; bf16_t* MERGED;
    __device__ __forceinline__ void mid(Acc& acc, const Unit& u, int wr, int wc, int fr, int fq) const {
        int row0 = u.pm * BM + wr * 64 + fr; const int col0 = u.pn * BM + wc * 32 + 8 * fq;
        asm volatile("" : "+v"(row0));
#pragma unroll
        for (int ai = 0; ai < 2; ++ai)
#pragma unroll
            for (int m = 0; m < 4; ++m) { const bf16_t* rp = PROJ + (size_t)(row0 + ai * HALF + m * 16) * NPROJ + 2304 + col0;
#pragma unroll
                for (int bj = 0; bj < 2; ++bj) { const u32x4 g1 = *(const u32x4*)(rp + bj * HALF), g2 = *(const u32x4*)(rp + 1024 + bj * HALF);
                    const unsigned w1[4] = {g1.x, g1.y, g1.z, g1.w}, w2[4] = {g2.x, g2.y, g2.z, g2.w};
#pragma unroll
                    for (int q = 0; q < 4; ++q) { const int n = q >> 1, i = (q & 1) * 2;
                        const float r0 = (1.f + __builtin_amdgcn_exp2f(-bf16_lo(w2[q]) * LOG2E)) * __builtin_amdgcn_rcpf(1.f + __builtin_amdgcn_exp2f(-bf16_lo(w1[q]) * LOG2E));
                        const float r1 = (1.f + __builtin_amdgcn_exp2f(-bf16_hi(w2[q]) * LOG2E)) * __builtin_amdgcn_rcpf(1.f + __builtin_amdgcn_exp2f(-bf16_hi(w1[q]) * LOG2E));
                        acc[ai][bj][m][n][i] *= r0; acc[ai][bj][m][n][i + 1] *= r1; } }
                asm volatile("" ::: "memory"); }
    }
    __device__ __forceinline__ void operator()(const Acc& acc, const Unit& u, int wr, int wc, int fr, int fq) const {
        const int row0 = u.pm * BM + wr * 64 + fr, col0 = u.pn * BM + wc * 32 + 8 * fq;
#pragma unroll
        for (int ai = 0; ai < 2; ++ai)
#pragma unroll
            for (int m = 0; m < 4; ++m) { const int row = row0 + ai * HALF + m * 16; const bf16_t* rp = PROJ + (size_t)row * NPROJ + 3328 + col0;
#pragma unroll
                for (int bj = 0; bj < 2; ++bj) { const u32x4 g2 = *(const u32x4*)(rp + bj * HALF);
                    f32x4 s0, s1;
                    s0[0] = sigmoidf_(bf16_lo(g2.x)); s0[1] = sigmoidf_(bf16_hi(g2.x)); s0[2] = sigmoidf_(bf16_lo(g2.y)); s0[3] = sigmoidf_(bf16_hi(g2.y));
                    s1[0] = sigmoidf_(bf16_lo(g2.z)); s1[1] = sigmoidf_(bf16_hi(g2.z)); s1[2] = sigmoidf_(bf16_lo(g2.w)); s1[3] = sigmoidf_(bf16_hi(g2.w));
                    const f32x4 v0 = acc[ai][bj][m][0] * s0, v1 = acc[ai][bj][m][1] * s1; u32x4 w;
                    w.x = cvt_pk_bf16(v0[0], v0[1]); w.y = cvt_pk_bf16(v0[2], v0[3]); w.z = cvt_pk_bf16(v1[0], v1[1]); w.w = cvt_pk_bf16(v1[2], v1[3]);
                    *(u32x4*)(MERGED + (size_t)row * 1024 + col0 + bj * HALF) = w; }
                asm volatile("" ::: "memory"); }
    }
};
struct EpiBf16Y {
    static constexpr bool PERM = true;
    bf16_t* C;
    __device__ __forceinline__ void operator()(const Acc& acc, const Unit& u, int wr, int wc, int fr, int fq) const {
        const int row0 = u.pm * BM + wr * 64 + fr, col0 = u.pn * BM + wc * 32 + 8 * fq;
#pragma unroll
        for (int ai = 0; ai < 2; ++ai)
#pragma unroll
            for (int m = 0; m < 4; ++m) { bf16_t* rowp = C + (size_t)(row0 + ai * HALF + m * 16) * 1024 + col0;
#pragma unroll
                for (int bj = 0; bj < 2; ++bj) { const f32x4 v0 = acc[ai][bj][m][0], v1 = acc[ai][bj][m][1]; u32x4 w;
                    w.x = cvt_pk_bf16(v0[0], v0[1]); w.y = cvt_pk_bf16(v0[2], v0[3]); w.z = cvt_pk_bf16(v1[0], v1[1]); w.w = cvt_pk_bf16(v1[2], v1[3]);
                    *(u32x4*)(rowp + bj * HALF) = w; } }
    }
};
struct EpiMoe1 {
    static constexpr bool PERM = true;
    const float* b1; unsigned char* ACT;
    __device__ __forceinline__ void operator()(const Acc& acc, const Unit& u, int wr, int wc, int fr, int fq) const {
        const int e = u.aux, row0 = u.pm * BM + wr * 64 + fr, col0 = u.pn * BM + wc * 32 + 8 * fq;
        constexpr float DS = 1.f / (SC_H2 * SC_W);
        f32x4 bv[2][2];
#pragma unroll
        for (int bj = 0; bj < 2; ++bj)
#pragma unroll
            for (int n = 0; n < 2; ++n) bv[bj][n] = *(const f32x4*)(b1 + (size_t)e * 2048 + col0 + bj * HALF + 4 * n);
#pragma unroll
        for (int ai = 0; ai < 2; ++ai)
#pragma unroll
            for (int m = 0; m < 4; ++m) { const int row = row0 + ai * HALF + m * 16;
#pragma unroll
                for (int bj = 0; bj < 2; ++bj) { float o[4];
#pragma unroll
                    for (int n = 0; n < 2; ++n) { const f32x4 v = acc[ai][bj][m][n] * DS + bv[bj][n];
#pragma unroll
                        for (int q = 0; q < 2; ++q) { const float xg = fminf(v[2 * q], 7.f), xl = fminf(fmaxf(v[2 * q + 1], -7.f), 7.f);
                            o[2 * n + q] = xg * sigmoidf_(1.702f * xg) * (xl + 1.f) * SC_ACT; } }
                    int w = __builtin_amdgcn_cvt_pk_fp8_f32(o[0], o[1], 0, false); w = __builtin_amdgcn_cvt_pk_fp8_f32(o[2], o[3], w, true);
                    *(int*)(ACT + (size_t)row * 1024 + ((col0 + bj * HALF) >> 1)) = w; } }
    }
};
struct EpiMoe2 {
    static constexpr bool PERM = true;
    const float* b2; bf16_t* YIT;
    __device__ __forceinline__ void operator()(const Acc& acc, const Unit& u, int wr, int wc, int fr, int fq) const {
        const int e = u.aux, row0 = u.pm * BM + wr * 64 + fr, col0 = u.pn * BM + wc * 32 + 8 * fq;
        f32x4 bv[2][2];
#pragma unroll
        for (int bj = 0; bj < 2; ++bj)
#pragma unroll
            for (int n = 0; n < 2; ++n) bv[bj][n] = *(const f32x4*)(b2 + (size_t)e * 1024 + col0 + bj * HALF + 4 * n);
#pragma unroll
        for (int ai = 0; ai < 2; ++ai)
#pragma unroll
            for (int m = 0; m < 4; ++m) { const int row = row0 + ai * HALF + m * 16;
#pragma unroll
                for (int bj = 0; bj < 2; ++bj) { const f32x4 v0 = acc[ai][bj][m][0] * (1.f / (SC_ACT * SC_W)) + bv[bj][0], v1 = acc[ai][bj][m][1] * (1.f / (SC_ACT * SC_W)) + bv[bj][1]; u32x4 w;
                    w.x = cvt_pk_bf16(v0[0], v0[1]); w.y = cvt_pk_bf16(v0[2], v0[3]); w.z = cvt_pk_bf16(v1[0], v1[1]); w.w = cvt_pk_bf16(v1[2], v1[3]);
                    *(u32x4*)(YIT + (size_t)row * 1024 + col0 + bj * HALF) = w; } }
    }
};
}

namespace attn {
#define SBAR() __builtin_amdgcn_sched_barrier(0)
constexpr int NW = 8, QBLK = 32, KVBLK = 64;
constexpr float THR = 8.f;
__device__ __forceinline__ int crow(int r, int hi) { return (r & 3) + 8 * (r >> 2) + 4 * hi; }
constexpr int KROW_MLA = 96 * 2 + 16, KROW_NA = 64 * 2 + 16;
constexpr int SHM_K = 64 * KROW_MLA  , SHM_V = 64 * 64 * 2  ;
constexpr int OFF_V = 0, OFF_K = 4 * SHM_V, OFF_WS = OFF_K + 4 * SHM_K, OFF_OST = OFF_WS + NW * 256, OFF_BIAS = OFF_OST + NW * 4096, ATTN_LDS = OFF_BIAS + 2048;

__device__ __forceinline__ int v_st(int k, int c) { const int kk = (k & ~0xC) | ((k & 4) << 1) | ((k & 8) >> 1); return ((kk >> 3) * 2 + (c >> 5)) * 512 + ((kk & 7) * 32 + (c & 31)) * 2; }
__device__ __forceinline__ int v_rd_base(int lane) { return ((lane & 3) << 3) | (((lane >> 2) & 3) << 6) | (((lane >> 4) & 1) << 5) | (((lane >> 5) & 1) << 8); }
constexpr int v_rd_off(int d0, int ks, int half) { return d0 * 512 + ks * 2048 + half * 1024; }
template <int OFF> __device__ __forceinline__ s16x4 tr_read(int vb) {
    s16x4 r; asm volatile("ds_read_b64_tr_b16 %0, %1 offset:%2" : "=&v"(r) : "v"(vb), "i"(OFF) : "memory"); return r;
}
template <int D0> __device__ __forceinline__ void pv_one(f32x16& od, int vb, bf16x8 pa0, bf16x8 pa1, bf16x8 pa2, bf16x8 pa3) {
    const s16x4 l0 = tr_read<v_rd_off(D0, 0, 0)>(vb), h0 = tr_read<v_rd_off(D0, 0, 1)>(vb), l1 = tr_read<v_rd_off(D0, 1, 0)>(vb), h1 = tr_read<v_rd_off(D0, 1, 1)>(vb);
    const s16x4 l2 = tr_read<v_rd_off(D0, 2, 0)>(vb), h2 = tr_read<v_rd_off(D0, 2, 1)>(vb), l3 = tr_read<v_rd_off(D0, 3, 0)>(vb), h3 = tr_read<v_rd_off(D0, 3, 1)>(vb);
    asm volatile("s_waitcnt lgkmcnt(0)" ::: "memory"); SBAR();
#define PK(L, H) (bf16x8){L[0], L[1], L[2], L[3], H[0], H[1], H[2], H[3]}
    od = __builtin_amdgcn_mfma_f32_32x32x16_bf16(pa0, PK(l0, h0), od, 0, 0, 0);
    od = __builtin_amdgcn_mfma_f32_32x32x16_bf16(pa1, PK(l1, h1), od, 0, 0, 0);
    od = __builtin_amdgcn_mfma_f32_32x32x16_bf16(pa2, PK(l2, h2), od, 0, 0, 0);
    od = __builtin_amdgcn_mfma_f32_32x32x16_bf16(pa3, PK(l3, h3), od, 0, 0, 0);
#undef PK
}
__device__ __forceinline__ void pv_d0(f32x16* o, int vb, bf16x8 pa0, bf16x8 pa1, bf16x8 pa2, bf16x8 pa3) {
    pv_one<0>(o[0], vb, pa0, pa1, pa2, pa3); pv_one<1>(o[1], vb, pa0, pa1, pa2, pa3);
}
__device__ __forceinline__ void partialSM(f32x16& p0, f32x16& p1, float& m_ref, f32x16& negm, float& alpha, bool& fresh) {
    float pmax = p0[0];
#pragma unroll
    for (int r = 1; r < 16; ++r) pmax = fmaxf(pmax, p0[r]);
#pragma unroll
    for (int r = 0; r < 16; ++r) pmax = fmaxf(pmax, p1[r]);
    { auto rr = __builtin_amdgcn_permlane32_swap(__float_as_uint(pmax), __float_as_uint(pmax), false, false);
      pmax = fmaxf(__uint_as_float(rr[0]), __uint_as_float(rr[1])); }
    alpha = 1.f;
    if (__builtin_expect(fresh || !__all(pmax <= THR), 0)) {
        const float dl = fresh ? pmax : fmaxf(pmax, 0.f);
        m_ref += dl;
#pragma unroll
        for (int r = 0; r < 16; ++r) { p0[r] -= dl; p1[r] -= dl; }
        const float nm = -m_ref;
#pragma unroll
        for (int r = 0; r < 16; ++r) negm[r] = nm;
        alpha = fresh ? 1.f : __builtin_amdgcn_exp2f(-dl);
        fresh = false;
    }
#pragma unroll
    for (int r = 0; r < 16; ++r) p0[r] = __builtin_amdgcn_exp2f(p0[r]);
}
__device__ __forceinline__ void finishSM(f32x16& p0, f32x16& p1, float alpha, float& l_reg, bf16x8& pa0, bf16x8& pa1, bf16x8& pa2, bf16x8& pa3) {
#pragma unroll
    for (int r = 0; r < 16; ++r) p1[r] = __builtin_amdgcn_exp2f(p1[r]);
    float ps = 0;
#pragma unroll
    for (int r = 0; r < 16; ++r) ps += p0[r];
#pragma unroll
    for (int r = 0; r < 16; ++r) ps += p1[r];
    { auto rr = __builtin_amdgcn_permlane32_swap(__float_as_uint(ps), __float_as_uint(ps), false, false);
      ps = __uint_as_float(rr[0]) + __uint_as_float(rr[1]); }
    l_reg = l_reg * alpha + ps;
#define PK4(P, BASE, OUT) do { unsigned a0 = cvt_pk_bf16(P[BASE + 0], P[BASE + 1]), a1 = cvt_pk_bf16(P[BASE + 2], P[BASE + 3]);   \
    unsigned b0 = cvt_pk_bf16(P[BASE + 4], P[BASE + 5]), b1 = cvt_pk_bf16(P[BASE + 6], P[BASE + 7]);                              \
    auto r0 = __builtin_amdgcn_permlane32_swap(a0, b0, false, false); auto r1 = __builtin_amdgcn_permlane32_swap(a1, b1, false, false); \
    u32x4 w = {r0[0], r1[0], r0[1], r1[1]}; OUT = *reinterpret_cast<bf16x8*>(&w); } while (0)
    PK4(p0, 0, pa0); PK4(p0, 8, pa1); PK4(p1, 0, pa2); PK4(p1, 8, pa3);
#undef PK4
}
template <int ND0, int KROW>
__device__ __forceinline__ void qkt(f32x16& p0, f32x16& p1, const char* Ks, const bf16x8* qr, const f32x16& negm, int r32, int hi) {
#pragma unroll
    for (int d0 = 0; d0 < ND0; ++d0) { const int cb = (d0 * 16 + hi * 8) * 2;
        const bf16x8 b0 = *reinterpret_cast<const bf16x8*>(Ks + r32 * KROW + cb);
        const bf16x8 b1 = *reinterpret_cast<const bf16x8*>(Ks + (32 + r32) * KROW + cb);
        if (d0 == 0) { p0 = __builtin_amdgcn_mfma_f32_32x32x16_bf16(b0, qr[0], negm, 0, 0, 0); p1 = __builtin_amdgcn_mfma_f32_32x32x16_bf16(b1, qr[0], negm, 0, 0, 0); }
        else { p0 = __builtin_amdgcn_mfma_f32_32x32x16_bf16(b0, qr[d0], p0, 0, 0, 0); p1 = __builtin_amdgcn_mfma_f32_32x32x16_bf16(b1, qr[d0], p1, 0, 0, 0); } }
}

template <int MODE>
__device__ __forceinline__ void attn_unit(const bf16_t* __restrict__ Qa, int ldqa, const bf16_t* __restrict__ Qb, int ldqb,
                                          const bf16_t* __restrict__ Ka, int ldka, const bf16_t* __restrict__ Kb, int ldkb, const bf16_t* __restrict__ Vv, int ldv,
                                          bf16_t* __restrict__ O, int NT, int krow0, int ntreal, int qrow0, const float* __restrict__ rpbh, char* lds) {
    constexpr int ND0 = MODE == 0 ? 6 : 4, KROW = MODE == 0 ? KROW_MLA : KROW_NA;
    const int tid = threadIdx.x, wid = __builtin_amdgcn_readfirstlane(tid >> 6), lane = tid & 63, r32 = lane & 31, hi = lane >> 5;
    char* V_lds = lds + OFF_V; char* K_lds = lds + OFF_K;
    float* ws = (float*)(lds + OFF_WS) + wid * 64; float* li_l = ws; float* al_l = ws + 32;
    float* biasL = (float*)(lds + OFF_BIAS);
    float m_ref = 0.f, l_reg = 0; f32x16 o[2] = {}; f32x16 negm = {}; bool fresh = true; bf16x8 qr[ND0];
    {   const bf16_t* Qw = Qa + (size_t)(wid * QBLK + r32) * ldqa + hi * 8;
#pragma unroll
        for (int d0 = 0; d0 < 4; ++d0) qr[d0] = *reinterpret_cast<const bf16x8*>(Qw + d0 * 16);
        if constexpr (MODE == 0) { const bf16_t* Qw2 = Qb + (size_t)(wid * QBLK + r32) * ldqb + hi * 8;
#pragma unroll
            for (int d0 = 0; d0 < 2; ++d0) qr[4 + d0] = *reinterpret_cast<const bf16x8*>(Qw2 + d0 * 16); } }
    int qgr = 0, rs0 = 0, qc = 0, cs = 0;
    if constexpr (MODE == 1) {
        qgr = qrow0 + (wid >> 1); rs0 = min(max(qgr - 4, 0), 120); qc = 32 * (wid & 1) + r32; cs = min(max(qc - 8, 0), 48);
        for (int i = tid; i < 15 * 31; i += 512) biasL[i] = rpbh[i] * LOG2E;
    }
    const int sr = tid >> 3, sc = (tid & 7) * 8;
    const int sr2 = (tid & 255) >> 2, sc2 = (tid & 3) * 8;
    const int vst = v_st(sr, sc);
    const int vb0 = (int)(uintptr_t)V_lds + v_rd_base(lane);
    struct { bf16x8 v, k, k2; } sr_[1];
#define KROWOF(t) (MODE == 1 ? min(krow0 + (t), 127) * 64 : (t) * 64)
#define SLOAD(i, t) do { const long k0_ = KROWOF(t); sr_[i].v = *reinterpret_cast<const bf16x8*>(&Vv[(k0_ + sr) * ldv + sc]); sr_[i].k = *reinterpret_cast<const bf16x8*>(&Ka[(k0_ + sr) * ldka + sc]); \
        if constexpr (MODE == 0) sr_[i].k2 = *reinterpret_cast<const bf16x8*>(&Kb[(k0_ + sr2) * ldkb + sc2]); } while (0)
#define SWRITE(b, i) do { *(bf16x8*)(V_lds + (b) * SHM_V + vst) = sr_[i].v; *(bf16x8*)(K_lds + (b) * SHM_K + sr * KROW + sc * 2) = sr_[i].k; \
        if constexpr (MODE == 0) { if (tid < 256) *(bf16x8*)(K_lds + (b) * SHM_K + sr2 * KROW + 128 + sc2 * 2) = sr_[i].k2; } } while (0)
#define SWAIT() do { if constexpr (MODE == 0) asm volatile("s_waitcnt vmcnt(3)" ::: "memory"); else asm volatile("s_waitcnt vmcnt(2)" ::: "memory"); } while (0)
#define RESC(a) do { if (__any((a) < 1.f)) { if (hi == 0) al_l[r32] = (a); asm volatile("s_waitcnt lgkmcnt(0)" ::: "memory"); \
        _Pragma("unroll") for (int d = 0; d < 2; ++d) _Pragma("unroll") for (int r = 0; r < 16; ++r) o[d][r] *= al_l[crow(r, hi)]; } } while (0)
#define TVALID(t) (MODE == 0 ? true : ((t) < ntreal && (krow0 + (t)) >= rs0 && (krow0 + (t)) < rs0 + 8))
#define MASKB(P0, P1, t) do { if constexpr (MODE == 1) { const int dr_ = krow0 + (t) - qgr + 7; int d_ = 4 * hi - cs; asm volatile("" : "+v"(d_)); \
        const LAS float* bl_ = (const LAS float*)((LAS char*)lds + OFF_BIAS) + (dr_ * 31 + 15 - qc + 4 * hi); \
        _Pragma("unroll") for (int r = 0; r < 16; ++r) { const int c0_ = (r & 3) + 8 * (r >> 2); \
            const bool in0 = (unsigned)(c0_ + d_) < 16u, in1 = (unsigned)(c0_ + 32 + d_) < 16u; \
            const float b0_ = bl_[c0_], b1_ = bl_[c0_ + 32]; \
            P0[r] = in0 ? P0[r] + b0_ : -1e30f; P1[r] = in1 ? P1[r] + b1_ : -1e30f; } } } while (0)
    f32x16 pA0, pA1, pB0, pB1; float alA = 1.f, alB = 1.f; bf16x8 pa0, pa1, pa2, pa3;
    SLOAD(0, 0); asm volatile("s_waitcnt vmcnt(0)" ::: "memory"); SWRITE(0, 0); SLOAD(0, 1); asm volatile("s_waitcnt vmcnt(0)" ::: "memory"); SWRITE(1, 0);
    if (NT > 2) SLOAD(0, 2);
    __syncthreads();
    const int NI = NT >> 1;
    for (int it = 0; it < NI; ++it) {
        const int kb = (it & 1) * 2, nb = 2 - kb; const bool more = it + 1 < NI;
        if (more) { SWRITE(nb, 0); SLOAD(0, 2 * it + 3); }
        const int ta = 2 * it, tb = ta + 1;
        const bool vA = TVALID(ta), vB = TVALID(tb);
        if (vA) { qkt<ND0, KROW>(pA0, pA1, K_lds + kb * SHM_K, qr, negm, r32, hi); MASKB(pA0, pA1, ta); partialSM(pA0, pA1, m_ref, negm, alA, fresh); RESC(alA); }
        SBAR();
        if (vB) { qkt<ND0, KROW>(pB0, pB1, K_lds + (kb + 1) * SHM_K, qr, negm, r32, hi); MASKB(pB0, pB1, tb); }
        if (vA) { finishSM(pA0, pA1, alA, l_reg, pa0, pa1, pa2, pa3); SBAR(); pv_d0(o, vb0 + kb * SHM_V, pa0, pa1, pa2, pa3); }
        if (more) { SWRITE(nb + 1, 0); if (it + 2 < NI) SLOAD(0, 2 * it + 4); }
        if (vB) { partialSM(pB0, pB1, m_ref, negm, alB, fresh); RESC(alB); finishSM(pB0, pB1, alB, l_reg, pa0, pa1, pa2, pa3); SBAR(); pv_d0(o, vb0 + (kb + 1) * SHM_V, pa0, pa1, pa2, pa3); }
        __syncthreads();
    }
    asm volatile("s_waitcnt vmcnt(0)" ::: "memory");
    if (hi == 0) li_l[r32] = l_reg; asm volatile("s_waitcnt lgkmcnt(0)" ::: "memory");
    float rli[16];
#pragma unroll
    for (int r = 0; r < 16; ++r) rli[r] = __builtin_amdgcn_rcpf(li_l[crow(r, hi)]);
    {   bf16_t* stg = (bf16_t*)(lds + OFF_OST) + wid * 2048;
#pragma unroll
        for (int r = 0; r < 16; ++r) { const int orow = crow(r, hi);
#pragma unroll
            for (int d0 = 0; d0 < 2; ++d0) stg[orow * 64 + d0 * 32 + r32] = (bf16_t)(cvt_pk_bf16(o[d0][r] * rli[r], 0.f) & 0xffffu); }
        asm volatile("s_waitcnt lgkmcnt(0)" ::: "memory");
        bf16_t* Ow = O + (size_t)(wid * QBLK) * 512;
#pragma unroll
        for (int i = 0; i < 4; ++i) { const int row = i * 8 + (lane >> 3), ch = lane & 7; const u32x4 v = *(const u32x4*)(stg + row * 64 + ch * 8); *(u32x4*)(Ow + (size_t)row * 512 + ch * 8) = v; } }
    __syncthreads();
#undef KROWOF
#undef SLOAD
#undef SWRITE
#undef SWAIT
#undef RESC
#undef TVALID
#undef MASKB
}
#undef SBAR
}

constexpr size_t MiB = 1u << 20;
constexpr size_t WS_CTL = 0, CTL_ZERO_BYTES = 1 * MiB;
constexpr size_t WS_WIN = 2 * MiB;
constexpr size_t WS_WUQ = 11 * MiB;
constexpr size_t WS_WUKV = 12 * MiB;
constexpr size_t WS_WNA = 13 * MiB, WS_WMLA = 14 * MiB;
constexpr size_t WS_WOUT = 15 * MiB;
constexpr size_t WS_W1 = 18 * MiB;
constexpr size_t WS_W2 = 146 * MiB;
constexpr size_t WS_XN = 210 * MiB;
constexpr size_t WS_PROJ = 242 * MiB;
constexpr size_t WS_QN = 378 * MiB, WS_QR = 394 * MiB, WS_KN = 402 * MiB, WS_KR = 418 * MiB, WS_VM = 419 * MiB;
constexpr size_t WS_ONA = 435 * MiB, WS_OMLA = 451 * MiB;
constexpr size_t WS_MERGED = 467 * MiB;
constexpr size_t WS_TMP = 499 * MiB;
constexpr size_t WS_LIST = 563 * MiB;
constexpr size_t WS_TOKPOS = 565 * MiB, WS_TOKG = 566 * MiB;
constexpr size_t WS_ACT = 568 * MiB;
constexpr size_t WS_YIT = 712 * MiB;
constexpr size_t WS_SSQ = 856 * MiB;
constexpr size_t WS_MODP = 857 * MiB;
constexpr size_t WS_WRT = 858 * MiB;
constexpr size_t WS_END = 859 * MiB;
constexpr int CW_BAR = 4096;
constexpr int CW_CNT = 8192;
constexpr int CW_MOD = 16384;
constexpr int CW_ROPE = 32768;
static_assert((CW_ROPE + 2048) * 4 <= (int)CTL_ZERO_BYTES, "CTL");

constexpr int RING_BYTES = 131072;
constexpr int TAB_OFF = RING_BYTES;
constexpr int TAB_BLK = TAB_OFF, TAB_GATH = TAB_OFF + 2048;
constexpr int MISC_OFF = TAB_GATH + 11 * 1024;
constexpr int LDS_BYTES = 147456;
static_assert(MISC_OFF + 256 <= LDS_BYTES, "LDS map");

#define RLX_AGENT __ATOMIC_RELAXED, __HIP_MEMORY_SCOPE_AGENT
#define LDS_WAIT() asm volatile("s_waitcnt lgkmcnt(0)" ::: "memory")

#define XB_TMO      128
#define XB_XCNT(j)  (256  + 64 * (j))
#define XB_XSUB(j)  (1280 + 64 * (j))
#define XB_XGEN(j)  (2304 + 64 * (j))
#define XB_TOP      3328
#define XB_TOPGEN   3392
#define XCD_BAR_WORDS 3456
#define XB_SPIN_CAP (1u << 22)
__device__ __forceinline__ unsigned xb_ld(unsigned* p)              { return __hip_atomic_load(p, __ATOMIC_RELAXED, __HIP_MEMORY_SCOPE_AGENT); }
__device__ __forceinline__ unsigned xb_add(unsigned* p, unsigned v) { return __hip_atomic_fetch_add(p, v, __ATOMIC_RELAXED, __HIP_MEMORY_SCOPE_AGENT); }
__device__ __forceinline__ unsigned xb_xcc_id() { return (unsigned)__builtin_amdgcn_s_getreg((3 << 11) | 20) & 0xFu; }
#define XB_SPIN(cond, bar) do { unsigned _sp = 0; while (cond) { __builtin_amdgcn_s_sleep(1); \
    if ((++_sp & 255u) == 0u) { if (xb_ld(&(bar)[XB_TMO])) break; if (_sp > XB_SPIN_CAP) { atomicAdd(&(bar)[XB_TMO], 1u); break; } } } } while (0)
struct XcdBarrier { unsigned* bar; unsigned x; volatile LAS unsigned* st; };
__device__ __forceinline__ XcdBarrier xcd_barrier_post(unsigned* bar, volatile LAS unsigned* st) {
    XcdBarrier b; b.bar = bar; b.x = xb_xcc_id(); b.st = st;
    if (threadIdx.x == 0) (void)xb_add(&bar[XB_XCNT(b.x)], 1u);
    return b;
}
__device__ __forceinline__ void xcd_barrier_complete(unsigned* bar, unsigned x, unsigned& nloc, unsigned& nx) {
    const unsigned G = gridDim.x * gridDim.y * gridDim.z;
    unsigned sum, cnt, mine, sp = 0u;
    for (;;) {
        sum = 0u; cnt = 0u; mine = 0u;
#pragma unroll
        for (unsigned j = 0; j < 16; ++j) { const unsigned c = xb_ld(&bar[XB_XCNT(j)]); sum += c; cnt += (c > 0u) ? 1u : 0u; mine = (j == x) ? c : mine; }
        if (sum == G) break;
        __builtin_amdgcn_s_sleep(1);
        if ((++sp & 255u) == 0u) { if (xb_ld(&bar[XB_TMO])) break; if (sp > XB_SPIN_CAP) { atomicAdd(&bar[XB_TMO], 1u); break; } }
    }
    nloc = mine > 0u ? mine : 1u; nx = cnt > 0u ? cnt : 1u;
}
__device__ __forceinline__ void xcd_barrier(const XcdBarrier& b) {
    asm volatile("s_waitcnt vmcnt(0)" ::: "memory");
    __syncthreads();
    if (threadIdx.x == 0) {
        unsigned* bar = b.bar;
        __builtin_amdgcn_s_waitcnt(0);
        unsigned nloc = b.st[0], nx = b.st[1];
        if (nloc == 0u) { xcd_barrier_complete(bar, b.x, nloc, nx); b.st[0] = nloc; b.st[1] = nx; }
        const unsigned old = xb_add(&bar[XB_XSUB(b.x)], 1u);
        const unsigned gen = old / nloc;
        if (old + 1u == (gen + 1u) * nloc) {
            __builtin_amdgcn_fence(__ATOMIC_RELEASE, "agent");
            asm volatile("s_waitcnt vmcnt(0)" ::: "memory");
            const unsigned og = xb_add(&bar[XB_TOP], 1u);
            const unsigned tg = og / nx;
            if (og + 1u == (tg + 1u) * nx) xb_add(&bar[XB_TOPGEN], 1u);
            else XB_SPIN(xb_ld(&bar[XB_TOPGEN]) == tg, bar);
            __builtin_amdgcn_fence(__ATOMIC_ACQUIRE, "agent");
            xb_add(&bar[XB_XGEN(b.x)], 1u);
            asm volatile("s_waitcnt vmcnt(0)" ::: "memory");
        } else {
            XB_SPIN(xb_ld(&bar[XB_XGEN(b.x)]) == gen, bar);
            __builtin_amdgcn_fence(__ATOMIC_ACQUIRE, "agent");
            asm volatile("s_waitcnt vmcnt(0)" ::: "memory");
        }
    }
    __syncthreads();
}

constexpr int NWAVES = 8;
struct Args { const float* in[24]; float* out; unsigned char* ws; int ph_lo, ph_hi; };
enum { I_X = 0, I_C, I_WADA, I_BADA, I_GAPRE, I_GAPOST, I_WIN, I_BGATE, I_RPB, I_QNG, I_KVNG, I_WUQ, I_WUKV, I_WNAUP, I_WMLAUP, I_WOUT, I_GFPRE, I_GFPOST, I_WR, I_BR, I_W1, I_B1, I_W2, I_B2 };

__device__ __forceinline__ void tr_store_tile(LAS unsigned char* scr, bf16_t* dst, int K, int n0, int k0, int lane) {
    LDS_WAIT(); asm volatile("" ::: "memory");
#pragma unroll
    for (int j = 0; j < 8; ++j) { const int idx = j * 64 + lane, n = idx >> 3, ch = idx & 7;
        const u32x4 v = *(const LAS u32x4*)(scr + n * 144 + ch * 16);
        *(GAS u32x4*)(dst + (size_t)(n0 + n) * K + k0 + ch * 8) = v; }
    LDS_WAIT(); asm volatile("" ::: "memory");
}
__device__ __forceinline__ void tr_tile_fast(const float* src, int Nsrc, int src0, const float* kscale, bf16_t* dst, int K, int n0, int k0, LAS unsigned char* scr, int lane) {
#pragma unroll
    for (int st = 0; st < 8; ++st) { const int kq = st * 4 + (lane >> 4), c4 = (lane & 15) * 4, k = 2 * kq;
        f32x4 a = *(const GAS f32x4*)(src + (size_t)(k0 + k) * Nsrc + src0 + c4);
        f32x4 b = *(const GAS f32x4*)(src + (size_t)(k0 + k + 1) * Nsrc + src0 + c4);
        if (kscale) { const float s0 = kscale[k0 + k], s1 = kscale[k0 + k + 1]; a = a * s0; b = b * s1; }
#pragma unroll
        for (int i = 0; i < 4; ++i) *(LAS unsigned*)(scr + (c4 + i) * 144 + k * 2) = cvt_pk_bf16(a[i], b[i]); }
    tr_store_tile(scr, dst, K, n0, k0, lane);
}
__device__ __forceinline__ void tr_tile_slow(const float* src, int Nsrc, int srccol  , const float* kscale, bf16_t* dst, int K, int n0, int k0, LAS unsigned char* scr, int lane) {
#pragma unroll
    for (int k = 0; k < 64; k += 2) {
        float a = 0.f, b = 0.f;
        if (srccol >= 0) { a = src[(size_t)(k0 + k) * Nsrc + srccol]; b = src[(size_t)(k0 + k + 1) * Nsrc + srccol];
            if (kscale) { a *= kscale[k0 + k]; b *= kscale[k0 + k + 1]; } }
        *(LAS unsigned*)(scr + lane * 144 + k * 2) = cvt_pk_bf16(a, b); }
    tr_store_tile(scr, dst, K, n0, k0, lane);
}
__device__ __forceinline__ void tr_tile_fast8(const float* src, int Nsrc, int src0, unsigned char* dst, int K, int n0, int k0, LAS unsigned char* scr, int lane) {
#pragma unroll
    for (int st = 0; st < 4; ++st) { const int kq = st * 4 + (lane >> 4), c4 = (lane & 15) * 4, k = 4 * kq;
        const f32x4 a = __builtin_nontemporal_load((const f32x4*)(src + (size_t)(k0 + k) * Nsrc + src0 + c4)) * SC_W, b = __builtin_nontemporal_load((const f32x4*)(src + (size_t)(k0 + k + 1) * Nsrc + src0 + c4)) * SC_W;
        const f32x4 c = __builtin_nontemporal_load((const f32x4*)(src + (size_t)(k0 + k + 2) * Nsrc + src0 + c4)) * SC_W, d = __builtin_nontemporal_load((const f32x4*)(src + (size_t)(k0 + k + 3) * Nsrc + src0 + c4)) * SC_W;
#pragma unroll
        for (int i = 0; i < 4; ++i) { int w = __builtin_amdgcn_cvt_pk_fp8_f32(a[i], b[i], 0, false); w = __builtin_amdgcn_cvt_pk_fp8_f32(c[i], d[i], w, true);
            *(LAS int*)(scr + (c4 + i) * 80 + k) = w; } }
    LDS_WAIT(); asm volatile("" ::: "memory");
#pragma unroll
    for (int j = 0; j < 4; ++j) { const int idx = j * 64 + lane, n = idx >> 2, ch = idx & 3;
        const u32x4 v = *(const LAS u32x4*)(scr + n * 80 + ch * 16);
        __builtin_nontemporal_store(v, (u32x4*)(dst + (size_t)(n0 + n) * K + k0 + ch * 16)); }
    LDS_WAIT(); asm volatile("" ::: "memory");
}
__device__ __forceinline__ int rope_orig(int p) { return (p & 16) + 8 * (p & 1) + ((p & 15) >> 1); }

__global__ void __launch_bounds__(NWAVES * 64, 2) fwd_kernel(Args args_unused_) {
#define args (*(const __attribute__((address_space(4))) Args*)__builtin_amdgcn_kernarg_segment_ptr())
    extern __shared__ __attribute__((aligned(16))) unsigned char lds[];
    LAS unsigned char* L = (LAS unsigned char*)lds;
    volatile LAS unsigned* MISC = (volatile LAS unsigned*)(L + MISC_OFF);
    const int tid = threadIdx.x, lane = tid & 63, wave = __builtin_amdgcn_readfirstlane(tid >> 6);
    const int G = gridDim.x, bx = blockIdx.x, vcu = (G % 8 == 0) ? (bx % 8) * (G / 8) + bx / 8 : bx;
    unsigned char* ws = args.ws;
    gu32* ctl = (gu32*)(ws + WS_CTL);
    const int lo = args.ph_lo, hi = args.ph_hi;
    for (int u = tid; u < 64; u += NWAVES * 64) MISC[u] = 0u;
    __syncthreads();
    XcdBarrier bar; bar.bar = (unsigned*)(ctl + CW_BAR); bar.x = 0; bar.st = nullptr;
    const bool use_bar = (hi - lo) > 1;
    if (use_bar) bar = xcd_barrier_post((unsigned*)(ctl + CW_BAR), MISC + 8);
#ifndef PHASE_MASK
#define PHASE_MASK 0xFFFF
#endif
#define IN(k) (((PHASE_MASK >> (k)) & 1) && lo <= (k) && (k) < hi)
#ifndef REPMASK
#define REPMASK 0
#endif
#define NREP(k) (1 + ((REPMASK >> (k)) & 1))
#define SEAM(k) do { if (IN(k) && IN((k) + 1)) xcd_barrier(bar); } while (0)
    const int gw = vcu * NWAVES + wave, NGW = G * NWAVES;
    float* ROPE = (float*)(ctl + CW_ROPE);
    float* MODP = (float*)(ws + WS_MODP); float* MOD = (float*)(ws + WS_MODP + 512 * 1024); float* SSQ = (float*)(ws + WS_SSQ); unsigned* CNT = (unsigned*)(ctl + CW_CNT);
    bf16_t* WINT = (bf16_t*)(ws + WS_WIN); bf16_t* WUQT = (bf16_t*)(ws + WS_WUQ); bf16_t* WUKVT = (bf16_t*)(ws + WS_WUKV);
    bf16_t* WNAT = (bf16_t*)(ws + WS_WNA); bf16_t* WMLAT = (bf16_t*)(ws + WS_WMLA); bf16_t* WOUTT = (bf16_t*)(ws + WS_WOUT);
    bf16_t* W1T = (bf16_t*)(ws + WS_W1); bf16_t* W2T = (bf16_t*)(ws + WS_W2);
    bf16_t* XN = (bf16_t*)(ws + WS_XN); bf16_t* PROJ = (bf16_t*)(ws + WS_PROJ);
    bf16_t* QN = (bf16_t*)(ws + WS_QN); bf16_t* QR = (bf16_t*)(ws + WS_QR); bf16_t* KN = (bf16_t*)(ws + WS_KN); bf16_t* KR = (bf16_t*)(ws + WS_KR); bf16_t* VM = (bf16_t*)(ws + WS_VM);
    bf16_t* ONA = (bf16_t*)(ws + WS_ONA); bf16_t* OMLA = (bf16_t*)(ws + WS_OMLA); bf16_t* MERGED = (bf16_t*)(ws + WS_MERGED);
    float* TMP = (float*)(ws + WS_TMP); unsigned* LIST = (unsigned*)(ws + WS_LIST); unsigned* TOKPOS = (unsigned*)(ws + WS_TOKPOS); float* TOKG = (float*)(ws + WS_TOKG);
    bf16_t* ACT = (bf16_t*)(ws + WS_ACT); bf16_t* YIT = (bf16_t*)(ws + WS_YIT);
    const float* X = args.in[I_X]; float* OUT = args.out;

    if (IN(0)) for (int rep_ = 0; rep_ < NREP(0); ++rep_) {
        LAS unsigned char* scr = L + wave * 16384;
        if (vcu < 192) { const float* c = args.in[I_C]; const float* wada = args.in[I_WADA]; const float* bada = args.in[I_BADA];
            const int cb = vcu % 24, kc = vcu / 24, k0 = kc * 128 + wave * 16, n0 = cb * 256 + lane * 4;
            f32x4 w[16];
#pragma unroll
            for (int k = 0; k < 16; ++k) w[k] = *(const GAS f32x4*)(wada + (size_t)(k0 + k) * 6144 + n0);
            f32x4 a0 = {0.f, 0.f, 0.f, 0.f}, a1 = {0.f, 0.f, 0.f, 0.f};
#pragma unroll
            for (int k = 0; k < 16; ++k) { const float c0 = c[k0 + k], c1 = c[1024 + k0 + k]; a0 += w[k] * (c0 * sigmoidf_(c0)); a1 += w[k] * (c1 * sigmoidf_(c1)); }
            LAS f32x4* red = (LAS f32x4*)(L + 65536);
            red[(wave * 2 + 0) * 64 + lane] = a0; red[(wave * 2 + 1) * 64 + lane] = a1;
            __syncthreads();
            { const int b = tid >> 8, col = tid & 255; const LAS float* rf = (const LAS float*)red; float sm = 0.f;
#pragma unroll
              for (int wv = 0; wv < 8; ++wv) sm += rf[(wv * 2 + b) * 256 + col];
              if (kc == 0) sm += bada[cb * 256 + col];
              MODP[(kc * 2 + b) * 6144 + cb * 256 + col] = sm; }
            __syncthreads();
        }
        if (bx == 0) { for (int i = tid; i < 128 * 8; i += NWAVES * 64) { const int pos = i >> 3, j = i & 7; float c, sn; rope_cs((float)pos, j, c, sn); ROPE[pos * 16 + j] = c; ROPE[pos * 16 + 8 + j] = sn; } }
        { const float* Wr = args.in[I_WR]; float* WRT = (float*)(ws + WS_WRT);
          for (int it = NGW - 1 - gw; it < NEXP * 16; it += NGW) { const int e = it >> 4, k = (it & 15) * 64 + lane; WRT[e * 1024 + k] = Wr[(size_t)k * 32 + e]; } }
        {   constexpr int I_WIN_ = 16 * 68, I_UQ = 6 * 12, I_UKV = 4 * 16, I_UP = 8 * 16, I_OUT = 16 * 16;
            constexpr int NITEMS = I_WIN_ + I_UQ + I_UKV + 2 * I_UP + I_OUT;
            for (int it = gw; it < NITEMS; it += NGW) {
                int r = it;
                if (r < I_WIN_) { const int kb = r / 68, nb = r % 68;
                    if (nb < 34) tr_tile_fast(args.in[I_WIN], 4256, nb * 64, nullptr, WINT, 1024, nb * 64, kb * 64, scr, lane);
                    else if (nb >= 36) tr_tile_fast(args.in[I_WIN], 4256, 2208 + (nb - 36) * 64, nullptr, WINT, 1024, nb * 64, kb * 64, scr, lane);
                    else { const int n = nb * 64 + lane; const int sc = (n < 2208) ? 2176 + rope_orig(n - 2176) : -1;
                        tr_tile_slow(args.in[I_WIN], 4256, sc, nullptr, WINT, 1024, nb * 64, kb * 64, scr, lane); }
                    continue; } r -= I_WIN_;
                if (r < I_UQ) { const int kb = r / 12, nb = r % 12;
                    if (nb < 8) tr_tile_fast(args.in[I_WUQ], 768, nb * 96, args.in[I_QNG], WUQT, 384, nb * 64, kb * 64, scr, lane);
                    else { const int n = nb * 64 + lane - 512, h = n >> 5, p = n & 31;
                        tr_tile_slow(args.in[I_WUQ], 768, h * 96 + 64 + rope_orig(p), args.in[I_QNG], WUQT, 384, nb * 64, kb * 64, scr, lane); }
                    continue; } r -= I_UQ;
                if (r < I_UKV) { const int kb = r / 16, nb = r % 16;
                    const int s0 = (nb < 8) ? nb * 128 : (nb - 8) * 128 + 64;
                    tr_tile_fast(args.in[I_WUKV], 1024, s0, args.in[I_KVNG], WUKVT, 256, nb * 64, kb * 64, scr, lane); continue; } r -= I_UKV;
                if (r < I_UP) { const int kb = r / 16, nb = r % 16; tr_tile_fast(args.in[I_WNAUP], 1024, nb * 64, nullptr, WNAT, 512, nb * 64, kb * 64, scr, lane); continue; } r -= I_UP;
                if (r < I_UP) { const int kb = r / 16, nb = r % 16; tr_tile_fast(args.in[I_WMLAUP], 1024, nb * 64, nullptr, WMLAT, 512, nb * 64, kb * 64, scr, lane); continue; } r -= I_UP;
                { const int kb = r / 16, nb = r % 16; tr_tile_fast(args.in[I_WOUT], 1024, nb * 64, nullptr, WOUTT, 1024, nb * 64, kb * 64, scr, lane); }
            } }
    }
    SEAM(0);
    if (IN(1)) {
        const float* g = args.in[I_GAPRE];
        LAS float* modl = (LAS float*)L;
        for (int i = tid; i < 4096; i += NWAVES * 64) { const int b = i >> 11, c = i & 2047; float sm = 0.f;
#pragma unroll
            for (int kc = 0; kc < 8; ++kc) sm += MODP[(kc * 2 + b) * 6144 + c];
            modl[i] = sm; }
        for (int idx = bx * (NWAVES * 64) + tid; idx < 2 * 6144; idx += G * NWAVES * 64) { const int b = idx / 6144, n = idx % 6144; float sm = 0.f;
#pragma unroll
            for (int kc = 0; kc < 8; ++kc) sm += MODP[(kc * 2 + b) * 6144 + n];
            MOD[idx] = sm; }
        __syncthreads();
        for (int m0 = gw * 2; m0 < MTOK; m0 += NGW * 2) { const int b = m0 >> 13;
            f32x4 v[2][4]; float ss[2] = {0.f, 0.f};
#pragma unroll
            for (int r = 0; r < 2; ++r) { const GAS f32x4* xr = (const GAS f32x4*)(X + (size_t)(m0 + r) * DM) + lane;
#pragma unroll
                for (int j = 0; j < 4; ++j) v[r][j] = xr[64 * j]; }
#pragma unroll
            for (int r = 0; r < 2; ++r)
#pragma unroll
                for (int j = 0; j < 4; ++j) ss[r] += (v[r][j].x * v[r][j].x + v[r][j].y * v[r][j].y) + (v[r][j].z * v[r][j].z + v[r][j].w * v[r][j].w);
#pragma unroll
            for (int r = 0; r < 2; ++r) { const float rstd = __builtin_amdgcn_rsqf(wave_sum(ss[r]) * (1.f / DM) + RMS_EPS);
                GAS u32x2* o8 = (GAS u32x2*)(XN + (size_t)(m0 + r) * DM) + lane;
#pragma unroll
                for (int j = 0; j < 4; ++j) { const int col = 4 * lane + 256 * j;
                    const f32x4 gg = *(const f32x4*)(g + col), sh = *(const LAS f32x4*)(modl + b * 2048 + col), scl = *(const LAS f32x4*)(modl + b * 2048 + 1024 + col);
                    const f32x4 h = v[r][j] * rstd * gg * (scl + 1.f) + sh; u32x2 w; w.x = cvt_pk_bf16(h[0], h[1]); w.y = cvt_pk_bf16(h[2], h[3]); o8[64 * j] = w; } } }
    }
    SEAM(1);
    if (IN(2)) for (int rep_ = 0; rep_ < NREP(2); ++rep_) {
        if (bx < NG_INPROJ || G < 256) {
            const int ng = G < 256 ? G : NG_INPROJ;
            pg8::SchedDense S{(const char*)XN, (const char*)WINT, (size_t)256 * 1024 * 2, (size_t)256 * 1024 * 2, MTOK / 256, NPROJ / 256, ng, bx};
            pg8::EpiInProj E{PROJ, SSQ, KR, ROPE, args.in[I_BGATE]};
            pg8::gemm_phase<pg8::EpiInProj, pg8::SchedDense, true, false, false>(L, 16, 2048, 2048, S, E);
        }
        {   LAS unsigned char* scr = L + wave * 16384;
            constexpr int I_W1_ = NEXP * 16 * 32, I_W2_ = NEXP * 16 * 16, NCHUNK = (I_W1_ + I_W2_) / 32;
            for (;;) {
                if (tid == 0) MISC[20] = atomicAdd(CNT + 64, 1u);
                __syncthreads();
                const int chunk = (int)MISC[20];
                __syncthreads();
                if (chunk >= NCHUNK) break;
#pragma unroll 1
                for (int k = 0; k < 4; ++k) { int r = chunk * 32 + wave * 4 + k;
                    if (r < I_W1_) { const int e = r / 512, q = r % 512, kb = q / 32, nb = q % 32;
                        tr_tile_fast8(args.in[I_W1] + (size_t)e * 1024 * 2048, 2048, nb * 64, (unsigned char*)W1T + (size_t)e * 2048 * 1024, 1024, nb * 64, kb * 64, scr, lane); }
                    else { r -= I_W1_; const int e = r / 256, q = r % 256, kb = q / 16, nb = q % 16;
                        tr_tile_fast8(args.in[I_W2] + (size_t)e * 1024 * 1024, 1024, nb * 64, (unsigned char*)W2T + (size_t)e * 1024 * 1024, 1024, nb * 64, kb * 64, scr, lane); } }
            } }
    }
    SEAM(2);
    if (IN(3)) for (int rep_ = 0; rep_ < NREP(3); ++rep_) {
#ifndef NO_QUP
        {   pg8::SchedDense S{(const char*)(PROJ + 1536), (const char*)WUQT, (size_t)256 * NPROJ * 2, (size_t)256 * 384 * 2, MTOK / 256, 3, G, bx};
            pg8::EpiQUp E{QN, QR, SSQ, ROPE};
            pg8::gemm_phase<pg8::EpiQUp, pg8::SchedDense, true, false, false>(L, 6, NPROJ * 2, 768, S, E); }
#endif
#ifndef NO_KVUP
        {   pg8::SchedDense S{(const char*)(PROJ + 1920), (const char*)WUKVT, (size_t)256 * NPROJ * 2, (size_t)256 * 256 * 2, MTOK / 256, 4, G, G - 1 - bx};
            pg8::EpiKVUp E{KN, VM, SSQ};
            pg8::gemm_phase<pg8::EpiKVUp, pg8::SchedDense, true, false, false>(L, 4, NPROJ * 2, 512, S, E); }
#endif
    }
    SEAM(3);
    if (IN(4)) for (int rep_ = 0; rep_ < NREP(4); ++rep_) {
#ifndef NO_MLA
        for (int u = vcu; u < 512; u += G) {
            const int bh = u >> 5, qb = u & 31, b = bh >> 3, h = bh & 7; const size_t row0 = (size_t)b * SEQ + qb * 256, key0 = (size_t)b * SEQ;
            attn::attn_unit<0>(QN + row0 * 512 + h * 64, 512, QR + row0 * 256 + h * 32, 256, KN + key0 * 512 + h * 64, 512, KR + key0 * 32, 32, VM + key0 * 512 + h * 64, 512,
                               OMLA + row0 * 512 + h * 64, 128, 0, 128, 0, nullptr, (char*)lds);
        }
#endif
#ifndef NO_NA
        for (int u = vcu; u < 512; u += G) {
            const int bh = u >> 5, rb = u & 31, b = bh >> 3, h = bh & 7; const size_t row0 = (size_t)b * SEQ + rb * 256, key0 = (size_t)b * SEQ;
            const int krow0 = min(max(4 * rb - 4, 0), 120), klast = min(max(4 * rb + 3 - 4, 0), 120) + 7, ntreal = klast - krow0 + 1, NT = (ntreal + 1) & ~1;
            attn::attn_unit<1>(PROJ + row0 * NPROJ + h * 64, NPROJ, nullptr, 0, PROJ + key0 * NPROJ + 512 + h * 64, NPROJ, nullptr, 0, PROJ + key0 * NPROJ + 1024 + h * 64, NPROJ,
                               ONA + row0 * 512 + h * 64, NT, krow0, ntreal, 4 * rb, args.in[I_RPB] + h * 15 * 31, (char*)lds);
        }
#endif
    }
    SEAM(4);
    if (IN(5)) for (int rep_ = 0; rep_ < NREP(5); ++rep_) {
        pg8::SchedMerge S{(const char*)ONA, (const char*)OMLA, (const char*)WNAT, (const char*)WMLAT, MTOK / 256, 4, G, bx};
        pg8::EpiMerge E{PROJ, MERGED};
        pg8::gemm_phase<pg8::EpiMerge, pg8::SchedMerge, true, false, false, true>(L, 16, 1024, 1024, S, E);
    }
    SEAM(5);
    if (IN(6)) for (int rep_ = 0; rep_ < NREP(6); ++rep_) {
        pg8::SchedDense S{(const char*)MERGED, (const char*)WOUTT, (size_t)256 * 1024 * 2, (size_t)256 * 1024 * 2, MTOK / 256, 4, G, bx};
        pg8::EpiBf16Y E{(bf16_t*)TMP};
        pg8::gemm_phase<pg8::EpiBf16Y, pg8::SchedDense, true, false, false>(L, 16, 2048, 2048, S, E);
    }
    SEAM(6);
    if (IN(7)) {
        LAS int* sel_e = (LAS int*)(L + 0); LAS float* sel_g = (LAS float*)(L + 1024); LAS int* sel_r = (LAS int*)(L + 2048);
        LAS int* lcnt = (LAS int*)(L + 3072); LAS int* lbase = (LAS int*)(L + 3072 + 128);
        const float* gpo = args.in[I_GAPOST]; const float* gfp = args.in[I_GFPRE]; const float* br = args.in[I_BR];
        const float* WRT = (const float*)(ws + WS_WRT);
        for (int blk = vcu; blk < MTOK / 64; blk += G) {
            if (tid < 32) lcnt[tid] = 0;
            __syncthreads();
            f32x4 hreg[8][4];
#pragma unroll
            for (int rr = 0; rr < 8; ++rr) { const int m = blk * 64 + wave * 8 + rr, b = m >> 13;
                const GAS u32x2* yr = (const GAS u32x2*)((const bf16_t*)TMP + (size_t)m * DM) + lane; const GAS f32x4* xr = (const GAS f32x4*)(X + (size_t)m * DM) + lane;
                f32x4 y[4], x1[4]; float s = 0.f;
#pragma unroll
                for (int j = 0; j < 4; ++j) { const u32x2 yw = yr[64 * j]; y[j] = (f32x4){bf16_lo(yw.x), bf16_hi(yw.x), bf16_lo(yw.y), bf16_hi(yw.y)}; x1[j] = xr[64 * j]; s += (y[j].x * y[j].x + y[j].y * y[j].y) + (y[j].z * y[j].z + y[j].w * y[j].w); }
                const float rstd = __builtin_amdgcn_rsqf(wave_sum(s) * (1.f / DM) + RMS_EPS); float s2 = 0.f;
#pragma unroll
                for (int j = 0; j < 4; ++j) { const int col = 4 * lane + 256 * j;
                    const f32x4 gg = *(const f32x4*)(gpo + col), ga = *(const f32x4*)(MOD + b * 6144 + 2048 + col);
                    x1[j] = x1[j] + ga * (y[j] * rstd * gg);
                    *((GAS f32x4*)(OUT + (size_t)m * DM) + lane + 64 * j) = x1[j];
                    s2 += (x1[j].x * x1[j].x + x1[j].y * x1[j].y) + (x1[j].z * x1[j].z + x1[j].w * x1[j].w); }
                const float rstd2 = __builtin_amdgcn_rsqf(wave_sum(s2) * (1.f / DM) + RMS_EPS);
                GAS int* o4 = (GAS int*)((unsigned char*)XN + (size_t)m * DM) + lane;
#pragma unroll
                for (int j = 0; j < 4; ++j) { const int col = 4 * lane + 256 * j;
                    const f32x4 gg = *(const f32x4*)(gfp + col), sh = *(const f32x4*)(MOD + b * 6144 + 3072 + col), scl = *(const f32x4*)(MOD + b * 6144 + 4096 + col);
                    const f32x4 h = x1[j] * rstd2 * gg * (scl + 1.f) + sh;
                    int w = __builtin_amdgcn_cvt_pk_fp8_f32(h[0] * SC_H2, h[1] * SC_H2, 0, false); w = __builtin_amdgcn_cvt_pk_fp8_f32(h[2] * SC_H2, h[3] * SC_H2, w, true); o4[64 * j] = w;
                    hreg[rr][j] = h; }
            }
            const bool b5 = (lane & 32) != 0, b4 = (lane & 16) != 0, b3 = (lane & 8) != 0;
            float t0 = -3.0e38f, t1 = -3.0e38f, t2 = -3.0e38f, t3 = -3.0e38f; int i0 = 0, i1 = 0, i2 = 0, i3 = 0;
#pragma unroll 2
            for (int e = 0; e < NEXP; ++e) {
                f32x4 w[4];
#pragma unroll
                for (int j = 0; j < 4; ++j) w[j] = *(const GAS f32x4*)(WRT + e * 1024 + 4 * lane + 256 * j);
                float p[8];
#pragma unroll
                for (int r = 0; r < 8; ++r) { f32x4 a = hreg[r][0] * w[0]; a += hreg[r][1] * w[1]; a += hreg[r][2] * w[2]; a += hreg[r][3] * w[3]; p[r] = (a.x + a.y) + (a.z + a.w); }
                float q[4], u[2];
#pragma unroll
                for (int i = 0; i < 4; ++i) { const float keep = b5 ? p[i + 4] : p[i], send = b5 ? p[i] : p[i + 4]; q[i] = keep + __shfl_xor(send, 32); }
#pragma unroll
                for (int i = 0; i < 2; ++i) { const float keep = b4 ? q[i + 2] : q[i], send = b4 ? q[i] : q[i + 2]; u[i] = keep + __shfl_xor(send, 16); }
                float v = (b3 ? u[1] : u[0]) + __shfl_xor(b3 ? u[0] : u[1], 8);
                v += __shfl_xor(v, 4); v += __shfl_xor(v, 2); v += __shfl_xor(v, 1);
                v += br[e];
                const bool c0 = v > t0, c1 = v > t1, c2 = v > t2, c3 = v > t3;
                t3 = c2 ? t2 : (c3 ? v : t3); i3 = c2 ? i2 : (c3 ? e : i3);
                t2 = c1 ? t1 : (c2 ? v : t2); i2 = c1 ? i1 : (c2 ? e : i2);
                t1 = c0 ? t0 : (c1 ? v : t1); i1 = c0 ? i0 : (c1 ? e : i1);
                t0 = c0 ? v : t0;             i0 = c0 ? e : i0;
            }
            {   const float e1 = __builtin_amdgcn_exp2f((t1 - t0) * LOG2E), e2 = __builtin_amdgcn_exp2f((t2 - t0) * LOG2E), e3 = __builtin_amdgcn_exp2f((t3 - t0) * LOG2E);
                const float inv = 1.f / (1.f + e1 + e2 + e3);
                const int lrow = wave * 8 + (b5 ? 4 : 0) + (b4 ? 2 : 0) + (b3 ? 1 : 0), t = lane & 7;
                if (t < 4) { const int ee = t == 0 ? i0 : t == 1 ? i1 : t == 2 ? i2 : i3;
                    const float gg = (t == 0 ? 1.f : t == 1 ? e1 : t == 2 ? e2 : e3) * inv;
                    const int rk = __hip_atomic_fetch_add(&lcnt[ee], 1, __ATOMIC_RELAXED, __HIP_MEMORY_SCOPE_WORKGROUP);
                    sel_e[lrow * 4 + t] = ee; sel_g[lrow * 4 + t] = gg; sel_r[lrow * 4 + t] = rk; } }
            __syncthreads();
            if (tid < 32) lbase[tid] = (int)atomicAdd(CNT + tid, (unsigned)lcnt[tid]);
            __syncthreads();
            if (tid < 256) { const int ee = sel_e[tid], pos = lbase[ee] + sel_r[tid], tok = blk * 64 + (tid >> 2);
                LIST[(size_t)ee * LISTCAP + pos] = (unsigned)tok; TOKPOS[(size_t)tok * 4 + (tid & 3)] = ((unsigned)ee << 16) | (unsigned)pos; TOKG[(size_t)tok * 4 + (tid & 3)] = sel_g[tid]; }
            __syncthreads();
        }
    }
    SEAM(7);
    if (IN(8) || IN(9)) {
        LAS int* blk_e = (LAS int*)(L + TAB_BLK); LAS int* eb0 = (LAS int*)(L + TAB_BLK + 1280); LAS int* ecnt = (LAS int*)(L + TAB_BLK + 1408);
        if (tid < 64) { const int c = (lane < NEXP) ? (int)__hip_atomic_load(CNT + lane, RLX_AGENT) : 0; const int n = (c + 255) >> 8; int incl = n;
#pragma unroll
            for (int o = 1; o < 64; o <<= 1) { const int t = __shfl_up(incl, o); if (lane >= o) incl += t; }
            const int start = incl - n;
            if (lane < NEXP) { eb0[lane] = start; ecnt[lane] = c; for (int i = 0; i < n; ++i) blk_e[start + i] = lane; }
            if (lane == 63) MISC[16] = (unsigned)incl; }
        __syncthreads();
        const int NB = (int)MISC[16];
        if (IN(8)) for (int rep_ = 0; rep_ < NREP(8); ++rep_) {
            for (int i = wave; i < 11; i += NWAVES) { const long Lu = (long)i * G + bx; if (Lu >= (long)NB * 8) break;
                const int grb = (int)(Lu >> 3), e = blk_e[grb], first = eb0[e], cnt = ecnt[e];
#pragma unroll
                for (int q = 0; q < 4; ++q) { const int r = q * 64 + lane, ri = (grb - first) * 256 + r; const unsigned tok = (ri < cnt) ? LIST[(size_t)e * LISTCAP + ri] : 0u;
                    *(LAS unsigned*)(L + TAB_GATH + i * 1024 + r * 4) = tok * 1024u; } }
            __syncthreads();
            pg8::SchedMoe<8, true> S{(const char*)XN, (const char*)W1T, (size_t)2048 * 1024, blk_e, NB, G, bx, TAB_GATH};
            pg8::EpiMoe1 E{args.in[I_B1], (unsigned char*)ACT};
            pg8::gemm_phase<pg8::EpiMoe1, pg8::SchedMoe<8, true>, true, true, true>(L, 8, 1024, 1024, S, E);
        }
        SEAM(8);
        if (IN(9)) for (int rep_ = 0; rep_ < NREP(9); ++rep_) {
            pg8::SchedMoe<4, false> S{(const char*)ACT, (const char*)W2T, (size_t)1024 * 1024, blk_e, NB, G, bx, 0};
            pg8::EpiMoe2 E{args.in[I_B2], YIT};
            pg8::gemm_phase<pg8::EpiMoe2, pg8::SchedMoe<4, false>, true, false, true>(L, 8, 1024, 1024, S, E);
        }
    }
    SEAM(9);
    if (IN(10)) {
        LAS int* rbase = (LAS int*)(L + 0);
        if (tid < 64) { const int c = (lane < NEXP) ? (int)__hip_atomic_load(CNT + lane, RLX_AGENT) : 0; const int n = (c + 255) >> 8; int incl = n;
#pragma unroll
            for (int o = 1; o < 64; o <<= 1) { const int t = __shfl_up(incl, o); if (lane >= o) incl += t; }
            if (lane < NEXP) rbase[lane] = (incl - n) * 256; }
        __syncthreads();
        const float* gfo = args.in[I_GFPOST];
        for (int m = gw; m < MTOK; m += NGW) { const int b = m >> 13;
            f32x4 y[4];
#pragma unroll
            for (int j = 0; j < 4; ++j) y[j] = (f32x4){0.f, 0.f, 0.f, 0.f};
#pragma unroll
            for (int t = 0; t < 4; ++t) { const unsigned tp = TOKPOS[(size_t)m * 4 + t]; const float gt = TOKG[(size_t)m * 4 + t];
                const size_t row = (size_t)rbase[tp >> 16] + (tp & 0xffffu); const GAS u32x2* yr = (const GAS u32x2*)(YIT + row * 1024) + lane;
#pragma unroll
                for (int j = 0; j < 4; ++j) { const u32x2 w = yr[64 * j]; y[j][0] += gt * bf16_lo(w.x); y[j][1] += gt * bf16_hi(w.x); y[j][2] += gt * bf16_lo(w.y); y[j][3] += gt * bf16_hi(w.y); } }
            float s = 0.f;
#pragma unroll
            for (int j = 0; j < 4; ++j) s += (y[j].x * y[j].x + y[j].y * y[j].y) + (y[j].z * y[j].z + y[j].w * y[j].w);
            const float rstd = __builtin_amdgcn_rsqf(wave_sum(s) * (1.f / DM) + RMS_EPS);
            GAS f32x4* orow = (GAS f32x4*)(OUT + (size_t)m * DM) + lane;
#pragma unroll
            for (int j = 0; j < 4; ++j) { const int col = 4 * lane + 256 * j;
                const f32x4 gg = *(const f32x4*)(gfo + col), gf = *(const f32x4*)(MOD + b * 6144 + 5120 + col);
                orow[64 * j] = orow[64 * j] + gf * (y[j] * rstd * gg); } }
    }
#undef IN
#undef SEAM
#undef args
}

constexpr int N_PHASES = 11;
extern "C" void kernel_launch(void* const* d_in, const int* in_sizes, int n_in, void* d_out, int out_size, void* d_ws, size_t ws_size, hipStream_t stream) {
    static int grid = 0;
    if (grid == 0) {
        if (n_in != 24 || out_size != MTOK * DM || ws_size < WS_END) { fprintf(stderr, "kernel_launch: unexpected shapes (n_in %d out %d ws %zu)\n", n_in, out_size, ws_size); grid = -1; return; }
        int dev = 0, cus = 0, per_cu = 0;
        if (hipGetDevice(&dev) != hipSuccess || hipDeviceGetAttribute(&cus, hipDeviceAttributeMultiprocessorCount, dev) != hipSuccess) { grid = -1; return; }
        if (hipFuncSetAttribute((const void*)fwd_kernel, hipFuncAttributeMaxDynamicSharedMemorySize, LDS_BYTES) != hipSuccess) { fprintf(stderr, "kernel_launch: hipFuncSetAttribute failed\n"); grid = -1; return; }
        if (hipOccupancyMaxActiveBlocksPerMultiprocessor(&per_cu, (const void*)fwd_kernel, NWAVES * 64, LDS_BYTES) != hipSuccess || per_cu < 1) { fprintf(stderr, "kernel_launch: occupancy query says %d\n", per_cu); per_cu = 1; }
        (void)hipGetLastError();
        grid = cus;
    }
    if (grid < 0) return;
    (void)hipMemsetAsync((char*)d_ws + WS_CTL + 16384, 0, 32768, stream);
    Args a{};
    for (int i = 0; i < 24; ++i) a.in[i] = (const float*)d_in[i];
    a.out = (float*)d_out; a.ws = (unsigned char*)d_ws;
#if MK_N_LAUNCHES == 1
    a.ph_lo = 0; a.ph_hi = N_PHASES;
    {   void* kargs[] = {(void*)&a};
        const hipError_t ce = hipLaunchCooperativeKernel((const void*)fwd_kernel, dim3(grid), dim3(NWAVES * 64), kargs, LDS_BYTES, stream);
        if (ce != hipSuccess) fprintf(stderr, "kernel_launch: cooperative launch failed: %s (grid %d)\n", hipGetErrorName(ce), grid); }
#else
    for (int p = 0; p < N_PHASES; ++p) { a.ph_lo = p; a.ph_hi = p + 1; hipLaunchKernelGGL(fwd_kernel, dim3(grid), dim3(NWAVES * 64), LDS_BYTES, stream, a); }
#endif
    const hipError_t le = hipPeekAtLastError();
    if (le != hipSuccess) fprintf(stderr, "kernel_launch: launch failed: %s\n", hipGetErrorName(le));
}
```

```cpp
#include <hip/hip_runtime.h>
#include <hip/hip_bf16.h>
#include <cstdio>
#include <cstdint>

#ifndef MK_N_LAUNCHES
#define MK_N_LAUNCHES 1
#endif

constexpr int BATCH = 2, SEQ = 8192, DM = 1024, MTOK = BATCH * SEQ;
constexpr int NPROJ = 4352;
constexpr int NEXP = 32, DFF = 1024, TOPK = 4;
constexpr int QLORA = 384, KVLORA = 256;
constexpr float RMS_EPS = 1e-6f;
constexpr float LOG2E = 1.4426950408889634f;
constexpr float C2NA = 0.125f * LOG2E;
constexpr float C2MLA = 0.10206207261596575f * LOG2E;
constexpr float SC_H2 = 8.f, SC_W = 64.f, SC_ACT = 4.f, SC_Y = 32.f;
constexpr int NG_INPROJ = 168;
constexpr int LISTCAP = 16384;
constexpr int MAXROWS = 65536 + NEXP * 256;

#define GAS __attribute__((address_space(1)))
#define LAS __attribute__((address_space(3)))
typedef unsigned short bf16_t;
typedef short bf16x8 __attribute__((ext_vector_type(8)));
typedef short s16x4 __attribute__((ext_vector_type(4)));
typedef float f32x4 __attribute__((ext_vector_type(4)));
typedef float f32x2 __attribute__((ext_vector_type(2)));
typedef float f32x16 __attribute__((ext_vector_type(16)));
typedef unsigned u32x4 __attribute__((ext_vector_type(4)));
typedef unsigned u32x2 __attribute__((ext_vector_type(2)));
typedef GAS unsigned gu32;

__device__ __forceinline__ unsigned cvt_pk_bf16(float lo, float hi) { unsigned r; asm volatile("v_cvt_pk_bf16_f32 %0, %1, %2" : "=v"(r) : "v"(lo), "v"(hi)); return r; }
__device__ __forceinline__ float bf16_lo(unsigned w) { return __uint_as_float(w << 16); }
__device__ __forceinline__ float bf16_hi(unsigned w) { return __uint_as_float(w & 0xffff0000u); }
__device__ __forceinline__ float sigmoidf_(float z) { return __builtin_amdgcn_rcpf(1.f + __builtin_amdgcn_exp2f(-z * LOG2E)); }
__device__ __forceinline__ float wave_sum(float v) {
#pragma unroll
    for (int o = 1; o < 64; o <<= 1) v += __shfl_xor(v, o);
    return v;
}
__device__ __forceinline__ void rope_cs(float pos, int j, float& c, float& s) {
    const float inv = __builtin_amdgcn_exp2f(-(float)j * 0.83048202372184059f);
    const float rev = __builtin_amdgcn_fractf(pos * inv * 0.15915494309189535f);
    c = __builtin_amdgcn_cosf(rev); s = __builtin_amdgcn_sinf(rev);
}

namespace pg8 {
constexpr int BM = 256, BK = 64, HALF = 128, HTB = HALF * BK * 2, STAGE_BYTES = 8 * HTB, NXCD = 8, WGM = 8;
__host__ __device__ __forceinline__ int lds_byte(int r, int c) { const int st = (r >> 4) * 2 + (c >> 5), rr = r & 15, cc = c & 31, ob = rr * 64 + cc * 2; return st * 1024 + (ob ^ (((ob >> 9) & 1) << 5)); }
__host__ __device__ __forceinline__ void stage_rc(int b, int& R, int& C) { const int st = b / 1024, sb = b % 1024, swz = sb ^ (((sb >> 9) & 1) << 5); R = (st >> 1) * 16 + swz / 64; C = (st & 1) * 32 + (swz % 64) / 2; }
__host__ __device__ __forceinline__ int perm32(int rho) { const int n = rho >> 4, i = rho & 15; return 8 * (i >> 2) + 4 * n + (i & 3); }

struct Unit { const char* A; const char* B; const char* A2; const char* B2; int pm, pn, aux, tab; };

__device__ __forceinline__ void tile_of(int wgid, int nM, int nN, int& pm, int& pn) {
    const int nwg = nM * nN;
    { const int q = nwg / NXCD, r = nwg % NXCD, xcd = wgid % NXCD, off = wgid / NXCD; wgid = (xcd < r ? xcd * (q + 1) : r * (q + 1) + (xcd - r) * q) + off; }
    const int nig = WGM * nN, gid = wgid / nig, fm = gid * WGM, gsz = (nM - fm) < WGM ? (nM - fm) : WGM;
    pm = fm + ((wgid % nig) % gsz); pn = (wgid % nig) / gsz;
}

typedef int v8i32 __attribute__((ext_vector_type(8)));
typedef int v4i32_ __attribute__((ext_vector_type(4)));
template <class Epi, class Sched, bool ALIGN_EPI, bool GATHER, bool FP8, bool DUAL = false>
__device__ __forceinline__ void gemm_phase(LAS unsigned char* lds, const int nt, const int ldab, const int ldbb, const Sched& S, const Epi& E) {
    const int tid = threadIdx.x, wid = __builtin_amdgcn_readfirstlane(tid >> 6), lane = tid & 63, wr = wid >> 2, wc = wid & 3, fr = lane & 15, fq = lane >> 4;
    int Rr[2], Cc[2];
    unsigned voffA[2], voffB[2];
#pragma unroll
    for (int i = 0; i < 2; ++i) { int R, C; stage_rc(tid * 16 + i * 8192, R, C); const int Rb = Epi::PERM ? ((R & ~31) + perm32(R & 31)) : R;
        Rr[i] = R; Cc[i] = C; voffA[i] = (unsigned)(R * ldab + C * 2); voffB[i] = (unsigned)(Rb * ldbb + C * 2); }
    const size_t kstep = (size_t)(BK * 2);
    const size_t hstepA = (size_t)HALF * ldab, hstepB = (size_t)HALF * ldbb;
    const unsigned ldsw = (unsigned)wid * 1024u;
    const int aoff = lds_byte(wr * 64 + fr, fq * 8), boff = lds_byte(wc * 32 + fr, fq * 8);
#define PG8_SA(b, h) (((b) * 2 + (h)) * HTB)
#define PG8_SB(b, h) ((4 + (b) * 2 + (h)) * HTB)
#define PG8_STAGE(bufoff, gbase, voff) do { _Pragma("unroll") for (int _i = 0; _i < 2; ++_i) \
        __builtin_amdgcn_global_load_lds((const unsigned*)((const char*)(gbase) + (voff)[_i]), (LAS unsigned*)(lds + (bufoff) + ldsw + _i * 8192), 16, 0, 0); } while (0)
#define PG8_STAGE_A(bufoff, gbase, h, G) do { if constexpr (GATHER) { PG8_STAGE(bufoff, gbase, (G)[h]); } else { PG8_STAGE(bufoff, (gbase) + (h) * hstepA, voffA); } } while (0)
#define PG8_STAGE_B(bufoff, gbase, h) PG8_STAGE(bufoff, (gbase) + (h) * hstepB, voffB)
#define PG8_LD8(addr) __builtin_shufflevector(*(const LAS v4i32_*)(addr), *(const LAS v4i32_*)((addr) + 1024), 0, 1, 2, 3, 4, 5, 6, 7)
#define PG8_LDA(dst, b, h) do { if constexpr (FP8) { _Pragma("unroll") for (int m = 0; m < 4; ++m) dst##8[m] = PG8_LD8(lds + PG8_SA(b, h) + aoff + m * 2048); } \
        else { _Pragma("unroll") for (int m = 0; m < 4; ++m) _Pragma("unroll") for (int k = 0; k < 2; ++k) dst[m][k] = *(const LAS bf16x8*)(lds + PG8_SA(b, h) + aoff + m * 2048 + k * 1024); } } while (0)
#define PG8_LDB(dst, b, h) do { if constexpr (FP8) { _Pragma("unroll") for (int n = 0; n < 2; ++n) dst##8[n] = PG8_LD8(lds + PG8_SB(b, h) + boff + n * 2048); } \
        else { _Pragma("unroll") for (int n = 0; n < 2; ++n) _Pragma("unroll") for (int k = 0; k < 2; ++k) dst[n][k] = *(const LAS bf16x8*)(lds + PG8_SB(b, h) + boff + n * 2048 + k * 1024); } } while (0)
#define PG8_MMA(ai, bj, At, Bt) do { __builtin_amdgcn_s_setprio(1); _Pragma("unroll") for (int m = 0; m < 4; ++m) _Pragma("unroll") for (int n = 0; n < 2; ++n) { \
        if constexpr (FP8) { asm volatile("v_mfma_scale_f32_16x16x128_f8f6f4 %0, %1, %2, %0, %3, %3 op_sel_hi:[0,0,0]" : "+v"(acc[ai][bj][m][n]) : "v"(Bt##8[n]), "v"(At##8[m]), "v"(sc1_)); } \
        else { _Pragma("unroll") for (int k = 0; k < 2; ++k) acc[ai][bj][m][n] = __builtin_amdgcn_mfma_f32_16x16x32_bf16(Bt[n][k], At[m][k], acc[ai][bj][m][n], 0, 0, 0); } } \
        __builtin_amdgcn_s_setprio(0); } while (0)
#define PG8_WAIT_V(n) asm volatile("s_waitcnt vmcnt(" #n ")" ::: "memory")
#define PG8_WAIT_L(n) asm volatile("s_waitcnt lgkmcnt(" #n ")" ::: "memory")
#define PG8_BAR __builtin_amdgcn_s_barrier()
#define PG8_SCHED __builtin_amdgcn_sched_barrier(0)
    Unit cur, nxt; int ui = 0;
    if (!S.next(0, cur)) return;
    f32x4 acc[2][2][4][2];
#pragma unroll
    for (int a = 0; a < 2; ++a)
#pragma unroll
        for (int b = 0; b < 2; ++b)
#pragma unroll
            for (int m = 0; m < 4; ++m)
#pragma unroll
                for (int n = 0; n < 2; ++n) acc[a][b][m][n] = (f32x4){0.f, 0.f, 0.f, 0.f};
    bf16x8 At[4][2], B0[2][2], B1[2][2]; v8i32 At8[4], B08[2], B18[2];
    int sc1_ = 0x7F7F7F7F; asm volatile("" : "+v"(sc1_));
    unsigned gC[2][2], gN[2][2];
#define PG8_GLOAD(G, u) do { if constexpr (GATHER) { const LAS unsigned* tb_ = (const LAS unsigned*)(lds + (u).tab); _Pragma("unroll") for (int h_ = 0; h_ < 2; ++h_) _Pragma("unroll") for (int i_ = 0; i_ < 2; ++i_) \
        (G)[h_][i_] = tb_[h_ * 128 + Rr[i_]] + (unsigned)(Cc[i_] * 2); } } while (0)
    PG8_GLOAD(gC, cur);
    const char* cA = cur.A; const char* cB = cur.B; const char* cA2 = cur.A2; const char* cB2 = cur.B2; const int nth = nt >> 1;
    PG8_STAGE_B(PG8_SB(0, 0), cB, 0); PG8_STAGE_B(PG8_SB(0, 1), cB, 1); PG8_STAGE_A(PG8_SA(0, 0), cA, 0, gC); PG8_STAGE_A(PG8_SA(0, 1), cA, 1, gC);
    if (wr == 1) PG8_BAR;
    PG8_WAIT_V(2); PG8_BAR;
    PG8_STAGE_B(PG8_SB(1, 0), cB + kstep, 0); PG8_STAGE_A(PG8_SA(1, 0), cA + kstep, 0, gC); PG8_STAGE_B(PG8_SB(1, 1), cB + kstep, 1);
    PG8_WAIT_V(6); PG8_BAR;
    for (;;) {
        const bool has_next = S.next(ui + 1, nxt);
        const char* nA = has_next ? nxt.A : cA; const char* nB = has_next ? nxt.B : cB;
        if constexpr (GATHER) { if (has_next) { PG8_GLOAD(gN, nxt); } else {
#pragma unroll
            for (int h_ = 0; h_ < 2; ++h_)
#pragma unroll
                for (int i_ = 0; i_ < 2; ++i_) gN[h_][i_] = gC[h_][i_]; } }
#pragma unroll 1
        for (int t = 0; t < nt; t += 2) {
            const bool last = (t == nt - 2);
            if constexpr (DUAL) { if (t == nth) E.mid(acc, cur, wr, wc, fr, fq); }
#define PG8_TILEA(tt) (((DUAL && (tt) >= nth) ? cA2 - (size_t)nth * kstep : cA) + (size_t)(tt) * kstep)
#define PG8_TILEB(tt) (((DUAL && (tt) >= nth) ? cB2 - (size_t)nth * kstep : cB) + (size_t)(tt) * kstep)
            const char* a1 = PG8_TILEA(t + 1);
            const char* a2 = last ? nA : PG8_TILEA(t + 2); const char* b2 = last ? nB : PG8_TILEB(t + 2);
            const char* a3 = a2 + kstep; const char* b3 = b2 + kstep;
            unsigned g2[2][2];
            if constexpr (GATHER) {
#pragma unroll
                for (int h_ = 0; h_ < 2; ++h_)
#pragma unroll
                    for (int i_ = 0; i_ < 2; ++i_) g2[h_][i_] = last ? gN[h_][i_] : gC[h_][i_]; }
            PG8_LDB(B0, 0, 0); PG8_LDB(B1, 0, 1); PG8_SCHED; PG8_LDA(At, 0, 0); PG8_STAGE_A(PG8_SA(1, 1), a1, 1, gC);
            PG8_WAIT_V(8); PG8_WAIT_L(0); PG8_BAR; PG8_MMA(0, 0, At, B0); PG8_MMA(0, 1, At, B1); PG8_BAR; PG8_SCHED;
            PG8_LDA(At, 0, 1); PG8_STAGE_B(PG8_SB(0, 0), b2, 0); PG8_STAGE_B(PG8_SB(0, 1), b2, 1); PG8_STAGE_A(PG8_SA(0, 0), a2, 0, g2);
            PG8_WAIT_V(8); PG8_WAIT_L(0); PG8_BAR; PG8_MMA(1, 0, At, B0); PG8_MMA(1, 1, At, B1); PG8_BAR; PG8_SCHED;
            PG8_LDB(B0, 1, 0); PG8_LDB(B1, 1, 1); PG8_SCHED; PG8_LDA(At, 1, 0); PG8_STAGE_A(PG8_SA(0, 1), a2, 1, g2);
            PG8_WAIT_V(8); PG8_WAIT_L(0); PG8_BAR; PG8_MMA(0, 0, At, B0); PG8_MMA(0, 1, At, B1); PG8_BAR; PG8_SCHED;
            PG8_LDA(At, 1, 1); PG8_STAGE_B(PG8_SB(1, 0), b3, 0); PG8_STAGE_B(PG8_SB(1, 1), b3, 1); PG8_STAGE_A(PG8_SA(1, 0), a3, 0, g2);
            PG8_WAIT_V(8); PG8_WAIT_L(0); PG8_BAR; PG8_MMA(1, 0, At, B0); PG8_MMA(1, 1, At, B1); PG8_BAR; PG8_SCHED;
        }
        if constexpr (ALIGN_EPI) { if (wr == 0) PG8_BAR; }
        if constexpr (FP8) asm volatile("s_nop 15\n\ts_nop 15" ::: "memory");
        E(acc, cur, wr, wc, fr, fq);
        if (!has_next) break;
#pragma unroll
        for (int a = 0; a < 2; ++a)
#pragma unroll
            for (int b = 0; b < 2; ++b)
#pragma unroll
                for (int m = 0; m < 4; ++m)
#pragma unroll
                    for (int n = 0; n < 2; ++n) acc[a][b][m][n] = (f32x4){0.f, 0.f, 0.f, 0.f};
        cur = nxt; cA = nA; cB = nB; cA2 = cur.A2; cB2 = cur.B2; ++ui;
        if constexpr (GATHER) {
#pragma unroll
            for (int h_ = 0; h_ < 2; ++h_)
#pragma unroll
                for (int i_ = 0; i_ < 2; ++i_) gC[h_][i_] = gN[h_][i_]; }
        if constexpr (ALIGN_EPI) { if (wr == 1) PG8_BAR; }
    }
    PG8_WAIT_V(0);
    if constexpr (!ALIGN_EPI) { if (wr == 0) PG8_BAR; }
    PG8_BAR;
#undef PG8_SA
#undef PG8_SB
#undef PG8_STAGE
#undef PG8_STAGE_A
#undef PG8_STAGE_B
#undef PG8_LDA
#undef PG8_LD8
#undef PG8_LDB
#undef PG8_MMA
#undef PG8_WAIT_V
#undef PG8_WAIT_L
#undef PG8_BAR
#undef PG8_SCHED
#undef PG8_GLOAD
#undef PG8_TILEA
#undef PG8_TILEB
}

typedef f32x4 Acc[2][2][4][2];

struct SchedDense {
    const char* A; const char* B; size_t a_tile_bytes, b_tile_bytes; int nM, nN, G, c;
    __device__ __forceinline__ bool next(int i, Unit& u) const {
        const long L = (long)i * G + c; if (L >= (long)nM * nN) return false;
        int pm, pn; tile_of((int)L, nM, nN, pm, pn);
        u.pm = pm; u.pn = pn; u.aux = 0; u.tab = 0; u.A = A + (size_t)pm * a_tile_bytes; u.B = B + (size_t)pn * b_tile_bytes; u.A2 = u.A; u.B2 = u.B; return true;
    }
};
struct SchedMerge {
    const char* A0; const char* A1; const char* B0; const char* B1; int nM, nN, G, c;
    __device__ __forceinline__ bool next(int i, Unit& u) const {
        const long T = (long)i * G + c; if (T >= (long)nM * nN) return false;
        int pm, pn; tile_of((int)T, nM, nN, pm, pn);
        u.pm = pm; u.pn = pn; u.aux = 0; u.tab = 0;
        u.A = A0 + (size_t)pm * (256 * 512 * 2); u.B = B0 + (size_t)pn * (256 * 512 * 2); u.A2 = A1 + (size_t)pm * (256 * 512 * 2); u.B2 = B1 + (size_t)pn * (256 * 512 * 2); return true;
    }
};
template <int NPN, bool GATHER>
struct SchedMoe {
    const char* A; const char* B; size_t b_expert_bytes; LAS const int* blk_e; int NB, G, c, tab0;
    __device__ __forceinline__ bool next(int i, Unit& u) const {
        const long L = (long)i * G + c; if (L >= (long)NB * NPN) return false;
        const int grb = (int)(L / NPN), pn = (int)(L % NPN);
        const int e = __builtin_amdgcn_readfirstlane(blk_e[grb]);
        u.pm = grb; u.pn = pn; u.aux = e; u.tab = tab0 + i * 1024;
        u.A = GATHER ? A : A + (size_t)grb * (256 * 1024);
        u.B = B + (size_t)e * b_expert_bytes + (size_t)pn * (256 * 1024); u.A2 = u.A; u.B2 = u.B; return true;
    }
};

struct EpiInProj {
    static constexpr bool PERM = true;
    bf16_t* PROJ; float* SSQ; bf16_t* KR; const float* ROPE; const float* bgate;
    __device__ __forceinline__ void operator()(const Acc& acc, const Unit& u, int wr, int wc, int fr, int fq) const {
        const int pn = u.pn, row0 = u.pm * BM + wr * 64 + fr, colb = pn * BM + wc * 32 + 8 * fq;
        const float sc = (pn < 2) ? C2NA : 1.f;
        f32x4 gb[2][2];
#pragma unroll
        for (int bj = 0; bj < 2; ++bj)
#pragma unroll
            for (int n = 0; n < 2; ++n) gb[bj][n] = (pn >= 9) ? *(const f32x4*)(bgate + (colb - 2304) + bj * HALF + 4 * n) : (f32x4){0.f, 0.f, 0.f, 0.f};
#pragma unroll
        for (int ai = 0; ai < 2; ++ai)
#pragma unroll
            for (int m = 0; m < 4; ++m) { const int row = row0 + ai * HALF + m * 16; bf16_t* rowp = PROJ + (size_t)row * NPROJ + colb;
#pragma unroll
                for (int bj = 0; bj < 2; ++bj) { const f32x4 v0 = acc[ai][bj][m][0] * sc + gb[bj][0], v1 = acc[ai][bj][m][1] * sc + gb[bj][1]; u32x4 w;
                    w.x = cvt_pk_bf16(v0[0], v0[1]); w.y = cvt_pk_bf16(v0[2], v0[3]); w.z = cvt_pk_bf16(v1[0], v1[1]); w.w = cvt_pk_bf16(v1[2], v1[3]);
                    *(u32x4*)(rowp + bj * HALF) = w; } }
        if (pn >= 6 && pn <= 8) {
#pragma unroll
            for (int ai = 0; ai < 2; ++ai)
#pragma unroll
                for (int m = 0; m < 4; ++m) { const int row = row0 + ai * HALF + m * 16; float s[2];
#pragma unroll
                    for (int bj = 0; bj < 2; ++bj) { const f32x4 a = acc[ai][bj][m][0], b = acc[ai][bj][m][1];
                        float t = (a[0] * a[0] + a[1] * a[1]) + (a[2] * a[2] + a[3] * a[3]) + (b[0] * b[0] + b[1] * b[1]) + (b[2] * b[2] + b[3] * b[3]);
                        t += __shfl_xor(t, 16); t += __shfl_xor(t, 32); s[bj] = t; }
                    if (fq == 0) {
                        float* sp = SSQ + (size_t)row * 16 + wc;
                        if (pn == 6) { sp[0] = s[0] + s[1]; }
                        else if (pn == 7) { sp[4] = s[0]; sp[8] = s[1]; }
                        else { sp[12] = s[0]; }
                    } }
            if (pn == 8 && wc == 0) {
#pragma unroll
                for (int ai = 0; ai < 2; ++ai)
#pragma unroll
                    for (int m = 0; m < 4; ++m) { const int row = row0 + ai * HALF + m * 16, tok = row & (SEQ - 1);
                        const int pos = (fq >> 1) ? (tok & 63) : (tok >> 6); float o[8];
                        const f32x4 cs4 = *(const f32x4*)(ROPE + pos * 16 + 4 * (fq & 1)), sn4 = *(const f32x4*)(ROPE + pos * 16 + 8 + 4 * (fq & 1));
#pragma unroll
                        for (int n = 0; n < 2; ++n)
#pragma unroll
                            for (int q = 0; q < 2; ++q) { const float c = cs4[2 * n + q], s = sn4[2 * n + q];
                                const float x1 = acc[ai][1][m][n][2 * q], x2 = acc[ai][1][m][n][2 * q + 1];
                                o[4 * n + 2 * q] = x1 * c - x2 * s; o[4 * n + 2 * q + 1] = x1 * s + x2 * c; }
                        u32x4 w; w.x = cvt_pk_bf16(o[0], o[1]); w.y = cvt_pk_bf16(o[2], o[3]); w.z = cvt_pk_bf16(o[4], o[5]); w.w = cvt_pk_bf16(o[6], o[7]);
                        *(u32x4*)(KR + (size_t)row * 32 + 8 * fq) = w; }
            }
        }
    }
};
struct EpiQUp {
    static constexpr bool PERM = true;
    bf16_t* QN; bf16_t* QR; const float* SSQ; const float* ROPE;
    __device__ __forceinline__ void operator()(const Acc& acc, const Unit& u, int wr, int wc, int fr, int fq) const {
        const int pn = u.pn, row0 = u.pm * BM + wr * 64 + fr, colt = wc * 32 + 8 * fq;
#pragma unroll
        for (int ai = 0; ai < 2; ++ai)
#pragma unroll
            for (int m = 0; m < 4; ++m) { const int row = row0 + ai * HALF + m * 16;
                const f32x4 q0_ = *(const f32x4*)(SSQ + (size_t)row * 16), q1_ = *(const f32x4*)(SSQ + (size_t)row * 16 + 4);
                const float rs = __builtin_amdgcn_rsqf((((q0_[0] + q0_[1]) + (q0_[2] + q0_[3])) + ((q1_[0] + q1_[1]) + (q1_[2] + q1_[3]))) * (1.f / QLORA) + RMS_EPS) * C2MLA;
                if (pn < 2) {
#pragma unroll
                    for (int bj = 0; bj < 2; ++bj) { const f32x4 v0 = acc[ai][bj][m][0] * rs, v1 = acc[ai][bj][m][1] * rs; u32x4 w;
                        w.x = cvt_pk_bf16(v0[0], v0[1]); w.y = cvt_pk_bf16(v0[2], v0[3]); w.z = cvt_pk_bf16(v1[0], v1[1]); w.w = cvt_pk_bf16(v1[2], v1[3]);
                        *(u32x4*)(QN + (size_t)row * 512 + pn * 256 + bj * HALF + colt) = w; }
                } else {
                    const int tok = row & (SEQ - 1); const int pos = (fq >> 1) ? (tok & 63) : (tok >> 6);
                    const f32x4 cs4 = *(const f32x4*)(ROPE + pos * 16 + 4 * (fq & 1)), sn4 = *(const f32x4*)(ROPE + pos * 16 + 8 + 4 * (fq & 1));
#pragma unroll
                    for (int bj = 0; bj < 2; ++bj) { float o[8];
#pragma unroll
                        for (int n = 0; n < 2; ++n)
#pragma unroll
                            for (int q = 0; q < 2; ++q) { const float c = cs4[2 * n + q], s = sn4[2 * n + q];
                                const float x1 = acc[ai][bj][m][n][2 * q] * rs, x2 = acc[ai][bj][m][n][2 * q + 1] * rs;
                                o[4 * n + 2 * q] = x1 * c - x2 * s; o[4 * n + 2 * q + 1] = x1 * s + x2 * c; }
                        u32x4 w; w.x = cvt_pk_bf16(o[0], o[1]); w.y = cvt_pk_bf16(o[2], o[3]); w.z = cvt_pk_bf16(o[4], o[5]); w.w = cvt_pk_bf16(o[6], o[7]);
                        *(u32x4*)(QR + (size_t)row * 256 + bj * HALF + colt) = w; }
                }
                asm volatile("" ::: "memory"); }
    }
};
struct EpiKVUp {
    static constexpr bool PERM = true;
    bf16_t* KN; bf16_t* VM; const float* SSQ;
    __device__ __forceinline__ void operator()(const Acc& acc, const Unit& u, int wr, int wc, int fr, int fq) const {
        const int pn = u.pn, row0 = u.pm * BM + wr * 64 + fr, colt = wc * 32 + 8 * fq;
        bf16_t* dst = (pn < 2) ? KN + pn * 256 : VM + (pn - 2) * 256;
#pragma unroll
        for (int ai = 0; ai < 2; ++ai)
#pragma unroll
            for (int m = 0; m < 4; ++m) { const int row = row0 + ai * HALF + m * 16;
                const f32x4 q0_ = *(const f32x4*)(SSQ + (size_t)row * 16 + 8), q1_ = *(const f32x4*)(SSQ + (size_t)row * 16 + 12);
                const float rs = __builtin_amdgcn_rsqf((((q0_[0] + q0_[1]) + (q0_[2] + q0_[3])) + ((q1_[0] + q1_[1]) + (q1_[2] + q1_[3]))) * (1.f / KVLORA) + RMS_EPS);
#pragma unroll
                for (int bj = 0; bj < 2; ++bj) { const f32x4 v0 = acc[ai][bj][m][0] * rs, v1 = acc[ai][bj][m][1] * rs; u32x4 w;
                    w.x = cvt_pk_bf16(v0[0], v0[1]); w.y = cvt_pk_bf16(v0[2], v0[3]); w.z = cvt_pk_bf16(v1[0], v1[1]); w.w = cvt_pk_bf16(v1[2], v1[3]);
                    *(u32x4*)(dst + (size_t)row * 512 + bj * HALF + colt) = w; } }
    }
};
struct EpiMerge {
    static constexpr bool PERM = true;
    const bf16_t* PROJ; bf16_t* MERGED;
    __device__ __forceinline__ void mid(Acc& acc, const Unit& u, int wr, int wc, int fr, int fq) const {
        int row0 = u.pm * BM + wr * 64 + fr; const int col0 = u.pn * BM + wc * 32 + 8 * fq;
        asm volatile("" : "+v"(row0));
#pragma unroll
        for (int ai = 0; ai < 2; ++ai)
#pragma unroll
            for (int m = 0; m < 4; ++m) { const bf16_t* rp = PROJ + (size_t)(row0 + ai * HALF + m * 16) * NPROJ + 2304 + col0;
#pragma unroll
                for (int bj = 0; bj < 2; ++bj) { const u32x4 g1 = *(const u32x4*)(rp + bj * HALF), g2 = *(const u32x4*)(rp + 1024 + bj * HALF);
                    const unsigned w1[4] = {g1.x, g1.y, g1.z, g1.w}, w2[4] = {g2.x, g2.y, g2.z, g2.w};
#pragma unroll
                    for (int q = 0; q < 4; ++q) { const int n = q >> 1, i = (q & 1) * 2;
                        const float r0 = (1.f + __builtin_amdgcn_exp2f(-bf16_lo(w2[q]) * LOG2E)) * __builtin_amdgcn_rcpf(1.f + __builtin_amdgcn_exp2f(-bf16_lo(w1[q]) * LOG2E));
                        const float r1 = (1.f + __builtin_amdgcn_exp2f(-bf16_hi(w2[q]) * LOG2E)) * __builtin_amdgcn_rcpf(1.f + __builtin_amdgcn_exp2f(-bf16_hi(w1[q]) * LOG2E));
                        acc[ai][bj][m][n][i] *= r0; acc[ai][bj][m][n][i + 1] *= r1; } }
                asm volatile("" ::: "memory"); }
    }
    __device__ __forceinline__ void operator()(const Acc& acc, const Unit& u, int wr, int wc, int fr, int fq) const {
        const int row0 = u.pm * BM + wr * 64 + fr, col0 = u.pn * BM + wc * 32 + 8 * fq;
#pragma unroll
        for (int ai = 0; ai < 2; ++ai)
#pragma unroll
            for (int m = 0; m < 4; ++m) { const int row = row0 + ai * HALF + m * 16; const bf16_t* rp = PROJ + (size_t)row * NPROJ + 3328 + col0;
#pragma unroll
                for (int bj = 0; bj < 2; ++bj) { const u32x4 g2 = *(const u32x4*)(rp + bj * HALF);
                    f32x4 s0, s1;
                    s0[0] = sigmoidf_(bf16_lo(g2.x)); s0[1] = sigmoidf_(bf16_hi(g2.x)); s0[2] = sigmoidf_(bf16_lo(g2.y)); s0[3] = sigmoidf_(bf16_hi(g2.y));
                    s1[0] = sigmoidf_(bf16_lo(g2.z)); s1[1] = sigmoidf_(bf16_hi(g2.z)); s1[2] = sigmoidf_(bf16_lo(g2.w)); s1[3] = sigmoidf_(bf16_hi(g2.w));
                    const f32x4 v0 = acc[ai][bj][m][0] * s0, v1 = acc[ai][bj][m][1] * s1; u32x4 w;
                    w.x = cvt_pk_bf16(v0[0], v0[1]); w.y = cvt_pk_bf16(v0[2], v0[3]); w.z = cvt_pk_bf16(v1[0], v1[1]); w.w = cvt_pk_bf16(v1[2], v1[3]);
                    *(u32x4*)(MERGED + (size_t)row * 1024 + col0 + bj * HALF) = w; }
                asm volatile("" ::: "memory"); }
    }
};
struct EpiBf16Y {
    static constexpr bool PERM = true;
    bf16_t* C;
    __device__ __forceinline__ void operator()(const Acc& acc, const Unit& u, int wr, int wc, int fr, int fq) const {
        const int row0 = u.pm * BM + wr * 64 + fr, col0 = u.pn * BM + wc * 32 + 8 * fq;
#pragma unroll
        for (int ai = 0; ai < 2; ++ai)
#pragma unroll
            for (int m = 0; m < 4; ++m) { bf16_t* rowp = C + (size_t)(row0 + ai * HALF + m * 16) * 1024 + col0;
#pragma unroll
                for (int bj = 0; bj < 2; ++bj) { const f32x4 v0 = acc[ai][bj][m][0], v1 = acc[ai][bj][m][1]; u32x4 w;
                    w.x = cvt_pk_bf16(v0[0], v0[1]); w.y = cvt_pk_bf16(v0[2], v0[3]); w.z = cvt_pk_bf16(v1[0], v1[1]); w.w = cvt_pk_bf16(v1[2], v1[3]);
                    *(u32x4*)(rowp + bj * HALF) = w; } }
    }
};
struct EpiMoe1 {
    static constexpr bool PERM = true;
    const float* b1; unsigned char* ACT;
    __device__ __forceinline__ void operator()(const Acc& acc, const Unit& u, int wr, int wc, int fr, int fq) const {
        const int e = u.aux, row0 = u.pm * BM + wr * 64 + fr, col0 = u.pn * BM + wc * 32 + 8 * fq;
        constexpr float DS = 1.f / (SC_H2 * SC_W);
        f32x4 bv[2][2];
#pragma unroll
        for (int bj = 0; bj < 2; ++bj)
#pragma unroll
            for (int n = 0; n < 2; ++n) bv[bj][n] = *(const f32x4*)(b1 + (size_t)e * 2048 + col0 + bj * HALF + 4 * n);
#pragma unroll
        for (int ai = 0; ai < 2; ++ai)
#pragma unroll
            for (int m = 0; m < 4; ++m) { const int row = row0 + ai * HALF + m * 16;
#pragma unroll
                for (int bj = 0; bj < 2; ++bj) { float o[4];
#pragma unroll
                    for (int n = 0; n < 2; ++n) { const f32x4 v = acc[ai][bj][m][n] * DS + bv[bj][n];
#pragma unroll
                        for (int q = 0; q < 2; ++q) { const float xg = fminf(v[2 * q], 7.f), xl = __builtin_amdgcn_fmed3f(v[2 * q + 1], -7.f, 7.f);
                            const float sg = __builtin_amdgcn_rcpf(1.f + __builtin_amdgcn_exp2f(xg * (-1.702f * LOG2E)));
                            o[2 * n + q] = (xg * sg) * __builtin_fmaf(xl, SC_ACT, SC_ACT); } }
                    int w = __builtin_amdgcn_cvt_pk_fp8_f32(o[0], o[1], 0, false); w = __builtin_amdgcn_cvt_pk_fp8_f32(o[2], o[3], w, true);
                    *(int*)(ACT + (size_t)row * 1024 + ((col0 + bj * HALF) >> 1)) = w; } }
    }
};
struct EpiMoe2 {
    static constexpr bool PERM = true;
    const float* b2; unsigned char* YIT;
    __device__ __forceinline__ void operator()(const Acc& acc, const Unit& u, int wr, int wc, int fr, int fq) const {
        const int e = u.aux, row0 = u.pm * BM + wr * 64 + fr, col0 = u.pn * BM + wc * 32 + 8 * fq;
        constexpr float DS = SC_Y / (SC_ACT * SC_W);
        f32x4 bv[2][2];
#pragma unroll
        for (int bj = 0; bj < 2; ++bj)
#pragma unroll
            for (int n = 0; n < 2; ++n) bv[bj][n] = *(const f32x4*)(b2 + (size_t)e * 1024 + col0 + bj * HALF + 4 * n) * SC_Y;
#pragma unroll
        for (int ai = 0; ai < 2; ++ai)
#pragma unroll
            for (int m = 0; m < 4; ++m) { const int row = row0 + ai * HALF + m * 16;
#pragma unroll
                for (int bj = 0; bj < 2; ++bj) { f32x4 v0 = acc[ai][bj][m][0] * DS + bv[bj][0], v1 = acc[ai][bj][m][1] * DS + bv[bj][1];
                    v0 = __builtin_elementwise_min(__builtin_elementwise_max(v0, (f32x4){-448.f, -448.f, -448.f, -448.f}), (f32x4){448.f, 448.f, 448.f, 448.f});
                    v1 = __builtin_elementwise_min(__builtin_elementwise_max(v1, (f32x4){-448.f, -448.f, -448.f, -448.f}), (f32x4){448.f, 448.f, 448.f, 448.f});
                    u32x2 w; int t = __builtin_amdgcn_cvt_pk_fp8_f32(v0[0], v0[1], 0, false); t = __builtin_amdgcn_cvt_pk_fp8_f32(v0[2], v0[3], t, true); w.x = (unsigned)t;
                    t = __builtin_amdgcn_cvt_pk_fp8_f32(v1[0], v1[1], 0, false); t = __builtin_amdgcn_cvt_pk_fp8_f32(v1[2], v1[3], t, true); w.y = (unsigned)t;
                    *(u32x2*)(YIT + (size_t)row * 1024 + col0 + bj * HALF) = w; } }
    }
};
}

namespace attn {
#define SBAR() __builtin_amdgcn_sched_barrier(0)
constexpr int NW = 8, QBLK = 32, KVBLK = 64;
constexpr float THR = 8.f;
__device__ __forceinline__ int crow(int r, int hi) { return (r & 3) + 8 * (r >> 2) + 4 * hi; }
constexpr int KROW_MLA = 96 * 2 + 16, KROW_NA = 64 * 2 + 16;
constexpr int SHM_K = 64 * KROW_MLA  , SHM_V = 64 * 64 * 2  ;
constexpr int OFF_V = 0, OFF_K = 4 * SHM_V, OFF_WS = OFF_K + 4 * SHM_K, OFF_OST = OFF_WS + NW * 256, OFF_BIAS = OFF_OST + NW * 4096, ATTN_LDS = OFF_BIAS + 2048;

__device__ __forceinline__ int v_st(int k, int c) { const int kk = (k & ~0xC) | ((k & 4) << 1) | ((k & 8) >> 1); return ((kk >> 3) * 2 + (c >> 5)) * 512 + ((kk & 7) * 32 + (c & 31)) * 2; }
__device__ __forceinline__ int v_rd_base(int lane) { return ((lane & 3) << 3) | (((lane >> 2) & 3) << 6) | (((lane >> 4) & 1) << 5) | (((lane >> 5) & 1) << 8); }
constexpr int v_rd_off(int d0, int ks, int half) { return d0 * 512 + ks * 2048 + half * 1024; }
template <int OFF> __device__ __forceinline__ s16x4 tr_read(int vb) {
    s16x4 r; asm volatile("ds_read_b64_tr_b16 %0, %1 offset:%2" : "=&v"(r) : "v"(vb), "i"(OFF) : "memory"); return r;
}
template <int D0> __device__ __forceinline__ void pv_one(f32x16& od, int vb, bf16x8 pa0, bf16x8 pa1, bf16x8 pa2, bf16x8 pa3) {
    const s16x4 l0 = tr_read<v_rd_off(D0, 0, 0)>(vb), h0 = tr_read<v_rd_off(D0, 0, 1)>(vb), l1 = tr_read<v_rd_off(D0, 1, 0)>(vb), h1 = tr_read<v_rd_off(D0, 1, 1)>(vb);
    const s16x4 l2 = tr_read<v_rd_off(D0, 2, 0)>(vb), h2 = tr_read<v_rd_off(D0, 2, 1)>(vb), l3 = tr_read<v_rd_off(D0, 3, 0)>(vb), h3 = tr_read<v_rd_off(D0, 3, 1)>(vb);
    asm volatile("s_waitcnt lgkmcnt(0)" ::: "memory"); SBAR();
#define PK(L, H) (bf16x8){L[0], L[1], L[2], L[3], H[0], H[1], H[2], H[3]}
    od = __builtin_amdgcn_mfma_f32_32x32x16_bf16(pa0, PK(l0, h0), od, 0, 0, 0);
    od = __builtin_amdgcn_mfma_f32_32x32x16_bf16(pa1, PK(l1, h1), od, 0, 0, 0);
    od = __builtin_amdgcn_mfma_f32_32x32x16_bf16(pa2, PK(l2, h2), od, 0, 0, 0);
    od = __builtin_amdgcn_mfma_f32_32x32x16_bf16(pa3, PK(l3, h3), od, 0, 0, 0);
#undef PK
}
__device__ __forceinline__ void pv_d0(f32x16* o, int vb, bf16x8 pa0, bf16x8 pa1, bf16x8 pa2, bf16x8 pa3) {
    pv_one<0>(o[0], vb, pa0, pa1, pa2, pa3); pv_one<1>(o[1], vb, pa0, pa1, pa2, pa3);
}
__device__ __forceinline__ void partialSM(f32x16& p0, f32x16& p1, float& m_ref, f32x16& negm, float& alpha, bool& fresh) {
    float pmax = p0[0];
#pragma unroll
    for (int r = 1; r < 16; ++r) pmax = fmaxf(pmax, p0[r]);
#pragma unroll
    for (int r = 0; r < 16; ++r) pmax = fmaxf(pmax, p1[r]);
    { auto rr = __builtin_amdgcn_permlane32_swap(__float_as_uint(pmax), __float_as_uint(pmax), false, false);
      pmax = fmaxf(__uint_as_float(rr[0]), __uint_as_float(rr[1])); }
    alpha = 1.f;
    if (__builtin_expect(fresh || !__all(pmax <= THR), 0)) {
        const float dl = fresh ? pmax : fmaxf(pmax, 0.f);
        m_ref += dl;
#pragma unroll
        for (int r = 0; r < 16; ++r) { p0[r] -= dl; p1[r] -= dl; }
        const float nm = -m_ref;
#pragma unroll
        for (int r = 0; r < 16; ++r) negm[r] = nm;
        alpha = fresh ? 1.f : __builtin_amdgcn_exp2f(-dl);
        fresh = false;
    }
#pragma unroll
    for (int r = 0; r < 16; ++r) p0[r] = __builtin_amdgcn_exp2f(p0[r]);
}
__device__ __forceinline__ void finishSM(f32x16& p0, f32x16& p1, float alpha, float& l_reg, bf16x8& pa0, bf16x8& pa1, bf16x8& pa2, bf16x8& pa3) {
#pragma unroll
    for (int r = 0; r < 16; ++r) p1[r] = __builtin_amdgcn_exp2f(p1[r]);
    float ps = 0;
#pragma unroll
    for (int r = 0; r < 16; ++r) ps += p0[r];
#pragma unroll
    for (int r = 0; r < 16; ++r) ps += p1[r];
    { auto rr = __builtin_amdgcn_permlane32_swap(__float_as_uint(ps), __float_as_uint(ps), false, false);
      ps = __uint_as_float(rr[0]) + __uint_as_float(rr[1]); }
    l_reg = l_reg * alpha + ps;
#define PK4(P, BASE, OUT) do { unsigned a0 = cvt_pk_bf16(P[BASE + 0], P[BASE + 1]), a1 = cvt_pk_bf16(P[BASE + 2], P[BASE + 3]);   \
    unsigned b0 = cvt_pk_bf16(P[BASE + 4], P[BASE + 5]), b1 = cvt_pk_bf16(P[BASE + 6], P[BASE + 7]);                              \
    auto r0 = __builtin_amdgcn_permlane32_swap(a0, b0, false, false); auto r1 = __builtin_amdgcn_permlane32_swap(a1, b1, false, false); \
    u32x4 w = {r0[0], r1[0], r0[1], r1[1]}; OUT = *reinterpret_cast<bf16x8*>(&w); } while (0)
    PK4(p0, 0, pa0); PK4(p0, 8, pa1); PK4(p1, 0, pa2); PK4(p1, 8, pa3);
#undef PK4
}
template <int ND0, int KROW>
__device__ __forceinline__ void qkt(f32x16& p0, f32x16& p1, const char* Ks, const bf16x8* qr, const f32x16& negm, int r32, int hi) {
#pragma unroll
    for (int d0 = 0; d0 < ND0; ++d0) { const int cb = (d0 * 16 + hi * 8) * 2;
        const bf16x8 b0 = *reinterpret_cast<const bf16x8*>(Ks + r32 * KROW + cb);
        const bf16x8 b1 = *reinterpret_cast<const bf16x8*>(Ks + (32 + r32) * KROW + cb);
        if (d0 == 0) { p0 = __builtin_amdgcn_mfma_f32_32x32x16_bf16(b0, qr[0], negm, 0, 0, 0); p1 = __builtin_amdgcn_mfma_f32_32x32x16_bf16(b1, qr[0], negm, 0, 0, 0); }
        else { p0 = __builtin_amdgcn_mfma_f32_32x32x16_bf16(b0, qr[d0], p0, 0, 0, 0); p1 = __builtin_amdgcn_mfma_f32_32x32x16_bf16(b1, qr[d0], p1, 0, 0, 0); } }
}

template <int MODE>
__device__ __forceinline__ void attn_unit(const bf16_t* __restrict__ Qa, int ldqa, const bf16_t* __restrict__ Qb, int ldqb,
                                          const bf16_t* __restrict__ Ka, int ldka, const bf16_t* __restrict__ Kb, int ldkb, const bf16_t* __restrict__ Vv, int ldv,
                                          bf16_t* __restrict__ O, int NT, int krow0, int ntreal, int qrow0, const float* __restrict__ rpbh, char* lds) {
    constexpr int ND0 = MODE == 0 ? 6 : 4, KROW = MODE == 0 ? KROW_MLA : KROW_NA;
    const int tid = threadIdx.x, wid = __builtin_amdgcn_readfirstlane(tid >> 6), lane = tid & 63, r32 = lane & 31, hi = lane >> 5;
    char* V_lds = lds + OFF_V; char* K_lds = lds + OFF_K;
    float* ws = (float*)(lds + OFF_WS) + wid * 64; float* li_l = ws; float* al_l = ws + 32;
    float* biasL = (float*)(lds + OFF_BIAS);
    float m_ref = 0.f, l_reg = 0; f32x16 o[2] = {}; f32x16 negm = {}; bool fresh = true; bf16x8 qr[ND0];
    {   const bf16_t* Qw = Qa + (size_t)(wid * QBLK + r32) * ldqa + hi * 8;
#pragma unroll
        for (int d0 = 0; d0 < 4; ++d0) qr[d0] = *reinterpret_cast<const bf16x8*>(Qw + d0 * 16);
        if constexpr (MODE == 0) { const bf16_t* Qw2 = Qb + (size_t)(wid * QBLK + r32) * ldqb + hi * 8;
#pragma unroll
            for (int d0 = 0; d0 < 2; ++d0) qr[4 + d0] = *reinterpret_cast<const bf16x8*>(Qw2 + d0 * 16); } }
    int qgr = 0, rs0 = 0, qc = 0, cs = 0;
    if constexpr (MODE == 1) {
        qgr = qrow0 + (wid >> 1); rs0 = min(max(qgr - 4, 0), 120); qc = 32 * (wid & 1) + r32; cs = min(max(qc - 8, 0), 48);
        for (int i = tid; i < 15 * 31; i += 512) biasL[i] = rpbh[i] * LOG2E;
    }
    const int sr = tid >> 3, sc = (tid & 7) * 8;
    const int sr2 = (tid & 255) >> 2, sc2 = (tid & 3) * 8;
    const int vst = v_st(sr, sc);
    const int vb0 = (int)(uintptr_t)V_lds + v_rd_base(lane);
    struct { bf16x8 v, k, k2; } sr_[1];
#define KROWOF(t) (MODE == 1 ? min(krow0 + (t), 127) * 64 : (t) * 64)
#define SLOAD(i, t) do { const long k0_ = KROWOF(t); sr_[i].v = *reinterpret_cast<const bf16x8*>(&Vv[(k0_ + sr) * ldv + sc]); sr_[i].k = *reinterpret_cast<const bf16x8*>(&Ka[(k0_ + sr) * ldka + sc]); \
        if constexpr (MODE == 0) sr_[i].k2 = *reinterpret_cast<const bf16x8*>(&Kb[(k0_ + sr2) * ldkb + sc2]); } while (0)
#define SWRITE(b, i) do { *(bf16x8*)(V_lds + (b) * SHM_V + vst) = sr_[i].v; *(bf16x8*)(K_lds + (b) * SHM_K + sr * KROW + sc * 2) = sr_[i].k; \
        if constexpr (MODE == 0) { if (tid < 256) *(bf16x8*)(K_lds + (b) * SHM_K + sr2 * KROW + 128 + sc2 * 2) = sr_[i].k2; } } while (0)
#define SWAIT() do { if constexpr (MODE == 0) asm volatile("s_waitcnt vmcnt(3)" ::: "memory"); else asm volatile("s_waitcnt vmcnt(2)" ::: "memory"); } while (0)
#define RESC(a) do { if (__any((a) < 1.f)) { if (hi == 0) al_l[r32] = (a); asm volatile("s_waitcnt lgkmcnt(0)" ::: "memory"); \
        _Pragma("unroll") for (int d = 0; d < 2; ++d) _Pragma("unroll") for (int r = 0; r < 16; ++r) o[d][r] *= al_l[crow(r, hi)]; } } while (0)
#define TVALID(t) (MODE == 0 ? true : ((t) < ntreal && (krow0 + (t)) >= rs0 && (krow0 + (t)) < rs0 + 8))
#define MASKB(P0, P1, t) do { if constexpr (MODE == 1) { const int dr_ = krow0 + (t) - qgr + 7; int d_ = 4 * hi - cs; asm volatile("" : "+v"(d_)); \
        const LAS float* bl_ = (const LAS float*)((LAS char*)lds + OFF_BIAS) + (dr_ * 31 + 15 - qc + 4 * hi); \
        _Pragma("unroll") for (int r = 0; r < 16; ++r) { const int c0_ = (r & 3) + 8 * (r >> 2); \
            const bool in0 = (unsigned)(c0_ + d_) < 16u, in1 = (unsigned)(c0_ + 32 + d_) < 16u; \
            const float b0_ = bl_[c0_], b1_ = bl_[c0_ + 32]; \
            P0[r] = in0 ? P0[r] + b0_ : -1e30f; P1[r] = in1 ? P1[r] + b1_ : -1e30f; } } } while (0)
    f32x16 pA0, pA1, pB0, pB1; float alA = 1.f, alB = 1.f; bf16x8 pa0, pa1, pa2, pa3;
    SLOAD(0, 0); asm volatile("s_waitcnt vmcnt(0)" ::: "memory"); SWRITE(0, 0); SLOAD(0, 1); asm volatile("s_waitcnt vmcnt(0)" ::: "memory"); SWRITE(1, 0);
    if (NT > 2) SLOAD(0, 2);
    __syncthreads();
    const int NI = NT >> 1;
    for (int it = 0; it < NI; ++it) {
        const int kb = (it & 1) * 2, nb = 2 - kb; const bool more = it + 1 < NI;
        if (more) { SWRITE(nb, 0); SLOAD(0, 2 * it + 3); }
        const int ta = 2 * it, tb = ta + 1;
        const bool vA = TVALID(ta), vB = TVALID(tb);
        if (vA) { qkt<ND0, KROW>(pA0, pA1, K_lds + kb * SHM_K, qr, negm, r32, hi); MASKB(pA0, pA1, ta); partialSM(pA0, pA1, m_ref, negm, alA, fresh); RESC(alA); }
        SBAR();
        if (vB) { qkt<ND0, KROW>(pB0, pB1, K_lds + (kb + 1) * SHM_K, qr, negm, r32, hi); MASKB(pB0, pB1, tb); }
        if (vA) { finishSM(pA0, pA1, alA, l_reg, pa0, pa1, pa2, pa3); SBAR(); pv_d0(o, vb0 + kb * SHM_V, pa0, pa1, pa2, pa3); }
        if (more) { SWRITE(nb + 1, 0); if (it + 2 < NI) SLOAD(0, 2 * it + 4); }
        if (vB) { partialSM(pB0, pB1, m_ref, negm, alB, fresh); RESC(alB); finishSM(pB0, pB1, alB, l_reg, pa0, pa1, pa2, pa3); SBAR(); pv_d0(o, vb0 + (kb + 1) * SHM_V, pa0, pa1, pa2, pa3); }
        __syncthreads();
    }
    asm volatile("s_waitcnt vmcnt(0)" ::: "memory");
    if (hi == 0) li_l[r32] = l_reg; asm volatile("s_waitcnt lgkmcnt(0)" ::: "memory");
    float rli[16];
#pragma unroll
    for (int r = 0; r < 16; ++r) rli[r] = __builtin_amdgcn_rcpf(li_l[crow(r, hi)]);
    {   bf16_t* stg = (bf16_t*)(lds + OFF_OST) + wid * 2048;
#pragma unroll
        for (int r = 0; r < 16; ++r) { const int orow = crow(r, hi);
#pragma unroll
            for (int d0 = 0; d0 < 2; ++d0) stg[orow * 64 + d0 * 32 + r32] = (bf16_t)(cvt_pk_bf16(o[d0][r] * rli[r], 0.f) & 0xffffu); }
        asm volatile("s_waitcnt lgkmcnt(0)" ::: "memory");
        bf16_t* Ow = O + (size_t)(wid * QBLK) * 512;
#pragma unroll
        for (int i = 0; i < 4; ++i) { const int row = i * 8 + (lane >> 3), ch = lane & 7; const u32x4 v = *(const u32x4*)(stg + row * 64 + ch * 8); *(u32x4*)(Ow + (size_t)row * 512 + ch * 8) = v; } }
    __syncthreads();
#undef KROWOF
#undef SLOAD
#undef SWRITE
#undef SWAIT
#undef RESC
#undef TVALID
#undef MASKB
}
#undef SBAR
}

constexpr size_t MiB = 1u << 20;
constexpr size_t WS_CTL = 0, CTL_ZERO_BYTES = 1 * MiB;
constexpr size_t WS_WIN = 2 * MiB;
constexpr size_t WS_WUQ = 11 * MiB;
constexpr size_t WS_WUKV = 12 * MiB;
constexpr size_t WS_WNA = 13 * MiB, WS_WMLA = 14 * MiB;
constexpr size_t WS_WOUT = 15 * MiB;
constexpr size_t WS_W1 = 18 * MiB;
constexpr size_t WS_W2 = 146 * MiB;
constexpr size_t WS_XN = 210 * MiB;
constexpr size_t WS_PROJ = 242 * MiB;
constexpr size_t WS_QN = 378 * MiB, WS_QR = 394 * MiB, WS_KN = 402 * MiB, WS_KR = 418 * MiB, WS_VM = 419 * MiB;
constexpr size_t WS_ONA = 435 * MiB, WS_OMLA = 451 * MiB;
constexpr size_t WS_MERGED = 467 * MiB;
constexpr size_t WS_TMP = 499 * MiB;
constexpr size_t WS_LIST = 563 * MiB;
constexpr size_t WS_TOKPOS = 565 * MiB, WS_TOKG = 566 * MiB;
constexpr size_t WS_ACT = 568 * MiB;
constexpr size_t WS_YIT = 712 * MiB;
constexpr size_t WS_SSQ = 856 * MiB;
constexpr size_t WS_MODP = 857 * MiB;
constexpr size_t WS_WRT = 858 * MiB;
constexpr size_t WS_END = 859 * MiB;
constexpr int CW_BAR = 4096;
constexpr int CW_CNT = 8192;
constexpr int CW_MOD = 16384;
constexpr int CW_ROPE = 32768;
static_assert((CW_ROPE + 2048) * 4 <= (int)CTL_ZERO_BYTES, "CTL");

constexpr int RING_BYTES = 131072;
constexpr int TAB_OFF = RING_BYTES;
constexpr int TAB_BLK = TAB_OFF, TAB_GATH = TAB_OFF + 2048;
constexpr int MISC_OFF = TAB_GATH + 11 * 1024;
constexpr int LDS_BYTES = 147456;
static_assert(MISC_OFF + 256 <= LDS_BYTES, "LDS map");

#define RLX_AGENT __ATOMIC_RELAXED, __HIP_MEMORY_SCOPE_AGENT
#define LDS_WAIT() asm volatile("s_waitcnt lgkmcnt(0)" ::: "memory")

#define XB_TMO      128
#define XB_XCNT(j)  (256  + 64 * (j))
#define XB_XSUB(j)  (1280 + 64 * (j))
#define XB_XGEN(j)  (2304 + 64 * (j))
#define XB_TOP      3328
#define XB_TOPGEN   3392
#define XCD_BAR_WORDS 3456
#define XB_SPIN_CAP (1u << 22)
__device__ __forceinline__ unsigned xb_ld(unsigned* p)              { return __hip_atomic_load(p, __ATOMIC_RELAXED, __HIP_MEMORY_SCOPE_AGENT); }
__device__ __forceinline__ unsigned xb_add(unsigned* p, unsigned v) { return __hip_atomic_fetch_add(p, v, __ATOMIC_RELAXED, __HIP_MEMORY_SCOPE_AGENT); }
__device__ __forceinline__ unsigned xb_xcc_id() { return (unsigned)__builtin_amdgcn_s_getreg((3 << 11) | 20) & 0xFu; }
#define XB_SPIN(cond, bar) do { unsigned _sp = 0; while (cond) { __builtin_amdgcn_s_sleep(1); \
    if ((++_sp & 255u) == 0u) { if (xb_ld(&(bar)[XB_TMO])) break; if (_sp > XB_SPIN_CAP) { atomicAdd(&(bar)[XB_TMO], 1u); break; } } } } while (0)
struct XcdBarrier { unsigned* bar; unsigned x; volatile LAS unsigned* st; };
__device__ __forceinline__ XcdBarrier xcd_barrier_post(unsigned* bar, volatile LAS unsigned* st) {
    XcdBarrier b; b.bar = bar; b.x = xb_xcc_id(); b.st = st;
    if (threadIdx.x == 0) (void)xb_add(&bar[XB_XCNT(b.x)], 1u);
    return b;
}
__device__ __forceinline__ void xcd_barrier_complete(unsigned* bar, unsigned x, unsigned& nloc, unsigned& nx) {
    const unsigned G = gridDim.x * gridDim.y * gridDim.z;
    unsigned sum, cnt, mine, sp = 0u;
    for (;;) {
        sum = 0u; cnt = 0u; mine = 0u;
#pragma unroll
        for (unsigned j = 0; j < 16; ++j) { const unsigned c = xb_ld(&bar[XB_XCNT(j)]); sum += c; cnt += (c > 0u) ? 1u : 0u; mine = (j == x) ? c : mine; }
        if (sum == G) break;
        __builtin_amdgcn_s_sleep(1);
        if ((++sp & 255u) == 0u) { if (xb_ld(&bar[XB_TMO])) break; if (sp > XB_SPIN_CAP) { atomicAdd(&bar[XB_TMO], 1u); break; } }
    }
    nloc = mine > 0u ? mine : 1u; nx = cnt > 0u ? cnt : 1u;
}
__device__ __forceinline__ void xcd_barrier(const XcdBarrier& b) {
    asm volatile("s_waitcnt vmcnt(0)" ::: "memory");
    __syncthreads();
    if (threadIdx.x == 0) {
        unsigned* bar = b.bar;
        __builtin_amdgcn_s_waitcnt(0);
        unsigned nloc = b.st[0], nx = b.st[1];
        if (nloc == 0u) { xcd_barrier_complete(bar, b.x, nloc, nx); b.st[0] = nloc; b.st[1] = nx; }
        const unsigned old = xb_add(&bar[XB_XSUB(b.x)], 1u);
        const unsigned gen = old / nloc;
        if (old + 1u == (gen + 1u) * nloc) {
            __builtin_amdgcn_fence(__ATOMIC_RELEASE, "agent");
            asm volatile("s_waitcnt vmcnt(0)" ::: "memory");
            const unsigned og = xb_add(&bar[XB_TOP], 1u);
            const unsigned tg = og / nx;
            if (og + 1u == (tg + 1u) * nx) xb_add(&bar[XB_TOPGEN], 1u);
            else XB_SPIN(xb_ld(&bar[XB_TOPGEN]) == tg, bar);
            __builtin_amdgcn_fence(__ATOMIC_ACQUIRE, "agent");
            xb_add(&bar[XB_XGEN(b.x)], 1u);
            asm volatile("s_waitcnt vmcnt(0)" ::: "memory");
        } else {
            XB_SPIN(xb_ld(&bar[XB_XGEN(b.x)]) == gen, bar);
            __builtin_amdgcn_fence(__ATOMIC_ACQUIRE, "agent");
            asm volatile("s_waitcnt vmcnt(0)" ::: "memory");
        }
    }
    __syncthreads();
}

constexpr int NWAVES = 8;
struct Args { const float* in[24]; float* out; unsigned char* ws; int ph_lo, ph_hi; };
enum { I_X = 0, I_C, I_WADA, I_BADA, I_GAPRE, I_GAPOST, I_WIN, I_BGATE, I_RPB, I_QNG, I_KVNG, I_WUQ, I_WUKV, I_WNAUP, I_WMLAUP, I_WOUT, I_GFPRE, I_GFPOST, I_WR, I_BR, I_W1, I_B1, I_W2, I_B2 };

__device__ __forceinline__ void tr_store_tile(LAS unsigned char* scr, bf16_t* dst, int K, int n0, int k0, int lane) {
    LDS_WAIT(); asm volatile("" ::: "memory");
#pragma unroll
    for (int j = 0; j < 8; ++j) { const int idx = j * 64 + lane, n = idx >> 3, ch = idx & 7;
        const u32x4 v = *(const LAS u32x4*)(scr + n * 144 + ch * 16);
        *(GAS u32x4*)(dst + (size_t)(n0 + n) * K + k0 + ch * 8) = v; }
    LDS_WAIT(); asm volatile("" ::: "memory");
}
__device__ __forceinline__ void tr_tile_fast(const float* src, int Nsrc, int src0, const float* kscale, bf16_t* dst, int K, int n0, int k0, LAS unsigned char* scr, int lane) {
#pragma unroll
    for (int st = 0; st < 8; ++st) { const int kq = st * 4 + (lane >> 4), c4 = (lane & 15) * 4, k = 2 * kq;
        f32x4 a = *(const GAS f32x4*)(src + (size_t)(k0 + k) * Nsrc + src0 + c4);
        f32x4 b = *(const GAS f32x4*)(src + (size_t)(k0 + k + 1) * Nsrc + src0 + c4);
        if (kscale) { const float s0 = kscale[k0 + k], s1 = kscale[k0 + k + 1]; a = a * s0; b = b * s1; }
#pragma unroll
        for (int i = 0; i < 4; ++i) *(LAS unsigned*)(scr + (c4 + i) * 144 + k * 2) = cvt_pk_bf16(a[i], b[i]); }
    tr_store_tile(scr, dst, K, n0, k0, lane);
}
__device__ __forceinline__ void tr_tile_slow(const float* src, int Nsrc, int srccol  , const float* kscale, bf16_t* dst, int K, int n0, int k0, LAS unsigned char* scr, int lane) {
#pragma unroll
    for (int k = 0; k < 64; k += 2) {
        float a = 0.f, b = 0.f;
        if (srccol >= 0) { a = src[(size_t)(k0 + k) * Nsrc + srccol]; b = src[(size_t)(k0 + k + 1) * Nsrc + srccol];
            if (kscale) { a *= kscale[k0 + k]; b *= kscale[k0 + k + 1]; } }
        *(LAS unsigned*)(scr + lane * 144 + k * 2) = cvt_pk_bf16(a, b); }
    tr_store_tile(scr, dst, K, n0, k0, lane);
}
__device__ __forceinline__ void tr_tile_fast8(const float* src, int Nsrc, int src0, unsigned char* dst, int K, int n0, int k0, LAS unsigned char* scr, int lane) {
#pragma unroll
    for (int st = 0; st < 4; ++st) { const int kq = st * 4 + (lane >> 4), c4 = (lane & 15) * 4, k = 4 * kq;
        const f32x4 a = __builtin_nontemporal_load((const f32x4*)(src + (size_t)(k0 + k) * Nsrc + src0 + c4)) * SC_W, b = __builtin_nontemporal_load((const f32x4*)(src + (size_t)(k0 + k + 1) * Nsrc + src0 + c4)) * SC_W;
        const f32x4 c = __builtin_nontemporal_load((const f32x4*)(src + (size_t)(k0 + k + 2) * Nsrc + src0 + c4)) * SC_W, d = __builtin_nontemporal_load((const f32x4*)(src + (size_t)(k0 + k + 3) * Nsrc + src0 + c4)) * SC_W;
#pragma unroll
        for (int i = 0; i < 4; ++i) { int w = __builtin_amdgcn_cvt_pk_fp8_f32(a[i], b[i], 0, false); w = __builtin_amdgcn_cvt_pk_fp8_f32(c[i], d[i], w, true);
            *(LAS int*)(scr + (c4 + i) * 80 + k) = w; } }
    LDS_WAIT(); asm volatile("" ::: "memory");
#pragma unroll
    for (int j = 0; j < 4; ++j) { const int idx = j * 64 + lane, n = idx >> 2, ch = idx & 3;
        const u32x4 v = *(const LAS u32x4*)(scr + n * 80 + ch * 16);
        __builtin_nontemporal_store(v, (u32x4*)(dst + (size_t)(n0 + n) * K + k0 + ch * 16)); }
    LDS_WAIT(); asm volatile("" ::: "memory");
}
__device__ __forceinline__ int rope_orig(int p) { return (p & 16) + 8 * (p & 1) + ((p & 15) >> 1); }

__global__ void __launch_bounds__(NWAVES * 64, 2) fwd_kernel(Args args_unused_) {
#define args (*(const __attribute__((address_space(4))) Args*)__builtin_amdgcn_kernarg_segment_ptr())
    extern __shared__ __attribute__((aligned(16))) unsigned char lds[];
    LAS unsigned char* L = (LAS unsigned char*)lds;
    volatile LAS unsigned* MISC = (volatile LAS unsigned*)(L + MISC_OFF);
    const int tid = threadIdx.x, lane = tid & 63, wave = __builtin_amdgcn_readfirstlane(tid >> 6);
    const int G = gridDim.x, bx = blockIdx.x, vcu = (G % 8 == 0) ? (bx % 8) * (G / 8) + bx / 8 : bx;
    unsigned char* ws = args.ws;
    gu32* ctl = (gu32*)(ws + WS_CTL);
    const int lo = args.ph_lo, hi = args.ph_hi;
    for (int u = tid; u < 64; u += NWAVES * 64) MISC[u] = 0u;
    __syncthreads();
    XcdBarrier bar; bar.bar = (unsigned*)(ctl + CW_BAR); bar.x = 0; bar.st = nullptr;
    const bool use_bar = (hi - lo) > 1;
    if (use_bar) bar = xcd_barrier_post((unsigned*)(ctl + CW_BAR), MISC + 8);
#ifndef PHASE_MASK
#define PHASE_MASK 0xFFFF
#endif
#define IN(k) (((PHASE_MASK >> (k)) & 1) && lo <= (k) && (k) < hi)
#ifndef REPMASK
#define REPMASK 0
#endif
#define NREP(k) (1 + ((REPMASK >> (k)) & 1))
#define SEAM(k) do { if (IN(k) && IN((k) + 1)) xcd_barrier(bar); } while (0)
    const int gw = vcu * NWAVES + wave, NGW = G * NWAVES;
    float* ROPE = (float*)(ctl + CW_ROPE);
    float* MODP = (float*)(ws + WS_MODP); float* MOD = (float*)(ws + WS_MODP + 512 * 1024); float* SSQ = (float*)(ws + WS_SSQ); unsigned* CNT = (unsigned*)(ctl + CW_CNT);
    bf16_t* WINT = (bf16_t*)(ws + WS_WIN); bf16_t* WUQT = (bf16_t*)(ws + WS_WUQ); bf16_t* WUKVT = (bf16_t*)(ws + WS_WUKV);
    bf16_t* WNAT = (bf16_t*)(ws + WS_WNA); bf16_t* WMLAT = (bf16_t*)(ws + WS_WMLA); bf16_t* WOUTT = (bf16_t*)(ws + WS_WOUT);
    bf16_t* W1T = (bf16_t*)(ws + WS_W1); bf16_t* W2T = (bf16_t*)(ws + WS_W2);
    bf16_t* XN = (bf16_t*)(ws + WS_XN); bf16_t* PROJ = (bf16_t*)(ws + WS_PROJ);
    bf16_t* QN = (bf16_t*)(ws + WS_QN); bf16_t* QR = (bf16_t*)(ws + WS_QR); bf16_t* KN = (bf16_t*)(ws + WS_KN); bf16_t* KR = (bf16_t*)(ws + WS_KR); bf16_t* VM = (bf16_t*)(ws + WS_VM);
    bf16_t* ONA = (bf16_t*)(ws + WS_ONA); bf16_t* OMLA = (bf16_t*)(ws + WS_OMLA); bf16_t* MERGED = (bf16_t*)(ws + WS_MERGED);
    float* TMP = (float*)(ws + WS_TMP); unsigned* LIST = (unsigned*)(ws + WS_LIST); unsigned* TOKPOS = (unsigned*)(ws + WS_TOKPOS); float* TOKG = (float*)(ws + WS_TOKG);
    bf16_t* ACT = (bf16_t*)(ws + WS_ACT); bf16_t* YIT = (bf16_t*)(ws + WS_YIT);
    const float* X = args.in[I_X]; float* OUT = args.out; bf16_t* X1B = (bf16_t*)TMP + (size_t)MTOK * DM;

    if (IN(0)) for (int rep_ = 0; rep_ < NREP(0); ++rep_) {
        LAS unsigned char* scr = L + wave * 16384;
        if (vcu < 192) { const float* c = args.in[I_C]; const float* wada = args.in[I_WADA]; const float* bada = args.in[I_BADA];
            const int cb = vcu % 24, kc = vcu / 24, k0 = kc * 128 + wave * 16, n0 = cb * 256 + lane * 4;
            f32x4 w[16];
#pragma unroll
            for (int k = 0; k < 16; ++k) w[k] = *(const GAS f32x4*)(wada + (size_t)(k0 + k) * 6144 + n0);
            f32x4 a0 = {0.f, 0.f, 0.f, 0.f}, a1 = {0.f, 0.f, 0.f, 0.f};
#pragma unroll
            for (int k = 0; k < 16; ++k) { const float c0 = c[k0 + k], c1 = c[1024 + k0 + k]; a0 += w[k] * (c0 * sigmoidf_(c0)); a1 += w[k] * (c1 * sigmoidf_(c1)); }
            LAS f32x4* red = (LAS f32x4*)(L + 65536);
            red[(wave * 2 + 0) * 64 + lane] = a0; red[(wave * 2 + 1) * 64 + lane] = a1;
            __syncthreads();
            { const int b = tid >> 8, col = tid & 255; const LAS float* rf = (const LAS float*)red; float sm = 0.f;
#pragma unroll
              for (int wv = 0; wv < 8; ++wv) sm += rf[(wv * 2 + b) * 256 + col];
              if (kc == 0) sm += bada[cb * 256 + col];
              MODP[(kc * 2 + b) * 6144 + cb * 256 + col] = sm; }
            __syncthreads();
        }
        if (bx == 0) { for (int i = tid; i < 128 * 8; i += NWAVES * 64) { const int pos = i >> 3, j = i & 7; float c, sn; rope_cs((float)pos, j, c, sn); ROPE[pos * 16 + j] = c; ROPE[pos * 16 + 8 + j] = sn; } }
        { const float* Wr = args.in[I_WR]; float* WRT = (float*)(ws + WS_WRT);
          for (int it = NGW - 1 - gw; it < NEXP * 16; it += NGW) { const int e = it >> 4, k = (it & 15) * 64 + lane; WRT[e * 1024 + k] = Wr[(size_t)k * 32 + e]; } }
        {   constexpr int I_WIN_ = 16 * 68, I_UQ = 6 * 12, I_UKV = 4 * 16, I_UP = 8 * 16, I_OUT = 16 * 16;
            constexpr int NITEMS = I_WIN_ + I_UQ + I_UKV + 2 * I_UP + I_OUT;
            for (int it = gw; it < NITEMS; it += NGW) {
                int r = it;
                if (r < I_WIN_) { const int kb = r / 68, nb = r % 68;
                    if (nb < 34) tr_tile_fast(args.in[I_WIN], 4256, nb * 64, nullptr, WINT, 1024, nb * 64, kb * 64, scr, lane);
                    else if (nb >= 36) tr_tile_fast(args.in[I_WIN], 4256, 2208 + (nb - 36) * 64, nullptr, WINT, 1024, nb * 64, kb * 64, scr, lane);
                    else { const int n = nb * 64 + lane; const int sc = (n < 2208) ? 2176 + rope_orig(n - 2176) : -1;
                        tr_tile_slow(args.in[I_WIN], 4256, sc, nullptr, WINT, 1024, nb * 64, kb * 64, scr, lane); }
                    continue; } r -= I_WIN_;
                if (r < I_UQ) { const int kb = r / 12, nb = r % 12;
                    if (nb < 8) tr_tile_fast(args.in[I_WUQ], 768, nb * 96, args.in[I_QNG], WUQT, 384, nb * 64, kb * 64, scr, lane);
                    else { const int n = nb * 64 + lane - 512, h = n >> 5, p = n & 31;
                        tr_tile_slow(args.in[I_WUQ], 768, h * 96 + 64 + rope_orig(p), args.in[I_QNG], WUQT, 384, nb * 64, kb * 64, scr, lane); }
                    continue; } r -= I_UQ;
                if (r < I_UKV) { const int kb = r / 16, nb = r % 16;
                    const int s0 = (nb < 8) ? nb * 128 : (nb - 8) * 128 + 64;
                    tr_tile_fast(args.in[I_WUKV], 1024, s0, args.in[I_KVNG], WUKVT, 256, nb * 64, kb * 64, scr, lane); continue; } r -= I_UKV;
                if (r < I_UP) { const int kb = r / 16, nb = r % 16; tr_tile_fast(args.in[I_WNAUP], 1024, nb * 64, nullptr, WNAT, 512, nb * 64, kb * 64, scr, lane); continue; } r -= I_UP;
                if (r < I_UP) { const int kb = r / 16, nb = r % 16; tr_tile_fast(args.in[I_WMLAUP], 1024, nb * 64, nullptr, WMLAT, 512, nb * 64, kb * 64, scr, lane); continue; } r -= I_UP;
                { const int kb = r / 16, nb = r % 16; tr_tile_fast(args.in[I_WOUT], 1024, nb * 64, nullptr, WOUTT, 1024, nb * 64, kb * 64, scr, lane); }
            } }
    }
    SEAM(0);
    if (IN(1)) {
        const float* g = args.in[I_GAPRE];
        LAS float* modl = (LAS float*)L;
        for (int i = tid; i < 4096; i += NWAVES * 64) { const int b = i >> 11, c = i & 2047; float sm = 0.f;
#pragma unroll
            for (int kc = 0; kc < 8; ++kc) sm += MODP[(kc * 2 + b) * 6144 + c];
            modl[i] = sm; }
        for (int idx = bx * (NWAVES * 64) + tid; idx < 2 * 6144; idx += G * NWAVES * 64) { const int b = idx / 6144, n = idx % 6144; float sm = 0.f;
#pragma unroll
            for (int kc = 0; kc < 8; ++kc) sm += MODP[(kc * 2 + b) * 6144 + n];
            MOD[idx] = sm; }
        __syncthreads();
        for (int m0 = gw * 2; m0 < MTOK; m0 += NGW * 2) { const int b = m0 >> 13;
            f32x4 v[2][4]; float ss[2] = {0.f, 0.f};
#pragma unroll
            for (int r = 0; r < 2; ++r) { const GAS f32x4* xr = (const GAS f32x4*)(X + (size_t)(m0 + r) * DM) + lane;
#pragma unroll
                for (int j = 0; j < 4; ++j) v[r][j] = xr[64 * j]; }
#pragma unroll
            for (int r = 0; r < 2; ++r)
#pragma unroll
                for (int j = 0; j < 4; ++j) ss[r] += (v[r][j].x * v[r][j].x + v[r][j].y * v[r][j].y) + (v[r][j].z * v[r][j].z + v[r][j].w * v[r][j].w);
#pragma unroll
            for (int r = 0; r < 2; ++r) { const float rstd = __builtin_amdgcn_rsqf(wave_sum(ss[r]) * (1.f / DM) + RMS_EPS);
                GAS u32x2* o8 = (GAS u32x2*)(XN + (size_t)(m0 + r) * DM) + lane;
#pragma unroll
                for (int j = 0; j < 4; ++j) { const int col = 4 * lane + 256 * j;
                    const f32x4 gg = *(const f32x4*)(g + col), sh = *(const LAS f32x4*)(modl + b * 2048 + col), scl = *(const LAS f32x4*)(modl + b * 2048 + 1024 + col);
                    const f32x4 h = v[r][j] * rstd * gg * (scl + 1.f) + sh; u32x2 w; w.x = cvt_pk_bf16(h[0], h[1]); w.y = cvt_pk_bf16(h[2], h[3]); o8[64 * j] = w; } } }
    }
    SEAM(1);
    if (IN(2)) for (int rep_ = 0; rep_ < NREP(2); ++rep_) {
        if (bx < NG_INPROJ || G < 256) {
            const int ng = G < 256 ? G : NG_INPROJ;
            pg8::SchedDense S{(const char*)XN, (const char*)WINT, (size_t)256 * 1024 * 2, (size_t)256 * 1024 * 2, MTOK / 256, NPROJ / 256, ng, bx};
            pg8::EpiInProj E{PROJ, SSQ, KR, ROPE, args.in[I_BGATE]};
            pg8::gemm_phase<pg8::EpiInProj, pg8::SchedDense, true, false, false>(L, 16, 2048, 2048, S, E);
        }
        {   LAS unsigned char* scr = L + wave * 16384;
            constexpr int I_W1_ = NEXP * 16 * 32, I_W2_ = NEXP * 16 * 16, NCHUNK = (I_W1_ + I_W2_) / 32;
            for (;;) {
                if (tid == 0) MISC[20] = atomicAdd(CNT + 64, 1u);
                __syncthreads();
                const int chunk = (int)MISC[20];
                __syncthreads();
                if (chunk >= NCHUNK) break;
#pragma unroll 1
                for (int k = 0; k < 4; ++k) { int r = chunk * 32 + wave * 4 + k;
                    if (r < I_W1_) { const int e = r / 512, q = r % 512, kb = q / 32, nb = q % 32;
                        tr_tile_fast8(args.in[I_W1] + (size_t)e * 1024 * 2048, 2048, nb * 64, (unsigned char*)W1T + (size_t)e * 2048 * 1024, 1024, nb * 64, kb * 64, scr, lane); }
                    else { r -= I_W1_; const int e = r / 256, q = r % 256, kb = q / 16, nb = q % 16;
                        tr_tile_fast8(args.in[I_W2] + (size_t)e * 1024 * 1024, 1024, nb * 64, (unsigned char*)W2T + (size_t)e * 1024 * 1024, 1024, nb * 64, kb * 64, scr, lane); } }
            } }
    }
    SEAM(2);
    if (IN(3)) for (int rep_ = 0; rep_ < NREP(3); ++rep_) {
#ifndef NO_QUP
        {   pg8::SchedDense S{(const char*)(PROJ + 1536), (const char*)WUQT, (size_t)256 * NPROJ * 2, (size_t)256 * 384 * 2, MTOK / 256, 3, G, bx};
            pg8::EpiQUp E{QN, QR, SSQ, ROPE};
            pg8::gemm_phase<pg8::EpiQUp, pg8::SchedDense, true, false, false>(L, 6, NPROJ * 2, 768, S, E); }
#endif
#ifndef NO_KVUP
        {   pg8::SchedDense S{(const char*)(PROJ + 1920), (const char*)WUKVT, (size_t)256 * NPROJ * 2, (size_t)256 * 256 * 2, MTOK / 256, 4, G, G - 1 - bx};
            pg8::EpiKVUp E{KN, VM, SSQ};
            pg8::gemm_phase<pg8::EpiKVUp, pg8::SchedDense, true, false, false>(L, 4, NPROJ * 2, 512, S, E); }
#endif
    }
    SEAM(3);
    if (IN(4)) for (int rep_ = 0; rep_ < NREP(4); ++rep_) {
#ifndef NO_MLA
        for (int u = vcu; u < 512; u += G) {
            const int bh = u >> 5, qb = u & 31, b = bh >> 3, h = bh & 7; const size_t row0 = (size_t)b * SEQ + qb * 256, key0 = (size_t)b * SEQ;
            attn::attn_unit<0>(QN + row0 * 512 + h * 64, 512, QR + row0 * 256 + h * 32, 256, KN + key0 * 512 + h * 64, 512, KR + key0 * 32, 32, VM + key0 * 512 + h * 64, 512,
                               OMLA + row0 * 512 + h * 64, 128, 0, 128, 0, nullptr, (char*)lds);
        }
#endif
#ifndef NO_NA
        for (int u = vcu; u < 512; u += G) {
            const int bh = u >> 5, rb = u & 31, b = bh >> 3, h = bh & 7; const size_t row0 = (size_t)b * SEQ + rb * 256, key0 = (size_t)b * SEQ;
            const int krow0 = min(max(4 * rb - 4, 0), 120), klast = min(max(4 * rb + 3 - 4, 0), 120) + 7, ntreal = klast - krow0 + 1, NT = (ntreal + 1) & ~1;
            attn::attn_unit<1>(PROJ + row0 * NPROJ + h * 64, NPROJ, nullptr, 0, PROJ + key0 * NPROJ + 512 + h * 64, NPROJ, nullptr, 0, PROJ + key0 * NPROJ + 1024 + h * 64, NPROJ,
                               ONA + row0 * 512 + h * 64, NT, krow0, ntreal, 4 * rb, args.in[I_RPB] + h * 15 * 31, (char*)lds);
        }
#endif
    }
    SEAM(4);
    if (IN(5)) for (int rep_ = 0; rep_ < NREP(5); ++rep_) {
        pg8::SchedMerge S{(const char*)ONA, (const char*)OMLA, (const char*)WNAT, (const char*)WMLAT, MTOK / 256, 4, G, bx};
        pg8::EpiMerge E{PROJ, MERGED};
        pg8::gemm_phase<pg8::EpiMerge, pg8::SchedMerge, true, false, false, true>(L, 16, 1024, 1024, S, E);
    }
    SEAM(5);
    if (IN(6)) for (int rep_ = 0; rep_ < NREP(6); ++rep_) {
        pg8::SchedDense S{(const char*)MERGED, (const char*)WOUTT, (size_t)256 * 1024 * 2, (size_t)256 * 1024 * 2, MTOK / 256, 4, G, bx};
        pg8::EpiBf16Y E{(bf16_t*)TMP};
        pg8::gemm_phase<pg8::EpiBf16Y, pg8::SchedDense, true, false, false>(L, 16, 2048, 2048, S, E);
    }
    SEAM(6);
    if (IN(7)) {
        LAS int* sel_e = (LAS int*)(L + 0); LAS float* sel_g = (LAS float*)(L + 1024); LAS int* sel_r = (LAS int*)(L + 2048);
        LAS int* lcnt = (LAS int*)(L + 3072); LAS int* lbase = (LAS int*)(L + 3072 + 128);
        const float* gpo = args.in[I_GAPOST]; const float* gfp = args.in[I_GFPRE]; const float* br = args.in[I_BR];
        const float* WRT = (const float*)(ws + WS_WRT);
        for (int blk = vcu; blk < MTOK / 64; blk += G) {
            if (tid < 32) lcnt[tid] = 0;
            __syncthreads();
            f32x4 hreg[8][4];
#pragma unroll
            for (int rr = 0; rr < 8; ++rr) { const int m = blk * 64 + wave * 8 + rr, b = m >> 13;
                const GAS u32x2* yr = (const GAS u32x2*)((const bf16_t*)TMP + (size_t)m * DM) + lane; const GAS f32x4* xr = (const GAS f32x4*)(X + (size_t)m * DM) + lane;
                f32x4 y[4], x1[4]; float s = 0.f;
#pragma unroll
                for (int j = 0; j < 4; ++j) { const u32x2 yw = yr[64 * j]; y[j] = (f32x4){bf16_lo(yw.x), bf16_hi(yw.x), bf16_lo(yw.y), bf16_hi(yw.y)}; x1[j] = xr[64 * j]; s += (y[j].x * y[j].x + y[j].y * y[j].y) + (y[j].z * y[j].z + y[j].w * y[j].w); }
                const float rstd = __builtin_amdgcn_rsqf(wave_sum(s) * (1.f / DM) + RMS_EPS); float s2 = 0.f;
#pragma unroll
                for (int j = 0; j < 4; ++j) { const int col = 4 * lane + 256 * j;
                    const f32x4 gg = *(const f32x4*)(gpo + col), ga = *(const f32x4*)(MOD + b * 6144 + 2048 + col);
                    x1[j] = x1[j] + ga * (y[j] * rstd * gg);
                    { u32x2 xw; xw.x = cvt_pk_bf16(x1[j][0], x1[j][1]); xw.y = cvt_pk_bf16(x1[j][2], x1[j][3]); *((GAS u32x2*)(X1B + (size_t)m * DM) + lane + 64 * j) = xw; }
                    s2 += (x1[j].x * x1[j].x + x1[j].y * x1[j].y) + (x1[j].z * x1[j].z + x1[j].w * x1[j].w); }
                const float rstd2 = __builtin_amdgcn_rsqf(wave_sum(s2) * (1.f / DM) + RMS_EPS);
                GAS int* o4 = (GAS int*)((unsigned char*)XN + (size_t)m * DM) + lane;
#pragma unroll
                for (int j = 0; j < 4; ++j) { const int col = 4 * lane + 256 * j;
                    const f32x4 gg = *(const f32x4*)(gfp + col), sh = *(const f32x4*)(MOD + b * 6144 + 3072 + col), scl = *(const f32x4*)(MOD + b * 6144 + 4096 + col);
                    const f32x4 h = x1[j] * rstd2 * gg * (scl + 1.f) + sh;
                    int w = __builtin_amdgcn_cvt_pk_fp8_f32(h[0] * SC_H2, h[1] * SC_H2, 0, false); w = __builtin_amdgcn_cvt_pk_fp8_f32(h[2] * SC_H2, h[3] * SC_H2, w, true); o4[64 * j] = w;
                    hreg[rr][j] = h; }
            }
            const bool b5 = (lane & 32) != 0, b4 = (lane & 16) != 0, b3 = (lane & 8) != 0;
            float t0 = -3.0e38f, t1 = -3.0e38f, t2 = -3.0e38f, t3 = -3.0e38f; int i0 = 0, i1 = 0, i2 = 0, i3 = 0;
#pragma unroll 2
            for (int e = 0; e < NEXP; ++e) {
                f32x4 w[4];
#pragma unroll
                for (int j = 0; j < 4; ++j) w[j] = *(const GAS f32x4*)(WRT + e * 1024 + 4 * lane + 256 * j);
                float p[8];
#pragma unroll
                for (int r = 0; r < 8; ++r) { f32x4 a = hreg[r][0] * w[0]; a += hreg[r][1] * w[1]; a += hreg[r][2] * w[2]; a += hreg[r][3] * w[3]; p[r] = (a.x + a.y) + (a.z + a.w); }
                float q[4], u[2];
#pragma unroll
                for (int i = 0; i < 4; ++i) { const float keep = b5 ? p[i + 4] : p[i], send = b5 ? p[i] : p[i + 4]; q[i] = keep + __shfl_xor(send, 32); }
#pragma unroll
                for (int i = 0; i < 2; ++i) { const float keep = b4 ? q[i + 2] : q[i], send = b4 ? q[i] : q[i + 2]; u[i] = keep + __shfl_xor(send, 16); }
                float v = (b3 ? u[1] : u[0]) + __shfl_xor(b3 ? u[0] : u[1], 8);
                v += __shfl_xor(v, 4); v += __shfl_xor(v, 2); v += __shfl_xor(v, 1);
                v += br[e];
                const bool c0 = v > t0, c1 = v > t1, c2 = v > t2, c3 = v > t3;
                t3 = c2 ? t2 : (c3 ? v : t3); i3 = c2 ? i2 : (c3 ? e : i3);
                t2 = c1 ? t1 : (c2 ? v : t2); i2 = c1 ? i1 : (c2 ? e : i2);
                t1 = c0 ? t0 : (c1 ? v : t1); i1 = c0 ? i0 : (c1 ? e : i1);
                t0 = c0 ? v : t0;             i0 = c0 ? e : i0;
            }
            {   const float e1 = __builtin_amdgcn_exp2f((t1 - t0) * LOG2E), e2 = __builtin_amdgcn_exp2f((t2 - t0) * LOG2E), e3 = __builtin_amdgcn_exp2f((t3 - t0) * LOG2E);
                const float inv = 1.f / (1.f + e1 + e2 + e3);
                const int lrow = wave * 8 + (b5 ? 4 : 0) + (b4 ? 2 : 0) + (b3 ? 1 : 0), t = lane & 7;
                if (t < 4) { const int ee = t == 0 ? i0 : t == 1 ? i1 : t == 2 ? i2 : i3;
                    const float gg = (t == 0 ? 1.f : t == 1 ? e1 : t == 2 ? e2 : e3) * inv;
                    const int rk = __hip_atomic_fetch_add(&lcnt[ee], 1, __ATOMIC_RELAXED, __HIP_MEMORY_SCOPE_WORKGROUP);
                    sel_e[lrow * 4 + t] = ee; sel_g[lrow * 4 + t] = gg; sel_r[lrow * 4 + t] = rk; } }
            __syncthreads();
            if (tid < 32) lbase[tid] = (int)atomicAdd(CNT + tid, (unsigned)lcnt[tid]);
            __syncthreads();
            if (tid < 256) { const int ee = sel_e[tid], pos = lbase[ee] + sel_r[tid], tok = blk * 64 + (tid >> 2);
                LIST[(size_t)ee * LISTCAP + pos] = (unsigned)tok; TOKPOS[(size_t)tok * 4 + (tid & 3)] = ((unsigned)ee << 16) | (unsigned)pos; TOKG[(size_t)tok * 4 + (tid & 3)] = sel_g[tid]; }
            __syncthreads();
        }
    }
    SEAM(7);
    if (IN(8) || IN(9)) {
        LAS int* blk_e = (LAS int*)(L + TAB_BLK); LAS int* eb0 = (LAS int*)(L + TAB_BLK + 1280); LAS int* ecnt = (LAS int*)(L + TAB_BLK + 1408);
        if (tid < 64) { const int c = (lane < NEXP) ? (int)__hip_atomic_load(CNT + lane, RLX_AGENT) : 0; const int n = (c + 255) >> 8; int incl = n;
#pragma unroll
            for (int o = 1; o < 64; o <<= 1) { const int t = __shfl_up(incl, o); if (lane >= o) incl += t; }
            const int start = incl - n;
            if (lane < NEXP) { eb0[lane] = start; ecnt[lane] = c; for (int i = 0; i < n; ++i) blk_e[start + i] = lane; }
            if (lane == 63) MISC[16] = (unsigned)incl; }
        __syncthreads();
        const int NB = (int)MISC[16];
        if (IN(8)) for (int rep_ = 0; rep_ < NREP(8); ++rep_) {
            for (int i = wave; i < 11; i += NWAVES) { const long Lu = (long)i * G + bx; if (Lu >= (long)NB * 8) break;
                const int grb = (int)(Lu >> 3), e = blk_e[grb], first = eb0[e], cnt = ecnt[e];
#pragma unroll
                for (int q = 0; q < 4; ++q) { const int r = q * 64 + lane, ri = (grb - first) * 256 + r; const unsigned tok = (ri < cnt) ? LIST[(size_t)e * LISTCAP + ri] : 0u;
                    *(LAS unsigned*)(L + TAB_GATH + i * 1024 + r * 4) = tok * 1024u; } }
            __syncthreads();
            pg8::SchedMoe<8, true> S{(const char*)XN, (const char*)W1T, (size_t)2048 * 1024, blk_e, NB, G, bx, TAB_GATH};
            pg8::EpiMoe1 E{args.in[I_B1], (unsigned char*)ACT};
            pg8::gemm_phase<pg8::EpiMoe1, pg8::SchedMoe<8, true>, true, true, true>(L, 8, 1024, 1024, S, E);
        }
        SEAM(8);
        if (IN(9)) for (int rep_ = 0; rep_ < NREP(9); ++rep_) {
            pg8::SchedMoe<4, false> S{(const char*)ACT, (const char*)W2T, (size_t)1024 * 1024, blk_e, NB, G, bx, 0};
            pg8::EpiMoe2 E{args.in[I_B2], (unsigned char*)YIT};
            pg8::gemm_phase<pg8::EpiMoe2, pg8::SchedMoe<4, false>, true, false, true>(L, 8, 1024, 1024, S, E);
        }
    }
    SEAM(9);
    if (IN(10)) {
        LAS int* rbase = (LAS int*)(L + 0);
        if (tid < 64) { const int c = (lane < NEXP) ? (int)__hip_atomic_load(CNT + lane, RLX_AGENT) : 0; const int n = (c + 255) >> 8; int incl = n;
#pragma unroll
            for (int o = 1; o < 64; o <<= 1) { const int t = __shfl_up(incl, o); if (lane >= o) incl += t; }
            if (lane < NEXP) rbase[lane] = (incl - n) * 256; }
        __syncthreads();
        const float* gfo = args.in[I_GFPOST];
        for (int m = gw; m < MTOK; m += NGW) { const int b = m >> 13;
            f32x4 y[4];
#pragma unroll
            for (int j = 0; j < 4; ++j) y[j] = (f32x4){0.f, 0.f, 0.f, 0.f};
#pragma unroll
            for (int t = 0; t < 4; ++t) { const unsigned tp = TOKPOS[(size_t)m * 4 + t]; const float gt = TOKG[(size_t)m * 4 + t];
                const size_t row = (size_t)rbase[tp >> 16] + (tp & 0xffffu); const GAS unsigned* yr = (const GAS unsigned*)((const unsigned char*)YIT + row * 1024) + lane; const float gs = gt * (1.f / SC_Y);
#pragma unroll
                for (int j = 0; j < 4; ++j) { const unsigned w = yr[64 * j]; const f32x2 lo = __builtin_amdgcn_cvt_pk_f32_fp8((int)w, false), hi2 = __builtin_amdgcn_cvt_pk_f32_fp8((int)w, true);
                    y[j][0] += gs * lo[0]; y[j][1] += gs * lo[1]; y[j][2] += gs * hi2[0]; y[j][3] += gs * hi2[1]; } }
            float s = 0.f;
#pragma unroll
            for (int j = 0; j < 4; ++j) s += (y[j].x * y[j].x + y[j].y * y[j].y) + (y[j].z * y[j].z + y[j].w * y[j].w);
            const float rstd = __builtin_amdgcn_rsqf(wave_sum(s) * (1.f / DM) + RMS_EPS);
            GAS f32x4* orow = (GAS f32x4*)(OUT + (size_t)m * DM) + lane; const GAS u32x2* xrow = (const GAS u32x2*)(X1B + (size_t)m * DM) + lane;
#pragma unroll
            for (int j = 0; j < 4; ++j) { const int col = 4 * lane + 256 * j;
                const f32x4 gg = *(const f32x4*)(gfo + col), gf = *(const f32x4*)(MOD + b * 6144 + 5120 + col);
                const u32x2 xw = xrow[64 * j]; const f32x4 x1 = {bf16_lo(xw.x), bf16_hi(xw.x), bf16_lo(xw.y), bf16_hi(xw.y)};
                orow[64 * j] = x1 + gf * (y[j] * rstd * gg); } }
    }
#undef IN
#undef SEAM
#undef args
}

constexpr int N_PHASES = 11;
extern "C" void kernel_launch(void* const* d_in, const int* in_sizes, int n_in, void* d_out, int out_size, void* d_ws, size_t ws_size, hipStream_t stream) {
    static int grid = 0;
    if (grid == 0) {
        if (n_in != 24 || out_size != MTOK * DM || ws_size < WS_END) { fprintf(stderr, "kernel_launch: unexpected shapes (n_in %d out %d ws %zu)\n", n_in, out_size, ws_size); grid = -1; return; }
        int dev = 0, cus = 0, per_cu = 0;
        if (hipGetDevice(&dev) != hipSuccess || hipDeviceGetAttribute(&cus, hipDeviceAttributeMultiprocessorCount, dev) != hipSuccess) { grid = -1; return; }
        if (hipFuncSetAttribute((const void*)fwd_kernel, hipFuncAttributeMaxDynamicSharedMemorySize, LDS_BYTES) != hipSuccess) { fprintf(stderr, "kernel_launch: hipFuncSetAttribute failed\n"); grid = -1; return; }
        if (hipOccupancyMaxActiveBlocksPerMultiprocessor(&per_cu, (const void*)fwd_kernel, NWAVES * 64, LDS_BYTES) != hipSuccess || per_cu < 1) { fprintf(stderr, "kernel_launch: occupancy query says %d\n", per_cu); per_cu = 1; }
        (void)hipGetLastError();
        grid = cus;
    }
    if (grid < 0) return;
    (void)hipMemsetAsync((char*)d_ws + WS_CTL + 16384, 0, 32768, stream);
    Args a{};
    for (int i = 0; i < 24; ++i) a.in[i] = (const float*)d_in[i];
    a.out = (float*)d_out; a.ws = (unsigned char*)d_ws;
#if MK_N_LAUNCHES == 1
    a.ph_lo = 0; a.ph_hi = N_PHASES;
    {   void* kargs[] = {(void*)&a};
        const hipError_t ce = hipLaunchCooperativeKernel((const void*)fwd_kernel, dim3(grid), dim3(NWAVES * 64), kargs, LDS_BYTES, stream);
        if (ce != hipSuccess) fprintf(stderr, "kernel_launch: cooperative launch failed: %s (grid %d)\n", hipGetErrorName(ce), grid); }
#else
    for (int p = 0; p < N_PHASES; ++p) { a.ph_lo = p; a.ph_hi = p + 1; hipLaunchKernelGGL(fwd_kernel, dim3(grid), dim3(NWAVES * 64), LDS_BYTES, stream, a); }
#endif
    const hipError_t le = hipPeekAtLastError();
    if (le != hipSuccess) fprintf(stderr, "kernel_launch: launch failed: %s\n", hipGetErrorName(le));
}
```

```cpp
#include <hip/hip_runtime.h>
#include <hip/hip_bf16.h>
#include <cstdio>
#include <cstdint>

#ifndef MK_N_LAUNCHES
#define MK_N_LAUNCHES 1
#endif

constexpr int BATCH = 2, SEQ = 8192, DM = 1024, MTOK = BATCH * SEQ;
constexpr int NPROJ = 4352;
constexpr int NEXP = 32, DFF = 1024, TOPK = 4;
constexpr int QLORA = 384, KVLORA = 256;
constexpr float RMS_EPS = 1e-6f;
constexpr float LOG2E = 1.4426950408889634f;
constexpr float C2NA = 0.125f * LOG2E;
constexpr float C2MLA = 0.10206207261596575f * LOG2E;
constexpr float SC_H2 = 8.f, SC_W = 64.f, SC_ACT = 4.f, SC_Y = 32.f;
constexpr int NG_INPROJ = 168;
constexpr int LISTCAP = 16384;
constexpr int MAXROWS = 65536 + NEXP * 256;

#define GAS __attribute__((address_space(1)))
#define LAS __attribute__((address_space(3)))
typedef unsigned short bf16_t;
typedef short bf16x8 __attribute__((ext_vector_type(8)));
typedef short s16x4 __attribute__((ext_vector_type(4)));
typedef float f32x4 __attribute__((ext_vector_type(4)));
typedef float f32x2 __attribute__((ext_vector_type(2)));
typedef float f32x16 __attribute__((ext_vector_type(16)));
typedef unsigned u32x4 __attribute__((ext_vector_type(4)));
typedef unsigned u32x2 __attribute__((ext_vector_type(2)));
typedef GAS unsigned gu32;

__device__ __forceinline__ unsigned cvt_pk_bf16(float lo, float hi) { unsigned r; asm volatile("v_cvt_pk_bf16_f32 %0, %1, %2" : "=v"(r) : "v"(lo), "v"(hi)); return r; }
__device__ __forceinline__ float bf16_lo(unsigned w) { return __uint_as_float(w << 16); }
__device__ __forceinline__ float bf16_hi(unsigned w) { return __uint_as_float(w & 0xffff0000u); }
__device__ __forceinline__ float sigmoidf_(float z) { return __builtin_amdgcn_rcpf(1.f + __builtin_amdgcn_exp2f(-z * LOG2E)); }
__device__ __forceinline__ float wave_sum(float v) {
#pragma unroll
    for (int o = 1; o < 64; o <<= 1) v += __shfl_xor(v, o);
    return v;
}
__device__ __forceinline__ void rope_cs(float pos, int j, float& c, float& s) {
    const float inv = __builtin_amdgcn_exp2f(-(float)j * 0.83048202372184059f);
    const float rev = __builtin_amdgcn_fractf(pos * inv * 0.15915494309189535f);
    c = __builtin_amdgcn_cosf(rev); s = __builtin_amdgcn_sinf(rev);
}

namespace pg8 {
constexpr int BM = 256, BK = 64, HALF = 128, HTB = HALF * BK * 2, STAGE_BYTES = 8 * HTB, NXCD = 8, WGM = 8;
__host__ __device__ __forceinline__ int lds_byte(int r, int c) { const int st = (r >> 4) * 2 + (c >> 5), rr = r & 15, cc = c & 31, ob = rr * 64 + cc * 2; return st * 1024 + (ob ^ (((ob >> 9) & 1) << 5)); }
__host__ __device__ __forceinline__ void stage_rc(int b, int& R, int& C) { const int st = b / 1024, sb = b % 1024, swz = sb ^ (((sb >> 9) & 1) << 5); R = (st >> 1) * 16 + swz / 64; C = (st & 1) * 32 + (swz % 64) / 2; }
__host__ __device__ __forceinline__ int perm32(int rho) { const int n = rho >> 4, i = rho & 15; return 8 * (i >> 2) + 4 * n + (i & 3); }

struct Unit { const char* A; const char* B; const char* A2; const char* B2; int pm, pn, aux, tab; };

__device__ __forceinline__ void tile_of(int wgid, int nM, int nN, int& pm, int& pn) {
    const int nwg = nM * nN;
    { const int q = nwg / NXCD, r = nwg % NXCD, xcd = wgid % NXCD, off = wgid / NXCD; wgid = (xcd < r ? xcd * (q + 1) : r * (q + 1) + (xcd - r) * q) + off; }
    const int nig = WGM * nN, gid = wgid / nig, fm = gid * WGM, gsz = (nM - fm) < WGM ? (nM - fm) : WGM;
    pm = fm + ((wgid % nig) % gsz); pn = (wgid % nig) / gsz;
}

typedef int v8i32 __attribute__((ext_vector_type(8)));
typedef int v4i32_ __attribute__((ext_vector_type(4)));
template <class Epi, class Sched, bool ALIGN_EPI, bool GATHER, bool FP8, bool DUAL = false>
__device__ __forceinline__ void gemm_phase(LAS unsigned char* lds, const int nt, const int ldab, const int ldbb, const Sched& S, const Epi& E) {
    const int tid = threadIdx.x, wid = __builtin_amdgcn_readfirstlane(tid >> 6), lane = tid & 63, wr = wid >> 2, wc = wid & 3, fr = lane & 15, fq = lane >> 4;
    int Rr[2], Cc[2];
    unsigned voffA[2], voffB[2];
#pragma unroll
    for (int i = 0; i < 2; ++i) { int R, C; stage_rc(tid * 16 + i * 8192, R, C); const int Rb = Epi::PERM ? ((R & ~31) + perm32(R & 31)) : R;
        Rr[i] = R; Cc[i] = C; voffA[i] = (unsigned)(R * ldab + C * 2); voffB[i] = (unsigned)(Rb * ldbb + C * 2); }
    const size_t kstep = (size_t)(BK * 2);
    const size_t hstepA = (size_t)HALF * ldab, hstepB = (size_t)HALF * ldbb;
    const unsigned ldsw = (unsigned)wid * 1024u;
    const int aoff = lds_byte(wr * 64 + fr, fq * 8), boff = lds_byte(wc * 32 + fr, fq * 8);
#define PG8_SA(b, h) (((b) * 2 + (h)) * HTB)
#define PG8_SB(b, h) ((4 + (b) * 2 + (h)) * HTB)
#define PG8_STAGE(bufoff, gbase, voff) do { _Pragma("unroll") for (int _i = 0; _i < 2; ++_i) \
        __builtin_amdgcn_global_load_lds((const unsigned*)((const char*)(gbase) + (voff)[_i]), (LAS unsigned*)(lds + (bufoff) + ldsw + _i * 8192), 16, 0, 0); } while (0)
#define PG8_STAGE_A(bufoff, gbase, h, G) do { if constexpr (GATHER) { PG8_STAGE(bufoff, gbase, (G)[h]); } else { PG8_STAGE(bufoff, (gbase) + (h) * hstepA, voffA); } } while (0)
#define PG8_STAGE_B(bufoff, gbase, h) PG8_STAGE(bufoff, (gbase) + (h) * hstepB, voffB)
#define PG8_LD8(addr) __builtin_shufflevector(*(const LAS v4i32_*)(addr), *(const LAS v4i32_*)((addr) + 1024), 0, 1, 2, 3, 4, 5, 6, 7)
#define PG8_LDA(dst, b, h) do { if constexpr (FP8) { _Pragma("unroll") for (int m = 0; m < 4; ++m) dst##8[m] = PG8_LD8(lds + PG8_SA(b, h) + aoff + m * 2048); } \
        else { _Pragma("unroll") for (int m = 0; m < 4; ++m) _Pragma("unroll") for (int k = 0; k < 2; ++k) dst[m][k] = *(const LAS bf16x8*)(lds + PG8_SA(b, h) + aoff + m * 2048 + k * 1024); } } while (0)
#define PG8_LDB(dst, b, h) do { if constexpr (FP8) { _Pragma("unroll") for (int n = 0; n < 2; ++n) dst##8[n] = PG8_LD8(lds + PG8_SB(b, h) + boff + n * 2048); } \
        else { _Pragma("unroll") for (int n = 0; n < 2; ++n) _Pragma("unroll") for (int k = 0; k < 2; ++k) dst[n][k] = *(const LAS bf16x8*)(lds + PG8_SB(b, h) + boff + n * 2048 + k * 1024); } } while (0)
#define PG8_MMA(ai, bj, At, Bt) do { __builtin_amdgcn_s_setprio(1); _Pragma("unroll") for (int m = 0; m < 4; ++m) _Pragma("unroll") for (int n = 0; n < 2; ++n) { \
        if constexpr (FP8) { asm volatile("v_mfma_scale_f32_16x16x128_f8f6f4 %0, %1, %2, %0, %3, %3 op_sel_hi:[0,0,0]" : "+v"(acc[ai][bj][m][n]) : "v"(Bt##8[n]), "v"(At##8[m]), "v"(sc1_)); } \
        else { _Pragma("unroll") for (int k = 0; k < 2; ++k) acc[ai][bj][m][n] = __builtin_amdgcn_mfma_f32_16x16x32_bf16(Bt[n][k], At[m][k], acc[ai][bj][m][n], 0, 0, 0); } } \
        __builtin_amdgcn_s_setprio(0); } while (0)
#define PG8_WAIT_V(n) asm volatile("s_waitcnt vmcnt(" #n ")" ::: "memory")
#define PG8_WAIT_L(n) asm volatile("s_waitcnt lgkmcnt(" #n ")" ::: "memory")
#define PG8_BAR __builtin_amdgcn_s_barrier()
#define PG8_SCHED __builtin_amdgcn_sched_barrier(0)
    Unit cur, nxt; int ui = 0;
    if (!S.next(0, cur)) return;
    f32x4 acc[2][2][4][2];
#pragma unroll
    for (int a = 0; a < 2; ++a)
#pragma unroll
        for (int b = 0; b < 2; ++b)
#pragma unroll
            for (int m = 0; m < 4; ++m)
#pragma unroll
                for (int n = 0; n < 2; ++n) acc[a][b][m][n] = (f32x4){0.f, 0.f, 0.f, 0.f};
    bf16x8 At[4][2], B0[2][2], B1[2][2]; v8i32 At8[4], B08[2], B18[2];
    int sc1_ = 0x7F7F7F7F; asm volatile("" : "+v"(sc1_));
    unsigned gC[2][2], gN[2][2];
#define PG8_GLOAD(G, u) do { if constexpr (GATHER) { const LAS unsigned* tb_ = (const LAS unsigned*)(lds + (u).tab); _Pragma("unroll") for (int h_ = 0; h_ < 2; ++h_) _Pragma("unroll") for (int i_ = 0; i_ < 2; ++i_) \
        (G)[h_][i_] = tb_[h_ * 128 + Rr[i_]] + (unsigned)(Cc[i_] * 2); } } while (0)
    PG8_GLOAD(gC, cur);
    const char* cA = cur.A; const char* cB = cur.B; const char* cA2 = cur.A2; const char* cB2 = cur.B2; const int nth = nt >> 1;
    PG8_STAGE_B(PG8_SB(0, 0), cB, 0); PG8_STAGE_B(PG8_SB(0, 1), cB, 1); PG8_STAGE_A(PG8_SA(0, 0), cA, 0, gC); PG8_STAGE_A(PG8_SA(0, 1), cA, 1, gC);
    if (wr == 1) PG8_BAR;
    PG8_WAIT_V(2); PG8_BAR;
    PG8_STAGE_B(PG8_SB(1, 0), cB + kstep, 0); PG8_STAGE_A(PG8_SA(1, 0), cA + kstep, 0, gC); PG8_STAGE_B(PG8_SB(1, 1), cB + kstep, 1);
    PG8_WAIT_V(6); PG8_BAR;
    for (;;) {
        const bool has_next = S.next(ui + 1, nxt);
        const char* nA = has_next ? nxt.A : cA; const char* nB = has_next ? nxt.B : cB;
        if constexpr (GATHER) { if (has_next) { PG8_GLOAD(gN, nxt); } else {
#pragma unroll
            for (int h_ = 0; h_ < 2; ++h_)
#pragma unroll
                for (int i_ = 0; i_ < 2; ++i_) gN[h_][i_] = gC[h_][i_]; } }
#pragma unroll 1
        for (int t = 0; t < nt; t += 2) {
            const bool last = (t == nt - 2);
            if constexpr (DUAL) { if (t == nth) E.mid(acc, cur, wr, wc, fr, fq); }
#define PG8_TILEA(tt) (((DUAL && (tt) >= nth) ? cA2 - (size_t)nth * kstep : cA) + (size_t)(tt) * kstep)
#define PG8_TILEB(tt) (((DUAL && (tt) >= nth) ? cB2 - (size_t)nth * kstep : cB) + (size_t)(tt) * kstep)
            const char* a1 = PG8_TILEA(t + 1);
            const char* a2 = last ? nA : PG8_TILEA(t + 2); const char* b2 = last ? nB : PG8_TILEB(t + 2);
            const char* a3 = a2 + kstep; const char* b3 = b2 + kstep;
            unsigned g2[2][2];
            if constexpr (GATHER) {
#pragma unroll
                for (int h_ = 0; h_ < 2; ++h_)
#pragma unroll
                    for (int i_ = 0; i_ < 2; ++i_) g2[h_][i_] = last ? gN[h_][i_] : gC[h_][i_]; }
            PG8_LDB(B0, 0, 0); PG8_LDB(B1, 0, 1); PG8_SCHED; PG8_LDA(At, 0, 0); PG8_STAGE_A(PG8_SA(1, 1), a1, 1, gC);
            PG8_WAIT_V(8); PG8_WAIT_L(0); PG8_BAR; PG8_MMA(0, 0, At, B0); PG8_MMA(0, 1, At, B1); PG8_BAR; PG8_SCHED;
            PG8_LDA(At, 0, 1); PG8_STAGE_B(PG8_SB(0, 0), b2, 0); PG8_STAGE_B(PG8_SB(0, 1), b2, 1); PG8_STAGE_A(PG8_SA(0, 0), a2, 0, g2);
            PG8_WAIT_V(8); PG8_WAIT_L(0); PG8_BAR; PG8_MMA(1, 0, At, B0); PG8_MMA(1, 1, At, B1); PG8_BAR; PG8_SCHED;
            PG8_LDB(B0, 1, 0); PG8_LDB(B1, 1, 1); PG8_SCHED; PG8_LDA(At, 1, 0); PG8_STAGE_A(PG8_SA(0, 1), a2, 1, g2);
            PG8_WAIT_V(8); PG8_WAIT_L(0); PG8_BAR; PG8_MMA(0, 0, At, B0); PG8_MMA(0, 1, At, B1); PG8_BAR; PG8_SCHED;
            PG8_LDA(At, 1, 1); PG8_STAGE_B(PG8_SB(1, 0), b3, 0); PG8_STAGE_B(PG8_SB(1, 1), b3, 1); PG8_STAGE_A(PG8_SA(1, 0), a3, 0, g2);
            PG8_WAIT_V(8); PG8_WAIT_L(0); PG8_BAR; PG8_MMA(1, 0, At, B0); PG8_MMA(1, 1, At, B1); PG8_BAR; PG8_SCHED;
        }
        if constexpr (ALIGN_EPI) { if (wr == 0) PG8_BAR; }
        if constexpr (FP8) asm volatile("s_nop 15\n\ts_nop 15" ::: "memory");
        E(acc, cur, wr, wc, fr, fq);
        if (!has_next) break;
#pragma unroll
        for (int a = 0; a < 2; ++a)
#pragma unroll
            for (int b = 0; b < 2; ++b)
#pragma unroll
                for (int m = 0; m < 4; ++m)
#pragma unroll
                    for (int n = 0; n < 2; ++n) acc[a][b][m][n] = (f32x4){0.f, 0.f, 0.f, 0.f};
        cur = nxt; cA = nA; cB = nB; cA2 = cur.A2; cB2 = cur.B2; ++ui;
        if constexpr (GATHER) {
#pragma unroll
            for (int h_ = 0; h_ < 2; ++h_)
#pragma unroll
                for (int i_ = 0; i_ < 2; ++i_) gC[h_][i_] = gN[h_][i_]; }
        if constexpr (ALIGN_EPI) { if (wr == 1) PG8_BAR; }
    }
    PG8_WAIT_V(0);
    if constexpr (!ALIGN_EPI) { if (wr == 0) PG8_BAR; }
    PG8_BAR;
#undef PG8_SA
#undef PG8_SB
#undef PG8_STAGE
#undef PG8_STAGE_A
#undef PG8_STAGE_B
#undef PG8_LDA
#undef PG8_LD8
#undef PG8_LDB
#undef PG8_MMA
#undef PG8_WAIT_V
#undef PG8_WAIT_L
#undef PG8_BAR
#undef PG8_SCHED
#undef PG8_GLOAD
#undef PG8_TILEA
#undef PG8_TILEB
}

typedef f32x4 Acc[2][2][4][2];

struct SchedDense {
    const char* A; const char* B; size_t a_tile_bytes, b_tile_bytes; int nM, nN, G, c;
    __device__ __forceinline__ bool next(int i, Unit& u) const {
        const long L = (long)i * G + c; if (L >= (long)nM * nN) return false;
        int pm, pn; tile_of((int)L, nM, nN, pm, pn);
        u.pm = pm; u.pn = pn; u.aux = 0; u.tab = 0; u.A = A + (size_t)pm * a_tile_bytes; u.B = B + (size_t)pn * b_tile_bytes; u.A2 = u.A; u.B2 = u.B; return true;
    }
};
struct SchedMerge {
    const char* A0; const char* A1; const char* B0; const char* B1; int nM, nN, G, c;
    __device__ __forceinline__ bool next(int i, Unit& u) const {
        const long T = (long)i * G + c; if (T >= (long)nM * nN) return false;
        int pm, pn; tile_of((int)T, nM, nN, pm, pn);
        u.pm = pm; u.pn = pn; u.aux = 0; u.tab = 0;
        u.A = A0 + (size_t)pm * (256 * 512 * 2); u.B = B0 + (size_t)pn * (256 * 512 * 2); u.A2 = A1 + (size_t)pm * (256 * 512 * 2); u.B2 = B1 + (size_t)pn * (256 * 512 * 2); return true;
    }
};
template <int NPN, bool GATHER>
struct SchedMoe {
    const char* A; const char* B; size_t b_expert_bytes; LAS const int* blk_e; int NB, G, c, tab0;
    __device__ __forceinline__ bool next(int i, Unit& u) const {
        const long L = (long)i * G + c; if (L >= (long)NB * NPN) return false;
        const int grb = (int)(L / NPN), pn = (int)(L % NPN);
        const int e = __builtin_amdgcn_readfirstlane(blk_e[grb]);
        u.pm = grb; u.pn = pn; u.aux = e; u.tab = tab0 + i * 1024;
        u.A = GATHER ? A : A + (size_t)grb * (256 * 1024);
        u.B = B + (size_t)e * b_expert_bytes + (size_t)pn * (256 * 1024); u.A2 = u.A; u.B2 = u.B; return true;
    }
};

struct EpiInProj {
    static constexpr bool PERM = true;
    bf16_t* PROJ; float* SSQ; bf16_t* KR; const float* ROPE; const float* bgate;
    __device__ __forceinline__ void operator()(const Acc& acc, const Unit& u, int wr, int wc, int fr, int fq) const {
        const int pn = u.pn, row0 = u.pm * BM + wr * 64 + fr, colb = pn * BM + wc * 32 + 8 * fq;
        const float sc = (pn < 2) ? C2NA : 1.f;
        f32x4 gb[2][2];
#pragma unroll
        for (int bj = 0; bj < 2; ++bj)
#pragma unroll
            for (int n = 0; n < 2; ++n) gb[bj][n] = (pn >= 9) ? *(const f32x4*)(bgate + (colb - 2304) + bj * HALF + 4 * n) : (f32x4){0.f, 0.f, 0.f, 0.f};
#pragma unroll
        for (int ai = 0; ai < 2; ++ai)
#pragma unroll
            for (int m = 0; m < 4; ++m) { const int row = row0 + ai * HALF + m * 16; bf16_t* rowp = PROJ + (size_t)row * NPROJ + colb;
#pragma unroll
                for (int bj = 0; bj < 2; ++bj) { const f32x4 v0 = acc[ai][bj][m][0] * sc + gb[bj][0], v1 = acc[ai][bj][m][1] * sc + gb[bj][1]; u32x4 w;
                    w.x = cvt_pk_bf16(v0[0], v0[1]); w.y = cvt_pk_bf16(v0[2], v0[3]); w.z = cvt_pk_bf16(v1[0], v1[1]); w.w = cvt_pk_bf16(v1[2], v1[3]);
                    *(u32x4*)(rowp + bj * HALF) = w; } }
        if (pn >= 6 && pn <= 8) {
#pragma unroll
            for (int ai = 0; ai < 2; ++ai)
#pragma unroll
                for (int m = 0; m < 4; ++m) { const int row = row0 + ai * HALF + m * 16; float s[2];
#pragma unroll
                    for (int bj = 0; bj < 2; ++bj) { const f32x4 a = acc[ai][bj][m][0], b = acc[ai][bj][m][1];
                        float t = (a[0] * a[0] + a[1] * a[1]) + (a[2] * a[2] + a[3] * a[3]) + (b[0] * b[0] + b[1] * b[1]) + (b[2] * b[2] + b[3] * b[3]);
                        t += __shfl_xor(t, 16); t += __shfl_xor(t, 32); s[bj] = t; }
                    if (fq == 0) {
                        float* sp = SSQ + (size_t)row * 16 + wc;
                        if (pn == 6) { sp[0] = s[0] + s[1]; }
                        else if (pn == 7) { sp[4] = s[0]; sp[8] = s[1]; }
                        else { sp[12] = s[0]; }
                    } }
            if (pn == 8 && wc == 0) {
#pragma unroll
                for (int ai = 0; ai < 2; ++ai)
#pragma unroll
                    for (int m = 0; m < 4; ++m) { const int row = row0 + ai * HALF + m * 16, tok = row & (SEQ - 1);
                        const int pos = (fq >> 1) ? (tok & 63) : (tok >> 6); float o[8];
                        const f32x4 cs4 = *(const f32x4*)(ROPE + pos * 16 + 4 * (fq & 1)), sn4 = *(const f32x4*)(ROPE + pos * 16 + 8 + 4 * (fq & 1));
#pragma unroll
                        for (int n = 0; n < 2; ++n)
#pragma unroll
                            for (int q = 0; q < 2; ++q) { const float c = cs4[2 * n + q], s = sn4[2 * n + q];
                                const float x1 = acc[ai][1][m][n][2 * q], x2 = acc[ai][1][m][n][2 * q + 1];
                                o[4 * n + 2 * q] = x1 * c - x2 * s; o[4 * n + 2 * q + 1] = x1 * s + x2 * c; }
                        u32x4 w; w.x = cvt_pk_bf16(o[0], o[1]); w.y = cvt_pk_bf16(o[2], o[3]); w.z = cvt_pk_bf16(o[4], o[5]); w.w = cvt_pk_bf16(o[6], o[7]);
                        *(u32x4*)(KR + (size_t)row * 32 + 8 * fq) = w; }
            }
        }
    }
};
struct EpiQUp {
    static constexpr bool PERM = true;
    bf16_t* QN; bf16_t* QR; const float* SSQ; const float* ROPE;
    __device__ __forceinline__ void operator()(const Acc& acc, const Unit& u, int wr, int wc, int fr, int fq) const {
        const int pn = u.pn, row0 = u.pm * BM + wr * 64 + fr, colt = wc * 32 + 8 * fq;
#pragma unroll
        for (int ai = 0; ai < 2; ++ai)
#pragma unroll
            for (int m = 0; m < 4; ++m) { const int row = row0 + ai * HALF + m * 16;
                const f32x4 q0_ = *(const f32x4*)(SSQ + (size_t)row * 16), q1_ = *(const f32x4*)(SSQ + (size_t)row * 16 + 4);
                const float rs = __builtin_amdgcn_rsqf((((q0_[0] + q0_[1]) + (q0_[2] + q0_[3])) + ((q1_[0] + q1_[1]) + (q1_[2] + q1_[3]))) * (1.f / QLORA) + RMS_EPS) * C2MLA;
                if (pn < 2) {
#pragma unroll
                    for (int bj = 0; bj < 2; ++bj) { const f32x4 v0 = acc[ai][bj][m][0] * rs, v1 = acc[ai][bj][m][1] * rs; u32x4 w;
                        w.x = cvt_pk_bf16(v0[0], v0[1]); w.y = cvt_pk_bf16(v0[2], v0[3]); w.z = cvt_pk_bf16(v1[0], v1[1]); w.w = cvt_pk_bf16(v1[2], v1[3]);
                        *(u32x4*)(QN + (size_t)row * 512 + pn * 256 + bj * HALF + colt) = w; }
                } else {
                    const int tok = row & (SEQ - 1); const int pos = (fq >> 1) ? (tok & 63) : (tok >> 6);
                    const f32x4 cs4 = *(const f32x4*)(ROPE + pos * 16 + 4 * (fq & 1)), sn4 = *(const f32x4*)(ROPE + pos * 16 + 8 + 4 * (fq & 1));
#pragma unroll
                    for (int bj = 0; bj < 2; ++bj) { float o[8];
#pragma unroll
                        for (int n = 0; n < 2; ++n)
#pragma unroll
                            for (int q = 0; q < 2; ++q) { const float c = cs4[2 * n + q], s = sn4[2 * n + q];
                                const float x1 = acc[ai][bj][m][n][2 * q] * rs, x2 = acc[ai][bj][m][n][2 * q + 1] * rs;
                                o[4 * n + 2 * q] = x1 * c - x2 * s; o[4 * n + 2 * q + 1] = x1 * s + x2 * c; }
                        u32x4 w; w.x = cvt_pk_bf16(o[0], o[1]); w.y = cvt_pk_bf16(o[2], o[3]); w.z = cvt_pk_bf16(o[4], o[5]); w.w = cvt_pk_bf16(o[6], o[7]);
                        *(u32x4*)(QR + (size_t)row * 256 + bj * HALF + colt) = w; }
                }
                asm volatile("" ::: "memory"); }
    }
};
struct EpiKVUp {
    static constexpr bool PERM = true;
    bf16_t* KN; bf16_t* VM; const float* SSQ;
    __device__ __forceinline__ void operator()(const Acc& acc, const Unit& u, int wr, int wc, int fr, int fq) const {
        const int pn = u.pn, row0 = u.pm * BM + wr * 64 + fr, colt = wc * 32 + 8 * fq;
        bf16_t* dst = (pn < 2) ? KN + pn * 256 : VM + (pn - 2) * 256;
#pragma unroll
        for (int ai = 0; ai < 2; ++ai)
#pragma unroll
            for (int m = 0; m < 4; ++m) { const int row = row0 + ai * HALF + m * 16;
                const f32x4 q0_ = *(const f32x4*)(SSQ + (size_t)row * 16 + 8), q1_ = *(const f32x4*)(SSQ + (size_t)row * 16 + 12);
                const float rs = __builtin_amdgcn_rsqf((((q0_[0] + q0_[1]) + (q0_[2] + q0_[3])) + ((q1_[0] + q1_[1]) + (q1_[2] + q1_[3]))) * (1.f / KVLORA) + RMS_EPS);
#pragma unroll
                for (int bj = 0; bj < 2; ++bj) { const f32x4 v0 = acc[ai][bj][m][0] * rs, v1 = acc[ai][bj][m][1] * rs; u32x4 w;
                    w.x = cvt_pk_bf16(v0[0], v0[1]); w.y = cvt_pk_bf16(v0[2], v0[3]); w.z = cvt_pk_bf16(v1[0], v1[1]); w.w = cvt_pk_bf16(v1[2], v1[3]);
                    *(u32x4*)(dst + (size_t)row * 512 + bj * HALF + colt) = w; } }
    }
};
struct EpiMerge {
    static constexpr bool PERM = true;
    const bf16_t* PROJ; bf16_t* MERGED;
    __device__ __forceinline__ void mid(Acc& acc, const Unit& u, int wr, int wc, int fr, int fq) const {
        int row0 = u.pm * BM + wr * 64 + fr; const int col0 = u.pn * BM + wc * 32 + 8 * fq;
        asm volatile("" : "+v"(row0));
#pragma unroll
        for (int ai = 0; ai < 2; ++ai)
#pragma unroll
            for (int m = 0; m < 4; ++m) { const bf16_t* rp = PROJ + (size_t)(row0 + ai * HALF + m * 16) * NPROJ + 2304 + col0;
#pragma unroll
                for (int bj = 0; bj < 2; ++bj) { const u32x4 g1 = *(const u32x4*)(rp + bj * HALF), g2 = *(const u32x4*)(rp + 1024 + bj * HALF);
                    const unsigned w1[4] = {g1.x, g1.y, g1.z, g1.w}, w2[4] = {g2.x, g2.y, g2.z, g2.w};
#pragma unroll
                    for (int q = 0; q < 4; ++q) { const int n = q >> 1, i = (q & 1) * 2;
                        const float r0 = (1.f + __builtin_amdgcn_exp2f(-bf16_lo(w2[q]) * LOG2E)) * __builtin_amdgcn_rcpf(1.f + __builtin_amdgcn_exp2f(-bf16_lo(w1[q]) * LOG2E));
                        const float r1 = (1.f + __builtin_amdgcn_exp2f(-bf16_hi(w2[q]) * LOG2E)) * __builtin_amdgcn_rcpf(1.f + __builtin_amdgcn_exp2f(-bf16_hi(w1[q]) * LOG2E));
                        acc[ai][bj][m][n][i] *= r0; acc[ai][bj][m][n][i + 1] *= r1; } }
                asm volatile("" ::: "memory"); }
    }
    __device__ __forceinline__ void operator()(const Acc& acc, const Unit& u, int wr, int wc, int fr, int fq) const {
        const int row0 = u.pm * BM + wr * 64 + fr, col0 = u.pn * BM + wc * 32 + 8 * fq;
#pragma unroll
        for (int ai = 0; ai < 2; ++ai)
#pragma unroll
            for (int m = 0; m < 4; ++m) { const int row = row0 + ai * HALF + m * 16; const bf16_t* rp = PROJ + (size_t)row * NPROJ + 3328 + col0;
#pragma unroll
                for (int bj = 0; bj < 2; ++bj) { const u32x4 g2 = *(const u32x4*)(rp + bj * HALF);
                    f32x4 s0, s1;
                    s0[0] = sigmoidf_(bf16_lo(g2.x)); s0[1] = sigmoidf_(bf16_hi(g2.x)); s0[2] = sigmoidf_(bf16_lo(g2.y)); s0[3] = sigmoidf_(bf16_hi(g2.y));
                    s1[0] = sigmoidf_(bf16_lo(g2.z)); s1[1] = sigmoidf_(bf16_hi(g2.z)); s1[2] = sigmoidf_(bf16_lo(g2.w)); s1[3] = sigmoidf_(bf16_hi(g2.w));
                    const f32x4 v0 = acc[ai][bj][m][0] * s0, v1 = acc[ai][bj][m][1] * s1; u32x4 w;
                    w.x = cvt_pk_bf16(v0[0], v0[1]); w.y = cvt_pk_bf16(v0[2], v0[3]); w.z = cvt_pk_bf16(v1[0], v1[1]); w.w = cvt_pk_bf16(v1[2], v1[3]);
                    *(u32x4*)(MERGED + (size_t)row * 1024 + col0 + bj * HALF) = w; }
                asm volatile("" ::: "memory"); }
    }
};
struct EpiBf16Y {
    static constexpr bool PERM = true;
    bf16_t* C;
    __device__ __forceinline__ void operator()(const Acc& acc, const Unit& u, int wr, int wc, int fr, int fq) const {
        const int row0 = u.pm * BM + wr * 64 + fr, col0 = u.pn * BM + wc * 32 + 8 * fq;
#pragma unroll
        for (int ai = 0; ai < 2; ++ai)
#pragma unroll
            for (int m = 0; m < 4; ++m) { bf16_t* rowp = C + (size_t)(row0 + ai * HALF + m * 16) * 1024 + col0;
#pragma unroll
                for (int bj = 0; bj < 2; ++bj) { const f32x4 v0 = acc[ai][bj][m][0], v1 = acc[ai][bj][m][1]; u32x4 w;
                    w.x = cvt_pk_bf16(v0[0], v0[1]); w.y = cvt_pk_bf16(v0[2], v0[3]); w.z = cvt_pk_bf16(v1[0], v1[1]); w.w = cvt_pk_bf16(v1[2], v1[3]);
                    *(u32x4*)(rowp + bj * HALF) = w; } }
    }
};
struct EpiMoe1 {
    static constexpr bool PERM = true;
    const float* b1; unsigned char* ACT;
    __device__ __forceinline__ void operator()(const Acc& acc, const Unit& u, int wr, int wc, int fr, int fq) const {
        const int e = u.aux, row0 = u.pm * BM + wr * 64 + fr, col0 = u.pn * BM + wc * 32 + 8 * fq;
        constexpr float DS = 1.f / (SC_H2 * SC_W);
        f32x4 bv[2][2];
#pragma unroll
        for (int bj = 0; bj < 2; ++bj)
#pragma unroll
            for (int n = 0; n < 2; ++n) bv[bj][n] = *(const f32x4*)(b1 + (size_t)e * 2048 + col0 + bj * HALF + 4 * n);
#pragma unroll
        for (int ai = 0; ai < 2; ++ai)
#pragma unroll
            for (int m = 0; m < 4; ++m) { const int row = row0 + ai * HALF + m * 16;
#pragma unroll
                for (int bj = 0; bj < 2; ++bj) { float o[4];
#pragma unroll
                    for (int n = 0; n < 2; ++n) { const f32x4 v = acc[ai][bj][m][n] * DS + bv[bj][n];
#pragma unroll
                        for (int q = 0; q < 2; ++q) { const float xg = fminf(v[2 * q], 7.f), xl = __builtin_amdgcn_fmed3f(v[2 * q + 1], -7.f, 7.f);
                            const float sg = __builtin_amdgcn_rcpf(1.f + __builtin_amdgcn_exp2f(xg * (-1.702f * LOG2E)));
                            o[2 * n + q] = (xg * sg) * __builtin_fmaf(xl, SC_ACT, SC_ACT); } }
                    int w = __builtin_amdgcn_cvt_pk_fp8_f32(o[0], o[1], 0, false); w = __builtin_amdgcn_cvt_pk_fp8_f32(o[2], o[3], w, true);
                    *(int*)(ACT + (size_t)row * 1024 + ((col0 + bj * HALF) >> 1)) = w; } }
    }
};
struct EpiMoe2 {
    static constexpr bool PERM = true;
    const float* b2; unsigned char* YIT;
    __device__ __forceinline__ void operator()(const Acc& acc, const Unit& u, int wr, int wc, int fr, int fq) const {
        const int e = u.aux, row0 = u.pm * BM + wr * 64 + fr, col0 = u.pn * BM + wc * 32 + 8 * fq;
        constexpr float DS = SC_Y / (SC_ACT * SC_W);
        f32x4 bv[2][2];
#pragma unroll
        for (int bj = 0; bj < 2; ++bj)
#pragma unroll
            for (int n = 0; n < 2; ++n) bv[bj][n] = *(const f32x4*)(b2 + (size_t)e * 1024 + col0 + bj * HALF + 4 * n) * SC_Y;
#pragma unroll
        for (int ai = 0; ai < 2; ++ai)
#pragma unroll
            for (int m = 0; m < 4; ++m) { const int row = row0 + ai * HALF + m * 16;
#pragma unroll
                for (int bj = 0; bj < 2; ++bj) { f32x4 v0 = acc[ai][bj][m][0] * DS + bv[bj][0], v1 = acc[ai][bj][m][1] * DS + bv[bj][1];
                    v0 = __builtin_elementwise_min(__builtin_elementwise_max(v0, (f32x4){-448.f, -448.f, -448.f, -448.f}), (f32x4){448.f, 448.f, 448.f, 448.f});
                    v1 = __builtin_elementwise_min(__builtin_elementwise_max(v1, (f32x4){-448.f, -448.f, -448.f, -448.f}), (f32x4){448.f, 448.f, 448.f, 448.f});
                    u32x2 w; int t = __builtin_amdgcn_cvt_pk_fp8_f32(v0[0], v0[1], 0, false); t = __builtin_amdgcn_cvt_pk_fp8_f32(v0[2], v0[3], t, true); w.x = (unsigned)t;
                    t = __builtin_amdgcn_cvt_pk_fp8_f32(v1[0], v1[1], 0, false); t = __builtin_amdgcn_cvt_pk_fp8_f32(v1[2], v1[3], t, true); w.y = (unsigned)t;
                    *(u32x2*)(YIT + (size_t)row * 1024 + col0 + bj * HALF) = w; } }
    }
};
}

namespace attn {
#define SBAR() __builtin_amdgcn_sched_barrier(0)
constexpr int NW = 8, QBLK = 32, KVBLK = 64;
constexpr float THR = 8.f;
__device__ __forceinline__ int crow(int r, int hi) { return (r & 3) + 8 * (r >> 2) + 4 * hi; }
constexpr int KROW_MLA = 96 * 2 + 16, KROW_NA = 64 * 2 + 16;
constexpr int SHM_K = 64 * KROW_MLA  , SHM_V = 64 * 64 * 2  ;
constexpr int OFF_V = 0, OFF_K = 4 * SHM_V, OFF_WS = OFF_K + 4 * SHM_K, OFF_OST = OFF_WS + NW * 256, OFF_BIAS = OFF_OST + NW * 4096, ATTN_LDS = OFF_BIAS + 2048;

__device__ __forceinline__ int v_st(int k, int c) { const int kk = (k & ~0xC) | ((k & 4) << 1) | ((k & 8) >> 1); return ((kk >> 3) * 2 + (c >> 5)) * 512 + ((kk & 7) * 32 + (c & 31)) * 2; }
__device__ __forceinline__ int v_rd_base(int lane) { return ((lane & 3) << 3) | (((lane >> 2) & 3) << 6) | (((lane >> 4) & 1) << 5) | (((lane >> 5) & 1) << 8); }
constexpr int v_rd_off(int d0, int ks, int half) { return d0 * 512 + ks * 2048 + half * 1024; }
template <int OFF> __device__ __forceinline__ s16x4 tr_read(int vb) {
    s16x4 r; asm volatile("ds_read_b64_tr_b16 %0, %1 offset:%2" : "=&v"(r) : "v"(vb), "i"(OFF) : "memory"); return r;
}
template <int D0> __device__ __forceinline__ void pv_one(f32x16& od, int vb, bf16x8 pa0, bf16x8 pa1, bf16x8 pa2, bf16x8 pa3) {
    const s16x4 l0 = tr_read<v_rd_off(D0, 0, 0)>(vb), h0 = tr_read<v_rd_off(D0, 0, 1)>(vb), l1 = tr_read<v_rd_off(D0, 1, 0)>(vb), h1 = tr_read<v_rd_off(D0, 1, 1)>(vb);
    const s16x4 l2 = tr_read<v_rd_off(D0, 2, 0)>(vb), h2 = tr_read<v_rd_off(D0, 2, 1)>(vb), l3 = tr_read<v_rd_off(D0, 3, 0)>(vb), h3 = tr_read<v_rd_off(D0, 3, 1)>(vb);
    asm volatile("s_waitcnt lgkmcnt(0)" ::: "memory"); SBAR();
#define PK(L, H) (bf16x8){L[0], L[1], L[2], L[3], H[0], H[1], H[2], H[3]}
    od = __builtin_amdgcn_mfma_f32_32x32x16_bf16(pa0, PK(l0, h0), od, 0, 0, 0);
    od = __builtin_amdgcn_mfma_f32_32x32x16_bf16(pa1, PK(l1, h1), od, 0, 0, 0);
    od = __builtin_amdgcn_mfma_f32_32x32x16_bf16(pa2, PK(l2, h2), od, 0, 0, 0);
    od = __builtin_amdgcn_mfma_f32_32x32x16_bf16(pa3, PK(l3, h3), od, 0, 0, 0);
#undef PK
}
__device__ __forceinline__ void pv_d0(f32x16* o, int vb, bf16x8 pa0, bf16x8 pa1, bf16x8 pa2, bf16x8 pa3) {
    pv_one<0>(o[0], vb, pa0, pa1, pa2, pa3); pv_one<1>(o[1], vb, pa0, pa1, pa2, pa3);
}
__device__ __forceinline__ void partialSM(f32x16& p0, f32x16& p1, float& m_ref, f32x16& negm, float& alpha, bool& fresh) {
    float pmax = p0[0];
#pragma unroll
    for (int r = 1; r < 16; ++r) pmax = fmaxf(pmax, p0[r]);
#pragma unroll
    for (int r = 0; r < 16; ++r) pmax = fmaxf(pmax, p1[r]);
    { auto rr = __builtin_amdgcn_permlane32_swap(__float_as_uint(pmax), __float_as_uint(pmax), false, false);
      pmax = fmaxf(__uint_as_float(rr[0]), __uint_as_float(rr[1])); }
    alpha = 1.f;
    if (__builtin_expect(fresh || !__all(pmax <= THR), 0)) {
        const float dl = fresh ? pmax : fmaxf(pmax, 0.f);
        m_ref += dl;
#pragma unroll
        for (int r = 0; r < 16; ++r) { p0[r] -= dl; p1[r] -= dl; }
        const float nm = -m_ref;
#pragma unroll
        for (int r = 0; r < 16; ++r) negm[r] = nm;
        alpha = fresh ? 1.f : __builtin_amdgcn_exp2f(-dl);
        fresh = false;
    }
#pragma unroll
    for (int r = 0; r < 16; ++r) p0[r] = __builtin_amdgcn_exp2f(p0[r]);
}
__device__ __forceinline__ void finishSM(f32x16& p0, f32x16& p1, float alpha, float& l_reg, bf16x8& pa0, bf16x8& pa1, bf16x8& pa2, bf16x8& pa3) {
#pragma unroll
    for (int r = 0; r < 16; ++r) p1[r] = __builtin_amdgcn_exp2f(p1[r]);
    float ps = 0;
#pragma unroll
    for (int r = 0; r < 16; ++r) ps += p0[r];
#pragma unroll
    for (int r = 0; r < 16; ++r) ps += p1[r];
    { auto rr = __builtin_amdgcn_permlane32_swap(__float_as_uint(ps), __float_as_uint(ps), false, false);
      ps = __uint_as_float(rr[0]) + __uint_as_float(rr[1]); }
    l_reg = l_reg * alpha + ps;
#define PK4(P, BASE, OUT) do { unsigned a0 = cvt_pk_bf16(P[BASE + 0], P[BASE + 1]), a1 = cvt_pk_bf16(P[BASE + 2], P[BASE + 3]);   \
    unsigned b0 = cvt_pk_bf16(P[BASE + 4], P[BASE + 5]), b1 = cvt_pk_bf16(P[BASE + 6], P[BASE + 7]);                              \
    auto r0 = __builtin_amdgcn_permlane32_swap(a0, b0, false, false); auto r1 = __builtin_amdgcn_permlane32_swap(a1, b1, false, false); \
    u32x4 w = {r0[0], r1[0], r0[1], r1[1]}; OUT = *reinterpret_cast<bf16x8*>(&w); } while (0)
    PK4(p0, 0, pa0); PK4(p0, 8, pa1); PK4(p1, 0, pa2); PK4(p1, 8, pa3);
#undef PK4
}
template <int ND0, int KROW>
__device__ __forceinline__ void qkt(f32x16& p0, f32x16& p1, const char* Ks, const bf16x8* qr, const f32x16& negm, int r32, int hi) {
#pragma unroll
    for (int d0 = 0; d0 < ND0; ++d0) { const int cb = (d0 * 16 + hi * 8) * 2;
        const bf16x8 b0 = *reinterpret_cast<const bf16x8*>(Ks + r32 * KROW + cb);
        const bf16x8 b1 = *reinterpret_cast<const bf16x8*>(Ks + (32 + r32) * KROW + cb);
        if (d0 == 0) { p0 = __builtin_amdgcn_mfma_f32_32x32x16_bf16(b0, qr[0], negm, 0, 0, 0); p1 = __builtin_amdgcn_mfma_f32_32x32x16_bf16(b1, qr[0], negm, 0, 0, 0); }
        else { p0 = __builtin_amdgcn_mfma_f32_32x32x16_bf16(b0, qr[d0], p0, 0, 0, 0); p1 = __builtin_amdgcn_mfma_f32_32x32x16_bf16(b1, qr[d0], p1, 0, 0, 0); } }
}

template <int MODE>
__device__ __forceinline__ void attn_unit(const bf16_t* __restrict__ Qa, int ldqa, const bf16_t* __restrict__ Qb, int ldqb,
                                          const bf16_t* __restrict__ Ka, int ldka, const bf16_t* __restrict__ Kb, int ldkb, const bf16_t* __restrict__ Vv, int ldv,
                                          bf16_t* __restrict__ O, int NT, int krow0, int ntreal, int qrow0, const float* __restrict__ rpbh, char* lds) {
    constexpr int ND0 = MODE == 0 ? 6 : 4, KROW = MODE == 0 ? KROW_MLA : KROW_NA;
    const int tid = threadIdx.x, wid = __builtin_amdgcn_readfirstlane(tid >> 6), lane = tid & 63, r32 = lane & 31, hi = lane >> 5;
    char* V_lds = lds + OFF_V; char* K_lds = lds + OFF_K;
    float* ws = (float*)(lds + OFF_WS) + wid * 64; float* li_l = ws; float* al_l = ws + 32;
    float* biasL = (float*)(lds + OFF_BIAS);
    float m_ref = 0.f, l_reg = 0; f32x16 o[2] = {}; f32x16 negm = {}; bool fresh = true; bf16x8 qr[ND0];
    {   const bf16_t* Qw = Qa + (size_t)(wid * QBLK + r32) * ldqa + hi * 8;
#pragma unroll
        for (int d0 = 0; d0 < 4; ++d0) qr[d0] = *reinterpret_cast<const bf16x8*>(Qw + d0 * 16);
        if constexpr (MODE == 0) { const bf16_t* Qw2 = Qb + (size_t)(wid * QBLK + r32) * ldqb + hi * 8;
#pragma unroll
            for (int d0 = 0; d0 < 2; ++d0) qr[4 + d0] = *reinterpret_cast<const bf16x8*>(Qw2 + d0 * 16); } }
    int qgr = 0, rs0 = 0, qc = 0, cs = 0;
    if constexpr (MODE == 1) {
        qgr = qrow0 + (wid >> 1); rs0 = min(max(qgr - 4, 0), 120); qc = 32 * (wid & 1) + r32; cs = min(max(qc - 8, 0), 48);
        for (int i = tid; i < 15 * 31; i += 512) biasL[i] = rpbh[i] * LOG2E;
    }
    const int sr = tid >> 3, sc = (tid & 7) * 8;
    const int sr2 = (tid & 255) >> 2, sc2 = (tid & 3) * 8;
    const int vst = v_st(sr, sc);
    const int vb0 = (int)(uintptr_t)V_lds + v_rd_base(lane);
    struct { bf16x8 v, k, k2; } sr_[1];
#define KROWOF(t) (MODE == 1 ? min(krow0 + (t), 127) * 64 : (t) * 64)
#define SLOAD(i, t) do { const long k0_ = KROWOF(t); sr_[i].v = *reinterpret_cast<const bf16x8*>(&Vv[(k0_ + sr) * ldv + sc]); sr_[i].k = *reinterpret_cast<const bf16x8*>(&Ka[(k0_ + sr) * ldka + sc]); \
        if constexpr (MODE == 0) sr_[i].k2 = *reinterpret_cast<const bf16x8*>(&Kb[(k0_ + sr2) * ldkb + sc2]); } while (0)
#define SWRITE(b, i) do { *(bf16x8*)(V_lds + (b) * SHM_V + vst) = sr_[i].v; *(bf16x8*)(K_lds + (b) * SHM_K + sr * KROW + sc * 2) = sr_[i].k; \
        if constexpr (MODE == 0) { if (tid < 256) *(bf16x8*)(K_lds + (b) * SHM_K + sr2 * KROW + 128 + sc2 * 2) = sr_[i].k2; } } while (0)
#define SWAIT() do { if constexpr (MODE == 0) asm volatile("s_waitcnt vmcnt(3)" ::: "memory"); else asm volatile("s_waitcnt vmcnt(2)" ::: "memory"); } while (0)
#define RESC(a) do { if (__any((a) < 1.f)) { if (hi == 0) al_l[r32] = (a); asm volatile("s_waitcnt lgkmcnt(0)" ::: "memory"); \
        _Pragma("unroll") for (int d = 0; d < 2; ++d) _Pragma("unroll") for (int r = 0; r < 16; ++r) o[d][r] *= al_l[crow(r, hi)]; } } while (0)
#define TVALID(t) (MODE == 0 ? true : ((t) < ntreal && (krow0 + (t)) >= rs0 && (krow0 + (t)) < rs0 + 8))
#define MASKB(P0, P1, t) do { if constexpr (MODE == 1) { const int dr_ = krow0 + (t) - qgr + 7; int d_ = 4 * hi - cs; asm volatile("" : "+v"(d_)); \
        const LAS float* bl_ = (const LAS float*)((LAS char*)lds + OFF_BIAS) + (dr_ * 31 + 15 - qc + 4 * hi); \
        _Pragma("unroll") for (int r = 0; r < 16; ++r) { const int c0_ = (r & 3) + 8 * (r >> 2); \
            const bool in0 = (unsigned)(c0_ + d_) < 16u, in1 = (unsigned)(c0_ + 32 + d_) < 16u; \
            const float b0_ = bl_[c0_], b1_ = bl_[c0_ + 32]; \
            P0[r] = in0 ? P0[r] + b0_ : -1e30f; P1[r] = in1 ? P1[r] + b1_ : -1e30f; } } } while (0)
    f32x16 pA0, pA1, pB0, pB1; float alA = 1.f, alB = 1.f; bf16x8 pa0, pa1, pa2, pa3;
    SLOAD(0, 0); asm volatile("s_waitcnt vmcnt(0)" ::: "memory"); SWRITE(0, 0); SLOAD(0, 1); asm volatile("s_waitcnt vmcnt(0)" ::: "memory"); SWRITE(1, 0);
    if (NT > 2) SLOAD(0, 2);
    __syncthreads();
    const int NI = NT >> 1;
    for (int it = 0; it < NI; ++it) {
        const int kb = (it & 1) * 2, nb = 2 - kb; const bool more = it + 1 < NI;
        if (more) { SWRITE(nb, 0); SLOAD(0, 2 * it + 3); }
        const int ta = 2 * it, tb = ta + 1;
        const bool vA = TVALID(ta), vB = TVALID(tb);
        if (vA) { qkt<ND0, KROW>(pA0, pA1, K_lds + kb * SHM_K, qr, negm, r32, hi); MASKB(pA0, pA1, ta); partialSM(pA0, pA1, m_ref, negm, alA, fresh); RESC(alA); }
        SBAR();
        if (vB) { qkt<ND0, KROW>(pB0, pB1, K_lds + (kb + 1) * SHM_K, qr, negm, r32, hi); MASKB(pB0, pB1, tb); }
        if (vA) { finishSM(pA0, pA1, alA, l_reg, pa0, pa1, pa2, pa3); SBAR(); pv_d0(o, vb0 + kb * SHM_V, pa0, pa1, pa2, pa3); }
        if (more) { SWRITE(nb + 1, 0); if (it + 2 < NI) SLOAD(0, 2 * it + 4); }
        if (vB) { partialSM(pB0, pB1, m_ref, negm, alB, fresh); RESC(alB); finishSM(pB0, pB1, alB, l_reg, pa0, pa1, pa2, pa3); SBAR(); pv_d0(o, vb0 + (kb + 1) * SHM_V, pa0, pa1, pa2, pa3); }
        __syncthreads();
    }
    asm volatile("s_waitcnt vmcnt(0)" ::: "memory");
    if (hi == 0) li_l[r32] = l_reg; asm volatile("s_waitcnt lgkmcnt(0)" ::: "memory");
    float rli[16];
#pragma unroll
    for (int r = 0; r < 16; ++r) rli[r] = __builtin_amdgcn_rcpf(li_l[crow(r, hi)]);
    {   bf16_t* stg = (bf16_t*)(lds + OFF_OST) + wid * 2048;
#pragma unroll
        for (int r = 0; r < 16; ++r) { const int orow = crow(r, hi);
#pragma unroll
            for (int d0 = 0; d0 < 2; ++d0) stg[orow * 64 + d0 * 32 + r32] = (bf16_t)(cvt_pk_bf16(o[d0][r] * rli[r], 0.f) & 0xffffu); }
        asm volatile("s_waitcnt lgkmcnt(0)" ::: "memory");
        bf16_t* Ow = O + (size_t)(wid * QBLK) * 512;
#pragma unroll
        for (int i = 0; i < 4; ++i) { const int row = i * 8 + (lane >> 3), ch = lane & 7; const u32x4 v = *(const u32x4*)(stg + row * 64 + ch * 8); *(u32x4*)(Ow + (size_t)row * 512 + ch * 8) = v; } }
    __syncthreads();
#undef KROWOF
#undef SLOAD
#undef SWRITE
#undef SWAIT
#undef RESC
#undef TVALID
#undef MASKB
}
#undef SBAR
}

constexpr size_t MiB = 1u << 20;
constexpr size_t WS_CTL = 0, CTL_ZERO_BYTES = 1 * MiB;
constexpr size_t WS_WIN = 2 * MiB;
constexpr size_t WS_WUQ = 11 * MiB;
constexpr size_t WS_WUKV = 12 * MiB;
constexpr size_t WS_WNA = 13 * MiB, WS_WMLA = 14 * MiB;
constexpr size_t WS_WOUT = 15 * MiB;
constexpr size_t WS_W1 = 18 * MiB;
constexpr size_t WS_W2 = 146 * MiB;
constexpr size_t WS_XN = 210 * MiB;
constexpr size_t WS_PROJ = 242 * MiB;
constexpr size_t WS_QN = 378 * MiB, WS_QR = 394 * MiB, WS_KN = 402 * MiB, WS_KR = 418 * MiB, WS_VM = 419 * MiB;
constexpr size_t WS_ONA = 435 * MiB, WS_OMLA = 451 * MiB;
constexpr size_t WS_MERGED = 467 * MiB;
constexpr size_t WS_TMP = 499 * MiB;
constexpr size_t WS_LIST = 563 * MiB;
constexpr size_t WS_TOKPOS = 565 * MiB, WS_TOKG = 566 * MiB;
constexpr size_t WS_ACT = 568 * MiB;
constexpr size_t WS_YIT = 712 * MiB;
constexpr size_t WS_SSQ = 856 * MiB;
constexpr size_t WS_MODP = 857 * MiB;
constexpr size_t WS_WRT = 858 * MiB;
constexpr size_t WS_END = 859 * MiB;
constexpr int CW_BAR = 4096;
constexpr int CW_CNT = 8192;
constexpr int CW_MOD = 16384;
constexpr int CW_ROPE = 32768;
static_assert((CW_ROPE + 2048) * 4 <= (int)CTL_ZERO_BYTES, "CTL");

constexpr int RING_BYTES = 131072;
constexpr int TAB_OFF = RING_BYTES;
constexpr int TAB_BLK = TAB_OFF, TAB_GATH = TAB_OFF + 2048;
constexpr int MISC_OFF = TAB_GATH + 11 * 1024;
constexpr int LDS_BYTES = 147456;
static_assert(MISC_OFF + 256 <= LDS_BYTES, "LDS map");

#define RLX_AGENT __ATOMIC_RELAXED, __HIP_MEMORY_SCOPE_AGENT
#define LDS_WAIT() asm volatile("s_waitcnt lgkmcnt(0)" ::: "memory")

#define XB_TMO      128
#define XB_XCNT(j)  (256  + 64 * (j))
#define XB_XSUB(j)  (1280 + 64 * (j))
#define XB_XGEN(j)  (2304 + 64 * (j))
#define XB_TOP      3328
#define XB_TOPGEN   3392
#define XCD_BAR_WORDS 3456
#define XB_SPIN_CAP (1u << 22)
__device__ __forceinline__ unsigned xb_ld(unsigned* p)              { return __hip_atomic_load(p, __ATOMIC_RELAXED, __HIP_MEMORY_SCOPE_AGENT); }
__device__ __forceinline__ unsigned xb_add(unsigned* p, unsigned v) { return __hip_atomic_fetch_add(p, v, __ATOMIC_RELAXED, __HIP_MEMORY_SCOPE_AGENT); }
__device__ __forceinline__ unsigned xb_xcc_id() { return (unsigned)__builtin_amdgcn_s_getreg((3 << 11) | 20) & 0xFu; }
#define XB_SPIN(cond, bar) do { unsigned _sp = 0; while (cond) { __builtin_amdgcn_s_sleep(1); \
    if ((++_sp & 255u) == 0u) { if (xb_ld(&(bar)[XB_TMO])) break; if (_sp > XB_SPIN_CAP) { atomicAdd(&(bar)[XB_TMO], 1u); break; } } } } while (0)
struct XcdBarrier { unsigned* bar; unsigned x; volatile LAS unsigned* st; };
__device__ __forceinline__ XcdBarrier xcd_barrier_post(unsigned* bar, volatile LAS unsigned* st) {
    XcdBarrier b; b.bar = bar; b.x = xb_xcc_id(); b.st = st;
    if (threadIdx.x == 0) (void)xb_add(&bar[XB_XCNT(b.x)], 1u);
    return b;
}
__device__ __forceinline__ void xcd_barrier_complete(unsigned* bar, unsigned x, unsigned& nloc, unsigned& nx) {
    const unsigned G = gridDim.x * gridDim.y * gridDim.z;
    unsigned sum, cnt, mine, sp = 0u;
    for (;;) {
        sum = 0u; cnt = 0u; mine = 0u;
#pragma unroll
        for (unsigned j = 0; j < 16; ++j) { const unsigned c = xb_ld(&bar[XB_XCNT(j)]); sum += c; cnt += (c > 0u) ? 1u : 0u; mine = (j == x) ? c : mine; }
        if (sum == G) break;
        __builtin_amdgcn_s_sleep(1);
        if ((++sp & 255u) == 0u) { if (xb_ld(&bar[XB_TMO])) break; if (sp > XB_SPIN_CAP) { atomicAdd(&bar[XB_TMO], 1u); break; } }
    }
    nloc = mine > 0u ? mine : 1u; nx = cnt > 0u ? cnt : 1u;
}
__device__ __forceinline__ void xcd_barrier(const XcdBarrier& b) {
    asm volatile("s_waitcnt vmcnt(0)" ::: "memory");
    __syncthreads();
    if (threadIdx.x == 0) {
        unsigned* bar = b.bar;
        __builtin_amdgcn_s_waitcnt(0);
        unsigned nloc = b.st[0], nx = b.st[1];
        if (nloc == 0u) { xcd_barrier_complete(bar, b.x, nloc, nx); b.st[0] = nloc; b.st[1] = nx; }
        const unsigned old = xb_add(&bar[XB_XSUB(b.x)], 1u);
        const unsigned gen = old / nloc;
        if (old + 1u == (gen + 1u) * nloc) {
            __builtin_amdgcn_fence(__ATOMIC_RELEASE, "agent");
            asm volatile("s_waitcnt vmcnt(0)" ::: "memory");
            const unsigned og = xb_add(&bar[XB_TOP], 1u);
            const unsigned tg = og / nx;
            if (og + 1u == (tg + 1u) * nx) xb_add(&bar[XB_TOPGEN], 1u);
            else XB_SPIN(xb_ld(&bar[XB_TOPGEN]) == tg, bar);
            __builtin_amdgcn_fence(__ATOMIC_ACQUIRE, "agent");
            xb_add(&bar[XB_XGEN(b.x)], 1u);
            asm volatile("s_waitcnt vmcnt(0)" ::: "memory");
        } else {
            XB_SPIN(xb_ld(&bar[XB_XGEN(b.x)]) == gen, bar);
            __builtin_amdgcn_fence(__ATOMIC_ACQUIRE, "agent");
            asm volatile("s_waitcnt vmcnt(0)" ::: "memory");
        }
    }
    __syncthreads();
}

constexpr int NWAVES = 8;
struct Args { const float* in[24]; float* out; unsigned char* ws; int ph_lo, ph_hi; };
enum { I_X = 0, I_C, I_WADA, I_BADA, I_GAPRE, I_GAPOST, I_WIN, I_BGATE, I_RPB, I_QNG, I_KVNG, I_WUQ, I_WUKV, I_WNAUP, I_WMLAUP, I_WOUT, I_GFPRE, I_GFPOST, I_WR, I_BR, I_W1, I_B1, I_W2, I_B2 };

__device__ __forceinline__ void tr_store_tile(LAS unsigned char* scr, bf16_t* dst, int K, int n0, int k0, int lane) {
    LDS_WAIT(); asm volatile("" ::: "memory");
#pragma unroll
    for (int j = 0; j < 8; ++j) { const int idx = j * 64 + lane, n = idx >> 3, ch = idx & 7;
        const u32x4 v = *(const LAS u32x4*)(scr + n * 144 + ch * 16);
        *(GAS u32x4*)(dst + (size_t)(n0 + n) * K + k0 + ch * 8) = v; }
    LDS_WAIT(); asm volatile("" ::: "memory");
}
__device__ __forceinline__ void tr_tile_fast(const float* src, int Nsrc, int src0, const float* kscale, bf16_t* dst, int K, int n0, int k0, LAS unsigned char* scr, int lane) {
#pragma unroll
    for (int st = 0; st < 8; ++st) { const int kq = st * 4 + (lane >> 4), c4 = (lane & 15) * 4, k = 2 * kq;
        f32x4 a = *(const GAS f32x4*)(src + (size_t)(k0 + k) * Nsrc + src0 + c4);
        f32x4 b = *(const GAS f32x4*)(src + (size_t)(k0 + k + 1) * Nsrc + src0 + c4);
        if (kscale) { const float s0 = kscale[k0 + k], s1 = kscale[k0 + k + 1]; a = a * s0; b = b * s1; }
#pragma unroll
        for (int i = 0; i < 4; ++i) *(LAS unsigned*)(scr + (c4 + i) * 144 + k * 2) = cvt_pk_bf16(a[i], b[i]); }
    tr_store_tile(scr, dst, K, n0, k0, lane);
}
__device__ __forceinline__ void tr_tile_slow(const float* src, int Nsrc, int srccol  , const float* kscale, bf16_t* dst, int K, int n0, int k0, LAS unsigned char* scr, int lane) {
#pragma unroll
    for (int k = 0; k < 64; k += 2) {
        float a = 0.f, b = 0.f;
        if (srccol >= 0) { a = src[(size_t)(k0 + k) * Nsrc + srccol]; b = src[(size_t)(k0 + k + 1) * Nsrc + srccol];
            if (kscale) { a *= kscale[k0 + k]; b *= kscale[k0 + k + 1]; } }
        *(LAS unsigned*)(scr + lane * 144 + k * 2) = cvt_pk_bf16(a, b); }
    tr_store_tile(scr, dst, K, n0, k0, lane);
}
__device__ __forceinline__ void tr_tile_fast8(const float* src, int Nsrc, int src0, unsigned char* dst, int K, int n0, int k0, LAS unsigned char* scr, int lane) {
#pragma unroll
    for (int st = 0; st < 4; ++st) { const int kq = st * 4 + (lane >> 4), c4 = (lane & 15) * 4, k = 4 * kq;
        const f32x4 a = __builtin_nontemporal_load((const f32x4*)(src + (size_t)(k0 + k) * Nsrc + src0 + c4)) * SC_W, b = __builtin_nontemporal_load((const f32x4*)(src + (size_t)(k0 + k + 1) * Nsrc + src0 + c4)) * SC_W;
        const f32x4 c = __builtin_nontemporal_load((const f32x4*)(src + (size_t)(k0 + k + 2) * Nsrc + src0 + c4)) * SC_W, d = __builtin_nontemporal_load((const f32x4*)(src + (size_t)(k0 + k + 3) * Nsrc + src0 + c4)) * SC_W;
#pragma unroll
        for (int i = 0; i < 4; ++i) { int w = __builtin_amdgcn_cvt_pk_fp8_f32(a[i], b[i], 0, false); w = __builtin_amdgcn_cvt_pk_fp8_f32(c[i], d[i], w, true);
            *(LAS int*)(scr + (c4 + i) * 80 + k) = w; } }
    LDS_WAIT(); asm volatile("" ::: "memory");
#pragma unroll
    for (int j = 0; j < 4; ++j) { const int idx = j * 64 + lane, n = idx >> 2, ch = idx & 3;
        const u32x4 v = *(const LAS u32x4*)(scr + n * 80 + ch * 16);
        __builtin_nontemporal_store(v, (u32x4*)(dst + (size_t)(n0 + n) * K + k0 + ch * 16)); }
    LDS_WAIT(); asm volatile("" ::: "memory");
}
__device__ __forceinline__ int rope_orig(int p) { return (p & 16) + 8 * (p & 1) + ((p & 15) >> 1); }

__global__ void __launch_bounds__(NWAVES * 64, 2) fwd_kernel(Args args_unused_) {
#define args (*(const __attribute__((address_space(4))) Args*)__builtin_amdgcn_kernarg_segment_ptr())
    extern __shared__ __attribute__((aligned(16))) unsigned char lds[];
    LAS unsigned char* L = (LAS unsigned char*)lds;
    volatile LAS unsigned* MISC = (volatile LAS unsigned*)(L + MISC_OFF);
    const int tid = threadIdx.x, lane = tid & 63, wave = __builtin_amdgcn_readfirstlane(tid >> 6);
    const int G = gridDim.x, bx = blockIdx.x, vcu = (G % 8 == 0) ? (bx % 8) * (G / 8) + bx / 8 : bx;
    unsigned char* ws = args.ws;
    gu32* ctl = (gu32*)(ws + WS_CTL);
    const int lo = args.ph_lo, hi = args.ph_hi;
    for (int u = tid; u < 64; u += NWAVES * 64) MISC[u] = 0u;
    __syncthreads();
    XcdBarrier bar; bar.bar = (unsigned*)(ctl + CW_BAR); bar.x = 0; bar.st = nullptr;
    const bool use_bar = (hi - lo) > 1;
    if (use_bar) bar = xcd_barrier_post((unsigned*)(ctl + CW_BAR), MISC + 8);
#ifndef PHASE_MASK
#define PHASE_MASK 0xFFFF
#endif
#define IN(k) (((PHASE_MASK >> (k)) & 1) && lo <= (k) && (k) < hi)
#ifndef REPMASK
#define REPMASK 0
#endif
#define NREP(k) (1 + ((REPMASK >> (k)) & 1))
#define SEAM(k) do { if (IN(k) && IN((k) + 1)) xcd_barrier(bar); } while (0)
    const int gw = vcu * NWAVES + wave, NGW = G * NWAVES;
    float* ROPE = (float*)(ctl + CW_ROPE);
    float* MODP = (float*)(ws + WS_MODP); float* MOD = (float*)(ws + WS_MODP + 512 * 1024); float* SSQ = (float*)(ws + WS_SSQ); unsigned* CNT = (unsigned*)(ctl + CW_CNT);
    bf16_t* WINT = (bf16_t*)(ws + WS_WIN); bf16_t* WUQT = (bf16_t*)(ws + WS_WUQ); bf16_t* WUKVT = (bf16_t*)(ws + WS_WUKV);
    bf16_t* WNAT = (bf16_t*)(ws + WS_WNA); bf16_t* WMLAT = (bf16_t*)(ws + WS_WMLA); bf16_t* WOUTT = (bf16_t*)(ws + WS_WOUT);
    bf16_t* W1T = (bf16_t*)(ws + WS_W1); bf16_t* W2T = (bf16_t*)(ws + WS_W2);
    bf16_t* XN = (bf16_t*)(ws + WS_XN); bf16_t* PROJ = (bf16_t*)(ws + WS_PROJ);
    bf16_t* QN = (bf16_t*)(ws + WS_QN); bf16_t* QR = (bf16_t*)(ws + WS_QR); bf16_t* KN = (bf16_t*)(ws + WS_KN); bf16_t* KR = (bf16_t*)(ws + WS_KR); bf16_t* VM = (bf16_t*)(ws + WS_VM);
    bf16_t* ONA = (bf16_t*)(ws + WS_ONA); bf16_t* OMLA = (bf16_t*)(ws + WS_OMLA); bf16_t* MERGED = (bf16_t*)(ws + WS_MERGED);
    float* TMP = (float*)(ws + WS_TMP); unsigned* LIST = (unsigned*)(ws + WS_LIST); unsigned* TOKPOS = (unsigned*)(ws + WS_TOKPOS); float* TOKG = (float*)(ws + WS_TOKG);
    bf16_t* ACT = (bf16_t*)(ws + WS_ACT); bf16_t* YIT = (bf16_t*)(ws + WS_YIT);
    const float* X = args.in[I_X]; float* OUT = args.out; bf16_t* X1B = (bf16_t*)TMP + (size_t)MTOK * DM;

    if (IN(0)) for (int rep_ = 0; rep_ < NREP(0); ++rep_) {
        LAS unsigned char* scr = L + wave * 16384;
        if (vcu < 192) { const float* c = args.in[I_C]; const float* wada = args.in[I_WADA]; const float* bada = args.in[I_BADA];
            const int cb = vcu % 24, kc = vcu / 24, k0 = kc * 128 + wave * 16, n0 = cb * 256 + lane * 4;
            f32x4 w[16];
#pragma unroll
            for (int k = 0; k < 16; ++k) w[k] = *(const GAS f32x4*)(wada + (size_t)(k0 + k) * 6144 + n0);
            f32x4 a0 = {0.f, 0.f, 0.f, 0.f}, a1 = {0.f, 0.f, 0.f, 0.f};
#pragma unroll
            for (int k = 0; k < 16; ++k) { const float c0 = c[k0 + k], c1 = c[1024 + k0 + k]; a0 += w[k] * (c0 * sigmoidf_(c0)); a1 += w[k] * (c1 * sigmoidf_(c1)); }
            LAS f32x4* red = (LAS f32x4*)(L + 65536);
            red[(wave * 2 + 0) * 64 + lane] = a0; red[(wave * 2 + 1) * 64 + lane] = a1;
            __syncthreads();
            { const int b = tid >> 8, col = tid & 255; const LAS float* rf = (const LAS float*)red; float sm = 0.f;
#pragma unroll
              for (int wv = 0; wv < 8; ++wv) sm += rf[(wv * 2 + b) * 256 + col];
              if (kc == 0) sm += bada[cb * 256 + col];
              MODP[(kc * 2 + b) * 6144 + cb * 256 + col] = sm; }
            __syncthreads();
        }
        if (bx == 0) { for (int i = tid; i < 128 * 8; i += NWAVES * 64) { const int pos = i >> 3, j = i & 7; float c, sn; rope_cs((float)pos, j, c, sn); ROPE[pos * 16 + j] = c; ROPE[pos * 16 + 8 + j] = sn; } }
        { const float* Wr = args.in[I_WR]; float* WRT = (float*)(ws + WS_WRT);
          for (int it = NGW - 1 - gw; it < NEXP * 16; it += NGW) { const int e = it >> 4, k = (it & 15) * 64 + lane; WRT[e * 1024 + k] = Wr[(size_t)k * 32 + e]; } }
        {   constexpr int I_WIN_ = 16 * 68, I_UQ = 6 * 12, I_UKV = 4 * 16, I_UP = 8 * 16, I_OUT = 16 * 16;
            constexpr int NITEMS = I_WIN_ + I_UQ + I_UKV + 2 * I_UP + I_OUT;
            for (int it = gw; it < NITEMS; it += NGW) {
                int r = it;
                if (r < I_WIN_) { const int kb = r / 68, nb = r % 68;
                    if (nb < 34) tr_tile_fast(args.in[I_WIN], 4256, nb * 64, nullptr, WINT, 1024, nb * 64, kb * 64, scr, lane);
                    else if (nb >= 36) tr_tile_fast(args.in[I_WIN], 4256, 2208 + (nb - 36) * 64, nullptr, WINT, 1024, nb * 64, kb * 64, scr, lane);
                    else { const int n = nb * 64 + lane; const int sc = (n < 2208) ? 2176 + rope_orig(n - 2176) : -1;
                        tr_tile_slow(args.in[I_WIN], 4256, sc, nullptr, WINT, 1024, nb * 64, kb * 64, scr, lane); }
                    continue; } r -= I_WIN_;
                if (r < I_UQ) { const int kb = r / 12, nb = r % 12;
                    if (nb < 8) tr_tile_fast(args.in[I_WUQ], 768, nb * 96, args.in[I_QNG], WUQT, 384, nb * 64, kb * 64, scr, lane);
                    else { const int n = nb * 64 + lane - 512, h = n >> 5, p = n & 31;
                        tr_tile_slow(args.in[I_WUQ], 768, h * 96 + 64 + rope_orig(p), args.in[I_QNG], WUQT, 384, nb * 64, kb * 64, scr, lane); }
                    continue; } r -= I_UQ;
                if (r < I_UKV) { const int kb = r / 16, nb = r % 16;
                    const int s0 = (nb < 8) ? nb * 128 : (nb - 8) * 128 + 64;
                    tr_tile_fast(args.in[I_WUKV], 1024, s0, args.in[I_KVNG], WUKVT, 256, nb * 64, kb * 64, scr, lane); continue; } r -= I_UKV;
                if (r < I_UP) { const int kb = r / 16, nb = r % 16; tr_tile_fast(args.in[I_WNAUP], 1024, nb * 64, nullptr, WNAT, 512, nb * 64, kb * 64, scr, lane); continue; } r -= I_UP;
                if (r < I_UP) { const int kb = r / 16, nb = r % 16; tr_tile_fast(args.in[I_WMLAUP], 1024, nb * 64, nullptr, WMLAT, 512, nb * 64, kb * 64, scr, lane); continue; } r -= I_UP;
                { const int kb = r / 16, nb = r % 16; tr_tile_fast(args.in[I_WOUT], 1024, nb * 64, nullptr, WOUTT, 1024, nb * 64, kb * 64, scr, lane); }
            } }
    }
    SEAM(0);
    if (IN(1)) {
        const float* g = args.in[I_GAPRE];
        LAS float* modl = (LAS float*)L;
        for (int i = tid; i < 4096; i += NWAVES * 64) { const int b = i >> 11, c = i & 2047; float sm = 0.f;
#pragma unroll
            for (int kc = 0; kc < 8; ++kc) sm += MODP[(kc * 2 + b) * 6144 + c];
            modl[i] = sm; }
        for (int idx = bx * (NWAVES * 64) + tid; idx < 2 * 6144; idx += G * NWAVES * 64) { const int b = idx / 6144, n = idx % 6144; float sm = 0.f;
#pragma unroll
            for (int kc = 0; kc < 8; ++kc) sm += MODP[(kc * 2 + b) * 6144 + n];
            MOD[idx] = sm; }
        __syncthreads();
        for (int m0 = gw * 2; m0 < MTOK; m0 += NGW * 2) { const int b = m0 >> 13;
            f32x4 v[2][4]; float ss[2] = {0.f, 0.f};
#pragma unroll
            for (int r = 0; r < 2; ++r) { const GAS f32x4* xr = (const GAS f32x4*)(X + (size_t)(m0 + r) * DM) + lane;
#pragma unroll
                for (int j = 0; j < 4; ++j) v[r][j] = xr[64 * j]; }
#pragma unroll
            for (int r = 0; r < 2; ++r)
#pragma unroll
                for (int j = 0; j < 4; ++j) ss[r] += (v[r][j].x * v[r][j].x + v[r][j].y * v[r][j].y) + (v[r][j].z * v[r][j].z + v[r][j].w * v[r][j].w);
#pragma unroll
            for (int r = 0; r < 2; ++r) { const float rstd = __builtin_amdgcn_rsqf(wave_sum(ss[r]) * (1.f / DM) + RMS_EPS);
                GAS u32x2* o8 = (GAS u32x2*)(XN + (size_t)(m0 + r) * DM) + lane;
#pragma unroll
                for (int j = 0; j < 4; ++j) { const int col = 4 * lane + 256 * j;
                    const f32x4 gg = *(const f32x4*)(g + col), sh = *(const LAS f32x4*)(modl + b * 2048 + col), scl = *(const LAS f32x4*)(modl + b * 2048 + 1024 + col);
                    const f32x4 h = v[r][j] * rstd * gg * (scl + 1.f) + sh; u32x2 w; w.x = cvt_pk_bf16(h[0], h[1]); w.y = cvt_pk_bf16(h[2], h[3]); o8[64 * j] = w; } } }
    }
    SEAM(1);
    if (IN(2)) for (int rep_ = 0; rep_ < NREP(2); ++rep_) {
        if (bx < NG_INPROJ || G < 256) {
            const int ng = G < 256 ? G : NG_INPROJ;
            pg8::SchedDense S{(const char*)XN, (const char*)WINT, (size_t)256 * 1024 * 2, (size_t)256 * 1024 * 2, MTOK / 256, NPROJ / 256, ng, bx};
            pg8::EpiInProj E{PROJ, SSQ, KR, ROPE, args.in[I_BGATE]};
            pg8::gemm_phase<pg8::EpiInProj, pg8::SchedDense, true, false, false>(L, 16, 2048, 2048, S, E);
        }
        {   LAS unsigned char* scr = L + wave * 16384;
            constexpr int I_W1_ = NEXP * 16 * 32, I_W2_ = NEXP * 16 * 16, NCHUNK = (I_W1_ + I_W2_) / 32;
            for (;;) {
                if (tid == 0) MISC[20] = atomicAdd(CNT + 64, 1u);
                __syncthreads();
                const int chunk = (int)MISC[20];
                __syncthreads();
                if (chunk >= NCHUNK) break;
#pragma unroll 1
                for (int k = 0; k < 4; ++k) { int r = chunk * 32 + wave * 4 + k;
                    if (r < I_W1_) { const int e = r / 512, q = r % 512, kb = q / 32, nb = q % 32;
                        tr_tile_fast8(args.in[I_W1] + (size_t)e * 1024 * 2048, 2048, nb * 64, (unsigned char*)W1T + (size_t)e * 2048 * 1024, 1024, nb * 64, kb * 64, scr, lane); }
                    else { r -= I_W1_; const int e = r / 256, q = r % 256, kb = q / 16, nb = q % 16;
                        tr_tile_fast8(args.in[I_W2] + (size_t)e * 1024 * 1024, 1024, nb * 64, (unsigned char*)W2T + (size_t)e * 1024 * 1024, 1024, nb * 64, kb * 64, scr, lane); } }
            } }
    }
    SEAM(2);
    if (IN(3)) for (int rep_ = 0; rep_ < NREP(3); ++rep_) {
#ifndef NO_QUP
        {   pg8::SchedDense S{(const char*)(PROJ + 1536), (const char*)WUQT, (size_t)256 * NPROJ * 2, (size_t)256 * 384 * 2, MTOK / 256, 3, G, bx};
            pg8::EpiQUp E{QN, QR, SSQ, ROPE};
            pg8::gemm_phase<pg8::EpiQUp, pg8::SchedDense, true, false, false>(L, 6, NPROJ * 2, 768, S, E); }
#endif
#ifndef NO_KVUP
        {   pg8::SchedDense S{(const char*)(PROJ + 1920), (const char*)WUKVT, (size_t)256 * NPROJ * 2, (size_t)256 * 256 * 2, MTOK / 256, 4, G, G - 1 - bx};
            pg8::EpiKVUp E{KN, VM, SSQ};
            pg8::gemm_phase<pg8::EpiKVUp, pg8::SchedDense, true, false, false>(L, 4, NPROJ * 2, 512, S, E); }
#endif
    }
    SEAM(3);
    if (IN(4)) for (int rep_ = 0; rep_ < NREP(4); ++rep_) {
#ifndef NO_MLA
        for (int u = vcu; u < 512; u += G) {
            const int bh = u >> 5, qb = u & 31, b = bh >> 3, h = bh & 7; const size_t row0 = (size_t)b * SEQ + qb * 256, key0 = (size_t)b * SEQ;
            attn::attn_unit<0>(QN + row0 * 512 + h * 64, 512, QR + row0 * 256 + h * 32, 256, KN + key0 * 512 + h * 64, 512, KR + key0 * 32, 32, VM + key0 * 512 + h * 64, 512,
                               OMLA + row0 * 512 + h * 64, 128, 0, 128, 0, nullptr, (char*)lds);
        }
#endif
#ifndef NO_NA
        for (int u = vcu; u < 512; u += G) {
            const int bh = u >> 5, rb = u & 31, b = bh >> 3, h = bh & 7; const size_t row0 = (size_t)b * SEQ + rb * 256, key0 = (size_t)b * SEQ;
            const int krow0 = min(max(4 * rb - 4, 0), 120), klast = min(max(4 * rb + 3 - 4, 0), 120) + 7, ntreal = klast - krow0 + 1, NT = (ntreal + 1) & ~1;
            attn::attn_unit<1>(PROJ + row0 * NPROJ + h * 64, NPROJ, nullptr, 0, PROJ + key0 * NPROJ + 512 + h * 64, NPROJ, nullptr, 0, PROJ + key0 * NPROJ + 1024 + h * 64, NPROJ,
                               ONA + row0 * 512 + h * 64, NT, krow0, ntreal, 4 * rb, args.in[I_RPB] + h * 15 * 31, (char*)lds);
        }
#endif
    }
    SEAM(4);
    if (IN(5)) for (int rep_ = 0; rep_ < NREP(5); ++rep_) {
        pg8::SchedMerge S{(const char*)ONA, (const char*)OMLA, (const char*)WNAT, (const char*)WMLAT, MTOK / 256, 4, G, bx};
        pg8::EpiMerge E{PROJ, MERGED};
        pg8::gemm_phase<pg8::EpiMerge, pg8::SchedMerge, true, false, false, true>(L, 16, 1024, 1024, S, E);
    }
    SEAM(5);
    if (IN(6)) for (int rep_ = 0; rep_ < NREP(6); ++rep_) {
        pg8::SchedDense S{(const char*)MERGED, (const char*)WOUTT, (size_t)256 * 1024 * 2, (size_t)256 * 1024 * 2, MTOK / 256, 4, G, bx};
        pg8::EpiBf16Y E{(bf16_t*)TMP};
        pg8::gemm_phase<pg8::EpiBf16Y, pg8::SchedDense, true, false, false>(L, 16, 2048, 2048, S, E);
    }
    SEAM(6);
    if (IN(7)) {
        LAS int* sel_e = (LAS int*)(L + TAB_OFF); LAS float* sel_g = (LAS float*)(L + TAB_OFF + 1024); LAS int* sel_r = (LAS int*)(L + TAB_OFF + 2048);
        LAS int* lcnt = (LAS int*)(L + TAB_OFF + 3072); LAS int* lbase = (LAS int*)(L + TAB_OFF + 3072 + 128);
        LAS float* wl = (LAS float*)L;
        const float* gpo = args.in[I_GAPOST]; const float* gfp = args.in[I_GFPRE]; const float* br = args.in[I_BR];
        const float* WRT = (const float*)(ws + WS_WRT);
        {   f32x4 t_[16];
#pragma unroll
            for (int q = 0; q < 16; ++q) t_[q] = *((const GAS f32x4*)WRT + q * (NWAVES * 64) + tid);
#pragma unroll
            for (int q = 0; q < 16; ++q) *((LAS f32x4*)wl + q * (NWAVES * 64) + tid) = t_[q]; }
        __syncthreads();
        for (int blk = vcu; blk < MTOK / 64; blk += G) {
            if (tid < 32) lcnt[tid] = 0;
            __syncthreads();
            f32x4 hreg[8][4];
#pragma unroll
            for (int rr = 0; rr < 8; ++rr) { const int m = blk * 64 + wave * 8 + rr, b = m >> 13;
                const GAS u32x2* yr = (const GAS u32x2*)((const bf16_t*)TMP + (size_t)m * DM) + lane; const GAS f32x4* xr = (const GAS f32x4*)(X + (size_t)m * DM) + lane;
                f32x4 y[4], x1[4]; float s = 0.f;
#pragma unroll
                for (int j = 0; j < 4; ++j) { const u32x2 yw = yr[64 * j]; y[j] = (f32x4){bf16_lo(yw.x), bf16_hi(yw.x), bf16_lo(yw.y), bf16_hi(yw.y)}; x1[j] = xr[64 * j]; s += (y[j].x * y[j].x + y[j].y * y[j].y) + (y[j].z * y[j].z + y[j].w * y[j].w); }
                const float rstd = __builtin_amdgcn_rsqf(wave_sum(s) * (1.f / DM) + RMS_EPS); float s2 = 0.f;
#pragma unroll
                for (int j = 0; j < 4; ++j) { const int col = 4 * lane + 256 * j;
                    const f32x4 gg = *(const f32x4*)(gpo + col), ga = *(const f32x4*)(MOD + b * 6144 + 2048 + col);
                    x1[j] = x1[j] + ga * (y[j] * rstd * gg);
                    { u32x2 xw; xw.x = cvt_pk_bf16(x1[j][0], x1[j][1]); xw.y = cvt_pk_bf16(x1[j][2], x1[j][3]); *((GAS u32x2*)(X1B + (size_t)m * DM) + lane + 64 * j) = xw; }
                    s2 += (x1[j].x * x1[j].x + x1[j].y * x1[j].y) + (x1[j].z * x1[j].z + x1[j].w * x1[j].w); }
                const float rstd2 = __builtin_amdgcn_rsqf(wave_sum(s2) * (1.f / DM) + RMS_EPS);
                GAS int* o4 = (GAS int*)((unsigned char*)XN + (size_t)m * DM) + lane;
#pragma unroll
                for (int j = 0; j < 4; ++j) { const int col = 4 * lane + 256 * j;
                    const f32x4 gg = *(const f32x4*)(gfp + col), sh = *(const f32x4*)(MOD + b * 6144 + 3072 + col), scl = *(const f32x4*)(MOD + b * 6144 + 4096 + col);
                    const f32x4 h = x1[j] * rstd2 * gg * (scl + 1.f) + sh;
                    int w = __builtin_amdgcn_cvt_pk_fp8_f32(h[0] * SC_H2, h[1] * SC_H2, 0, false); w = __builtin_amdgcn_cvt_pk_fp8_f32(h[2] * SC_H2, h[3] * SC_H2, w, true); o4[64 * j] = w;
                    hreg[rr][j] = h; }
            }
            const bool b5 = (lane & 32) != 0, b4 = (lane & 16) != 0, b3 = (lane & 8) != 0;
            float t0 = -3.0e38f, t1 = -3.0e38f, t2 = -3.0e38f, t3 = -3.0e38f; int i0 = 0, i1 = 0, i2 = 0, i3 = 0;
#pragma unroll 2
            for (int e = 0; e < NEXP; ++e) {
                f32x4 w[4];
#pragma unroll
                for (int j = 0; j < 4; ++j) w[j] = *(const LAS f32x4*)(wl + e * 1024 + 4 * lane + 256 * j);
                float p[8];
#pragma unroll
                for (int r = 0; r < 8; ++r) { f32x4 a = hreg[r][0] * w[0]; a += hreg[r][1] * w[1]; a += hreg[r][2] * w[2]; a += hreg[r][3] * w[3]; p[r] = (a.x + a.y) + (a.z + a.w); }
                float q[4], u[2];
#pragma unroll
                for (int i = 0; i < 4; ++i) { const auto r_ = __builtin_amdgcn_permlane32_swap(__float_as_uint(p[i]), __float_as_uint(p[i + 4]), false, false); q[i] = __uint_as_float(r_[0]) + __uint_as_float(r_[1]); }
#pragma unroll
                for (int i = 0; i < 2; ++i) { const auto r_ = __builtin_amdgcn_permlane16_swap(__float_as_uint(q[i]), __float_as_uint(q[i + 2]), false, false); u[i] = __uint_as_float(r_[0]) + __uint_as_float(r_[1]); }
                const float keep_ = b3 ? u[1] : u[0], send_ = b3 ? u[0] : u[1];
                float v = keep_ + __uint_as_float((unsigned)__builtin_amdgcn_update_dpp(0, (int)__float_as_uint(send_), 0x128  , 0xf, 0xf, false));
                v += __uint_as_float((unsigned)__builtin_amdgcn_update_dpp(0, (int)__float_as_uint(v), 0x141  , 0xf, 0xf, false));
                v += __uint_as_float((unsigned)__builtin_amdgcn_update_dpp(0, (int)__float_as_uint(v), 0x4E  , 0xf, 0xf, false));
                v += __uint_as_float((unsigned)__builtin_amdgcn_update_dpp(0, (int)__float_as_uint(v), 0xB1  , 0xf, 0xf, false));
                v += br[e];
                const bool c0 = v > t0, c1 = v > t1, c2 = v > t2, c3 = v > t3;
                t3 = c2 ? t2 : (c3 ? v : t3); i3 = c2 ? i2 : (c3 ? e : i3);
                t2 = c1 ? t1 : (c2 ? v : t2); i2 = c1 ? i1 : (c2 ? e : i2);
                t1 = c0 ? t0 : (c1 ? v : t1); i1 = c0 ? i0 : (c1 ? e : i1);
                t0 = c0 ? v : t0;             i0 = c0 ? e : i0;
            }
            {   const float e1 = __builtin_amdgcn_exp2f((t1 - t0) * LOG2E), e2 = __builtin_amdgcn_exp2f((t2 - t0) * LOG2E), e3 = __builtin_amdgcn_exp2f((t3 - t0) * LOG2E);
                const float inv = 1.f / (1.f + e1 + e2 + e3);
                const int lrow = wave * 8 + (b5 ? 4 : 0) + (b4 ? 2 : 0) + (b3 ? 1 : 0), t = lane & 7;
                if (t < 4) { const int ee = t == 0 ? i0 : t == 1 ? i1 : t == 2 ? i2 : i3;
                    const float gg = (t == 0 ? 1.f : t == 1 ? e1 : t == 2 ? e2 : e3) * inv;
                    const int rk = __hip_atomic_fetch_add(&lcnt[ee], 1, __ATOMIC_RELAXED, __HIP_MEMORY_SCOPE_WORKGROUP);
                    sel_e[lrow * 4 + t] = ee; sel_g[lrow * 4 + t] = gg; sel_r[lrow * 4 + t] = rk; } }
            __syncthreads();
            if (tid < 32) lbase[tid] = (int)atomicAdd(CNT + tid, (unsigned)lcnt[tid]);
            __syncthreads();
            if (tid < 256) { const int ee = sel_e[tid], pos = lbase[ee] + sel_r[tid], tok = blk * 64 + (tid >> 2);
                LIST[(size_t)ee * LISTCAP + pos] = (unsigned)tok; TOKPOS[(size_t)tok * 4 + (tid & 3)] = ((unsigned)ee << 16) | (unsigned)pos; TOKG[(size_t)tok * 4 + (tid & 3)] = sel_g[tid]; }
            __syncthreads();
        }
    }
    SEAM(7);
    if (IN(8) || IN(9)) {
        LAS int* blk_e = (LAS int*)(L + TAB_BLK); LAS int* eb0 = (LAS int*)(L + TAB_BLK + 1280); LAS int* ecnt = (LAS int*)(L + TAB_BLK + 1408);
        if (tid < 64) { const int c = (lane < NEXP) ? (int)__hip_atomic_load(CNT + lane, RLX_AGENT) : 0; const int n = (c + 255) >> 8; int incl = n;
#pragma unroll
            for (int o = 1; o < 64; o <<= 1) { const int t = __shfl_up(incl, o); if (lane >= o) incl += t; }
            const int start = incl - n;
            if (lane < NEXP) { eb0[lane] = start; ecnt[lane] = c; for (int i = 0; i < n; ++i) blk_e[start + i] = lane; }
            if (lane == 63) MISC[16] = (unsigned)incl; }
        __syncthreads();
        const int NB = (int)MISC[16];
        if (IN(8)) for (int rep_ = 0; rep_ < NREP(8); ++rep_) {
            for (int i = wave; i < 11; i += NWAVES) { const long Lu = (long)i * G + bx; if (Lu >= (long)NB * 8) break;
                const int grb = (int)(Lu >> 3), e = blk_e[grb], first = eb0[e], cnt = ecnt[e];
#pragma unroll
                for (int q = 0; q < 4; ++q) { const int r = q * 64 + lane, ri = (grb - first) * 256 + r; const unsigned tok = (ri < cnt) ? LIST[(size_t)e * LISTCAP + ri] : 0u;
                    *(LAS unsigned*)(L + TAB_GATH + i * 1024 + r * 4) = tok * 1024u; } }
            __syncthreads();
            pg8::SchedMoe<8, true> S{(const char*)XN, (const char*)W1T, (size_t)2048 * 1024, blk_e, NB, G, bx, TAB_GATH};
            pg8::EpiMoe1 E{args.in[I_B1], (unsigned char*)ACT};
            pg8::gemm_phase<pg8::EpiMoe1, pg8::SchedMoe<8, true>, true, true, true>(L, 8, 1024, 1024, S, E);
        }
        SEAM(8);
        if (IN(9)) for (int rep_ = 0; rep_ < NREP(9); ++rep_) {
            pg8::SchedMoe<4, false> S{(const char*)ACT, (const char*)W2T, (size_t)1024 * 1024, blk_e, NB, G, bx, 0};
            pg8::EpiMoe2 E{args.in[I_B2], (unsigned char*)YIT};
            pg8::gemm_phase<pg8::EpiMoe2, pg8::SchedMoe<4, false>, true, false, true>(L, 8, 1024, 1024, S, E);
        }
    }
    SEAM(9);
    if (IN(10)) {
        LAS int* rbase = (LAS int*)(L + 0);
        if (tid < 64) { const int c = (lane < NEXP) ? (int)__hip_atomic_load(CNT + lane, RLX_AGENT) : 0; const int n = (c + 255) >> 8; int incl = n;
#pragma unroll
            for (int o = 1; o < 64; o <<= 1) { const int t = __shfl_up(incl, o); if (lane >= o) incl += t; }
            if (lane < NEXP) rbase[lane] = (incl - n) * 256; }
        __syncthreads();
        const float* gfo = args.in[I_GFPOST];
        for (int m = gw; m < MTOK; m += NGW) { const int b = m >> 13;
            f32x4 y[4];
#pragma unroll
            for (int j = 0; j < 4; ++j) y[j] = (f32x4){0.f, 0.f, 0.f, 0.f};
#pragma unroll
            for (int t = 0; t < 4; ++t) { const unsigned tp = TOKPOS[(size_t)m * 4 + t]; const float gt = TOKG[(size_t)m * 4 + t];
                const size_t row = (size_t)rbase[tp >> 16] + (tp & 0xffffu); const GAS unsigned* yr = (const GAS unsigned*)((const unsigned char*)YIT + row * 1024) + lane; const float gs = gt * (1.f / SC_Y);
#pragma unroll
                for (int j = 0; j < 4; ++j) { const unsigned w = yr[64 * j]; const f32x2 lo = __builtin_amdgcn_cvt_pk_f32_fp8((int)w, false), hi2 = __builtin_amdgcn_cvt_pk_f32_fp8((int)w, true);
                    y[j][0] += gs * lo[0]; y[j][1] += gs * lo[1]; y[j][2] += gs * hi2[0]; y[j][3] += gs * hi2[1]; } }
            float s = 0.f;
#pragma unroll
            for (int j = 0; j < 4; ++j) s += (y[j].x * y[j].x + y[j].y * y[j].y) + (y[j].z * y[j].z + y[j].w * y[j].w);
            const float rstd = __builtin_amdgcn_rsqf(wave_sum(s) * (1.f / DM) + RMS_EPS);
            GAS f32x4* orow = (GAS f32x4*)(OUT + (size_t)m * DM) + lane; const GAS u32x2* xrow = (const GAS u32x2*)(X1B + (size_t)m * DM) + lane;
#pragma unroll
            for (int j = 0; j < 4; ++j) { const int col = 4 * lane + 256 * j;
                const f32x4 gg = *(const f32x4*)(gfo + col), gf = *(const f32x4*)(MOD + b * 6144 + 5120 + col);
                const u32x2 xw = xrow[64 * j]; const f32x4 x1 = {bf16_lo(xw.x), bf16_hi(xw.x), bf16_lo(xw.y), bf16_hi(xw.y)};
                orow[64 * j] = x1 + gf * (y[j] * rstd * gg); } }
    }
#undef IN
#undef SEAM
#undef args
}

constexpr int N_PHASES = 11;
extern "C" void kernel_launch(void* const* d_in, const int* in_sizes, int n_in, void* d_out, int out_size, void* d_ws, size_t ws_size, hipStream_t stream) {
    static int grid = 0;
    if (grid == 0) {
        if (n_in != 24 || out_size != MTOK * DM || ws_size < WS_END) { fprintf(stderr, "kernel_launch: unexpected shapes (n_in %d out %d ws %zu)\n", n_in, out_size, ws_size); grid = -1; return; }
        int dev = 0, cus = 0, per_cu = 0;
        if (hipGetDevice(&dev) != hipSuccess || hipDeviceGetAttribute(&cus, hipDeviceAttributeMultiprocessorCount, dev) != hipSuccess) { grid = -1; return; }
        if (hipFuncSetAttribute((const void*)fwd_kernel, hipFuncAttributeMaxDynamicSharedMemorySize, LDS_BYTES) != hipSuccess) { fprintf(stderr, "kernel_launch: hipFuncSetAttribute failed\n"); grid = -1; return; }
        if (hipOccupancyMaxActiveBlocksPerMultiprocessor(&per_cu, (const void*)fwd_kernel, NWAVES * 64, LDS_BYTES) != hipSuccess || per_cu < 1) { fprintf(stderr, "kernel_launch: occupancy query says %d\n", per_cu); per_cu = 1; }
        (void)hipGetLastError();
        grid = cus;
    }
    if (grid < 0) return;
    (void)hipMemsetAsync((char*)d_ws + WS_CTL + 16384, 0, 32768, stream);
    Args a{};
    for (int i = 0; i < 24; ++i) a.in[i] = (const float*)d_in[i];
    a.out = (float*)d_out; a.ws = (unsigned char*)d_ws;
#if MK_N_LAUNCHES == 1
    a.ph_lo = 0; a.ph_hi = N_PHASES;
    {   void* kargs[] = {(void*)&a};
        const hipError_t ce = hipLaunchCooperativeKernel((const void*)fwd_kernel, dim3(grid), dim3(NWAVES * 64), kargs, LDS_BYTES, stream);
        if (ce != hipSuccess) fprintf(stderr, "kernel_launch: cooperative launch failed: %s (grid %d)\n", hipGetErrorName(ce), grid); }
#else
    for (int p = 0; p < N_PHASES; ++p) { a.ph_lo = p; a.ph_hi = p + 1; hipLaunchKernelGGL(fwd_kernel, dim3(grid), dim3(NWAVES * 64), LDS_BYTES, stream, a); }
#endif
    const hipError_t le = hipPeekAtLastError();
    if (le != hipSuccess) fprintf(stderr, "kernel_launch: launch failed: %s\n", hipGetErrorName(le));
}
```

```cpp
#include <hip/hip_runtime.h>
#include <hip/hip_bf16.h>
#include <cstdio>
#include <cstdint>

#ifndef MK_N_LAUNCHES
#define MK_N_LAUNCHES 1
#endif

constexpr int BATCH = 2, SEQ = 8192, DM = 1024, MTOK = BATCH * SEQ;
constexpr int NPROJ = 4352;
constexpr int NEXP = 32, DFF = 1024, TOPK = 4;
constexpr int QLORA = 384, KVLORA = 256;
constexpr float RMS_EPS = 1e-6f;
constexpr float LOG2E = 1.4426950408889634f;
constexpr float C2NA = 0.125f * LOG2E;
constexpr float C2MLA = 0.10206207261596575f * LOG2E;
constexpr float SC_H2 = 8.f, SC_W = 64.f, SC_ACT = 4.f, SC_Y = 32.f;
constexpr int NG_INPROJ = 168;
constexpr int LISTCAP = 16384;
constexpr int MAXROWS = 65536 + NEXP * 256;

#define GAS __attribute__((address_space(1)))
#define LAS __attribute__((address_space(3)))
typedef unsigned short bf16_t;
typedef short bf16x8 __attribute__((ext_vector_type(8)));
typedef short s16x4 __attribute__((ext_vector_type(4)));
typedef float f32x4 __attribute__((ext_vector_type(4)));
typedef float f32x2 __attribute__((ext_vector_type(2)));
typedef float f32x16 __attribute__((ext_vector_type(16)));
typedef unsigned u32x4 __attribute__((ext_vector_type(4)));
typedef unsigned u32x2 __attribute__((ext_vector_type(2)));
typedef GAS unsigned gu32;

__device__ __forceinline__ unsigned cvt_pk_bf16(float lo, float hi) { unsigned r; asm volatile("v_cvt_pk_bf16_f32 %0, %1, %2" : "=v"(r) : "v"(lo), "v"(hi)); return r; }
__device__ __forceinline__ float bf16_lo(unsigned w) { return __uint_as_float(w << 16); }
__device__ __forceinline__ float bf16_hi(unsigned w) { return __uint_as_float(w & 0xffff0000u); }
__device__ __forceinline__ float sigmoidf_(float z) { return __builtin_amdgcn_rcpf(1.f + __builtin_amdgcn_exp2f(-z * LOG2E)); }
__device__ __forceinline__ float wave_sum(float v) {
#pragma unroll
    for (int o = 1; o < 64; o <<= 1) v += __shfl_xor(v, o);
    return v;
}
__device__ __forceinline__ void rope_cs(float pos, int j, float& c, float& s) {
    const float inv = __builtin_amdgcn_exp2f(-(float)j * 0.83048202372184059f);
    const float rev = __builtin_amdgcn_fractf(pos * inv * 0.15915494309189535f);
    c = __builtin_amdgcn_cosf(rev); s = __builtin_amdgcn_sinf(rev);
}

namespace pg8 {
constexpr int BM = 256, BK = 64, HALF = 128, HTB = HALF * BK * 2, STAGE_BYTES = 8 * HTB, NXCD = 8, WGM = 8;
__host__ __device__ __forceinline__ int lds_byte(int r, int c) { const int st = (r >> 4) * 2 + (c >> 5), rr = r & 15, cc = c & 31, ob = rr * 64 + cc * 2; return st * 1024 + (ob ^ (((ob >> 9) & 1) << 5)); }
__host__ __device__ __forceinline__ void stage_rc(int b, int& R, int& C) { const int st = b / 1024, sb = b % 1024, swz = sb ^ (((sb >> 9) & 1) << 5); R = (st >> 1) * 16 + swz / 64; C = (st & 1) * 32 + (swz % 64) / 2; }
__host__ __device__ __forceinline__ int perm32(int rho) { const int n = rho >> 4, i = rho & 15; return 8 * (i >> 2) + 4 * n + (i & 3); }

struct Unit { const char* A; const char* B; const char* A2; const char* B2; int pm, pn, aux, tab; };

__device__ __forceinline__ void tile_of(int wgid, int nM, int nN, int& pm, int& pn) {
    const int nwg = nM * nN;
    { const int q = nwg / NXCD, r = nwg % NXCD, xcd = wgid % NXCD, off = wgid / NXCD; wgid = (xcd < r ? xcd * (q + 1) : r * (q + 1) + (xcd - r) * q) + off; }
    const int nig = WGM * nN, gid = wgid / nig, fm = gid * WGM, gsz = (nM - fm) < WGM ? (nM - fm) : WGM;
    pm = fm + ((wgid % nig) % gsz); pn = (wgid % nig) / gsz;
}

typedef int v8i32 __attribute__((ext_vector_type(8)));
typedef int v4i32_ __attribute__((ext_vector_type(4)));
template <class Epi, class Sched, bool ALIGN_EPI, bool GATHER, bool FP8, bool DUAL = false>
__device__ __forceinline__ void gemm_phase(LAS unsigned char* lds, const int nt, const int ldab, const int ldbb, const Sched& S, const Epi& E) {
    const int tid = threadIdx.x, wid = __builtin_amdgcn_readfirstlane(tid >> 6), lane = tid & 63, wr = wid >> 2, wc = wid & 3, fr = lane & 15, fq = lane >> 4;
    int Rr[2], Cc[2];
    unsigned voffA[2], voffB[2];
#pragma unroll
    for (int i = 0; i < 2; ++i) { int R, C; stage_rc(tid * 16 + i * 8192, R, C); const int Rb = Epi::PERM ? ((R & ~31) + perm32(R & 31)) : R;
        Rr[i] = R; Cc[i] = C; voffA[i] = (unsigned)(R * ldab + C * 2); voffB[i] = (unsigned)(Rb * ldbb + C * 2); }
    const size_t kstep = (size_t)(BK * 2);
    const size_t hstepA = (size_t)HALF * ldab, hstepB = (size_t)HALF * ldbb;
    const unsigned ldsw = (unsigned)wid * 1024u;
    const int aoff = lds_byte(wr * 64 + fr, fq * 8), boff = lds_byte(wc * 32 + fr, fq * 8);
#define PG8_SA(b, h) (((b) * 2 + (h)) * HTB)
#define PG8_SB(b, h) ((4 + (b) * 2 + (h)) * HTB)
#define PG8_STAGE(bufoff, gbase, voff) do { _Pragma("unroll") for (int _i = 0; _i < 2; ++_i) \
        __builtin_amdgcn_global_load_lds((const unsigned*)((const char*)(gbase) + (voff)[_i]), (LAS unsigned*)(lds + (bufoff) + ldsw + _i * 8192), 16, 0, 0); } while (0)
#define PG8_STAGE_A(bufoff, gbase, h, G) do { if constexpr (GATHER) { PG8_STAGE(bufoff, gbase, (G)[h]); } else { PG8_STAGE(bufoff, (gbase) + (h) * hstepA, voffA); } } while (0)
#define PG8_STAGE_B(bufoff, gbase, h) PG8_STAGE(bufoff, (gbase) + (h) * hstepB, voffB)
#define PG8_LD8(addr) __builtin_shufflevector(*(const LAS v4i32_*)(addr), *(const LAS v4i32_*)((addr) + 1024), 0, 1, 2, 3, 4, 5, 6, 7)
#define PG8_LDA(dst, b, h) do { if constexpr (FP8) { _Pragma("unroll") for (int m = 0; m < 4; ++m) dst##8[m] = PG8_LD8(lds + PG8_SA(b, h) + aoff + m * 2048); } \
        else { _Pragma("unroll") for (int m = 0; m < 4; ++m) _Pragma("unroll") for (int k = 0; k < 2; ++k) dst[m][k] = *(const LAS bf16x8*)(lds + PG8_SA(b, h) + aoff + m * 2048 + k * 1024); } } while (0)
#define PG8_LDB(dst, b, h) do { if constexpr (FP8) { _Pragma("unroll") for (int n = 0; n < 2; ++n) dst##8[n] = PG8_LD8(lds + PG8_SB(b, h) + boff + n * 2048); } \
        else { _Pragma("unroll") for (int n = 0; n < 2; ++n) _Pragma("unroll") for (int k = 0; k < 2; ++k) dst[n][k] = *(const LAS bf16x8*)(lds + PG8_SB(b, h) + boff + n * 2048 + k * 1024); } } while (0)
#define PG8_MMA(ai, bj, At, Bt) do { __builtin_amdgcn_s_setprio(1); _Pragma("unroll") for (int m = 0; m < 4; ++m) _Pragma("unroll") for (int n = 0; n < 2; ++n) { \
        if constexpr (FP8) { asm volatile("v_mfma_scale_f32_16x16x128_f8f6f4 %0, %1, %2, %0, %3, %3 op_sel_hi:[0,0,0]" : "+v"(acc[ai][bj][m][n]) : "v"(Bt##8[n]), "v"(At##8[m]), "v"(sc1_)); } \
        else { _Pragma("unroll") for (int k = 0; k < 2; ++k) acc[ai][bj][m][n] = __builtin_amdgcn_mfma_f32_16x16x32_bf16(Bt[n][k], At[m][k], acc[ai][bj][m][n], 0, 0, 0); } } \
        __builtin_amdgcn_s_setprio(0); } while (0)
#define PG8_WAIT_V(n) asm volatile("s_waitcnt vmcnt(" #n ")" ::: "memory")
#define PG8_WAIT_L(n) asm volatile("s_waitcnt lgkmcnt(" #n ")" ::: "memory")
#define PG8_BAR __builtin_amdgcn_s_barrier()
#define PG8_SCHED __builtin_amdgcn_sched_barrier(0)
    Unit cur, nxt; int ui = 0;
    if (!S.next(0, cur)) return;
    f32x4 acc[2][2][4][2];
#pragma unroll
    for (int a = 0; a < 2; ++a)
#pragma unroll
        for (int b = 0; b < 2; ++b)
#pragma unroll
            for (int m = 0; m < 4; ++m)
#pragma unroll
                for (int n = 0; n < 2; ++n) acc[a][b][m][n] = (f32x4){0.f, 0.f, 0.f, 0.f};
    bf16x8 At[4][2], B0[2][2], B1[2][2]; v8i32 At8[4], B08[2], B18[2];
    int sc1_ = 0x7F7F7F7F; asm volatile("" : "+v"(sc1_));
    unsigned gC[2][2], gN[2][2];
#define PG8_GLOAD(G, u) do { if constexpr (GATHER) { const LAS unsigned* tb_ = (const LAS unsigned*)(lds + (u).tab); _Pragma("unroll") for (int h_ = 0; h_ < 2; ++h_) _Pragma("unroll") for (int i_ = 0; i_ < 2; ++i_) \
        (G)[h_][i_] = tb_[h_ * 128 + Rr[i_]] + (unsigned)(Cc[i_] * 2); } } while (0)
    PG8_GLOAD(gC, cur);
    const char* cA = cur.A; const char* cB = cur.B; const char* cA2 = cur.A2; const char* cB2 = cur.B2; const int nth = nt >> 1;
    PG8_STAGE_B(PG8_SB(0, 0), cB, 0); PG8_STAGE_B(PG8_SB(0, 1), cB, 1); PG8_STAGE_A(PG8_SA(0, 0), cA, 0, gC); PG8_STAGE_A(PG8_SA(0, 1), cA, 1, gC);
    if (wr == 1) PG8_BAR;
    PG8_WAIT_V(2); PG8_BAR;
    PG8_STAGE_B(PG8_SB(1, 0), cB + kstep, 0); PG8_STAGE_A(PG8_SA(1, 0), cA + kstep, 0, gC); PG8_STAGE_B(PG8_SB(1, 1), cB + kstep, 1);
    PG8_WAIT_V(6); PG8_BAR;
    for (;;) {
        const bool has_next = S.next(ui + 1, nxt);
        const char* nA = has_next ? nxt.A : cA; const char* nB = has_next ? nxt.B : cB;
        if constexpr (GATHER) { if (has_next) { PG8_GLOAD(gN, nxt); } else {
#pragma unroll
            for (int h_ = 0; h_ < 2; ++h_)
#pragma unroll
                for (int i_ = 0; i_ < 2; ++i_) gN[h_][i_] = gC[h_][i_]; } }
#pragma unroll 1
        for (int t = 0; t < nt; t += 2) {
            const bool last = (t == nt - 2);
            if constexpr (DUAL) { if (t == nth) { if (wr == 0) PG8_BAR; E.mid(acc, cur, wr, wc, fr, fq); if (wr == 1) PG8_BAR; } }
#define PG8_TILEA(tt) (((DUAL && (tt) >= nth) ? cA2 - (size_t)nth * kstep : cA) + (size_t)(tt) * kstep)
#define PG8_TILEB(tt) (((DUAL && (tt) >= nth) ? cB2 - (size_t)nth * kstep : cB) + (size_t)(tt) * kstep)
            const char* a1 = PG8_TILEA(t + 1);
            const char* a2 = last ? nA : PG8_TILEA(t + 2); const char* b2 = last ? nB : PG8_TILEB(t + 2);
            const char* a3 = a2 + kstep; const char* b3 = b2 + kstep;
            unsigned g2[2][2];
            if constexpr (GATHER) {
#pragma unroll
                for (int h_ = 0; h_ < 2; ++h_)
#pragma unroll
                    for (int i_ = 0; i_ < 2; ++i_) g2[h_][i_] = last ? gN[h_][i_] : gC[h_][i_]; }
            PG8_LDB(B0, 0, 0); PG8_LDB(B1, 0, 1); PG8_SCHED; PG8_LDA(At, 0, 0); PG8_STAGE_A(PG8_SA(1, 1), a1, 1, gC);
            PG8_WAIT_V(8); PG8_WAIT_L(0); PG8_BAR; PG8_MMA(0, 0, At, B0); PG8_MMA(0, 1, At, B1); PG8_BAR; PG8_SCHED;
            PG8_LDA(At, 0, 1); PG8_STAGE_B(PG8_SB(0, 0), b2, 0); PG8_STAGE_B(PG8_SB(0, 1), b2, 1); PG8_STAGE_A(PG8_SA(0, 0), a2, 0, g2);
            PG8_WAIT_V(8); PG8_WAIT_L(0); PG8_BAR; PG8_MMA(1, 0, At, B0); PG8_MMA(1, 1, At, B1); PG8_BAR; PG8_SCHED;
            PG8_LDB(B0, 1, 0); PG8_LDB(B1, 1, 1); PG8_SCHED; PG8_LDA(At, 1, 0); PG8_STAGE_A(PG8_SA(0, 1), a2, 1, g2);
            PG8_WAIT_V(8); PG8_WAIT_L(0); PG8_BAR; PG8_MMA(0, 0, At, B0); PG8_MMA(0, 1, At, B1); PG8_BAR; PG8_SCHED;
            PG8_LDA(At, 1, 1); PG8_STAGE_B(PG8_SB(1, 0), b3, 0); PG8_STAGE_B(PG8_SB(1, 1), b3, 1); PG8_STAGE_A(PG8_SA(1, 0), a3, 0, g2);
            PG8_WAIT_V(8); PG8_WAIT_L(0); PG8_BAR; PG8_MMA(1, 0, At, B0); PG8_MMA(1, 1, At, B1); PG8_BAR; PG8_SCHED;
        }
        if constexpr (ALIGN_EPI) { if (wr == 0) PG8_BAR; }
        if constexpr (FP8) asm volatile("s_nop 15\n\ts_nop 15" ::: "memory");
        E(acc, cur, wr, wc, fr, fq);
        if (!has_next) break;
#pragma unroll
        for (int a = 0; a < 2; ++a)
#pragma unroll
            for (int b = 0; b < 2; ++b)
#pragma unroll
                for (int m = 0; m < 4; ++m)
#pragma unroll
                    for (int n = 0; n < 2; ++n) acc[a][b][m][n] = (f32x4){0.f, 0.f, 0.f, 0.f};
        cur = nxt; cA = nA; cB = nB; cA2 = cur.A2; cB2 = cur.B2; ++ui;
        if constexpr (GATHER) {
#pragma unroll
            for (int h_ = 0; h_ < 2; ++h_)
#pragma unroll
                for (int i_ = 0; i_ < 2; ++i_) gC[h_][i_] = gN[h_][i_]; }
        if constexpr (ALIGN_EPI) { if (wr == 1) PG8_BAR; }
    }
    PG8_WAIT_V(0);
    if constexpr (!ALIGN_EPI) { if (wr == 0) PG8_BAR; }
    PG8_BAR;
#undef PG8_SA
#undef PG8_SB
#undef PG8_STAGE
#undef PG8_STAGE_A
#undef PG8_STAGE_B
#undef PG8_LDA
#undef PG8_LD8
#undef PG8_LDB
#undef PG8_MMA
#undef PG8_WAIT_V
#undef PG8_WAIT_L
#undef PG8_BAR
#undef PG8_SCHED
#undef PG8_GLOAD
#undef PG8_TILEA
#undef PG8_TILEB
}

typedef f32x4 Acc[2][2][4][2];

struct SchedDense {
    const char* A; const char* B; size_t a_tile_bytes, b_tile_bytes; int nM, nN, G, c;
    __device__ __forceinline__ bool next(int i, Unit& u) const {
        const long L = (long)i * G + c; if (L >= (long)nM * nN) return false;
        int pm, pn; tile_of((int)L, nM, nN, pm, pn);
        u.pm = pm; u.pn = pn; u.aux = 0; u.tab = 0; u.A = A + (size_t)pm * a_tile_bytes; u.B = B + (size_t)pn * b_tile_bytes; u.A2 = u.A; u.B2 = u.B; return true;
    }
};
struct SchedMerge {
    const char* A0; const char* A1; const char* B0; const char* B1; int nM, nN, G, c;
    __device__ __forceinline__ bool next(int i, Unit& u) const {
        const long T = (long)i * G + c; if (T >= (long)nM * nN) return false;
        int pm, pn; tile_of((int)T, nM, nN, pm, pn);
        u.pm = pm; u.pn = pn; u.aux = 0; u.tab = 0;
        u.A = A0 + (size_t)pm * (256 * 512 * 2); u.B = B0 + (size_t)pn * (256 * 512 * 2); u.A2 = A1 + (size_t)pm * (256 * 512 * 2); u.B2 = B1 + (size_t)pn * (256 * 512 * 2); return true;
    }
};
template <int NPN, bool GATHER>
struct SchedMoe {
    const char* A; const char* B; size_t b_expert_bytes; LAS const int* blk_e; int NB, G, c, tab0;
    __device__ __forceinline__ bool next(int i, Unit& u) const {
        const long L = (long)i * G + c; if (L >= (long)NB * NPN) return false;
        const int grb = (int)(L / NPN), pn = (int)(L % NPN);
        const int e = __builtin_amdgcn_readfirstlane(blk_e[grb]);
        u.pm = grb; u.pn = pn; u.aux = e; u.tab = tab0 + i * 1024;
        u.A = GATHER ? A : A + (size_t)grb * (256 * 1024);
        u.B = B + (size_t)e * b_expert_bytes + (size_t)pn * (256 * 1024); u.A2 = u.A; u.B2 = u.B; return true;
    }
};

struct EpiInProj {
    static constexpr bool PERM = true;
    bf16_t* PROJ; float* SSQ; bf16_t* KR; const float* ROPE; const float* bgate;
    __device__ __forceinline__ void operator()(const Acc& acc, const Unit& u, int wr, int wc, int fr, int fq) const {
        const int pn = u.pn, row0 = u.pm * BM + wr * 64 + fr, colb = pn * BM + wc * 32 + 8 * fq;
        const float sc = (pn < 2) ? C2NA : 1.f;
        f32x4 gb[2][2];
#pragma unroll
        for (int bj = 0; bj < 2; ++bj)
#pragma unroll
            for (int n = 0; n < 2; ++n) gb[bj][n] = (pn >= 9) ? *(const f32x4*)(bgate + (colb - 2304) + bj * HALF + 4 * n) : (f32x4){0.f, 0.f, 0.f, 0.f};
#pragma unroll
        for (int ai = 0; ai < 2; ++ai)
#pragma unroll
            for (int m = 0; m < 4; ++m) { const int row = row0 + ai * HALF + m * 16; bf16_t* rowp = PROJ + (size_t)row * NPROJ + colb;
#pragma unroll
                for (int bj = 0; bj < 2; ++bj) { const f32x4 v0 = acc[ai][bj][m][0] * sc + gb[bj][0], v1 = acc[ai][bj][m][1] * sc + gb[bj][1]; u32x4 w;
                    w.x = cvt_pk_bf16(v0[0], v0[1]); w.y = cvt_pk_bf16(v0[2], v0[3]); w.z = cvt_pk_bf16(v1[0], v1[1]); w.w = cvt_pk_bf16(v1[2], v1[3]);
                    *(u32x4*)(rowp + bj * HALF) = w; } }
        if (pn >= 6 && pn <= 8) {
#pragma unroll
            for (int ai = 0; ai < 2; ++ai)
#pragma unroll
                for (int m = 0; m < 4; ++m) { const int row = row0 + ai * HALF + m * 16; float s[2];
#pragma unroll
                    for (int bj = 0; bj < 2; ++bj) { const f32x4 a = acc[ai][bj][m][0], b = acc[ai][bj][m][1];
                        float t = (a[0] * a[0] + a[1] * a[1]) + (a[2] * a[2] + a[3] * a[3]) + (b[0] * b[0] + b[1] * b[1]) + (b[2] * b[2] + b[3] * b[3]);
                        t += __shfl_xor(t, 16); t += __shfl_xor(t, 32); s[bj] = t; }
                    if (fq == 0) {
                        float* sp = SSQ + (size_t)row * 16 + wc;
                        if (pn == 6) { sp[0] = s[0] + s[1]; }
                        else if (pn == 7) { sp[4] = s[0]; sp[8] = s[1]; }
                        else { sp[12] = s[0]; }
                    } }
            if (pn == 8 && wc == 0) {
#pragma unroll
                for (int ai = 0; ai < 2; ++ai)
#pragma unroll
                    for (int m = 0; m < 4; ++m) { const int row = row0 + ai * HALF + m * 16, tok = row & (SEQ - 1);
                        const int pos = (fq >> 1) ? (tok & 63) : (tok >> 6); float o[8];
                        const f32x4 cs4 = *(const f32x4*)(ROPE + pos * 16 + 4 * (fq & 1)), sn4 = *(const f32x4*)(ROPE + pos * 16 + 8 + 4 * (fq & 1));
#pragma unroll
                        for (int n = 0; n < 2; ++n)
#pragma unroll
                            for (int q = 0; q < 2; ++q) { const float c = cs4[2 * n + q], s = sn4[2 * n + q];
                                const float x1 = acc[ai][1][m][n][2 * q], x2 = acc[ai][1][m][n][2 * q + 1];
                                o[4 * n + 2 * q] = x1 * c - x2 * s; o[4 * n + 2 * q + 1] = x1 * s + x2 * c; }
                        u32x4 w; w.x = cvt_pk_bf16(o[0], o[1]); w.y = cvt_pk_bf16(o[2], o[3]); w.z = cvt_pk_bf16(o[4], o[5]); w.w = cvt_pk_bf16(o[6], o[7]);
                        *(u32x4*)(KR + (size_t)row * 32 + 8 * fq) = w; }
            }
        }
    }
};
struct EpiQUp {
    static constexpr bool PERM = true;
    bf16_t* QN; bf16_t* QR; const float* SSQ; const float* ROPE;
    __device__ __forceinline__ void operator()(const Acc& acc, const Unit& u, int wr, int wc, int fr, int fq) const {
        const int pn = u.pn, row0 = u.pm * BM + wr * 64 + fr, colt = wc * 32 + 8 * fq;
#pragma unroll
        for (int ai = 0; ai < 2; ++ai)
#pragma unroll
            for (int m = 0; m < 4; ++m) { const int row = row0 + ai * HALF + m * 16;
                const f32x4 q0_ = *(const f32x4*)(SSQ + (size_t)row * 16), q1_ = *(const f32x4*)(SSQ + (size_t)row * 16 + 4);
                const float rs = __builtin_amdgcn_rsqf((((q0_[0] + q0_[1]) + (q0_[2] + q0_[3])) + ((q1_[0] + q1_[1]) + (q1_[2] + q1_[3]))) * (1.f / QLORA) + RMS_EPS) * C2MLA;
                if (pn < 2) {
#pragma unroll
                    for (int bj = 0; bj < 2; ++bj) { const f32x4 v0 = acc[ai][bj][m][0] * rs, v1 = acc[ai][bj][m][1] * rs; u32x4 w;
                        w.x = cvt_pk_bf16(v0[0], v0[1]); w.y = cvt_pk_bf16(v0[2], v0[3]); w.z = cvt_pk_bf16(v1[0], v1[1]); w.w = cvt_pk_bf16(v1[2], v1[3]);
                        *(u32x4*)(QN + (size_t)row * 512 + pn * 256 + bj * HALF + colt) = w; }
                } else {
                    const int tok = row & (SEQ - 1); const int pos = (fq >> 1) ? (tok & 63) : (tok >> 6);
                    const f32x4 cs4 = *(const f32x4*)(ROPE + pos * 16 + 4 * (fq & 1)), sn4 = *(const f32x4*)(ROPE + pos * 16 + 8 + 4 * (fq & 1));
#pragma unroll
                    for (int bj = 0; bj < 2; ++bj) { float o[8];
#pragma unroll
                        for (int n = 0; n < 2; ++n)
#pragma unroll
                            for (int q = 0; q < 2; ++q) { const float c = cs4[2 * n + q], s = sn4[2 * n + q];
                                const float x1 = acc[ai][bj][m][n][2 * q] * rs, x2 = acc[ai][bj][m][n][2 * q + 1] * rs;
                                o[4 * n + 2 * q] = x1 * c - x2 * s; o[4 * n + 2 * q + 1] = x1 * s + x2 * c; }
                        u32x4 w; w.x = cvt_pk_bf16(o[0], o[1]); w.y = cvt_pk_bf16(o[2], o[3]); w.z = cvt_pk_bf16(o[4], o[5]); w.w = cvt_pk_bf16(o[6], o[7]);
                        *(u32x4*)(QR + (size_t)row * 256 + bj * HALF + colt) = w; }
                }
                asm volatile("" ::: "memory"); }
    }
};
struct EpiKVUp {
    static constexpr bool PERM = true;
    bf16_t* KN; bf16_t* VM; const float* SSQ;
    __device__ __forceinline__ void operator()(const Acc& acc, const Unit& u, int wr, int wc, int fr, int fq) const {
        const int pn = u.pn, row0 = u.pm * BM + wr * 64 + fr, colt = wc * 32 + 8 * fq;
        bf16_t* dst = (pn < 2) ? KN + pn * 256 : VM + (pn - 2) * 256;
#pragma unroll
        for (int ai = 0; ai < 2; ++ai)
#pragma unroll
            for (int m = 0; m < 4; ++m) { const int row = row0 + ai * HALF + m * 16;
                const f32x4 q0_ = *(const f32x4*)(SSQ + (size_t)row * 16 + 8), q1_ = *(const f32x4*)(SSQ + (size_t)row * 16 + 12);
                const float rs = __builtin_amdgcn_rsqf((((q0_[0] + q0_[1]) + (q0_[2] + q0_[3])) + ((q1_[0] + q1_[1]) + (q1_[2] + q1_[3]))) * (1.f / KVLORA) + RMS_EPS);
#pragma unroll
                for (int bj = 0; bj < 2; ++bj) { const f32x4 v0 = acc[ai][bj][m][0] * rs, v1 = acc[ai][bj][m][1] * rs; u32x4 w;
                    w.x = cvt_pk_bf16(v0[0], v0[1]); w.y = cvt_pk_bf16(v0[2], v0[3]); w.z = cvt_pk_bf16(v1[0], v1[1]); w.w = cvt_pk_bf16(v1[2], v1[3]);
                    *(u32x4*)(dst + (size_t)row * 512 + bj * HALF + colt) = w; } }
    }
};
struct EpiMerge {
    static constexpr bool PERM = true;
    const bf16_t* PROJ; bf16_t* MERGED;
    __device__ __forceinline__ void mid(Acc& acc, const Unit& u, int wr, int wc, int fr, int fq) const {
        int row0 = u.pm * BM + wr * 64 + fr; const int col0 = u.pn * BM + wc * 32 + 8 * fq;
        asm volatile("" : "+v"(row0));
#pragma unroll
        for (int ai = 0; ai < 2; ++ai)
#pragma unroll
            for (int m = 0; m < 4; ++m) { const bf16_t* rp = PROJ + (size_t)(row0 + ai * HALF + m * 16) * NPROJ + 2304 + col0;
#pragma unroll
                for (int bj = 0; bj < 2; ++bj) { const u32x4 g1 = *(const u32x4*)(rp + bj * HALF), g2 = *(const u32x4*)(rp + 1024 + bj * HALF);
                    const unsigned w1[4] = {g1.x, g1.y, g1.z, g1.w}, w2[4] = {g2.x, g2.y, g2.z, g2.w};
#pragma unroll
                    for (int q = 0; q < 4; ++q) { const int n = q >> 1, i = (q & 1) * 2;
                        const float r0 = (1.f + __builtin_amdgcn_exp2f(-bf16_lo(w2[q]) * LOG2E)) * __builtin_amdgcn_rcpf(1.f + __builtin_amdgcn_exp2f(-bf16_lo(w1[q]) * LOG2E));
                        const float r1 = (1.f + __builtin_amdgcn_exp2f(-bf16_hi(w2[q]) * LOG2E)) * __builtin_amdgcn_rcpf(1.f + __builtin_amdgcn_exp2f(-bf16_hi(w1[q]) * LOG2E));
                        acc[ai][bj][m][n][i] *= r0; acc[ai][bj][m][n][i + 1] *= r1; } }
                asm volatile("" ::: "memory"); }
    }
    __device__ __forceinline__ void operator()(const Acc& acc, const Unit& u, int wr, int wc, int fr, int fq) const {
        const int row0 = u.pm * BM + wr * 64 + fr, col0 = u.pn * BM + wc * 32 + 8 * fq;
#pragma unroll
        for (int ai = 0; ai < 2; ++ai)
#pragma unroll
            for (int m = 0; m < 4; ++m) { const int row = row0 + ai * HALF + m * 16; const bf16_t* rp = PROJ + (size_t)row * NPROJ + 3328 + col0;
#pragma unroll
                for (int bj = 0; bj < 2; ++bj) { const u32x4 g2 = *(const u32x4*)(rp + bj * HALF);
                    f32x4 s0, s1;
                    s0[0] = sigmoidf_(bf16_lo(g2.x)); s0[1] = sigmoidf_(bf16_hi(g2.x)); s0[2] = sigmoidf_(bf16_lo(g2.y)); s0[3] = sigmoidf_(bf16_hi(g2.y));
                    s1[0] = sigmoidf_(bf16_lo(g2.z)); s1[1] = sigmoidf_(bf16_hi(g2.z)); s1[2] = sigmoidf_(bf16_lo(g2.w)); s1[3] = sigmoidf_(bf16_hi(g2.w));
                    const f32x4 v0 = acc[ai][bj][m][0] * s0, v1 = acc[ai][bj][m][1] * s1; u32x4 w;
                    w.x = cvt_pk_bf16(v0[0], v0[1]); w.y = cvt_pk_bf16(v0[2], v0[3]); w.z = cvt_pk_bf16(v1[0], v1[1]); w.w = cvt_pk_bf16(v1[2], v1[3]);
                    *(u32x4*)(MERGED + (size_t)row * 1024 + col0 + bj * HALF) = w; }
                asm volatile("" ::: "memory"); }
    }
};
struct EpiBf16Y {
    static constexpr bool PERM = true;
    bf16_t* C;
    __device__ __forceinline__ void operator()(const Acc& acc, const Unit& u, int wr, int wc, int fr, int fq) const {
        const int row0 = u.pm * BM + wr * 64 + fr, col0 = u.pn * BM + wc * 32 + 8 * fq;
#pragma unroll
        for (int ai = 0; ai < 2; ++ai)
#pragma unroll
            for (int m = 0; m < 4; ++m) { bf16_t* rowp = C + (size_t)(row0 + ai * HALF + m * 16) * 1024 + col0;
#pragma unroll
                for (int bj = 0; bj < 2; ++bj) { const f32x4 v0 = acc[ai][bj][m][0], v1 = acc[ai][bj][m][1]; u32x4 w;
                    w.x = cvt_pk_bf16(v0[0], v0[1]); w.y = cvt_pk_bf16(v0[2], v0[3]); w.z = cvt_pk_bf16(v1[0], v1[1]); w.w = cvt_pk_bf16(v1[2], v1[3]);
                    *(u32x4*)(rowp + bj * HALF) = w; } }
    }
};
struct EpiMoe1 {
    static constexpr bool PERM = true;
    const float* b1; unsigned char* ACT;
    __device__ __forceinline__ void operator()(const Acc& acc, const Unit& u, int wr, int wc, int fr, int fq) const {
        const int e = u.aux, row0 = u.pm * BM + wr * 64 + fr, col0 = u.pn * BM + wc * 32 + 8 * fq;
        constexpr float DS = 1.f / (SC_H2 * SC_W);
        f32x4 bv[2][2];
#pragma unroll
        for (int bj = 0; bj < 2; ++bj)
#pragma unroll
            for (int n = 0; n < 2; ++n) bv[bj][n] = *(const f32x4*)(b1 + (size_t)e * 2048 + col0 + bj * HALF + 4 * n);
#pragma unroll
        for (int ai = 0; ai < 2; ++ai)
#pragma unroll
            for (int m = 0; m < 4; ++m) { const int row = row0 + ai * HALF + m * 16;
#pragma unroll
                for (int bj = 0; bj < 2; ++bj) { float o[4];
#pragma unroll
                    for (int n = 0; n < 2; ++n) { const f32x4 v = acc[ai][bj][m][n] * DS + bv[bj][n];
#pragma unroll
                        for (int q = 0; q < 2; ++q) { const float xg = fminf(v[2 * q], 7.f), xl = __builtin_amdgcn_fmed3f(v[2 * q + 1], -7.f, 7.f);
                            const float sg = __builtin_amdgcn_rcpf(1.f + __builtin_amdgcn_exp2f(xg * (-1.702f * LOG2E)));
                            o[2 * n + q] = (xg * sg) * __builtin_fmaf(xl, SC_ACT, SC_ACT); } }
                    int w = __builtin_amdgcn_cvt_pk_fp8_f32(o[0], o[1], 0, false); w = __builtin_amdgcn_cvt_pk_fp8_f32(o[2], o[3], w, true);
                    *(int*)(ACT + (size_t)row * 1024 + ((col0 + bj * HALF) >> 1)) = w; } }
    }
};
struct EpiMoe2 {
    static constexpr bool PERM = true;
    const float* b2; unsigned char* YIT;
    __device__ __forceinline__ void operator()(const Acc& acc, const Unit& u, int wr, int wc, int fr, int fq) const {
        const int e = u.aux, row0 = u.pm * BM + wr * 64 + fr, col0 = u.pn * BM + wc * 32 + 8 * fq;
        constexpr float DS = SC_Y / (SC_ACT * SC_W);
        f32x4 bv[2][2];
#pragma unroll
        for (int bj = 0; bj < 2; ++bj)
#pragma unroll
            for (int n = 0; n < 2; ++n) bv[bj][n] = *(const f32x4*)(b2 + (size_t)e * 1024 + col0 + bj * HALF + 4 * n) * SC_Y;
#pragma unroll
        for (int ai = 0; ai < 2; ++ai)
#pragma unroll
            for (int m = 0; m < 4; ++m) { const int row = row0 + ai * HALF + m * 16;
#pragma unroll
                for (int bj = 0; bj < 2; ++bj) { f32x4 v0 = acc[ai][bj][m][0] * DS + bv[bj][0], v1 = acc[ai][bj][m][1] * DS + bv[bj][1];
                    v0 = __builtin_elementwise_min(__builtin_elementwise_max(v0, (f32x4){-448.f, -448.f, -448.f, -448.f}), (f32x4){448.f, 448.f, 448.f, 448.f});
                    v1 = __builtin_elementwise_min(__builtin_elementwise_max(v1, (f32x4){-448.f, -448.f, -448.f, -448.f}), (f32x4){448.f, 448.f, 448.f, 448.f});
                    u32x2 w; int t = __builtin_amdgcn_cvt_pk_fp8_f32(v0[0], v0[1], 0, false); t = __builtin_amdgcn_cvt_pk_fp8_f32(v0[2], v0[3], t, true); w.x = (unsigned)t;
                    t = __builtin_amdgcn_cvt_pk_fp8_f32(v1[0], v1[1], 0, false); t = __builtin_amdgcn_cvt_pk_fp8_f32(v1[2], v1[3], t, true); w.y = (unsigned)t;
                    *(u32x2*)(YIT + (size_t)row * 1024 + col0 + bj * HALF) = w; } }
    }
};
}

namespace attn {
#define SBAR() __builtin_amdgcn_sched_barrier(0)
constexpr int NW = 8, QBLK = 32, KVBLK = 64;
constexpr float THR = 8.f;
__device__ __forceinline__ int crow(int r, int hi) { return (r & 3) + 8 * (r >> 2) + 4 * hi; }
constexpr int KROW_MLA = 96 * 2 + 16, KROW_NA = 64 * 2 + 16;
constexpr int SHM_K = 64 * KROW_MLA  , SHM_V = 64 * 64 * 2  ;
constexpr int OFF_V = 0, OFF_K = 4 * SHM_V, OFF_WS = OFF_K + 4 * SHM_K, OFF_OST = OFF_WS + NW * 256, OFF_BIAS = OFF_OST + NW * 4096, ATTN_LDS = OFF_BIAS + 2048;

__device__ __forceinline__ int v_st(int k, int c) { const int kk = (k & ~0xC) | ((k & 4) << 1) | ((k & 8) >> 1); return ((kk >> 3) * 2 + (c >> 5)) * 512 + ((kk & 7) * 32 + (c & 31)) * 2; }
__device__ __forceinline__ int v_rd_base(int lane) { return ((lane & 3) << 3) | (((lane >> 2) & 3) << 6) | (((lane >> 4) & 1) << 5) | (((lane >> 5) & 1) << 8); }
constexpr int v_rd_off(int d0, int ks, int half) { return d0 * 512 + ks * 2048 + half * 1024; }
template <int OFF> __device__ __forceinline__ s16x4 tr_read(int vb) {
    s16x4 r; asm volatile("ds_read_b64_tr_b16 %0, %1 offset:%2" : "=&v"(r) : "v"(vb), "i"(OFF) : "memory"); return r;
}
template <int D0> __device__ __forceinline__ void pv_one(f32x16& od, int vb, bf16x8 pa0, bf16x8 pa1, bf16x8 pa2, bf16x8 pa3) {
    const s16x4 l0 = tr_read<v_rd_off(D0, 0, 0)>(vb), h0 = tr_read<v_rd_off(D0, 0, 1)>(vb), l1 = tr_read<v_rd_off(D0, 1, 0)>(vb), h1 = tr_read<v_rd_off(D0, 1, 1)>(vb);
    const s16x4 l2 = tr_read<v_rd_off(D0, 2, 0)>(vb), h2 = tr_read<v_rd_off(D0, 2, 1)>(vb), l3 = tr_read<v_rd_off(D0, 3, 0)>(vb), h3 = tr_read<v_rd_off(D0, 3, 1)>(vb);
    asm volatile("s_waitcnt lgkmcnt(0)" ::: "memory"); SBAR();
#define PK(L, H) (bf16x8){L[0], L[1], L[2], L[3], H[0], H[1], H[2], H[3]}
    od = __builtin_amdgcn_mfma_f32_32x32x16_bf16(pa0, PK(l0, h0), od, 0, 0, 0);
    od = __builtin_amdgcn_mfma_f32_32x32x16_bf16(pa1, PK(l1, h1), od, 0, 0, 0);
    od = __builtin_amdgcn_mfma_f32_32x32x16_bf16(pa2, PK(l2, h2), od, 0, 0, 0);
    od = __builtin_amdgcn_mfma_f32_32x32x16_bf16(pa3, PK(l3, h3), od, 0, 0, 0);
#undef PK
}
__device__ __forceinline__ void pv_d0(f32x16* o, int vb, bf16x8 pa0, bf16x8 pa1, bf16x8 pa2, bf16x8 pa3) {
    pv_one<0>(o[0], vb, pa0, pa1, pa2, pa3); pv_one<1>(o[1], vb, pa0, pa1, pa2, pa3);
}
__device__ __forceinline__ void partialSM(f32x16& p0, f32x16& p1, float& m_ref, f32x16& negm, float& alpha, bool& fresh) {
    float pmax = p0[0];
#pragma unroll
    for (int r = 1; r < 16; ++r) pmax = fmaxf(pmax, p0[r]);
#pragma unroll
    for (int r = 0; r < 16; ++r) pmax = fmaxf(pmax, p1[r]);
    { auto rr = __builtin_amdgcn_permlane32_swap(__float_as_uint(pmax), __float_as_uint(pmax), false, false);
      pmax = fmaxf(__uint_as_float(rr[0]), __uint_as_float(rr[1])); }
    alpha = 1.f;
    if (__builtin_expect(fresh || !__all(pmax <= THR), 0)) {
        const float dl = fresh ? pmax : fmaxf(pmax, 0.f);
        m_ref += dl;
#pragma unroll
        for (int r = 0; r < 16; ++r) { p0[r] -= dl; p1[r] -= dl; }
        const float nm = -m_ref;
#pragma unroll
        for (int r = 0; r < 16; ++r) negm[r] = nm;
        alpha = fresh ? 1.f : __builtin_amdgcn_exp2f(-dl);
        fresh = false;
    }
#pragma unroll
    for (int r = 0; r < 16; ++r) p0[r] = __builtin_amdgcn_exp2f(p0[r]);
}
__device__ __forceinline__ void finishSM(f32x16& p0, f32x16& p1, float alpha, float& l_reg, bf16x8& pa0, bf16x8& pa1, bf16x8& pa2, bf16x8& pa3) {
#pragma unroll
    for (int r = 0; r < 16; ++r) p1[r] = __builtin_amdgcn_exp2f(p1[r]);
    float ps = 0;
#pragma unroll
    for (int r = 0; r < 16; ++r) ps += p0[r];
#pragma unroll
    for (int r = 0; r < 16; ++r) ps += p1[r];
    { auto rr = __builtin_amdgcn_permlane32_swap(__float_as_uint(ps), __float_as_uint(ps), false, false);
      ps = __uint_as_float(rr[0]) + __uint_as_float(rr[1]); }
    l_reg = l_reg * alpha + ps;
#define PK4(P, BASE, OUT) do { unsigned a0 = cvt_pk_bf16(P[BASE + 0], P[BASE + 1]), a1 = cvt_pk_bf16(P[BASE + 2], P[BASE + 3]);   \
    unsigned b0 = cvt_pk_bf16(P[BASE + 4], P[BASE + 5]), b1 = cvt_pk_bf16(P[BASE + 6], P[BASE + 7]);                              \
    auto r0 = __builtin_amdgcn_permlane32_swap(a0, b0, false, false); auto r1 = __builtin_amdgcn_permlane32_swap(a1, b1, false, false); \
    u32x4 w = {r0[0], r1[0], r0[1], r1[1]}; OUT = *reinterpret_cast<bf16x8*>(&w); } while (0)
    PK4(p0, 0, pa0); PK4(p0, 8, pa1); PK4(p1, 0, pa2); PK4(p1, 8, pa3);
#undef PK4
}
template <int ND0, int KROW>
__device__ __forceinline__ void qkt(f32x16& p0, f32x16& p1, const char* Ks, const bf16x8* qr, const f32x16& negm, int r32, int hi) {
#pragma unroll
    for (int d0 = 0; d0 < ND0; ++d0) { const int cb = (d0 * 16 + hi * 8) * 2;
        const bf16x8 b0 = *reinterpret_cast<const bf16x8*>(Ks + r32 * KROW + cb);
        const bf16x8 b1 = *reinterpret_cast<const bf16x8*>(Ks + (32 + r32) * KROW + cb);
        if (d0 == 0) { p0 = __builtin_amdgcn_mfma_f32_32x32x16_bf16(b0, qr[0], negm, 0, 0, 0); p1 = __builtin_amdgcn_mfma_f32_32x32x16_bf16(b1, qr[0], negm, 0, 0, 0); }
        else { p0 = __builtin_amdgcn_mfma_f32_32x32x16_bf16(b0, qr[d0], p0, 0, 0, 0); p1 = __builtin_amdgcn_mfma_f32_32x32x16_bf16(b1, qr[d0], p1, 0, 0, 0); } }
}

template <int MODE>
__device__ __forceinline__ void attn_unit(const bf16_t* __restrict__ Qa, int ldqa, const bf16_t* __restrict__ Qb, int ldqb,
                                          const bf16_t* __restrict__ Ka, int ldka, const bf16_t* __restrict__ Kb, int ldkb, const bf16_t* __restrict__ Vv, int ldv,
                                          bf16_t* __restrict__ O, int NT, int krow0, int ntreal, int qrow0, const float* __restrict__ rpbh, char* lds) {
    constexpr int ND0 = MODE == 0 ? 6 : 4, KROW = MODE == 0 ? KROW_MLA : KROW_NA;
    const int tid = threadIdx.x, wid = __builtin_amdgcn_readfirstlane(tid >> 6), lane = tid & 63, r32 = lane & 31, hi = lane >> 5;
    char* V_lds = lds + OFF_V; char* K_lds = lds + OFF_K;
    float* ws = (float*)(lds + OFF_WS) + wid * 64; float* li_l = ws; float* al_l = ws + 32;
    float* biasL = (float*)(lds + OFF_BIAS);
    float m_ref = 0.f, l_reg = 0; f32x16 o[2] = {}; f32x16 negm = {}; bool fresh = true; bf16x8 qr[ND0];
    {   const bf16_t* Qw = Qa + (size_t)(wid * QBLK + r32) * ldqa + hi * 8;
#pragma unroll
        for (int d0 = 0; d0 < 4; ++d0) qr[d0] = *reinterpret_cast<const bf16x8*>(Qw + d0 * 16);
        if constexpr (MODE == 0) { const bf16_t* Qw2 = Qb + (size_t)(wid * QBLK + r32) * ldqb + hi * 8;
#pragma unroll
            for (int d0 = 0; d0 < 2; ++d0) qr[4 + d0] = *reinterpret_cast<const bf16x8*>(Qw2 + d0 * 16); } }
    int qgr = 0, rs0 = 0, qc = 0, cs = 0;
    if constexpr (MODE == 1) {
        qgr = qrow0 + (wid >> 1); rs0 = min(max(qgr - 4, 0), 120); qc = 32 * (wid & 1) + r32; cs = min(max(qc - 8, 0), 48);
        for (int i = tid; i < 15 * 31; i += 512) biasL[i] = rpbh[i] * LOG2E;
    }
    const int sr = tid >> 3, sc = (tid & 7) * 8;
    const int sr2 = (tid & 255) >> 2, sc2 = (tid & 3) * 8;
    const int vst = v_st(sr, sc);
    const int vb0 = (int)(uintptr_t)V_lds + v_rd_base(lane);
    struct { bf16x8 v, k, k2; } sr_[1];
#define KROWOF(t) (MODE == 1 ? min(krow0 + (t), 127) * 64 : (t) * 64)
#define SLOAD(i, t) do { const long k0_ = KROWOF(t); sr_[i].v = *reinterpret_cast<const bf16x8*>(&Vv[(k0_ + sr) * ldv + sc]); sr_[i].k = *reinterpret_cast<const bf16x8*>(&Ka[(k0_ + sr) * ldka + sc]); \
        if constexpr (MODE == 0) sr_[i].k2 = *reinterpret_cast<const bf16x8*>(&Kb[(k0_ + sr2) * ldkb + sc2]); } while (0)
#define SWRITE(b, i) do { *(bf16x8*)(V_lds + (b) * SHM_V + vst) = sr_[i].v; *(bf16x8*)(K_lds + (b) * SHM_K + sr * KROW + sc * 2) = sr_[i].k; \
        if constexpr (MODE == 0) { if (tid < 256) *(bf16x8*)(K_lds + (b) * SHM_K + sr2 * KROW + 128 + sc2 * 2) = sr_[i].k2; } } while (0)
#define SWAIT() do { if constexpr (MODE == 0) asm volatile("s_waitcnt vmcnt(3)" ::: "memory"); else asm volatile("s_waitcnt vmcnt(2)" ::: "memory"); } while (0)
#define RESC(a) do { if (__any((a) < 1.f)) { if (hi == 0) al_l[r32] = (a); asm volatile("s_waitcnt lgkmcnt(0)" ::: "memory"); \
        _Pragma("unroll") for (int d = 0; d < 2; ++d) _Pragma("unroll") for (int r = 0; r < 16; ++r) o[d][r] *= al_l[crow(r, hi)]; } } while (0)
#define TVALID(t) (MODE == 0 ? true : ((t) < ntreal && (krow0 + (t)) >= rs0 && (krow0 + (t)) < rs0 + 8))
#define MASKB(P0, P1, t) do { if constexpr (MODE == 1) { const int dr_ = krow0 + (t) - qgr + 7; int d_ = 4 * hi - cs; asm volatile("" : "+v"(d_)); \
        const LAS float* bl_ = (const LAS float*)((LAS char*)lds + OFF_BIAS) + (dr_ * 31 + 15 - qc + 4 * hi); \
        _Pragma("unroll") for (int r = 0; r < 16; ++r) { const int c0_ = (r & 3) + 8 * (r >> 2); \
            const bool in0 = (unsigned)(c0_ + d_) < 16u, in1 = (unsigned)(c0_ + 32 + d_) < 16u; \
            const float b0_ = bl_[c0_], b1_ = bl_[c0_ + 32]; \
            P0[r] = in0 ? P0[r] + b0_ : -1e30f; P1[r] = in1 ? P1[r] + b1_ : -1e30f; } } } while (0)
    f32x16 pA0, pA1, pB0, pB1; float alA = 1.f, alB = 1.f; bf16x8 pa0, pa1, pa2, pa3;
    SLOAD(0, 0); asm volatile("s_waitcnt vmcnt(0)" ::: "memory"); SWRITE(0, 0); SLOAD(0, 1); asm volatile("s_waitcnt vmcnt(0)" ::: "memory"); SWRITE(1, 0);
    if (NT > 2) SLOAD(0, 2);
    __syncthreads();
    const int NI = NT >> 1;
    for (int it = 0; it < NI; ++it) {
        const int kb = (it & 1) * 2, nb = 2 - kb; const bool more = it + 1 < NI;
        if (more) { SWRITE(nb, 0); SLOAD(0, 2 * it + 3); }
        const int ta = 2 * it, tb = ta + 1;
        const bool vA = TVALID(ta), vB = TVALID(tb);
        if (vA) { qkt<ND0, KROW>(pA0, pA1, K_lds + kb * SHM_K, qr, negm, r32, hi); MASKB(pA0, pA1, ta); partialSM(pA0, pA1, m_ref, negm, alA, fresh); RESC(alA); }
        SBAR();
        if (vB) { qkt<ND0, KROW>(pB0, pB1, K_lds + (kb + 1) * SHM_K, qr, negm, r32, hi); MASKB(pB0, pB1, tb); }
        if (vA) { finishSM(pA0, pA1, alA, l_reg, pa0, pa1, pa2, pa3); SBAR(); pv_d0(o, vb0 + kb * SHM_V, pa0, pa1, pa2, pa3); }
        if (more) { SWRITE(nb + 1, 0); if (it + 2 < NI) SLOAD(0, 2 * it + 4); }
        if (vB) { partialSM(pB0, pB1, m_ref, negm, alB, fresh); RESC(alB); finishSM(pB0, pB1, alB, l_reg, pa0, pa1, pa2, pa3); SBAR(); pv_d0(o, vb0 + (kb + 1) * SHM_V, pa0, pa1, pa2, pa3); }
        __syncthreads();
    }
    asm volatile("s_waitcnt vmcnt(0)" ::: "memory");
    if (hi == 0) li_l[r32] = l_reg; asm volatile("s_waitcnt lgkmcnt(0)" ::: "memory");
    float rli[16];
#pragma unroll
    for (int r = 0; r < 16; ++r) rli[r] = __builtin_amdgcn_rcpf(li_l[crow(r, hi)]);
    {   bf16_t* stg = (bf16_t*)(lds + OFF_OST) + wid * 2048;
#pragma unroll
        for (int r = 0; r < 16; ++r) { const int orow = crow(r, hi);
#pragma unroll
            for (int d0 = 0; d0 < 2; ++d0) stg[orow * 64 + d0 * 32 + r32] = (bf16_t)(cvt_pk_bf16(o[d0][r] * rli[r], 0.f) & 0xffffu); }
        asm volatile("s_waitcnt lgkmcnt(0)" ::: "memory");
        bf16_t* Ow = O + (size_t)(wid * QBLK) * 512;
#pragma unroll
        for (int i = 0; i < 4; ++i) { const int row = i * 8 + (lane >> 3), ch = lane & 7; const u32x4 v = *(const u32x4*)(stg + row * 64 + ch * 8); *(u32x4*)(Ow + (size_t)row * 512 + ch * 8) = v; } }
    __syncthreads();
#undef KROWOF
#undef SLOAD
#undef SWRITE
#undef SWAIT
#undef RESC
#undef TVALID
#undef MASKB
}
#undef SBAR
}

constexpr size_t MiB = 1u << 20;
constexpr size_t WS_CTL = 0, CTL_ZERO_BYTES = 1 * MiB;
constexpr size_t WS_WIN = 2 * MiB;
constexpr size_t WS_WUQ = 11 * MiB;
constexpr size_t WS_WUKV = 12 * MiB;
constexpr size_t WS_WNA = 13 * MiB, WS_WMLA = 14 * MiB;
constexpr size_t WS_WOUT = 15 * MiB;
constexpr size_t WS_W1 = 18 * MiB;
constexpr size_t WS_W2 = 146 * MiB;
constexpr size_t WS_XN = 210 * MiB;
constexpr size_t WS_PROJ = 242 * MiB;
constexpr size_t WS_QN = 378 * MiB, WS_QR = 394 * MiB, WS_KN = 402 * MiB, WS_KR = 418 * MiB, WS_VM = 419 * MiB;
constexpr size_t WS_ONA = 435 * MiB, WS_OMLA = 451 * MiB;
constexpr size_t WS_MERGED = 467 * MiB;
constexpr size_t WS_TMP = 499 * MiB;
constexpr size_t WS_LIST = 563 * MiB;
constexpr size_t WS_TOKPOS = 565 * MiB, WS_TOKG = 566 * MiB;
constexpr size_t WS_ACT = 568 * MiB;
constexpr size_t WS_YIT = 712 * MiB;
constexpr size_t WS_SSQ = 856 * MiB;
constexpr size_t WS_MODP = 857 * MiB;
constexpr size_t WS_WRT = 858 * MiB;
constexpr size_t WS_END = 859 * MiB;
constexpr int CW_BAR = 4096;
constexpr int CW_CNT = 8192;
constexpr int CW_MOD = 16384;
constexpr int CW_ROPE = 32768;
static_assert((CW_ROPE + 2048) * 4 <= (int)CTL_ZERO_BYTES, "CTL");

constexpr int RING_BYTES = 131072;
constexpr int TAB_OFF = RING_BYTES;
constexpr int TAB_BLK = TAB_OFF, TAB_GATH = TAB_OFF + 2048;
constexpr int MISC_OFF = TAB_GATH + 11 * 1024;
constexpr int LDS_BYTES = 147456;
static_assert(MISC_OFF + 256 <= LDS_BYTES, "LDS map");

#define RLX_AGENT __ATOMIC_RELAXED, __HIP_MEMORY_SCOPE_AGENT
#define LDS_WAIT() asm volatile("s_waitcnt lgkmcnt(0)" ::: "memory")

#define XB_TMO      128
#define XB_XCNT(j)  (256  + 64 * (j))
#define XB_XSUB(j)  (1280 + 64 * (j))
#define XB_XGEN(j)  (2304 + 64 * (j))
#define XB_TOP      3328
#define XB_TOPGEN   3392
#define XCD_BAR_WORDS 3456
#define XB_SPIN_CAP (1u << 22)
__device__ __forceinline__ unsigned xb_ld(unsigned* p)              { return __hip_atomic_load(p, __ATOMIC_RELAXED, __HIP_MEMORY_SCOPE_AGENT); }
__device__ __forceinline__ unsigned xb_add(unsigned* p, unsigned v) { return __hip_atomic_fetch_add(p, v, __ATOMIC_RELAXED, __HIP_MEMORY_SCOPE_AGENT); }
__device__ __forceinline__ unsigned xb_xcc_id() { return (unsigned)__builtin_amdgcn_s_getreg((3 << 11) | 20) & 0xFu; }
#define XB_SPIN(cond, bar) do { unsigned _sp = 0; while (cond) { __builtin_amdgcn_s_sleep(1); \
    if ((++_sp & 255u) == 0u) { if (xb_ld(&(bar)[XB_TMO])) break; if (_sp > XB_SPIN_CAP) { atomicAdd(&(bar)[XB_TMO], 1u); break; } } } } while (0)
struct XcdBarrier { unsigned* bar; unsigned x; volatile LAS unsigned* st; };
__device__ __forceinline__ XcdBarrier xcd_barrier_post(unsigned* bar, volatile LAS unsigned* st) {
    XcdBarrier b; b.bar = bar; b.x = xb_xcc_id(); b.st = st;
    if (threadIdx.x == 0) (void)xb_add(&bar[XB_XCNT(b.x)], 1u);
    return b;
}
__device__ __forceinline__ void xcd_barrier_complete(unsigned* bar, unsigned x, unsigned& nloc, unsigned& nx) {
    const unsigned G = gridDim.x * gridDim.y * gridDim.z;
    unsigned sum, cnt, mine, sp = 0u;
    for (;;) {
        sum = 0u; cnt = 0u; mine = 0u;
#pragma unroll
        for (unsigned j = 0; j < 16; ++j) { const unsigned c = xb_ld(&bar[XB_XCNT(j)]); sum += c; cnt += (c > 0u) ? 1u : 0u; mine = (j == x) ? c : mine; }
        if (sum == G) break;
        __builtin_amdgcn_s_sleep(1);
        if ((++sp & 255u) == 0u) { if (xb_ld(&bar[XB_TMO])) break; if (sp > XB_SPIN_CAP) { atomicAdd(&bar[XB_TMO], 1u); break; } }
    }
    nloc = mine > 0u ? mine : 1u; nx = cnt > 0u ? cnt : 1u;
}
__device__ __forceinline__ void xcd_barrier(const XcdBarrier& b) {
    asm volatile("s_waitcnt vmcnt(0)" ::: "memory");
    __syncthreads();
    if (threadIdx.x == 0) {
        unsigned* bar = b.bar;
        __builtin_amdgcn_s_waitcnt(0);
        unsigned nloc = b.st[0], nx = b.st[1];
        if (nloc == 0u) { xcd_barrier_complete(bar, b.x, nloc, nx); b.st[0] = nloc; b.st[1] = nx; }
        const unsigned old = xb_add(&bar[XB_XSUB(b.x)], 1u);
        const unsigned gen = old / nloc;
        if (old + 1u == (gen + 1u) * nloc) {
            __builtin_amdgcn_fence(__ATOMIC_RELEASE, "agent");
            asm volatile("s_waitcnt vmcnt(0)" ::: "memory");
            const unsigned og = xb_add(&bar[XB_TOP], 1u);
            const unsigned tg = og / nx;
            if (og + 1u == (tg + 1u) * nx) xb_add(&bar[XB_TOPGEN], 1u);
            else XB_SPIN(xb_ld(&bar[XB_TOPGEN]) == tg, bar);
            __builtin_amdgcn_fence(__ATOMIC_ACQUIRE, "agent");
            xb_add(&bar[XB_XGEN(b.x)], 1u);
            asm volatile("s_waitcnt vmcnt(0)" ::: "memory");
        } else {
            XB_SPIN(xb_ld(&bar[XB_XGEN(b.x)]) == gen, bar);
            __builtin_amdgcn_fence(__ATOMIC_ACQUIRE, "agent");
            asm volatile("s_waitcnt vmcnt(0)" ::: "memory");
        }
    }
    __syncthreads();
}

constexpr int NWAVES = 8;
struct Args { const float* in[24]; float* out; unsigned char* ws; int ph_lo, ph_hi; };
enum { I_X = 0, I_C, I_WADA, I_BADA, I_GAPRE, I_GAPOST, I_WIN, I_BGATE, I_RPB, I_QNG, I_KVNG, I_WUQ, I_WUKV, I_WNAUP, I_WMLAUP, I_WOUT, I_GFPRE, I_GFPOST, I_WR, I_BR, I_W1, I_B1, I_W2, I_B2 };

__device__ __forceinline__ void tr_store_tile(LAS unsigned char* scr, bf16_t* dst, int K, int n0, int k0, int lane) {
    LDS_WAIT(); asm volatile("" ::: "memory");
#pragma unroll
    for (int j = 0; j < 8; ++j) { const int idx = j * 64 + lane, n = idx >> 3, ch = idx & 7;
        const u32x4 v = *(const LAS u32x4*)(scr + n * 144 + ch * 16);
        *(GAS u32x4*)(dst + (size_t)(n0 + n) * K + k0 + ch * 8) = v; }
    LDS_WAIT(); asm volatile("" ::: "memory");
}
__device__ __forceinline__ void tr_tile_fast(const float* src, int Nsrc, int src0, const float* kscale, bf16_t* dst, int K, int n0, int k0, LAS unsigned char* scr, int lane) {
#pragma unroll
    for (int st = 0; st < 8; ++st) { const int kq = st * 4 + (lane >> 4), c4 = (lane & 15) * 4, k = 2 * kq;
        f32x4 a = *(const GAS f32x4*)(src + (size_t)(k0 + k) * Nsrc + src0 + c4);
        f32x4 b = *(const GAS f32x4*)(src + (size_t)(k0 + k + 1) * Nsrc + src0 + c4);
        if (kscale) { const float s0 = kscale[k0 + k], s1 = kscale[k0 + k + 1]; a = a * s0; b = b * s1; }
#pragma unroll
        for (int i = 0; i < 4; ++i) *(LAS unsigned*)(scr + (c4 + i) * 144 + k * 2) = cvt_pk_bf16(a[i], b[i]); }
    tr_store_tile(scr, dst, K, n0, k0, lane);
}
__device__ __forceinline__ void tr_tile_slow(const float* src, int Nsrc, int srccol  , const float* kscale, bf16_t* dst, int K, int n0, int k0, LAS unsigned char* scr, int lane) {
#pragma unroll
    for (int k = 0; k < 64; k += 2) {
        float a = 0.f, b = 0.f;
        if (srccol >= 0) { a = src[(size_t)(k0 + k) * Nsrc + srccol]; b = src[(size_t)(k0 + k + 1) * Nsrc + srccol];
            if (kscale) { a *= kscale[k0 + k]; b *= kscale[k0 + k + 1]; } }
        *(LAS unsigned*)(scr + lane * 144 + k * 2) = cvt_pk_bf16(a, b); }
    tr_store_tile(scr, dst, K, n0, k0, lane);
}
__device__ __forceinline__ void tr_tile_fast8(const float* src, int Nsrc, int src0, unsigned char* dst, int K, int n0, int k0, LAS unsigned char* scr, int lane) {
#pragma unroll
    for (int st = 0; st < 4; ++st) { const int kq = st * 4 + (lane >> 4), c4 = (lane & 15) * 4, k = 4 * kq;
        const f32x4 a = __builtin_nontemporal_load((const f32x4*)(src + (size_t)(k0 + k) * Nsrc + src0 + c4)) * SC_W, b = __builtin_nontemporal_load((const f32x4*)(src + (size_t)(k0 + k + 1) * Nsrc + src0 + c4)) * SC_W;
        const f32x4 c = __builtin_nontemporal_load((const f32x4*)(src + (size_t)(k0 + k + 2) * Nsrc + src0 + c4)) * SC_W, d = __builtin_nontemporal_load((const f32x4*)(src + (size_t)(k0 + k + 3) * Nsrc + src0 + c4)) * SC_W;
#pragma unroll
        for (int i = 0; i < 4; ++i) { int w = __builtin_amdgcn_cvt_pk_fp8_f32(a[i], b[i], 0, false); w = __builtin_amdgcn_cvt_pk_fp8_f32(c[i], d[i], w, true);
            *(LAS int*)(scr + (c4 + i) * 80 + k) = w; } }
    LDS_WAIT(); asm volatile("" ::: "memory");
#pragma unroll
    for (int j = 0; j < 4; ++j) { const int idx = j * 64 + lane, n = idx >> 2, ch = idx & 3;
        const u32x4 v = *(const LAS u32x4*)(scr + n * 80 + ch * 16);
        __builtin_nontemporal_store(v, (u32x4*)(dst + (size_t)(n0 + n) * K + k0 + ch * 16)); }
    LDS_WAIT(); asm volatile("" ::: "memory");
}
__device__ __forceinline__ int rope_orig(int p) { return (p & 16) + 8 * (p & 1) + ((p & 15) >> 1); }

__global__ void __launch_bounds__(NWAVES * 64, 2) fwd_kernel(Args args_unused_) {
#define args (*(const __attribute__((address_space(4))) Args*)__builtin_amdgcn_kernarg_segment_ptr())
    extern __shared__ __attribute__((aligned(16))) unsigned char lds[];
    LAS unsigned char* L = (LAS unsigned char*)lds;
    volatile LAS unsigned* MISC = (volatile LAS unsigned*)(L + MISC_OFF);
    const int tid = threadIdx.x, lane = tid & 63, wave = __builtin_amdgcn_readfirstlane(tid >> 6);
    const int G = gridDim.x, bx = blockIdx.x, vcu = (G % 8 == 0) ? (bx % 8) * (G / 8) + bx / 8 : bx;
    unsigned char* ws = args.ws;
    gu32* ctl = (gu32*)(ws + WS_CTL);
    const int lo = args.ph_lo, hi = args.ph_hi;
    for (int u = tid; u < 64; u += NWAVES * 64) MISC[u] = 0u;
    __syncthreads();
    XcdBarrier bar; bar.bar = (unsigned*)(ctl + CW_BAR); bar.x = 0; bar.st = nullptr;
    const bool use_bar = (hi - lo) > 1;
    if (use_bar) bar = xcd_barrier_post((unsigned*)(ctl + CW_BAR), MISC + 8);
#ifndef PHASE_MASK
#define PHASE_MASK 0xFFFF
#endif
#define IN(k) (((PHASE_MASK >> (k)) & 1) && lo <= (k) && (k) < hi)
#ifndef REPMASK
#define REPMASK 0
#endif
#define NREP(k) (1 + ((REPMASK >> (k)) & 1))
#define SEAM(k) do { if (IN(k) && IN((k) + 1)) xcd_barrier(bar); } while (0)
    const int gw = vcu * NWAVES + wave, NGW = G * NWAVES;
    float* ROPE = (float*)(ctl + CW_ROPE);
    float* MODP = (float*)(ws + WS_MODP); float* MOD = (float*)(ws + WS_MODP + 512 * 1024); float* SSQ = (float*)(ws + WS_SSQ); unsigned* CNT = (unsigned*)(ctl + CW_CNT);
    bf16_t* WINT = (bf16_t*)(ws + WS_WIN); bf16_t* WUQT = (bf16_t*)(ws + WS_WUQ); bf16_t* WUKVT = (bf16_t*)(ws + WS_WUKV);
    bf16_t* WNAT = (bf16_t*)(ws + WS_WNA); bf16_t* WMLAT = (bf16_t*)(ws + WS_WMLA); bf16_t* WOUTT = (bf16_t*)(ws + WS_WOUT);
    bf16_t* W1T = (bf16_t*)(ws + WS_W1); bf16_t* W2T = (bf16_t*)(ws + WS_W2);
    bf16_t* XN = (bf16_t*)(ws + WS_XN); bf16_t* PROJ = (bf16_t*)(ws + WS_PROJ);
    bf16_t* QN = (bf16_t*)(ws + WS_QN); bf16_t* QR = (bf16_t*)(ws + WS_QR); bf16_t* KN = (bf16_t*)(ws + WS_KN); bf16_t* KR = (bf16_t*)(ws + WS_KR); bf16_t* VM = (bf16_t*)(ws + WS_VM);
    bf16_t* ONA = (bf16_t*)(ws + WS_ONA); bf16_t* OMLA = (bf16_t*)(ws + WS_OMLA); bf16_t* MERGED = (bf16_t*)(ws + WS_MERGED);
    float* TMP = (float*)(ws + WS_TMP); unsigned* LIST = (unsigned*)(ws + WS_LIST); unsigned* TOKPOS = (unsigned*)(ws + WS_TOKPOS); float* TOKG = (float*)(ws + WS_TOKG);
    bf16_t* ACT = (bf16_t*)(ws + WS_ACT); bf16_t* YIT = (bf16_t*)(ws + WS_YIT);
    const float* X = args.in[I_X]; float* OUT = args.out; bf16_t* X1B = (bf16_t*)TMP + (size_t)MTOK * DM;

    if (IN(0)) for (int rep_ = 0; rep_ < NREP(0); ++rep_) {
        LAS unsigned char* scr = L + wave * 16384;
        if (vcu < 192) { const float* c = args.in[I_C]; const float* wada = args.in[I_WADA]; const float* bada = args.in[I_BADA];
            const int cb = vcu % 24, kc = vcu / 24, k0 = kc * 128 + wave * 16, n0 = cb * 256 + lane * 4;
            f32x4 w[16];
#pragma unroll
            for (int k = 0; k < 16; ++k) w[k] = *(const GAS f32x4*)(wada + (size_t)(k0 + k) * 6144 + n0);
            f32x4 a0 = {0.f, 0.f, 0.f, 0.f}, a1 = {0.f, 0.f, 0.f, 0.f};
#pragma unroll
            for (int k = 0; k < 16; ++k) { const float c0 = c[k0 + k], c1 = c[1024 + k0 + k]; a0 += w[k] * (c0 * sigmoidf_(c0)); a1 += w[k] * (c1 * sigmoidf_(c1)); }
            LAS f32x4* red = (LAS f32x4*)(L + 65536);
            red[(wave * 2 + 0) * 64 + lane] = a0; red[(wave * 2 + 1) * 64 + lane] = a1;
            __syncthreads();
            { const int b = tid >> 8, col = tid & 255; const LAS float* rf = (const LAS float*)red; float sm = 0.f;
#pragma unroll
              for (int wv = 0; wv < 8; ++wv) sm += rf[(wv * 2 + b) * 256 + col];
              if (kc == 0) sm += bada[cb * 256 + col];
              MODP[(kc * 2 + b) * 6144 + cb * 256 + col] = sm; }
            __syncthreads();
        }
        if (bx == 0) { for (int i = tid; i < 128 * 8; i += NWAVES * 64) { const int pos = i >> 3, j = i & 7; float c, sn; rope_cs((float)pos, j, c, sn); ROPE[pos * 16 + j] = c; ROPE[pos * 16 + 8 + j] = sn; } }
        { const float* Wr = args.in[I_WR]; float* WRT = (float*)(ws + WS_WRT);
          for (int it = NGW - 1 - gw; it < NEXP * 16; it += NGW) { const int e = it >> 4, k = (it & 15) * 64 + lane; WRT[e * 1024 + k] = Wr[(size_t)k * 32 + e]; } }
        {   constexpr int I_WIN_ = 16 * 68, I_UQ = 6 * 12, I_UKV = 4 * 16, I_UP = 8 * 16, I_OUT = 16 * 16;
            constexpr int NITEMS = I_WIN_ + I_UQ + I_UKV + 2 * I_UP + I_OUT;
            for (int it = gw; it < NITEMS; it += NGW) {
                int r = it;
                if (r < I_WIN_) { const int kb = r / 68, nb = r % 68;
                    if (nb < 34) tr_tile_fast(args.in[I_WIN], 4256, nb * 64, nullptr, WINT, 1024, nb * 64, kb * 64, scr, lane);
                    else if (nb >= 36) tr_tile_fast(args.in[I_WIN], 4256, 2208 + (nb - 36) * 64, nullptr, WINT, 1024, nb * 64, kb * 64, scr, lane);
                    else { const int n = nb * 64 + lane; const int sc = (n < 2208) ? 2176 + rope_orig(n - 2176) : -1;
                        tr_tile_slow(args.in[I_WIN], 4256, sc, nullptr, WINT, 1024, nb * 64, kb * 64, scr, lane); }
                    continue; } r -= I_WIN_;
                if (r < I_UQ) { const int kb = r / 12, nb = r % 12;
                    if (nb < 8) tr_tile_fast(args.in[I_WUQ], 768, nb * 96, args.in[I_QNG], WUQT, 384, nb * 64, kb * 64, scr, lane);
                    else { const int n = nb * 64 + lane - 512, h = n >> 5, p = n & 31;
                        tr_tile_slow(args.in[I_WUQ], 768, h * 96 + 64 + rope_orig(p), args.in[I_QNG], WUQT, 384, nb * 64, kb * 64, scr, lane); }
                    continue; } r -= I_UQ;
                if (r < I_UKV) { const int kb = r / 16, nb = r % 16;
                    const int s0 = (nb < 8) ? nb * 128 : (nb - 8) * 128 + 64;
                    tr_tile_fast(args.in[I_WUKV], 1024, s0, args.in[I_KVNG], WUKVT, 256, nb * 64, kb * 64, scr, lane); continue; } r -= I_UKV;
                if (r < I_UP) { const int kb = r / 16, nb = r % 16; tr_tile_fast(args.in[I_WNAUP], 1024, nb * 64, nullptr, WNAT, 512, nb * 64, kb * 64, scr, lane); continue; } r -= I_UP;
                if (r < I_UP) { const int kb = r / 16, nb = r % 16; tr_tile_fast(args.in[I_WMLAUP], 1024, nb * 64, nullptr, WMLAT, 512, nb * 64, kb * 64, scr, lane); continue; } r -= I_UP;
                { const int kb = r / 16, nb = r % 16; tr_tile_fast(args.in[I_WOUT], 1024, nb * 64, nullptr, WOUTT, 1024, nb * 64, kb * 64, scr, lane); }
            } }
    }
    SEAM(0);
    if (IN(1)) {
        const float* g = args.in[I_GAPRE];
        LAS float* modl = (LAS float*)L;
        for (int i = tid; i < 4096; i += NWAVES * 64) { const int b = i >> 11, c = i & 2047; float sm = 0.f;
#pragma unroll
            for (int kc = 0; kc < 8; ++kc) sm += MODP[(kc * 2 + b) * 6144 + c];
            modl[i] = sm; }
        for (int idx = bx * (NWAVES * 64) + tid; idx < 2 * 6144; idx += G * NWAVES * 64) { const int b = idx / 6144, n = idx % 6144; float sm = 0.f;
#pragma unroll
            for (int kc = 0; kc < 8; ++kc) sm += MODP[(kc * 2 + b) * 6144 + n];
            MOD[idx] = sm; }
        __syncthreads();
        for (int m0 = gw * 2; m0 < MTOK; m0 += NGW * 2) { const int b = m0 >> 13;
            f32x4 v[2][4]; float ss[2] = {0.f, 0.f};
#pragma unroll
            for (int r = 0; r < 2; ++r) { const GAS f32x4* xr = (const GAS f32x4*)(X + (size_t)(m0 + r) * DM) + lane;
#pragma unroll
                for (int j = 0; j < 4; ++j) v[r][j] = xr[64 * j]; }
#pragma unroll
            for (int r = 0; r < 2; ++r)
#pragma unroll
                for (int j = 0; j < 4; ++j) ss[r] += (v[r][j].x * v[r][j].x + v[r][j].y * v[r][j].y) + (v[r][j].z * v[r][j].z + v[r][j].w * v[r][j].w);
#pragma unroll
            for (int r = 0; r < 2; ++r) { const float rstd = __builtin_amdgcn_rsqf(wave_sum(ss[r]) * (1.f / DM) + RMS_EPS);
                GAS u32x2* o8 = (GAS u32x2*)(XN + (size_t)(m0 + r) * DM) + lane;
#pragma unroll
                for (int j = 0; j < 4; ++j) { const int col = 4 * lane + 256 * j;
                    const f32x4 gg = *(const f32x4*)(g + col), sh = *(const LAS f32x4*)(modl + b * 2048 + col), scl = *(const LAS f32x4*)(modl + b * 2048 + 1024 + col);
                    const f32x4 h = v[r][j] * rstd * gg * (scl + 1.f) + sh; u32x2 w; w.x = cvt_pk_bf16(h[0], h[1]); w.y = cvt_pk_bf16(h[2], h[3]); o8[64 * j] = w; } } }
    }
    SEAM(1);
    if (IN(2)) for (int rep_ = 0; rep_ < NREP(2); ++rep_) {
        if (bx < NG_INPROJ || G < 256) {
            const int ng = G < 256 ? G : NG_INPROJ;
            pg8::SchedDense S{(const char*)XN, (const char*)WINT, (size_t)256 * 1024 * 2, (size_t)256 * 1024 * 2, MTOK / 256, NPROJ / 256, ng, bx};
            pg8::EpiInProj E{PROJ, SSQ, KR, ROPE, args.in[I_BGATE]};
            pg8::gemm_phase<pg8::EpiInProj, pg8::SchedDense, true, false, false>(L, 16, 2048, 2048, S, E);
        }
        {   LAS unsigned char* scr = L + wave * 16384;
            constexpr int I_W1_ = NEXP * 16 * 32, I_W2_ = NEXP * 16 * 16, NCHUNK = (I_W1_ + I_W2_) / 32;
            for (;;) {
                if (tid == 0) MISC[20] = atomicAdd(CNT + 64, 1u);
                __syncthreads();
                const int chunk = (int)MISC[20];
                __syncthreads();
                if (chunk >= NCHUNK) break;
#pragma unroll 1
                for (int k = 0; k < 4; ++k) { int r = chunk * 32 + wave * 4 + k;
                    if (r < I_W1_) { const int e = r / 512, q = r % 512, kb = q / 32, nb = q % 32;
                        tr_tile_fast8(args.in[I_W1] + (size_t)e * 1024 * 2048, 2048, nb * 64, (unsigned char*)W1T + (size_t)e * 2048 * 1024, 1024, nb * 64, kb * 64, scr, lane); }
                    else { r -= I_W1_; const int e = r / 256, q = r % 256, kb = q / 16, nb = q % 16;
                        tr_tile_fast8(args.in[I_W2] + (size_t)e * 1024 * 1024, 1024, nb * 64, (unsigned char*)W2T + (size_t)e * 1024 * 1024, 1024, nb * 64, kb * 64, scr, lane); } }
            } }
    }
    SEAM(2);
    if (IN(3)) for (int rep_ = 0; rep_ < NREP(3); ++rep_) {
#ifndef NO_QUP
        {   pg8::SchedDense S{(const char*)(PROJ + 1536), (const char*)WUQT, (size_t)256 * NPROJ * 2, (size_t)256 * 384 * 2, MTOK / 256, 3, G, bx};
            pg8::EpiQUp E{QN, QR, SSQ, ROPE};
            pg8::gemm_phase<pg8::EpiQUp, pg8::SchedDense, true, false, false>(L, 6, NPROJ * 2, 768, S, E); }
#endif
#ifndef NO_KVUP
        {   pg8::SchedDense S{(const char*)(PROJ + 1920), (const char*)WUKVT, (size_t)256 * NPROJ * 2, (size_t)256 * 256 * 2, MTOK / 256, 4, G, G - 1 - bx};
            pg8::EpiKVUp E{KN, VM, SSQ};
            pg8::gemm_phase<pg8::EpiKVUp, pg8::SchedDense, true, false, false>(L, 4, NPROJ * 2, 512, S, E); }
#endif
    }
    SEAM(3);
    if (IN(4)) for (int rep_ = 0; rep_ < NREP(4); ++rep_) {
#ifndef NO_MLA
        for (int u = vcu; u < 512; u += G) {
            const int bh = u >> 5, qb = u & 31, b = bh >> 3, h = bh & 7; const size_t row0 = (size_t)b * SEQ + qb * 256, key0 = (size_t)b * SEQ;
            attn::attn_unit<0>(QN + row0 * 512 + h * 64, 512, QR + row0 * 256 + h * 32, 256, KN + key0 * 512 + h * 64, 512, KR + key0 * 32, 32, VM + key0 * 512 + h * 64, 512,
                               OMLA + row0 * 512 + h * 64, 128, 0, 128, 0, nullptr, (char*)lds);
        }
#endif
#ifndef NO_NA
        for (int u = vcu; u < 512; u += G) {
            const int bh = u >> 5, rb = u & 31, b = bh >> 3, h = bh & 7; const size_t row0 = (size_t)b * SEQ + rb * 256, key0 = (size_t)b * SEQ;
            const int krow0 = min(max(4 * rb - 4, 0), 120), klast = min(max(4 * rb + 3 - 4, 0), 120) + 7, ntreal = klast - krow0 + 1, NT = (ntreal + 1) & ~1;
            attn::attn_unit<1>(PROJ + row0 * NPROJ + h * 64, NPROJ, nullptr, 0, PROJ + key0 * NPROJ + 512 + h * 64, NPROJ, nullptr, 0, PROJ + key0 * NPROJ + 1024 + h * 64, NPROJ,
                               ONA + row0 * 512 + h * 64, NT, krow0, ntreal, 4 * rb, args.in[I_RPB] + h * 15 * 31, (char*)lds);
        }
#endif
    }
    SEAM(4);
    if (IN(5)) for (int rep_ = 0; rep_ < NREP(5); ++rep_) {
        pg8::SchedMerge S{(const char*)ONA, (const char*)OMLA, (const char*)WNAT, (const char*)WMLAT, MTOK / 256, 4, G, bx};
        pg8::EpiMerge E{PROJ, MERGED};
        pg8::gemm_phase<pg8::EpiMerge, pg8::SchedMerge, true, false, false, true>(L, 16, 1024, 1024, S, E);
    }
    SEAM(5);
    if (IN(6)) for (int rep_ = 0; rep_ < NREP(6); ++rep_) {
        pg8::SchedDense S{(const char*)MERGED, (const char*)WOUTT, (size_t)256 * 1024 * 2, (size_t)256 * 1024 * 2, MTOK / 256, 4, G, bx};
        pg8::EpiBf16Y E{(bf16_t*)TMP};
        pg8::gemm_phase<pg8::EpiBf16Y, pg8::SchedDense, true, false, false>(L, 16, 2048, 2048, S, E);
    }
    SEAM(6);
    if (IN(7)) {
        LAS int* sel_e = (LAS int*)(L + TAB_OFF); LAS float* sel_g = (LAS float*)(L + TAB_OFF + 1024); LAS int* sel_r = (LAS int*)(L + TAB_OFF + 2048);
        LAS int* lcnt = (LAS int*)(L + TAB_OFF + 3072); LAS int* lbase = (LAS int*)(L + TAB_OFF + 3072 + 128);
        LAS float* wl = (LAS float*)L;
        const float* gpo = args.in[I_GAPOST]; const float* gfp = args.in[I_GFPRE]; const float* br = args.in[I_BR];
        const float* WRT = (const float*)(ws + WS_WRT);
        {   f32x4 t_[16];
#pragma unroll
            for (int q = 0; q < 16; ++q) t_[q] = *((const GAS f32x4*)WRT + q * (NWAVES * 64) + tid);
#pragma unroll
            for (int q = 0; q < 16; ++q) *((LAS f32x4*)wl + q * (NWAVES * 64) + tid) = t_[q]; }
        __syncthreads();
        for (int blk = vcu; blk < MTOK / 64; blk += G) {
            if (tid < 32) lcnt[tid] = 0;
            __syncthreads();
            f32x4 hreg[8][4];
#pragma unroll
            for (int rr = 0; rr < 8; ++rr) { const int m = blk * 64 + wave * 8 + rr, b = m >> 13;
                const GAS u32x2* yr = (const GAS u32x2*)((const bf16_t*)TMP + (size_t)m * DM) + lane; const GAS f32x4* xr = (const GAS f32x4*)(X + (size_t)m * DM) + lane;
                f32x4 y[4], x1[4]; float s = 0.f;
#pragma unroll
                for (int j = 0; j < 4; ++j) { const u32x2 yw = yr[64 * j]; y[j] = (f32x4){bf16_lo(yw.x), bf16_hi(yw.x), bf16_lo(yw.y), bf16_hi(yw.y)}; x1[j] = xr[64 * j]; s += (y[j].x * y[j].x + y[j].y * y[j].y) + (y[j].z * y[j].z + y[j].w * y[j].w); }
                const float rstd = __builtin_amdgcn_rsqf(wave_sum(s) * (1.f / DM) + RMS_EPS); float s2 = 0.f;
#pragma unroll
                for (int j = 0; j < 4; ++j) { const int col = 4 * lane + 256 * j;
                    const f32x4 gg = *(const f32x4*)(gpo + col), ga = *(const f32x4*)(MOD + b * 6144 + 2048 + col);
                    x1[j] = x1[j] + ga * (y[j] * rstd * gg);
                    { u32x2 xw; xw.x = cvt_pk_bf16(x1[j][0], x1[j][1]); xw.y = cvt_pk_bf16(x1[j][2], x1[j][3]); *((GAS u32x2*)(X1B + (size_t)m * DM) + lane + 64 * j) = xw; }
                    s2 += (x1[j].x * x1[j].x + x1[j].y * x1[j].y) + (x1[j].z * x1[j].z + x1[j].w * x1[j].w); }
                const float rstd2 = __builtin_amdgcn_rsqf(wave_sum(s2) * (1.f / DM) + RMS_EPS);
                GAS int* o4 = (GAS int*)((unsigned char*)XN + (size_t)m * DM) + lane;
#pragma unroll
                for (int j = 0; j < 4; ++j) { const int col = 4 * lane + 256 * j;
                    const f32x4 gg = *(const f32x4*)(gfp + col), sh = *(const f32x4*)(MOD + b * 6144 + 3072 + col), scl = *(const f32x4*)(MOD + b * 6144 + 4096 + col);
                    const f32x4 h = x1[j] * rstd2 * gg * (scl + 1.f) + sh;
                    int w = __builtin_amdgcn_cvt_pk_fp8_f32(h[0] * SC_H2, h[1] * SC_H2, 0, false); w = __builtin_amdgcn_cvt_pk_fp8_f32(h[2] * SC_H2, h[3] * SC_H2, w, true); o4[64 * j] = w;
                    hreg[rr][j] = h; }
            }
            const bool b5 = (lane & 32) != 0, b4 = (lane & 16) != 0, b3 = (lane & 8) != 0;
            float t0 = -3.0e38f, t1 = -3.0e38f, t2 = -3.0e38f, t3 = -3.0e38f; int i0 = 0, i1 = 0, i2 = 0, i3 = 0;
#pragma unroll 2
            for (int e = 0; e < NEXP; ++e) {
                f32x4 w[4];
#pragma unroll
                for (int j = 0; j < 4; ++j) w[j] = *(const LAS f32x4*)(wl + e * 1024 + 4 * lane + 256 * j);
                float p[8];
#pragma unroll
                for (int r = 0; r < 8; ++r) { f32x4 a = hreg[r][0] * w[0]; a += hreg[r][1] * w[1]; a += hreg[r][2] * w[2]; a += hreg[r][3] * w[3]; p[r] = (a.x + a.y) + (a.z + a.w); }
                float q[4], u[2];
#pragma unroll
                for (int i = 0; i < 4; ++i) { const auto r_ = __builtin_amdgcn_permlane32_swap(__float_as_uint(p[i]), __float_as_uint(p[i + 4]), false, false); q[i] = __uint_as_float(r_[0]) + __uint_as_float(r_[1]); }
#pragma unroll
                for (int i = 0; i < 2; ++i) { const auto r_ = __builtin_amdgcn_permlane16_swap(__float_as_uint(q[i]), __float_as_uint(q[i + 2]), false, false); u[i] = __uint_as_float(r_[0]) + __uint_as_float(r_[1]); }
                const float keep_ = b3 ? u[1] : u[0], send_ = b3 ? u[0] : u[1];
                float v = keep_ + __uint_as_float((unsigned)__builtin_amdgcn_update_dpp(0, (int)__float_as_uint(send_), 0x128  , 0xf, 0xf, false));
                v += __uint_as_float((unsigned)__builtin_amdgcn_update_dpp(0, (int)__float_as_uint(v), 0x141  , 0xf, 0xf, false));
                v += __uint_as_float((unsigned)__builtin_amdgcn_update_dpp(0, (int)__float_as_uint(v), 0x4E  , 0xf, 0xf, false));
                v += __uint_as_float((unsigned)__builtin_amdgcn_update_dpp(0, (int)__float_as_uint(v), 0xB1  , 0xf, 0xf, false));
                v += br[e];
                const bool c0 = v > t0, c1 = v > t1, c2 = v > t2, c3 = v > t3;
                t3 = c2 ? t2 : (c3 ? v : t3); i3 = c2 ? i2 : (c3 ? e : i3);
                t2 = c1 ? t1 : (c2 ? v : t2); i2 = c1 ? i1 : (c2 ? e : i2);
                t1 = c0 ? t0 : (c1 ? v : t1); i1 = c0 ? i0 : (c1 ? e : i1);
                t0 = c0 ? v : t0;             i0 = c0 ? e : i0;
            }
            {   const float e1 = __builtin_amdgcn_exp2f((t1 - t0) * LOG2E), e2 = __builtin_amdgcn_exp2f((t2 - t0) * LOG2E), e3 = __builtin_amdgcn_exp2f((t3 - t0) * LOG2E);
                const float inv = 1.f / (1.f + e1 + e2 + e3);
                const int lrow = wave * 8 + (b5 ? 4 : 0) + (b4 ? 2 : 0) + (b3 ? 1 : 0), t = lane & 7;
                if (t < 4) { const int ee = t == 0 ? i0 : t == 1 ? i1 : t == 2 ? i2 : i3;
                    const float gg = (t == 0 ? 1.f : t == 1 ? e1 : t == 2 ? e2 : e3) * inv;
                    const int rk = __hip_atomic_fetch_add(&lcnt[ee], 1, __ATOMIC_RELAXED, __HIP_MEMORY_SCOPE_WORKGROUP);
                    sel_e[lrow * 4 + t] = ee; sel_g[lrow * 4 + t] = gg; sel_r[lrow * 4 + t] = rk; } }
            __syncthreads();
            if (tid < 32) lbase[tid] = (int)atomicAdd(CNT + tid, (unsigned)lcnt[tid]);
            __syncthreads();
            if (tid < 256) { const int ee = sel_e[tid], pos = lbase[ee] + sel_r[tid], tok = blk * 64 + (tid >> 2);
                LIST[(size_t)ee * LISTCAP + pos] = (unsigned)tok; TOKPOS[(size_t)tok * 4 + (tid & 3)] = ((unsigned)ee << 16) | (unsigned)pos; TOKG[(size_t)tok * 4 + (tid & 3)] = sel_g[tid]; }
            __syncthreads();
        }
    }
    SEAM(7);
    if (IN(8) || IN(9)) {
        LAS int* blk_e = (LAS int*)(L + TAB_BLK); LAS int* eb0 = (LAS int*)(L + TAB_BLK + 1280); LAS int* ecnt = (LAS int*)(L + TAB_BLK + 1408);
        if (tid < 64) { const int c = (lane < NEXP) ? (int)__hip_atomic_load(CNT + lane, RLX_AGENT) : 0; const int n = (c + 255) >> 8; int incl = n;
#pragma unroll
            for (int o = 1; o < 64; o <<= 1) { const int t = __shfl_up(incl, o); if (lane >= o) incl += t; }
            const int start = incl - n;
            if (lane < NEXP) { eb0[lane] = start; ecnt[lane] = c; for (int i = 0; i < n; ++i) blk_e[start + i] = lane; }
            if (lane == 63) MISC[16] = (unsigned)incl; }
        __syncthreads();
        const int NB = (int)MISC[16];
        if (IN(8)) for (int rep_ = 0; rep_ < NREP(8); ++rep_) {
            for (int i = wave; i < 11; i += NWAVES) { const long Lu = (long)i * G + bx; if (Lu >= (long)NB * 8) break;
                const int grb = (int)(Lu >> 3), e = blk_e[grb], first = eb0[e], cnt = ecnt[e];
#pragma unroll
                for (int q = 0; q < 4; ++q) { const int r = q * 64 + lane, ri = (grb - first) * 256 + r; const unsigned tok = (ri < cnt) ? LIST[(size_t)e * LISTCAP + ri] : 0u;
                    *(LAS unsigned*)(L + TAB_GATH + i * 1024 + r * 4) = tok * 1024u; } }
            __syncthreads();
            pg8::SchedMoe<8, true> S{(const char*)XN, (const char*)W1T, (size_t)2048 * 1024, blk_e, NB, G, bx, TAB_GATH};
            pg8::EpiMoe1 E{args.in[I_B1], (unsigned char*)ACT};
            pg8::gemm_phase<pg8::EpiMoe1, pg8::SchedMoe<8, true>, true, true, true>(L, 8, 1024, 1024, S, E);
        }
        SEAM(8);
        if (IN(9)) for (int rep_ = 0; rep_ < NREP(9); ++rep_) {
            pg8::SchedMoe<4, false> S{(const char*)ACT, (const char*)W2T, (size_t)1024 * 1024, blk_e, NB, G, bx, 0};
            pg8::EpiMoe2 E{args.in[I_B2], (unsigned char*)YIT};
            pg8::gemm_phase<pg8::EpiMoe2, pg8::SchedMoe<4, false>, true, false, true>(L, 8, 1024, 1024, S, E);
        }
    }
    SEAM(9);
    if (IN(10)) {
        LAS int* rbase = (LAS int*)(L + 0);
        if (tid < 64) { const int c = (lane < NEXP) ? (int)__hip_atomic_load(CNT + lane, RLX_AGENT) : 0; const int n = (c + 255) >> 8; int incl = n;
#pragma unroll
            for (int o = 1; o < 64; o <<= 1) { const int t = __shfl_up(incl, o); if (lane >= o) incl += t; }
            if (lane < NEXP) rbase[lane] = (incl - n) * 256; }
        __syncthreads();
        const float* gfo = args.in[I_GFPOST];
        for (int m = gw; m < MTOK; m += NGW) { const int b = m >> 13;
            f32x4 y[4];
#pragma unroll
            for (int j = 0; j < 4; ++j) y[j] = (f32x4){0.f, 0.f, 0.f, 0.f};
#pragma unroll
            for (int t = 0; t < 4; ++t) { const unsigned tp = TOKPOS[(size_t)m * 4 + t]; const float gt = TOKG[(size_t)m * 4 + t];
                const size_t row = (size_t)rbase[tp >> 16] + (tp & 0xffffu); const GAS unsigned* yr = (const GAS unsigned*)((const unsigned char*)YIT + row * 1024) + lane; const float gs = gt * (1.f / SC_Y);
#pragma unroll
                for (int j = 0; j < 4; ++j) { const unsigned w = yr[64 * j]; const f32x2 lo = __builtin_amdgcn_cvt_pk_f32_fp8((int)w, false), hi2 = __builtin_amdgcn_cvt_pk_f32_fp8((int)w, true);
                    y[j][0] += gs * lo[0]; y[j][1] += gs * lo[1]; y[j][2] += gs * hi2[0]; y[j][3] += gs * hi2[1]; } }
            float s = 0.f;
#pragma unroll
            for (int j = 0; j < 4; ++j) s += (y[j].x * y[j].x + y[j].y * y[j].y) + (y[j].z * y[j].z + y[j].w * y[j].w);
            const float rstd = __builtin_amdgcn_rsqf(wave_sum(s) * (1.f / DM) + RMS_EPS);
            GAS f32x4* orow = (GAS f32x4*)(OUT + (size_t)m * DM) + lane; const GAS u32x2* xrow = (const GAS u32x2*)(X1B + (size_t)m * DM) + lane;
#pragma unroll
            for (int j = 0; j < 4; ++j) { const int col = 4 * lane + 256 * j;
                const f32x4 gg = *(const f32x4*)(gfo + col), gf = *(const f32x4*)(MOD + b * 6144 + 5120 + col);
                const u32x2 xw = xrow[64 * j]; const f32x4 x1 = {bf16_lo(xw.x), bf16_hi(xw.x), bf16_lo(xw.y), bf16_hi(xw.y)};
                orow[64 * j] = x1 + gf * (y[j] * rstd * gg); } }
    }
#undef IN
#undef SEAM
#undef args
}

constexpr int N_PHASES = 11;
extern "C" void kernel_launch(void* const* d_in, const int* in_sizes, int n_in, void* d_out, int out_size, void* d_ws, size_t ws_size, hipStream_t stream) {
    static int grid = 0;
    if (grid == 0) {
        if (n_in != 24 || out_size != MTOK * DM || ws_size < WS_END) { fprintf(stderr, "kernel_launch: unexpected shapes (n_in %d out %d ws %zu)\n", n_in, out_size, ws_size); grid = -1; return; }
        int dev = 0, cus = 0, per_cu = 0;
        if (hipGetDevice(&dev) != hipSuccess || hipDeviceGetAttribute(&cus, hipDeviceAttributeMultiprocessorCount, dev) != hipSuccess) { grid = -1; return; }
        if (hipFuncSetAttribute((const void*)fwd_kernel, hipFuncAttributeMaxDynamicSharedMemorySize, LDS_BYTES) != hipSuccess) { fprintf(stderr, "kernel_launch: hipFuncSetAttribute failed\n"); grid = -1; return; }
        if (hipOccupancyMaxActiveBlocksPerMultiprocessor(&per_cu, (const void*)fwd_kernel, NWAVES * 64, LDS_BYTES) != hipSuccess || per_cu < 1) { fprintf(stderr, "kernel_launch: occupancy query says %d\n", per_cu); per_cu = 1; }
        (void)hipGetLastError();
        grid = cus;
    }
    if (grid < 0) return;
    (void)hipMemsetAsync((char*)d_ws + WS_CTL + 16384, 0, 32768, stream);
    Args a{};
    for (int i = 0; i < 24; ++i) a.in[i] = (const float*)d_in[i];
    a.out = (float*)d_out; a.ws = (unsigned char*)d_ws;
#if MK_N_LAUNCHES == 1
    a.ph_lo = 0; a.ph_hi = N_PHASES;
    {   void* kargs[] = {(void*)&a};
        const hipError_t ce = hipLaunchCooperativeKernel((const void*)fwd_kernel, dim3(grid), dim3(NWAVES * 64), kargs, LDS_BYTES, stream);
        if (ce != hipSuccess) fprintf(stderr, "kernel_launch: cooperative launch failed: %s (grid %d)\n", hipGetErrorName(ce), grid); }
#else
    for (int p = 0; p < N_PHASES; ++p) { a.ph_lo = p; a.ph_hi = p + 1; hipLaunchKernelGGL(fwd_kernel, dim3(grid), dim3(NWAVES * 64), LDS_BYTES, stream, a); }
#endif
    const hipError_t le = hipPeekAtLastError();
    if (le != hipSuccess) fprintf(stderr, "kernel_launch: launch failed: %s\n", hipGetErrorName(le));
}
```

```cpp
#include <hip/hip_runtime.h>
#include <hip/hip_bf16.h>
#include <cstdio>
#include <cstdint>

#ifndef MK_N_LAUNCHES
#define MK_N_LAUNCHES 1
#endif

constexpr int BATCH = 2, SEQ = 8192, DM = 1024, MTOK = BATCH * SEQ;
constexpr int NPROJ = 4352;
constexpr int NEXP = 32, DFF = 1024, TOPK = 4;
constexpr int QLORA = 384, KVLORA = 256;
constexpr float RMS_EPS = 1e-6f;
constexpr float LOG2E = 1.4426950408889634f;
constexpr float C2NA = 0.125f * LOG2E;
constexpr float C2MLA = 0.10206207261596575f * LOG2E;
constexpr float SC_H2 = 8.f, SC_W = 64.f, SC_ACT = 4.f, SC_Y = 32.f;
constexpr int NG_INPROJ = 168;
constexpr int LISTCAP = 16384;
constexpr int MAXROWS = 65536 + NEXP * 256;

#define GAS __attribute__((address_space(1)))
#define LAS __attribute__((address_space(3)))
typedef unsigned short bf16_t;
typedef short bf16x8 __attribute__((ext_vector_type(8)));
typedef short s16x4 __attribute__((ext_vector_type(4)));
typedef float f32x4 __attribute__((ext_vector_type(4)));
typedef float f32x2 __attribute__((ext_vector_type(2)));
typedef float f32x16 __attribute__((ext_vector_type(16)));
typedef unsigned u32x4 __attribute__((ext_vector_type(4)));
typedef unsigned u32x2 __attribute__((ext_vector_type(2)));
typedef GAS unsigned gu32;

__device__ __forceinline__ unsigned cvt_pk_bf16(float lo, float hi) { unsigned r; asm volatile("v_cvt_pk_bf16_f32 %0, %1, %2" : "=v"(r) : "v"(lo), "v"(hi)); return r; }
__device__ __forceinline__ float bf16_lo(unsigned w) { return __uint_as_float(w << 16); }
__device__ __forceinline__ float bf16_hi(unsigned w) { return __uint_as_float(w & 0xffff0000u); }
__device__ __forceinline__ float sigmoidf_(float z) { return __builtin_amdgcn_rcpf(1.f + __builtin_amdgcn_exp2f(-z * LOG2E)); }
__device__ __forceinline__ float wave_sum(float v) {
#pragma unroll
    for (int o = 1; o < 64; o <<= 1) v += __shfl_xor(v, o);
    return v;
}
__device__ __forceinline__ void rope_cs(float pos, int j, float& c, float& s) {
    const float inv = __builtin_amdgcn_exp2f(-(float)j * 0.83048202372184059f);
    const float rev = __builtin_amdgcn_fractf(pos * inv * 0.15915494309189535f);
    c = __builtin_amdgcn_cosf(rev); s = __builtin_amdgcn_sinf(rev);
}

namespace pg8 {
constexpr int BM = 256, BK = 64, HALF = 128, HTB = HALF * BK * 2, STAGE_BYTES = 8 * HTB, NXCD = 8, WGM = 8;
__host__ __device__ __forceinline__ int lds_byte(int r, int c) { const int st = (r >> 4) * 2 + (c >> 5), rr = r & 15, cc = c & 31, ob = rr * 64 + cc * 2; return st * 1024 + (ob ^ (((ob >> 9) & 1) << 5)); }
__host__ __device__ __forceinline__ void stage_rc(int b, int& R, int& C) { const int st = b / 1024, sb = b % 1024, swz = sb ^ (((sb >> 9) & 1) << 5); R = (st >> 1) * 16 + swz / 64; C = (st & 1) * 32 + (swz % 64) / 2; }
__host__ __device__ __forceinline__ int perm32(int rho) { const int n = rho >> 4, i = rho & 15; return 8 * (i >> 2) + 4 * n + (i & 3); }

struct Unit { const char* A; const char* B; const char* A2; const char* B2; int pm, pn, aux, tab; };

__device__ __forceinline__ void tile_of(int wgid, int nM, int nN, int& pm, int& pn) {
    const int nwg = nM * nN;
    { const int q = nwg / NXCD, r = nwg % NXCD, xcd = wgid % NXCD, off = wgid / NXCD; wgid = (xcd < r ? xcd * (q + 1) : r * (q + 1) + (xcd - r) * q) + off; }
    const int nig = WGM * nN, gid = wgid / nig, fm = gid * WGM, gsz = (nM - fm) < WGM ? (nM - fm) : WGM;
    pm = fm + ((wgid % nig) % gsz); pn = (wgid % nig) / gsz;
}

typedef int v8i32 __attribute__((ext_vector_type(8)));
typedef int v4i32_ __attribute__((ext_vector_type(4)));
template <class Epi, class Sched, bool ALIGN_EPI, bool GATHER, bool FP8, bool DUAL = false, bool PUB = false>
__device__ __forceinline__ void gemm_phase(LAS unsigned char* lds, const int nt, const int ldab, const int ldbb, const Sched& S, const Epi& E) {
    const int tid = threadIdx.x, wid = __builtin_amdgcn_readfirstlane(tid >> 6), lane = tid & 63, wr = wid >> 2, wc = wid & 3, fr = lane & 15, fq = lane >> 4;
    int Rr[2], Cc[2];
    unsigned voffA[2], voffB[2];
#pragma unroll
    for (int i = 0; i < 2; ++i) { int R, C; stage_rc(tid * 16 + i * 8192, R, C); const int Rb = Epi::PERM ? ((R & ~31) + perm32(R & 31)) : R;
        Rr[i] = R; Cc[i] = C; voffA[i] = (unsigned)(R * ldab + C * 2); voffB[i] = (unsigned)(Rb * ldbb + C * 2); }
    const size_t kstep = (size_t)(BK * 2);
    const size_t hstepA = (size_t)HALF * ldab, hstepB = (size_t)HALF * ldbb;
    const unsigned ldsw = (unsigned)wid * 1024u;
    const int aoff = lds_byte(wr * 64 + fr, fq * 8), boff = lds_byte(wc * 32 + fr, fq * 8);
#define PG8_SA(b, h) (((b) * 2 + (h)) * HTB)
#define PG8_SB(b, h) ((4 + (b) * 2 + (h)) * HTB)
#define PG8_STAGE(bufoff, gbase, voff) do { _Pragma("unroll") for (int _i = 0; _i < 2; ++_i) \
        __builtin_amdgcn_global_load_lds((const unsigned*)((const char*)(gbase) + (voff)[_i]), (LAS unsigned*)(lds + (bufoff) + ldsw + _i * 8192), 16, 0, 0); } while (0)
#define PG8_STAGE_A(bufoff, gbase, h, G) do { if constexpr (GATHER) { PG8_STAGE(bufoff, gbase, (G)[h]); } else { PG8_STAGE(bufoff, (gbase) + (h) * hstepA, voffA); } } while (0)
#define PG8_STAGE_B(bufoff, gbase, h) PG8_STAGE(bufoff, (gbase) + (h) * hstepB, voffB)
#define PG8_LD8(addr) __builtin_shufflevector(*(const LAS v4i32_*)(addr), *(const LAS v4i32_*)((addr) + 1024), 0, 1, 2, 3, 4, 5, 6, 7)
#define PG8_LDA(dst, b, h) do { if constexpr (FP8) { _Pragma("unroll") for (int m = 0; m < 4; ++m) dst##8[m] = PG8_LD8(lds + PG8_SA(b, h) + aoff + m * 2048); } \
        else { _Pragma("unroll") for (int m = 0; m < 4; ++m) _Pragma("unroll") for (int k = 0; k < 2; ++k) dst[m][k] = *(const LAS bf16x8*)(lds + PG8_SA(b, h) + aoff + m * 2048 + k * 1024); } } while (0)
#define PG8_LDB(dst, b, h) do { if constexpr (FP8) { _Pragma("unroll") for (int n = 0; n < 2; ++n) dst##8[n] = PG8_LD8(lds + PG8_SB(b, h) + boff + n * 2048); } \
        else { _Pragma("unroll") for (int n = 0; n < 2; ++n) _Pragma("unroll") for (int k = 0; k < 2; ++k) dst[n][k] = *(const LAS bf16x8*)(lds + PG8_SB(b, h) + boff + n * 2048 + k * 1024); } } while (0)
#define PG8_MMA(ai, bj, At, Bt) do { __builtin_amdgcn_s_setprio(1); _Pragma("unroll") for (int m = 0; m < 4; ++m) _Pragma("unroll") for (int n = 0; n < 2; ++n) { \
        if constexpr (FP8) { asm volatile("v_mfma_scale_f32_16x16x128_f8f6f4 %0, %1, %2, %0, %3, %3 op_sel_hi:[0,0,0]" : "+v"(acc[ai][bj][m][n]) : "v"(Bt##8[n]), "v"(At##8[m]), "v"(sc1_)); } \
        else { _Pragma("unroll") for (int k = 0; k < 2; ++k) acc[ai][bj][m][n] = __builtin_amdgcn_mfma_f32_16x16x32_bf16(Bt[n][k], At[m][k], acc[ai][bj][m][n], 0, 0, 0); } } \
        __builtin_amdgcn_s_setprio(0); } while (0)
#define PG8_WAIT_V(n) asm volatile("s_waitcnt vmcnt(" #n ")" ::: "memory")
#define PG8_WAIT_L(n) asm volatile("s_waitcnt lgkmcnt(" #n ")" ::: "memory")
#define PG8_BAR __builtin_amdgcn_s_barrier()
#define PG8_SCHED __builtin_amdgcn_sched_barrier(0)
    Unit cur, nxt; int ui = 0;
    if (!S.next(0, cur)) return;
    f32x4 acc[2][2][4][2];
#pragma unroll
    for (int a = 0; a < 2; ++a)
#pragma unroll
        for (int b = 0; b < 2; ++b)
#pragma unroll
            for (int m = 0; m < 4; ++m)
#pragma unroll
                for (int n = 0; n < 2; ++n) acc[a][b][m][n] = (f32x4){0.f, 0.f, 0.f, 0.f};
    bf16x8 At[4][2], B0[2][2], B1[2][2]; v8i32 At8[4], B08[2], B18[2];
    int sc1_ = 0x7F7F7F7F; asm volatile("" : "+v"(sc1_));
    unsigned gC[2][2], gN[2][2];
#define PG8_GLOAD(G, u) do { if constexpr (GATHER) { const LAS unsigned* tb_ = (const LAS unsigned*)(lds + (u).tab); _Pragma("unroll") for (int h_ = 0; h_ < 2; ++h_) _Pragma("unroll") for (int i_ = 0; i_ < 2; ++i_) \
        (G)[h_][i_] = tb_[h_ * 128 + Rr[i_]] + (unsigned)(Cc[i_] * 2); } } while (0)
    PG8_GLOAD(gC, cur);
    const char* cA = cur.A; const char* cB = cur.B; const char* cA2 = cur.A2; const char* cB2 = cur.B2; const int nth = nt >> 1;
    PG8_STAGE_B(PG8_SB(0, 0), cB, 0); PG8_STAGE_B(PG8_SB(0, 1), cB, 1); PG8_STAGE_A(PG8_SA(0, 0), cA, 0, gC); PG8_STAGE_A(PG8_SA(0, 1), cA, 1, gC);
    if (wr == 1) PG8_BAR;
    PG8_WAIT_V(2); PG8_BAR;
    PG8_STAGE_B(PG8_SB(1, 0), cB + kstep, 0); PG8_STAGE_A(PG8_SA(1, 0), cA + kstep, 0, gC); PG8_STAGE_B(PG8_SB(1, 1), cB + kstep, 1);
    PG8_WAIT_V(6); PG8_BAR;
    for (;;) {
        const bool has_next = S.next(ui + 1, nxt);
        const char* nA = has_next ? nxt.A : cA; const char* nB = has_next ? nxt.B : cB;
        if constexpr (GATHER) { if (has_next) { PG8_GLOAD(gN, nxt); } else {
#pragma unroll
            for (int h_ = 0; h_ < 2; ++h_)
#pragma unroll
                for (int i_ = 0; i_ < 2; ++i_) gN[h_][i_] = gC[h_][i_]; } }
#pragma unroll 1
        for (int t = 0; t < nt; t += 2) {
            const bool last = (t == nt - 2);
            if constexpr (DUAL) { if (t == nth) { if (wr == 0) PG8_BAR; E.mid(acc, cur, wr, wc, fr, fq); if (wr == 1) PG8_BAR; } }
#define PG8_TILEA(tt) (((DUAL && (tt) >= nth) ? cA2 - (size_t)nth * kstep : cA) + (size_t)(tt) * kstep)
#define PG8_TILEB(tt) (((DUAL && (tt) >= nth) ? cB2 - (size_t)nth * kstep : cB) + (size_t)(tt) * kstep)
            const char* a1 = PG8_TILEA(t + 1);
            const char* a2 = last ? nA : PG8_TILEA(t + 2); const char* b2 = last ? nB : PG8_TILEB(t + 2);
            const char* a3 = a2 + kstep; const char* b3 = b2 + kstep;
            unsigned g2[2][2];
            if constexpr (GATHER) {
#pragma unroll
                for (int h_ = 0; h_ < 2; ++h_)
#pragma unroll
                    for (int i_ = 0; i_ < 2; ++i_) g2[h_][i_] = last ? gN[h_][i_] : gC[h_][i_]; }
            PG8_LDB(B0, 0, 0); PG8_LDB(B1, 0, 1); PG8_SCHED; PG8_LDA(At, 0, 0); PG8_STAGE_A(PG8_SA(1, 1), a1, 1, gC);
            PG8_WAIT_V(8); PG8_WAIT_L(0); PG8_BAR; PG8_MMA(0, 0, At, B0); PG8_MMA(0, 1, At, B1); PG8_BAR; PG8_SCHED;
            PG8_LDA(At, 0, 1); PG8_STAGE_B(PG8_SB(0, 0), b2, 0); PG8_STAGE_B(PG8_SB(0, 1), b2, 1); PG8_STAGE_A(PG8_SA(0, 0), a2, 0, g2);
            PG8_WAIT_V(8); PG8_WAIT_L(0); PG8_BAR; PG8_MMA(1, 0, At, B0); PG8_MMA(1, 1, At, B1); PG8_BAR; PG8_SCHED;
            PG8_LDB(B0, 1, 0); PG8_LDB(B1, 1, 1); PG8_SCHED; PG8_LDA(At, 1, 0); PG8_STAGE_A(PG8_SA(0, 1), a2, 1, g2);
            PG8_WAIT_V(8); PG8_WAIT_L(0); PG8_BAR; PG8_MMA(0, 0, At, B0); PG8_MMA(0, 1, At, B1); PG8_BAR; PG8_SCHED;
            PG8_LDA(At, 1, 1); PG8_STAGE_B(PG8_SB(1, 0), b3, 0); PG8_STAGE_B(PG8_SB(1, 1), b3, 1); PG8_STAGE_A(PG8_SA(1, 0), a3, 0, g2);
            PG8_WAIT_V(8); PG8_WAIT_L(0); PG8_BAR; PG8_MMA(1, 0, At, B0); PG8_MMA(1, 1, At, B1); PG8_BAR; PG8_SCHED;
        }
        if constexpr (ALIGN_EPI) { if (wr == 0) PG8_BAR; }
        if constexpr (FP8) asm volatile("s_nop 15\n\ts_nop 15" ::: "memory");
        E(acc, cur, wr, wc, fr, fq);
        if constexpr (PUB) { unsigned* pc_ = S.pub(ui, cur);
            if (pc_ != nullptr) { asm volatile("s_waitcnt vmcnt(0)" ::: "memory"); PG8_BAR;
                if (tid == 0) { __builtin_amdgcn_fence(__ATOMIC_RELEASE, "agent"); asm volatile("s_waitcnt vmcnt(0)" ::: "memory"); (void)__hip_atomic_fetch_add(pc_, 1u, __ATOMIC_RELAXED, __HIP_MEMORY_SCOPE_AGENT); } } }
        if (!has_next) break;
#pragma unroll
        for (int a = 0; a < 2; ++a)
#pragma unroll
            for (int b = 0; b < 2; ++b)
#pragma unroll
                for (int m = 0; m < 4; ++m)
#pragma unroll
                    for (int n = 0; n < 2; ++n) acc[a][b][m][n] = (f32x4){0.f, 0.f, 0.f, 0.f};
        cur = nxt; cA = nA; cB = nB; cA2 = cur.A2; cB2 = cur.B2; ++ui;
        if constexpr (GATHER) {
#pragma unroll
            for (int h_ = 0; h_ < 2; ++h_)
#pragma unroll
                for (int i_ = 0; i_ < 2; ++i_) gC[h_][i_] = gN[h_][i_]; }
        if constexpr (ALIGN_EPI) { if (wr == 1) PG8_BAR; }
    }
    PG8_WAIT_V(0);
    if constexpr (!ALIGN_EPI) { if (wr == 0) PG8_BAR; }
    PG8_BAR;
#undef PG8_SA
#undef PG8_SB
#undef PG8_STAGE
#undef PG8_STAGE_A
#undef PG8_STAGE_B
#undef PG8_LDA
#undef PG8_LD8
#undef PG8_LDB
#undef PG8_MMA
#undef PG8_WAIT_V
#undef PG8_WAIT_L
#undef PG8_BAR
#undef PG8_SCHED
#undef PG8_GLOAD
#undef PG8_TILEA
#undef PG8_TILEB
}

typedef f32x4 Acc[2][2][4][2];

struct SchedDense {
    const char* A; const char* B; size_t a_tile_bytes, b_tile_bytes; int nM, nN, G, c;
    __device__ __forceinline__ bool next(int i, Unit& u) const {
        const long L = (long)i * G + c; if (L >= (long)nM * nN) return false;
        int pm, pn; tile_of((int)L, nM, nN, pm, pn);
        u.pm = pm; u.pn = pn; u.aux = 0; u.tab = 0; u.A = A + (size_t)pm * a_tile_bytes; u.B = B + (size_t)pn * b_tile_bytes; u.A2 = u.A; u.B2 = u.B; return true;
    }
};
struct SchedMerge {
    const char* A0; const char* A1; const char* B0; const char* B1; int nM, nN, G, c;
    __device__ __forceinline__ bool next(int i, Unit& u) const {
        const long T = (long)i * G + c; if (T >= (long)nM * nN) return false;
        int pm, pn; tile_of((int)T, nM, nN, pm, pn);
        u.pm = pm; u.pn = pn; u.aux = 0; u.tab = 0;
        u.A = A0 + (size_t)pm * (256 * 512 * 2); u.B = B0 + (size_t)pn * (256 * 512 * 2); u.A2 = A1 + (size_t)pm * (256 * 512 * 2); u.B2 = B1 + (size_t)pn * (256 * 512 * 2); return true;
    }
};
template <int NPN, bool GATHER>
struct SchedMoe {
    const char* A; const char* B; size_t b_expert_bytes; LAS const int* blk_e; int NB, G, c, tab0;
    int gx0, nmove; unsigned* pubc;
    const char* A2e; const char* B2e; int r0;
    __device__ __forceinline__ bool next(int i, Unit& u) const {
        const long L = (long)i * G + c;
        if ((GATHER || G != 256) && L >= (long)(GATHER ? NB : NB - nmove) * NPN) {
            if constexpr (GATHER) {
                const int j = c - r0;
                if (nmove > 0 && j >= 0 && j < nmove * 4 && L < (long)NB * NPN + G) {
                    const int grb = gx0 + (j >> 2), e = __builtin_amdgcn_readfirstlane(blk_e[grb]);
                    if (threadIdx.x == 0) { unsigned sp = 0; while (__hip_atomic_load(pubc + grb, __ATOMIC_RELAXED, __HIP_MEMORY_SCOPE_AGENT) < 8u && ++sp < (1u << 22)) __builtin_amdgcn_s_sleep(2);
                        __builtin_amdgcn_fence(__ATOMIC_ACQUIRE, "agent"); asm volatile("s_waitcnt vmcnt(0)" ::: "memory"); }
                    u.pm = grb; u.pn = j & 3; u.aux = e | 0x100; u.tab = tab0 + i * 1024; u.A = A2e; u.B = B2e + (size_t)e * (1024 * 1024) + (size_t)(j & 3) * (256 * 1024); u.A2 = u.A; u.B2 = u.B; return true; } }
            return false; }
        int grb = (int)(L / NPN); int pn = (int)(L % NPN);
        if constexpr (!GATHER) {
            if (G == 256) { const int x_ = c & 7, k_ = c >> 3; grb = i * 64 + x_ * 8 + (k_ >> 2); pn = k_ & 3; if (grb >= NB - nmove) return false; }
            if (grb >= gx0) grb += nmove; }
        const int e = __builtin_amdgcn_readfirstlane(blk_e[grb]);
        u.pm = grb; u.pn = pn; u.aux = e; u.tab = tab0 + i * 1024;
        u.A = GATHER ? A : A + (size_t)grb * (256 * 1024);
        u.B = B + (size_t)e * b_expert_bytes + (size_t)pn * (256 * 1024); u.A2 = u.A; u.B2 = u.B; return true;
    }
    __device__ __forceinline__ unsigned* pub(int ui, const Unit& u) const { return (ui == 0 && u.pm >= gx0 && u.pm < gx0 + nmove && !(u.aux & 0x100)) ? pubc + u.pm : nullptr; }
};
struct SchedOne {
    const char* A; const char* B; int grb, pn, e;
    __device__ __forceinline__ bool next(int i, Unit& u) const { if (i != 0) return false;
        u.pm = grb; u.pn = pn; u.aux = e; u.tab = 0; u.A = A + (size_t)grb * (256 * 1024); u.B = B + (size_t)e * (1024 * 1024) + (size_t)pn * (256 * 1024); u.A2 = u.A; u.B2 = u.B; return true; }
};


struct EpiInProj {
    static constexpr bool PERM = true;
    bf16_t* PROJ; float* SSQ; bf16_t* KR; const float* ROPE; const float* bgate;
    __device__ __forceinline__ void operator()(const Acc& acc, const Unit& u, int wr, int wc, int fr, int fq) const {
        const int pn = u.pn, row0 = u.pm * BM + wr * 64 + fr, colb = pn * BM + wc * 32 + 8 * fq;
        const float sc = (pn < 2) ? C2NA : 1.f;
        f32x4 gb[2][2];
#pragma unroll
        for (int bj = 0; bj < 2; ++bj)
#pragma unroll
            for (int n = 0; n < 2; ++n) gb[bj][n] = (pn >= 9) ? *(const f32x4*)(bgate + (colb - 2304) + bj * HALF + 4 * n) : (f32x4){0.f, 0.f, 0.f, 0.f};
#pragma unroll
        for (int ai = 0; ai < 2; ++ai)
#pragma unroll
            for (int m = 0; m < 4; ++m) { const int row = row0 + ai * HALF + m * 16; bf16_t* rowp = PROJ + (size_t)row * NPROJ + colb;
#pragma unroll
                for (int bj = 0; bj < 2; ++bj) { const f32x4 v0 = acc[ai][bj][m][0] * sc + gb[bj][0], v1 = acc[ai][bj][m][1] * sc + gb[bj][1]; u32x4 w;
                    w.x = cvt_pk_bf16(v0[0], v0[1]); w.y = cvt_pk_bf16(v0[2], v0[3]); w.z = cvt_pk_bf16(v1[0], v1[1]); w.w = cvt_pk_bf16(v1[2], v1[3]);
                    *(u32x4*)(rowp + bj * HALF) = w; } }
        if (pn >= 6 && pn <= 8) {
#pragma unroll
            for (int ai = 0; ai < 2; ++ai)
#pragma unroll
                for (int m = 0; m < 4; ++m) { const int row = row0 + ai * HALF + m * 16; float s[2];
#pragma unroll
                    for (int bj = 0; bj < 2; ++bj) { const f32x4 a = acc[ai][bj][m][0], b = acc[ai][bj][m][1];
                        float t = (a[0] * a[0] + a[1] * a[1]) + (a[2] * a[2] + a[3] * a[3]) + (b[0] * b[0] + b[1] * b[1]) + (b[2] * b[2] + b[3] * b[3]);
                        t += __shfl_xor(t, 16); t += __shfl_xor(t, 32); s[bj] = t; }
                    if (fq == 0) {
                        float* sp = SSQ + (size_t)row * 16 + wc;
                        if (pn == 6) { sp[0] = s[0] + s[1]; }
                        else if (pn == 7) { sp[4] = s[0]; sp[8] = s[1]; }
                        else { sp[12] = s[0]; }
                    } }
            if (pn == 8 && wc == 0) {
#pragma unroll
                for (int ai = 0; ai < 2; ++ai)
#pragma unroll
                    for (int m = 0; m < 4; ++m) { const int row = row0 + ai * HALF + m * 16, tok = row & (SEQ - 1);
                        const int pos = (fq >> 1) ? (tok & 63) : (tok >> 6); float o[8];
                        const f32x4 cs4 = *(const f32x4*)(ROPE + pos * 16 + 4 * (fq & 1)), sn4 = *(const f32x4*)(ROPE + pos * 16 + 8 + 4 * (fq & 1));
#pragma unroll
                        for (int n = 0; n < 2; ++n)
#pragma unroll
                            for (int q = 0; q < 2; ++q) { const float c = cs4[2 * n + q], s = sn4[2 * n + q];
                                const float x1 = acc[ai][1][m][n][2 * q], x2 = acc[ai][1][m][n][2 * q + 1];
                                o[4 * n + 2 * q] = x1 * c - x2 * s; o[4 * n + 2 * q + 1] = x1 * s + x2 * c; }
                        u32x4 w; w.x = cvt_pk_bf16(o[0], o[1]); w.y = cvt_pk_bf16(o[2], o[3]); w.z = cvt_pk_bf16(o[4], o[5]); w.w = cvt_pk_bf16(o[6], o[7]);
                        *(u32x4*)(KR + (size_t)row * 32 + 8 * fq) = w; }
            }
        }
    }
};
struct EpiQUp {
    static constexpr bool PERM = true;
    bf16_t* QN; bf16_t* QR; const float* SSQ; const float* ROPE;
    __device__ __forceinline__ void operator()(const Acc& acc, const Unit& u, int wr, int wc, int fr, int fq) const {
        const int pn = u.pn, row0 = u.pm * BM + wr * 64 + fr, colt = wc * 32 + 8 * fq;
#pragma unroll
        for (int ai = 0; ai < 2; ++ai)
#pragma unroll
            for (int m = 0; m < 4; ++m) { const int row = row0 + ai * HALF + m * 16;
                const f32x4 q0_ = *(const f32x4*)(SSQ + (size_t)row * 16), q1_ = *(const f32x4*)(SSQ + (size_t)row * 16 + 4);
                const float rs = __builtin_amdgcn_rsqf((((q0_[0] + q0_[1]) + (q0_[2] + q0_[3])) + ((q1_[0] + q1_[1]) + (q1_[2] + q1_[3]))) * (1.f / QLORA) + RMS_EPS) * C2MLA;
                if (pn < 2) {
#pragma unroll
                    for (int bj = 0; bj < 2; ++bj) { const f32x4 v0 = acc[ai][bj][m][0] * rs, v1 = acc[ai][bj][m][1] * rs; u32x4 w;
                        w.x = cvt_pk_bf16(v0[0], v0[1]); w.y = cvt_pk_bf16(v0[2], v0[3]); w.z = cvt_pk_bf16(v1[0], v1[1]); w.w = cvt_pk_bf16(v1[2], v1[3]);
                        *(u32x4*)(QN + (size_t)row * 512 + pn * 256 + bj * HALF + colt) = w; }
                } else {
                    const int tok = row & (SEQ - 1); const int pos = (fq >> 1) ? (tok & 63) : (tok >> 6);
                    const f32x4 cs4 = *(const f32x4*)(ROPE + pos * 16 + 4 * (fq & 1)), sn4 = *(const f32x4*)(ROPE + pos * 16 + 8 + 4 * (fq & 1));
#pragma unroll
                    for (int bj = 0; bj < 2; ++bj) { float o[8];
#pragma unroll
                        for (int n = 0; n < 2; ++n)
#pragma unroll
                            for (int q = 0; q < 2; ++q) { const float c = cs4[2 * n + q], s = sn4[2 * n + q];
                                const float x1 = acc[ai][bj][m][n][2 * q] * rs, x2 = acc[ai][bj][m][n][2 * q + 1] * rs;
                                o[4 * n + 2 * q] = x1 * c - x2 * s; o[4 * n + 2 * q + 1] = x1 * s + x2 * c; }
                        u32x4 w; w.x = cvt_pk_bf16(o[0], o[1]); w.y = cvt_pk_bf16(o[2], o[3]); w.z = cvt_pk_bf16(o[4], o[5]); w.w = cvt_pk_bf16(o[6], o[7]);
                        *(u32x4*)(QR + (size_t)row * 256 + bj * HALF + colt) = w; }
                }
                asm volatile("" ::: "memory"); }
    }
};
struct EpiKVUp {
    static constexpr bool PERM = true;
    bf16_t* KN; bf16_t* VM; const float* SSQ;
    __device__ __forceinline__ void operator()(const Acc& acc, const Unit& u, int wr, int wc, int fr, int fq) const {
        const int pn = u.pn, row0 = u.pm * BM + wr * 64 + fr, colt = wc * 32 + 8 * fq;
        bf16_t* dst = (pn < 2) ? KN + pn * 256 : VM + (pn - 2) * 256;
#pragma unroll
        for (int ai = 0; ai < 2; ++ai)
#pragma unroll
            for (int m = 0; m < 4; ++m) { const int row = row0 + ai * HALF + m * 16;
                const f32x4 q0_ = *(const f32x4*)(SSQ + (size_t)row * 16 + 8), q1_ = *(const f32x4*)(SSQ + (size_t)row * 16 + 12);
                const float rs = __builtin_amdgcn_rsqf((((q0_[0] + q0_[1]) + (q0_[2] + q0_[3])) + ((q1_[0] + q1_[1]) + (q1_[2] + q1_[3]))) * (1.f / KVLORA) + RMS_EPS);
#pragma unroll
                for (int bj = 0; bj < 2; ++bj) { const f32x4 v0 = acc[ai][bj][m][0] * rs, v1 = acc[ai][bj][m][1] * rs; u32x4 w;
                    w.x = cvt_pk_bf16(v0[0], v0[1]); w.y = cvt_pk_bf16(v0[2], v0[3]); w.z = cvt_pk_bf16(v1[0], v1[1]); w.w = cvt_pk_bf16(v1[2], v1[3]);
                    *(u32x4*)(dst + (size_t)row * 512 + bj * HALF + colt) = w; } }
    }
};
struct EpiMerge {
    static constexpr bool PERM = true;
    const bf16_t* PROJ; bf16_t* MERGED;
    __device__ __forceinline__ void mid(Acc& acc, const Unit& u, int wr, int wc, int fr, int fq) const {
        int row0 = u.pm * BM + wr * 64 + fr; const int col0 = u.pn * BM + wc * 32 + 8 * fq;
        asm volatile("" : "+v"(row0));
#pragma unroll
        for (int ai = 0; ai < 2; ++ai)
#pragma unroll
            for (int m = 0; m < 4; ++m) { const bf16_t* rp = PROJ + (size_t)(row0 + ai * HALF + m * 16) * NPROJ + 2304 + col0;
#pragma unroll
                for (int bj = 0; bj < 2; ++bj) { const u32x4 g1 = *(const u32x4*)(rp + bj * HALF), g2 = *(const u32x4*)(rp + 1024 + bj * HALF);
                    const unsigned w1[4] = {g1.x, g1.y, g1.z, g1.w}, w2[4] = {g2.x, g2.y, g2.z, g2.w};
#pragma unroll
                    for (int q = 0; q < 4; ++q) { const int n = q >> 1, i = (q & 1) * 2;
                        const float r0 = (1.f + __builtin_amdgcn_exp2f(-bf16_lo(w2[q]) * LOG2E)) * __builtin_amdgcn_rcpf(1.f + __builtin_amdgcn_exp2f(-bf16_lo(w1[q]) * LOG2E));
                        const float r1 = (1.f + __builtin_amdgcn_exp2f(-bf16_hi(w2[q]) * LOG2E)) * __builtin_amdgcn_rcpf(1.f + __builtin_amdgcn_exp2f(-bf16_hi(w1[q]) * LOG2E));
                        acc[ai][bj][m][n][i] *= r0; acc[ai][bj][m][n][i + 1] *= r1; } }
                asm volatile("" ::: "memory"); }
    }
    __device__ __forceinline__ void operator()(const Acc& acc, const Unit& u, int wr, int wc, int fr, int fq) const {
        const int row0 = u.pm * BM + wr * 64 + fr, col0 = u.pn * BM + wc * 32 + 8 * fq;
#pragma unroll
        for (int ai = 0; ai < 2; ++ai)
#pragma unroll
            for (int m = 0; m < 4; ++m) { const int row = row0 + ai * HALF + m * 16; const bf16_t* rp = PROJ + (size_t)row * NPROJ + 3328 + col0;
#pragma unroll
                for (int bj = 0; bj < 2; ++bj) { const u32x4 g2 = *(const u32x4*)(rp + bj * HALF);
                    f32x4 s0, s1;
                    s0[0] = sigmoidf_(bf16_lo(g2.x)); s0[1] = sigmoidf_(bf16_hi(g2.x)); s0[2] = sigmoidf_(bf16_lo(g2.y)); s0[3] = sigmoidf_(bf16_hi(g2.y));
                    s1[0] = sigmoidf_(bf16_lo(g2.z)); s1[1] = sigmoidf_(bf16_hi(g2.z)); s1[2] = sigmoidf_(bf16_lo(g2.w)); s1[3] = sigmoidf_(bf16_hi(g2.w));
                    const f32x4 v0 = acc[ai][bj][m][0] * s0, v1 = acc[ai][bj][m][1] * s1; u32x4 w;
                    w.x = cvt_pk_bf16(v0[0], v0[1]); w.y = cvt_pk_bf16(v0[2], v0[3]); w.z = cvt_pk_bf16(v1[0], v1[1]); w.w = cvt_pk_bf16(v1[2], v1[3]);
                    *(u32x4*)(MERGED + (size_t)row * 1024 + col0 + bj * HALF) = w; }
                asm volatile("" ::: "memory"); }
    }
};
struct EpiBf16Y {
    static constexpr bool PERM = true;
    bf16_t* C;
    __device__ __forceinline__ void operator()(const Acc& acc, const Unit& u, int wr, int wc, int fr, int fq) const {
        const int row0 = u.pm * BM + wr * 64 + fr, col0 = u.pn * BM + wc * 32 + 8 * fq;
#pragma unroll
        for (int ai = 0; ai < 2; ++ai)
#pragma unroll
            for (int m = 0; m < 4; ++m) { bf16_t* rowp = C + (size_t)(row0 + ai * HALF + m * 16) * 1024 + col0;
#pragma unroll
                for (int bj = 0; bj < 2; ++bj) { const f32x4 v0 = acc[ai][bj][m][0], v1 = acc[ai][bj][m][1]; u32x4 w;
                    w.x = cvt_pk_bf16(v0[0], v0[1]); w.y = cvt_pk_bf16(v0[2], v0[3]); w.z = cvt_pk_bf16(v1[0], v1[1]); w.w = cvt_pk_bf16(v1[2], v1[3]);
                    *(u32x4*)(rowp + bj * HALF) = w; } }
    }
};
struct EpiMoe1 {
    static constexpr bool PERM = true;
    const float* b1; unsigned char* ACT;
    __device__ __forceinline__ void operator()(const Acc& acc, const Unit& u, int wr, int wc, int fr, int fq) const {
        const int e = u.aux, row0 = u.pm * BM + wr * 64 + fr, col0 = u.pn * BM + wc * 32 + 8 * fq;
        constexpr float DS = 1.f / (SC_H2 * SC_W);
        f32x4 bv[2][2];
#pragma unroll
        for (int bj = 0; bj < 2; ++bj)
#pragma unroll
            for (int n = 0; n < 2; ++n) bv[bj][n] = *(const f32x4*)(b1 + (size_t)e * 2048 + col0 + bj * HALF + 4 * n);
#pragma unroll
        for (int ai = 0; ai < 2; ++ai)
#pragma unroll
            for (int m = 0; m < 4; ++m) { const int row = row0 + ai * HALF + m * 16;
#pragma unroll
                for (int bj = 0; bj < 2; ++bj) { float o[4];
#pragma unroll
                    for (int n = 0; n < 2; ++n) { const f32x4 v = acc[ai][bj][m][n] * DS + bv[bj][n];
#pragma unroll
                        for (int q = 0; q < 2; ++q) { const float xg = fminf(v[2 * q], 7.f), xl = __builtin_amdgcn_fmed3f(v[2 * q + 1], -7.f, 7.f);
                            const float sg = __builtin_amdgcn_rcpf(1.f + __builtin_amdgcn_exp2f(xg * (-1.702f * LOG2E)));
                            o[2 * n + q] = (xg * sg) * __builtin_fmaf(xl, SC_ACT, SC_ACT); } }
                    int w = __builtin_amdgcn_cvt_pk_fp8_f32(o[0], o[1], 0, false); w = __builtin_amdgcn_cvt_pk_fp8_f32(o[2], o[3], w, true);
                    *(int*)(ACT + (size_t)row * 1024 + ((col0 + bj * HALF) >> 1)) = w; } }
    }
};
struct EpiMoe2 {
    static constexpr bool PERM = true;
    const float* b2; unsigned char* YIT;
    __device__ __forceinline__ void operator()(const Acc& acc, const Unit& u, int wr, int wc, int fr, int fq) const {
        const int e = u.aux, row0 = u.pm * BM + wr * 64 + fr, col0 = u.pn * BM + wc * 32 + 8 * fq;
        constexpr float DS = SC_Y / (SC_ACT * SC_W);
        f32x4 bv[2][2];
#pragma unroll
        for (int bj = 0; bj < 2; ++bj)
#pragma unroll
            for (int n = 0; n < 2; ++n) bv[bj][n] = *(const f32x4*)(b2 + (size_t)e * 1024 + col0 + bj * HALF + 4 * n) * SC_Y;
#pragma unroll
        for (int ai = 0; ai < 2; ++ai)
#pragma unroll
            for (int m = 0; m < 4; ++m) { const int row = row0 + ai * HALF + m * 16;
#pragma unroll
                for (int bj = 0; bj < 2; ++bj) { f32x4 v0 = acc[ai][bj][m][0] * DS + bv[bj][0], v1 = acc[ai][bj][m][1] * DS + bv[bj][1];
                    v0 = __builtin_elementwise_min(__builtin_elementwise_max(v0, (f32x4){-448.f, -448.f, -448.f, -448.f}), (f32x4){448.f, 448.f, 448.f, 448.f});
                    v1 = __builtin_elementwise_min(__builtin_elementwise_max(v1, (f32x4){-448.f, -448.f, -448.f, -448.f}), (f32x4){448.f, 448.f, 448.f, 448.f});
                    u32x2 w; int t = __builtin_amdgcn_cvt_pk_fp8_f32(v0[0], v0[1], 0, false); t = __builtin_amdgcn_cvt_pk_fp8_f32(v0[2], v0[3], t, true); w.x = (unsigned)t;
                    t = __builtin_amdgcn_cvt_pk_fp8_f32(v1[0], v1[1], 0, false); t = __builtin_amdgcn_cvt_pk_fp8_f32(v1[2], v1[3], t, true); w.y = (unsigned)t;
                    *(u32x2*)(YIT + (size_t)row * 1024 + col0 + bj * HALF) = w; } }
    }
};
struct EpiMoe12 {
    static constexpr bool PERM = true;
    EpiMoe1 e1; EpiMoe2 e2;
    __device__ __forceinline__ void operator()(const Acc& acc, const Unit& u, int wr, int wc, int fr, int fq) const {
        if (u.aux & 0x100) { Unit v = u; v.aux &= 0xff; e2(acc, v, wr, wc, fr, fq); } else e1(acc, u, wr, wc, fr, fq); }
};
}

namespace attn {
#define SBAR() __builtin_amdgcn_sched_barrier(0)
constexpr int NW = 8, QBLK = 32, KVBLK = 64;
constexpr float THR = 8.f;
__device__ __forceinline__ int crow(int r, int hi) { return (r & 3) + 8 * (r >> 2) + 4 * hi; }
constexpr int KROW_MLA = 96 * 2 + 16, KROW_NA = 64 * 2 + 16;
constexpr int SHM_K = 64 * KROW_MLA  , SHM_V = 64 * 64 * 2  ;
constexpr int OFF_V = 0, OFF_K = 4 * SHM_V, OFF_WS = OFF_K + 4 * SHM_K, OFF_OST = OFF_WS + NW * 256, OFF_BIAS = OFF_OST + NW * 4096, ATTN_LDS = OFF_BIAS + 2048;

__device__ __forceinline__ int v_st(int k, int c) { const int kk = (k & ~0xC) | ((k & 4) << 1) | ((k & 8) >> 1); return ((kk >> 3) * 2 + (c >> 5)) * 512 + ((kk & 7) * 32 + (c & 31)) * 2; }
__device__ __forceinline__ int v_st_nat(int k, int c) { return ((k >> 3) * 2 + (c >> 5)) * 512 + ((k & 7) * 32 + (c & 31)) * 2; }
__device__ __forceinline__ int v_rd_base(int lane) { return ((lane & 3) << 3) | (((lane >> 2) & 3) << 6) | (((lane >> 4) & 1) << 5) | (((lane >> 5) & 1) << 8); }
constexpr int v_rd_off(int d0, int ks, int half) { return d0 * 512 + ks * 2048 + half * 1024; }
template <int OFF> __device__ __forceinline__ s16x4 tr_read(int vb) {
    s16x4 r; asm volatile("ds_read_b64_tr_b16 %0, %1 offset:%2" : "=&v"(r) : "v"(vb), "i"(OFF) : "memory"); return r;
}
template <int D0> __device__ __forceinline__ void pv_one(f32x16& od, int vb, bf16x8 pa0, bf16x8 pa1, bf16x8 pa2, bf16x8 pa3) {
    const s16x4 l0 = tr_read<v_rd_off(D0, 0, 0)>(vb), h0 = tr_read<v_rd_off(D0, 0, 1)>(vb), l1 = tr_read<v_rd_off(D0, 1, 0)>(vb), h1 = tr_read<v_rd_off(D0, 1, 1)>(vb);
    const s16x4 l2 = tr_read<v_rd_off(D0, 2, 0)>(vb), h2 = tr_read<v_rd_off(D0, 2, 1)>(vb), l3 = tr_read<v_rd_off(D0, 3, 0)>(vb), h3 = tr_read<v_rd_off(D0, 3, 1)>(vb);
    asm volatile("s_waitcnt lgkmcnt(0)" ::: "memory"); SBAR();
#define PK(L, H) (bf16x8){L[0], L[1], L[2], L[3], H[0], H[1], H[2], H[3]}
    od = __builtin_amdgcn_mfma_f32_32x32x16_bf16(pa0, PK(l0, h0), od, 0, 0, 0);
    od = __builtin_amdgcn_mfma_f32_32x32x16_bf16(pa1, PK(l1, h1), od, 0, 0, 0);
    od = __builtin_amdgcn_mfma_f32_32x32x16_bf16(pa2, PK(l2, h2), od, 0, 0, 0);
    od = __builtin_amdgcn_mfma_f32_32x32x16_bf16(pa3, PK(l3, h3), od, 0, 0, 0);
#undef PK
}
__device__ __forceinline__ void pv_d0(f32x16* o, int vb, bf16x8 pa0, bf16x8 pa1, bf16x8 pa2, bf16x8 pa3) {
    pv_one<0>(o[0], vb, pa0, pa1, pa2, pa3); pv_one<1>(o[1], vb, pa0, pa1, pa2, pa3);
}
__device__ __forceinline__ void partialSM(f32x16& p0, f32x16& p1, float& m_ref, f32x16& negm, float& alpha, bool& fresh) {
    float pmax = p0[0];
#pragma unroll
    for (int r = 1; r < 16; ++r) pmax = fmaxf(pmax, p0[r]);
#pragma unroll
    for (int r = 0; r < 16; ++r) pmax = fmaxf(pmax, p1[r]);
    { auto rr = __builtin_amdgcn_permlane32_swap(__float_as_uint(pmax), __float_as_uint(pmax), false, false);
      pmax = fmaxf(__uint_as_float(rr[0]), __uint_as_float(rr[1])); }
    alpha = 1.f;
    if (__builtin_expect(fresh || !__all(pmax <= THR), 0)) {
        const float dl = fresh ? pmax : fmaxf(pmax, 0.f);
        m_ref += dl;
#pragma unroll
        for (int r = 0; r < 16; ++r) { p0[r] -= dl; p1[r] -= dl; }
        const float nm = -m_ref;
#pragma unroll
        for (int r = 0; r < 16; ++r) negm[r] = nm;
        alpha = fresh ? 1.f : __builtin_amdgcn_exp2f(-dl);
        fresh = false;
    }
#pragma unroll
    for (int r = 0; r < 16; ++r) p0[r] = __builtin_amdgcn_exp2f(p0[r]);
}
__device__ __forceinline__ void finishSM(f32x16& p0, f32x16& p1, float alpha, float& l_reg, bf16x8& pa0, bf16x8& pa1, bf16x8& pa2, bf16x8& pa3) {
#pragma unroll
    for (int r = 0; r < 16; ++r) p1[r] = __builtin_amdgcn_exp2f(p1[r]);
    float ps = 0;
#pragma unroll
    for (int r = 0; r < 16; ++r) ps += p0[r];
#pragma unroll
    for (int r = 0; r < 16; ++r) ps += p1[r];
    { auto rr = __builtin_amdgcn_permlane32_swap(__float_as_uint(ps), __float_as_uint(ps), false, false);
      ps = __uint_as_float(rr[0]) + __uint_as_float(rr[1]); }
    l_reg = l_reg * alpha + ps;
#define PK4(P, BASE, OUT) do { unsigned a0 = cvt_pk_bf16(P[BASE + 0], P[BASE + 1]), a1 = cvt_pk_bf16(P[BASE + 2], P[BASE + 3]);   \
    unsigned b0 = cvt_pk_bf16(P[BASE + 4], P[BASE + 5]), b1 = cvt_pk_bf16(P[BASE + 6], P[BASE + 7]);                              \
    auto r0 = __builtin_amdgcn_permlane32_swap(a0, b0, false, false); auto r1 = __builtin_amdgcn_permlane32_swap(a1, b1, false, false); \
    u32x4 w = {r0[0], r1[0], r0[1], r1[1]}; OUT = *reinterpret_cast<bf16x8*>(&w); } while (0)
#define PKN_(P, BASE, OUT) do { u32x4 w = {cvt_pk_bf16(P[BASE + 0], P[BASE + 1]), cvt_pk_bf16(P[BASE + 2], P[BASE + 3]), cvt_pk_bf16(P[BASE + 4], P[BASE + 5]), cvt_pk_bf16(P[BASE + 6], P[BASE + 7])}; OUT = *reinterpret_cast<bf16x8*>(&w); } while (0)
    PKN_(p0, 0, pa0); PKN_(p0, 8, pa1); PKN_(p1, 0, pa2); PKN_(p1, 8, pa3);
#undef PKN_
#undef PK4
}
template <int ND0, int KROW>
__device__ __forceinline__ void qkt(f32x16& p0, f32x16& p1, const char* Ks, const bf16x8* qr, const f32x16& negm, int r32, int hi) {
#pragma unroll
    for (int d0 = 0; d0 < ND0; ++d0) { const int cb = (d0 * 16 + hi * 8) * 2;
        const bf16x8 b0 = *reinterpret_cast<const bf16x8*>(Ks + r32 * KROW + cb);
        const bf16x8 b1 = *reinterpret_cast<const bf16x8*>(Ks + (32 + r32) * KROW + cb);
        if (d0 == 0) { p0 = __builtin_amdgcn_mfma_f32_32x32x16_bf16(b0, qr[0], negm, 0, 0, 0); p1 = __builtin_amdgcn_mfma_f32_32x32x16_bf16(b1, qr[0], negm, 0, 0, 0); }
        else { p0 = __builtin_amdgcn_mfma_f32_32x32x16_bf16(b0, qr[d0], p0, 0, 0, 0); p1 = __builtin_amdgcn_mfma_f32_32x32x16_bf16(b1, qr[d0], p1, 0, 0, 0); } }
}

template <int MODE>
__device__ __forceinline__ void attn_unit(const bf16_t* __restrict__ Qa, int ldqa, const bf16_t* __restrict__ Qb, int ldqb,
                                          const bf16_t* __restrict__ Ka, int ldka, const bf16_t* __restrict__ Kb, int ldkb, const bf16_t* __restrict__ Vv, int ldv,
                                          bf16_t* __restrict__ O, int NT, int krow0, int ntreal, int qrow0, const float* __restrict__ rpbh, char* lds) {
    constexpr int ND0 = MODE == 0 ? 6 : 4, KROW = MODE == 0 ? KROW_MLA : KROW_NA;
    const int tid = threadIdx.x, wid = __builtin_amdgcn_readfirstlane(tid >> 6), lane = tid & 63, r32 = lane & 31, hi = lane >> 5;
    char* V_lds = lds + OFF_V; char* K_lds = lds + OFF_K;
    float* ws = (float*)(lds + OFF_WS) + wid * 64; float* li_l = ws; float* al_l = ws + 32;
    float* biasL = (float*)(lds + OFF_BIAS);
    float m_ref = 0.f, l_reg = 0; f32x16 o[2] = {}; f32x16 negm = {}; bool fresh = true; bf16x8 qr[ND0];
    {   const bf16_t* Qw = Qa + (size_t)(wid * QBLK + r32) * ldqa + hi * 8;
#pragma unroll
        for (int d0 = 0; d0 < 4; ++d0) qr[d0] = *reinterpret_cast<const bf16x8*>(Qw + d0 * 16);
        if constexpr (MODE == 0) { const bf16_t* Qw2 = Qb + (size_t)(wid * QBLK + r32) * ldqb + hi * 8;
#pragma unroll
            for (int d0 = 0; d0 < 2; ++d0) qr[4 + d0] = *reinterpret_cast<const bf16x8*>(Qw2 + d0 * 16); } }
    int qgr = 0, rs0 = 0, qc = 0, cs = 0;
    if constexpr (MODE == 1) {
        qgr = qrow0 + (wid >> 1); rs0 = min(max(qgr - 4, 0), 120); qc = 32 * (wid & 1) + r32; cs = min(max(qc - 8, 0), 48);
        for (int i = tid; i < 15 * 31; i += 512) biasL[i] = rpbh[i] * LOG2E;
    }
    const int sr = tid >> 3, sc = (tid & 7) * 8;
    const int sr2 = (tid & 255) >> 2, sc2 = (tid & 3) * 8;
    const int vst = v_st_nat(sr, sc);
    const int vb0 = (int)(uintptr_t)V_lds + v_rd_base(lane);
    struct { bf16x8 v, k, k2; } sr_[1];
#define KROWOF(t) (MODE == 1 ? min(krow0 + (t), 127) * 64 : (t) * 64)
#define SLOAD(i, t) do { const long k0_ = KROWOF(t); sr_[i].v = *reinterpret_cast<const bf16x8*>(&Vv[(k0_ + sr) * ldv + sc]); sr_[i].k = *reinterpret_cast<const bf16x8*>(&Ka[(k0_ + sr) * ldka + sc]); \
        if constexpr (MODE == 0) sr_[i].k2 = *reinterpret_cast<const bf16x8*>(&Kb[(k0_ + sr2) * ldkb + sc2]); } while (0)
#define SWRITE(b, i) do { *(bf16x8*)(V_lds + (b) * SHM_V + vst) = sr_[i].v; *(bf16x8*)(K_lds + (b) * SHM_K + sr * KROW + sc * 2) = sr_[i].k; \
        if constexpr (MODE == 0) { if (tid < 256) *(bf16x8*)(K_lds + (b) * SHM_K + sr2 * KROW + 128 + sc2 * 2) = sr_[i].k2; } } while (0)
#define SWAIT() do { if constexpr (MODE == 0) asm volatile("s_waitcnt vmcnt(3)" ::: "memory"); else asm volatile("s_waitcnt vmcnt(2)" ::: "memory"); } while (0)
#define RESC(a) do { if (__any((a) < 1.f)) { if (hi == 0) al_l[r32] = (a); asm volatile("s_waitcnt lgkmcnt(0)" ::: "memory"); \
        _Pragma("unroll") for (int d = 0; d < 2; ++d) _Pragma("unroll") for (int r = 0; r < 16; ++r) o[d][r] *= al_l[crow(r, hi)]; } } while (0)
#define TVALID(t) (MODE == 0 ? true : ((t) < ntreal && (krow0 + (t)) >= rs0 && (krow0 + (t)) < rs0 + 8))
#define MASKB(P0, P1, t) do { if constexpr (MODE == 1) { const int dr_ = krow0 + (t) - qgr + 7; int d_ = 4 * hi - cs; asm volatile("" : "+v"(d_)); \
        const LAS float* bl_ = (const LAS float*)((LAS char*)lds + OFF_BIAS) + (dr_ * 31 + 15 - qc + 4 * hi); \
        _Pragma("unroll") for (int r = 0; r < 16; ++r) { const int c0_ = (r & 3) + 8 * (r >> 2); \
            const bool in0 = (unsigned)(c0_ + d_) < 16u, in1 = (unsigned)(c0_ + 32 + d_) < 16u; \
            const float b0_ = bl_[c0_], b1_ = bl_[c0_ + 32]; \
            P0[r] = in0 ? P0[r] + b0_ : -1e30f; P1[r] = in1 ? P1[r] + b1_ : -1e30f; } } } while (0)
    f32x16 pA0, pA1, pB0, pB1; float alA = 1.f, alB = 1.f; bf16x8 pa0, pa1, pa2, pa3;
    SLOAD(0, 0); asm volatile("s_waitcnt vmcnt(0)" ::: "memory"); SWRITE(0, 0); SLOAD(0, 1); asm volatile("s_waitcnt vmcnt(0)" ::: "memory"); SWRITE(1, 0);
    if (NT > 2) SLOAD(0, 2);
    __syncthreads();
    const int NI = NT >> 1;
    for (int it = 0; it < NI; ++it) {
        const int kb = (it & 1) * 2, nb = 2 - kb; const bool more = it + 1 < NI;
        if (more) { SWRITE(nb, 0); SLOAD(0, 2 * it + 3); }
        const int ta = 2 * it, tb = ta + 1;
        const bool vA = TVALID(ta), vB = TVALID(tb);
        if (vA) { qkt<ND0, KROW>(pA0, pA1, K_lds + kb * SHM_K, qr, negm, r32, hi); MASKB(pA0, pA1, ta); partialSM(pA0, pA1, m_ref, negm, alA, fresh); RESC(alA); }
        SBAR();
        if (vB) { qkt<ND0, KROW>(pB0, pB1, K_lds + (kb + 1) * SHM_K, qr, negm, r32, hi); MASKB(pB0, pB1, tb); }
        if (vA) { finishSM(pA0, pA1, alA, l_reg, pa0, pa1, pa2, pa3); SBAR(); pv_d0(o, vb0 + kb * SHM_V, pa0, pa1, pa2, pa3); }
        if (more) { SWRITE(nb + 1, 0); if (it + 2 < NI) SLOAD(0, 2 * it + 4); }
        if (vB) { partialSM(pB0, pB1, m_ref, negm, alB, fresh); RESC(alB); finishSM(pB0, pB1, alB, l_reg, pa0, pa1, pa2, pa3); SBAR(); pv_d0(o, vb0 + (kb + 1) * SHM_V, pa0, pa1, pa2, pa3); }
        __syncthreads();
    }
    asm volatile("s_waitcnt vmcnt(0)" ::: "memory");
    if (hi == 0) li_l[r32] = l_reg; asm volatile("s_waitcnt lgkmcnt(0)" ::: "memory");
    float rli[16];
#pragma unroll
    for (int r = 0; r < 16; ++r) rli[r] = __builtin_amdgcn_rcpf(li_l[crow(r, hi)]);
    {   bf16_t* stg = (bf16_t*)(lds + OFF_OST) + wid * 2048;
#pragma unroll
        for (int r = 0; r < 16; ++r) { const int orow = crow(r, hi);
#pragma unroll
            for (int d0 = 0; d0 < 2; ++d0) stg[orow * 64 + d0 * 32 + r32] = (bf16_t)(cvt_pk_bf16(o[d0][r] * rli[r], 0.f) & 0xffffu); }
        asm volatile("s_waitcnt lgkmcnt(0)" ::: "memory");
        bf16_t* Ow = O + (size_t)(wid * QBLK) * 512;
#pragma unroll
        for (int i = 0; i < 4; ++i) { const int row = i * 8 + (lane >> 3), ch = lane & 7; const u32x4 v = *(const u32x4*)(stg + row * 64 + ch * 8); *(u32x4*)(Ow + (size_t)row * 512 + ch * 8) = v; } }
    __syncthreads();
#undef KROWOF
#undef SLOAD
#undef SWRITE
#undef SWAIT
#undef RESC
#undef TVALID
#undef MASKB
}

constexpr float BIG = 65536.f;
__device__ __forceinline__ void qk32(f32x16& s0, f32x16& s1, const char* Kb, const bf16x8* q0, const bf16x8* q1, bf16x8 aone, bf16x8 bm0, bf16x8 bm1, int r32, int hi) {
    const f32x16 z = {};
    s0 = __builtin_amdgcn_mfma_f32_32x32x16_bf16(aone, bm0, z, 0, 0, 0); s1 = __builtin_amdgcn_mfma_f32_32x32x16_bf16(aone, bm1, z, 0, 0, 0);
#pragma unroll
    for (int d0 = 0; d0 < 6; ++d0) {
        const bf16x8 kf = *reinterpret_cast<const bf16x8*>(Kb + r32 * KROW_MLA + (d0 * 16 + hi * 8) * 2);
        s0 = __builtin_amdgcn_mfma_f32_32x32x16_bf16(kf, q0[d0], s0, 0, 0, 0); s1 = __builtin_amdgcn_mfma_f32_32x32x16_bf16(kf, q1[d0], s1, 0, 0, 0);
    }
}
__device__ __forceinline__ float expsum16(f32x16& s) {
#pragma unroll
    for (int r = 0; r < 16; ++r) s[r] = __builtin_amdgcn_exp2f(s[r]);
    float ps = s[0];
#pragma unroll
    for (int r = 1; r < 16; ++r) ps += s[r];
    auto rr = __builtin_amdgcn_permlane32_swap(__float_as_uint(ps), __float_as_uint(ps), false, false);
    return __uint_as_float(rr[0]) + __uint_as_float(rr[1]);
}
__device__ __forceinline__ void raise16(f32x16& s, float& m, float& l, f32x16& oa, f32x16& ob, float* al, int r32, int hi) {
    float pmax = s[0];
#pragma unroll
    for (int r = 1; r < 16; ++r) pmax = fmaxf(pmax, s[r]);
    { auto rr = __builtin_amdgcn_permlane32_swap(__float_as_uint(pmax), __float_as_uint(pmax), false, false);
      pmax = fmaxf(__uint_as_float(rr[0]), __uint_as_float(rr[1])); }
    const float mn = __uint_as_float((__float_as_uint(fmaxf(m, pmax)) + 0x8000u) & 0xffff0000u), a = __builtin_amdgcn_exp2f(m - mn);
    m = mn; l *= a;
#pragma unroll
    for (int r = 0; r < 16; ++r) s[r] -= mn;
    if (hi == 0) al[r32] = a;
    asm volatile("s_waitcnt lgkmcnt(0)" ::: "memory");
#pragma unroll
    for (int r = 0; r < 16; ++r) { const float ar = al[crow(r, hi)]; oa[r] *= ar; ob[r] *= ar; }
}
__device__ __forceinline__ bf16x8 bmfrag(float m, int hi, bool zero) {
    u32x4 w = {(hi == 0 && !zero) ? ((__float_as_uint(m) ^ 0x80000000u) >> 16) : 0u, 0u, 0u, 0u}; return *reinterpret_cast<bf16x8*>(&w);
}
#define PK4(P, BASE, OUT) do { unsigned a0 = cvt_pk_bf16(P[BASE + 0], P[BASE + 1]), a1 = cvt_pk_bf16(P[BASE + 2], P[BASE + 3]);   \
    unsigned b0 = cvt_pk_bf16(P[BASE + 4], P[BASE + 5]), b1 = cvt_pk_bf16(P[BASE + 6], P[BASE + 7]);                              \
    auto r0 = __builtin_amdgcn_permlane32_swap(a0, b0, false, false); auto r1 = __builtin_amdgcn_permlane32_swap(a1, b1, false, false); \
    u32x4 w = {r0[0], r1[0], r0[1], r1[1]}; OUT = *reinterpret_cast<bf16x8*>(&w); } while (0)
#define PKN(P, BASE, OUT) do { u32x4 w = {cvt_pk_bf16(P[BASE + 0], P[BASE + 1]), cvt_pk_bf16(P[BASE + 2], P[BASE + 3]), cvt_pk_bf16(P[BASE + 4], P[BASE + 5]), cvt_pk_bf16(P[BASE + 6], P[BASE + 7])}; OUT = *reinterpret_cast<bf16x8*>(&w); } while (0)
#define PKV(L, H) (bf16x8){L[0], L[1], L[2], L[3], H[0], H[1], H[2], H[3]}
__device__ __forceinline__ void qk16raw(f32x16& s, const char* Kb, const bf16x8* q, int r32, int hi) {
    const f32x16 z = {};
#pragma unroll
    for (int d0 = 0; d0 < 6; ++d0) { const bf16x8 kf = *reinterpret_cast<const bf16x8*>(Kb + r32 * KROW_MLA + (d0 * 16 + hi * 8) * 2);
        s = __builtin_amdgcn_mfma_f32_32x32x16_bf16(kf, q[d0], d0 == 0 ? z : s, 0, 0, 0); }
}
template <int OFF> __device__ __forceinline__ bf16x8 k_read(int ka) {
    bf16x8 r; asm volatile("ds_read_b128 %0, %1 offset:%2" : "=&v"(r) : "v"(ka), "i"(OFF) : "memory"); return r;
}
__device__ __forceinline__ void k_issue(bf16x8* kf, int ka) {
    kf[0] = k_read<0>(ka); kf[1] = k_read<32>(ka); kf[2] = k_read<64>(ka); kf[3] = k_read<96>(ka); kf[4] = k_read<128>(ka); kf[5] = k_read<160>(ka);
}
template <int HF, bool PREF>
__device__ __forceinline__ void block64(const char* Kt, int ka, int kan, bf16x8* kf, int vb, const bf16x8* q0, const bf16x8* q1, float& m0, float& m1, float& l0, float& l1,
                                        f32x16& o00, f32x16& o01, f32x16& o10, f32x16& o11, float* al, int r32, int hi, bf16x8 aone) {
    const char* Kb = Kt + HF * 32 * KROW_MLA;
    if constexpr (!PREF) k_issue(kf, ka);
    f32x16 s0, s1; const f32x16 z = {};
    s0 = __builtin_amdgcn_mfma_f32_32x32x16_bf16(aone, bmfrag(m0, hi, false), z, 0, 0, 0); s1 = __builtin_amdgcn_mfma_f32_32x32x16_bf16(aone, bmfrag(m1, hi, false), z, 0, 0, 0);
    asm volatile("s_waitcnt lgkmcnt(4)" ::: "memory"); SBAR();
    s0 = __builtin_amdgcn_mfma_f32_32x32x16_bf16(kf[0], q0[0], s0, 0, 0, 0); s1 = __builtin_amdgcn_mfma_f32_32x32x16_bf16(kf[0], q1[0], s1, 0, 0, 0);
    s0 = __builtin_amdgcn_mfma_f32_32x32x16_bf16(kf[1], q0[1], s0, 0, 0, 0); s1 = __builtin_amdgcn_mfma_f32_32x32x16_bf16(kf[1], q1[1], s1, 0, 0, 0);
    asm volatile("s_waitcnt lgkmcnt(2)" ::: "memory"); SBAR();
    s0 = __builtin_amdgcn_mfma_f32_32x32x16_bf16(kf[2], q0[2], s0, 0, 0, 0); s1 = __builtin_amdgcn_mfma_f32_32x32x16_bf16(kf[2], q1[2], s1, 0, 0, 0);
    s0 = __builtin_amdgcn_mfma_f32_32x32x16_bf16(kf[3], q0[3], s0, 0, 0, 0); s1 = __builtin_amdgcn_mfma_f32_32x32x16_bf16(kf[3], q1[3], s1, 0, 0, 0);
    asm volatile("s_waitcnt lgkmcnt(0)" ::: "memory"); SBAR();
    s0 = __builtin_amdgcn_mfma_f32_32x32x16_bf16(kf[4], q0[4], s0, 0, 0, 0); s1 = __builtin_amdgcn_mfma_f32_32x32x16_bf16(kf[4], q1[4], s1, 0, 0, 0);
    s0 = __builtin_amdgcn_mfma_f32_32x32x16_bf16(kf[5], q0[5], s0, 0, 0, 0); s1 = __builtin_amdgcn_mfma_f32_32x32x16_bf16(kf[5], q1[5], s1, 0, 0, 0);
    SBAR();
    const s16x4 va0 = tr_read<v_rd_off(0, HF * 2, 0)>(vb), vb0_ = tr_read<v_rd_off(0, HF * 2, 1)>(vb), va1 = tr_read<v_rd_off(0, HF * 2 + 1, 0)>(vb), vb1 = tr_read<v_rd_off(0, HF * 2 + 1, 1)>(vb);
    const s16x4 va2 = tr_read<v_rd_off(1, HF * 2, 0)>(vb), vb2 = tr_read<v_rd_off(1, HF * 2, 1)>(vb), va3 = tr_read<v_rd_off(1, HF * 2 + 1, 0)>(vb), vb3 = tr_read<v_rd_off(1, HF * 2 + 1, 1)>(vb);
    SBAR();
    float ps0 = expsum16(s0);
    if (__builtin_expect(!__all(ps0 < BIG), 0)) { qk16raw(s0, Kb, q0, r32, hi); raise16(s0, m0, l0, o00, o01, al, r32, hi); ps0 = expsum16(s0); }
    l0 += ps0;
    bf16x8 pa00, pa01, pa10, pa11;
    PKN(s0, 0, pa00); PKN(s0, 8, pa01);
    asm volatile("s_waitcnt lgkmcnt(0)" ::: "memory"); SBAR();
    if (kan != 0) k_issue(kf, kan);
    SBAR();
    o00 = __builtin_amdgcn_mfma_f32_32x32x16_bf16(pa00, PKV(va0, vb0_), o00, 0, 0, 0);
    o01 = __builtin_amdgcn_mfma_f32_32x32x16_bf16(pa00, PKV(va2, vb2), o01, 0, 0, 0);
    o00 = __builtin_amdgcn_mfma_f32_32x32x16_bf16(pa01, PKV(va1, vb1), o00, 0, 0, 0);
    o01 = __builtin_amdgcn_mfma_f32_32x32x16_bf16(pa01, PKV(va3, vb3), o01, 0, 0, 0);
    float ps1 = expsum16(s1);
    if (__builtin_expect(!__all(ps1 < BIG), 0)) { qk16raw(s1, Kb, q1, r32, hi); raise16(s1, m1, l1, o10, o11, al + 32, r32, hi); ps1 = expsum16(s1); }
    l1 += ps1;
    PKN(s1, 0, pa10); PKN(s1, 8, pa11);
    o10 = __builtin_amdgcn_mfma_f32_32x32x16_bf16(pa10, PKV(va0, vb0_), o10, 0, 0, 0);
    o11 = __builtin_amdgcn_mfma_f32_32x32x16_bf16(pa10, PKV(va2, vb2), o11, 0, 0, 0);
    o10 = __builtin_amdgcn_mfma_f32_32x32x16_bf16(pa11, PKV(va1, vb1), o10, 0, 0, 0);
    o11 = __builtin_amdgcn_mfma_f32_32x32x16_bf16(pa11, PKV(va3, vb3), o11, 0, 0, 0);
}
__device__ __forceinline__ void attn_mla64(const bf16_t* __restrict__ Qa, const bf16_t* __restrict__ Qb, const bf16_t* __restrict__ Ka, const bf16_t* __restrict__ Kb,
                                           const bf16_t* __restrict__ Vv, bf16_t* __restrict__ O, char* lds, const char* wsb) {
    constexpr int NI = 64;
    const int tid = threadIdx.x, wid = __builtin_amdgcn_readfirstlane(tid >> 6), lane = tid & 63, r32 = lane & 31, hi = lane >> 5;
    constexpr int M_OFF_V = 0, M_OFF_K = 6 * SHM_V, M_OFF_WS = M_OFF_K + 6 * SHM_K;
    static_assert(M_OFF_WS + NW * 512 <= 144 * 1024, "MLA LDS");
    char* V_lds = lds + M_OFF_V; char* K_lds = lds + M_OFF_K;
    float* li_l = (float*)(lds + M_OFF_WS) + wid * 128; float* al_l = li_l + 64;
    const float MINIT = -1.2676506e30f;
    float m0 = MINIT, m1 = MINIT, l0 = 0.f, l1 = 0.f; bf16x8 aone; { u32x4 w = {hi == 0 ? 0x3F80u : 0u, 0u, 0u, 0u}; aone = *reinterpret_cast<bf16x8*>(&w); }
    f32x16 o00 = {}, o01 = {}, o10 = {}, o11 = {}; bf16x8 q0[6], q1[6];
    {   const bf16_t* Qw = Qa + (size_t)(wid * 64 + r32) * 512 + hi * 8; const bf16_t* Qw2 = Qb + (size_t)(wid * 64 + r32) * 256 + hi * 8;
#pragma unroll
        for (int d0 = 0; d0 < 4; ++d0) { q0[d0] = *reinterpret_cast<const bf16x8*>(Qw + d0 * 16); q1[d0] = *reinterpret_cast<const bf16x8*>(Qw + 32 * 512 + d0 * 16); }
#pragma unroll
        for (int d0 = 0; d0 < 2; ++d0) { q0[4 + d0] = *reinterpret_cast<const bf16x8*>(Qw2 + d0 * 16); q1[4 + d0] = *reinterpret_cast<const bf16x8*>(Qw2 + 32 * 256 + d0 * 16); } }
    unsigned offV, offK0, offK1, strK0, strK1;
    {   const unsigned oKa = (unsigned)((const char*)Ka - wsb), oKb = (unsigned)((const char*)Kb - wsb), oV = (unsigned)((const char*)Vv - wsb);
        { const int j = wid * 64 + lane, sub = j >> 5, k = (sub >> 1) * 8 + ((j >> 2) & 7), c = (sub & 1) * 32 + (j & 3) * 8; offV = oV + k * 1024 + c * 2; }
        { const int j = wid * 64 + lane, row = j / 13, cc = j - row * 13; const bool rope = cc >= 8 && cc < 12;
          offK0 = rope ? oKb + row * 64 + (cc - 8) * 16 : oKa + row * 1024 + (cc == 12 ? 0 : cc) * 16; strK0 = rope ? 64u * 64u : 64u * 1024u; }
        { const int j = min((8 + wid) * 64 + lane, 831), row = j / 13, cc = j - row * 13; const bool rope = cc >= 8 && cc < 12;
          offK1 = rope ? oKb + row * 64 + (cc - 8) * 16 : oKa + row * 1024 + (cc == 12 ? 0 : cc) * 16; strK1 = rope ? 64u * 64u : 64u * 1024u; } }
    LAS char* Vl = (LAS char*)V_lds + wid * 1024; LAS char* Kl = (LAS char*)K_lds + wid * 1024;
#define DMA(b) do { __builtin_amdgcn_global_load_lds((const unsigned*)(wsb + offV), (LAS unsigned*)(Vl + (b) * SHM_V), 16, 0, 0); \
        __builtin_amdgcn_global_load_lds((const unsigned*)(wsb + offK0), (LAS unsigned*)(Kl + (b) * SHM_K), 16, 0, 0); \
        if (wid < 5) __builtin_amdgcn_global_load_lds((const unsigned*)(wsb + offK1), (LAS unsigned*)(Kl + (b) * SHM_K + 8192), 16, 0, 0); \
        offV += 65536u; offK0 += strK0; offK1 += strK1; } while (0)
    const int vb0 = (int)(uintptr_t)V_lds + v_rd_base(lane), kb0 = (int)(uintptr_t)K_lds + r32 * KROW_MLA + hi * 16;
    bf16x8 kf[6];
    DMA(0); DMA(1);
    asm volatile("s_waitcnt vmcnt(0)" ::: "memory");
    __syncthreads();
    f32x16 s0, s1; const f32x16 z = {}; float ps0, ps1;
    bf16x8 pa00, pa01, pa10 = {}, pa11 = {};
    s16x4 va0 = {}, vb0_ = {}, va1 = {}, vb1 = {}, va2 = {}, vb2 = {}, va3 = {}, vb3 = {};
#define MF(A, B, C) __builtin_amdgcn_mfma_f32_32x32x16_bf16(A, B, C, 0, 0, 0)
#define QKA(S, Q, M) do { S = MF(aone, bmfrag(M, hi, false), z); _Pragma("unroll") for (int d_ = 0; d_ < 6; ++d_) S = MF(kf[d_], Q[d_], S); } while (0)
#define PVC(PA0, PA1, OA, OB) do { OA = MF(PA0, PKV(va0, vb0_), OA); OB = MF(PA0, PKV(va2, vb2), OB); OA = MF(PA1, PKV(va1, vb1), OA); OB = MF(PA1, PKV(va3, vb3), OB); } while (0)
#define VISSUE(VB, HF) do { va0 = tr_read<v_rd_off(0, HF * 2, 0)>(VB); vb0_ = tr_read<v_rd_off(0, HF * 2, 1)>(VB); va1 = tr_read<v_rd_off(0, HF * 2 + 1, 0)>(VB); vb1 = tr_read<v_rd_off(0, HF * 2 + 1, 1)>(VB); \
        va2 = tr_read<v_rd_off(1, HF * 2, 0)>(VB); vb2 = tr_read<v_rd_off(1, HF * 2, 1)>(VB); va3 = tr_read<v_rd_off(1, HF * 2 + 1, 0)>(VB); vb3 = tr_read<v_rd_off(1, HF * 2 + 1, 1)>(VB); } while (0)
#define EXPA(S, PS) do { _Pragma("unroll") for (int r_ = 0; r_ < 8; ++r_) S[r_] = __builtin_amdgcn_exp2f(S[r_]); PS = S[0]; _Pragma("unroll") for (int r_ = 1; r_ < 8; ++r_) PS += S[r_]; } while (0)
#define EXPB(S, PS) do { _Pragma("unroll") for (int r_ = 8; r_ < 16; ++r_) S[r_] = __builtin_amdgcn_exp2f(S[r_]); _Pragma("unroll") for (int r_ = 8; r_ < 16; ++r_) PS += S[r_]; \
        auto rr_ = __builtin_amdgcn_permlane32_swap(__float_as_uint(PS), __float_as_uint(PS), false, false); PS = __uint_as_float(rr_[0]) + __uint_as_float(rr_[1]); } while (0)
#define CHECK(S, PS, KB, Q, M, L, OA, OB, AL) do { if (__builtin_expect(!__all(PS < BIG), 0)) { qk16raw(S, KB, Q, r32, hi); raise16(S, M, L, OA, OB, AL, r32, hi); PS = expsum16(S); } L += PS; } while (0)
#define LWAIT(n) asm volatile("s_waitcnt lgkmcnt(" #n ")" ::: "memory")
#define STAGE0(VB, HF, KB, KAN) do { PKN(s1, 0, pa10); PKN(s1, 8, pa11); SBAR(); PVC(pa10, pa11, o10, o11); EXPA(s0, ps0); SBAR(); VISSUE(VB, HF); SBAR(); \
        QKA(s1, q1, m1); EXPB(s0, ps0); SBAR(); if ((KAN) != 0) k_issue(kf, KAN); SBAR(); CHECK(s0, ps0, KB, q0, m0, l0, o00, o01, al_l); } while (0)
#define STAGE1(KB, LAST) do { PKN(s0, 0, pa00); PKN(s0, 8, pa01); if (LAST) LWAIT(0); else LWAIT(6); SBAR(); PVC(pa00, pa01, o00, o01); EXPA(s1, ps1); SBAR(); \
        if (!(LAST)) { LWAIT(0); SBAR(); QKA(s0, q0, m0); } EXPB(s1, ps1); SBAR(); CHECK(s1, ps1, KB, q1, m1, l1, o10, o11, al_l + 32); } while (0)
    s1 = z;
    k_issue(kf, kb0); SBAR(); LWAIT(0); SBAR(); QKA(s0, q0, m0); SBAR();
    int cur = 0;
    for (int it = 0; it < NI; ++it) {
        const int nxt = cur == 2 ? 0 : cur + 1; const bool more = it + 1 < NI;
        if (more) DMA(nxt * 2);
        const char* Kt0 = K_lds + cur * 2 * SHM_K; const char* Kt1 = Kt0 + SHM_K; const int ka0 = kb0 + cur * 2 * SHM_K, ka1 = ka0 + SHM_K, va = vb0 + cur * 2 * SHM_V;
        STAGE0(va, 0, Kt0, ka0 + 32 * KROW_MLA);
        STAGE1(Kt0, false);
        STAGE0(va, 1, Kt0 + 32 * KROW_MLA, ka1);
        STAGE1(Kt0 + 32 * KROW_MLA, false);
        if (more) DMA(nxt * 2 + 1);
        STAGE0(va + SHM_V, 0, Kt1, ka1 + 32 * KROW_MLA);
        STAGE1(Kt1, false);
        STAGE0(va + SHM_V, 1, Kt1 + 32 * KROW_MLA, 0);
        PKN(s0, 0, pa00); PKN(s0, 8, pa01);
        asm volatile("s_waitcnt vmcnt(0)" ::: "memory");
        __syncthreads();
        k_issue(kf, kb0 + nxt * 2 * SHM_K); SBAR();
        LWAIT(6); SBAR(); PVC(pa00, pa01, o00, o01); EXPA(s1, ps1); SBAR(); LWAIT(0); SBAR(); QKA(s0, q0, m0); EXPB(s1, ps1); SBAR();
        CHECK(s1, ps1, Kt1 + 32 * KROW_MLA, q1, m1, l1, o10, o11, al_l + 32);
        cur = nxt;
    }
    PKN(s1, 0, pa10); PKN(s1, 8, pa11);
    asm volatile("s_waitcnt lgkmcnt(0)" ::: "memory");
    PVC(pa10, pa11, o10, o11);
    __syncthreads();
#undef MF
#undef QKA
#undef PVC
#undef VISSUE
#undef EXPA
#undef EXPB
#undef CHECK
#undef LWAIT
#undef STAGE0
#undef STAGE1
    if (hi == 0) { li_l[r32] = l0; li_l[32 + r32] = l1; } asm volatile("s_waitcnt lgkmcnt(0)" ::: "memory");
    {   bf16_t* stg = (bf16_t*)(lds + OFF_V) + wid * 4096;
        unsigned sb = (unsigned)(uintptr_t)(LAS char*)(lds + OFF_V) + wid * 8192 + (4 * hi * 64 + r32) * 2; asm volatile("" : "+v"(sb));
        unsigned lb = (unsigned)(uintptr_t)(LAS char*)li_l + 16 * hi; asm volatile("" : "+v"(lb));
        LAS bf16_t* sp = (LAS bf16_t*)(uintptr_t)sb; const LAS float* lp = (const LAS float*)(uintptr_t)lb;
#pragma unroll
        for (int r = 0; r < 16; ++r) { const int c = (r & 3) + 8 * (r >> 2); const float ra = __builtin_amdgcn_rcpf(lp[c]), rb = __builtin_amdgcn_rcpf(lp[32 + c]);
            sp[c * 64] = (bf16_t)(cvt_pk_bf16(o00[r] * ra, 0.f) & 0xffffu); sp[c * 64 + 32] = (bf16_t)(cvt_pk_bf16(o01[r] * ra, 0.f) & 0xffffu);
            sp[(32 + c) * 64] = (bf16_t)(cvt_pk_bf16(o10[r] * rb, 0.f) & 0xffffu); sp[(32 + c) * 64 + 32] = (bf16_t)(cvt_pk_bf16(o11[r] * rb, 0.f) & 0xffffu); }
        asm volatile("s_waitcnt lgkmcnt(0)" ::: "memory");
        bf16_t* Ow = O + (size_t)(wid * 64) * 512;
        int ln = lane; asm volatile("" : "+v"(ln));
        const bf16_t* sl = stg + (ln >> 3) * 64 + (ln & 7) * 8; bf16_t* og = Ow + (size_t)(ln >> 3) * 512 + (ln & 7) * 8;
#pragma unroll
        for (int i = 0; i < 8; ++i) { const u32x4 v = *(const u32x4*)(sl + i * 8 * 64); *(u32x4*)(og + (size_t)i * 8 * 512) = v; } }
    __syncthreads();
#undef DMA
}

__device__ __forceinline__ void attn_na2(const bf16_t* __restrict__ Qa, const bf16_t* __restrict__ Ka, const bf16_t* __restrict__ Vv, bf16_t* __restrict__ O,
                                         int ntreal, int krow0, int qrow0, const float* __restrict__ rpbh, char* lds, const char* wsb) {
    constexpr int KROW = KROW_NA, ld = NPROJ;
    constexpr int N_SHV = 8192, N_SHK = 64 * KROW_NA, N_OFF_K = 8 * N_SHV, N_OFF_BIAS = N_OFF_K + 8 * N_SHK;
    static_assert(N_OFF_BIAS + 2048 <= 144 * 1024, "NA LDS");
    const int tid = threadIdx.x, wid = __builtin_amdgcn_readfirstlane(tid >> 6), lane = tid & 63, r32 = lane & 31, hi = lane >> 5;
    char* V_lds = lds; char* K_lds = lds + N_OFF_K; float* biasL = (float*)(lds + N_OFF_BIAS);
    const int rp = wid >> 2, cg = wid & 3, qh = r32 >> 4, qr = qrow0 + 2 * rp + qh, qcol = 16 * cg + (r32 & 15);
    const int rs0 = min(max(qr - 4, 0), 120), cs = min(max(qcol - 8, 0), 48), c0 = min(max(16 * cg - 8, 0), 32);
    const int rsa = min(max(qrow0 + 2 * rp - 4, 0), 120), rsb = min(max(qrow0 + 2 * rp + 1 - 4, 0), 120), tlo = rsa - krow0, thi = rsb + 7 - krow0;
    const int vb0 = (int)(uintptr_t)V_lds + v_rd_base(lane) + (c0 >> 3) * 1024;
    unsigned offV, offK0, offK1;
    {   const unsigned oK = (unsigned)((const char*)Ka - wsb) + (unsigned)krow0 * 64u * (unsigned)(ld * 2), oV = (unsigned)((const char*)Vv - wsb) + (unsigned)krow0 * 64u * (unsigned)(ld * 2);
        { const int j = wid * 64 + lane, sub = j >> 5, k = (sub >> 1) * 8 + ((j >> 2) & 7), c = (sub & 1) * 32 + (j & 3) * 8; offV = oV + k * (ld * 2) + c * 2; }
        { const int j = wid * 64 + lane, row = j / 9, cc = j - row * 9; offK0 = oK + row * (ld * 2) + (cc == 8 ? 0 : cc) * 16; }
        { const int j = (wid == 0 ? 512 : wid * 64) + lane, row = j / 9, cc = j - row * 9; offK1 = oK + row * (ld * 2) + (cc == 8 ? 0 : cc) * 16; } }
    LAS char* Vl = (LAS char*)V_lds + wid * 1024; LAS char* Kl = (LAS char*)K_lds + wid * 1024; LAS char* Kl1 = (LAS char*)K_lds + (wid == 0 ? 8192 : wid * 1024);
#define DMA(t) do { const unsigned to_ = (unsigned)(t) * 64u * (unsigned)(ld * 2); const int b_ = (t) & 7; \
        __builtin_amdgcn_global_load_lds((const unsigned*)(wsb + offV + to_), (LAS unsigned*)(Vl + b_ * N_SHV), 16, 0, 0); \
        __builtin_amdgcn_global_load_lds((const unsigned*)(wsb + offK0 + to_), (LAS unsigned*)(Kl + b_ * N_SHK), 16, 0, 0); \
        __builtin_amdgcn_global_load_lds((const unsigned*)(wsb + offK1 + to_), (LAS unsigned*)(Kl1 + b_ * N_SHK), 16, 0, 0); } while (0)
    float m = -1e20f, l = 0.f; f32x16 o0 = {}, o1 = {};
#define NA_PAIR(ba, bb, ta_) do { \
        const char* Ka_ = K_lds + (ba) * N_SHK + (c0 + r32) * KROW + hi * 16; const char* Kb_ = K_lds + (bb) * N_SHK + (c0 + r32) * KROW + hi * 16; f32x16 s0_, s1_; { const f32x16 z_ = {}; \
            s0_ = __builtin_amdgcn_mfma_f32_32x32x16_bf16(*reinterpret_cast<const bf16x8*>(Ka_), q[0], z_, 0, 0, 0); s1_ = __builtin_amdgcn_mfma_f32_32x32x16_bf16(*reinterpret_cast<const bf16x8*>(Kb_), q[0], z_, 0, 0, 0); \
            _Pragma("unroll") for (int d0 = 1; d0 < 4; ++d0) { s0_ = __builtin_amdgcn_mfma_f32_32x32x16_bf16(*reinterpret_cast<const bf16x8*>(Ka_ + d0 * 32), q[d0], s0_, 0, 0, 0); \
                s1_ = __builtin_amdgcn_mfma_f32_32x32x16_bf16(*reinterpret_cast<const bf16x8*>(Kb_ + d0 * 32), q[d0], s1_, 0, 0, 0); } } \
        const int vba_ = vb0 + (ba) * N_SHV, vbb_ = vb0 + (bb) * N_SHV; \
        const s16x4 va0 = tr_read<v_rd_off(0, 0, 0)>(vba_), vh0 = tr_read<v_rd_off(0, 0, 1)>(vba_), va1 = tr_read<v_rd_off(0, 1, 0)>(vba_), vh1 = tr_read<v_rd_off(0, 1, 1)>(vba_); \
        const s16x4 va2 = tr_read<v_rd_off(1, 0, 0)>(vba_), vh2 = tr_read<v_rd_off(1, 0, 1)>(vba_), va3 = tr_read<v_rd_off(1, 1, 0)>(vba_), vh3 = tr_read<v_rd_off(1, 1, 1)>(vba_); \
        const s16x4 wa0 = tr_read<v_rd_off(0, 0, 0)>(vbb_), wh0 = tr_read<v_rd_off(0, 0, 1)>(vbb_), wa1 = tr_read<v_rd_off(0, 1, 0)>(vbb_), wh1 = tr_read<v_rd_off(0, 1, 1)>(vbb_); \
        const s16x4 wa2 = tr_read<v_rd_off(1, 0, 0)>(vbb_), wh2 = tr_read<v_rd_off(1, 0, 1)>(vbb_), wa3 = tr_read<v_rd_off(1, 1, 0)>(vbb_), wh3 = tr_read<v_rd_off(1, 1, 1)>(vbb_); \
        const int kra_ = krow0 + (ta_); const bool vra_ = (kra_ >= rs0) && (kra_ < rs0 + 8), vrb_ = (kra_ + 1 >= rs0) && (kra_ + 1 < rs0 + 8); int dcol_ = c0 + 4 * hi - cs; asm volatile("" : "+v"(dcol_)); \
        const LAS float* bl_ = (const LAS float*)((LAS char*)lds + N_OFF_BIAS) + ((kra_ - qr + 7) * 31 + c0 - qcol + 15 + 4 * hi); \
        float pmax_ = -1e30f; \
        _Pragma("unroll") for (int r = 0; r < 16; ++r) { const int cc_ = (r & 3) + 8 * (r >> 2); const bool inc_ = (unsigned)(cc_ + dcol_) < 16u; \
            float ba_ = bl_[cc_], bb_ = bl_[31 + cc_]; asm volatile("" : "+v"(ba_), "+v"(bb_));        \
            s0_[r] = (vra_ && inc_) ? s0_[r] + ba_ : -1e30f; s1_[r] = (vrb_ && inc_) ? s1_[r] + bb_ : -1e30f; pmax_ = fmaxf(pmax_, fmaxf(s0_[r], s1_[r])); } \
        { auto rr_ = __builtin_amdgcn_permlane32_swap(__float_as_uint(pmax_), __float_as_uint(pmax_), false, false); pmax_ = fmaxf(__uint_as_float(rr_[0]), __uint_as_float(rr_[1])); } \
        if (!__all(pmax_ <= m + THR)) { const float mn_ = fmaxf(m, pmax_), al_ = __builtin_amdgcn_exp2f(m - mn_); m = mn_; l *= al_; \
            _Pragma("unroll") for (int r = 0; r < 16; ++r) { o0[r] *= al_; o1[r] *= al_; } } \
        float ps_ = 0.f; \
        _Pragma("unroll") for (int r = 0; r < 16; ++r) { s0_[r] = __builtin_amdgcn_exp2f(s0_[r] - m); s1_[r] = __builtin_amdgcn_exp2f(s1_[r] - m); ps_ += s0_[r] + s1_[r]; } \
        l += ps_; \
        bf16x8 pa0_, pa1_, pb0_, pb1_; PKN(s0_, 0, pa0_); PKN(s0_, 8, pa1_); PKN(s1_, 0, pb0_); PKN(s1_, 8, pb1_); \
        asm volatile("s_waitcnt lgkmcnt(0)" ::: "memory"); SBAR(); \
        o0 = __builtin_amdgcn_mfma_f32_32x32x16_bf16(PKV(va0, vh0), pa0_, o0, 0, 0, 0); o1 = __builtin_amdgcn_mfma_f32_32x32x16_bf16(PKV(va2, vh2), pa0_, o1, 0, 0, 0); \
        o0 = __builtin_amdgcn_mfma_f32_32x32x16_bf16(PKV(va1, vh1), pa1_, o0, 0, 0, 0); o1 = __builtin_amdgcn_mfma_f32_32x32x16_bf16(PKV(va3, vh3), pa1_, o1, 0, 0, 0); \
        o0 = __builtin_amdgcn_mfma_f32_32x32x16_bf16(PKV(wa0, wh0), pb0_, o0, 0, 0, 0); o1 = __builtin_amdgcn_mfma_f32_32x32x16_bf16(PKV(wa2, wh2), pb0_, o1, 0, 0, 0); \
        o0 = __builtin_amdgcn_mfma_f32_32x32x16_bf16(PKV(wa1, wh1), pb1_, o0, 0, 0, 0); o1 = __builtin_amdgcn_mfma_f32_32x32x16_bf16(PKV(wa3, wh3), pb1_, o1, 0, 0, 0); } while (0)
#pragma unroll
    for (int t = 0; t < 6; ++t) DMA(t);
    bf16x8 q[4];
    {   const bf16_t* Qw = Qa + (size_t)((2 * rp + qh) * 64 + qcol) * ld + hi * 8;
#pragma unroll
        for (int d0 = 0; d0 < 4; ++d0) q[d0] = *reinterpret_cast<const bf16x8*>(Qw + d0 * 16); }
    for (int i = tid; i < 15 * 31; i += 512) biasL[i] = rpbh[i] * LOG2E;
    asm volatile("s_waitcnt vmcnt(0)" ::: "memory");
    asm volatile("s_waitcnt lgkmcnt(0)" ::: "memory"); __builtin_amdgcn_s_barrier();
    const int NI = (ntreal + 1) >> 1;
    for (int it = 0; it < NI; ++it) {
        const int ta = 2 * it, tb = ta + 1;
        if (ta + 6 < ntreal) DMA(ta + 6);
        if (ta + 7 < ntreal) DMA(ta + 7);
        if (tb >= tlo && ta <= thi) NA_PAIR(ta & 7, tb & 7, ta);
        if (ta + 7 < ntreal) asm volatile("s_waitcnt vmcnt(12)" ::: "memory"); else asm volatile("s_waitcnt vmcnt(0)" ::: "memory");
        asm volatile("s_waitcnt lgkmcnt(0)" ::: "memory"); __builtin_amdgcn_s_barrier();
    }
    asm volatile("s_waitcnt vmcnt(0)" ::: "memory");
    { auto rr_ = __builtin_amdgcn_permlane32_swap(__float_as_uint(l), __float_as_uint(l), false, false); l = __uint_as_float(rr_[0]) + __uint_as_float(rr_[1]); }
    {   const float rl = __builtin_amdgcn_rcpf(l);
        bf16_t* Ow = O + (size_t)((2 * rp + qh) * 64 + qcol) * 512 + 4 * hi;
#pragma unroll
        for (int g = 0; g < 4; ++g) {
            u32x2 w0 = {cvt_pk_bf16(o0[4 * g] * rl, o0[4 * g + 1] * rl), cvt_pk_bf16(o0[4 * g + 2] * rl, o0[4 * g + 3] * rl)}; *(u32x2*)(Ow + 8 * g) = w0;
            u32x2 w1 = {cvt_pk_bf16(o1[4 * g] * rl, o1[4 * g + 1] * rl), cvt_pk_bf16(o1[4 * g + 2] * rl, o1[4 * g + 3] * rl)}; *(u32x2*)(Ow + 32 + 8 * g) = w1; } }
#undef DMA
#undef NA_PAIR
}
#undef PK4
#undef PKN
#undef PKV
#undef SBAR
}

constexpr size_t MiB = 1u << 20;
constexpr size_t WS_CTL = 0, CTL_ZERO_BYTES = 1 * MiB;
constexpr size_t WS_WIN = 2 * MiB;
constexpr size_t WS_WUQ = 11 * MiB;
constexpr size_t WS_WUKV = 12 * MiB;
constexpr size_t WS_WNA = 13 * MiB, WS_WMLA = 14 * MiB;
constexpr size_t WS_WOUT = 15 * MiB;
constexpr size_t WS_W1 = 18 * MiB;
constexpr size_t WS_W2 = 146 * MiB;
constexpr size_t WS_XN = 210 * MiB;
constexpr size_t WS_PROJ = 242 * MiB;
constexpr size_t WS_QN = 378 * MiB, WS_QR = 394 * MiB, WS_KN = 402 * MiB, WS_KR = 418 * MiB, WS_VM = 419 * MiB;
constexpr size_t WS_ONA = 435 * MiB, WS_OMLA = 451 * MiB;
constexpr size_t WS_MERGED = 467 * MiB;
constexpr size_t WS_TMP = 499 * MiB;
constexpr size_t WS_LIST = 563 * MiB;
constexpr size_t WS_TOKPOS = 565 * MiB, WS_TOKG = 566 * MiB;
constexpr size_t WS_ACT = 568 * MiB;
constexpr size_t WS_YIT = 712 * MiB;
constexpr size_t WS_SSQ = 856 * MiB;
constexpr size_t WS_MODP = 857 * MiB;
constexpr size_t WS_WRT = 858 * MiB;
constexpr size_t WS_END = 859 * MiB;
constexpr int CW_BAR = 4096;
constexpr int CW_CNT = 8192;
constexpr int CW_NAQ = 9008;
constexpr int CW_XMAP = 9016;
constexpr int CW_RBC = 9040;
constexpr int CW_MOD = 16384;
constexpr int CW_ROPE = 32768;
static_assert((CW_ROPE + 2048) * 4 <= (int)CTL_ZERO_BYTES, "CTL");

constexpr int RING_BYTES = 131072;
constexpr int TAB_OFF = RING_BYTES;
constexpr int TAB_BLK = TAB_OFF, TAB_GATH = TAB_OFF + 2048;
constexpr int MISC_OFF = TAB_GATH + 11 * 1024;
constexpr int LDS_BYTES = 147456;
static_assert(MISC_OFF + 256 <= LDS_BYTES, "LDS map");

#define RLX_AGENT __ATOMIC_RELAXED, __HIP_MEMORY_SCOPE_AGENT
#define LDS_WAIT() asm volatile("s_waitcnt lgkmcnt(0)" ::: "memory")

#define XB_TMO      128
#define XB_XCNT(j)  (256  + 64 * (j))
#define XB_XSUB(j)  (1280 + 64 * (j))
#define XB_XGEN(j)  (2304 + 64 * (j))
#define XB_TOP      3328
#define XB_TOPGEN   3392
#define XCD_BAR_WORDS 3456
#define XB_SPIN_CAP (1u << 22)
__device__ __forceinline__ unsigned xb_ld(unsigned* p)              { return __hip_atomic_load(p, __ATOMIC_RELAXED, __HIP_MEMORY_SCOPE_AGENT); }
__device__ __forceinline__ unsigned xb_add(unsigned* p, unsigned v) { return __hip_atomic_fetch_add(p, v, __ATOMIC_RELAXED, __HIP_MEMORY_SCOPE_AGENT); }
__device__ __forceinline__ unsigned xb_xcc_id() { return (unsigned)__builtin_amdgcn_s_getreg((3 << 11) | 20) & 0xFu; }
#define XB_SPIN(cond, bar) do { unsigned _sp = 0; while (cond) { __builtin_amdgcn_s_sleep(1); \
    if ((++_sp & 255u) == 0u) { if (xb_ld(&(bar)[XB_TMO])) break; if (_sp > XB_SPIN_CAP) { atomicAdd(&(bar)[XB_TMO], 1u); break; } } } } while (0)
struct XcdBarrier { unsigned* bar; unsigned x; volatile LAS unsigned* st; };
__device__ __forceinline__ XcdBarrier xcd_barrier_post(unsigned* bar, volatile LAS unsigned* st) {
    XcdBarrier b; b.bar = bar; b.x = xb_xcc_id(); b.st = st;
    if (threadIdx.x == 0) (void)xb_add(&bar[XB_XCNT(b.x)], 1u);
    return b;
}
__device__ __forceinline__ void xcd_barrier_complete(unsigned* bar, unsigned x, unsigned& nloc, unsigned& nx) {
    const unsigned G = gridDim.x * gridDim.y * gridDim.z;
    unsigned sum, cnt, mine, sp = 0u;
    for (;;) {
        sum = 0u; cnt = 0u; mine = 0u;
#pragma unroll
        for (unsigned j = 0; j < 16; ++j) { const unsigned c = xb_ld(&bar[XB_XCNT(j)]); sum += c; cnt += (c > 0u) ? 1u : 0u; mine = (j == x) ? c : mine; }
        if (sum == G) break;
        __builtin_amdgcn_s_sleep(1);
        if ((++sp & 255u) == 0u) { if (xb_ld(&bar[XB_TMO])) break; if (sp > XB_SPIN_CAP) { atomicAdd(&bar[XB_TMO], 1u); break; } }
    }
    nloc = mine > 0u ? mine : 1u; nx = cnt > 0u ? cnt : 1u;
}
__device__ __forceinline__ void xcd_barrier(const XcdBarrier& b) {
    asm volatile("s_waitcnt vmcnt(0)" ::: "memory");
    __syncthreads();
    if (threadIdx.x == 0) {
        unsigned* bar = b.bar;
        __builtin_amdgcn_s_waitcnt(0);
        unsigned nloc = b.st[0], nx = b.st[1];
        if (nloc == 0u) { xcd_barrier_complete(bar, b.x, nloc, nx); b.st[0] = nloc; b.st[1] = nx; }
        const unsigned old = xb_add(&bar[XB_XSUB(b.x)], 1u);
        const unsigned gen = old / nloc;
        if (old + 1u == (gen + 1u) * nloc) {
            __builtin_amdgcn_fence(__ATOMIC_RELEASE, "agent");
            asm volatile("s_waitcnt vmcnt(0)" ::: "memory");
            const unsigned og = xb_add(&bar[XB_TOP], 1u);
            const unsigned tg = og / nx;
            if (og + 1u == (tg + 1u) * nx) xb_add(&bar[XB_TOPGEN], 1u);
            else XB_SPIN(xb_ld(&bar[XB_TOPGEN]) == tg, bar);
            __builtin_amdgcn_fence(__ATOMIC_ACQUIRE, "agent");
            xb_add(&bar[XB_XGEN(b.x)], 1u);
            asm volatile("s_waitcnt vmcnt(0)" ::: "memory");
        } else {
            XB_SPIN(xb_ld(&bar[XB_XGEN(b.x)]) == gen, bar);
            __builtin_amdgcn_fence(__ATOMIC_ACQUIRE, "agent");
            asm volatile("s_waitcnt vmcnt(0)" ::: "memory");
        }
    }
    __syncthreads();
}
__device__ __forceinline__ void xcd_barrier_local(const XcdBarrier& b) {
    asm volatile("s_waitcnt vmcnt(0)" ::: "memory");
    __syncthreads();
    if (threadIdx.x == 0) {
        unsigned* bar = b.bar;
        __builtin_amdgcn_s_waitcnt(0);
        const unsigned nloc = b.st[0];
        const unsigned old = xb_add(&bar[XB_XSUB(b.x)], 1u);
        const unsigned gen = old / nloc;
        if (old + 1u == (gen + 1u) * nloc) xb_add(&bar[XB_XGEN(b.x)], 1u);
        else XB_SPIN(xb_ld(&bar[XB_XGEN(b.x)]) == gen, bar);
        __builtin_amdgcn_fence(__ATOMIC_ACQUIRE, "agent");
        asm volatile("s_waitcnt vmcnt(0)" ::: "memory");
    }
    __syncthreads();
}

constexpr int NWAVES = 8;
struct Args { const float* in[24]; float* out; unsigned char* ws; int ph_lo, ph_hi; };
enum { I_X = 0, I_C, I_WADA, I_BADA, I_GAPRE, I_GAPOST, I_WIN, I_BGATE, I_RPB, I_QNG, I_KVNG, I_WUQ, I_WUKV, I_WNAUP, I_WMLAUP, I_WOUT, I_GFPRE, I_GFPOST, I_WR, I_BR, I_W1, I_B1, I_W2, I_B2 };

__device__ __forceinline__ void tr_store_tile(LAS unsigned char* scr, bf16_t* dst, int K, int n0, int k0, int lane) {
    LDS_WAIT(); asm volatile("" ::: "memory");
#pragma unroll
    for (int j = 0; j < 8; ++j) { const int idx = j * 64 + lane, n = idx >> 3, ch = idx & 7;
        const u32x4 v = *(const LAS u32x4*)(scr + n * 144 + ch * 16);
        *(GAS u32x4*)(dst + (size_t)(n0 + n) * K + k0 + ch * 8) = v; }
    LDS_WAIT(); asm volatile("" ::: "memory");
}
__device__ __forceinline__ void tr_tile_fast(const float* src, int Nsrc, int src0, const float* kscale, bf16_t* dst, int K, int n0, int k0, LAS unsigned char* scr, int lane) {
    f32x4 a[8], b[8];
#pragma unroll
    for (int st = 0; st < 8; ++st) { const int kq = st * 4 + (lane >> 4), c4 = (lane & 15) * 4, k = 2 * kq;
        a[st] = *(const GAS f32x4*)(src + (size_t)(k0 + k) * Nsrc + src0 + c4); b[st] = *(const GAS f32x4*)(src + (size_t)(k0 + k + 1) * Nsrc + src0 + c4); }
    if (kscale) {
#pragma unroll
        for (int st = 0; st < 8; ++st) { const int k = 2 * (st * 4 + (lane >> 4)); a[st] = a[st] * kscale[k0 + k]; b[st] = b[st] * kscale[k0 + k + 1]; } }
#pragma unroll
    for (int st = 0; st < 8; ++st) { const int kq = st * 4 + (lane >> 4), c4 = (lane & 15) * 4, k = 2 * kq;
#pragma unroll
        for (int i = 0; i < 4; ++i) *(LAS unsigned*)(scr + (c4 + i) * 144 + k * 2) = cvt_pk_bf16(a[st][i], b[st][i]); }
    tr_store_tile(scr, dst, K, n0, k0, lane);
}
__device__ __forceinline__ void tr_tile_slow(const float* src, int Nsrc, int srccol  , const float* kscale, bf16_t* dst, int K, int n0, int k0, LAS unsigned char* scr, int lane) {
    const int sc = srccol < 0 ? 0 : srccol; const float msk = srccol < 0 ? 0.f : 1.f;
    float v[64];
#pragma unroll
    for (int k = 0; k < 64; ++k) v[k] = src[(size_t)(k0 + k) * Nsrc + sc];
    if (kscale) {
#pragma unroll
        for (int k = 0; k < 64; ++k) v[k] *= kscale[k0 + k]; }
#pragma unroll
    for (int k = 0; k < 64; k += 2) *(LAS unsigned*)(scr + lane * 144 + k * 2) = cvt_pk_bf16(v[k] * msk, v[k + 1] * msk);
    tr_store_tile(scr, dst, K, n0, k0, lane);
}
__device__ __forceinline__ void tr_tile_fast8(const float* src, int Nsrc, int src0, unsigned char* dst, int K, int n0, int k0, LAS unsigned char* scr, int lane) {
#pragma unroll
    for (int st = 0; st < 4; ++st) { const int kq = st * 4 + (lane >> 4), c4 = (lane & 15) * 4, k = 4 * kq;
        const f32x4 a = __builtin_nontemporal_load((const f32x4*)(src + (size_t)(k0 + k) * Nsrc + src0 + c4)) * SC_W, b = __builtin_nontemporal_load((const f32x4*)(src + (size_t)(k0 + k + 1) * Nsrc + src0 + c4)) * SC_W;
        const f32x4 c = __builtin_nontemporal_load((const f32x4*)(src + (size_t)(k0 + k + 2) * Nsrc + src0 + c4)) * SC_W, d = __builtin_nontemporal_load((const f32x4*)(src + (size_t)(k0 + k + 3) * Nsrc + src0 + c4)) * SC_W;
#pragma unroll
        for (int i = 0; i < 4; ++i) { int w = __builtin_amdgcn_cvt_pk_fp8_f32(a[i], b[i], 0, false); w = __builtin_amdgcn_cvt_pk_fp8_f32(c[i], d[i], w, true);
            *(LAS int*)(scr + (c4 + i) * 80 + k) = w; } }
    LDS_WAIT(); asm volatile("" ::: "memory");
#pragma unroll
    for (int j = 0; j < 4; ++j) { const int idx = j * 64 + lane, n = idx >> 2, ch = idx & 3;
        const u32x4 v = *(const LAS u32x4*)(scr + n * 80 + ch * 16);
        __builtin_nontemporal_store(v, (u32x4*)(dst + (size_t)(n0 + n) * K + k0 + ch * 16)); }
    LDS_WAIT(); asm volatile("" ::: "memory");
}
__device__ __forceinline__ int rope_orig(int p) { return (p & 16) + 8 * (p & 1) + ((p & 15) >> 1); }

__global__ void __launch_bounds__(NWAVES * 64, 2) fwd_kernel(Args args_unused_) {
#define args (*(const __attribute__((address_space(4))) Args*)__builtin_amdgcn_kernarg_segment_ptr())
    extern __shared__ __attribute__((aligned(16))) unsigned char lds[];
    LAS unsigned char* L = (LAS unsigned char*)lds;
    volatile LAS unsigned* MISC = (volatile LAS unsigned*)(L + MISC_OFF);
    const int tid = threadIdx.x, lane = tid & 63, wave = __builtin_amdgcn_readfirstlane(tid >> 6);
    const int G = gridDim.x, bx = blockIdx.x, vcu = (G % 8 == 0) ? (bx % 8) * (G / 8) + bx / 8 : bx;
    unsigned char* ws = args.ws;
    gu32* ctl = (gu32*)(ws + WS_CTL);
    const int lo = args.ph_lo, hi = args.ph_hi;
    for (int u = tid; u < 64; u += NWAVES * 64) MISC[u] = 0u;
    __syncthreads();
    XcdBarrier bar; bar.bar = (unsigned*)(ctl + CW_BAR); bar.x = 0; bar.st = nullptr;
    const bool use_bar = (hi - lo) > 1;
    if (use_bar) bar = xcd_barrier_post((unsigned*)(ctl + CW_BAR), MISC + 8);
    if (use_bar && gridDim.x == 256 && tid == 0) { const unsigned xi_ = xb_xcc_id(); atomicMax((unsigned*)(ctl + CW_XMAP + (bx & 7)), xi_ + 1u); atomicMax((unsigned*)(ctl + CW_XMAP + 8 + (bx & 7)), 16u - xi_); }
#ifndef PHASE_MASK
#define PHASE_MASK 0xFFFF
#endif
#define IN(k) (((PHASE_MASK >> (k)) & 1) && lo <= (k) && (k) < hi)
#ifndef REPMASK
#define REPMASK 0
#endif
#define NREP(k) (1 + ((REPMASK >> (k)) & 1))
#define SEAM(k) do { if (IN(k) && IN((k) + 1)) xcd_barrier(bar); } while (0)
    const int gw = vcu * NWAVES + wave, NGW = G * NWAVES;
    float* ROPE = (float*)(ctl + CW_ROPE);
    float* MODP = (float*)(ws + WS_MODP); float* MOD = (float*)(ws + WS_MODP + 512 * 1024); float* SSQ = (float*)(ws + WS_SSQ); unsigned* CNT = (unsigned*)(ctl + CW_CNT);
    bf16_t* WINT = (bf16_t*)(ws + WS_WIN); bf16_t* WUQT = (bf16_t*)(ws + WS_WUQ); bf16_t* WUKVT = (bf16_t*)(ws + WS_WUKV);
    bf16_t* WNAT = (bf16_t*)(ws + WS_WNA); bf16_t* WMLAT = (bf16_t*)(ws + WS_WMLA); bf16_t* WOUTT = (bf16_t*)(ws + WS_WOUT);
    bf16_t* W1T = (bf16_t*)(ws + WS_W1); bf16_t* W2T = (bf16_t*)(ws + WS_W2);
    bf16_t* XN = (bf16_t*)(ws + WS_XN); bf16_t* PROJ = (bf16_t*)(ws + WS_PROJ);
    bf16_t* QN = (bf16_t*)(ws + WS_QN); bf16_t* QR = (bf16_t*)(ws + WS_QR); bf16_t* KN = (bf16_t*)(ws + WS_KN); bf16_t* KR = (bf16_t*)(ws + WS_KR); bf16_t* VM = (bf16_t*)(ws + WS_VM);
    bf16_t* ONA = (bf16_t*)(ws + WS_ONA); bf16_t* OMLA = (bf16_t*)(ws + WS_OMLA); bf16_t* MERGED = (bf16_t*)(ws + WS_MERGED);
    float* TMP = (float*)(ws + WS_TMP); unsigned* LIST = (unsigned*)(ws + WS_LIST); unsigned* TOKPOS = (unsigned*)(ws + WS_TOKPOS); float* TOKG = (float*)(ws + WS_TOKG);
    bf16_t* ACT = (bf16_t*)(ws + WS_ACT); bf16_t* YIT = (bf16_t*)(ws + WS_YIT);
    const float* X = args.in[I_X]; float* OUT = args.out; bf16_t* X1B = (bf16_t*)TMP + (size_t)MTOK * DM;

    if (IN(0)) for (int rep_ = 0; rep_ < NREP(0); ++rep_) {
        LAS unsigned char* scr = L + wave * 16384;
        if (vcu < 192) { const float* c = args.in[I_C]; const float* wada = args.in[I_WADA]; const float* bada = args.in[I_BADA];
            const int cb = vcu % 24, kc = vcu / 24, k0 = kc * 128 + wave * 16, n0 = cb * 256 + lane * 4;
            f32x4 w[16];
#pragma unroll
            for (int k = 0; k < 16; ++k) w[k] = *(const GAS f32x4*)(wada + (size_t)(k0 + k) * 6144 + n0);
            f32x4 a0 = {0.f, 0.f, 0.f, 0.f}, a1 = {0.f, 0.f, 0.f, 0.f};
#pragma unroll
            for (int k = 0; k < 16; ++k) { const float c0 = c[k0 + k], c1 = c[1024 + k0 + k]; a0 += w[k] * (c0 * sigmoidf_(c0)); a1 += w[k] * (c1 * sigmoidf_(c1)); }
            LAS f32x4* red = (LAS f32x4*)(L + 65536);
            red[(wave * 2 + 0) * 64 + lane] = a0; red[(wave * 2 + 1) * 64 + lane] = a1;
            __syncthreads();
            { const int b = tid >> 8, col = tid & 255; const LAS float* rf = (const LAS float*)red; float sm = 0.f;
#pragma unroll
              for (int wv = 0; wv < 8; ++wv) sm += rf[(wv * 2 + b) * 256 + col];
              if (kc == 0) sm += bada[cb * 256 + col];
              MODP[(kc * 2 + b) * 6144 + cb * 256 + col] = sm; }
            __syncthreads();
        }
        if (bx == 0) { for (int i = tid; i < 128 * 8; i += NWAVES * 64) { const int pos = i >> 3, j = i & 7; float c, sn; rope_cs((float)pos, j, c, sn); ROPE[pos * 16 + j] = c; ROPE[pos * 16 + 8 + j] = sn; } }
        { const float* Wr = args.in[I_WR]; float* WRT = (float*)(ws + WS_WRT);
          for (int it = NGW - 1 - gw; it < NEXP * 16; it += NGW) { const int e = it >> 4, k = (it & 15) * 64 + lane; WRT[e * 1024 + k] = Wr[(size_t)k * 32 + e]; } }
        {   constexpr int I_WIN_ = 16 * 68, I_UQ = 6 * 12, I_UKV = 4 * 16, I_UP = 8 * 16, I_OUT = 16 * 16;
            constexpr int NITEMS = I_WIN_ + I_UQ + I_UKV + 2 * I_UP + I_OUT;
            for (int it = gw; it < NITEMS; it += NGW) {
                int r = it;
                if (r < I_WIN_) { const int kb = r / 68, nb = r % 68;
                    if (nb < 34) tr_tile_fast(args.in[I_WIN], 4256, nb * 64, nullptr, WINT, 1024, nb * 64, kb * 64, scr, lane);
                    else if (nb >= 36) tr_tile_fast(args.in[I_WIN], 4256, 2208 + (nb - 36) * 64, nullptr, WINT, 1024, nb * 64, kb * 64, scr, lane);
                    else { const int n = nb * 64 + lane; const int sc = (n < 2208) ? 2176 + rope_orig(n - 2176) : -1;
                        tr_tile_slow(args.in[I_WIN], 4256, sc, nullptr, WINT, 1024, nb * 64, kb * 64, scr, lane); }
                    continue; } r -= I_WIN_;
                if (r < I_UQ) { const int kb = r / 12, nb = r % 12;
                    if (nb < 8) tr_tile_fast(args.in[I_WUQ], 768, nb * 96, args.in[I_QNG], WUQT, 384, nb * 64, kb * 64, scr, lane);
                    else { const int n = nb * 64 + lane - 512, h = n >> 5, p = n & 31;
                        tr_tile_slow(args.in[I_WUQ], 768, h * 96 + 64 + rope_orig(p), args.in[I_QNG], WUQT, 384, nb * 64, kb * 64, scr, lane); }
                    continue; } r -= I_UQ;
                if (r < I_UKV) { const int kb = r / 16, nb = r % 16;
                    const int s0 = (nb < 8) ? nb * 128 : (nb - 8) * 128 + 64;
                    tr_tile_fast(args.in[I_WUKV], 1024, s0, args.in[I_KVNG], WUKVT, 256, nb * 64, kb * 64, scr, lane); continue; } r -= I_UKV;
                if (r < I_UP) { const int kb = r / 16, nb = r % 16; tr_tile_fast(args.in[I_WNAUP], 1024, nb * 64, nullptr, WNAT, 512, nb * 64, kb * 64, scr, lane); continue; } r -= I_UP;
                if (r < I_UP) { const int kb = r / 16, nb = r % 16; tr_tile_fast(args.in[I_WMLAUP], 1024, nb * 64, nullptr, WMLAT, 512, nb * 64, kb * 64, scr, lane); continue; } r -= I_UP;
                { const int kb = r / 16, nb = r % 16; tr_tile_fast(args.in[I_WOUT], 1024, nb * 64, nullptr, WOUTT, 1024, nb * 64, kb * 64, scr, lane); }
            } }
    }
    f32x4 vx[2][2][4];
#define P1_LOAD(buf, m0_) do { _Pragma("unroll") for (int r_ = 0; r_ < 2; ++r_) { const GAS f32x4* xr_ = (const GAS f32x4*)(X + (size_t)((m0_) + r_) * DM) + lane; \
        _Pragma("unroll") for (int j_ = 0; j_ < 4; ++j_) vx[buf][r_][j_] = xr_[64 * j_]; } } while (0)
    if (IN(1) && gw * 2 < MTOK) P1_LOAD(0, gw * 2);
    SEAM(0);
    bool xl_ok = false;
    if (use_bar && IN(0) && gridDim.x == 256) { xl_ok = true;
        for (int g_ = 0; g_ < 8; ++g_) { const unsigned a_ = xb_ld((unsigned*)(ctl + CW_XMAP + g_)), b_ = xb_ld((unsigned*)(ctl + CW_XMAP + 8 + g_)); xl_ok = xl_ok && (a_ > 0u) && (a_ - 1u == 16u - b_); } }
    if (IN(1)) {
        const float* g = args.in[I_GAPRE];
        LAS float* modl = (LAS float*)L;
        for (int i = tid; i < 4096; i += NWAVES * 64) { const int b = i >> 11, c = i & 2047; float sm = 0.f;
#pragma unroll
            for (int kc = 0; kc < 8; ++kc) sm += MODP[(kc * 2 + b) * 6144 + c];
            modl[i] = sm; }
        for (int idx = bx * (NWAVES * 64) + tid; idx < 2 * 6144; idx += G * NWAVES * 64) { const int b = idx / 6144, n = idx % 6144; float sm = 0.f;
#pragma unroll
            for (int kc = 0; kc < 8; ++kc) sm += MODP[(kc * 2 + b) * 6144 + n];
            MOD[idx] = sm; }
        __syncthreads();
#define P1_ROWS(buf, m0_) do { const int b = (m0_) >> 13; float ss[2] = {0.f, 0.f}; \
            _Pragma("unroll") for (int r = 0; r < 2; ++r) _Pragma("unroll") for (int j = 0; j < 4; ++j) { const f32x4 q = vx[buf][r][j]; ss[r] += (q.x * q.x + q.y * q.y) + (q.z * q.z + q.w * q.w); } \
            _Pragma("unroll") for (int r = 0; r < 2; ++r) { const float rstd = __builtin_amdgcn_rsqf(wave_sum(ss[r]) * (1.f / DM) + RMS_EPS); \
                GAS u32x2* o8 = (GAS u32x2*)(XN + (size_t)((m0_) + r) * DM) + lane; \
                _Pragma("unroll") for (int j = 0; j < 4; ++j) { const int col = 4 * lane + 256 * j; \
                    const f32x4 gg = pg1[j], sh = *(const LAS f32x4*)(modl + b * 2048 + col), scl = *(const LAS f32x4*)(modl + b * 2048 + 1024 + col); \
                    const f32x4 h = vx[buf][r][j] * rstd * gg * (scl + 1.f) + sh; u32x2 w; w.x = cvt_pk_bf16(h[0], h[1]); w.y = cvt_pk_bf16(h[2], h[3]); o8[64 * j] = w; } } } while (0)
        f32x4 pg1[4];
#pragma unroll
        for (int j = 0; j < 4; ++j) pg1[j] = *(const f32x4*)(g + 4 * lane + 256 * j);
        for (int m0 = gw * 2; m0 < MTOK; ) {
            const int m1 = m0 + NGW * 2; P1_LOAD(1, min(m1, MTOK - 2));
            P1_ROWS(0, m0);
            if (m1 >= MTOK) break;
            const int m2 = m1 + NGW * 2; P1_LOAD(0, min(m2, MTOK - 2));
            P1_ROWS(1, m1);
            m0 = m2;
        }
        asm volatile("s_waitcnt vmcnt(0)" ::: "memory");
#undef P1_ROWS
    }
#undef P1_LOAD
    SEAM(1);
    if (IN(2)) for (int rep_ = 0; rep_ < NREP(2); ++rep_) {
        if (bx < NG_INPROJ || G < 256) {
            const int ng = G < 256 ? G : NG_INPROJ;
            pg8::SchedDense S{(const char*)XN, (const char*)WINT, (size_t)256 * 1024 * 2, (size_t)256 * 1024 * 2, MTOK / 256, NPROJ / 256, ng, bx};
            pg8::EpiInProj E{PROJ, SSQ, KR, ROPE, args.in[I_BGATE]};
            pg8::gemm_phase<pg8::EpiInProj, pg8::SchedDense, true, false, false>(L, 16, 2048, 2048, S, E);
        }
        {   LAS unsigned char* scr = L + wave * 16384;
            constexpr int I_W1_ = NEXP * 16 * 32, I_W2_ = NEXP * 16 * 16, NCHUNK = (I_W1_ + I_W2_) / 32;
            for (;;) {
                if (tid == 0) MISC[20] = atomicAdd(CNT + 64, 1u);
                __syncthreads();
                const int chunk = (int)MISC[20];
                __syncthreads();
                if (chunk >= NCHUNK) break;
#pragma unroll 1
                for (int k = 0; k < 4; ++k) { int r = chunk * 32 + wave * 4 + k;
                    if (r < I_W1_) { const int e = r / 512, q = r % 512, kb = q / 32, nb = q % 32;
                        tr_tile_fast8(args.in[I_W1] + (size_t)e * 1024 * 2048, 2048, nb * 64, (unsigned char*)W1T + (size_t)e * 2048 * 1024, 1024, nb * 64, kb * 64, scr, lane); }
                    else { r -= I_W1_; const int e = r / 256, q = r % 256, kb = q / 16, nb = q % 16;
                        tr_tile_fast8(args.in[I_W2] + (size_t)e * 1024 * 1024, 1024, nb * 64, (unsigned char*)W2T + (size_t)e * 1024 * 1024, 1024, nb * 64, kb * 64, scr, lane); } }
            } }
    }
    SEAM(2);
    if (IN(3)) for (int rep_ = 0; rep_ < NREP(3); ++rep_) {
#ifndef NO_QUP
        {   pg8::SchedDense S{(const char*)(PROJ + 1536), (const char*)WUQT, (size_t)256 * NPROJ * 2, (size_t)256 * 384 * 2, MTOK / 256, 3, G, bx};
            pg8::EpiQUp E{QN, QR, SSQ, ROPE};
            pg8::gemm_phase<pg8::EpiQUp, pg8::SchedDense, true, false, false>(L, 6, NPROJ * 2, 768, S, E); }
#endif
#ifndef NO_KVUP
        {   pg8::SchedDense S{(const char*)(PROJ + 1920), (const char*)WUKVT, (size_t)256 * NPROJ * 2, (size_t)256 * 256 * 2, MTOK / 256, 4, G, G - 1 - bx};
            pg8::EpiKVUp E{KN, VM, SSQ};
            pg8::gemm_phase<pg8::EpiKVUp, pg8::SchedDense, true, false, false>(L, 4, NPROJ * 2, 512, S, E); }
#endif
    }
    SEAM(3);
    if (IN(4)) for (int rep_ = 0; rep_ < NREP(4); ++rep_) {
#ifndef NO_MLA
        for (int u = vcu; u < 256; u += G) {
            const int bh = u >> 4, qb = u & 15, b = bh >> 3, h = bh & 7; const size_t row0 = (size_t)b * SEQ + qb * 512, key0 = (size_t)b * SEQ;
            attn::attn_mla64(QN + row0 * 512 + h * 64, QR + row0 * 256 + h * 32, KN + key0 * 512 + h * 64, KR + key0 * 32, VM + key0 * 512 + h * 64, OMLA + row0 * 512 + h * 64, (char*)lds, (const char*)ws);
        }
#endif
#ifndef NO_NA
        for (int u = vcu; u < 512; ) {
            unsigned nxt_ = 0;
            if (tid == 0) nxt_ = (unsigned)G + xb_add((unsigned*)(ctl + CW_NAQ), 1u);
            const int bh = u >> 5, rb = u & 31, b = bh >> 3, h = bh & 7; const size_t row0 = (size_t)b * SEQ + rb * 256, key0 = (size_t)b * SEQ;
            const int krow0 = min(max(4 * rb - 4, 0), 120), klast = min(max(4 * rb + 3 - 4, 0), 120) + 7, ntreal = klast - krow0 + 1, NT = (ntreal + 1) & ~1;
            attn::attn_na2(PROJ + row0 * NPROJ + h * 64, PROJ + key0 * NPROJ + 512 + h * 64, PROJ + key0 * NPROJ + 1024 + h * 64, ONA + row0 * 512 + h * 64, ntreal, krow0, 4 * rb, args.in[I_RPB] + h * 15 * 31, (char*)lds, (const char*)ws);
            if (tid == 0) MISC[32] = nxt_;
            asm volatile("s_waitcnt lgkmcnt(0)" ::: "memory"); __builtin_amdgcn_s_barrier();
            u = (int)MISC[32];
        }
#endif
    }
    SEAM(4);
    if (IN(5)) for (int rep_ = 0; rep_ < NREP(5); ++rep_) {
        pg8::SchedMerge S{(const char*)ONA, (const char*)OMLA, (const char*)WNAT, (const char*)WMLAT, MTOK / 256, 4, G, bx};
        pg8::EpiMerge E{PROJ, MERGED};
        pg8::gemm_phase<pg8::EpiMerge, pg8::SchedMerge, true, false, false, true>(L, 16, 1024, 1024, S, E);
    }
    if (IN(5) && IN(6)) { if (xl_ok) xcd_barrier_local(bar); else xcd_barrier(bar); }
    if (IN(6)) for (int rep_ = 0; rep_ < NREP(6); ++rep_) {
        pg8::SchedDense S{(const char*)MERGED, (const char*)WOUTT, (size_t)256 * 1024 * 2, (size_t)256 * 1024 * 2, MTOK / 256, 4, G, bx};
        pg8::EpiBf16Y E{(bf16_t*)TMP};
        pg8::gemm_phase<pg8::EpiBf16Y, pg8::SchedDense, true, false, false>(L, 16, 2048, 2048, S, E);
    }
    if (IN(6) && IN(7)) { if (xl_ok) xcd_barrier_local(bar); else xcd_barrier(bar); }
    if (IN(7)) {
        LAS int* sel_e = (LAS int*)(L + TAB_OFF); LAS float* sel_g = (LAS float*)(L + TAB_OFF + 1024); LAS int* sel_r = (LAS int*)(L + TAB_OFF + 2048);
        LAS int* lcnt = (LAS int*)(L + TAB_OFF + 3072); LAS int* lbase = (LAS int*)(L + TAB_OFF + 3072 + 128);
        LAS float* wl = (LAS float*)L;
        const float* gpo = args.in[I_GAPOST]; const float* gfp = args.in[I_GFPRE]; const float* br = args.in[I_BR];
        const float* WRT = (const float*)(ws + WS_WRT);
        {   f32x4 t_[16];
#pragma unroll
            for (int q = 0; q < 16; ++q) t_[q] = *((const GAS f32x4*)WRT + q * (NWAVES * 64) + tid);
#pragma unroll
            for (int q = 0; q < 16; ++q) *((LAS f32x4*)wl + q * (NWAVES * 64) + tid) = t_[q]; }
        __syncthreads();
        for (int blk = vcu; blk < MTOK / 64; blk += G) {
            if (tid < 32) lcnt[tid] = 0;
            __syncthreads();
            f32x4 hreg[8][4];
            f32x4 pga[4], pg2[4], psh[4];
            {   const int b0_ = (blk * 64) >> 13;
#pragma unroll
                for (int j = 0; j < 4; ++j) { const int col = 4 * lane + 256 * j;
                    pga[j] = *(const f32x4*)(gpo + col) * *(const f32x4*)(MOD + b0_ * 6144 + 2048 + col);
                    pg2[j] = *(const f32x4*)(gfp + col) * (*(const f32x4*)(MOD + b0_ * 6144 + 4096 + col) + 1.f); psh[j] = *(const f32x4*)(MOD + b0_ * 6144 + 3072 + col); } }
#pragma unroll
            for (int rr = 0; rr < 8; ++rr) { const int m = blk * 64 + wave * 8 + rr;
                const GAS u32x2* yr = (const GAS u32x2*)((const bf16_t*)TMP + (size_t)m * DM) + lane; const GAS f32x4* xr = (const GAS f32x4*)(X + (size_t)m * DM) + lane;
                f32x4 y[4], x1[4]; float s = 0.f;
#pragma unroll
                for (int j = 0; j < 4; ++j) { const u32x2 yw = yr[64 * j]; y[j] = (f32x4){bf16_lo(yw.x), bf16_hi(yw.x), bf16_lo(yw.y), bf16_hi(yw.y)}; x1[j] = xr[64 * j]; s += (y[j].x * y[j].x + y[j].y * y[j].y) + (y[j].z * y[j].z + y[j].w * y[j].w); }
                const float rstd = __builtin_amdgcn_rsqf(wave_sum(s) * (1.f / DM) + RMS_EPS); float s2 = 0.f;
#pragma unroll
                for (int j = 0; j < 4; ++j) {
                    x1[j] = x1[j] + pga[j] * (y[j] * rstd);
                    { u32x2 xw; xw.x = cvt_pk_bf16(x1[j][0], x1[j][1]); xw.y = cvt_pk_bf16(x1[j][2], x1[j][3]); *((GAS u32x2*)(X1B + (size_t)m * DM) + lane + 64 * j) = xw; }
                    s2 += (x1[j].x * x1[j].x + x1[j].y * x1[j].y) + (x1[j].z * x1[j].z + x1[j].w * x1[j].w); }
                const float rstd2 = __builtin_amdgcn_rsqf(wave_sum(s2) * (1.f / DM) + RMS_EPS);
                GAS int* o4 = (GAS int*)((unsigned char*)XN + (size_t)m * DM) + lane;
#pragma unroll
                for (int j = 0; j < 4; ++j) {
                    const f32x4 h = x1[j] * rstd2 * pg2[j] + psh[j];
                    int w = __builtin_amdgcn_cvt_pk_fp8_f32(h[0] * SC_H2, h[1] * SC_H2, 0, false); w = __builtin_amdgcn_cvt_pk_fp8_f32(h[2] * SC_H2, h[3] * SC_H2, w, true); o4[64 * j] = w;
                    hreg[rr][j] = h; }
            }
            const bool b5 = (lane & 32) != 0, b4 = (lane & 16) != 0, b3 = (lane & 8) != 0;
            float t0 = -3.0e38f, t1 = -3.0e38f, t2 = -3.0e38f, t3 = -3.0e38f; int i0 = 0, i1 = 0, i2 = 0, i3 = 0;
#pragma unroll 2
            for (int e = 0; e < NEXP; ++e) {
                f32x4 w[4];
#pragma unroll
                for (int j = 0; j < 4; ++j) w[j] = *(const LAS f32x4*)(wl + e * 1024 + 4 * lane + 256 * j);
                float p[8];
#pragma unroll
                for (int r = 0; r < 8; ++r) { f32x4 a = hreg[r][0] * w[0]; a += hreg[r][1] * w[1]; a += hreg[r][2] * w[2]; a += hreg[r][3] * w[3]; p[r] = (a.x + a.y) + (a.z + a.w); }
                float q[4], u[2];
#pragma unroll
                for (int i = 0; i < 4; ++i) { const auto r_ = __builtin_amdgcn_permlane32_swap(__float_as_uint(p[i]), __float_as_uint(p[i + 4]), false, false); q[i] = __uint_as_float(r_[0]) + __uint_as_float(r_[1]); }
#pragma unroll
                for (int i = 0; i < 2; ++i) { const auto r_ = __builtin_amdgcn_permlane16_swap(__float_as_uint(q[i]), __float_as_uint(q[i + 2]), false, false); u[i] = __uint_as_float(r_[0]) + __uint_as_float(r_[1]); }
                const float keep_ = b3 ? u[1] : u[0], send_ = b3 ? u[0] : u[1];
                float v = keep_ + __uint_as_float((unsigned)__builtin_amdgcn_update_dpp(0, (int)__float_as_uint(send_), 0x128  , 0xf, 0xf, false));
                v += __uint_as_float((unsigned)__builtin_amdgcn_update_dpp(0, (int)__float_as_uint(v), 0x141  , 0xf, 0xf, false));
                v += __uint_as_float((unsigned)__builtin_amdgcn_update_dpp(0, (int)__float_as_uint(v), 0x4E  , 0xf, 0xf, false));
                v += __uint_as_float((unsigned)__builtin_amdgcn_update_dpp(0, (int)__float_as_uint(v), 0xB1  , 0xf, 0xf, false));
                v += br[e];
                const bool c0 = v > t0, c1 = v > t1, c2 = v > t2, c3 = v > t3;
                t3 = c2 ? t2 : (c3 ? v : t3); i3 = c2 ? i2 : (c3 ? e : i3);
                t2 = c1 ? t1 : (c2 ? v : t2); i2 = c1 ? i1 : (c2 ? e : i2);
                t1 = c0 ? t0 : (c1 ? v : t1); i1 = c0 ? i0 : (c1 ? e : i1);
                t0 = c0 ? v : t0;             i0 = c0 ? e : i0;
            }
            {   const float e1 = __builtin_amdgcn_exp2f((t1 - t0) * LOG2E), e2 = __builtin_amdgcn_exp2f((t2 - t0) * LOG2E), e3 = __builtin_amdgcn_exp2f((t3 - t0) * LOG2E);
                const float inv = 1.f / (1.f + e1 + e2 + e3);
                const int lrow = wave * 8 + (b5 ? 4 : 0) + (b4 ? 2 : 0) + (b3 ? 1 : 0), t = lane & 7;
                if (t < 4) { const int ee = t == 0 ? i0 : t == 1 ? i1 : t == 2 ? i2 : i3;
                    const float gg = (t == 0 ? 1.f : t == 1 ? e1 : t == 2 ? e2 : e3) * inv;
                    const int rk = __hip_atomic_fetch_add(&lcnt[ee], 1, __ATOMIC_RELAXED, __HIP_MEMORY_SCOPE_WORKGROUP);
                    sel_e[lrow * 4 + t] = ee; sel_g[lrow * 4 + t] = gg; sel_r[lrow * 4 + t] = rk; } }
            __syncthreads();
            if (tid < 32) lbase[tid] = (int)atomicAdd(CNT + tid, (unsigned)lcnt[tid]);
            __syncthreads();
            if (tid < 256) { const int ee = sel_e[tid], pos = lbase[ee] + sel_r[tid], tok = blk * 64 + (tid >> 2);
                LIST[(size_t)ee * LISTCAP + pos] = (unsigned)tok; TOKPOS[(size_t)tok * 4 + (tid & 3)] = ((unsigned)ee << 16) | (unsigned)pos; TOKG[(size_t)tok * 4 + (tid & 3)] = sel_g[tid]; }
            __syncthreads();
        }
    }
    SEAM(7);
    if (IN(8) || IN(9)) {
        LAS int* blk_e = (LAS int*)(L + TAB_BLK); LAS int* eb0 = (LAS int*)(L + TAB_BLK + 1280); LAS int* ecnt = (LAS int*)(L + TAB_BLK + 1408);
        if (tid < 64) { const int c = (lane < NEXP) ? (int)__hip_atomic_load(CNT + lane, RLX_AGENT) : 0; const int n = (c + 255) >> 8; int incl = n;
#pragma unroll
            for (int o = 1; o < 64; o <<= 1) { const int t = __shfl_up(incl, o); if (lane >= o) incl += t; }
            const int start = incl - n;
            if (lane < NEXP) { eb0[lane] = start; ecnt[lane] = c; for (int i = 0; i < n; ++i) blk_e[start + i] = lane; }
            if (lane == 63) MISC[16] = (unsigned)incl; }
        __syncthreads();
        const int NB = (int)MISC[16];
        int mv_r0 = 0, mv_gx0 = 0, mv_n = 0; unsigned* RBC = (unsigned*)(ctl + CW_RBC);
        if (IN(8) && IN(9) && G == 256 && NB > 256 && NB < 320) { mv_r0 = (NB * 8) & 255; if (mv_r0 > 0) { mv_gx0 = mv_r0 >> 3; mv_n = min(NB - 256, 32 - mv_gx0); } }
        if (IN(8)) for (int rep_ = 0; rep_ < NREP(8); ++rep_) {
            for (int i = wave; i < 11; i += NWAVES) { const long Lu = (long)i * G + bx;
                if (Lu >= (long)NB * 8) {
                    const int j_ = bx - mv_r0;
                    if (mv_n > 0 && j_ >= 0 && j_ < mv_n * 4 && Lu < (long)NB * 8 + G) { const int grb_ = mv_gx0 + (j_ >> 2);
#pragma unroll
                        for (int q = 0; q < 4; ++q) { const int r = q * 64 + lane; *(LAS unsigned*)(L + TAB_GATH + i * 1024 + r * 4) = (unsigned)(grb_ * 256 + r) * 1024u; } }
                    break; }
                const int grb = (int)(Lu >> 3), e = blk_e[grb], first = eb0[e], cnt = ecnt[e];
#pragma unroll
                for (int q = 0; q < 4; ++q) { const int r = q * 64 + lane, ri = (grb - first) * 256 + r; const unsigned tok = (ri < cnt) ? LIST[(size_t)e * LISTCAP + ri] : 0u;
                    *(LAS unsigned*)(L + TAB_GATH + i * 1024 + r * 4) = tok * 1024u; } }
            __syncthreads();
            pg8::SchedMoe<8, true> S{(const char*)XN, (const char*)W1T, (size_t)2048 * 1024, blk_e, NB, G, bx, TAB_GATH, mv_gx0, mv_n, RBC, (const char*)ACT, (const char*)W2T, mv_r0};
            pg8::EpiMoe12 E{pg8::EpiMoe1{args.in[I_B1], (unsigned char*)ACT}, pg8::EpiMoe2{args.in[I_B2], (unsigned char*)YIT}};
            pg8::gemm_phase<pg8::EpiMoe12, pg8::SchedMoe<8, true>, true, true, true, false, true>(L, 8, 1024, 1024, S, E);
        }
        SEAM(8);
        if (IN(9)) for (int rep_ = 0; rep_ < NREP(9); ++rep_) {
            pg8::SchedMoe<4, false> S{(const char*)ACT, (const char*)W2T, (size_t)1024 * 1024, blk_e, NB, G, bx, 0, mv_gx0, mv_n, RBC, nullptr, nullptr, 0};
            pg8::EpiMoe2 E{args.in[I_B2], (unsigned char*)YIT};
            pg8::gemm_phase<pg8::EpiMoe2, pg8::SchedMoe<4, false>, true, false, true>(L, 8, 1024, 1024, S, E);
        }
    }
    SEAM(9);
    if (IN(10)) {
        LAS int* rbase = (LAS int*)(L + 0);
        if (tid < 64) { const int c = (lane < NEXP) ? (int)__hip_atomic_load(CNT + lane, RLX_AGENT) : 0; const int n = (c + 255) >> 8; int incl = n;
#pragma unroll
            for (int o = 1; o < 64; o <<= 1) { const int t = __shfl_up(incl, o); if (lane >= o) incl += t; }
            if (lane < NEXP) rbase[lane] = (incl - n) * 256; }
        __syncthreads();
        const float* gfo = args.in[I_GFPOST];
        const int nrows = (MTOK - gw + NGW - 1) / NGW;
        unsigned tpn[4]; float gtn[4]; unsigned yb[2][4][4]; u32x2 xb[2][4]; float gb[2][4]; f32x4 gfb[2][4], pgo[4];
#pragma unroll
        for (int j = 0; j < 4; ++j) pgo[j] = *(const f32x4*)(gfo + 4 * lane + 256 * j);
#define P10_ROW(k_) min(gw + (k_) * NGW, MTOK - 1)
#define P10_TP(k_) do { const int m_ = P10_ROW(k_); _Pragma("unroll") for (int t = 0; t < 4; ++t) { tpn[t] = TOKPOS[(size_t)m_ * 4 + t]; gtn[t] = TOKG[(size_t)m_ * 4 + t]; } } while (0)
#define P10_LOAD(buf, k_) do { const int m_ = P10_ROW(k_); _Pragma("unroll") for (int t = 0; t < 4; ++t) { const size_t row_ = (size_t)rbase[tpn[t] >> 16] + (tpn[t] & 0xffffu); \
                const GAS unsigned* yr_ = (const GAS unsigned*)((const unsigned char*)YIT + row_ * 1024) + lane; gb[buf][t] = gtn[t] * (1.f / SC_Y); \
                _Pragma("unroll") for (int j = 0; j < 4; ++j) yb[buf][t][j] = yr_[64 * j]; } \
            const GAS u32x2* xrow_ = (const GAS u32x2*)(X1B + (size_t)m_ * DM) + lane; _Pragma("unroll") for (int j = 0; j < 4; ++j) { xb[buf][j] = xrow_[64 * j]; gfb[buf][j] = *(const f32x4*)(MOD + (m_ >> 13) * 6144 + 5120 + 4 * lane + 256 * j); } } while (0)
#define P10_MATH(buf, k_) do { const int m_ = P10_ROW(k_), b_ = m_ >> 13; f32x4 y[4]; \
            _Pragma("unroll") for (int j = 0; j < 4; ++j) y[j] = (f32x4){0.f, 0.f, 0.f, 0.f}; \
            _Pragma("unroll") for (int t = 0; t < 4; ++t) { const float gs = gb[buf][t]; \
                _Pragma("unroll") for (int j = 0; j < 4; ++j) { const unsigned w = yb[buf][t][j]; const f32x2 lo = __builtin_amdgcn_cvt_pk_f32_fp8((int)w, false), hi2 = __builtin_amdgcn_cvt_pk_f32_fp8((int)w, true); \
                    y[j][0] += gs * lo[0]; y[j][1] += gs * lo[1]; y[j][2] += gs * hi2[0]; y[j][3] += gs * hi2[1]; } } \
            float s_ = 0.f; \
            _Pragma("unroll") for (int j = 0; j < 4; ++j) s_ += (y[j].x * y[j].x + y[j].y * y[j].y) + (y[j].z * y[j].z + y[j].w * y[j].w); \
            const float rstd = __builtin_amdgcn_rsqf(wave_sum(s_) * (1.f / DM) + RMS_EPS); \
            GAS f32x4* orow = (GAS f32x4*)(OUT + (size_t)m_ * DM) + lane; \
            _Pragma("unroll") for (int j = 0; j < 4; ++j) { const int col = 4 * lane + 256 * j; \
                const f32x4 gg = pgo[j], gf = gfb[buf][j]; (void)col; (void)b_; \
                const u32x2 xw = xb[buf][j]; const f32x4 x1 = {bf16_lo(xw.x), bf16_hi(xw.x), bf16_lo(xw.y), bf16_hi(xw.y)}; \
                orow[64 * j] = x1 + gf * (y[j] * rstd * gg); } } while (0)
        if (nrows > 0) {
            P10_TP(0); P10_LOAD(0, 0); P10_TP(1);
            for (int k = 0; k < nrows; k += 2) {
                P10_LOAD(1, k + 1); P10_TP(k + 2); P10_MATH(0, k);
                P10_LOAD(0, k + 2); P10_TP(k + 3); P10_MATH(1, k + 1);
            }
            asm volatile("s_waitcnt vmcnt(0)" ::: "memory");
        }
#undef P10_ROW
#undef P10_TP
#undef P10_LOAD
#undef P10_MATH
    }
#undef IN
#undef SEAM
#undef args
}

constexpr int N_PHASES = 11;
extern "C" void kernel_launch(void* const* d_in, const int* in_sizes, int n_in, void* d_out, int out_size, void* d_ws, size_t ws_size, hipStream_t stream) {
    static int grid = 0;
    if (grid == 0) {
        if (n_in != 24 || out_size != MTOK * DM || ws_size < WS_END) { fprintf(stderr, "kernel_launch: unexpected shapes (n_in %d out %d ws %zu)\n", n_in, out_size, ws_size); grid = -1; return; }
        int dev = 0, cus = 0, per_cu = 0;
        if (hipGetDevice(&dev) != hipSuccess || hipDeviceGetAttribute(&cus, hipDeviceAttributeMultiprocessorCount, dev) != hipSuccess) { grid = -1; return; }
        if (hipFuncSetAttribute((const void*)fwd_kernel, hipFuncAttributeMaxDynamicSharedMemorySize, LDS_BYTES) != hipSuccess) { fprintf(stderr, "kernel_launch: hipFuncSetAttribute failed\n"); grid = -1; return; }
        if (hipOccupancyMaxActiveBlocksPerMultiprocessor(&per_cu, (const void*)fwd_kernel, NWAVES * 64, LDS_BYTES) != hipSuccess || per_cu < 1) { fprintf(stderr, "kernel_launch: occupancy query says %d\n", per_cu); per_cu = 1; }
        (void)hipGetLastError();
        grid = cus;
    }
    if (grid < 0) return;
    (void)hipMemsetAsync((char*)d_ws + WS_CTL + 16384, 0, 32768, stream);
    Args a{};
    for (int i = 0; i < 24; ++i) a.in[i] = (const float*)d_in[i];
    a.out = (float*)d_out; a.ws = (unsigned char*)d_ws;
#if MK_N_LAUNCHES == 1
    a.ph_lo = 0; a.ph_hi = N_PHASES;
    {   void* kargs[] = {(void*)&a};
        const hipError_t ce = hipLaunchCooperativeKernel((const void*)fwd_kernel, dim3(grid), dim3(NWAVES * 64), kargs, LDS_BYTES, stream);
        if (ce != hipSuccess) fprintf(stderr, "kernel_launch: cooperative launch failed: %s (grid %d)\n", hipGetErrorName(ce), grid); }
#else
    for (int p = 0; p < N_PHASES; ++p) { a.ph_lo = p; a.ph_hi = p + 1; hipLaunchKernelGGL(fwd_kernel, dim3(grid), dim3(NWAVES * 64), LDS_BYTES, stream, a); }
#endif
    const hipError_t le = hipPeekAtLastError();
    if (le != hipSuccess) fprintf(stderr, "kernel_launch: launch failed: %s\n", hipGetErrorName(le));
}
```
